# Optimizing an MI355X kernel written in HIP

```python
import math
import jax, jax.numpy as jnp
from jax import lax
import numpy as np

D_MODEL = 1024
BATCH = 4
SEQ = 4096
DEPTH = 2

HEAD_DIM = 64
N_HEADS_A = D_MODEL // (2 * HEAD_DIM)
N_HEADS_B = D_MODEL // (2 * HEAD_DIM)
N_KV_B = max(1, N_HEADS_B // 4)
GROUP_B = N_HEADS_B // N_KV_B
MIX_WIDTH = (N_HEADS_A + N_HEADS_B) * HEAD_DIM
DILATED_CONFIGS = ((128, 1), (512, 4), (2048, 16))
SWA_RADIUS = 128
N_BUCKETS = 32
MAX_DISTANCE = 1024
D_FF = ((8 * D_MODEL // 3 + 127) // 128) * 128
PLE_DIM = 256
EPS = 1e-6
QBLOCK = 128
NEG = -1e30

QKV_WIDTHS = (N_HEADS_A * HEAD_DIM, N_HEADS_A * HEAD_DIM, N_HEADS_A * HEAD_DIM,
              N_HEADS_B * HEAD_DIM, N_KV_B * HEAD_DIM, N_KV_B * HEAD_DIM)
QKV_WIDTH = sum(QKV_WIDTHS)

kernel_name = "hybrid_dilated_swa_macaron_encoder"


def rms_norm(x, g):
    xf = x.astype(jnp.float32)
    y = xf * lax.rsqrt(jnp.mean(xf * xf, axis=-1, keepdims=True) + EPS) * g.astype(jnp.float32)
    return y.astype(x.dtype)


def swiglu(h, w_in, w_out):
    gate, up = jnp.split(h @ w_in, 2, axis=-1)
    return (jax.nn.silu(gate) * up) @ w_out


def t5_bucket(rel):
    half = N_BUCKETS // 2
    max_exact = half // 2
    ret = jnp.where(rel > 0, half, 0)
    n = jnp.abs(rel)
    nf = jnp.maximum(n, 1).astype(jnp.float32)
    large = max_exact + (jnp.log(nf / max_exact) / math.log(MAX_DISTANCE / max_exact)
                         * (half - max_exact)).astype(jnp.int32)
    large = jnp.minimum(large, half - 1)
    return ret + jnp.where(n < max_exact, n, large)


def banded_attention(q, k, v, radius, dilation, bias_heads, sink=None):
    N, Hk, G, L, E = q.shape
    bq = math.gcd(L, QBLOCK)
    nb = L // bq
    W = bq + 2 * radius
    pad = ((0, 0), (0, 0), (radius, radius), (0, 0))
    idx = (jnp.arange(nb) * bq)[:, None] + jnp.arange(W)[None, :]
    kb = jnp.pad(k, pad)[:, :, idx]
    vb = jnp.pad(v, pad)[:, :, idx]
    qb = q.reshape(N, Hk, G, nb, bq, E)
    logits = jnp.einsum('nhgbqe,nhbke->nhgbqk', qb, kb,
                        preferred_element_type=jnp.float32) * (E ** -0.5)
    rel = jnp.arange(W)[None, :] - radius - jnp.arange(bq)[:, None]
    bias = bias_heads[t5_bucket(rel * dilation)].astype(jnp.float32)
    bias = jnp.transpose(bias.reshape(bq, W, Hk, G), (2, 3, 0, 1))[:, :, None]
    in_band = jnp.abs(rel) <= radius
    in_seq = (idx >= radius) & (idx < radius + L)
    valid = in_band[None] & in_seq[:, None, :]
    logits = jnp.where(valid, logits + bias, NEG)
    m = jnp.max(logits, axis=-1)
    if sink is not None:
        sink_b = sink.astype(jnp.float32)[None, :, :, None, None]
        m = jnp.maximum(m, sink_b)
    pr = jnp.exp(logits - m[..., None])
    denom = jnp.sum(pr, axis=-1)
    if sink is not None:
        denom = denom + jnp.exp(sink_b - m)
    out = jnp.einsum('nhgbqk,nhbke->nhgbqe', pr.astype(v.dtype), vb,
                     preferred_element_type=jnp.float32) / denom[..., None]
    lse = m + jnp.log(denom)
    return out.reshape(N, Hk, G, L, E).astype(q.dtype), lse.reshape(N, Hk, G, L)


def dilated_attention(q, k, v, bias_heads):
    B, H, S, E = q.shape
    outs, lses = [], []
    for window, d in DILATED_CONFIGS:
        L = S // d
        def split(t):
            return t.reshape(B, H, L, d, E).transpose(0, 3, 1, 2, 4).reshape(B * d, H, L, E)
        o, lse = banded_attention(split(q)[:, :, None], split(k), split(v),
                                  window // (2 * d), d, bias_heads)
        outs.append(o[:, :, 0].reshape(B, d, H, L, E).transpose(0, 2, 3, 1, 4).reshape(B, H, S, E))
        lses.append(lse[:, :, 0].reshape(B, d, H, L).transpose(0, 2, 3, 1).reshape(B, H, S))
    wts = jax.nn.softmax(jnp.stack(lses), axis=0)
    return jnp.einsum('cbhs,cbhse->bhse', wts, jnp.stack(outs).astype(jnp.float32)).astype(q.dtype)


def setup_inputs(seed: int = 0) -> dict:
    key = jax.random.key(seed)
    ks = jax.random.split(key, 20)
    f32 = jnp.float32

    def nrm(k, shape):
        return jax.random.normal(k, shape, f32)

    def w(k, shape, fan_in):
        return nrm(k, shape) * fan_in ** -0.5

    def gain(k, shape):
        return 1.0 + 0.05 * nrm(k, shape)

    return {
        "x": nrm(ks[0], (BATCH, SEQ, D_MODEL)),
        "p": nrm(ks[1], (DEPTH, BATCH, SEQ, PLE_DIM)),
        "rel_bias": 0.5 * nrm(ks[2], (N_BUCKETS, N_HEADS_A + N_HEADS_B)),
        "norm_ffn1": gain(ks[3], (DEPTH, D_MODEL)),
        "ffn1_w_in": w(ks[4], (DEPTH, D_MODEL, 2 * D_FF), D_MODEL),
        "ffn1_w_out": w(ks[5], (DEPTH, D_FF, D_MODEL), D_FF),
        "norm_mix": gain(ks[6], (DEPTH, D_MODEL)),
        "w_qkv": w(ks[7], (DEPTH, D_MODEL, QKV_WIDTH), D_MODEL),
        "q_norm_a": gain(ks[8], (DEPTH, HEAD_DIM)),
        "k_norm_a": gain(ks[9], (DEPTH, HEAD_DIM)),
        "q_norm_b": gain(ks[10], (DEPTH, HEAD_DIM)),
        "k_norm_b": gain(ks[11], (DEPTH, HEAD_DIM)),
        "sink_b": 0.5 * nrm(ks[12], (DEPTH, N_HEADS_B)),
        "w_o": w(ks[13], (DEPTH, MIX_WIDTH, D_MODEL), MIX_WIDTH),
        "norm_ffn2": gain(ks[14], (DEPTH, D_MODEL)),
        "ffn2_w_in": w(ks[15], (DEPTH, D_MODEL, 2 * D_FF), D_MODEL),
        "ffn2_w_out": w(ks[16], (DEPTH, D_FF, D_MODEL), D_FF),
        "norm_ple": gain(ks[17], (DEPTH, D_MODEL)),
        "w_ple_gate": w(ks[18], (DEPTH, D_MODEL, D_MODEL), D_MODEL),
        "w_ple_proj": w(ks[19], (DEPTH, PLE_DIM, D_MODEL), PLE_DIM),
    }


def reference(x, p, rel_bias, norm_ffn1, ffn1_w_in, ffn1_w_out, norm_mix, w_qkv,
              q_norm_a, k_norm_a, q_norm_b, k_norm_b, sink_b, w_o, norm_ffn2,
              ffn2_w_in, ffn2_w_out, norm_ple, w_ple_gate, w_ple_proj):
    B, S, _ = x.shape
    split_at = [int(c) for c in np.cumsum(QKV_WIDTHS)[:-1]]
    bias_a = rel_bias[:, :N_HEADS_A]
    bias_b = rel_bias[:, N_HEADS_A:]

    def heads(t, n):
        return t.reshape(B, S, n, HEAD_DIM).transpose(0, 2, 1, 3)

    for i in range(DEPTH):
        x = x + 0.5 * swiglu(rms_norm(x, norm_ffn1[i]), ffn1_w_in[i], ffn1_w_out[i])

        h = rms_norm(x, norm_mix[i])
        qa, ka, va, qb, kb, vb = jnp.split(h @ w_qkv[i], split_at, axis=-1)

        qa = rms_norm(heads(qa, N_HEADS_A), q_norm_a[i])
        ka = rms_norm(heads(ka, N_HEADS_A), k_norm_a[i])
        oa = dilated_attention(qa, ka, heads(va, N_HEADS_A), bias_a)

        qb = rms_norm(heads(qb, N_HEADS_B), q_norm_b[i]).reshape(B, N_KV_B, GROUP_B, S, HEAD_DIM)
        kb = rms_norm(heads(kb, N_KV_B), k_norm_b[i])
        ob, _ = banded_attention(qb, kb, heads(vb, N_KV_B), SWA_RADIUS, 1, bias_b,
                                 sink_b[i].reshape(N_KV_B, GROUP_B))
        ob = ob.reshape(B, N_HEADS_B, S, HEAD_DIM)

        o = jnp.concatenate([oa, ob], axis=1).transpose(0, 2, 1, 3).reshape(B, S, MIX_WIDTH)
        x = x + o @ w_o[i]

        x = x + 0.5 * swiglu(rms_norm(x, norm_ffn2[i]), ffn2_w_in[i], ffn2_w_out[i])

        gate = jax.nn.sigmoid(rms_norm(x, norm_ple[i]) @ w_ple_gate[i])
        x = x + gate * (p[i] @ w_ple_proj[i])
    return x
```

```cpp
#include <hip/hip_runtime.h>
#include <cstdio>
#include <cstdint>

typedef unsigned short bf16_t;
constexpr int NB = 4, S = 4096, D = 1024, M = NB * S, DFF = 2816, QKVW = 2304, PLE = 256, DEPTH = 2, HD = 64;
constexpr float EPS = 1e-6f;
constexpr float QSCALE = 0.125f * 1.4426950408889634f;
constexpr float LOG2E = 1.4426950408889634f;

constexpr size_t MiB = 1u << 20;
constexpr size_t WS_CTL = 0, WS_W = 1 * MiB, WS_XB = 85 * MiB, WS_R = 117 * MiB, WS_PB = 221 * MiB, WS_PROJ = 229 * MiB, WS_SSP = 261 * MiB, WS_END = 262 * MiB;
constexpr size_t R_QA = 0, R_KA = 16 * MiB, R_VA = 32 * MiB, R_QB = 48 * MiB, R_KB = 64 * MiB, R_VB = 68 * MiB, R_O = 72 * MiB, R_ACT = 0;

__device__ __forceinline__ float bf2f(bf16_t v) { return __uint_as_float(((unsigned)v) << 16); }
__device__ __forceinline__ bf16_t f2bf(float f) { unsigned u = __float_as_uint(f); return (bf16_t)((u + 0x7fffu + ((u >> 16) & 1u)) >> 16); }

__global__ void __launch_bounds__(256) rowstat_kernel(const float* __restrict__ x, bf16_t* __restrict__ xb, float* __restrict__ ssp) {
    const int wave = threadIdx.x >> 6, lane = threadIdx.x & 63;
    const int row = blockIdx.x * 4 + wave;
    const float4* xr = (const float4*)(x + (size_t)row * D);
    float s = 0.f;
#pragma unroll
    for (int j = 0; j < 4; ++j) {
        float4 v = xr[lane + 64 * j];
        s += v.x * v.x + v.y * v.y + v.z * v.z + v.w * v.w;
        ushort4 o; o.x = f2bf(v.x); o.y = f2bf(v.y); o.z = f2bf(v.z); o.w = f2bf(v.w);
        ((ushort4*)(xb + (size_t)row * D))[lane + 64 * j] = o;
    }
#pragma unroll
    for (int o = 1; o < 64; o <<= 1) s += __shfl_xor(s, o);
    if (lane == 0) { float4 r; r.x = s; r.y = 0.f; r.z = 0.f; r.w = 0.f; ((float4*)ssp)[row] = r; }
}

__device__ __forceinline__ float row_rstd(const float* ssp, int row) {
    const float4 v = ((const float4*)ssp)[row];
    return rsqrtf(((v.x + v.y) + (v.z + v.w)) * (1.0f / D) + EPS);
}

template <typename AT> __device__ __forceinline__ float ldA(const AT* p);
template <> __device__ __forceinline__ float ldA<bf16_t>(const bf16_t* p) { return bf2f(*p); }
template <> __device__ __forceinline__ float ldA<float>(const float* p) { return *p; }

template <typename AT>
__device__ __forceinline__ void accum_tile(const AT* A, int lda, int K, const float* gain, const float* W, int ldw, int row0, int wcol0, float (&acc)[8][8], float* As, float* Bs) {
    const int tid = threadIdx.x, tx = tid & 15, ty = tid >> 4;
    for (int k0 = 0; k0 < K; k0 += 8) {
        __syncthreads();
#pragma unroll
        for (int i = 0; i < 4; ++i) { const int idx = tid + i * 256, r = idx >> 3, kk = idx & 7;
            As[kk * 132 + r] = ldA<AT>(A + (size_t)(row0 + r) * lda + k0 + kk) * (gain ? gain[k0 + kk] : 1.0f); }
#pragma unroll
        for (int i = 0; i < 4; ++i) { const int idx = tid + i * 256, kk = idx >> 7, c = idx & 127;
            Bs[kk * 128 + c] = W[(size_t)(k0 + kk) * ldw + wcol0 + c]; }
        __syncthreads();
#pragma unroll
        for (int kk = 0; kk < 8; ++kk) {
            float a[8], b[8];
#pragma unroll
            for (int i = 0; i < 8; ++i) a[i] = As[kk * 132 + ty * 8 + i];
#pragma unroll
            for (int j = 0; j < 8; ++j) b[j] = Bs[kk * 128 + tx * 8 + j];
#pragma unroll
            for (int i = 0; i < 8; ++i)
#pragma unroll
                for (int j = 0; j < 8; ++j) acc[i][j] += a[i] * b[j];
        }
    }
}
#define ZERO_ACC(acc) do { _Pragma("unroll") for (int i = 0; i < 8; ++i) _Pragma("unroll") for (int j = 0; j < 8; ++j) acc[i][j] = 0.f; } while (0)

__global__ void __launch_bounds__(256) naive_ffn_in(const bf16_t* xb, const float* ssp, const float* gain, const float* Win, bf16_t* act) {
    __shared__ float As[8 * 132]; __shared__ float Bs[8 * 128];
    const int row0 = blockIdx.y * 128, col0 = blockIdx.x * 128, tx = threadIdx.x & 15, ty = threadIdx.x >> 4;
    float ag[8][8], au[8][8]; ZERO_ACC(ag); ZERO_ACC(au);
    accum_tile<bf16_t>(xb, D, D, gain, Win, 2 * DFF, row0, col0, ag, As, Bs);
    accum_tile<bf16_t>(xb, D, D, gain, Win, 2 * DFF, row0, DFF + col0, au, As, Bs);
#pragma unroll
    for (int i = 0; i < 8; ++i) { const int row = row0 + ty * 8 + i; const float rs = row_rstd(ssp, row);
#pragma unroll
        for (int j = 0; j < 8; ++j) { const float g = ag[i][j] * rs, u = au[i][j] * rs; const float sg = g / (1.0f + __expf(-g));
            act[(size_t)row * DFF + col0 + tx * 8 + j] = f2bf(sg * u); } }
}
__global__ void __launch_bounds__(256) naive_resid(const bf16_t* A, int K, const float* W, const float* xin, float* xout, float coef) {
    __shared__ float As[8 * 132]; __shared__ float Bs[8 * 128];
    const int row0 = blockIdx.y * 128, col0 = blockIdx.x * 128, tx = threadIdx.x & 15, ty = threadIdx.x >> 4;
    float acc[8][8]; ZERO_ACC(acc);
    accum_tile<bf16_t>(A, K, K, nullptr, W, D, row0, col0, acc, As, Bs);
#pragma unroll
    for (int i = 0; i < 8; ++i) { const int row = row0 + ty * 8 + i;
#pragma unroll
        for (int j = 0; j < 8; ++j) { const size_t o = (size_t)row * D + col0 + tx * 8 + j; xout[o] = xin[o] + coef * acc[i][j]; } }
}
struct QkvOut { bf16_t *qa, *ka, *va, *qb, *kb, *vb; const float *qna, *kna, *qnb, *knb; };
__global__ void __launch_bounds__(256) naive_qkv(const bf16_t* xb, const float* ssp, const float* gain, const float* Wqkv, QkvOut o) {
    __shared__ float As[8 * 132]; __shared__ float Bs[8 * 128];
    const int row0 = blockIdx.y * 128, col0 = blockIdx.x * 128, tx = threadIdx.x & 15, ty = threadIdx.x >> 4;
    float acc[8][8]; ZERO_ACC(acc);
    accum_tile<bf16_t>(xb, D, D, gain, Wqkv, QKVW, row0, col0, acc, As, Bs);
    const int c = col0 + tx * 8;
    bf16_t* dst; const float* ng; int nh, hc; float sc = 1.0f;
    if (c < 512) { dst = o.qa; ng = o.qna; nh = 8; hc = c; sc = QSCALE; }
    else if (c < 1024) { dst = o.ka; ng = o.kna; nh = 8; hc = c - 512; }
    else if (c < 1536) { dst = o.va; ng = nullptr; nh = 8; hc = c - 1024; }
    else if (c < 2048) { dst = o.qb; ng = o.qnb; nh = 8; hc = c - 1536; sc = QSCALE; }
    else if (c < 2176) { dst = o.kb; ng = o.knb; nh = 2; hc = c - 2048; }
    else { dst = o.vb; ng = nullptr; nh = 2; hc = c - 2176; }
    const int h = hc >> 6, e0 = hc & 63;
#pragma unroll
    for (int i = 0; i < 8; ++i) { const int row = row0 + ty * 8 + i; const float rs = row_rstd(ssp, row);
        float v[8]; float ss = 0.f;
#pragma unroll
        for (int j = 0; j < 8; ++j) { v[j] = acc[i][j] * rs; ss += v[j] * v[j]; }
        ss += __shfl_xor(ss, 1); ss += __shfl_xor(ss, 2); ss += __shfl_xor(ss, 4);
        const float hr = rsqrtf(ss * (1.0f / HD) + EPS);
        const int b = row / S, s = row % S;
        bf16_t* p = dst + (((size_t)b * nh + h) * S + s) * HD + e0;
#pragma unroll
        for (int j = 0; j < 8; ++j) p[j] = f2bf(ng ? v[j] * hr * ng[e0 + j] * sc : v[j]); }
}
__global__ void __launch_bounds__(256) naive_ple(const bf16_t* xb, const float* ssp, const float* gain, const float* Wg, const float* p, const float* Wp, const float* xin, float* xout) {
    __shared__ float As[8 * 132]; __shared__ float Bs[8 * 128];
    const int row0 = blockIdx.y * 128, col0 = blockIdx.x * 128, tx = threadIdx.x & 15, ty = threadIdx.x >> 4;
    float ag[8][8], ap[8][8]; ZERO_ACC(ag); ZERO_ACC(ap);
    accum_tile<bf16_t>(xb, D, D, gain, Wg, D, row0, col0, ag, As, Bs);
    accum_tile<float>(p, PLE, PLE, nullptr, Wp, D, row0, col0, ap, As, Bs);
#pragma unroll
    for (int i = 0; i < 8; ++i) { const int row = row0 + ty * 8 + i; const float rs = row_rstd(ssp, row);
#pragma unroll
        for (int j = 0; j < 8; ++j) { const size_t o = (size_t)row * D + col0 + tx * 8 + j; const float g = 1.0f / (1.0f + __expf(-ag[i][j] * rs));
            xout[o] = xin[o] + g * ap[i][j]; } }
}

__device__ __forceinline__ int t5_bucket(int rel) {
    const int n = rel < 0 ? -rel : rel; const int ret = rel > 0 ? 16 : 0;
    if (n < 8) return ret + n;
    int large = 8 + (int)(logf((float)n / 8.0f) / 4.852030263919617f * 8.0f);
    large = large < 15 ? large : 15;
    return ret + large;
}
struct AttnIn { const bf16_t *qa, *ka, *va, *qb, *kb, *vb; const float* rel_bias; const float* sink; bf16_t* o; };
__global__ void __launch_bounds__(256) naive_attn(AttnIn a) {
    __shared__ float pl[4][400]; __shared__ int kl[4][400];
    const int wave = threadIdx.x >> 6, lane = threadIdx.x & 63;
    const int t = blockIdx.x * 4 + wave, head = blockIdx.y, b = blockIdx.z;
    const bool isA = head < 8;
    const bf16_t *q, *k, *v;
    if (isA) { q = a.qa + (((size_t)b * 8 + head) * S + t) * HD; k = a.ka + ((size_t)b * 8 + head) * S * HD; v = a.va + ((size_t)b * 8 + head) * S * HD; }
    else { const int hq = head - 8, hk = hq >> 2; q = a.qb + (((size_t)b * 8 + hq) * S + t) * HD; k = a.kb + ((size_t)b * 2 + hk) * S * HD; v = a.vb + ((size_t)b * 2 + hk) * S * HD; }
    float qf[HD];
#pragma unroll
    for (int e = 0; e < HD; ++e) qf[e] = bf2f(q[e]);
    const int nk = isA ? 387 : 257;
    float mx = -1e30f;
    for (int i = lane; i < nk; i += 64) {
        int rel;
        if (isA) { const int br = i / 129, j = i % 129 - 64; rel = j * (br == 0 ? 1 : br == 1 ? 4 : 16); }
        else rel = i - 128;
        const int tk = t + rel;
        float lg = -1e30f;
        if (tk >= 0 && tk < S) {
            float d = 0.f; const bf16_t* kr = k + (size_t)tk * HD;
#pragma unroll
            for (int e = 0; e < HD; ++e) d += qf[e] * bf2f(kr[e]);
            lg = d + a.rel_bias[t5_bucket(rel) * 16 + head] * LOG2E;
        }
        pl[wave][i] = lg; kl[wave][i] = tk;
        mx = fmaxf(mx, lg);
    }
#pragma unroll
    for (int o = 1; o < 64; o <<= 1) mx = fmaxf(mx, __shfl_xor(mx, o));
    float sinkl = 0.f;
    if (!isA) { sinkl = a.sink[head - 8] * LOG2E; mx = fmaxf(mx, sinkl); }
    float sum = 0.f;
    for (int i = lane; i < nk; i += 64) { const float lg = pl[wave][i]; const float pv = lg > -1e29f ? exp2f(lg - mx) : 0.f; pl[wave][i] = pv; sum += pv; }
#pragma unroll
    for (int o = 1; o < 64; o <<= 1) sum += __shfl_xor(sum, o);
    if (!isA) sum += exp2f(sinkl - mx);
    __syncthreads();
    float acc = 0.f;
    for (int i = 0; i < nk; ++i) { const float pv = pl[wave][i]; if (pv != 0.f) acc += pv * bf2f(v[(size_t)kl[wave][i] * HD + lane]); }
    a.o[((size_t)b * S + t) * D + head * HD + lane] = f2bf(acc / sum);
}

extern "C" void kernel_launch(void* const* d_in, const int* in_sizes, int n_in, void* d_out, int out_size, void* d_ws, size_t ws_size, hipStream_t stream) {
    if (n_in != 20 || in_sizes[0] != M * D || out_size != M * D || ws_size < WS_END) { fprintf(stderr, "kernel_launch: unexpected shapes (n_in %d, ws %zu)\n", n_in, ws_size); return; }
    const float* x = (const float*)d_in[0]; const float* p = (const float*)d_in[1]; const float* rel_bias = (const float*)d_in[2];
    const float* norm_ffn1 = (const float*)d_in[3]; const float* ffn1_w_in = (const float*)d_in[4]; const float* ffn1_w_out = (const float*)d_in[5];
    const float* norm_mix = (const float*)d_in[6]; const float* w_qkv = (const float*)d_in[7];
    const float* q_norm_a = (const float*)d_in[8]; const float* k_norm_a = (const float*)d_in[9]; const float* q_norm_b = (const float*)d_in[10]; const float* k_norm_b = (const float*)d_in[11];
    const float* sink_b = (const float*)d_in[12]; const float* w_o = (const float*)d_in[13]; const float* norm_ffn2 = (const float*)d_in[14];
    const float* ffn2_w_in = (const float*)d_in[15]; const float* ffn2_w_out = (const float*)d_in[16]; const float* norm_ple = (const float*)d_in[17];
    const float* w_ple_gate = (const float*)d_in[18]; const float* w_ple_proj = (const float*)d_in[19];
    float* out = (float*)d_out; unsigned char* ws = (unsigned char*)d_ws;
    bf16_t* xb = (bf16_t*)(ws + WS_XB); float* ssp = (float*)(ws + WS_SSP);
    bf16_t* act = (bf16_t*)(ws + WS_R + R_ACT);
    QkvOut qo; qo.qa = (bf16_t*)(ws + WS_R + R_QA); qo.ka = (bf16_t*)(ws + WS_R + R_KA); qo.va = (bf16_t*)(ws + WS_R + R_VA);
    qo.qb = (bf16_t*)(ws + WS_R + R_QB); qo.kb = (bf16_t*)(ws + WS_R + R_KB); qo.vb = (bf16_t*)(ws + WS_R + R_VB);
    bf16_t* ob = (bf16_t*)(ws + WS_R + R_O);
    rowstat_kernel<<<M / 4, 256, 0, stream>>>(x, xb, ssp);
    const float* xin = x;
    for (int l = 0; l < DEPTH; ++l) {
        naive_ffn_in<<<dim3(DFF / 128, M / 128), 256, 0, stream>>>(xb, ssp, norm_ffn1 + l * D, ffn1_w_in + (size_t)l * D * 2 * DFF, act);
        naive_resid<<<dim3(D / 128, M / 128), 256, 0, stream>>>(act, DFF, ffn1_w_out + (size_t)l * DFF * D, xin, out, 0.5f);
        xin = out;
        rowstat_kernel<<<M / 4, 256, 0, stream>>>(out, xb, ssp);
        qo.qna = q_norm_a + l * HD; qo.kna = k_norm_a + l * HD; qo.qnb = q_norm_b + l * HD; qo.knb = k_norm_b + l * HD;
        naive_qkv<<<dim3(QKVW / 128, M / 128), 256, 0, stream>>>(xb, ssp, norm_mix + l * D, w_qkv + (size_t)l * D * QKVW, qo);
        AttnIn ai; ai.qa = qo.qa; ai.ka = qo.ka; ai.va = qo.va; ai.qb = qo.qb; ai.kb = qo.kb; ai.vb = qo.vb; ai.rel_bias = rel_bias; ai.sink = sink_b + l * 8; ai.o = ob;
        naive_attn<<<dim3(S / 4, 16, NB), 256, 0, stream>>>(ai);
        naive_resid<<<dim3(D / 128, M / 128), 256, 0, stream>>>(ob, D, w_o + (size_t)l * D * D, out, out, 1.0f);
        rowstat_kernel<<<M / 4, 256, 0, stream>>>(out, xb, ssp);
        naive_ffn_in<<<dim3(DFF / 128, M / 128), 256, 0, stream>>>(xb, ssp, norm_ffn2 + l * D, ffn2_w_in + (size_t)l * D * 2 * DFF, act);
        naive_resid<<<dim3(D / 128, M / 128), 256, 0, stream>>>(act, DFF, ffn2_w_out + (size_t)l * DFF * D, out, out, 0.5f);
        rowstat_kernel<<<M / 4, 256, 0, stream>>>(out, xb, ssp);
        naive_ple<<<dim3(D / 128, M / 128), 256, 0, stream>>>(xb, ssp, norm_ple + l * D, w_ple_gate + (size_t)l * D * D, p + (size_t)l * M * PLE, w_ple_proj + (size_t)l * PLE * D, out, out);
        if (l + 1 < DEPTH) rowstat_kernel<<<M / 4, 256, 0, stream>>>(out, xb, ssp);
    }
}
```

```cpp
#include <hip/hip_runtime.h>
#include <cstdio>
#include <cstdint>

typedef unsigned short bf16_t;
constexpr int NB = 4, S = 4096, D = 1024, M = NB * S, DFF = 2816, QKVW = 2304, PLE = 256, DEPTH = 2, HD = 64;
constexpr float EPS = 1e-6f;
constexpr float QSCALE = 0.125f * 1.4426950408889634f;
constexpr float LOG2E = 1.4426950408889634f;

constexpr size_t MiB = 1u << 20;
constexpr size_t WS_CTL = 0, WS_W = 1 * MiB, WS_XB = 85 * MiB, WS_R = 117 * MiB, WS_PB = 221 * MiB, WS_PROJ = 229 * MiB, WS_SSP = 261 * MiB, WS_END = 263 * MiB + 512 * 1024;
constexpr size_t R_QA = 0, R_KA = 16 * MiB, R_VA = 32 * MiB, R_QB = 48 * MiB, R_KB = 64 * MiB, R_VB = 68 * MiB, R_O = 72 * MiB, R_ACT = 0;

__device__ __forceinline__ float bf2f(bf16_t v) { return __uint_as_float(((unsigned)v) << 16); }
__device__ __forceinline__ bf16_t f2bf(float f) { unsigned u = __float_as_uint(f); return (bf16_t)((u + 0x7fffu + ((u >> 16) & 1u)) >> 16); }

__global__ void __launch_bounds__(256) rowstat_kernel(const float* __restrict__ x, bf16_t* __restrict__ xb, float* __restrict__ ssp) {
    const int wave = threadIdx.x >> 6, lane = threadIdx.x & 63;
    const int row = blockIdx.x * 4 + wave;
    const float4* xr = (const float4*)(x + (size_t)row * D);
    float s = 0.f;
#pragma unroll
    for (int j = 0; j < 4; ++j) {
        float4 v = xr[lane + 64 * j];
        s += v.x * v.x + v.y * v.y + v.z * v.z + v.w * v.w;
        ushort4 o; o.x = f2bf(v.x); o.y = f2bf(v.y); o.z = f2bf(v.z); o.w = f2bf(v.w);
        ((ushort4*)(xb + (size_t)row * D))[lane + 64 * j] = o;
    }
#pragma unroll
    for (int o = 1; o < 64; o <<= 1) s += __shfl_xor(s, o);
    if (lane < 4) { float4 r; r.x = lane == 0 ? s : 0.f; r.y = 0.f; r.z = 0.f; r.w = 0.f; ((float4*)ssp)[row * 4 + lane] = r; }
}

__device__ __forceinline__ float row_rstd(const float* ssp, int row) {
    float s = 0.f;
#pragma unroll
    for (int j = 0; j < 4; ++j) { const float4 v = ((const float4*)ssp)[row * 4 + j]; s += (v.x + v.y) + (v.z + v.w); }
    return rsqrtf(s * (1.0f / D) + EPS);
}

template <typename AT> __device__ __forceinline__ float ldA(const AT* p);
template <> __device__ __forceinline__ float ldA<bf16_t>(const bf16_t* p) { return bf2f(*p); }
template <> __device__ __forceinline__ float ldA<float>(const float* p) { return *p; }

template <typename AT>
__device__ __forceinline__ void accum_tile(const AT* A, int lda, int K, const float* gain, const float* W, int ldw, int row0, int wcol0, float (&acc)[8][8], float* As, float* Bs) {
    const int tid = threadIdx.x, tx = tid & 15, ty = tid >> 4;
    for (int k0 = 0; k0 < K; k0 += 8) {
        __syncthreads();
#pragma unroll
        for (int i = 0; i < 4; ++i) { const int idx = tid + i * 256, r = idx >> 3, kk = idx & 7;
            As[kk * 132 + r] = ldA<AT>(A + (size_t)(row0 + r) * lda + k0 + kk) * (gain ? gain[k0 + kk] : 1.0f); }
#pragma unroll
        for (int i = 0; i < 4; ++i) { const int idx = tid + i * 256, kk = idx >> 7, c = idx & 127;
            Bs[kk * 128 + c] = W[(size_t)(k0 + kk) * ldw + wcol0 + c]; }
        __syncthreads();
#pragma unroll
        for (int kk = 0; kk < 8; ++kk) {
            float a[8], b[8];
#pragma unroll
            for (int i = 0; i < 8; ++i) a[i] = As[kk * 132 + ty * 8 + i];
#pragma unroll
            for (int j = 0; j < 8; ++j) b[j] = Bs[kk * 128 + tx * 8 + j];
#pragma unroll
            for (int i = 0; i < 8; ++i)
#pragma unroll
                for (int j = 0; j < 8; ++j) acc[i][j] += a[i] * b[j];
        }
    }
}
#define ZERO_ACC(acc) do { _Pragma("unroll") for (int i = 0; i < 8; ++i) _Pragma("unroll") for (int j = 0; j < 8; ++j) acc[i][j] = 0.f; } while (0)

__global__ void __launch_bounds__(256) naive_ffn_in(const bf16_t* xb, const float* ssp, const float* gain, const float* Win, bf16_t* act) {
    __shared__ float As[8 * 132]; __shared__ float Bs[8 * 128];
    const int row0 = blockIdx.y * 128, col0 = blockIdx.x * 128, tx = threadIdx.x & 15, ty = threadIdx.x >> 4;
    float ag[8][8], au[8][8]; ZERO_ACC(ag); ZERO_ACC(au);
    accum_tile<bf16_t>(xb, D, D, gain, Win, 2 * DFF, row0, col0, ag, As, Bs);
    accum_tile<bf16_t>(xb, D, D, gain, Win, 2 * DFF, row0, DFF + col0, au, As, Bs);
#pragma unroll
    for (int i = 0; i < 8; ++i) { const int row = row0 + ty * 8 + i; const float rs = row_rstd(ssp, row);
#pragma unroll
        for (int j = 0; j < 8; ++j) { const float g = ag[i][j] * rs, u = au[i][j] * rs; const float sg = g / (1.0f + __expf(-g));
            act[(size_t)row * DFF + col0 + tx * 8 + j] = f2bf(sg * u); } }
}
__global__ void __launch_bounds__(256) naive_resid(const bf16_t* A, int K, const float* W, const float* xin, float* xout, float coef) {
    __shared__ float As[8 * 132]; __shared__ float Bs[8 * 128];
    const int row0 = blockIdx.y * 128, col0 = blockIdx.x * 128, tx = threadIdx.x & 15, ty = threadIdx.x >> 4;
    float acc[8][8]; ZERO_ACC(acc);
    accum_tile<bf16_t>(A, K, K, nullptr, W, D, row0, col0, acc, As, Bs);
#pragma unroll
    for (int i = 0; i < 8; ++i) { const int row = row0 + ty * 8 + i;
#pragma unroll
        for (int j = 0; j < 8; ++j) { const size_t o = (size_t)row * D + col0 + tx * 8 + j; xout[o] = xin[o] + coef * acc[i][j]; } }
}
struct QkvOut { bf16_t *qa, *ka, *va, *qb, *kb, *vb; const float *qna, *kna, *qnb, *knb; };
__global__ void __launch_bounds__(256) naive_qkv(const bf16_t* xb, const float* ssp, const float* gain, const float* Wqkv, QkvOut o) {
    __shared__ float As[8 * 132]; __shared__ float Bs[8 * 128];
    const int row0 = blockIdx.y * 128, col0 = blockIdx.x * 128, tx = threadIdx.x & 15, ty = threadIdx.x >> 4;
    float acc[8][8]; ZERO_ACC(acc);
    accum_tile<bf16_t>(xb, D, D, gain, Wqkv, QKVW, row0, col0, acc, As, Bs);
    const int c = col0 + tx * 8;
    bf16_t* dst; const float* ng; int nh, hc; float sc = 1.0f;
    if (c < 512) { dst = o.qa; ng = o.qna; nh = 8; hc = c; sc = QSCALE; }
    else if (c < 1024) { dst = o.ka; ng = o.kna; nh = 8; hc = c - 512; }
    else if (c < 1536) { dst = o.va; ng = nullptr; nh = 8; hc = c - 1024; }
    else if (c < 2048) { dst = o.qb; ng = o.qnb; nh = 8; hc = c - 1536; sc = QSCALE; }
    else if (c < 2176) { dst = o.kb; ng = o.knb; nh = 2; hc = c - 2048; }
    else { dst = o.vb; ng = nullptr; nh = 2; hc = c - 2176; }
    const int h = hc >> 6, e0 = hc & 63;
#pragma unroll
    for (int i = 0; i < 8; ++i) { const int row = row0 + ty * 8 + i; const float rs = row_rstd(ssp, row);
        float v[8]; float ss = 0.f;
#pragma unroll
        for (int j = 0; j < 8; ++j) { v[j] = acc[i][j] * rs; ss += v[j] * v[j]; }
        ss += __shfl_xor(ss, 1); ss += __shfl_xor(ss, 2); ss += __shfl_xor(ss, 4);
        const float hr = rsqrtf(ss * (1.0f / HD) + EPS);
        const int b = row / S, s = row % S;
        bf16_t* p = dst + (((size_t)b * nh + h) * S + s) * HD + e0;
#pragma unroll
        for (int j = 0; j < 8; ++j) p[j] = f2bf(ng ? v[j] * hr * ng[e0 + j] * sc : v[j]); }
}
__global__ void __launch_bounds__(256) naive_ple(const bf16_t* xb, const float* ssp, const float* gain, const float* Wg, const float* p, const float* Wp, const float* xin, float* xout) {
    __shared__ float As[8 * 132]; __shared__ float Bs[8 * 128];
    const int row0 = blockIdx.y * 128, col0 = blockIdx.x * 128, tx = threadIdx.x & 15, ty = threadIdx.x >> 4;
    float ag[8][8], ap[8][8]; ZERO_ACC(ag); ZERO_ACC(ap);
    accum_tile<bf16_t>(xb, D, D, gain, Wg, D, row0, col0, ag, As, Bs);
    accum_tile<float>(p, PLE, PLE, nullptr, Wp, D, row0, col0, ap, As, Bs);
#pragma unroll
    for (int i = 0; i < 8; ++i) { const int row = row0 + ty * 8 + i; const float rs = row_rstd(ssp, row);
#pragma unroll
        for (int j = 0; j < 8; ++j) { const size_t o = (size_t)row * D + col0 + tx * 8 + j; const float g = 1.0f / (1.0f + __expf(-ag[i][j] * rs));
            xout[o] = xin[o] + g * ap[i][j]; } }
}

__device__ __forceinline__ int t5_bucket(int rel) {
    const int n = rel < 0 ? -rel : rel; const int ret = rel > 0 ? 16 : 0;
    if (n < 8) return ret + n;
    int large = 8 + (int)(logf((float)n / 8.0f) / 4.852030263919617f * 8.0f);
    large = large < 15 ? large : 15;
    return ret + large;
}
struct AttnIn { const bf16_t *qa, *ka, *va, *qb, *kb, *vb; const float* rel_bias; const float* sink; bf16_t* o; };
__global__ void __launch_bounds__(256) naive_attn(AttnIn a) {
    __shared__ float pl[4][400]; __shared__ int kl[4][400];
    const int wave = threadIdx.x >> 6, lane = threadIdx.x & 63;
    const int t = blockIdx.x * 4 + wave, head = blockIdx.y, b = blockIdx.z;
    const bool isA = head < 8;
    const bf16_t *q, *k, *v;
    if (isA) { q = a.qa + (((size_t)b * 8 + head) * S + t) * HD; k = a.ka + ((size_t)b * 8 + head) * S * HD; v = a.va + ((size_t)b * 8 + head) * S * HD; }
    else { const int hq = head - 8, hk = hq >> 2; q = a.qb + (((size_t)b * 8 + hq) * S + t) * HD; k = a.kb + ((size_t)b * 2 + hk) * S * HD; v = a.vb + ((size_t)b * 2 + hk) * S * HD; }
    float qf[HD];
#pragma unroll
    for (int e = 0; e < HD; ++e) qf[e] = bf2f(q[e]);
    const int nk = isA ? 387 : 257;
    float mx = -1e30f;
    for (int i = lane; i < nk; i += 64) {
        int rel;
        if (isA) { const int br = i / 129, j = i % 129 - 64; rel = j * (br == 0 ? 1 : br == 1 ? 4 : 16); }
        else rel = i - 128;
        const int tk = t + rel;
        float lg = -1e30f;
        if (tk >= 0 && tk < S) {
            float d = 0.f; const bf16_t* kr = k + (size_t)tk * HD;
#pragma unroll
            for (int e = 0; e < HD; ++e) d += qf[e] * bf2f(kr[e]);
            lg = d + a.rel_bias[t5_bucket(rel) * 16 + head] * LOG2E;
        }
        pl[wave][i] = lg; kl[wave][i] = tk;
        mx = fmaxf(mx, lg);
    }
#pragma unroll
    for (int o = 1; o < 64; o <<= 1) mx = fmaxf(mx, __shfl_xor(mx, o));
    float sinkl = 0.f;
    if (!isA) { sinkl = a.sink[head - 8] * LOG2E; mx = fmaxf(mx, sinkl); }
    float sum = 0.f;
    for (int i = lane; i < nk; i += 64) { const float lg = pl[wave][i]; const float pv = lg > -1e29f ? exp2f(lg - mx) : 0.f; pl[wave][i] = pv; sum += pv; }
#pragma unroll
    for (int o = 1; o < 64; o <<= 1) sum += __shfl_xor(sum, o);
    if (!isA) sum += exp2f(sinkl - mx);
    __syncthreads();
    float acc = 0.f;
    for (int i = 0; i < nk; ++i) { const float pv = pl[wave][i]; if (pv != 0.f) acc += pv * bf2f(v[(size_t)kl[wave][i] * HD + lane]); }
    a.o[((size_t)b * S + t) * D + head * HD + lane] = f2bf(acc / sum);
}

namespace pg8 {
#define PG8_LAS __attribute__((address_space(3)))
typedef unsigned short bf16_t;
typedef short bf16x8 __attribute__((ext_vector_type(8)));
typedef float f32x4 __attribute__((ext_vector_type(4)));
typedef unsigned u32x4 __attribute__((ext_vector_type(4)));
constexpr int BM = 256, BK = 64, HALF = 128, HTB = HALF * BK * 2  , STAGE_BYTES = 8 * HTB, NXCD = 8, WGM = 8;

__host__ __device__ __forceinline__ int lds_byte(int r, int c) { const int st = (r >> 4) * 2 + (c >> 5), rr = r & 15, cc = c & 31, ob = rr * 64 + cc * 2; return st * 1024 + (ob ^ (((ob >> 9) & 1) << 5)); }
__host__ __device__ __forceinline__ void stage_rc(int b, int& R, int& C) { const int st = b / 1024, sb = b % 1024, swz = sb ^ (((sb >> 9) & 1) << 5); R = (st >> 1) * 16 + swz / 64; C = (st & 1) * 32 + (swz % 64) / 2; }
__host__ __device__ __forceinline__ int perm32(int rho) { const int n = rho >> 4, i = rho & 15; return 8 * (i >> 2) + 4 * n + (i & 3); }

struct Unit { int pm, pn; };
struct Gemm { const bf16_t* A; const bf16_t* Bt; int M, N, K; };

struct StaticOrder {
    int nM, nN, nwg, G, c;
    __host__ __device__ void init(int M, int N, int G_, int c_) { nM = M / BM; nN = N / BM; nwg = nM * nN; G = G_; c = c_; }
    __host__ __device__ bool next(int i, Unit& u) const {
        const long L = (long)i * G + c; if (L >= nwg) return false;
        int wgid = (int)L; { const int q = nwg / NXCD, r = nwg % NXCD, xcd = wgid % NXCD, off = wgid / NXCD; wgid = (xcd < r ? xcd * (q + 1) : r * (q + 1) + (xcd - r) * q) + off; }
        const int nig = WGM * nN, gid = wgid / nig, fm = gid * WGM, gsz = (nM - fm) < WGM ? (nM - fm) : WGM;
        u.pm = fm + ((wgid % nig) % gsz); u.pn = (wgid % nig) / gsz; return true;
    }
    __device__ __forceinline__ void a_ready(const Unit&) const {}
    __device__ __forceinline__ void done(const Unit&) const {}
};

__device__ __forceinline__ unsigned cvt_pk_bf16(float lo, float hi) { unsigned r; asm volatile("v_cvt_pk_bf16_f32 %0, %1, %2" : "=v"(r) : "v"(lo), "v"(hi)); return r; }
typedef float f32x2 __attribute__((ext_vector_type(2)));
template <class Epi, class Sched, bool ALIGN_EPI = false, bool SP2 = false>
__device__ __forceinline__ void gemm_phase(PG8_LAS unsigned char* lds, const Gemm g, const Sched& S, const Epi& E, const int tid) {
    const int wid = __builtin_amdgcn_readfirstlane(tid >> 6), lane = tid & 63, wr = wid >> 2, wc = wid & 3, fr = lane & 15, fq = lane >> 4;
    const int K = g.K, nt = K / BK;
    unsigned voffA[2], voffB[2];
#pragma unroll
    for (int i = 0; i < 2; ++i) { int R, C; stage_rc(tid * 16 + i * 8192, R, C); const int Rb = Epi::PERM ? ((R & ~31) + perm32(R & 31)) : R;
        voffA[i] = (unsigned)(R * K + C) * 2u; voffB[i] = (unsigned)(Rb * K + C) * 2u; }
    const size_t kstep = (size_t)(BK * 2);
    const size_t hstep = (size_t)HALF * K * 2;
    const size_t tstep = 2 * hstep;
    const unsigned ldsw = (unsigned)wid * 1024u;
    const int aoff = lds_byte(wr * 64 + fr, fq * 8), boff = lds_byte(wc * 32 + fr, fq * 8);
#define PG8_SA(b, h) (((b) * 2 + (h)) * HTB)
#define PG8_SB(b, h) ((4 + (b) * 2 + (h)) * HTB)
#define PG8_STAGE(bufoff, gbase, voff) do { _Pragma("unroll") for (int _i = 0; _i < 2; ++_i) \
        __builtin_amdgcn_global_load_lds((const unsigned*)((const char*)(gbase) + (voff)[_i]), (PG8_LAS unsigned*)(lds + (bufoff) + ldsw + _i * 8192), 16, 0, 0); } while (0)
#define PG8_LDA(dst, b, h) do { _Pragma("unroll") for (int m = 0; m < 4; ++m) _Pragma("unroll") for (int k = 0; k < 2; ++k) dst[m][k] = *(const PG8_LAS bf16x8*)(lds + PG8_SA(b, h) + aoff + m * 2048 + k * 1024); } while (0)
#define PG8_LDB(dst, b, h) do { _Pragma("unroll") for (int n = 0; n < 2; ++n) _Pragma("unroll") for (int k = 0; k < 2; ++k) dst[n][k] = *(const PG8_LAS bf16x8*)(lds + PG8_SB(b, h) + boff + n * 2048 + k * 1024); } while (0)
#define PG8_MMA(ai, bj, At, Bt) do { __builtin_amdgcn_s_setprio(1); _Pragma("unroll") for (int m = 0; m < 4; ++m) _Pragma("unroll") for (int n = 0; n < 2; ++n) _Pragma("unroll") for (int k = 0; k < 2; ++k) \
        acc[ai][bj][m][n] = __builtin_amdgcn_mfma_f32_16x16x32_bf16(Bt[n][k], At[m][k], acc[ai][bj][m][n], 0, 0, 0); __builtin_amdgcn_s_setprio(0); } while (0)
#define PG8_WAIT_V(n) asm volatile("s_waitcnt vmcnt(" #n ")" ::: "memory")
#define PG8_WAIT_L(n) asm volatile("s_waitcnt lgkmcnt(" #n ")" ::: "memory")
#define PG8_BAR __builtin_amdgcn_s_barrier()
#define PG8_SCHED __builtin_amdgcn_sched_barrier(0)
    Unit cur, nxt; int ui = 0;
    if (!S.next(0, cur)) return;
    f32x4 acc[2][2][4][2];
#pragma unroll
    for (int a = 0; a < 2; ++a)
#pragma unroll
        for (int b = 0; b < 2; ++b)
#pragma unroll
            for (int m = 0; m < 4; ++m)
#pragma unroll
                for (int n = 0; n < 2; ++n) acc[a][b][m][n] = (f32x4){0.f, 0.f, 0.f, 0.f};
    bf16x8 At[4][2], B0[2][2], B1[2][2];
    const char* cA = (const char*)g.A + (size_t)cur.pm * tstep; const char* cB = (const char*)g.Bt + (size_t)cur.pn * tstep;
    S.a_ready(cur);
    if constexpr (SP2) {
        PG8_STAGE(PG8_SB(0, 0), cB, voffB); PG8_STAGE(PG8_SB(0, 1), cB + hstep, voffB); PG8_STAGE(PG8_SA(0, 0), cA, voffA); PG8_STAGE(PG8_SA(0, 1), cA + hstep, voffA);
        if (wr == 1) PG8_BAR;
        PG8_WAIT_V(2); PG8_BAR;
        PG8_STAGE(PG8_SB(1, 0), cB + kstep, voffB); PG8_STAGE(PG8_SA(1, 0), cA + kstep, voffA); PG8_STAGE(PG8_SB(1, 1), cB + hstep + kstep, voffB);
        PG8_WAIT_V(6); PG8_BAR;
    } else {
        PG8_STAGE(PG8_SB(0, 0), cB, voffB); PG8_STAGE(PG8_SA(0, 0), cA, voffA); PG8_STAGE(PG8_SB(0, 1), cB + hstep, voffB); PG8_STAGE(PG8_SA(0, 1), cA + hstep, voffA);
        if (wr == 1) PG8_BAR;
        PG8_WAIT_V(4); PG8_BAR;
        PG8_STAGE(PG8_SB(1, 0), cB + kstep, voffB); PG8_STAGE(PG8_SA(1, 0), cA + kstep, voffA); PG8_STAGE(PG8_SB(1, 1), cB + hstep + kstep, voffB);
        PG8_WAIT_V(6); PG8_BAR;
    }
    for (;;) {
        const bool has_next = S.next(ui + 1, nxt);
        const char* nA = has_next ? (const char*)g.A + (size_t)nxt.pm * tstep : cA; const char* nB = has_next ? (const char*)g.Bt + (size_t)nxt.pn * tstep : cB;
        for (int t = 0; t < nt; t += 2) {
            const bool last = (t == nt - 2);
            const char* a1 = cA + (size_t)(t + 1) * kstep;
            const char* a2 = last ? nA : cA + (size_t)(t + 2) * kstep; const char* b2 = last ? nB : cB + (size_t)(t + 2) * kstep;
            const char* a3 = a2 + kstep; const char* b3 = b2 + kstep;
            if (last && has_next) S.a_ready(nxt);
            if constexpr (SP2) {
            PG8_LDB(B0, 0, 0); PG8_LDB(B1, 0, 1); PG8_SCHED; PG8_LDA(At, 0, 0); PG8_STAGE(PG8_SA(1, 1), a1 + hstep, voffA);
            PG8_WAIT_V(8); PG8_WAIT_L(0); PG8_BAR; PG8_MMA(0, 0, At, B0); PG8_MMA(0, 1, At, B1); PG8_BAR; PG8_SCHED;
            PG8_LDA(At, 0, 1); PG8_STAGE(PG8_SB(0, 0), b2, voffB); PG8_STAGE(PG8_SB(0, 1), b2 + hstep, voffB); PG8_STAGE(PG8_SA(0, 0), a2, voffA);
            PG8_WAIT_V(8); PG8_WAIT_L(0); PG8_BAR; PG8_MMA(1, 0, At, B0); PG8_MMA(1, 1, At, B1); PG8_BAR; PG8_SCHED;
            PG8_LDB(B0, 1, 0); PG8_LDB(B1, 1, 1); PG8_SCHED; PG8_LDA(At, 1, 0); PG8_STAGE(PG8_SA(0, 1), a2 + hstep, voffA);
            PG8_WAIT_V(8); PG8_WAIT_L(0); PG8_BAR; PG8_MMA(0, 0, At, B0); PG8_MMA(0, 1, At, B1); PG8_BAR; PG8_SCHED;
            PG8_LDA(At, 1, 1); PG8_STAGE(PG8_SB(1, 0), b3, voffB); PG8_STAGE(PG8_SB(1, 1), b3 + hstep, voffB); PG8_STAGE(PG8_SA(1, 0), a3, voffA);
            PG8_WAIT_V(8); PG8_WAIT_L(0); PG8_BAR; PG8_MMA(1, 0, At, B0); PG8_MMA(1, 1, At, B1); PG8_BAR; PG8_SCHED;
            } else {
            PG8_LDB(B0, 0, 0); PG8_SCHED; PG8_LDA(At, 0, 0); PG8_STAGE(PG8_SA(1, 1), a1 + hstep, voffA);
            PG8_WAIT_L(8); PG8_BAR; PG8_WAIT_L(0); PG8_MMA(0, 0, At, B0); PG8_BAR; PG8_SCHED;
            PG8_LDB(B1, 0, 1); PG8_STAGE(PG8_SB(0, 0), b2, voffB);
            PG8_BAR; PG8_WAIT_L(0); PG8_MMA(0, 1, At, B1); PG8_BAR;
            PG8_LDA(At, 0, 1); PG8_STAGE(PG8_SA(0, 0), a2, voffA);
            PG8_BAR; PG8_WAIT_L(0); PG8_MMA(1, 0, At, B0); PG8_BAR; PG8_SCHED;
            PG8_STAGE(PG8_SB(0, 1), b2 + hstep, voffB);
            PG8_WAIT_V(6); PG8_BAR; PG8_MMA(1, 1, At, B1); PG8_BAR;
            PG8_LDB(B0, 1, 0); PG8_SCHED; PG8_LDA(At, 1, 0); PG8_STAGE(PG8_SA(0, 1), a2 + hstep, voffA);
            PG8_WAIT_L(8); PG8_BAR; PG8_WAIT_L(0); PG8_MMA(0, 0, At, B0); PG8_BAR; PG8_SCHED;
            PG8_LDB(B1, 1, 1); PG8_STAGE(PG8_SB(1, 0), b3, voffB);
            PG8_BAR; PG8_WAIT_L(0); PG8_MMA(0, 1, At, B1); PG8_BAR;
            PG8_LDA(At, 1, 1); PG8_STAGE(PG8_SA(1, 0), a3, voffA);
            PG8_BAR; PG8_WAIT_L(0); PG8_MMA(1, 0, At, B0); PG8_BAR; PG8_SCHED;
            PG8_STAGE(PG8_SB(1, 1), b3 + hstep, voffB);
            PG8_WAIT_V(6); PG8_BAR; PG8_MMA(1, 1, At, B1); PG8_BAR;
            }
        }
        if constexpr (ALIGN_EPI) { if (wr == 0) PG8_BAR; }
        if constexpr (!Epi::AFTER_DRAIN) { E(acc, cur, wr, wc, fr, fq); S.done(cur); }
        if (!has_next) break;
#pragma unroll
        for (int a = 0; a < 2; ++a)
#pragma unroll
            for (int b = 0; b < 2; ++b)
#pragma unroll
                for (int m = 0; m < 4; ++m)
#pragma unroll
                    for (int n = 0; n < 2; ++n) acc[a][b][m][n] = (f32x4){0.f, 0.f, 0.f, 0.f};
        cur = nxt; cA = nA; cB = nB; ++ui;
        if constexpr (ALIGN_EPI) { if (wr == 1) PG8_BAR; }
    }
    PG8_WAIT_V(0);
    if constexpr (!ALIGN_EPI) { if (wr == 0) PG8_BAR; }
    PG8_BAR;
    if constexpr (Epi::AFTER_DRAIN) { E.fused(acc, cur, wr, wc, fr, fq, lds, wid, lane); S.done(cur); }
#undef PG8_SA
#undef PG8_SB
#undef PG8_STAGE
#undef PG8_LDA
#undef PG8_LDB
#undef PG8_MMA
#undef PG8_WAIT_V
#undef PG8_WAIT_L
#undef PG8_BAR
#undef PG8_SCHED
}
}

namespace pg8 {
typedef float f32x2 __attribute__((ext_vector_type(2)));
__device__ __forceinline__ float shx(float v, int lane, int mask) { return __int_as_float(__builtin_amdgcn_ds_bpermute((lane ^ mask) << 2, __float_as_int(v))); }
__device__ __forceinline__ float rstd16(const float* ssp, int row, int fq, int lane) {
    const f32x4 v = *(const f32x4*)(ssp + (size_t)row * 16 + 4 * fq);
    float s = (v[0] + v[1]) + (v[2] + v[3]);
    s += shx(s, lane, 16); s += shx(s, lane, 32);
    return rsqrtf(s * (1.0f / 1024.0f) + 1e-6f);
}
__device__ __forceinline__ float sigm(float v) { return __builtin_amdgcn_rcpf(1.0f + __builtin_amdgcn_exp2f(-1.4426950408889634f * v)); }
__device__ __forceinline__ u32x4 pack8(const f32x4& a, const f32x4& b) { u32x4 w; w.x = cvt_pk_bf16(a[0], a[1]); w.y = cvt_pk_bf16(a[2], a[3]); w.z = cvt_pk_bf16(b[0], b[1]); w.w = cvt_pk_bf16(b[2], b[3]); return w; }
__device__ __forceinline__ float bflo(unsigned w) { return __uint_as_float(w << 16); }
__device__ __forceinline__ float bfhi(unsigned w) { return __uint_as_float(w & 0xffff0000u); }

struct EpiSwiglu {
    static constexpr bool PERM = true, AFTER_DRAIN = false;
    bf16_t* act; const float* ssp;
    __device__ __forceinline__ void operator()(const f32x4 (&acc)[2][2][4][2], const Unit& u, int wr, int wc, int fr, int fq) const {
        const int lane = fr + 16 * fq;
        const int row0 = u.pm * BM + wr * 64 + fr, col0 = u.pn * 128 + wc * 32 + 8 * fq;
#pragma unroll
        for (int ai = 0; ai < 2; ++ai)
#pragma unroll
            for (int m = 0; m < 4; ++m) { const int row = row0 + ai * HALF + m * 16; const float rs = rstd16(ssp, row, fq, lane);
                f32x4 o[2];
#pragma unroll
                for (int n = 0; n < 2; ++n)
#pragma unroll
                    for (int j = 0; j < 4; ++j) { const float g = acc[ai][0][m][n][j] * rs, up = acc[ai][1][m][n][j] * rs; o[n][j] = g * sigm(g) * up; }
                *(u32x4*)(act + (size_t)row * 2816 + col0) = pack8(o[0], o[1]); }
    }
};
struct EpiResid {
    static constexpr bool PERM = true, AFTER_DRAIN = false;
    const float* xin; float* xout; bf16_t* xb; float* sspw; float coef;
    __device__ __forceinline__ void operator()(const f32x4 (&acc)[2][2][4][2], const Unit& u, int wr, int wc, int fr, int fq) const {
        const int lane = fr + 16 * fq;
        const int row0 = u.pm * BM + wr * 64 + fr, col0 = u.pn * BM + wc * 32 + 8 * fq;
#pragma unroll
        for (int ai = 0; ai < 2; ++ai)
#pragma unroll
            for (int m = 0; m < 4; ++m) { const int row = row0 + ai * HALF + m * 16; float ss = 0.f;
#pragma unroll
                for (int bj = 0; bj < 2; ++bj) { const size_t off = (size_t)row * 1024 + col0 + bj * HALF;
                    f32x4 x0 = *(const f32x4*)(xin + off), x1 = *(const f32x4*)(xin + off + 4);
                    x0 = x0 + acc[ai][bj][m][0] * coef; x1 = x1 + acc[ai][bj][m][1] * coef;
                    *(f32x4*)(xout + off) = x0; *(f32x4*)(xout + off + 4) = x1;
                    *(u32x4*)(xb + off) = pack8(x0, x1);
                    ss += (x0[0] * x0[0] + x0[1] * x0[1]) + (x0[2] * x0[2] + x0[3] * x0[3]) + (x1[0] * x1[0] + x1[1] * x1[1]) + (x1[2] * x1[2] + x1[3] * x1[3]); }
                ss += shx(ss, lane, 16); ss += shx(ss, lane, 32);
                if (fq == 0) sspw[(size_t)row * 16 + u.pn * 4 + wc] = ss; }
    }
};
struct EpiGate {
    static constexpr bool PERM = true, AFTER_DRAIN = false;
    const float* xin; float* xout; bf16_t* xb; float* sspw; const float* sspr; const bf16_t* proj;
    __device__ __forceinline__ void operator()(const f32x4 (&acc)[2][2][4][2], const Unit& u, int wr, int wc, int fr, int fq) const {
        const int lane = fr + 16 * fq;
        const int row0 = u.pm * BM + wr * 64 + fr, col0 = u.pn * BM + wc * 32 + 8 * fq;
#pragma unroll
        for (int ai = 0; ai < 2; ++ai)
#pragma unroll
            for (int m = 0; m < 4; ++m) { const int row = row0 + ai * HALF + m * 16; const float rs = rstd16(sspr, row, fq, lane); float ss = 0.f;
#pragma unroll
                for (int bj = 0; bj < 2; ++bj) { const size_t off = (size_t)row * 1024 + col0 + bj * HALF;
                    f32x4 x0 = *(const f32x4*)(xin + off), x1 = *(const f32x4*)(xin + off + 4);
                    const u32x4 pw = *(const u32x4*)(proj + off);
                    const f32x4 p0 = {bflo(pw.x), bfhi(pw.x), bflo(pw.y), bfhi(pw.y)}, p1 = {bflo(pw.z), bfhi(pw.z), bflo(pw.w), bfhi(pw.w)};
#pragma unroll
                    for (int j = 0; j < 4; ++j) { x0[j] += sigm(acc[ai][bj][m][0][j] * rs) * p0[j]; x1[j] += sigm(acc[ai][bj][m][1][j] * rs) * p1[j]; }
                    *(f32x4*)(xout + off) = x0; *(f32x4*)(xout + off + 4) = x1;
                    *(u32x4*)(xb + off) = pack8(x0, x1);
                    ss += (x0[0] * x0[0] + x0[1] * x0[1]) + (x0[2] * x0[2] + x0[3] * x0[3]) + (x1[0] * x1[0] + x1[1] * x1[1]) + (x1[2] * x1[2] + x1[3] * x1[3]); }
                ss += shx(ss, lane, 16); ss += shx(ss, lane, 32);
                if (fq == 0) sspw[(size_t)row * 16 + u.pn * 4 + wc] = ss; }
    }
};
struct EpiStoreBf16 {
    static constexpr bool PERM = true, AFTER_DRAIN = false;
    bf16_t* O; int ldc;
    __device__ __forceinline__ void operator()(const f32x4 (&acc)[2][2][4][2], const Unit& u, int wr, int wc, int fr, int fq) const {
        const int lane = fr + 16 * fq;
        const int row0 = u.pm * BM + wr * 64 + fr, col0 = u.pn * BM + wc * 32 + 8 * fq;
#pragma unroll
        for (int ai = 0; ai < 2; ++ai)
#pragma unroll
            for (int m = 0; m < 4; ++m) { const int row = row0 + ai * HALF + m * 16;
#pragma unroll
                for (int bj = 0; bj < 2; ++bj) *(u32x4*)(O + (size_t)row * ldc + col0 + bj * HALF) = pack8(acc[ai][bj][m][0], acc[ai][bj][m][1]); }
    }
};
struct EpiQkv {
    static constexpr bool PERM = true, AFTER_DRAIN = false;
    const float* ssp; bf16_t *qa, *ka, *va, *qb, *kb, *vb; const float *qna, *kna, *qnb, *knb;
    __device__ __forceinline__ void operator()(const f32x4 (&acc)[2][2][4][2], const Unit& u, int wr, int wc, int fr, int fq) const {
        const int lane = fr + 16 * fq;
        const int t = u.pn; bf16_t* dst; const float* ng; int nh, h; float sc = 1.0f;
        if (t < 2) { dst = qa; ng = qna; nh = 8; h = 4 * t + wc; sc = QSCALE; }
        else if (t < 4) { dst = ka; ng = kna; nh = 8; h = 4 * (t - 2) + wc; }
        else if (t < 6) { dst = va; ng = nullptr; nh = 8; h = 4 * (t - 4) + wc; }
        else if (t < 8) { dst = qb; ng = qnb; nh = 8; h = 4 * (t - 6) + wc; sc = QSCALE; }
        else if (wc < 2) { dst = kb; ng = knb; nh = 2; h = wc; }
        else { dst = vb; ng = nullptr; nh = 2; h = wc - 2; }
        f32x4 gv[2][2];
#pragma unroll
        for (int bj = 0; bj < 2; ++bj)
#pragma unroll
            for (int n = 0; n < 2; ++n) { if (ng) gv[bj][n] = *(const f32x4*)(ng + 32 * bj + 8 * fq + 4 * n) * sc; else gv[bj][n] = (f32x4){1.f, 1.f, 1.f, 1.f}; }
        const int row0 = u.pm * BM + wr * 64 + fr;
#pragma unroll
        for (int ai = 0; ai < 2; ++ai)
#pragma unroll
            for (int m = 0; m < 4; ++m) { const int row = row0 + ai * HALF + m * 16; const float rs = rstd16(ssp, row, fq, lane);
                f32x4 v[2][2]; float ss = 0.f;
#pragma unroll
                for (int bj = 0; bj < 2; ++bj)
#pragma unroll
                    for (int n = 0; n < 2; ++n) { v[bj][n] = acc[ai][bj][m][n] * rs; ss += (v[bj][n][0] * v[bj][n][0] + v[bj][n][1] * v[bj][n][1]) + (v[bj][n][2] * v[bj][n][2] + v[bj][n][3] * v[bj][n][3]); }
                ss += shx(ss, lane, 16); ss += shx(ss, lane, 32);
                const float hr = ng ? rsqrtf(ss * (1.0f / 64.0f) + 1e-6f) : 1.0f;
                const int b = row >> 12, s = row & 4095;
                bf16_t* p = dst + (((size_t)b * nh + h) * 4096 + s) * 64 + 8 * fq;
#pragma unroll
                for (int bj = 0; bj < 2; ++bj) *(u32x4*)(p + 32 * bj) = pack8(v[bj][0] * hr * gv[bj][0], v[bj][1] * hr * gv[bj][1]); }
    }
};
}

#include <hip/hip_cooperative_groups.h>
namespace cg = cooperative_groups;
#define LAS __attribute__((address_space(3)))
typedef unsigned v4u __attribute__((ext_vector_type(4)));
constexpr int NWAVES = 8, RING_BYTES = 131072, LDS_BYTES = 147456;
constexpr int NPHASE = 1 + 8 * DEPTH;
constexpr size_t WO_F1IN = 0, WO_F1OUT = WO_F1IN + (size_t)2 * DFF * D, WO_QKV = WO_F1OUT + (size_t)D * DFF, WO_WO = WO_QKV + (size_t)QKVW * D,
                 WO_F2IN = WO_WO + (size_t)D * D, WO_F2OUT = WO_F2IN + (size_t)2 * DFF * D, WO_WG = WO_F2OUT + (size_t)D * DFF, WO_WP = WO_WG + (size_t)D * D, W_LAYER = WO_WP + (size_t)D * PLE;
static_assert(W_LAYER * 2 * DEPTH <= 84 * MiB, "weights fit");

struct Args { const float* in[20]; float* out; unsigned char* ws; int ph_lo, ph_hi; };

__device__ __forceinline__ void transpose_item(const float* W, int K, int N, const float* gain, bf16_t* Bt, int kind, int item, LAS float* scr, int lane) {
    const int kblocks = K / 64, nb = item / kblocks, kb = item % kblocks, k0 = 64 * kb, n0 = 32 * nb;
    int c0;
    if (kind == 0) c0 = n0;
    else if (kind == 1) c0 = ((n0 >> 7) & 1) * DFF + 128 * (n0 >> 8) + (n0 & 127);
    else c0 = 256 * (n0 >> 8) + 64 * ((n0 >> 5) & 3) + 32 * ((n0 >> 7) & 1);
#pragma unroll 8
    for (int i = 0; i < 32; ++i) { const int kk = 2 * i + (lane >> 5); const float g = gain ? gain[k0 + kk] : 1.0f; scr[kk * 33 + (lane & 31)] = W[(size_t)(k0 + kk) * N + c0 + (lane & 31)] * g; }
    asm volatile("s_waitcnt lgkmcnt(0)" ::: "memory");
    const int c = lane & 7;
#pragma unroll
    for (int j = 0; j < 4; ++j) { const int n = (lane >> 3) + 8 * j; const LAS float* s = scr + (8 * c) * 33 + n;
        v4u o; o.x = pg8::cvt_pk_bf16(s[0 * 33], s[1 * 33]); o.y = pg8::cvt_pk_bf16(s[2 * 33], s[3 * 33]); o.z = pg8::cvt_pk_bf16(s[4 * 33], s[5 * 33]); o.w = pg8::cvt_pk_bf16(s[6 * 33], s[7 * 33]);
        *(v4u*)(Bt + (size_t)(n0 + n) * K + k0 + 8 * c) = o; }
    asm volatile("s_waitcnt lgkmcnt(0)" ::: "memory");
}

template <class AT> __device__ __forceinline__ void prologue_phase(const AT& a, LAS unsigned char* lds, int gw, int NGW, int wave, int lane) {
    LAS float* scr = (LAS float*)(lds + wave * 16384);
    bf16_t* wbase = (bf16_t*)(a.ws() + WS_W);
    constexpr int I_FIN = (D / 64) * (2 * DFF / 32), I_FOUT = (DFF / 64) * (D / 32), I_QKV = (D / 64) * (QKVW / 32), I_SQ = (D / 64) * (D / 32), I_WP = (PLE / 64) * (D / 32);
    constexpr int I_LAYER = 2 * I_FIN + 2 * I_FOUT + I_QKV + 2 * I_SQ + I_WP;
    for (int it = gw; it < DEPTH * I_LAYER; it += NGW) {
        const int l = it / I_LAYER; int r = it % I_LAYER; bf16_t* wl = wbase + (size_t)l * W_LAYER;
        if (r < I_FIN) { transpose_item(a.in(4) + (size_t)l * D * 2 * DFF, D, 2 * DFF, a.in(3) + l * D, wl + WO_F1IN, 1, r, scr, lane); continue; } r -= I_FIN;
        if (r < I_FOUT) { transpose_item(a.in(5) + (size_t)l * DFF * D, DFF, D, nullptr, wl + WO_F1OUT, 0, r, scr, lane); continue; } r -= I_FOUT;
        if (r < I_QKV) { transpose_item(a.in(7) + (size_t)l * D * QKVW, D, QKVW, a.in(6) + l * D, wl + WO_QKV, 2, r, scr, lane); continue; } r -= I_QKV;
        if (r < I_SQ) { transpose_item(a.in(13) + (size_t)l * D * D, D, D, nullptr, wl + WO_WO, 0, r, scr, lane); continue; } r -= I_SQ;
        if (r < I_FIN) { transpose_item(a.in(15) + (size_t)l * D * 2 * DFF, D, 2 * DFF, a.in(14) + l * D, wl + WO_F2IN, 1, r, scr, lane); continue; } r -= I_FIN;
        if (r < I_FOUT) { transpose_item(a.in(16) + (size_t)l * DFF * D, DFF, D, nullptr, wl + WO_F2OUT, 0, r, scr, lane); continue; } r -= I_FOUT;
        if (r < I_SQ) { transpose_item(a.in(18) + (size_t)l * D * D, D, D, a.in(17) + l * D, wl + WO_WG, 0, r, scr, lane); continue; } r -= I_SQ;
        transpose_item(a.in(19) + (size_t)l * PLE * D, PLE, D, nullptr, wl + WO_WP, 0, r, scr, lane);
    }
    const float* x = a.in(0); bf16_t* xb = (bf16_t*)(a.ws() + WS_XB); float* ssp = (float*)(a.ws() + WS_SSP);
    for (int row = gw; row < M; row += NGW) {
        const float4* xr = (const float4*)(x + (size_t)row * D); float s = 0.f;
#pragma unroll
        for (int j = 0; j < 4; ++j) { const float4 v = xr[lane + 64 * j]; s += v.x * v.x + v.y * v.y + v.z * v.z + v.w * v.w;
            uint2 o; o.x = pg8::cvt_pk_bf16(v.x, v.y); o.y = pg8::cvt_pk_bf16(v.z, v.w); ((uint2*)(xb + (size_t)row * D))[lane + 64 * j] = o; }
#pragma unroll
        for (int o = 1; o < 64; o <<= 1) s += pg8::shx(s, lane, o);
        if (lane < 4) { float4 r; r.x = lane == 0 ? s : 0.f; r.y = 0.f; r.z = 0.f; r.w = 0.f; ((float4*)ssp)[row * 4 + lane] = r; }
    }
}
__device__ __forceinline__ void convert_p(const float* p, bf16_t* pb, int gtid, int nthreads) {
    for (int i = gtid; i < M * PLE / 8; i += nthreads) { const float4 v0 = ((const float4*)p)[2 * i], v1 = ((const float4*)p)[2 * i + 1];
        v4u o; o.x = pg8::cvt_pk_bf16(v0.x, v0.y); o.y = pg8::cvt_pk_bf16(v0.z, v0.w); o.z = pg8::cvt_pk_bf16(v1.x, v1.y); o.w = pg8::cvt_pk_bf16(v1.z, v1.w); ((v4u*)pb)[i] = o; }
}

__device__ __forceinline__ void attn_simple_phase(LAS unsigned char* lds, const AttnIn& a, int G, int wave, int lane) {
    LAS float* pl = (LAS float*)(lds + wave * 4096); LAS int* kl = (LAS int*)(lds + wave * 4096 + 2048);
    const int total = NB * 16 * S;
    for (int item = blockIdx.x * NWAVES + wave; item < total; item += G * NWAVES) {
        const int t = item & (S - 1), head = (item >> 12) & 15, b = item >> 16;
        const bool isA = head < 8;
        const bf16_t *q, *k, *v;
        if (isA) { q = a.qa + (((size_t)b * 8 + head) * S + t) * HD; k = a.ka + ((size_t)b * 8 + head) * S * HD; v = a.va + ((size_t)b * 8 + head) * S * HD; }
        else { const int hq = head - 8, hk = hq >> 2; q = a.qb + (((size_t)b * 8 + hq) * S + t) * HD; k = a.kb + ((size_t)b * 2 + hk) * S * HD; v = a.vb + ((size_t)b * 2 + hk) * S * HD; }
        float qf[HD];
#pragma unroll
        for (int e = 0; e < HD; ++e) qf[e] = bf2f(q[e]);
        const int nk = isA ? 387 : 257;
        float mx = -1e30f;
        for (int i = lane; i < nk; i += 64) {
            int rel;
            if (isA) { const int br = i / 129, j = i % 129 - 64; rel = j * (br == 0 ? 1 : br == 1 ? 4 : 16); } else rel = i - 128;
            const int tk = t + rel; float lg = -1e30f;
            if (tk >= 0 && tk < S) { float d = 0.f; const bf16_t* kr = k + (size_t)tk * HD;
#pragma unroll
                for (int e = 0; e < HD; ++e) d += qf[e] * bf2f(kr[e]);
                lg = d + a.rel_bias[t5_bucket(rel) * 16 + head] * LOG2E; }
            pl[i] = lg; kl[i] = tk; mx = fmaxf(mx, lg);
        }
#pragma unroll
        for (int o = 1; o < 64; o <<= 1) mx = fmaxf(mx, pg8::shx(mx, lane, o));
        float sinkl = 0.f;
        if (!isA) { sinkl = a.sink[head - 8] * LOG2E; mx = fmaxf(mx, sinkl); }
        float sum = 0.f;
        for (int i = lane; i < nk; i += 64) { const float lg = pl[i]; const float pv = lg > -1e29f ? exp2f(lg - mx) : 0.f; pl[i] = pv; sum += pv; }
#pragma unroll
        for (int o = 1; o < 64; o <<= 1) sum += pg8::shx(sum, lane, o);
        if (!isA) sum += exp2f(sinkl - mx);
        asm volatile("s_waitcnt lgkmcnt(0)" ::: "memory");
        float acc = 0.f;
        for (int i = 0; i < nk; ++i) { const float pv = pl[i]; if (pv != 0.f) acc += pv * bf2f(v[(size_t)kl[i] * HD + lane]); }
        a.o[((size_t)b * S + t) * D + head * HD + lane] = f2bf(acc / sum);
    }
}

typedef const float* cfptr_t; typedef float* fptr_t; typedef unsigned char* ucptr_t;
typedef __attribute__((address_space(4))) const unsigned char* kargp_t;
struct KA {
    kargp_t kp;
    __device__ __forceinline__ const float* in(int i) const { return *(__attribute__((address_space(4))) const cfptr_t*)(kp + 8 * i); }
    __device__ __forceinline__ float* out() const { return *(__attribute__((address_space(4))) const fptr_t*)(kp + 160); }
    __device__ __forceinline__ unsigned char* ws() const { return *(__attribute__((address_space(4))) const ucptr_t*)(kp + 168); }
    __device__ __forceinline__ int ph_lo() const { return *(__attribute__((address_space(4))) const int*)(kp + 176); }
    __device__ __forceinline__ int ph_hi() const { return *(__attribute__((address_space(4))) const int*)(kp + 180); }
};
static_assert(sizeof(Args) == 184, "Args layout");
__global__ void __launch_bounds__(NWAVES * 64, 2) mk_fwd(Args) {
    extern __shared__ __attribute__((aligned(16))) unsigned char lds_raw[];
    LAS unsigned char* lds = (LAS unsigned char*)lds_raw;
    cg::grid_group grid = cg::this_grid();
    const int wave0 = __builtin_amdgcn_readfirstlane(threadIdx.x >> 6);
    KA a; a.kp = (kargp_t)__builtin_amdgcn_kernarg_segment_ptr();
    const int ph_hi = a.ph_hi();
    for (int ph = a.ph_lo(); ph < ph_hi; ++ph) {
    asm volatile("" : "+s"(a.kp));
    int G_ = gridDim.x, bx_ = blockIdx.x; asm volatile("" : "+s"(G_), "+s"(bx_));
    const int G = G_, bx = bx_;
    const int wave = wave0;
#define FRESH_LANE() ({ int l_; asm volatile("v_mbcnt_lo_u32_b32 %0, -1, 0\n\tv_mbcnt_hi_u32_b32 %0, -1, %0" : "=v"(l_)); l_; })
    const int vcu = (G % 8 == 0) ? (bx % 8) * (G / 8) + bx / 8 : bx;
    const int gw = vcu * NWAVES + wave, NGW = G * NWAVES;
    unsigned char* ws = a.ws();
    bf16_t* xb = (bf16_t*)(ws + WS_XB); float* ssp0 = (float*)(ws + WS_SSP); float* ssp1 = ssp0 + (size_t)M * 16;
    bf16_t* xb2 = (bf16_t*)(ws + WS_W);
    bf16_t* act = (bf16_t*)(ws + WS_R + R_ACT); bf16_t* ob = (bf16_t*)(ws + WS_R + R_O);
    bf16_t* pb = (bf16_t*)(ws + WS_PB); bf16_t* proj = (bf16_t*)(ws + WS_PROJ);
        if (ph == 0) {
            prologue_phase(a, lds, gw, NGW, wave, FRESH_LANE());
            convert_p(a.in(1), pb, bx * NWAVES * 64 + wave0 * 64 + FRESH_LANE(), G * NWAVES * 64);
        } else {
            const int l = (ph - 1) >> 3, k = (ph - 1) & 7;
            const bf16_t* wl = (const bf16_t*)(ws + WS_W) + (size_t)l * W_LAYER;
            const float* xin = (l == 0 && k <= 1) ? a.in(0) : a.out();
            if (k == 0 || k == 5) {
                pg8::Gemm g{(k == 0 && l == 1) ? xb2 : xb, wl + (k == 0 ? WO_F1IN : WO_F2IN), M, 2 * DFF, D}; pg8::StaticOrder S; S.init(M, 2 * DFF, G, bx);
                pg8::EpiSwiglu E{act, ssp0};
                pg8::gemm_phase<pg8::EpiSwiglu, pg8::StaticOrder, true, true>(lds, g, S, E, wave0 * 64 + FRESH_LANE());
            } else if (k == 1 || k == 6) {
                pg8::Gemm g{act, wl + (k == 1 ? WO_F1OUT : WO_F2OUT), M, D, DFF}; pg8::StaticOrder S; S.init(M, D, G, bx);
                pg8::EpiResid E{xin, a.out(), xb, ssp1, 0.5f};
                pg8::gemm_phase<pg8::EpiResid, pg8::StaticOrder, true, true>(lds, g, S, E, wave0 * 64 + FRESH_LANE());
            } else if (k == 2) {
                { pg8::Gemm g{xb, wl + WO_QKV, M, QKVW, D}; pg8::StaticOrder S; S.init(M, QKVW, G, bx);
                  pg8::EpiQkv E; E.ssp = ssp1;
                  E.qa = (bf16_t*)(ws + WS_R + R_QA); E.ka = (bf16_t*)(ws + WS_R + R_KA); E.va = (bf16_t*)(ws + WS_R + R_VA);
                  E.qb = (bf16_t*)(ws + WS_R + R_QB); E.kb = (bf16_t*)(ws + WS_R + R_KB); E.vb = (bf16_t*)(ws + WS_R + R_VB);
                  E.qna = a.in(8) + l * HD; E.kna = a.in(9) + l * HD; E.qnb = a.in(10) + l * HD; E.knb = a.in(11) + l * HD;
                  pg8::gemm_phase<pg8::EpiQkv, pg8::StaticOrder, true, true>(lds, g, S, E, wave0 * 64 + FRESH_LANE()); }
                { pg8::Gemm g{pb, wl + WO_WP, M, D, PLE}; pg8::StaticOrder S; S.init(M, D, G, bx);
                  pg8::EpiStoreBf16 E{proj, D};
                  pg8::gemm_phase<pg8::EpiStoreBf16, pg8::StaticOrder, true, true>(lds, g, S, E, wave0 * 64 + FRESH_LANE()); }
            } else if (k == 3) {
                AttnIn ai; ai.qa = (bf16_t*)(ws + WS_R + R_QA); ai.ka = (bf16_t*)(ws + WS_R + R_KA); ai.va = (bf16_t*)(ws + WS_R + R_VA);
                ai.qb = (bf16_t*)(ws + WS_R + R_QB); ai.kb = (bf16_t*)(ws + WS_R + R_KB); ai.vb = (bf16_t*)(ws + WS_R + R_VB);
                ai.rel_bias = a.in(2); ai.sink = a.in(12) + l * 8; ai.o = ob;
                attn_simple_phase(lds, ai, G, wave, FRESH_LANE());
            } else if (k == 4) {
                if (l + 1 < DEPTH) { convert_p(a.in(1) + (size_t)(l + 1) * M * PLE, pb, bx * NWAVES * 64 + wave0 * 64 + FRESH_LANE(), G * NWAVES * 64); asm volatile("s_waitcnt vmcnt(0)" ::: "memory"); }
                pg8::Gemm g{ob, wl + WO_WO, M, D, D}; pg8::StaticOrder S; S.init(M, D, G, bx);
                pg8::EpiResid E{xin, a.out(), xb, ssp0, 1.0f};
                pg8::gemm_phase<pg8::EpiResid, pg8::StaticOrder, true, true>(lds, g, S, E, wave0 * 64 + FRESH_LANE());
            } else {
                pg8::Gemm g{xb, wl + WO_WG, M, D, D}; pg8::StaticOrder S; S.init(M, D, G, bx);
                pg8::EpiGate E{xin, a.out(), xb2, ssp0, ssp1, proj};
                pg8::gemm_phase<pg8::EpiGate, pg8::StaticOrder, true, true>(lds, g, S, E, wave0 * 64 + FRESH_LANE());
            }
        }
        if (ph + 1 < ph_hi) grid.sync();
    }
}

#ifndef FAST_MASK
#define FAST_MASK 0x1ffffu
#endif
extern "C" void kernel_launch(void* const* d_in, const int* in_sizes, int n_in, void* d_out, int out_size, void* d_ws, size_t ws_size, hipStream_t stream) {
    static int grid = 0;
    if (grid == 0) {
        if (n_in != 20 || in_sizes[0] != M * D || out_size != M * D || ws_size < WS_END) { fprintf(stderr, "kernel_launch: unexpected shapes (n_in %d, ws %zu)\n", n_in, ws_size); grid = -1; return; }
        int dev = 0, cus = 0, per_cu = 0;
        if (hipGetDevice(&dev) != hipSuccess || hipDeviceGetAttribute(&cus, hipDeviceAttributeMultiprocessorCount, dev) != hipSuccess) { grid = -1; return; }
        if (hipFuncSetAttribute((const void*)mk_fwd, hipFuncAttributeMaxDynamicSharedMemorySize, LDS_BYTES) != hipSuccess) { fprintf(stderr, "kernel_launch: hipFuncSetAttribute failed\n"); grid = -1; return; }
        if (hipOccupancyMaxActiveBlocksPerMultiprocessor(&per_cu, (const void*)mk_fwd, NWAVES * 64, LDS_BYTES) != hipSuccess || per_cu < 1) { fprintf(stderr, "kernel_launch: occupancy query says %d\n", per_cu); grid = -1; (void)hipGetLastError(); return; }
        grid = cus;
    }
    if (grid < 0) return;
    (void)hipMemsetAsync((char*)d_ws + WS_CTL, 0, 1 * MiB, stream);
    Args a{};
    for (int i = 0; i < 20; ++i) a.in[i] = (const float*)d_in[i];
    a.out = (float*)d_out; a.ws = (unsigned char*)d_ws;
    const unsigned fast = FAST_MASK;
    if (fast == 0x1ffffu) {
        a.ph_lo = 0; a.ph_hi = NPHASE;
        void* args[] = {&a};
        hipError_t e = hipLaunchCooperativeKernel((const void*)mk_fwd, dim3(grid), dim3(NWAVES * 64), args, LDS_BYTES, stream);
        if (e != hipSuccess) fprintf(stderr, "kernel_launch: cooperative launch failed: %s (grid %d)\n", hipGetErrorString(e), grid);
        return;
    }
    unsigned char* ws = (unsigned char*)d_ws; float* out = (float*)d_out;
    bf16_t* xb = (bf16_t*)(ws + WS_XB); bf16_t* xb2 = (bf16_t*)(ws + WS_W); float* ssp0 = (float*)(ws + WS_SSP); float* ssp1 = ssp0 + (size_t)M * 16;
    bf16_t* act = (bf16_t*)(ws + WS_R + R_ACT); bf16_t* ob = (bf16_t*)(ws + WS_R + R_O);
    QkvOut qo; qo.qa = (bf16_t*)(ws + WS_R + R_QA); qo.ka = (bf16_t*)(ws + WS_R + R_KA); qo.va = (bf16_t*)(ws + WS_R + R_VA);
    qo.qb = (bf16_t*)(ws + WS_R + R_QB); qo.kb = (bf16_t*)(ws + WS_R + R_KB); qo.vb = (bf16_t*)(ws + WS_R + R_VB);
    for (int ph = 0; ph < NPHASE; ++ph) {
        if ((fast >> ph) & 1u) { a.ph_lo = ph; a.ph_hi = ph + 1; hipLaunchKernelGGL(mk_fwd, dim3(grid), dim3(NWAVES * 64), LDS_BYTES, stream, a); continue; }
        if (ph == 0) { rowstat_kernel<<<M / 4, 256, 0, stream>>>(a.in[0], xb, ssp0); continue; }
        const int l = (ph - 1) >> 3, k = (ph - 1) & 7;
        const float* xin = (l == 0 && k <= 1) ? a.in[0] : out;
        bf16_t* xbl = (l == 1) ? xb2 : xb;
        switch (k) {
        case 0: naive_ffn_in<<<dim3(DFF / 128, M / 128), 256, 0, stream>>>(xbl, ssp0, a.in[3] + l * D, a.in[4] + (size_t)l * D * 2 * DFF, act); break;
        case 1: naive_resid<<<dim3(D / 128, M / 128), 256, 0, stream>>>(act, DFF, a.in[5] + (size_t)l * DFF * D, xin, out, 0.5f); rowstat_kernel<<<M / 4, 256, 0, stream>>>(out, xb, ssp1); break;
        case 2: qo.qna = a.in[8] + l * HD; qo.kna = a.in[9] + l * HD; qo.qnb = a.in[10] + l * HD; qo.knb = a.in[11] + l * HD;
                naive_qkv<<<dim3(QKVW / 128, M / 128), 256, 0, stream>>>(xb, ssp1, a.in[6] + l * D, a.in[7] + (size_t)l * D * QKVW, qo); break;
        case 3: { AttnIn ai; ai.qa = qo.qa; ai.ka = qo.ka; ai.va = qo.va; ai.qb = qo.qb; ai.kb = qo.kb; ai.vb = qo.vb; ai.rel_bias = a.in[2]; ai.sink = a.in[12] + l * 8; ai.o = ob;
                naive_attn<<<dim3(S / 4, 16, NB), 256, 0, stream>>>(ai); } break;
        case 4: naive_resid<<<dim3(D / 128, M / 128), 256, 0, stream>>>(ob, D, a.in[13] + (size_t)l * D * D, out, out, 1.0f); rowstat_kernel<<<M / 4, 256, 0, stream>>>(out, xb, ssp0); break;
        case 5: naive_ffn_in<<<dim3(DFF / 128, M / 128), 256, 0, stream>>>(xb, ssp0, a.in[14] + l * D, a.in[15] + (size_t)l * D * 2 * DFF, act); break;
        case 6: naive_resid<<<dim3(D / 128, M / 128), 256, 0, stream>>>(act, DFF, a.in[16] + (size_t)l * DFF * D, out, out, 0.5f); rowstat_kernel<<<M / 4, 256, 0, stream>>>(out, xb, ssp1); break;
        case 7: naive_ple<<<dim3(D / 128, M / 128), 256, 0, stream>>>(xb, ssp1, a.in[17] + l * D, a.in[18] + (size_t)l * D * D, a.in[1] + (size_t)l * M * PLE, a.in[19] + (size_t)l * PLE * D, out, out);
                rowstat_kernel<<<M / 4, 256, 0, stream>>>(out, xb2, ssp0); break;
        }
    }
}
```

```cpp
#include <hip/hip_runtime.h>
#include <cstdio>
#include <cstdint>
#ifndef ATT_FAST
#define ATT_FAST 1
#endif

typedef unsigned short bf16_t;
constexpr int NB = 4, S = 4096, D = 1024, M = NB * S, DFF = 2816, QKVW = 2304, PLE = 256, DEPTH = 2, HD = 64;
constexpr float EPS = 1e-6f;
constexpr float QSCALE = 0.125f * 1.4426950408889634f;
constexpr float LOG2E = 1.4426950408889634f;

constexpr size_t MiB = 1u << 20;
constexpr size_t WS_CTL = 0, WS_W = 1 * MiB, WS_XB = 85 * MiB, WS_R = 117 * MiB, WS_PB = 221 * MiB, WS_PROJ = 229 * MiB, WS_SSP = 261 * MiB, WS_END = 263 * MiB + 512 * 1024;
constexpr size_t R_QA = 0, R_KA = 16 * MiB, R_VA = 32 * MiB, R_QB = 48 * MiB, R_KB = 64 * MiB, R_VB = 68 * MiB, R_O = 72 * MiB, R_ACT = 0;

__device__ __forceinline__ float bf2f(bf16_t v) { return __uint_as_float(((unsigned)v) << 16); }
__device__ __forceinline__ bf16_t f2bf(float f) { unsigned u = __float_as_uint(f); return (bf16_t)((u + 0x7fffu + ((u >> 16) & 1u)) >> 16); }

__global__ void __launch_bounds__(256) rowstat_kernel(const float* __restrict__ x, bf16_t* __restrict__ xb, float* __restrict__ ssp) {
    const int wave = threadIdx.x >> 6, lane = threadIdx.x & 63;
    const int row = blockIdx.x * 4 + wave;
    const float4* xr = (const float4*)(x + (size_t)row * D);
    float s = 0.f;
#pragma unroll
    for (int j = 0; j < 4; ++j) {
        float4 v = xr[lane + 64 * j];
        s += v.x * v.x + v.y * v.y + v.z * v.z + v.w * v.w;
        ushort4 o; o.x = f2bf(v.x); o.y = f2bf(v.y); o.z = f2bf(v.z); o.w = f2bf(v.w);
        ((ushort4*)(xb + (size_t)row * D))[lane + 64 * j] = o;
    }
#pragma unroll
    for (int o = 1; o < 64; o <<= 1) s += __shfl_xor(s, o);
    if (lane < 4) { float4 r; r.x = lane == 0 ? s : 0.f; r.y = 0.f; r.z = 0.f; r.w = 0.f; ((float4*)ssp)[row * 4 + lane] = r; }
}

__device__ __forceinline__ float row_rstd(const float* ssp, int row) {
    float s = 0.f;
#pragma unroll
    for (int j = 0; j < 4; ++j) { const float4 v = ((const float4*)ssp)[row * 4 + j]; s += (v.x + v.y) + (v.z + v.w); }
    return rsqrtf(s * (1.0f / D) + EPS);
}

template <typename AT> __device__ __forceinline__ float ldA(const AT* p);
template <> __device__ __forceinline__ float ldA<bf16_t>(const bf16_t* p) { return bf2f(*p); }
template <> __device__ __forceinline__ float ldA<float>(const float* p) { return *p; }

template <typename AT>
__device__ __forceinline__ void accum_tile(const AT* A, int lda, int K, const float* gain, const float* W, int ldw, int row0, int wcol0, float (&acc)[8][8], float* As, float* Bs) {
    const int tid = threadIdx.x, tx = tid & 15, ty = tid >> 4;
    for (int k0 = 0; k0 < K; k0 += 8) {
        __syncthreads();
#pragma unroll
        for (int i = 0; i < 4; ++i) { const int idx = tid + i * 256, r = idx >> 3, kk = idx & 7;
            As[kk * 132 + r] = ldA<AT>(A + (size_t)(row0 + r) * lda + k0 + kk) * (gain ? gain[k0 + kk] : 1.0f); }
#pragma unroll
        for (int i = 0; i < 4; ++i) { const int idx = tid + i * 256, kk = idx >> 7, c = idx & 127;
            Bs[kk * 128 + c] = W[(size_t)(k0 + kk) * ldw + wcol0 + c]; }
        __syncthreads();
#pragma unroll
        for (int kk = 0; kk < 8; ++kk) {
            float a[8], b[8];
#pragma unroll
            for (int i = 0; i < 8; ++i) a[i] = As[kk * 132 + ty * 8 + i];
#pragma unroll
            for (int j = 0; j < 8; ++j) b[j] = Bs[kk * 128 + tx * 8 + j];
#pragma unroll
            for (int i = 0; i < 8; ++i)
#pragma unroll
                for (int j = 0; j < 8; ++j) acc[i][j] += a[i] * b[j];
        }
    }
}
#define ZERO_ACC(acc) do { _Pragma("unroll") for (int i = 0; i < 8; ++i) _Pragma("unroll") for (int j = 0; j < 8; ++j) acc[i][j] = 0.f; } while (0)

__global__ void __launch_bounds__(256) naive_ffn_in(const bf16_t* xb, const float* ssp, const float* gain, const float* Win, bf16_t* act) {
    __shared__ float As[8 * 132]; __shared__ float Bs[8 * 128];
    const int row0 = blockIdx.y * 128, col0 = blockIdx.x * 128, tx = threadIdx.x & 15, ty = threadIdx.x >> 4;
    float ag[8][8], au[8][8]; ZERO_ACC(ag); ZERO_ACC(au);
    accum_tile<bf16_t>(xb, D, D, gain, Win, 2 * DFF, row0, col0, ag, As, Bs);
    accum_tile<bf16_t>(xb, D, D, gain, Win, 2 * DFF, row0, DFF + col0, au, As, Bs);
#pragma unroll
    for (int i = 0; i < 8; ++i) { const int row = row0 + ty * 8 + i; const float rs = row_rstd(ssp, row);
#pragma unroll
        for (int j = 0; j < 8; ++j) { const float g = ag[i][j] * rs, u = au[i][j] * rs; const float sg = g / (1.0f + __expf(-g));
            act[(size_t)row * DFF + col0 + tx * 8 + j] = f2bf(sg * u); } }
}
__global__ void __launch_bounds__(256) naive_resid(const bf16_t* A, int K, const float* W, const float* xin, float* xout, float coef) {
    __shared__ float As[8 * 132]; __shared__ float Bs[8 * 128];
    const int row0 = blockIdx.y * 128, col0 = blockIdx.x * 128, tx = threadIdx.x & 15, ty = threadIdx.x >> 4;
    float acc[8][8]; ZERO_ACC(acc);
    accum_tile<bf16_t>(A, K, K, nullptr, W, D, row0, col0, acc, As, Bs);
#pragma unroll
    for (int i = 0; i < 8; ++i) { const int row = row0 + ty * 8 + i;
#pragma unroll
        for (int j = 0; j < 8; ++j) { const size_t o = (size_t)row * D + col0 + tx * 8 + j; xout[o] = xin[o] + coef * acc[i][j]; } }
}
struct QkvOut { bf16_t *qa, *ka, *va, *qb, *kb, *vb; const float *qna, *kna, *qnb, *knb; };
__global__ void __launch_bounds__(256) naive_qkv(const bf16_t* xb, const float* ssp, const float* gain, const float* Wqkv, QkvOut o) {
    __shared__ float As[8 * 132]; __shared__ float Bs[8 * 128];
    const int row0 = blockIdx.y * 128, col0 = blockIdx.x * 128, tx = threadIdx.x & 15, ty = threadIdx.x >> 4;
    float acc[8][8]; ZERO_ACC(acc);
    accum_tile<bf16_t>(xb, D, D, gain, Wqkv, QKVW, row0, col0, acc, As, Bs);
    const int c = col0 + tx * 8;
    bf16_t* dst; const float* ng; int nh, hc; float sc = 1.0f;
    if (c < 512) { dst = o.qa; ng = o.qna; nh = 8; hc = c; sc = QSCALE; }
    else if (c < 1024) { dst = o.ka; ng = o.kna; nh = 8; hc = c - 512; }
    else if (c < 1536) { dst = o.va; ng = nullptr; nh = 8; hc = c - 1024; }
    else if (c < 2048) { dst = o.qb; ng = o.qnb; nh = 8; hc = c - 1536; sc = QSCALE; }
    else if (c < 2176) { dst = o.kb; ng = o.knb; nh = 2; hc = c - 2048; }
    else { dst = o.vb; ng = nullptr; nh = 2; hc = c - 2176; }
    const int h = hc >> 6, e0 = hc & 63;
#pragma unroll
    for (int i = 0; i < 8; ++i) { const int row = row0 + ty * 8 + i; const float rs = row_rstd(ssp, row);
        float v[8]; float ss = 0.f;
#pragma unroll
        for (int j = 0; j < 8; ++j) { v[j] = acc[i][j] * rs; ss += v[j] * v[j]; }
        ss += __shfl_xor(ss, 1); ss += __shfl_xor(ss, 2); ss += __shfl_xor(ss, 4);
        const float hr = rsqrtf(ss * (1.0f / HD) + EPS);
        const int b = row / S, s = row % S;
        bf16_t* p = dst + (((size_t)b * nh + h) * S + s) * HD + e0;
#pragma unroll
        for (int j = 0; j < 8; ++j) p[j] = f2bf(ng ? v[j] * hr * ng[e0 + j] * sc : v[j]); }
}
__global__ void __launch_bounds__(256) naive_ple(const bf16_t* xb, const float* ssp, const float* gain, const float* Wg, const float* p, const float* Wp, const float* xin, float* xout) {
    __shared__ float As[8 * 132]; __shared__ float Bs[8 * 128];
    const int row0 = blockIdx.y * 128, col0 = blockIdx.x * 128, tx = threadIdx.x & 15, ty = threadIdx.x >> 4;
    float ag[8][8], ap[8][8]; ZERO_ACC(ag); ZERO_ACC(ap);
    accum_tile<bf16_t>(xb, D, D, gain, Wg, D, row0, col0, ag, As, Bs);
    accum_tile<float>(p, PLE, PLE, nullptr, Wp, D, row0, col0, ap, As, Bs);
#pragma unroll
    for (int i = 0; i < 8; ++i) { const int row = row0 + ty * 8 + i; const float rs = row_rstd(ssp, row);
#pragma unroll
        for (int j = 0; j < 8; ++j) { const size_t o = (size_t)row * D + col0 + tx * 8 + j; const float g = 1.0f / (1.0f + __expf(-ag[i][j] * rs));
            xout[o] = xin[o] + g * ap[i][j]; } }
}

__device__ __forceinline__ int t5_bucket(int rel) {
    const int n = rel < 0 ? -rel : rel; const int ret = rel > 0 ? 16 : 0;
    if (n < 8) return ret + n;
    int large = 8 + (int)(logf((float)n / 8.0f) / 4.852030263919617f * 8.0f);
    large = large < 15 ? large : 15;
    return ret + large;
}
struct AttnIn { const bf16_t *qa, *ka, *va, *qb, *kb, *vb; const float* rel_bias; const float* sink; bf16_t* o; };
__global__ void __launch_bounds__(256) naive_attn(AttnIn a) {
    __shared__ float pl[4][400]; __shared__ int kl[4][400];
    const int wave = threadIdx.x >> 6, lane = threadIdx.x & 63;
    const int t = blockIdx.x * 4 + wave, head = blockIdx.y, b = blockIdx.z;
    const bool isA = head < 8;
    const bf16_t *q, *k, *v;
    if (isA) { q = a.qa + (((size_t)b * 8 + head) * S + t) * HD; k = a.ka + ((size_t)b * 8 + head) * S * HD; v = a.va + ((size_t)b * 8 + head) * S * HD; }
    else { const int hq = head - 8, hk = hq >> 2; q = a.qb + (((size_t)b * 8 + hq) * S + t) * HD; k = a.kb + ((size_t)b * 2 + hk) * S * HD; v = a.vb + ((size_t)b * 2 + hk) * S * HD; }
    float qf[HD];
#pragma unroll
    for (int e = 0; e < HD; ++e) qf[e] = bf2f(q[e]);
    const int nk = isA ? 387 : 257;
    float mx = -1e30f;
    for (int i = lane; i < nk; i += 64) {
        int rel;
        if (isA) { const int br = i / 129, j = i % 129 - 64; rel = j * (br == 0 ? 1 : br == 1 ? 4 : 16); }
        else rel = i - 128;
        const int tk = t + rel;
        float lg = -1e30f;
        if (tk >= 0 && tk < S) {
            float d = 0.f; const bf16_t* kr = k + (size_t)tk * HD;
#pragma unroll
            for (int e = 0; e < HD; ++e) d += qf[e] * bf2f(kr[e]);
            lg = d + a.rel_bias[t5_bucket(rel) * 16 + head] * LOG2E;
        }
        pl[wave][i] = lg; kl[wave][i] = tk;
        mx = fmaxf(mx, lg);
    }
#pragma unroll
    for (int o = 1; o < 64; o <<= 1) mx = fmaxf(mx, __shfl_xor(mx, o));
    float sinkl = 0.f;
    if (!isA) { sinkl = a.sink[head - 8] * LOG2E; mx = fmaxf(mx, sinkl); }
    float sum = 0.f;
    for (int i = lane; i < nk; i += 64) { const float lg = pl[wave][i]; const float pv = lg > -1e29f ? exp2f(lg - mx) : 0.f; pl[wave][i] = pv; sum += pv; }
#pragma unroll
    for (int o = 1; o < 64; o <<= 1) sum += __shfl_xor(sum, o);
    if (!isA) sum += exp2f(sinkl - mx);
    __syncthreads();
    float acc = 0.f;
    for (int i = 0; i < nk; ++i) { const float pv = pl[wave][i]; if (pv != 0.f) acc += pv * bf2f(v[(size_t)kl[wave][i] * HD + lane]); }
    a.o[((size_t)b * S + t) * D + head * HD + lane] = f2bf(acc / sum);
}

namespace pg8 {
#define PG8_LAS __attribute__((address_space(3)))
typedef unsigned short bf16_t;
typedef short bf16x8 __attribute__((ext_vector_type(8)));
typedef float f32x4 __attribute__((ext_vector_type(4)));
typedef unsigned u32x4 __attribute__((ext_vector_type(4)));
constexpr int BM = 256, BK = 64, HALF = 128, HTB = HALF * BK * 2  , STAGE_BYTES = 8 * HTB, NXCD = 8, WGM = 8;

__host__ __device__ __forceinline__ int lds_byte(int r, int c) { const int st = (r >> 4) * 2 + (c >> 5), rr = r & 15, cc = c & 31, ob = rr * 64 + cc * 2; return st * 1024 + (ob ^ (((ob >> 9) & 1) << 5)); }
__host__ __device__ __forceinline__ void stage_rc(int b, int& R, int& C) { const int st = b / 1024, sb = b % 1024, swz = sb ^ (((sb >> 9) & 1) << 5); R = (st >> 1) * 16 + swz / 64; C = (st & 1) * 32 + (swz % 64) / 2; }
__host__ __device__ __forceinline__ int perm32(int rho) { const int n = rho >> 4, i = rho & 15; return 8 * (i >> 2) + 4 * n + (i & 3); }

struct Unit { int pm, pn; };
struct Gemm { const bf16_t* A; const bf16_t* Bt; int M, N, K; };

struct StaticOrder {
    int nM, nN, nwg, G, c;
    __host__ __device__ void init(int M, int N, int G_, int c_) { nM = M / BM; nN = N / BM; nwg = nM * nN; G = G_; c = c_; }
    __host__ __device__ bool next(int i, Unit& u) const {
        const long L = (long)i * G + c; if (L >= nwg) return false;
        int wgid = (int)L; { const int q = nwg / NXCD, r = nwg % NXCD, xcd = wgid % NXCD, off = wgid / NXCD; wgid = (xcd < r ? xcd * (q + 1) : r * (q + 1) + (xcd - r) * q) + off; }
        const int nig = WGM * nN, gid = wgid / nig, fm = gid * WGM, gsz = (nM - fm) < WGM ? (nM - fm) : WGM;
        u.pm = fm + ((wgid % nig) % gsz); u.pn = (wgid % nig) / gsz; return true;
    }
    __device__ __forceinline__ void a_ready(const Unit&) const {}
    __device__ __forceinline__ void done(const Unit&) const {}
};

__device__ __forceinline__ unsigned cvt_pk_bf16(float lo, float hi) { unsigned r; asm volatile("v_cvt_pk_bf16_f32 %0, %1, %2" : "=v"(r) : "v"(lo), "v"(hi)); return r; }
typedef float f32x2 __attribute__((ext_vector_type(2)));
template <class Epi, class Sched, bool ALIGN_EPI = false, bool SP2 = false>
__device__ __forceinline__ void gemm_phase(PG8_LAS unsigned char* lds, const Gemm g, const Sched& S, const Epi& E, const int tid) {
    const int wid = __builtin_amdgcn_readfirstlane(tid >> 6), lane = tid & 63, wr = wid >> 2, wc = wid & 3, fr = lane & 15, fq = lane >> 4;
    const int K = g.K, nt = K / BK;
    unsigned voffA[2], voffB[2];
#pragma unroll
    for (int i = 0; i < 2; ++i) { int R, C; stage_rc(tid * 16 + i * 8192, R, C); const int Rb = Epi::PERM ? ((R & ~31) + perm32(R & 31)) : R;
        voffA[i] = (unsigned)(R * K + C) * 2u; voffB[i] = (unsigned)(Rb * K + C) * 2u; }
    const size_t kstep = (size_t)(BK * 2);
    const size_t hstep = (size_t)HALF * K * 2;
    const size_t tstep = 2 * hstep;
    const unsigned ldsw = (unsigned)wid * 1024u;
    const int aoff = lds_byte(wr * 64 + fr, fq * 8), boff = lds_byte(wc * 32 + fr, fq * 8);
#define PG8_SA(b, h) (((b) * 2 + (h)) * HTB)
#define PG8_SB(b, h) ((4 + (b) * 2 + (h)) * HTB)
#define PG8_STAGE(bufoff, gbase, voff) do { _Pragma("unroll") for (int _i = 0; _i < 2; ++_i) \
        __builtin_amdgcn_global_load_lds((const unsigned*)((const char*)(gbase) + (voff)[_i]), (PG8_LAS unsigned*)(lds + (bufoff) + ldsw + _i * 8192), 16, 0, 0); } while (0)
#define PG8_LDA(dst, b, h) do { _Pragma("unroll") for (int m = 0; m < 4; ++m) _Pragma("unroll") for (int k = 0; k < 2; ++k) dst[m][k] = *(const PG8_LAS bf16x8*)(lds + PG8_SA(b, h) + aoff + m * 2048 + k * 1024); } while (0)
#define PG8_LDB(dst, b, h) do { _Pragma("unroll") for (int n = 0; n < 2; ++n) _Pragma("unroll") for (int k = 0; k < 2; ++k) dst[n][k] = *(const PG8_LAS bf16x8*)(lds + PG8_SB(b, h) + boff + n * 2048 + k * 1024); } while (0)
#define PG8_MMA(ai, bj, At, Bt) do { __builtin_amdgcn_s_setprio(1); _Pragma("unroll") for (int m = 0; m < 4; ++m) _Pragma("unroll") for (int n = 0; n < 2; ++n) _Pragma("unroll") for (int k = 0; k < 2; ++k) \
        acc[ai][bj][m][n] = __builtin_amdgcn_mfma_f32_16x16x32_bf16(Bt[n][k], At[m][k], acc[ai][bj][m][n], 0, 0, 0); __builtin_amdgcn_s_setprio(0); } while (0)
#define PG8_WAIT_V(n) asm volatile("s_waitcnt vmcnt(" #n ")" ::: "memory")
#define PG8_WAIT_L(n) asm volatile("s_waitcnt lgkmcnt(" #n ")" ::: "memory")
#define PG8_BAR __builtin_amdgcn_s_barrier()
#define PG8_SCHED __builtin_amdgcn_sched_barrier(0)
    Unit cur, nxt; int ui = 0;
    if (!S.next(0, cur)) return;
    f32x4 acc[2][2][4][2];
#pragma unroll
    for (int a = 0; a < 2; ++a)
#pragma unroll
        for (int b = 0; b < 2; ++b)
#pragma unroll
            for (int m = 0; m < 4; ++m)
#pragma unroll
                for (int n = 0; n < 2; ++n) acc[a][b][m][n] = (f32x4){0.f, 0.f, 0.f, 0.f};
    bf16x8 At[4][2], B0[2][2], B1[2][2];
    const char* cA = (const char*)g.A + (size_t)cur.pm * tstep; const char* cB = (const char*)g.Bt + (size_t)cur.pn * tstep;
    S.a_ready(cur);
    if constexpr (SP2) {
        PG8_STAGE(PG8_SB(0, 0), cB, voffB); PG8_STAGE(PG8_SB(0, 1), cB + hstep, voffB); PG8_STAGE(PG8_SA(0, 0), cA, voffA); PG8_STAGE(PG8_SA(0, 1), cA + hstep, voffA);
        if (wr == 1) PG8_BAR;
        PG8_WAIT_V(2); PG8_BAR;
        PG8_STAGE(PG8_SB(1, 0), cB + kstep, voffB); PG8_STAGE(PG8_SA(1, 0), cA + kstep, voffA); PG8_STAGE(PG8_SB(1, 1), cB + hstep + kstep, voffB);
        PG8_WAIT_V(6); PG8_BAR;
    } else {
        PG8_STAGE(PG8_SB(0, 0), cB, voffB); PG8_STAGE(PG8_SA(0, 0), cA, voffA); PG8_STAGE(PG8_SB(0, 1), cB + hstep, voffB); PG8_STAGE(PG8_SA(0, 1), cA + hstep, voffA);
        if (wr == 1) PG8_BAR;
        PG8_WAIT_V(4); PG8_BAR;
        PG8_STAGE(PG8_SB(1, 0), cB + kstep, voffB); PG8_STAGE(PG8_SA(1, 0), cA + kstep, voffA); PG8_STAGE(PG8_SB(1, 1), cB + hstep + kstep, voffB);
        PG8_WAIT_V(6); PG8_BAR;
    }
    for (;;) {
        const bool has_next = S.next(ui + 1, nxt);
        const char* nA = has_next ? (const char*)g.A + (size_t)nxt.pm * tstep : cA; const char* nB = has_next ? (const char*)g.Bt + (size_t)nxt.pn * tstep : cB;
        for (int t = 0; t < nt; t += 2) {
            const bool last = (t == nt - 2);
            const char* a1 = cA + (size_t)(t + 1) * kstep;
            const char* a2 = last ? nA : cA + (size_t)(t + 2) * kstep; const char* b2 = last ? nB : cB + (size_t)(t + 2) * kstep;
            const char* a3 = a2 + kstep; const char* b3 = b2 + kstep;
            if (last && has_next) S.a_ready(nxt);
            if constexpr (SP2) {
            PG8_LDB(B0, 0, 0); PG8_LDB(B1, 0, 1); PG8_SCHED; PG8_LDA(At, 0, 0); PG8_STAGE(PG8_SA(1, 1), a1 + hstep, voffA);
            PG8_WAIT_V(8); PG8_WAIT_L(0); PG8_BAR; PG8_MMA(0, 0, At, B0); PG8_MMA(0, 1, At, B1); PG8_BAR; PG8_SCHED;
            PG8_LDA(At, 0, 1); PG8_STAGE(PG8_SB(0, 0), b2, voffB); PG8_STAGE(PG8_SB(0, 1), b2 + hstep, voffB); PG8_STAGE(PG8_SA(0, 0), a2, voffA);
            PG8_WAIT_V(8); PG8_WAIT_L(0); PG8_BAR; PG8_MMA(1, 0, At, B0); PG8_MMA(1, 1, At, B1); PG8_BAR; PG8_SCHED;
            PG8_LDB(B0, 1, 0); PG8_LDB(B1, 1, 1); PG8_SCHED; PG8_LDA(At, 1, 0); PG8_STAGE(PG8_SA(0, 1), a2 + hstep, voffA);
            PG8_WAIT_V(8); PG8_WAIT_L(0); PG8_BAR; PG8_MMA(0, 0, At, B0); PG8_MMA(0, 1, At, B1); PG8_BAR; PG8_SCHED;
            PG8_LDA(At, 1, 1); PG8_STAGE(PG8_SB(1, 0), b3, voffB); PG8_STAGE(PG8_SB(1, 1), b3 + hstep, voffB); PG8_STAGE(PG8_SA(1, 0), a3, voffA);
            PG8_WAIT_V(8); PG8_WAIT_L(0); PG8_BAR; PG8_MMA(1, 0, At, B0); PG8_MMA(1, 1, At, B1); PG8_BAR; PG8_SCHED;
            } else {
            PG8_LDB(B0, 0, 0); PG8_SCHED; PG8_LDA(At, 0, 0); PG8_STAGE(PG8_SA(1, 1), a1 + hstep, voffA);
            PG8_WAIT_L(8); PG8_BAR; PG8_WAIT_L(0); PG8_MMA(0, 0, At, B0); PG8_BAR; PG8_SCHED;
            PG8_LDB(B1, 0, 1); PG8_STAGE(PG8_SB(0, 0), b2, voffB);
            PG8_BAR; PG8_WAIT_L(0); PG8_MMA(0, 1, At, B1); PG8_BAR;
            PG8_LDA(At, 0, 1); PG8_STAGE(PG8_SA(0, 0), a2, voffA);
            PG8_BAR; PG8_WAIT_L(0); PG8_MMA(1, 0, At, B0); PG8_BAR; PG8_SCHED;
            PG8_STAGE(PG8_SB(0, 1), b2 + hstep, voffB);
            PG8_WAIT_V(6); PG8_BAR; PG8_MMA(1, 1, At, B1); PG8_BAR;
            PG8_LDB(B0, 1, 0); PG8_SCHED; PG8_LDA(At, 1, 0); PG8_STAGE(PG8_SA(0, 1), a2 + hstep, voffA);
            PG8_WAIT_L(8); PG8_BAR; PG8_WAIT_L(0); PG8_MMA(0, 0, At, B0); PG8_BAR; PG8_SCHED;
            PG8_LDB(B1, 1, 1); PG8_STAGE(PG8_SB(1, 0), b3, voffB);
            PG8_BAR; PG8_WAIT_L(0); PG8_MMA(0, 1, At, B1); PG8_BAR;
            PG8_LDA(At, 1, 1); PG8_STAGE(PG8_SA(1, 0), a3, voffA);
            PG8_BAR; PG8_WAIT_L(0); PG8_MMA(1, 0, At, B0); PG8_BAR; PG8_SCHED;
            PG8_STAGE(PG8_SB(1, 1), b3 + hstep, voffB);
            PG8_WAIT_V(6); PG8_BAR; PG8_MMA(1, 1, At, B1); PG8_BAR;
            }
        }
        if constexpr (ALIGN_EPI) { if (wr == 0) PG8_BAR; }
        if constexpr (!Epi::AFTER_DRAIN) { int l2_; asm volatile("v_mbcnt_lo_u32_b32 %0, -1, 0\n\tv_mbcnt_hi_u32_b32 %0, -1, %0" : "=v"(l2_)); E(acc, cur, wr, wc, l2_ & 15, l2_ >> 4); S.done(cur); }
        if (!has_next) break;
#pragma unroll
        for (int a = 0; a < 2; ++a)
#pragma unroll
            for (int b = 0; b < 2; ++b)
#pragma unroll
                for (int m = 0; m < 4; ++m)
#pragma unroll
                    for (int n = 0; n < 2; ++n) acc[a][b][m][n] = (f32x4){0.f, 0.f, 0.f, 0.f};
        cur = nxt; cA = nA; cB = nB; ++ui;
        if constexpr (ALIGN_EPI) { if (wr == 1) PG8_BAR; }
    }
    PG8_WAIT_V(0);
    if constexpr (!ALIGN_EPI) { if (wr == 0) PG8_BAR; }
    PG8_BAR;
    if constexpr (Epi::AFTER_DRAIN) { E.fused(acc, cur, wr, wc, fr, fq, lds, wid, lane); S.done(cur); }
#undef PG8_SA
#undef PG8_SB
#undef PG8_STAGE
#undef PG8_LDA
#undef PG8_LDB
#undef PG8_MMA
#undef PG8_WAIT_V
#undef PG8_WAIT_L
#undef PG8_BAR
#undef PG8_SCHED
}
}

namespace pg8 {
typedef float f32x2 __attribute__((ext_vector_type(2)));
__device__ __forceinline__ float shx(float v, int lane, int mask) { return __int_as_float(__builtin_amdgcn_ds_bpermute((lane ^ mask) << 2, __float_as_int(v))); }
__device__ __forceinline__ float rstd16(const float* ssp, int row, int fq, int lane) {
    const f32x4 v = *(const f32x4*)(ssp + (size_t)row * 16 + 4 * fq);
    float s = (v[0] + v[1]) + (v[2] + v[3]);
    s += shx(s, lane, 16); s += shx(s, lane, 32);
    return rsqrtf(s * (1.0f / 1024.0f) + 1e-6f);
}
__device__ __forceinline__ float sigm(float v) { return __builtin_amdgcn_rcpf(1.0f + __builtin_amdgcn_exp2f(-1.4426950408889634f * v)); }
__device__ __forceinline__ u32x4 pack8(const f32x4& a, const f32x4& b) { u32x4 w; w.x = cvt_pk_bf16(a[0], a[1]); w.y = cvt_pk_bf16(a[2], a[3]); w.z = cvt_pk_bf16(b[0], b[1]); w.w = cvt_pk_bf16(b[2], b[3]); return w; }
__device__ __forceinline__ float bflo(unsigned w) { return __uint_as_float(w << 16); }
__device__ __forceinline__ float bfhi(unsigned w) { return __uint_as_float(w & 0xffff0000u); }

struct EpiSwiglu {
    static constexpr bool PERM = true, AFTER_DRAIN = false;
    bf16_t* act; const float* ssp;
    __device__ __forceinline__ void operator()(const f32x4 (&acc)[2][2][4][2], const Unit& u, int wr, int wc, int fr, int fq) const {
        const int lane = fr + 16 * fq;
        const int row0 = u.pm * BM + wr * 64 + fr, col0 = u.pn * 128 + wc * 32 + 8 * fq;
#pragma unroll
        for (int ai = 0; ai < 2; ++ai)
#pragma unroll
            for (int m = 0; m < 4; ++m) { const int row = row0 + ai * HALF + m * 16; const float rs = rstd16(ssp, row, fq, lane);
                f32x4 o[2];
#pragma unroll
                for (int n = 0; n < 2; ++n)
#pragma unroll
                    for (int j = 0; j < 4; ++j) { const float g = acc[ai][0][m][n][j] * rs, up = acc[ai][1][m][n][j] * rs; o[n][j] = g * sigm(g) * up; }
                *(u32x4*)(act + (size_t)row * 2816 + col0) = pack8(o[0], o[1]); }
    }
};
struct EpiResid {
    static constexpr bool PERM = true, AFTER_DRAIN = false;
    const float* xin; float* xout; bf16_t* xb; float* sspw; float coef;
    __device__ __forceinline__ void operator()(const f32x4 (&acc)[2][2][4][2], const Unit& u, int wr, int wc, int fr, int fq) const {
        const int lane = fr + 16 * fq;
        const int row0 = u.pm * BM + wr * 64 + fr, col0 = u.pn * BM + wc * 32 + 8 * fq;
#pragma unroll
        for (int ai = 0; ai < 2; ++ai)
#pragma unroll
            for (int m = 0; m < 4; ++m) { const int row = row0 + ai * HALF + m * 16; float ss = 0.f;
#pragma unroll
                for (int bj = 0; bj < 2; ++bj) { const size_t off = (size_t)row * 1024 + col0 + bj * HALF;
                    f32x4 x0 = *(const f32x4*)(xin + off), x1 = *(const f32x4*)(xin + off + 4);
                    x0 = x0 + acc[ai][bj][m][0] * coef; x1 = x1 + acc[ai][bj][m][1] * coef;
                    *(f32x4*)(xout + off) = x0; *(f32x4*)(xout + off + 4) = x1;
                    *(u32x4*)(xb + off) = pack8(x0, x1);
                    ss += (x0[0] * x0[0] + x0[1] * x0[1]) + (x0[2] * x0[2] + x0[3] * x0[3]) + (x1[0] * x1[0] + x1[1] * x1[1]) + (x1[2] * x1[2] + x1[3] * x1[3]); }
                ss += shx(ss, lane, 16); ss += shx(ss, lane, 32);
                if (fq == 0) sspw[(size_t)row * 16 + u.pn * 4 + wc] = ss; }
    }
};
struct EpiGate {
    static constexpr bool PERM = true, AFTER_DRAIN = false;
    const float* xin; float* xout; bf16_t* xb; float* sspw; const float* sspr; const bf16_t* proj;
    __device__ __forceinline__ void operator()(const f32x4 (&acc)[2][2][4][2], const Unit& u, int wr, int wc, int fr, int fq) const {
        const int lane = fr + 16 * fq;
        const int row0 = u.pm * BM + wr * 64 + fr, col0 = u.pn * BM + wc * 32 + 8 * fq;
#pragma unroll
        for (int ai = 0; ai < 2; ++ai)
#pragma unroll
            for (int m = 0; m < 4; ++m) { const int row = row0 + ai * HALF + m * 16; const float rs = rstd16(sspr, row, fq, lane); float ss = 0.f;
#pragma unroll
                for (int bj = 0; bj < 2; ++bj) { const size_t off = (size_t)row * 1024 + col0 + bj * HALF;
                    f32x4 x0 = *(const f32x4*)(xin + off), x1 = *(const f32x4*)(xin + off + 4);
                    const u32x4 pw = *(const u32x4*)(proj + off);
                    const f32x4 p0 = {bflo(pw.x), bfhi(pw.x), bflo(pw.y), bfhi(pw.y)}, p1 = {bflo(pw.z), bfhi(pw.z), bflo(pw.w), bfhi(pw.w)};
#pragma unroll
                    for (int j = 0; j < 4; ++j) { x0[j] += sigm(acc[ai][bj][m][0][j] * rs) * p0[j]; x1[j] += sigm(acc[ai][bj][m][1][j] * rs) * p1[j]; }
                    *(f32x4*)(xout + off) = x0; *(f32x4*)(xout + off + 4) = x1;
                    *(u32x4*)(xb + off) = pack8(x0, x1);
                    ss += (x0[0] * x0[0] + x0[1] * x0[1]) + (x0[2] * x0[2] + x0[3] * x0[3]) + (x1[0] * x1[0] + x1[1] * x1[1]) + (x1[2] * x1[2] + x1[3] * x1[3]); }
                ss += shx(ss, lane, 16); ss += shx(ss, lane, 32);
                if (fq == 0) sspw[(size_t)row * 16 + u.pn * 4 + wc] = ss; }
    }
};
struct EpiStoreBf16 {
    static constexpr bool PERM = true, AFTER_DRAIN = false;
    bf16_t* O; int ldc;
    __device__ __forceinline__ void operator()(const f32x4 (&acc)[2][2][4][2], const Unit& u, int wr, int wc, int fr, int fq) const {
        const int lane = fr + 16 * fq;
        const int row0 = u.pm * BM + wr * 64 + fr, col0 = u.pn * BM + wc * 32 + 8 * fq;
#pragma unroll
        for (int ai = 0; ai < 2; ++ai)
#pragma unroll
            for (int m = 0; m < 4; ++m) { const int row = row0 + ai * HALF + m * 16;
#pragma unroll
                for (int bj = 0; bj < 2; ++bj) *(u32x4*)(O + (size_t)row * ldc + col0 + bj * HALF) = pack8(acc[ai][bj][m][0], acc[ai][bj][m][1]); }
    }
};
struct EpiQkv {
    static constexpr bool PERM = true, AFTER_DRAIN = false;
    const float* ssp; bf16_t *qa, *ka, *va, *qb, *kb, *vb; const float *qna, *kna, *qnb, *knb;
    __device__ __forceinline__ void operator()(const f32x4 (&acc)[2][2][4][2], const Unit& u, int wr, int wc, int fr, int fq) const {
        const int lane = fr + 16 * fq;
        const int t = u.pn; bf16_t* dst; const float* ng; int nh, h; float sc = 1.0f;
        if (t < 2) { dst = qa; ng = qna; nh = 8; h = 4 * t + wc; sc = QSCALE; }
        else if (t < 4) { dst = ka; ng = kna; nh = 8; h = 4 * (t - 2) + wc; }
        else if (t < 6) { dst = va; ng = nullptr; nh = 8; h = 4 * (t - 4) + wc; }
        else if (t < 8) { dst = qb; ng = qnb; nh = 8; h = 4 * (t - 6) + wc; sc = QSCALE; }
        else if (wc < 2) { dst = kb; ng = knb; nh = 2; h = wc; }
        else { dst = vb; ng = nullptr; nh = 2; h = wc - 2; }
        f32x4 gv[2][2];
#pragma unroll
        for (int bj = 0; bj < 2; ++bj)
#pragma unroll
            for (int n = 0; n < 2; ++n) { if (ng) gv[bj][n] = *(const f32x4*)(ng + 32 * bj + 8 * fq + 4 * n) * sc; else gv[bj][n] = (f32x4){1.f, 1.f, 1.f, 1.f}; }
        const int row0 = u.pm * BM + wr * 64 + fr;
#pragma unroll
        for (int ai = 0; ai < 2; ++ai)
#pragma unroll
            for (int m = 0; m < 4; ++m) { const int row = row0 + ai * HALF + m * 16; const float rs = rstd16(ssp, row, fq, lane);
                f32x4 v[2][2]; float ss = 0.f;
#pragma unroll
                for (int bj = 0; bj < 2; ++bj)
#pragma unroll
                    for (int n = 0; n < 2; ++n) { v[bj][n] = acc[ai][bj][m][n] * rs; ss += (v[bj][n][0] * v[bj][n][0] + v[bj][n][1] * v[bj][n][1]) + (v[bj][n][2] * v[bj][n][2] + v[bj][n][3] * v[bj][n][3]); }
                ss += shx(ss, lane, 16); ss += shx(ss, lane, 32);
                const float hr = ng ? rsqrtf(ss * (1.0f / 64.0f) + 1e-6f) : 1.0f;
                const int b = row >> 12, s = row & 4095;
                bf16_t* p = dst + (((size_t)b * nh + h) * 4096 + s) * 64 + 8 * fq;
#pragma unroll
                for (int bj = 0; bj < 2; ++bj) *(u32x4*)(p + 32 * bj) = pack8(v[bj][0] * hr * gv[bj][0], v[bj][1] * hr * gv[bj][1]); }
    }
};
}

#include <hip/hip_cooperative_groups.h>
namespace cg = cooperative_groups;
#define LAS __attribute__((address_space(3)))
typedef unsigned v4u __attribute__((ext_vector_type(4)));
constexpr int NWAVES = 8, RING_BYTES = 131072, LDS_BYTES = 147456;
constexpr int NPHASE = 1 + 8 * DEPTH;
constexpr size_t WO_F1IN = 0, WO_F1OUT = WO_F1IN + (size_t)2 * DFF * D, WO_QKV = WO_F1OUT + (size_t)D * DFF, WO_WO = WO_QKV + (size_t)QKVW * D,
                 WO_F2IN = WO_WO + (size_t)D * D, WO_F2OUT = WO_F2IN + (size_t)2 * DFF * D, WO_WG = WO_F2OUT + (size_t)D * DFF, WO_WP = WO_WG + (size_t)D * D, W_LAYER = WO_WP + (size_t)D * PLE;
static_assert(W_LAYER * 2 * DEPTH <= 84 * MiB, "weights fit");

struct Args { const float* in[20]; float* out; unsigned char* ws; int ph_lo, ph_hi; };

__device__ __forceinline__ void transpose_item(const float* W, int K, int N, const float* gain, bf16_t* Bt, int kind, int item, LAS float* scr, int lane) {
    const int kblocks = K / 64, nb = item / kblocks, kb = item % kblocks, k0 = 64 * kb, n0 = 32 * nb;
    int c0;
    if (kind == 0) c0 = n0;
    else if (kind == 1) c0 = ((n0 >> 7) & 1) * DFF + 128 * (n0 >> 8) + (n0 & 127);
    else c0 = 256 * (n0 >> 8) + 64 * ((n0 >> 5) & 3) + 32 * ((n0 >> 7) & 1);
#pragma unroll 8
    for (int i = 0; i < 32; ++i) { const int kk = 2 * i + (lane >> 5); const float g = gain ? gain[k0 + kk] : 1.0f; scr[kk * 33 + (lane & 31)] = W[(size_t)(k0 + kk) * N + c0 + (lane & 31)] * g; }
    asm volatile("s_waitcnt lgkmcnt(0)" ::: "memory");
    const int c = lane & 7;
#pragma unroll
    for (int j = 0; j < 4; ++j) { const int n = (lane >> 3) + 8 * j; const LAS float* s = scr + (8 * c) * 33 + n;
        v4u o; o.x = pg8::cvt_pk_bf16(s[0 * 33], s[1 * 33]); o.y = pg8::cvt_pk_bf16(s[2 * 33], s[3 * 33]); o.z = pg8::cvt_pk_bf16(s[4 * 33], s[5 * 33]); o.w = pg8::cvt_pk_bf16(s[6 * 33], s[7 * 33]);
        *(v4u*)(Bt + (size_t)(n0 + n) * K + k0 + 8 * c) = o; }
    asm volatile("s_waitcnt lgkmcnt(0)" ::: "memory");
}

template <class AT> __device__ __forceinline__ void prologue_phase(const AT& a, LAS unsigned char* lds, int gw, int NGW, int wave, int lane) {
    LAS float* scr = (LAS float*)(lds + wave * 16384);
    bf16_t* wbase = (bf16_t*)(a.ws() + WS_W);
    constexpr int I_FIN = (D / 64) * (2 * DFF / 32), I_FOUT = (DFF / 64) * (D / 32), I_QKV = (D / 64) * (QKVW / 32), I_SQ = (D / 64) * (D / 32), I_WP = (PLE / 64) * (D / 32);
    constexpr int I_LAYER = 2 * I_FIN + 2 * I_FOUT + I_QKV + 2 * I_SQ + I_WP;
    for (int it = gw; it < DEPTH * I_LAYER; it += NGW) {
        const int l = it / I_LAYER; int r = it % I_LAYER; bf16_t* wl = wbase + (size_t)l * W_LAYER;
        if (r < I_FIN) { transpose_item(a.in(4) + (size_t)l * D * 2 * DFF, D, 2 * DFF, a.in(3) + l * D, wl + WO_F1IN, 1, r, scr, lane); continue; } r -= I_FIN;
        if (r < I_FOUT) { transpose_item(a.in(5) + (size_t)l * DFF * D, DFF, D, nullptr, wl + WO_F1OUT, 0, r, scr, lane); continue; } r -= I_FOUT;
        if (r < I_QKV) { transpose_item(a.in(7) + (size_t)l * D * QKVW, D, QKVW, a.in(6) + l * D, wl + WO_QKV, 2, r, scr, lane); continue; } r -= I_QKV;
        if (r < I_SQ) { transpose_item(a.in(13) + (size_t)l * D * D, D, D, nullptr, wl + WO_WO, 0, r, scr, lane); continue; } r -= I_SQ;
        if (r < I_FIN) { transpose_item(a.in(15) + (size_t)l * D * 2 * DFF, D, 2 * DFF, a.in(14) + l * D, wl + WO_F2IN, 1, r, scr, lane); continue; } r -= I_FIN;
        if (r < I_FOUT) { transpose_item(a.in(16) + (size_t)l * DFF * D, DFF, D, nullptr, wl + WO_F2OUT, 0, r, scr, lane); continue; } r -= I_FOUT;
        if (r < I_SQ) { transpose_item(a.in(18) + (size_t)l * D * D, D, D, a.in(17) + l * D, wl + WO_WG, 0, r, scr, lane); continue; } r -= I_SQ;
        transpose_item(a.in(19) + (size_t)l * PLE * D, PLE, D, nullptr, wl + WO_WP, 0, r, scr, lane);
    }
    const float* x = a.in(0); bf16_t* xb = (bf16_t*)(a.ws() + WS_XB); float* ssp = (float*)(a.ws() + WS_SSP);
    for (int row = gw; row < M; row += NGW) {
        const float4* xr = (const float4*)(x + (size_t)row * D); float s = 0.f;
#pragma unroll
        for (int j = 0; j < 4; ++j) { const float4 v = xr[lane + 64 * j]; s += v.x * v.x + v.y * v.y + v.z * v.z + v.w * v.w;
            uint2 o; o.x = pg8::cvt_pk_bf16(v.x, v.y); o.y = pg8::cvt_pk_bf16(v.z, v.w); ((uint2*)(xb + (size_t)row * D))[lane + 64 * j] = o; }
#pragma unroll
        for (int o = 1; o < 64; o <<= 1) s += pg8::shx(s, lane, o);
        if (lane < 4) { float4 r; r.x = lane == 0 ? s : 0.f; r.y = 0.f; r.z = 0.f; r.w = 0.f; ((float4*)ssp)[row * 4 + lane] = r; }
    }
}
__device__ __forceinline__ void convert_p(const float* p, bf16_t* pb, int gtid, int nthreads) {
    for (int i = gtid; i < M * PLE / 8; i += nthreads) { const float4 v0 = ((const float4*)p)[2 * i], v1 = ((const float4*)p)[2 * i + 1];
        v4u o; o.x = pg8::cvt_pk_bf16(v0.x, v0.y); o.y = pg8::cvt_pk_bf16(v0.z, v0.w); o.z = pg8::cvt_pk_bf16(v1.x, v1.y); o.w = pg8::cvt_pk_bf16(v1.z, v1.w); ((v4u*)pb)[i] = o; }
}

__device__ __forceinline__ void attn_simple_phase(LAS unsigned char* lds, const AttnIn& a, int G, int wave, int lane) {
    LAS float* pl = (LAS float*)(lds + wave * 4096); LAS int* kl = (LAS int*)(lds + wave * 4096 + 2048);
    const int total = NB * 16 * S;
    for (int item = blockIdx.x * NWAVES + wave; item < total; item += G * NWAVES) {
        const int t = item & (S - 1), head = (item >> 12) & 15, b = item >> 16;
        const bool isA = head < 8;
        const bf16_t *q, *k, *v;
        if (isA) { q = a.qa + (((size_t)b * 8 + head) * S + t) * HD; k = a.ka + ((size_t)b * 8 + head) * S * HD; v = a.va + ((size_t)b * 8 + head) * S * HD; }
        else { const int hq = head - 8, hk = hq >> 2; q = a.qb + (((size_t)b * 8 + hq) * S + t) * HD; k = a.kb + ((size_t)b * 2 + hk) * S * HD; v = a.vb + ((size_t)b * 2 + hk) * S * HD; }
        float qf[HD];
#pragma unroll
        for (int e = 0; e < HD; ++e) qf[e] = bf2f(q[e]);
        const int nk = isA ? 387 : 257;
        float mx = -1e30f;
        for (int i = lane; i < nk; i += 64) {
            int rel;
            if (isA) { const int br = i / 129, j = i % 129 - 64; rel = j * (br == 0 ? 1 : br == 1 ? 4 : 16); } else rel = i - 128;
            const int tk = t + rel; float lg = -1e30f;
            if (tk >= 0 && tk < S) { float d = 0.f; const bf16_t* kr = k + (size_t)tk * HD;
#pragma unroll
                for (int e = 0; e < HD; ++e) d += qf[e] * bf2f(kr[e]);
                lg = d + a.rel_bias[t5_bucket(rel) * 16 + head] * LOG2E; }
            pl[i] = lg; kl[i] = tk; mx = fmaxf(mx, lg);
        }
#pragma unroll
        for (int o = 1; o < 64; o <<= 1) mx = fmaxf(mx, pg8::shx(mx, lane, o));
        float sinkl = 0.f;
        if (!isA) { sinkl = a.sink[head - 8] * LOG2E; mx = fmaxf(mx, sinkl); }
        float sum = 0.f;
        for (int i = lane; i < nk; i += 64) { const float lg = pl[i]; const float pv = lg > -1e29f ? exp2f(lg - mx) : 0.f; pl[i] = pv; sum += pv; }
#pragma unroll
        for (int o = 1; o < 64; o <<= 1) sum += pg8::shx(sum, lane, o);
        if (!isA) sum += exp2f(sinkl - mx);
        asm volatile("s_waitcnt lgkmcnt(0)" ::: "memory");
        float acc = 0.f;
        for (int i = 0; i < nk; ++i) { const float pv = pl[i]; if (pv != 0.f) acc += pv * bf2f(v[(size_t)kl[i] * HD + lane]); }
        a.o[((size_t)b * S + t) * D + head * HD + lane] = f2bf(acc / sum);
    }
}

namespace att {
typedef short bf16x8 __attribute__((ext_vector_type(8)));
typedef short s16x4 __attribute__((ext_vector_type(4)));
typedef short v4i16_t __attribute__((ext_vector_type(4)));
typedef float f32x16 __attribute__((ext_vector_type(16)));
typedef unsigned u32x4 __attribute__((ext_vector_type(4)));
typedef float f32x2_t __attribute__((ext_vector_type(2))); typedef __bf16 bf16x2_t __attribute__((ext_vector_type(2)));
constexpr float NEG = -1e30f;
constexpr int WAVE_LDS = 8704, LUT_OFF = 8 * WAVE_LDS, LUTA_STRIDE = 200, LUTB_STRIDE = 328, LUTB_OFF = LUT_OFF + 3 * LUTA_STRIDE * 4, TAB_OFF = LUT_OFF + 8192, LSE_OFF = TAB_OFF + 65536, ATT_LDS_END = LSE_OFF + 2048;
static_assert(LUTB_OFF + 4 * LUTB_STRIDE * 4 <= TAB_OFF && ATT_LDS_END <= 147456, "attention LDS map");
__device__ __forceinline__ int crow(int r, int hi) { return (r & 3) + 8 * (r >> 2) + 4 * hi; }
__device__ __forceinline__ unsigned cvtpk(float lo, float hi) { f32x2_t v = {lo, hi}; bf16x2_t b = __builtin_convertvector(v, bf16x2_t); return __builtin_bit_cast(unsigned, b); }
__device__ __forceinline__ s16x4 vtr(const LAS unsigned char* p) { return __builtin_bit_cast(s16x4, __builtin_amdgcn_ds_read_tr16_b64_v4i16((LAS v4i16_t*)p)); }
__device__ __forceinline__ float halfmax(float v) { auto rr = __builtin_amdgcn_permlane32_swap(__float_as_uint(v), __float_as_uint(v), false, false); return fmaxf(__uint_as_float(rr[0]), __uint_as_float(rr[1])); }
__device__ __forceinline__ float halfsum(float v) { auto rr = __builtin_amdgcn_permlane32_swap(__float_as_uint(v), __float_as_uint(v), false, false); return __uint_as_float(rr[0]) + __uint_as_float(rr[1]); }

template <int NT>
__device__ __forceinline__ void qtile(const bf16_t* qrow, const bf16_t* kbase, const bf16_t* vbase, int tk0, int dstep, const LAS float* lut, float m0, float l0,
                                      LAS unsigned char* wl, int lane, f32x16 (&o)[2], float& m_out, float& l_out) {
    const int i = lane & 31, hi = lane >> 5;
    LAS float* wsf = (LAS float*)(wl + 8192);
    constexpr int C = NT / 2;
    bf16x8 qf[4];
#pragma unroll
    for (int ks = 0; ks < 4; ++ks) qf[ks] = *(const bf16x8*)(qrow + 16 * ks + 8 * hi);
    const int vrow = lane >> 3, vch = lane & 7;
    const int wr_off = vrow * 128 + ((vch ^ (((lane >> 4) & 1) << 2)) * 16);
    const int rd_base = (4 * hi + ((lane & 15) >> 2)) * 128 + 32 * ((lane >> 4) & 1) + 8 * (lane & 3);
    const int bit3 = (lane >> 3) & 1;
    const int vb0 = rd_base + 64 * bit3, vb1 = rd_base + 64 * (1 - bit3);
    bf16x8 kf[4]; u32x4 vr[4];
#define ATT_LOAD(j) do { \
        { int tk = tk0 + (32 * (j) + i) * dstep; tk = tk < 0 ? 0 : (tk > S - 1 ? S - 1 : tk); const bf16_t* kp = kbase + (size_t)tk * HD + 8 * hi; \
          _Pragma("unroll") for (int ks = 0; ks < 4; ++ks) kf[ks] = *(const bf16x8*)(kp + 16 * ks); } \
        _Pragma("unroll") for (int i4 = 0; i4 < 4; ++i4) { int tk = tk0 + (32 * (j) + vrow + 8 * i4) * dstep; tk = tk < 0 ? 0 : (tk > S - 1 ? S - 1 : tk); \
          vr[i4] = *(const u32x4*)(vbase + (size_t)tk * HD + 8 * vch); } } while (0)
    float m = m0, l = hi == 0 ? l0 : 0.f;
    o[0] = f32x16{}; o[1] = f32x16{};
    ATT_LOAD(C);
#pragma unroll 1
    for (int s = 0; s < NT; ++s) {
        const int j = (s == 0) ? C : (s <= C ? s - 1 : s);
        LAS unsigned char* vbuf = wl + (s & 1) * 4096;
#pragma unroll
        for (int i4 = 0; i4 < 4; ++i4) *(LAS u32x4*)(vbuf + wr_off + i4 * 1024) = vr[i4];
        f32x16 p = __builtin_amdgcn_mfma_f32_32x32x16_bf16(kf[0], qf[0], f32x16{}, 0, 0, 0);
        p = __builtin_amdgcn_mfma_f32_32x32x16_bf16(kf[1], qf[1], p, 0, 0, 0);
        p = __builtin_amdgcn_mfma_f32_32x32x16_bf16(kf[2], qf[2], p, 0, 0, 0);
        p = __builtin_amdgcn_mfma_f32_32x32x16_bf16(kf[3], qf[3], p, 0, 0, 0);
        if (s + 1 < NT) { const int jn = (s + 1 <= C) ? s : s + 1; ATT_LOAD(jn); }
        const int first = tk0 + 32 * j * dstep, lastk = first + 31 * dstep;
        const bool inside = first >= 0 && lastk < S;
        const LAS float* lp = lut + 32 * j - i + 4 * hi;
#pragma unroll
        for (int r = 0; r < 16; ++r) { const int kk0 = (r & 3) + 8 * (r >> 2); p[r] += lp[kk0]; }
        if (j == 0) {
#pragma unroll
            for (int r = 0; r < 16; ++r) { if (crow(r, hi) < i) p[r] = NEG; }
        }
        if (j == NT - 1) {
#pragma unroll
            for (int r = 0; r < 16; ++r) { if (crow(r, hi) > i) p[r] = NEG; }
        }
        if (!inside) {
#pragma unroll
            for (int r = 0; r < 16; ++r) { const int tk = first + crow(r, hi) * dstep; if ((unsigned)tk >= (unsigned)S) p[r] = NEG; }
        }
        float rm = p[0];
#pragma unroll
        for (int r = 1; r < 16; ++r) rm = fmaxf(rm, p[r]);
        rm = halfmax(rm);
        if (__any(rm > m)) {
            const float mn = fmaxf(m, rm), alpha = __builtin_amdgcn_exp2f(m - mn);
            l *= alpha; m = mn;
            if (hi == 0) wsf[i] = alpha;
#pragma unroll
            for (int r = 0; r < 16; ++r) { const float a = wsf[crow(r, hi)]; o[0][r] *= a; o[1][r] *= a; }
        }
        float rs = 0.f;
#pragma unroll
        for (int r = 0; r < 16; ++r) { p[r] = __builtin_amdgcn_exp2f(p[r] - m); rs += p[r]; }
        l += rs;
        u32x4 pw0 = {cvtpk(p[0], p[1]), cvtpk(p[2], p[3]), cvtpk(p[4], p[5]), cvtpk(p[6], p[7])};
        u32x4 pw1 = {cvtpk(p[8], p[9]), cvtpk(p[10], p[11]), cvtpk(p[12], p[13]), cvtpk(p[14], p[15])};
        const bf16x8 pa0 = __builtin_bit_cast(bf16x8, pw0), pa1 = __builtin_bit_cast(bf16x8, pw1);
#pragma unroll
        for (int d0 = 0; d0 < 2; ++d0) {
            const LAS unsigned char* vp = vbuf + (d0 == 0 ? vb0 : vb1);
            const s16x4 a0 = vtr(vp), a1 = vtr(vp + 1024), b0 = vtr(vp + 2048), b1 = vtr(vp + 3072);
            const bf16x8 f0 = {a0[0], a0[1], a0[2], a0[3], a1[0], a1[1], a1[2], a1[3]}, f1 = {b0[0], b0[1], b0[2], b0[3], b1[0], b1[1], b1[2], b1[3]};
            o[d0] = __builtin_amdgcn_mfma_f32_32x32x16_bf16(pa0, f0, o[d0], 0, 0, 0);
            o[d0] = __builtin_amdgcn_mfma_f32_32x32x16_bf16(pa1, f1, o[d0], 0, 0, 0);
        }
    }
#undef ATT_LOAD
    m_out = m; l_out = halfsum(l);
}

__device__ __forceinline__ void stage_o(const f32x16 (&o)[2], float m, float l, LAS unsigned char* wl, int lane) {
    const int i = lane & 31, hi = lane >> 5;
    LAS float* wsf = (LAS float*)(wl + 8192);
    if (hi == 0) { wsf[i] = __builtin_amdgcn_rcpf(l); wsf[32 + i] = m + __builtin_amdgcn_logf(l); }
    LAS bf16_t* stg = (LAS bf16_t*)wl;
#pragma unroll
    for (int r = 0; r < 16; ++r) { const int q = crow(r, hi); const float inv = wsf[q];
        stg[q * 64 + i] = (bf16_t)(cvtpk(o[0][r] * inv, 0.f) & 0xffffu); stg[q * 64 + 32 + i] = (bf16_t)(cvtpk(o[1][r] * inv, 0.f) & 0xffffu); }
}
__device__ __forceinline__ float bflo(unsigned w) { return __uint_as_float(w << 16); }
__device__ __forceinline__ float bfhi(unsigned w) { return __uint_as_float(w & 0xffff0000u); }
__device__ __forceinline__ unsigned mix2(unsigned a, unsigned b, float wa, float wb) { return cvtpk(wa * bflo(a) + wb * bflo(b), wa * bfhi(a) + wb * bfhi(b)); }

struct Tensors { const bf16_t *qa, *ka, *va, *qb, *kb, *vb; const float* rel_bias; const float* sink; bf16_t* o; };

__device__ __forceinline__ int bucket(int rel) {
    const int n = rel < 0 ? -rel : rel; const int ret = rel > 0 ? 16 : 0;
    if (n < 8) return ret + n;
    int large = 8 + (int)(logf((float)n / 8.0f) / 4.852030263919617f * 8.0f);
    large = large < 15 ? large : 15;
    return ret + large;
}

__device__ __forceinline__ void attn_unit(const Tensors& T, int u, LAS unsigned char* lds, int wave, int lane) {
    LAS unsigned char* wl = lds + wave * WAVE_LDS;
    LAS float* wsf = (LAS float*)(wl + 8192);
    LAS float* lutA = (LAS float*)(lds + LUT_OFF); LAS float* lutB = (LAS float*)(lds + LUTB_OFF);
    LAS unsigned char* tab = lds + TAB_OFF; LAS float* lsetab = (LAS float*)(lds + LSE_OFF);
    const int tid = wave * 64 + lane;
    const int i = lane & 31;
    {
        const int bh = u >> 3, blk = u & 7, b = bh >> 3, h = bh & 7, t0 = blk * 512;
        const bf16_t* qbase = T.qa + (size_t)bh * S * HD; const bf16_t* kbase = T.ka + (size_t)bh * S * HD; const bf16_t* vbase = T.va + (size_t)bh * S * HD;
        __syncthreads();
        for (int e = tid; e < 3 * 129; e += 512) { const int c = e / 129, idx = e % 129, d = c == 0 ? 1 : (c == 1 ? 4 : 16);
            lutA[c * LUTA_STRIDE + 32 + idx] = T.rel_bias[bucket((idx - 64) * d) * 16 + h] * LOG2E; }
        __syncthreads();
#pragma unroll 1
        for (int pass = 0; pass < 3; ++pass) {
            const int c = 2 - pass, d = c == 0 ? 1 : (c == 1 ? 4 : 16);
#pragma unroll 1
            for (int tt = 0; tt < 2; ++tt) {
                const int Tq = 2 * wave + tt;
                int rr, beta;
                if (c == 2) { rr = Tq; beta = 0; } else if (c == 1) { rr = Tq >> 2; beta = Tq & 3; } else { rr = 0; beta = Tq; }
                const int lam0 = 32 * beta;
                const int tq = t0 + d * (lam0 + i) + rr, tk0 = t0 + d * (lam0 - 64) + rr;
                f32x16 o[2]; float m, l;
                qtile<5>(qbase + (size_t)tq * HD, kbase, vbase, tk0, d, lutA + c * LUTA_STRIDE + 32, NEG, 0.f, wl, lane, o, m, l);
                stage_o(o, m, l, wl, lane);
#pragma unroll
                for (int i4 = 0; i4 < 4; ++i4) {
                    const int qi = (lane >> 3) + 8 * i4, ch = lane & 7, tau = d * (lam0 + qi) + rr;
                    u32x4 v = *(const LAS u32x4*)(wl + qi * 128 + ch * 16);
                    const float Lb = wsf[32 + qi];
                    LAS u32x4* te = (LAS u32x4*)(tab + tau * 128 + ch * 16);
                    if (pass == 0) { *te = v; if (ch == 0) lsetab[tau] = Lb; }
                    else {
                        const u32x4 tv = *te; const float La = lsetab[tau];
                        const float Lm = fmaxf(La, Lb), sa = __builtin_amdgcn_exp2f(La - Lm), sb = __builtin_amdgcn_exp2f(Lb - Lm), tot = sa + sb, rt = __builtin_amdgcn_rcpf(tot), wa = sa * rt, wb = sb * rt;
                        u32x4 w; w.x = mix2(tv.x, v.x, wa, wb); w.y = mix2(tv.y, v.y, wa, wb); w.z = mix2(tv.z, v.z, wa, wb); w.w = mix2(tv.w, v.w, wa, wb);
                        if (pass == 1) { *te = w; if (ch == 0) lsetab[tau] = Lm + __builtin_amdgcn_logf(tot); }
                        else *(u32x4*)(T.o + ((size_t)b * S + t0 + tau) * D + h * HD + ch * 8) = w;
                    }
                }
            }
            __syncthreads();
        }
    }
    {
        const int bk = u >> 5, blk = u & 31, b = bk >> 1, hk = bk & 1, t0 = blk * 128;
        const bf16_t* kbase = T.kb + (size_t)bk * S * HD; const bf16_t* vbase = T.vb + (size_t)bk * S * HD;
        for (int e = tid; e < 4 * 257; e += 512) { const int g = e / 257, idx = e % 257;
            lutB[g * LUTB_STRIDE + 32 + idx] = T.rel_bias[bucket(idx - 128) * 16 + 8 + 4 * hk + g] * LOG2E; }
        __syncthreads();
        const int qt = wave & 3;
#pragma unroll 1
        for (int gg = 0; gg < 2; ++gg) {
            const int g = 2 * (wave >> 2) + gg, hq = 4 * hk + g;
            const bf16_t* qbase = T.qb + ((size_t)b * 8 + hq) * S * HD;
            const int tq = t0 + 32 * qt + i, tk0 = t0 + 32 * qt - 128;
            f32x16 o[2]; float m, l;
            qtile<9>(qbase + (size_t)tq * HD, kbase, vbase, tk0, 1, lutB + g * LUTB_STRIDE + 32, T.sink[hq] * LOG2E, 1.0f, wl, lane, o, m, l);
            stage_o(o, m, l, wl, lane);
#pragma unroll
            for (int i4 = 0; i4 < 4; ++i4) { const int qi = (lane >> 3) + 8 * i4, ch = lane & 7;
                const u32x4 v = *(const LAS u32x4*)(wl + qi * 128 + ch * 16);
                *(u32x4*)(T.o + ((size_t)b * S + t0 + 32 * qt + qi) * D + (8 + hq) * HD + ch * 8) = v; }
        }
    }
}
}

typedef const float* cfptr_t; typedef float* fptr_t; typedef unsigned char* ucptr_t;
typedef __attribute__((address_space(4))) const unsigned char* kargp_t;
struct KA {
    kargp_t kp;
    __device__ __forceinline__ const float* in(int i) const { return *(__attribute__((address_space(4))) const cfptr_t*)(kp + 8 * i); }
    __device__ __forceinline__ float* out() const { return *(__attribute__((address_space(4))) const fptr_t*)(kp + 160); }
    __device__ __forceinline__ unsigned char* ws() const { return *(__attribute__((address_space(4))) const ucptr_t*)(kp + 168); }
    __device__ __forceinline__ int ph_lo() const { return *(__attribute__((address_space(4))) const int*)(kp + 176); }
    __device__ __forceinline__ int ph_hi() const { return *(__attribute__((address_space(4))) const int*)(kp + 180); }
};
static_assert(sizeof(Args) == 184, "Args layout");
__global__ void __launch_bounds__(NWAVES * 64, 2) mk_fwd(Args) {
    extern __shared__ __attribute__((aligned(16))) unsigned char lds_raw[];
    LAS unsigned char* lds = (LAS unsigned char*)lds_raw;
    cg::grid_group grid = cg::this_grid();
    const int wave0 = __builtin_amdgcn_readfirstlane(threadIdx.x >> 6);
    KA a; a.kp = (kargp_t)__builtin_amdgcn_kernarg_segment_ptr();
    const int ph_hi = a.ph_hi();
    for (int ph = a.ph_lo(); ph < ph_hi; ++ph) {
    asm volatile("" : "+s"(a.kp));
    int G_ = gridDim.x, bx_ = blockIdx.x; asm volatile("" : "+s"(G_), "+s"(bx_));
    const int G = G_, bx = bx_;
    const int wave = wave0;
#define FRESH_LANE() ({ int l_; asm volatile("v_mbcnt_lo_u32_b32 %0, -1, 0\n\tv_mbcnt_hi_u32_b32 %0, -1, %0" : "=v"(l_)); l_; })
    const int vcu = (G % 8 == 0) ? (bx % 8) * (G / 8) + bx / 8 : bx;
    const int gw = vcu * NWAVES + wave, NGW = G * NWAVES;
    unsigned char* ws = a.ws();
    bf16_t* xb = (bf16_t*)(ws + WS_XB); float* ssp0 = (float*)(ws + WS_SSP); float* ssp1 = ssp0 + (size_t)M * 16;
    bf16_t* xb2 = (bf16_t*)(ws + WS_W);
    bf16_t* act = (bf16_t*)(ws + WS_R + R_ACT); bf16_t* ob = (bf16_t*)(ws + WS_R + R_O);
    bf16_t* pb = (bf16_t*)(ws + WS_PB); bf16_t* proj = (bf16_t*)(ws + WS_PROJ);
        if (ph == 0) {
            prologue_phase(a, lds, gw, NGW, wave, FRESH_LANE());
            convert_p(a.in(1), pb, bx * NWAVES * 64 + wave0 * 64 + FRESH_LANE(), G * NWAVES * 64);
        } else {
            const int l = (ph - 1) >> 3, k = (ph - 1) & 7;
            const bf16_t* wl = (const bf16_t*)(ws + WS_W) + (size_t)l * W_LAYER;
            const float* xin = (l == 0 && k <= 1) ? a.in(0) : a.out();
            if (k == 0 || k == 5) {
                pg8::Gemm g{(k == 0 && l == 1) ? xb2 : xb, wl + (k == 0 ? WO_F1IN : WO_F2IN), M, 2 * DFF, D}; pg8::StaticOrder S; S.init(M, 2 * DFF, G, bx);
                pg8::EpiSwiglu E{act, ssp0};
                pg8::gemm_phase<pg8::EpiSwiglu, pg8::StaticOrder, true, true>(lds, g, S, E, wave0 * 64 + FRESH_LANE());
            } else if (k == 1 || k == 6) {
                pg8::Gemm g{act, wl + (k == 1 ? WO_F1OUT : WO_F2OUT), M, D, DFF}; pg8::StaticOrder S; S.init(M, D, G, bx);
                pg8::EpiResid E{xin, a.out(), xb, ssp1, 0.5f};
                pg8::gemm_phase<pg8::EpiResid, pg8::StaticOrder, true, true>(lds, g, S, E, wave0 * 64 + FRESH_LANE());
            } else if (k == 2) {
                { pg8::Gemm g{xb, wl + WO_QKV, M, QKVW, D}; pg8::StaticOrder S; S.init(M, QKVW, G, bx);
                  pg8::EpiQkv E; E.ssp = ssp1;
                  E.qa = (bf16_t*)(ws + WS_R + R_QA); E.ka = (bf16_t*)(ws + WS_R + R_KA); E.va = (bf16_t*)(ws + WS_R + R_VA);
                  E.qb = (bf16_t*)(ws + WS_R + R_QB); E.kb = (bf16_t*)(ws + WS_R + R_KB); E.vb = (bf16_t*)(ws + WS_R + R_VB);
                  E.qna = a.in(8) + l * HD; E.kna = a.in(9) + l * HD; E.qnb = a.in(10) + l * HD; E.knb = a.in(11) + l * HD;
                  pg8::gemm_phase<pg8::EpiQkv, pg8::StaticOrder, true, true>(lds, g, S, E, wave0 * 64 + FRESH_LANE()); }
                { pg8::Gemm g{pb, wl + WO_WP, M, D, PLE}; pg8::StaticOrder S; S.init(M, D, G, bx);
                  pg8::EpiStoreBf16 E{proj, D};
                  pg8::gemm_phase<pg8::EpiStoreBf16, pg8::StaticOrder, true, true>(lds, g, S, E, wave0 * 64 + FRESH_LANE()); }
            } else if (k == 3) {
                AttnIn ai; ai.qa = (bf16_t*)(ws + WS_R + R_QA); ai.ka = (bf16_t*)(ws + WS_R + R_KA); ai.va = (bf16_t*)(ws + WS_R + R_VA);
                ai.qb = (bf16_t*)(ws + WS_R + R_QB); ai.kb = (bf16_t*)(ws + WS_R + R_KB); ai.vb = (bf16_t*)(ws + WS_R + R_VB);
                ai.rel_bias = a.in(2); ai.sink = a.in(12) + l * 8; ai.o = ob;
#if ATT_FAST
                { att::Tensors T; T.qa = ai.qa; T.ka = ai.ka; T.va = ai.va; T.qb = ai.qb; T.kb = ai.kb; T.vb = ai.vb; T.rel_bias = ai.rel_bias; T.sink = ai.sink; T.o = ai.o;
                  const int lane = FRESH_LANE();
                  for (int u = vcu; u < 256; u += G) att::attn_unit(T, u, lds, wave, lane); }
#else
                attn_simple_phase(lds, ai, G, wave, FRESH_LANE());
#endif
            } else if (k == 4) {
                if (l + 1 < DEPTH) { convert_p(a.in(1) + (size_t)(l + 1) * M * PLE, pb, bx * NWAVES * 64 + wave0 * 64 + FRESH_LANE(), G * NWAVES * 64); asm volatile("s_waitcnt vmcnt(0)" ::: "memory"); }
                pg8::Gemm g{ob, wl + WO_WO, M, D, D}; pg8::StaticOrder S; S.init(M, D, G, bx);
                pg8::EpiResid E{xin, a.out(), xb, ssp0, 1.0f};
                pg8::gemm_phase<pg8::EpiResid, pg8::StaticOrder, true, true>(lds, g, S, E, wave0 * 64 + FRESH_LANE());
            } else {
                pg8::Gemm g{xb, wl + WO_WG, M, D, D}; pg8::StaticOrder S; S.init(M, D, G, bx);
                pg8::EpiGate E{xin, a.out(), xb2, ssp0, ssp1, proj};
                pg8::gemm_phase<pg8::EpiGate, pg8::StaticOrder, true, true>(lds, g, S, E, wave0 * 64 + FRESH_LANE());
            }
        }
        if (ph + 1 < ph_hi) grid.sync();
    }
}

#ifndef FAST_MASK
#define FAST_MASK 0x1ffffu
#endif
extern "C" void kernel_launch(void* const* d_in, const int* in_sizes, int n_in, void* d_out, int out_size, void* d_ws, size_t ws_size, hipStream_t stream) {
    static int grid = 0;
    if (grid == 0) {
        if (n_in != 20 || in_sizes[0] != M * D || out_size != M * D || ws_size < WS_END) { fprintf(stderr, "kernel_launch: unexpected shapes (n_in %d, ws %zu)\n", n_in, ws_size); grid = -1; return; }
        int dev = 0, cus = 0, per_cu = 0;
        if (hipGetDevice(&dev) != hipSuccess || hipDeviceGetAttribute(&cus, hipDeviceAttributeMultiprocessorCount, dev) != hipSuccess) { grid = -1; return; }
        if (hipFuncSetAttribute((const void*)mk_fwd, hipFuncAttributeMaxDynamicSharedMemorySize, LDS_BYTES) != hipSuccess) { fprintf(stderr, "kernel_launch: hipFuncSetAttribute failed\n"); grid = -1; return; }
        if (hipOccupancyMaxActiveBlocksPerMultiprocessor(&per_cu, (const void*)mk_fwd, NWAVES * 64, LDS_BYTES) != hipSuccess || per_cu < 1) { fprintf(stderr, "kernel_launch: occupancy query says %d\n", per_cu); grid = -1; (void)hipGetLastError(); return; }
        grid = cus;
    }
    if (grid < 0) return;
    (void)hipMemsetAsync((char*)d_ws + WS_CTL, 0, 1 * MiB, stream);
    Args a{};
    for (int i = 0; i < 20; ++i) a.in[i] = (const float*)d_in[i];
    a.out = (float*)d_out; a.ws = (unsigned char*)d_ws;
    const unsigned fast = FAST_MASK;
    if (fast == 0x1ffffu) {
        a.ph_lo = 0; a.ph_hi = NPHASE;
        void* args[] = {&a};
        hipError_t e = hipLaunchCooperativeKernel((const void*)mk_fwd, dim3(grid), dim3(NWAVES * 64), args, LDS_BYTES, stream);
        if (e != hipSuccess) fprintf(stderr, "kernel_launch: cooperative launch failed: %s (grid %d)\n", hipGetErrorString(e), grid);
        return;
    }
    unsigned char* ws = (unsigned char*)d_ws; float* out = (float*)d_out;
    bf16_t* xb = (bf16_t*)(ws + WS_XB); bf16_t* xb2 = (bf16_t*)(ws + WS_W); float* ssp0 = (float*)(ws + WS_SSP); float* ssp1 = ssp0 + (size_t)M * 16;
    bf16_t* act = (bf16_t*)(ws + WS_R + R_ACT); bf16_t* ob = (bf16_t*)(ws + WS_R + R_O);
    QkvOut qo; qo.qa = (bf16_t*)(ws + WS_R + R_QA); qo.ka = (bf16_t*)(ws + WS_R + R_KA); qo.va = (bf16_t*)(ws + WS_R + R_VA);
    qo.qb = (bf16_t*)(ws + WS_R + R_QB); qo.kb = (bf16_t*)(ws + WS_R + R_KB); qo.vb = (bf16_t*)(ws + WS_R + R_VB);
    for (int ph = 0; ph < NPHASE; ++ph) {
        if ((fast >> ph) & 1u) { a.ph_lo = ph; a.ph_hi = ph + 1; hipLaunchKernelGGL(mk_fwd, dim3(grid), dim3(NWAVES * 64), LDS_BYTES, stream, a); continue; }
        if (ph == 0) { rowstat_kernel<<<M / 4, 256, 0, stream>>>(a.in[0], xb, ssp0); continue; }
        const int l = (ph - 1) >> 3, k = (ph - 1) & 7;
        const float* xin = (l == 0 && k <= 1) ? a.in[0] : out;
        bf16_t* xbl = (l == 1) ? xb2 : xb;
        switch (k) {
        case 0: naive_ffn_in<<<dim3(DFF / 128, M / 128), 256, 0, stream>>>(xbl, ssp0, a.in[3] + l * D, a.in[4] + (size_t)l * D * 2 * DFF, act); break;
        case 1: naive_resid<<<dim3(D / 128, M / 128), 256, 0, stream>>>(act, DFF, a.in[5] + (size_t)l * DFF * D, xin, out, 0.5f); rowstat_kernel<<<M / 4, 256, 0, stream>>>(out, xb, ssp1); break;
        case 2: qo.qna = a.in[8] + l * HD; qo.kna = a.in[9] + l * HD; qo.qnb = a.in[10] + l * HD; qo.knb = a.in[11] + l * HD;
                naive_qkv<<<dim3(QKVW / 128, M / 128), 256, 0, stream>>>(xb, ssp1, a.in[6] + l * D, a.in[7] + (size_t)l * D * QKVW, qo); break;
        case 3: { AttnIn ai; ai.qa = qo.qa; ai.ka = qo.ka; ai.va = qo.va; ai.qb = qo.qb; ai.kb = qo.kb; ai.vb = qo.vb; ai.rel_bias = a.in[2]; ai.sink = a.in[12] + l * 8; ai.o = ob;
                naive_attn<<<dim3(S / 4, 16, NB), 256, 0, stream>>>(ai); } break;
        case 4: naive_resid<<<dim3(D / 128, M / 128), 256, 0, stream>>>(ob, D, a.in[13] + (size_t)l * D * D, out, out, 1.0f); rowstat_kernel<<<M / 4, 256, 0, stream>>>(out, xb, ssp0); break;
        case 5: naive_ffn_in<<<dim3(DFF / 128, M / 128), 256, 0, stream>>>(xb, ssp0, a.in[14] + l * D, a.in[15] + (size_t)l * D * 2 * DFF, act); break;
        case 6: naive_resid<<<dim3(D / 128, M / 128), 256, 0, stream>>>(act, DFF, a.in[16] + (size_t)l * DFF * D, out, out, 0.5f); rowstat_kernel<<<M / 4, 256, 0, stream>>>(out, xb, ssp1); break;
        case 7: naive_ple<<<dim3(D / 128, M / 128), 256, 0, stream>>>(xb, ssp1, a.in[17] + l * D, a.in[18] + (size_t)l * D * D, a.in[1] + (size_t)l * M * PLE, a.in[19] + (size_t)l * PLE * D, out, out);
                rowstat_kernel<<<M / 4, 256, 0, stream>>>(out, xb2, ssp0); break;
        }
    }
}
```

```cpp
#include <hip/hip_runtime.h>
#include <cstdio>
#include <cstdint>
#ifndef ATT_FAST
#define ATT_FAST 1
#endif

typedef unsigned short bf16_t;
constexpr int NB = 4, S = 4096, D = 1024, M = NB * S, DFF = 2816, QKVW = 2304, PLE = 256, DEPTH = 2, HD = 64;
constexpr float EPS = 1e-6f;
constexpr float QSCALE = 0.125f * 1.4426950408889634f;
constexpr float LOG2E = 1.4426950408889634f;

constexpr size_t MiB = 1u << 20;
constexpr size_t WS_CTL = 0, WS_W = 1 * MiB, WS_XB = 85 * MiB, WS_R = 117 * MiB, WS_PB = 221 * MiB, WS_PROJ = 229 * MiB, WS_SSP = 261 * MiB, WS_END = 263 * MiB + 512 * 1024;
constexpr size_t R_QA = 0, R_KA = 16 * MiB, R_VA = 32 * MiB, R_QB = 48 * MiB, R_KB = 64 * MiB, R_VB = 68 * MiB, R_O = 72 * MiB, R_ACT = 0;

__device__ __forceinline__ float bf2f(bf16_t v) { return __uint_as_float(((unsigned)v) << 16); }
__device__ __forceinline__ bf16_t f2bf(float f) { unsigned u = __float_as_uint(f); return (bf16_t)((u + 0x7fffu + ((u >> 16) & 1u)) >> 16); }

__global__ void __launch_bounds__(256) rowstat_kernel(const float* __restrict__ x, bf16_t* __restrict__ xb, float* __restrict__ ssp) {
    const int wave = threadIdx.x >> 6, lane = threadIdx.x & 63;
    const int row = blockIdx.x * 4 + wave;
    const float4* xr = (const float4*)(x + (size_t)row * D);
    float s = 0.f;
#pragma unroll
    for (int j = 0; j < 4; ++j) {
        float4 v = xr[lane + 64 * j];
        s += v.x * v.x + v.y * v.y + v.z * v.z + v.w * v.w;
        ushort4 o; o.x = f2bf(v.x); o.y = f2bf(v.y); o.z = f2bf(v.z); o.w = f2bf(v.w);
        ((ushort4*)(xb + (size_t)row * D))[lane + 64 * j] = o;
    }
#pragma unroll
    for (int o = 1; o < 64; o <<= 1) s += __shfl_xor(s, o);
    if (lane < 4) { float4 r; r.x = lane == 0 ? s : 0.f; r.y = 0.f; r.z = 0.f; r.w = 0.f; ((float4*)ssp)[row * 4 + lane] = r; }
}

__device__ __forceinline__ float row_rstd(const float* ssp, int row) {
    float s = 0.f;
#pragma unroll
    for (int j = 0; j < 4; ++j) { const float4 v = ((const float4*)ssp)[row * 4 + j]; s += (v.x + v.y) + (v.z + v.w); }
    return rsqrtf(s * (1.0f / D) + EPS);
}

template <typename AT> __device__ __forceinline__ float ldA(const AT* p);
template <> __device__ __forceinline__ float ldA<bf16_t>(const bf16_t* p) { return bf2f(*p); }
template <> __device__ __forceinline__ float ldA<float>(const float* p) { return *p; }

template <typename AT>
__device__ __forceinline__ void accum_tile(const AT* A, int lda, int K, const float* gain, const float* W, int ldw, int row0, int wcol0, float (&acc)[8][8], float* As, float* Bs) {
    const int tid = threadIdx.x, tx = tid & 15, ty = tid >> 4;
    for (int k0 = 0; k0 < K; k0 += 8) {
        __syncthreads();
#pragma unroll
        for (int i = 0; i < 4; ++i) { const int idx = tid + i * 256, r = idx >> 3, kk = idx & 7;
            As[kk * 132 + r] = ldA<AT>(A + (size_t)(row0 + r) * lda + k0 + kk) * (gain ? gain[k0 + kk] : 1.0f); }
#pragma unroll
        for (int i = 0; i < 4; ++i) { const int idx = tid + i * 256, kk = idx >> 7, c = idx & 127;
            Bs[kk * 128 + c] = W[(size_t)(k0 + kk) * ldw + wcol0 + c]; }
        __syncthreads();
#pragma unroll
        for (int kk = 0; kk < 8; ++kk) {
            float a[8], b[8];
#pragma unroll
            for (int i = 0; i < 8; ++i) a[i] = As[kk * 132 + ty * 8 + i];
#pragma unroll
            for (int j = 0; j < 8; ++j) b[j] = Bs[kk * 128 + tx * 8 + j];
#pragma unroll
            for (int i = 0; i < 8; ++i)
#pragma unroll
                for (int j = 0; j < 8; ++j) acc[i][j] += a[i] * b[j];
        }
    }
}
#define ZERO_ACC(acc) do { _Pragma("unroll") for (int i = 0; i < 8; ++i) _Pragma("unroll") for (int j = 0; j < 8; ++j) acc[i][j] = 0.f; } while (0)

__global__ void __launch_bounds__(256) naive_ffn_in(const bf16_t* xb, const float* ssp, const float* gain, const float* Win, bf16_t* act) {
    __shared__ float As[8 * 132]; __shared__ float Bs[8 * 128];
    const int row0 = blockIdx.y * 128, col0 = blockIdx.x * 128, tx = threadIdx.x & 15, ty = threadIdx.x >> 4;
    float ag[8][8], au[8][8]; ZERO_ACC(ag); ZERO_ACC(au);
    accum_tile<bf16_t>(xb, D, D, gain, Win, 2 * DFF, row0, col0, ag, As, Bs);
    accum_tile<bf16_t>(xb, D, D, gain, Win, 2 * DFF, row0, DFF + col0, au, As, Bs);
#pragma unroll
    for (int i = 0; i < 8; ++i) { const int row = row0 + ty * 8 + i; const float rs = row_rstd(ssp, row);
#pragma unroll
        for (int j = 0; j < 8; ++j) { const float g = ag[i][j] * rs, u = au[i][j] * rs; const float sg = g / (1.0f + __expf(-g));
            act[(size_t)row * DFF + col0 + tx * 8 + j] = f2bf(sg * u); } }
}
__global__ void __launch_bounds__(256) naive_resid(const bf16_t* A, int K, const float* W, const float* xin, float* xout, float coef) {
    __shared__ float As[8 * 132]; __shared__ float Bs[8 * 128];
    const int row0 = blockIdx.y * 128, col0 = blockIdx.x * 128, tx = threadIdx.x & 15, ty = threadIdx.x >> 4;
    float acc[8][8]; ZERO_ACC(acc);
    accum_tile<bf16_t>(A, K, K, nullptr, W, D, row0, col0, acc, As, Bs);
#pragma unroll
    for (int i = 0; i < 8; ++i) { const int row = row0 + ty * 8 + i;
#pragma unroll
        for (int j = 0; j < 8; ++j) { const size_t o = (size_t)row * D + col0 + tx * 8 + j; xout[o] = xin[o] + coef * acc[i][j]; } }
}
struct QkvOut { bf16_t *qa, *ka, *va, *qb, *kb, *vb; const float *qna, *kna, *qnb, *knb; };
__global__ void __launch_bounds__(256) naive_qkv(const bf16_t* xb, const float* ssp, const float* gain, const float* Wqkv, QkvOut o) {
    __shared__ float As[8 * 132]; __shared__ float Bs[8 * 128];
    const int row0 = blockIdx.y * 128, col0 = blockIdx.x * 128, tx = threadIdx.x & 15, ty = threadIdx.x >> 4;
    float acc[8][8]; ZERO_ACC(acc);
    accum_tile<bf16_t>(xb, D, D, gain, Wqkv, QKVW, row0, col0, acc, As, Bs);
    const int c = col0 + tx * 8;
    bf16_t* dst; const float* ng; int nh, hc; float sc = 1.0f;
    if (c < 512) { dst = o.qa; ng = o.qna; nh = 8; hc = c; sc = QSCALE; }
    else if (c < 1024) { dst = o.ka; ng = o.kna; nh = 8; hc = c - 512; }
    else if (c < 1536) { dst = o.va; ng = nullptr; nh = 8; hc = c - 1024; }
    else if (c < 2048) { dst = o.qb; ng = o.qnb; nh = 8; hc = c - 1536; sc = QSCALE; }
    else if (c < 2176) { dst = o.kb; ng = o.knb; nh = 2; hc = c - 2048; }
    else { dst = o.vb; ng = nullptr; nh = 2; hc = c - 2176; }
    const int h = hc >> 6, e0 = hc & 63;
#pragma unroll
    for (int i = 0; i < 8; ++i) { const int row = row0 + ty * 8 + i; const float rs = row_rstd(ssp, row);
        float v[8]; float ss = 0.f;
#pragma unroll
        for (int j = 0; j < 8; ++j) { v[j] = acc[i][j] * rs; ss += v[j] * v[j]; }
        ss += __shfl_xor(ss, 1); ss += __shfl_xor(ss, 2); ss += __shfl_xor(ss, 4);
        const float hr = rsqrtf(ss * (1.0f / HD) + EPS);
        const int b = row / S, s = row % S;
        bf16_t* p = dst + (((size_t)b * nh + h) * S + s) * HD + e0;
#pragma unroll
        for (int j = 0; j < 8; ++j) p[j] = f2bf(ng ? v[j] * hr * ng[e0 + j] * sc : v[j]); }
}
__global__ void __launch_bounds__(256) naive_ple(const bf16_t* xb, const float* ssp, const float* gain, const float* Wg, const float* p, const float* Wp, const float* xin, float* xout) {
    __shared__ float As[8 * 132]; __shared__ float Bs[8 * 128];
    const int row0 = blockIdx.y * 128, col0 = blockIdx.x * 128, tx = threadIdx.x & 15, ty = threadIdx.x >> 4;
    float ag[8][8], ap[8][8]; ZERO_ACC(ag); ZERO_ACC(ap);
    accum_tile<bf16_t>(xb, D, D, gain, Wg, D, row0, col0, ag, As, Bs);
    accum_tile<float>(p, PLE, PLE, nullptr, Wp, D, row0, col0, ap, As, Bs);
#pragma unroll
    for (int i = 0; i < 8; ++i) { const int row = row0 + ty * 8 + i; const float rs = row_rstd(ssp, row);
#pragma unroll
        for (int j = 0; j < 8; ++j) { const size_t o = (size_t)row * D + col0 + tx * 8 + j; const float g = 1.0f / (1.0f + __expf(-ag[i][j] * rs));
            xout[o] = xin[o] + g * ap[i][j]; } }
}

__device__ __forceinline__ int t5_bucket(int rel) {
    const int n = rel < 0 ? -rel : rel; const int ret = rel > 0 ? 16 : 0;
    if (n < 8) return ret + n;
    int large = 8 + (int)(logf((float)n / 8.0f) / 4.852030263919617f * 8.0f);
    large = large < 15 ? large : 15;
    return ret + large;
}
struct AttnIn { const bf16_t *qa, *ka, *va, *qb, *kb, *vb; const float* rel_bias; const float* sink; bf16_t* o; };
__global__ void __launch_bounds__(256) naive_attn(AttnIn a) {
    __shared__ float pl[4][400]; __shared__ int kl[4][400];
    const int wave = threadIdx.x >> 6, lane = threadIdx.x & 63;
    const int t = blockIdx.x * 4 + wave, head = blockIdx.y, b = blockIdx.z;
    const bool isA = head < 8;
    const bf16_t *q, *k, *v;
    if (isA) { q = a.qa + (((size_t)b * 8 + head) * S + t) * HD; k = a.ka + ((size_t)b * 8 + head) * S * HD; v = a.va + ((size_t)b * 8 + head) * S * HD; }
    else { const int hq = head - 8, hk = hq >> 2; q = a.qb + (((size_t)b * 8 + hq) * S + t) * HD; k = a.kb + ((size_t)b * 2 + hk) * S * HD; v = a.vb + ((size_t)b * 2 + hk) * S * HD; }
    float qf[HD];
#pragma unroll
    for (int e = 0; e < HD; ++e) qf[e] = bf2f(q[e]);
    const int nk = isA ? 387 : 257;
    float mx = -1e30f;
    for (int i = lane; i < nk; i += 64) {
        int rel;
        if (isA) { const int br = i / 129, j = i % 129 - 64; rel = j * (br == 0 ? 1 : br == 1 ? 4 : 16); }
        else rel = i - 128;
        const int tk = t + rel;
        float lg = -1e30f;
        if (tk >= 0 && tk < S) {
            float d = 0.f; const bf16_t* kr = k + (size_t)tk * HD;
#pragma unroll
            for (int e = 0; e < HD; ++e) d += qf[e] * bf2f(kr[e]);
            lg = d + a.rel_bias[t5_bucket(rel) * 16 + head] * LOG2E;
        }
        pl[wave][i] = lg; kl[wave][i] = tk;
        mx = fmaxf(mx, lg);
    }
#pragma unroll
    for (int o = 1; o < 64; o <<= 1) mx = fmaxf(mx, __shfl_xor(mx, o));
    float sinkl = 0.f;
    if (!isA) { sinkl = a.sink[head - 8] * LOG2E; mx = fmaxf(mx, sinkl); }
    float sum = 0.f;
    for (int i = lane; i < nk; i += 64) { const float lg = pl[wave][i]; const float pv = lg > -1e29f ? exp2f(lg - mx) : 0.f; pl[wave][i] = pv; sum += pv; }
#pragma unroll
    for (int o = 1; o < 64; o <<= 1) sum += __shfl_xor(sum, o);
    if (!isA) sum += exp2f(sinkl - mx);
    __syncthreads();
    float acc = 0.f;
    for (int i = 0; i < nk; ++i) { const float pv = pl[wave][i]; if (pv != 0.f) acc += pv * bf2f(v[(size_t)kl[wave][i] * HD + lane]); }
    a.o[((size_t)b * S + t) * D + head * HD + lane] = f2bf(acc / sum);
}

namespace pg8 {
#define PG8_LAS __attribute__((address_space(3)))
typedef unsigned short bf16_t;
typedef short bf16x8 __attribute__((ext_vector_type(8)));
typedef float f32x4 __attribute__((ext_vector_type(4)));
typedef unsigned u32x4 __attribute__((ext_vector_type(4)));
constexpr int BM = 256, BK = 64, HALF = 128, HTB = HALF * BK * 2  , STAGE_BYTES = 8 * HTB, NXCD = 8, WGM = 8;

__host__ __device__ __forceinline__ int lds_byte(int r, int c) { const int st = (r >> 4) * 2 + (c >> 5), rr = r & 15, cc = c & 31, ob = rr * 64 + cc * 2; return st * 1024 + (ob ^ (((ob >> 9) & 1) << 5)); }
__host__ __device__ __forceinline__ void stage_rc(int b, int& R, int& C) { const int st = b / 1024, sb = b % 1024, swz = sb ^ (((sb >> 9) & 1) << 5); R = (st >> 1) * 16 + swz / 64; C = (st & 1) * 32 + (swz % 64) / 2; }
__host__ __device__ __forceinline__ int perm32(int rho) { const int n = rho >> 4, i = rho & 15; return 8 * (i >> 2) + 4 * n + (i & 3); }

struct Unit { int pm, pn; };
struct Gemm { const bf16_t* A; const bf16_t* Bt; int M, N, K; };

struct StaticOrder {
    int nM, nN, nwg, G, c;
    __host__ __device__ void init(int M, int N, int G_, int c_) { nM = M / BM; nN = N / BM; nwg = nM * nN; G = G_; c = c_; }
    __host__ __device__ bool next(int i, Unit& u) const {
        const long L = (long)i * G + c; if (L >= nwg) return false;
        int wgid = (int)L; { const int q = nwg / NXCD, r = nwg % NXCD, xcd = wgid % NXCD, off = wgid / NXCD; wgid = (xcd < r ? xcd * (q + 1) : r * (q + 1) + (xcd - r) * q) + off; }
        const int nig = WGM * nN, gid = wgid / nig, fm = gid * WGM, gsz = (nM - fm) < WGM ? (nM - fm) : WGM;
        u.pm = fm + ((wgid % nig) % gsz); u.pn = (wgid % nig) / gsz; return true;
    }
    __device__ __forceinline__ void a_ready(const Unit&) const {}
    __device__ __forceinline__ void done(const Unit&) const {}
};

__device__ __forceinline__ unsigned cvt_pk_bf16(float lo, float hi) { unsigned r; asm volatile("v_cvt_pk_bf16_f32 %0, %1, %2" : "=v"(r) : "v"(lo), "v"(hi)); return r; }
typedef float f32x2 __attribute__((ext_vector_type(2)));
template <class Epi, class Sched, bool ALIGN_EPI = false, bool SP2 = false>
__device__ __forceinline__ void gemm_phase(PG8_LAS unsigned char* lds, const Gemm g, const Sched& S, const Epi& E, const int tid) {
    const int wid = __builtin_amdgcn_readfirstlane(tid >> 6), lane = tid & 63, wr = wid >> 2, wc = wid & 3, fr = lane & 15, fq = lane >> 4;
    const int K = g.K, nt = K / BK;
    unsigned voffA[2], voffB[2];
#pragma unroll
    for (int i = 0; i < 2; ++i) { int R, C; stage_rc(tid * 16 + i * 8192, R, C); const int Rb = Epi::PERM ? ((R & ~31) + perm32(R & 31)) : R;
        voffA[i] = (unsigned)(R * K + C) * 2u; voffB[i] = (unsigned)(Rb * K + C) * 2u; }
    const size_t kstep = (size_t)(BK * 2);
    const size_t hstep = (size_t)HALF * K * 2;
    const size_t tstep = 2 * hstep;
    const unsigned ldsw = (unsigned)wid * 1024u;
    const int aoff = lds_byte(wr * 64 + fr, fq * 8), boff = lds_byte(wc * 32 + fr, fq * 8);
#define PG8_SA(b, h) (((b) * 2 + (h)) * HTB)
#define PG8_SB(b, h) ((4 + (b) * 2 + (h)) * HTB)
#define PG8_STAGE(bufoff, gbase, voff) do { _Pragma("unroll") for (int _i = 0; _i < 2; ++_i) \
        __builtin_amdgcn_global_load_lds((const unsigned*)((const char*)(gbase) + (voff)[_i]), (PG8_LAS unsigned*)(lds + (bufoff) + ldsw + _i * 8192), 16, 0, 0); } while (0)
#define PG8_LDA(dst, b, h) do { _Pragma("unroll") for (int m = 0; m < 4; ++m) _Pragma("unroll") for (int k = 0; k < 2; ++k) dst[m][k] = *(const PG8_LAS bf16x8*)(lds + PG8_SA(b, h) + aoff + m * 2048 + k * 1024); } while (0)
#define PG8_LDB(dst, b, h) do { _Pragma("unroll") for (int n = 0; n < 2; ++n) _Pragma("unroll") for (int k = 0; k < 2; ++k) dst[n][k] = *(const PG8_LAS bf16x8*)(lds + PG8_SB(b, h) + boff + n * 2048 + k * 1024); } while (0)
#define PG8_MMA(ai, bj, At, Bt) do { __builtin_amdgcn_s_setprio(1); _Pragma("unroll") for (int m = 0; m < 4; ++m) _Pragma("unroll") for (int n = 0; n < 2; ++n) _Pragma("unroll") for (int k = 0; k < 2; ++k) \
        acc[ai][bj][m][n] = __builtin_amdgcn_mfma_f32_16x16x32_bf16(Bt[n][k], At[m][k], acc[ai][bj][m][n], 0, 0, 0); __builtin_amdgcn_s_setprio(0); } while (0)
#define PG8_WAIT_V(n) asm volatile("s_waitcnt vmcnt(" #n ")" ::: "memory")
#define PG8_WAIT_L(n) asm volatile("s_waitcnt lgkmcnt(" #n ")" ::: "memory")
#define PG8_BAR __builtin_amdgcn_s_barrier()
#define PG8_SCHED __builtin_amdgcn_sched_barrier(0)
    Unit cur, nxt; int ui = 0;
    if (!S.next(0, cur)) return;
    f32x4 acc[2][2][4][2];
#pragma unroll
    for (int a = 0; a < 2; ++a)
#pragma unroll
        for (int b = 0; b < 2; ++b)
#pragma unroll
            for (int m = 0; m < 4; ++m)
#pragma unroll
                for (int n = 0; n < 2; ++n) acc[a][b][m][n] = (f32x4){0.f, 0.f, 0.f, 0.f};
    bf16x8 At[4][2], B0[2][2], B1[2][2];
    const char* cA = (const char*)g.A + (size_t)cur.pm * tstep; const char* cB = (const char*)g.Bt + (size_t)cur.pn * tstep;
    S.a_ready(cur);
    if constexpr (SP2) {
        PG8_STAGE(PG8_SB(0, 0), cB, voffB); PG8_STAGE(PG8_SB(0, 1), cB + hstep, voffB); PG8_STAGE(PG8_SA(0, 0), cA, voffA); PG8_STAGE(PG8_SA(0, 1), cA + hstep, voffA);
        if (wr == 1) PG8_BAR;
        PG8_WAIT_V(2); PG8_BAR;
        PG8_STAGE(PG8_SB(1, 0), cB + kstep, voffB); PG8_STAGE(PG8_SA(1, 0), cA + kstep, voffA); PG8_STAGE(PG8_SB(1, 1), cB + hstep + kstep, voffB);
        PG8_WAIT_V(6); PG8_BAR;
    } else {
        PG8_STAGE(PG8_SB(0, 0), cB, voffB); PG8_STAGE(PG8_SA(0, 0), cA, voffA); PG8_STAGE(PG8_SB(0, 1), cB + hstep, voffB); PG8_STAGE(PG8_SA(0, 1), cA + hstep, voffA);
        if (wr == 1) PG8_BAR;
        PG8_WAIT_V(4); PG8_BAR;
        PG8_STAGE(PG8_SB(1, 0), cB + kstep, voffB); PG8_STAGE(PG8_SA(1, 0), cA + kstep, voffA); PG8_STAGE(PG8_SB(1, 1), cB + hstep + kstep, voffB);
        PG8_WAIT_V(6); PG8_BAR;
    }
    for (;;) {
        const bool has_next = S.next(ui + 1, nxt);
        const char* nA = has_next ? (const char*)g.A + (size_t)nxt.pm * tstep : cA; const char* nB = has_next ? (const char*)g.Bt + (size_t)nxt.pn * tstep : cB;
        for (int t = 0; t < nt; t += 2) {
            const bool last = (t == nt - 2);
            const char* a1 = cA + (size_t)(t + 1) * kstep;
            const char* a2 = last ? nA : cA + (size_t)(t + 2) * kstep; const char* b2 = last ? nB : cB + (size_t)(t + 2) * kstep;
            const char* a3 = a2 + kstep; const char* b3 = b2 + kstep;
            if (last && has_next) S.a_ready(nxt);
            if constexpr (SP2) {
            PG8_LDB(B0, 0, 0); PG8_LDB(B1, 0, 1); PG8_SCHED; PG8_LDA(At, 0, 0); PG8_STAGE(PG8_SA(1, 1), a1 + hstep, voffA);
            PG8_WAIT_V(8); PG8_WAIT_L(0); PG8_BAR; PG8_MMA(0, 0, At, B0); PG8_MMA(0, 1, At, B1); PG8_BAR; PG8_SCHED;
            PG8_LDA(At, 0, 1); PG8_STAGE(PG8_SB(0, 0), b2, voffB); PG8_STAGE(PG8_SB(0, 1), b2 + hstep, voffB); PG8_STAGE(PG8_SA(0, 0), a2, voffA);
            PG8_WAIT_V(8); PG8_WAIT_L(0); PG8_BAR; PG8_MMA(1, 0, At, B0); PG8_MMA(1, 1, At, B1); PG8_BAR; PG8_SCHED;
            PG8_LDB(B0, 1, 0); PG8_LDB(B1, 1, 1); PG8_SCHED; PG8_LDA(At, 1, 0); PG8_STAGE(PG8_SA(0, 1), a2 + hstep, voffA);
            PG8_WAIT_V(8); PG8_WAIT_L(0); PG8_BAR; PG8_MMA(0, 0, At, B0); PG8_MMA(0, 1, At, B1); PG8_BAR; PG8_SCHED;
            PG8_LDA(At, 1, 1); PG8_STAGE(PG8_SB(1, 0), b3, voffB); PG8_STAGE(PG8_SB(1, 1), b3 + hstep, voffB); PG8_STAGE(PG8_SA(1, 0), a3, voffA);
            PG8_WAIT_V(8); PG8_WAIT_L(0); PG8_BAR; PG8_MMA(1, 0, At, B0); PG8_MMA(1, 1, At, B1); PG8_BAR; PG8_SCHED;
            } else {
            PG8_LDB(B0, 0, 0); PG8_SCHED; PG8_LDA(At, 0, 0); PG8_STAGE(PG8_SA(1, 1), a1 + hstep, voffA);
            PG8_WAIT_L(8); PG8_BAR; PG8_WAIT_L(0); PG8_MMA(0, 0, At, B0); PG8_BAR; PG8_SCHED;
            PG8_LDB(B1, 0, 1); PG8_STAGE(PG8_SB(0, 0), b2, voffB);
            PG8_BAR; PG8_WAIT_L(0); PG8_MMA(0, 1, At, B1); PG8_BAR;
            PG8_LDA(At, 0, 1); PG8_STAGE(PG8_SA(0, 0), a2, voffA);
            PG8_BAR; PG8_WAIT_L(0); PG8_MMA(1, 0, At, B0); PG8_BAR; PG8_SCHED;
            PG8_STAGE(PG8_SB(0, 1), b2 + hstep, voffB);
            PG8_WAIT_V(6); PG8_BAR; PG8_MMA(1, 1, At, B1); PG8_BAR;
            PG8_LDB(B0, 1, 0); PG8_SCHED; PG8_LDA(At, 1, 0); PG8_STAGE(PG8_SA(0, 1), a2 + hstep, voffA);
            PG8_WAIT_L(8); PG8_BAR; PG8_WAIT_L(0); PG8_MMA(0, 0, At, B0); PG8_BAR; PG8_SCHED;
            PG8_LDB(B1, 1, 1); PG8_STAGE(PG8_SB(1, 0), b3, voffB);
            PG8_BAR; PG8_WAIT_L(0); PG8_MMA(0, 1, At, B1); PG8_BAR;
            PG8_LDA(At, 1, 1); PG8_STAGE(PG8_SA(1, 0), a3, voffA);
            PG8_BAR; PG8_WAIT_L(0); PG8_MMA(1, 0, At, B0); PG8_BAR; PG8_SCHED;
            PG8_STAGE(PG8_SB(1, 1), b3 + hstep, voffB);
            PG8_WAIT_V(6); PG8_BAR; PG8_MMA(1, 1, At, B1); PG8_BAR;
            }
        }
        if constexpr (ALIGN_EPI) { if (wr == 0) PG8_BAR; }
        if constexpr (!Epi::AFTER_DRAIN) { int l2_; asm volatile("v_mbcnt_lo_u32_b32 %0, -1, 0\n\tv_mbcnt_hi_u32_b32 %0, -1, %0" : "=v"(l2_)); E(acc, cur, wr, wc, l2_ & 15, l2_ >> 4); S.done(cur); }
        if (!has_next) break;
#pragma unroll
        for (int a = 0; a < 2; ++a)
#pragma unroll
            for (int b = 0; b < 2; ++b)
#pragma unroll
                for (int m = 0; m < 4; ++m)
#pragma unroll
                    for (int n = 0; n < 2; ++n) acc[a][b][m][n] = (f32x4){0.f, 0.f, 0.f, 0.f};
        cur = nxt; cA = nA; cB = nB; ++ui;
        if constexpr (ALIGN_EPI) { if (wr == 1) PG8_BAR; }
    }
    PG8_WAIT_V(0);
    if constexpr (!ALIGN_EPI) { if (wr == 0) PG8_BAR; }
    PG8_BAR;
    if constexpr (Epi::AFTER_DRAIN) { E.fused(acc, cur, wr, wc, fr, fq, lds, wid, lane); S.done(cur); }
#undef PG8_SA
#undef PG8_SB
#undef PG8_STAGE
#undef PG8_LDA
#undef PG8_LDB
#undef PG8_MMA
#undef PG8_WAIT_V
#undef PG8_WAIT_L
#undef PG8_BAR
#undef PG8_SCHED
}
}

namespace pg8 {
typedef float f32x2 __attribute__((ext_vector_type(2)));
__device__ __forceinline__ float shx(float v, int lane, int mask) { return __int_as_float(__builtin_amdgcn_ds_bpermute((lane ^ mask) << 2, __float_as_int(v))); }
__device__ __forceinline__ float rstd16(const float* ssp, int row, int fq, int lane) {
    const f32x4 v = *(const f32x4*)(ssp + (size_t)row * 16 + 4 * fq);
    float s = (v[0] + v[1]) + (v[2] + v[3]);
    s += shx(s, lane, 16); s += shx(s, lane, 32);
    return rsqrtf(s * (1.0f / 1024.0f) + 1e-6f);
}
__device__ __forceinline__ float sigm(float v) { return __builtin_amdgcn_rcpf(1.0f + __builtin_amdgcn_exp2f(-1.4426950408889634f * v)); }
__device__ __forceinline__ u32x4 pack8(const f32x4& a, const f32x4& b) { u32x4 w; w.x = cvt_pk_bf16(a[0], a[1]); w.y = cvt_pk_bf16(a[2], a[3]); w.z = cvt_pk_bf16(b[0], b[1]); w.w = cvt_pk_bf16(b[2], b[3]); return w; }
__device__ __forceinline__ float bflo(unsigned w) { return __uint_as_float(w << 16); }
__device__ __forceinline__ float bfhi(unsigned w) { return __uint_as_float(w & 0xffff0000u); }

struct EpiSwiglu {
    static constexpr bool PERM = true, AFTER_DRAIN = false;
    bf16_t* act; const float* ssp;
    __device__ __forceinline__ void operator()(const f32x4 (&acc)[2][2][4][2], const Unit& u, int wr, int wc, int fr, int fq) const {
        const int lane = fr + 16 * fq;
        const int row0 = u.pm * BM + wr * 64 + fr, col0 = u.pn * 128 + wc * 32 + 8 * fq;
#pragma unroll
        for (int ai = 0; ai < 2; ++ai)
#pragma unroll
            for (int m = 0; m < 4; ++m) { const int row = row0 + ai * HALF + m * 16; const float rs = rstd16(ssp, row, fq, lane);
                f32x4 o[2];
#pragma unroll
                for (int n = 0; n < 2; ++n)
#pragma unroll
                    for (int j = 0; j < 4; ++j) { const float g = acc[ai][0][m][n][j] * rs, up = acc[ai][1][m][n][j] * rs; o[n][j] = g * sigm(g) * up; }
                *(u32x4*)(act + (size_t)row * 2816 + col0) = pack8(o[0], o[1]); }
    }
};
struct EpiResid {
    static constexpr bool PERM = true, AFTER_DRAIN = false;
    const float* xin; float* xout; bf16_t* xb; float* sspw; float coef;
    __device__ __forceinline__ void operator()(const f32x4 (&acc)[2][2][4][2], const Unit& u, int wr, int wc, int fr, int fq) const {
        const int lane = fr + 16 * fq;
        const int row0 = u.pm * BM + wr * 64 + fr, col0 = u.pn * BM + wc * 32 + 8 * fq;
#pragma unroll
        for (int ai = 0; ai < 2; ++ai)
#pragma unroll
            for (int m = 0; m < 4; ++m) { const int row = row0 + ai * HALF + m * 16; float ss = 0.f;
#pragma unroll
                for (int bj = 0; bj < 2; ++bj) { const size_t off = (size_t)row * 1024 + col0 + bj * HALF;
                    f32x4 x0 = *(const f32x4*)(xin + off), x1 = *(const f32x4*)(xin + off + 4);
                    x0 = x0 + acc[ai][bj][m][0] * coef; x1 = x1 + acc[ai][bj][m][1] * coef;
                    *(f32x4*)(xout + off) = x0; *(f32x4*)(xout + off + 4) = x1;
                    *(u32x4*)(xb + off) = pack8(x0, x1);
                    ss += (x0[0] * x0[0] + x0[1] * x0[1]) + (x0[2] * x0[2] + x0[3] * x0[3]) + (x1[0] * x1[0] + x1[1] * x1[1]) + (x1[2] * x1[2] + x1[3] * x1[3]); }
                ss += shx(ss, lane, 16); ss += shx(ss, lane, 32);
                if (fq == 0) sspw[(size_t)row * 16 + u.pn * 4 + wc] = ss; }
    }
};
struct EpiGate {
    static constexpr bool PERM = true, AFTER_DRAIN = false;
    const float* xin; float* xout; bf16_t* xb; float* sspw; const float* sspr; const bf16_t* proj;
    __device__ __forceinline__ void operator()(const f32x4 (&acc)[2][2][4][2], const Unit& u, int wr, int wc, int fr, int fq) const {
        const int lane = fr + 16 * fq;
        const int row0 = u.pm * BM + wr * 64 + fr, col0 = u.pn * BM + wc * 32 + 8 * fq;
#pragma unroll
        for (int ai = 0; ai < 2; ++ai)
#pragma unroll
            for (int m = 0; m < 4; ++m) { const int row = row0 + ai * HALF + m * 16; const float rs = rstd16(sspr, row, fq, lane); float ss = 0.f;
#pragma unroll
                for (int bj = 0; bj < 2; ++bj) { const size_t off = (size_t)row * 1024 + col0 + bj * HALF;
                    f32x4 x0 = *(const f32x4*)(xin + off), x1 = *(const f32x4*)(xin + off + 4);
                    const u32x4 pw = *(const u32x4*)(proj + off);
                    const f32x4 p0 = {bflo(pw.x), bfhi(pw.x), bflo(pw.y), bfhi(pw.y)}, p1 = {bflo(pw.z), bfhi(pw.z), bflo(pw.w), bfhi(pw.w)};
#pragma unroll
                    for (int j = 0; j < 4; ++j) { x0[j] += sigm(acc[ai][bj][m][0][j] * rs) * p0[j]; x1[j] += sigm(acc[ai][bj][m][1][j] * rs) * p1[j]; }
                    *(f32x4*)(xout + off) = x0; *(f32x4*)(xout + off + 4) = x1;
                    *(u32x4*)(xb + off) = pack8(x0, x1);
                    ss += (x0[0] * x0[0] + x0[1] * x0[1]) + (x0[2] * x0[2] + x0[3] * x0[3]) + (x1[0] * x1[0] + x1[1] * x1[1]) + (x1[2] * x1[2] + x1[3] * x1[3]); }
                ss += shx(ss, lane, 16); ss += shx(ss, lane, 32);
                if (fq == 0) sspw[(size_t)row * 16 + u.pn * 4 + wc] = ss; }
    }
};
struct EpiStoreBf16 {
    static constexpr bool PERM = true, AFTER_DRAIN = false;
    bf16_t* O; int ldc;
    __device__ __forceinline__ void operator()(const f32x4 (&acc)[2][2][4][2], const Unit& u, int wr, int wc, int fr, int fq) const {
        const int lane = fr + 16 * fq;
        const int row0 = u.pm * BM + wr * 64 + fr, col0 = u.pn * BM + wc * 32 + 8 * fq;
#pragma unroll
        for (int ai = 0; ai < 2; ++ai)
#pragma unroll
            for (int m = 0; m < 4; ++m) { const int row = row0 + ai * HALF + m * 16;
#pragma unroll
                for (int bj = 0; bj < 2; ++bj) *(u32x4*)(O + (size_t)row * ldc + col0 + bj * HALF) = pack8(acc[ai][bj][m][0], acc[ai][bj][m][1]); }
    }
};
struct EpiQkv {
    static constexpr bool PERM = true, AFTER_DRAIN = false;
    const float* ssp; bf16_t *qa, *ka, *va, *qb, *kb, *vb; const float *qna, *kna, *qnb, *knb;
    __device__ __forceinline__ void operator()(const f32x4 (&acc)[2][2][4][2], const Unit& u, int wr, int wc, int fr, int fq) const {
        const int lane = fr + 16 * fq;
        const int t = u.pn; bf16_t* dst; const float* ng; int nh, h; float sc = 1.0f;
        if (t < 2) { dst = qa; ng = qna; nh = 8; h = 4 * t + wc; sc = QSCALE; }
        else if (t < 4) { dst = ka; ng = kna; nh = 8; h = 4 * (t - 2) + wc; }
        else if (t < 6) { dst = va; ng = nullptr; nh = 8; h = 4 * (t - 4) + wc; }
        else if (t < 8) { dst = qb; ng = qnb; nh = 8; h = 4 * (t - 6) + wc; sc = QSCALE; }
        else if (wc < 2) { dst = kb; ng = knb; nh = 2; h = wc; }
        else { dst = vb; ng = nullptr; nh = 2; h = wc - 2; }
        f32x4 gv[2][2];
#pragma unroll
        for (int bj = 0; bj < 2; ++bj)
#pragma unroll
            for (int n = 0; n < 2; ++n) { if (ng) gv[bj][n] = *(const f32x4*)(ng + 32 * bj + 8 * fq + 4 * n) * sc; else gv[bj][n] = (f32x4){1.f, 1.f, 1.f, 1.f}; }
        const int row0 = u.pm * BM + wr * 64 + fr;
#pragma unroll
        for (int ai = 0; ai < 2; ++ai)
#pragma unroll
            for (int m = 0; m < 4; ++m) { const int row = row0 + ai * HALF + m * 16; const float rs = rstd16(ssp, row, fq, lane);
                f32x4 v[2][2]; float ss = 0.f;
#pragma unroll
                for (int bj = 0; bj < 2; ++bj)
#pragma unroll
                    for (int n = 0; n < 2; ++n) { v[bj][n] = acc[ai][bj][m][n] * rs; ss += (v[bj][n][0] * v[bj][n][0] + v[bj][n][1] * v[bj][n][1]) + (v[bj][n][2] * v[bj][n][2] + v[bj][n][3] * v[bj][n][3]); }
                ss += shx(ss, lane, 16); ss += shx(ss, lane, 32);
                const float hr = ng ? rsqrtf(ss * (1.0f / 64.0f) + 1e-6f) : 1.0f;
                const int b = row >> 12, s = row & 4095;
                bf16_t* p = dst + (((size_t)b * nh + h) * 4096 + s) * 64 + 8 * fq;
#pragma unroll
                for (int bj = 0; bj < 2; ++bj) *(u32x4*)(p + 32 * bj) = pack8(v[bj][0] * hr * gv[bj][0], v[bj][1] * hr * gv[bj][1]); }
    }
};
}

#include <hip/hip_cooperative_groups.h>
namespace cg = cooperative_groups;
#define LAS __attribute__((address_space(3)))
typedef unsigned v4u __attribute__((ext_vector_type(4)));
constexpr int NWAVES = 8, RING_BYTES = 131072, LDS_BYTES = 147456;
constexpr int NPHASE = 1 + 8 * DEPTH;
constexpr size_t WO_F1IN = 0, WO_F1OUT = WO_F1IN + (size_t)2 * DFF * D, WO_QKV = WO_F1OUT + (size_t)D * DFF, WO_WO = WO_QKV + (size_t)QKVW * D,
                 WO_F2IN = WO_WO + (size_t)D * D, WO_F2OUT = WO_F2IN + (size_t)2 * DFF * D, WO_WG = WO_F2OUT + (size_t)D * DFF, WO_WP = WO_WG + (size_t)D * D, W_LAYER = WO_WP + (size_t)D * PLE;
static_assert(W_LAYER * 2 * DEPTH <= 84 * MiB, "weights fit");

struct Args { const float* in[20]; float* out; unsigned char* ws; int ph_lo, ph_hi; };

__device__ __forceinline__ void transpose_item(const float* W, int K, int N, const float* gain, bf16_t* Bt, int kind, int item, LAS float* scr, int lane) {
    const int kblocks = K / 64, nb = item / kblocks, kb = item % kblocks, k0 = 64 * kb, n0 = 32 * nb;
    int c0;
    if (kind == 0) c0 = n0;
    else if (kind == 1) c0 = ((n0 >> 7) & 1) * DFF + 128 * (n0 >> 8) + (n0 & 127);
    else c0 = 256 * (n0 >> 8) + 64 * ((n0 >> 5) & 3) + 32 * ((n0 >> 7) & 1);
#pragma unroll 8
    for (int i = 0; i < 32; ++i) { const int kk = 2 * i + (lane >> 5); const float g = gain ? gain[k0 + kk] : 1.0f; scr[kk * 33 + (lane & 31)] = W[(size_t)(k0 + kk) * N + c0 + (lane & 31)] * g; }
    asm volatile("s_waitcnt lgkmcnt(0)" ::: "memory");
    const int c = lane & 7;
#pragma unroll
    for (int j = 0; j < 4; ++j) { const int n = (lane >> 3) + 8 * j; const LAS float* s = scr + (8 * c) * 33 + n;
        v4u o; o.x = pg8::cvt_pk_bf16(s[0 * 33], s[1 * 33]); o.y = pg8::cvt_pk_bf16(s[2 * 33], s[3 * 33]); o.z = pg8::cvt_pk_bf16(s[4 * 33], s[5 * 33]); o.w = pg8::cvt_pk_bf16(s[6 * 33], s[7 * 33]);
        *(v4u*)(Bt + (size_t)(n0 + n) * K + k0 + 8 * c) = o; }
    asm volatile("s_waitcnt lgkmcnt(0)" ::: "memory");
}

template <class AT> __device__ __forceinline__ void prologue_phase(const AT& a, LAS unsigned char* lds, int gw, int NGW, int wave, int lane) {
    LAS float* scr = (LAS float*)(lds + wave * 16384);
    bf16_t* wbase = (bf16_t*)(a.ws() + WS_W);
    constexpr int I_FIN = (D / 64) * (2 * DFF / 32), I_FOUT = (DFF / 64) * (D / 32), I_QKV = (D / 64) * (QKVW / 32), I_SQ = (D / 64) * (D / 32), I_WP = (PLE / 64) * (D / 32);
    constexpr int I_LAYER = 2 * I_FIN + 2 * I_FOUT + I_QKV + 2 * I_SQ + I_WP;
    for (int it = gw; it < DEPTH * I_LAYER; it += NGW) {
        const int l = it / I_LAYER; int r = it % I_LAYER; bf16_t* wl = wbase + (size_t)l * W_LAYER;
        if (r < I_FIN) { transpose_item(a.in(4) + (size_t)l * D * 2 * DFF, D, 2 * DFF, a.in(3) + l * D, wl + WO_F1IN, 1, r, scr, lane); continue; } r -= I_FIN;
        if (r < I_FOUT) { transpose_item(a.in(5) + (size_t)l * DFF * D, DFF, D, nullptr, wl + WO_F1OUT, 0, r, scr, lane); continue; } r -= I_FOUT;
        if (r < I_QKV) { transpose_item(a.in(7) + (size_t)l * D * QKVW, D, QKVW, a.in(6) + l * D, wl + WO_QKV, 2, r, scr, lane); continue; } r -= I_QKV;
        if (r < I_SQ) { transpose_item(a.in(13) + (size_t)l * D * D, D, D, nullptr, wl + WO_WO, 0, r, scr, lane); continue; } r -= I_SQ;
        if (r < I_FIN) { transpose_item(a.in(15) + (size_t)l * D * 2 * DFF, D, 2 * DFF, a.in(14) + l * D, wl + WO_F2IN, 1, r, scr, lane); continue; } r -= I_FIN;
        if (r < I_FOUT) { transpose_item(a.in(16) + (size_t)l * DFF * D, DFF, D, nullptr, wl + WO_F2OUT, 0, r, scr, lane); continue; } r -= I_FOUT;
        if (r < I_SQ) { transpose_item(a.in(18) + (size_t)l * D * D, D, D, a.in(17) + l * D, wl + WO_WG, 0, r, scr, lane); continue; } r -= I_SQ;
        transpose_item(a.in(19) + (size_t)l * PLE * D, PLE, D, nullptr, wl + WO_WP, 0, r, scr, lane);
    }
    const float* x = a.in(0); bf16_t* xb = (bf16_t*)(a.ws() + WS_XB); float* ssp = (float*)(a.ws() + WS_SSP);
    for (int row = gw; row < M; row += NGW) {
        const float4* xr = (const float4*)(x + (size_t)row * D); float s = 0.f;
#pragma unroll
        for (int j = 0; j < 4; ++j) { const float4 v = xr[lane + 64 * j]; s += v.x * v.x + v.y * v.y + v.z * v.z + v.w * v.w;
            uint2 o; o.x = pg8::cvt_pk_bf16(v.x, v.y); o.y = pg8::cvt_pk_bf16(v.z, v.w); ((uint2*)(xb + (size_t)row * D))[lane + 64 * j] = o; }
#pragma unroll
        for (int o = 1; o < 64; o <<= 1) s += pg8::shx(s, lane, o);
        if (lane < 4) { float4 r; r.x = lane == 0 ? s : 0.f; r.y = 0.f; r.z = 0.f; r.w = 0.f; ((float4*)ssp)[row * 4 + lane] = r; }
    }
}
__device__ __forceinline__ void convert_p(const float* p, bf16_t* pb, int gtid, int nthreads) {
    for (int i = gtid; i < M * PLE / 8; i += nthreads) { const float4 v0 = ((const float4*)p)[2 * i], v1 = ((const float4*)p)[2 * i + 1];
        v4u o; o.x = pg8::cvt_pk_bf16(v0.x, v0.y); o.y = pg8::cvt_pk_bf16(v0.z, v0.w); o.z = pg8::cvt_pk_bf16(v1.x, v1.y); o.w = pg8::cvt_pk_bf16(v1.z, v1.w); ((v4u*)pb)[i] = o; }
}

__device__ __forceinline__ void attn_simple_phase(LAS unsigned char* lds, const AttnIn& a, int G, int wave, int lane) {
    LAS float* pl = (LAS float*)(lds + wave * 4096); LAS int* kl = (LAS int*)(lds + wave * 4096 + 2048);
    const int total = NB * 16 * S;
    for (int item = blockIdx.x * NWAVES + wave; item < total; item += G * NWAVES) {
        const int t = item & (S - 1), head = (item >> 12) & 15, b = item >> 16;
        const bool isA = head < 8;
        const bf16_t *q, *k, *v;
        if (isA) { q = a.qa + (((size_t)b * 8 + head) * S + t) * HD; k = a.ka + ((size_t)b * 8 + head) * S * HD; v = a.va + ((size_t)b * 8 + head) * S * HD; }
        else { const int hq = head - 8, hk = hq >> 2; q = a.qb + (((size_t)b * 8 + hq) * S + t) * HD; k = a.kb + ((size_t)b * 2 + hk) * S * HD; v = a.vb + ((size_t)b * 2 + hk) * S * HD; }
        float qf[HD];
#pragma unroll
        for (int e = 0; e < HD; ++e) qf[e] = bf2f(q[e]);
        const int nk = isA ? 387 : 257;
        float mx = -1e30f;
        for (int i = lane; i < nk; i += 64) {
            int rel;
            if (isA) { const int br = i / 129, j = i % 129 - 64; rel = j * (br == 0 ? 1 : br == 1 ? 4 : 16); } else rel = i - 128;
            const int tk = t + rel; float lg = -1e30f;
            if (tk >= 0 && tk < S) { float d = 0.f; const bf16_t* kr = k + (size_t)tk * HD;
#pragma unroll
                for (int e = 0; e < HD; ++e) d += qf[e] * bf2f(kr[e]);
                lg = d + a.rel_bias[t5_bucket(rel) * 16 + head] * LOG2E; }
            pl[i] = lg; kl[i] = tk; mx = fmaxf(mx, lg);
        }
#pragma unroll
        for (int o = 1; o < 64; o <<= 1) mx = fmaxf(mx, pg8::shx(mx, lane, o));
        float sinkl = 0.f;
        if (!isA) { sinkl = a.sink[head - 8] * LOG2E; mx = fmaxf(mx, sinkl); }
        float sum = 0.f;
        for (int i = lane; i < nk; i += 64) { const float lg = pl[i]; const float pv = lg > -1e29f ? exp2f(lg - mx) : 0.f; pl[i] = pv; sum += pv; }
#pragma unroll
        for (int o = 1; o < 64; o <<= 1) sum += pg8::shx(sum, lane, o);
        if (!isA) sum += exp2f(sinkl - mx);
        asm volatile("s_waitcnt lgkmcnt(0)" ::: "memory");
        float acc = 0.f;
        for (int i = 0; i < nk; ++i) { const float pv = pl[i]; if (pv != 0.f) acc += pv * bf2f(v[(size_t)kl[i] * HD + lane]); }
        a.o[((size_t)b * S + t) * D + head * HD + lane] = f2bf(acc / sum);
    }
}

namespace att {
typedef short bf16x8 __attribute__((ext_vector_type(8)));
typedef short s16x4 __attribute__((ext_vector_type(4)));
typedef short v4i16_t __attribute__((ext_vector_type(4)));
typedef float f32x16 __attribute__((ext_vector_type(16)));
typedef unsigned u32x4 __attribute__((ext_vector_type(4)));
typedef float f32x2_t __attribute__((ext_vector_type(2))); typedef __bf16 bf16x2_t __attribute__((ext_vector_type(2)));
constexpr float NEG = -1e30f;
constexpr int WAVE_LDS = 8704, LUT_OFF = 8 * WAVE_LDS, LUTA_STRIDE = 200, LUTB_STRIDE = 328, LUTB_OFF = LUT_OFF + 3 * LUTA_STRIDE * 4, TAB_OFF = LUT_OFF + 8192, LSE_OFF = TAB_OFF + 65536, ATT_LDS_END = LSE_OFF + 2048;
static_assert(LUTB_OFF + 4 * LUTB_STRIDE * 4 <= TAB_OFF && ATT_LDS_END <= 147456, "attention LDS map");
__device__ __forceinline__ int crow(int r, int hi) { return (r & 3) + 8 * (r >> 2) + 4 * hi; }
__device__ __forceinline__ unsigned cvtpk(float lo, float hi) { f32x2_t v = {lo, hi}; bf16x2_t b = __builtin_convertvector(v, bf16x2_t); return __builtin_bit_cast(unsigned, b); }
__device__ __forceinline__ s16x4 vtr(const LAS unsigned char* p) { return __builtin_bit_cast(s16x4, __builtin_amdgcn_ds_read_tr16_b64_v4i16((LAS v4i16_t*)p)); }
__device__ __forceinline__ float halfmax(float v) { auto rr = __builtin_amdgcn_permlane32_swap(__float_as_uint(v), __float_as_uint(v), false, false); return fmaxf(__uint_as_float(rr[0]), __uint_as_float(rr[1])); }
__device__ __forceinline__ float halfsum(float v) { auto rr = __builtin_amdgcn_permlane32_swap(__float_as_uint(v), __float_as_uint(v), false, false); return __uint_as_float(rr[0]) + __uint_as_float(rr[1]); }

template <int NT>
__device__ __forceinline__ void qtile(const bf16_t* qrow, const bf16_t* kbase, const bf16_t* vbase, int tk0, int dstep, const LAS float* lut, float m0, float l0,
                                      LAS unsigned char* wl, int lane, f32x16 (&o)[2], float& m_out, float& l_out) {
    const int i = lane & 31, hi = lane >> 5;
    LAS float* wsf = (LAS float*)(wl + 8192);
    constexpr int C = NT / 2;
    bf16x8 qf[4];
#pragma unroll
    for (int ks = 0; ks < 4; ++ks) qf[ks] = *(const bf16x8*)(qrow + 16 * ks + 8 * hi);
    const int vrow = lane >> 3, vch = lane & 7;
    const int wr_off = vrow * 128 + ((vch ^ (((lane >> 4) & 1) << 2)) * 16);
    const int rd_base = (4 * hi + ((lane & 15) >> 2)) * 128 + 32 * ((lane >> 4) & 1) + 8 * (lane & 3);
    const int bit3 = (lane >> 3) & 1;
    const int vb0 = rd_base + 64 * bit3, vb1 = rd_base + 64 * (1 - bit3);
    bf16x8 kf[4]; u32x4 vr[4];
#define ATT_LOAD(j) do { \
        { int tk = tk0 + (32 * (j) + i) * dstep; tk = tk < 0 ? 0 : (tk > S - 1 ? S - 1 : tk); const bf16_t* kp = kbase + (size_t)tk * HD + 8 * hi; \
          _Pragma("unroll") for (int ks = 0; ks < 4; ++ks) kf[ks] = *(const bf16x8*)(kp + 16 * ks); } \
        _Pragma("unroll") for (int i4 = 0; i4 < 4; ++i4) { int tk = tk0 + (32 * (j) + vrow + 8 * i4) * dstep; tk = tk < 0 ? 0 : (tk > S - 1 ? S - 1 : tk); \
          vr[i4] = *(const u32x4*)(vbase + (size_t)tk * HD + 8 * vch); } } while (0)
    float m = m0, l = hi == 0 ? l0 : 0.f;
    o[0] = f32x16{}; o[1] = f32x16{};
    ATT_LOAD(C);
#pragma unroll 1
    for (int s = 0; s < NT; ++s) {
        const int j = (s == 0) ? C : (s <= C ? s - 1 : s);
        LAS unsigned char* vbuf = wl + (s & 1) * 4096;
#pragma unroll
        for (int i4 = 0; i4 < 4; ++i4) *(LAS u32x4*)(vbuf + wr_off + i4 * 1024) = vr[i4];
        f32x16 p = __builtin_amdgcn_mfma_f32_32x32x16_bf16(kf[0], qf[0], f32x16{}, 0, 0, 0);
        p = __builtin_amdgcn_mfma_f32_32x32x16_bf16(kf[1], qf[1], p, 0, 0, 0);
        p = __builtin_amdgcn_mfma_f32_32x32x16_bf16(kf[2], qf[2], p, 0, 0, 0);
        p = __builtin_amdgcn_mfma_f32_32x32x16_bf16(kf[3], qf[3], p, 0, 0, 0);
        if (s + 1 < NT) { const int jn = (s + 1 <= C) ? s : s + 1; ATT_LOAD(jn); }
        const int first = tk0 + 32 * j * dstep, lastk = first + 31 * dstep;
        const bool inside = first >= 0 && lastk < S;
        const LAS float* lp = lut + 32 * j - i + 4 * hi;
#pragma unroll
        for (int r = 0; r < 16; ++r) { const int kk0 = (r & 3) + 8 * (r >> 2); p[r] += lp[kk0]; }
        if (j == 0) {
#pragma unroll
            for (int r = 0; r < 16; ++r) { if (crow(r, hi) < i) p[r] = NEG; }
        }
        if (j == NT - 1) {
#pragma unroll
            for (int r = 0; r < 16; ++r) { if (crow(r, hi) > i) p[r] = NEG; }
        }
        if (!inside) {
#pragma unroll
            for (int r = 0; r < 16; ++r) { const int tk = first + crow(r, hi) * dstep; if ((unsigned)tk >= (unsigned)S) p[r] = NEG; }
        }
        float rm = p[0];
#pragma unroll
        for (int r = 1; r < 16; ++r) rm = fmaxf(rm, p[r]);
        rm = halfmax(rm);
        if (__any(rm > m)) {
            const float mn = fmaxf(m, rm), alpha = __builtin_amdgcn_exp2f(m - mn);
            l *= alpha; m = mn;
            if (hi == 0) wsf[i] = alpha;
#pragma unroll
            for (int r = 0; r < 16; ++r) { const float a = wsf[crow(r, hi)]; o[0][r] *= a; o[1][r] *= a; }
        }
        float rs = 0.f;
#pragma unroll
        for (int r = 0; r < 16; ++r) { p[r] = __builtin_amdgcn_exp2f(p[r] - m); rs += p[r]; }
        l += rs;
        u32x4 pw0 = {cvtpk(p[0], p[1]), cvtpk(p[2], p[3]), cvtpk(p[4], p[5]), cvtpk(p[6], p[7])};
        u32x4 pw1 = {cvtpk(p[8], p[9]), cvtpk(p[10], p[11]), cvtpk(p[12], p[13]), cvtpk(p[14], p[15])};
        const bf16x8 pa0 = __builtin_bit_cast(bf16x8, pw0), pa1 = __builtin_bit_cast(bf16x8, pw1);
#pragma unroll
        for (int d0 = 0; d0 < 2; ++d0) {
            const LAS unsigned char* vp = vbuf + (d0 == 0 ? vb0 : vb1);
            const s16x4 a0 = vtr(vp), a1 = vtr(vp + 1024), b0 = vtr(vp + 2048), b1 = vtr(vp + 3072);
            const bf16x8 f0 = {a0[0], a0[1], a0[2], a0[3], a1[0], a1[1], a1[2], a1[3]}, f1 = {b0[0], b0[1], b0[2], b0[3], b1[0], b1[1], b1[2], b1[3]};
            o[d0] = __builtin_amdgcn_mfma_f32_32x32x16_bf16(pa0, f0, o[d0], 0, 0, 0);
            o[d0] = __builtin_amdgcn_mfma_f32_32x32x16_bf16(pa1, f1, o[d0], 0, 0, 0);
        }
    }
#undef ATT_LOAD
    m_out = m; l_out = halfsum(l);
}

__device__ __forceinline__ void stage_o(const f32x16 (&o)[2], float m, float l, LAS unsigned char* wl, int lane) {
    const int i = lane & 31, hi = lane >> 5;
    LAS float* wsf = (LAS float*)(wl + 8192);
    if (hi == 0) { wsf[i] = __builtin_amdgcn_rcpf(l); wsf[32 + i] = m + __builtin_amdgcn_logf(l); }
    LAS bf16_t* stg = (LAS bf16_t*)wl;
#pragma unroll
    for (int r = 0; r < 16; ++r) { const int q = crow(r, hi); const float inv = wsf[q];
        stg[q * 64 + i] = (bf16_t)(cvtpk(o[0][r] * inv, 0.f) & 0xffffu); stg[q * 64 + 32 + i] = (bf16_t)(cvtpk(o[1][r] * inv, 0.f) & 0xffffu); }
}
__device__ __forceinline__ float bflo(unsigned w) { return __uint_as_float(w << 16); }
__device__ __forceinline__ float bfhi(unsigned w) { return __uint_as_float(w & 0xffff0000u); }
__device__ __forceinline__ unsigned mix2(unsigned a, unsigned b, float wa, float wb) { return cvtpk(wa * bflo(a) + wb * bflo(b), wa * bfhi(a) + wb * bfhi(b)); }

struct Tensors { const bf16_t *qa, *ka, *va, *qb, *kb, *vb; const float* rel_bias; const float* sink; bf16_t* o; };

__device__ __forceinline__ int bucket(int rel) {
    const int n = rel < 0 ? -rel : rel; const int ret = rel > 0 ? 16 : 0;
    if (n < 8) return ret + n;
    int large = 8 + (int)(logf((float)n / 8.0f) / 4.852030263919617f * 8.0f);
    large = large < 15 ? large : 15;
    return ret + large;
}

__device__ __forceinline__ void attn_unit(const Tensors& T, int u, LAS unsigned char* lds, int wave, int lane) {
    LAS unsigned char* wl = lds + wave * WAVE_LDS;
    LAS float* wsf = (LAS float*)(wl + 8192);
    LAS float* lutA = (LAS float*)(lds + LUT_OFF); LAS float* lutB = (LAS float*)(lds + LUTB_OFF);
    LAS unsigned char* tab = lds + TAB_OFF; LAS float* lsetab = (LAS float*)(lds + LSE_OFF);
    const int tid = wave * 64 + lane;
    const int i = lane & 31;
    {
        const int bh = u >> 3, blk = u & 7, b = bh >> 3, h = bh & 7, t0 = blk * 512;
        const bf16_t* qbase = T.qa + (size_t)bh * S * HD; const bf16_t* kbase = T.ka + (size_t)bh * S * HD; const bf16_t* vbase = T.va + (size_t)bh * S * HD;
        __syncthreads();
        for (int e = tid; e < 3 * 129; e += 512) { const int c = e / 129, idx = e % 129, d = c == 0 ? 1 : (c == 1 ? 4 : 16);
            lutA[c * LUTA_STRIDE + 32 + idx] = T.rel_bias[bucket((idx - 64) * d) * 16 + h] * LOG2E; }
        __syncthreads();
#pragma unroll 1
        for (int pass = 0; pass < 3; ++pass) {
            const int c = 2 - pass, d = c == 0 ? 1 : (c == 1 ? 4 : 16);
#pragma unroll 1
            for (int tt = 0; tt < 2; ++tt) {
                const int Tq = 2 * wave + tt;
                int rr, beta;
                if (c == 2) { rr = Tq; beta = 0; } else if (c == 1) { rr = Tq >> 2; beta = Tq & 3; } else { rr = 0; beta = Tq; }
                const int lam0 = 32 * beta;
                const int tq = t0 + d * (lam0 + i) + rr, tk0 = t0 + d * (lam0 - 64) + rr;
                f32x16 o[2]; float m, l;
                qtile<5>(qbase + (size_t)tq * HD, kbase, vbase, tk0, d, lutA + c * LUTA_STRIDE + 32, NEG, 0.f, wl, lane, o, m, l);
                stage_o(o, m, l, wl, lane);
#pragma unroll
                for (int i4 = 0; i4 < 4; ++i4) {
                    const int qi = (lane >> 3) + 8 * i4, ch = lane & 7, tau = d * (lam0 + qi) + rr;
                    u32x4 v = *(const LAS u32x4*)(wl + qi * 128 + ch * 16);
                    const float Lb = wsf[32 + qi];
                    LAS u32x4* te = (LAS u32x4*)(tab + tau * 128 + ch * 16);
                    if (pass == 0) { *te = v; if (ch == 0) lsetab[tau] = Lb; }
                    else {
                        const u32x4 tv = *te; const float La = lsetab[tau];
                        const float Lm = fmaxf(La, Lb), sa = __builtin_amdgcn_exp2f(La - Lm), sb = __builtin_amdgcn_exp2f(Lb - Lm), tot = sa + sb, rt = __builtin_amdgcn_rcpf(tot), wa = sa * rt, wb = sb * rt;
                        u32x4 w; w.x = mix2(tv.x, v.x, wa, wb); w.y = mix2(tv.y, v.y, wa, wb); w.z = mix2(tv.z, v.z, wa, wb); w.w = mix2(tv.w, v.w, wa, wb);
                        if (pass == 1) { *te = w; if (ch == 0) lsetab[tau] = Lm + __builtin_amdgcn_logf(tot); }
                        else *(u32x4*)(T.o + ((size_t)b * S + t0 + tau) * D + h * HD + ch * 8) = w;
                    }
                }
            }
            __syncthreads();
        }
    }
    {
        const int bk = u >> 5, blk = u & 31, b = bk >> 1, hk = bk & 1, t0 = blk * 128;
        const bf16_t* kbase = T.kb + (size_t)bk * S * HD; const bf16_t* vbase = T.vb + (size_t)bk * S * HD;
        for (int e = tid; e < 4 * 257; e += 512) { const int g = e / 257, idx = e % 257;
            lutB[g * LUTB_STRIDE + 32 + idx] = T.rel_bias[bucket(idx - 128) * 16 + 8 + 4 * hk + g] * LOG2E; }
        __syncthreads();
        const int qt = wave & 3;
#pragma unroll 1
        for (int gg = 0; gg < 2; ++gg) {
            const int g = 2 * (wave >> 2) + gg, hq = 4 * hk + g;
            const bf16_t* qbase = T.qb + ((size_t)b * 8 + hq) * S * HD;
            const int tq = t0 + 32 * qt + i, tk0 = t0 + 32 * qt - 128;
            f32x16 o[2]; float m, l;
            qtile<9>(qbase + (size_t)tq * HD, kbase, vbase, tk0, 1, lutB + g * LUTB_STRIDE + 32, T.sink[hq] * LOG2E, 1.0f, wl, lane, o, m, l);
            stage_o(o, m, l, wl, lane);
#pragma unroll
            for (int i4 = 0; i4 < 4; ++i4) { const int qi = (lane >> 3) + 8 * i4, ch = lane & 7;
                const u32x4 v = *(const LAS u32x4*)(wl + qi * 128 + ch * 16);
                *(u32x4*)(T.o + ((size_t)b * S + t0 + 32 * qt + qi) * D + (8 + hq) * HD + ch * 8) = v; }
        }
    }
}
}

#define XB_TMO      128
#define XB_XCNT(j)  (256  + 64 * (j))
#define XB_XSUB(j)  (1280 + 64 * (j))
#define XB_XGEN(j)  (2304 + 64 * (j))
#define XB_TOP      3328
#define XB_TOPGEN   3392
#define XCD_BAR_WORDS 3456
#define XB_SPIN_CAP (1u << 18)

__device__ __forceinline__ unsigned xb_ld(unsigned* p)              { return __hip_atomic_load(p, __ATOMIC_RELAXED, __HIP_MEMORY_SCOPE_AGENT); }
__device__ __forceinline__ unsigned xb_add(unsigned* p, unsigned v) { return __hip_atomic_fetch_add(p, v, __ATOMIC_RELAXED, __HIP_MEMORY_SCOPE_AGENT); }
__device__ __forceinline__ unsigned xb_xcc_id() { return (unsigned)__builtin_amdgcn_s_getreg((3 << 11) | 20) & 0xFu; }
#define XB_SPIN(cond, bar) do { unsigned _sp = 0; while (cond) { __builtin_amdgcn_s_sleep(1); \
    if ((++_sp & 255u) == 0u) { if (xb_ld(&(bar)[XB_TMO])) break; if (_sp > XB_SPIN_CAP) { atomicAdd(&(bar)[XB_TMO], 1u); break; } } } } while (0)

struct XcdBarrier {
    unsigned* bar; unsigned x;
    volatile LAS unsigned* st;
};

__device__ __forceinline__ XcdBarrier xcd_barrier_post(unsigned* bar, volatile LAS unsigned* st) {
    XcdBarrier b; b.bar = bar; b.x = xb_xcc_id(); b.st = st;
    if (threadIdx.x == 0) (void)xb_add(&bar[XB_XCNT(b.x)], 1u);
    return b;
}
__device__ __forceinline__ void xcd_barrier_complete(unsigned* bar, unsigned x, unsigned& nloc, unsigned& nx) {
    const unsigned G = gridDim.x * gridDim.y * gridDim.z;
    unsigned sum, cnt, mine, sp = 0u;
    for (;;) {
        sum = 0u; cnt = 0u; mine = 0u;
#pragma unroll
        for (unsigned j = 0; j < 16; ++j) { const unsigned c = xb_ld(&bar[XB_XCNT(j)]); sum += c; cnt += (c > 0u) ? 1u : 0u; mine = (j == x) ? c : mine; }
        if (sum == G) break;
        __builtin_amdgcn_s_sleep(1);
        if ((++sp & 255u) == 0u) { if (xb_ld(&bar[XB_TMO])) break; if (sp > XB_SPIN_CAP) { atomicAdd(&bar[XB_TMO], 1u); break; } }
    }
    nloc = mine > 0u ? mine : 1u; nx = cnt > 0u ? cnt : 1u;
}

__device__ __forceinline__ void xcd_barrier(const XcdBarrier& b) {
    asm volatile("s_waitcnt vmcnt(0)" ::: "memory");
    __syncthreads();
    if (threadIdx.x == 0) {
        unsigned* bar = b.bar;
        __builtin_amdgcn_s_waitcnt(0);
        unsigned nloc = b.st[0], nx = b.st[1];
        if (nloc == 0u) { xcd_barrier_complete(bar, b.x, nloc, nx); b.st[0] = nloc; b.st[1] = nx; }
        const unsigned old = xb_add(&bar[XB_XSUB(b.x)], 1u);
        const unsigned gen = old / nloc;
        if (old + 1u == (gen + 1u) * nloc) {
            __builtin_amdgcn_fence(__ATOMIC_RELEASE, "agent");
            asm volatile("s_waitcnt vmcnt(0)" ::: "memory");
            const unsigned og = xb_add(&bar[XB_TOP], 1u);
            const unsigned tg = og / nx;
            if (og + 1u == (tg + 1u) * nx) xb_add(&bar[XB_TOPGEN], 1u);
            else XB_SPIN(xb_ld(&bar[XB_TOPGEN]) == tg, bar);
            __builtin_amdgcn_fence(__ATOMIC_ACQUIRE, "agent");
            xb_add(&bar[XB_XGEN(b.x)], 1u);
            asm volatile("s_waitcnt vmcnt(0)" ::: "memory");
        } else {
            XB_SPIN(xb_ld(&bar[XB_XGEN(b.x)]) == gen, bar);
            __builtin_amdgcn_fence(__ATOMIC_ACQUIRE, "agent");
            asm volatile("s_waitcnt vmcnt(0)" ::: "memory");
        }
    }
    __syncthreads();
}
typedef const float* cfptr_t; typedef float* fptr_t; typedef unsigned char* ucptr_t;
typedef __attribute__((address_space(4))) const unsigned char* kargp_t;
struct KA {
    kargp_t kp;
    __device__ __forceinline__ const float* in(int i) const { return *(__attribute__((address_space(4))) const cfptr_t*)(kp + 8 * i); }
    __device__ __forceinline__ float* out() const { return *(__attribute__((address_space(4))) const fptr_t*)(kp + 160); }
    __device__ __forceinline__ unsigned char* ws() const { return *(__attribute__((address_space(4))) const ucptr_t*)(kp + 168); }
    __device__ __forceinline__ int ph_lo() const { return *(__attribute__((address_space(4))) const int*)(kp + 176); }
    __device__ __forceinline__ int ph_hi() const { return *(__attribute__((address_space(4))) const int*)(kp + 180); }
};
static_assert(sizeof(Args) == 184, "Args layout");
__global__ void __launch_bounds__(NWAVES * 64, 2) mk_fwd(Args) {
    extern __shared__ __attribute__((aligned(16))) unsigned char lds_raw[];
    LAS unsigned char* lds = (LAS unsigned char*)lds_raw;
    cg::grid_group grid = cg::this_grid();
    const int wave0 = __builtin_amdgcn_readfirstlane(threadIdx.x >> 6);
    volatile LAS unsigned* bst = (volatile LAS unsigned*)((LAS unsigned char*)lds_raw + LDS_BYTES - 64);
    if (threadIdx.x < 2) bst[threadIdx.x] = 0u;
    __syncthreads();
    KA a; a.kp = (kargp_t)__builtin_amdgcn_kernarg_segment_ptr();
    const int ph_hi = a.ph_hi();
    XcdBarrier xbar; xbar.bar = (unsigned*)(a.ws() + WS_CTL) + 4096; xbar.x = 0; xbar.st = bst;
    if (ph_hi - a.ph_lo() > 1) xbar = xcd_barrier_post((unsigned*)(a.ws() + WS_CTL) + 4096, bst);
    for (int ph = a.ph_lo(); ph < ph_hi; ++ph) {
    asm volatile("" : "+s"(a.kp));
    int G_ = gridDim.x, bx_ = blockIdx.x; asm volatile("" : "+s"(G_), "+s"(bx_));
    const int G = G_, bx = bx_;
    const int wave = wave0;
#define FRESH_LANE() ({ int l_; asm volatile("v_mbcnt_lo_u32_b32 %0, -1, 0\n\tv_mbcnt_hi_u32_b32 %0, -1, %0" : "=v"(l_)); l_; })
    const int vcu = (G % 8 == 0) ? (bx % 8) * (G / 8) + bx / 8 : bx;
    const int gw = vcu * NWAVES + wave, NGW = G * NWAVES;
    unsigned char* ws = a.ws();
    bf16_t* xb = (bf16_t*)(ws + WS_XB); float* ssp0 = (float*)(ws + WS_SSP); float* ssp1 = ssp0 + (size_t)M * 16;
    bf16_t* xb2 = (bf16_t*)(ws + WS_W);
    bf16_t* act = (bf16_t*)(ws + WS_R + R_ACT); bf16_t* ob = (bf16_t*)(ws + WS_R + R_O);
    bf16_t* pb = (bf16_t*)(ws + WS_PB); bf16_t* proj = (bf16_t*)(ws + WS_PROJ);
        if (ph == 0) {
            prologue_phase(a, lds, gw, NGW, wave, FRESH_LANE());
            convert_p(a.in(1), pb, bx * NWAVES * 64 + wave0 * 64 + FRESH_LANE(), G * NWAVES * 64);
        } else {
            const int l = (ph - 1) >> 3, k = (ph - 1) & 7;
            const bf16_t* wl = (const bf16_t*)(ws + WS_W) + (size_t)l * W_LAYER;
            const float* xin = (l == 0 && k <= 1) ? a.in(0) : a.out();
            if (k == 0 || k == 5) {
                pg8::Gemm g{(k == 0 && l == 1) ? xb2 : xb, wl + (k == 0 ? WO_F1IN : WO_F2IN), M, 2 * DFF, D}; pg8::StaticOrder S; S.init(M, 2 * DFF, G, bx);
                pg8::EpiSwiglu E{act, ssp0};
                pg8::gemm_phase<pg8::EpiSwiglu, pg8::StaticOrder, true, true>(lds, g, S, E, wave0 * 64 + FRESH_LANE());
            } else if (k == 1 || k == 6) {
                pg8::Gemm g{act, wl + (k == 1 ? WO_F1OUT : WO_F2OUT), M, D, DFF}; pg8::StaticOrder S; S.init(M, D, G, bx);
                pg8::EpiResid E{xin, a.out(), xb, ssp1, 0.5f};
                pg8::gemm_phase<pg8::EpiResid, pg8::StaticOrder, true, true>(lds, g, S, E, wave0 * 64 + FRESH_LANE());
            } else if (k == 2) {
                { pg8::Gemm g{xb, wl + WO_QKV, M, QKVW, D}; pg8::StaticOrder S; S.init(M, QKVW, G, bx);
                  pg8::EpiQkv E; E.ssp = ssp1;
                  E.qa = (bf16_t*)(ws + WS_R + R_QA); E.ka = (bf16_t*)(ws + WS_R + R_KA); E.va = (bf16_t*)(ws + WS_R + R_VA);
                  E.qb = (bf16_t*)(ws + WS_R + R_QB); E.kb = (bf16_t*)(ws + WS_R + R_KB); E.vb = (bf16_t*)(ws + WS_R + R_VB);
                  E.qna = a.in(8) + l * HD; E.kna = a.in(9) + l * HD; E.qnb = a.in(10) + l * HD; E.knb = a.in(11) + l * HD;
                  pg8::gemm_phase<pg8::EpiQkv, pg8::StaticOrder, true, true>(lds, g, S, E, wave0 * 64 + FRESH_LANE()); }
                { pg8::Gemm g{pb, wl + WO_WP, M, D, PLE}; pg8::StaticOrder S; S.init(M, D, G, bx);
                  pg8::EpiStoreBf16 E{proj, D};
                  pg8::gemm_phase<pg8::EpiStoreBf16, pg8::StaticOrder, true, true>(lds, g, S, E, wave0 * 64 + FRESH_LANE()); }
            } else if (k == 3) {
                AttnIn ai; ai.qa = (bf16_t*)(ws + WS_R + R_QA); ai.ka = (bf16_t*)(ws + WS_R + R_KA); ai.va = (bf16_t*)(ws + WS_R + R_VA);
                ai.qb = (bf16_t*)(ws + WS_R + R_QB); ai.kb = (bf16_t*)(ws + WS_R + R_KB); ai.vb = (bf16_t*)(ws + WS_R + R_VB);
                ai.rel_bias = a.in(2); ai.sink = a.in(12) + l * 8; ai.o = ob;
#if ATT_FAST
                { att::Tensors T; T.qa = ai.qa; T.ka = ai.ka; T.va = ai.va; T.qb = ai.qb; T.kb = ai.kb; T.vb = ai.vb; T.rel_bias = ai.rel_bias; T.sink = ai.sink; T.o = ai.o;
                  const int lane = FRESH_LANE();
                  for (int u = vcu; u < 256; u += G) att::attn_unit(T, u, lds, wave, lane); }
#else
                attn_simple_phase(lds, ai, G, wave, FRESH_LANE());
#endif
            } else if (k == 4) {
                if (l + 1 < DEPTH) { convert_p(a.in(1) + (size_t)(l + 1) * M * PLE, pb, bx * NWAVES * 64 + wave0 * 64 + FRESH_LANE(), G * NWAVES * 64); asm volatile("s_waitcnt vmcnt(0)" ::: "memory"); }
                pg8::Gemm g{ob, wl + WO_WO, M, D, D}; pg8::StaticOrder S; S.init(M, D, G, bx);
                pg8::EpiResid E{xin, a.out(), xb, ssp0, 1.0f};
                pg8::gemm_phase<pg8::EpiResid, pg8::StaticOrder, true, true>(lds, g, S, E, wave0 * 64 + FRESH_LANE());
            } else {
                pg8::Gemm g{xb, wl + WO_WG, M, D, D}; pg8::StaticOrder S; S.init(M, D, G, bx);
                pg8::EpiGate E{xin, a.out(), xb2, ssp0, ssp1, proj};
                pg8::gemm_phase<pg8::EpiGate, pg8::StaticOrder, true, true>(lds, g, S, E, wave0 * 64 + FRESH_LANE());
            }
        }
        if (ph + 1 < ph_hi) { if (ph == 0) grid.sync(); else xcd_barrier(xbar); }
    }
}

#ifndef FAST_MASK
#define FAST_MASK 0x1ffffu
#endif
extern "C" void kernel_launch(void* const* d_in, const int* in_sizes, int n_in, void* d_out, int out_size, void* d_ws, size_t ws_size, hipStream_t stream) {
    static int grid = 0;
    if (grid == 0) {
        if (n_in != 20 || in_sizes[0] != M * D || out_size != M * D || ws_size < WS_END) { fprintf(stderr, "kernel_launch: unexpected shapes (n_in %d, ws %zu)\n", n_in, ws_size); grid = -1; return; }
        int dev = 0, cus = 0, per_cu = 0;
        if (hipGetDevice(&dev) != hipSuccess || hipDeviceGetAttribute(&cus, hipDeviceAttributeMultiprocessorCount, dev) != hipSuccess) { grid = -1; return; }
        if (hipFuncSetAttribute((const void*)mk_fwd, hipFuncAttributeMaxDynamicSharedMemorySize, LDS_BYTES) != hipSuccess) { fprintf(stderr, "kernel_launch: hipFuncSetAttribute failed\n"); grid = -1; return; }
        if (hipOccupancyMaxActiveBlocksPerMultiprocessor(&per_cu, (const void*)mk_fwd, NWAVES * 64, LDS_BYTES) != hipSuccess || per_cu < 1) { fprintf(stderr, "kernel_launch: occupancy query says %d\n", per_cu); grid = -1; (void)hipGetLastError(); return; }
        grid = cus;
    }
    if (grid < 0) return;
    (void)hipMemsetAsync((char*)d_ws + WS_CTL, 0, 1 * MiB, stream);
    Args a{};
    for (int i = 0; i < 20; ++i) a.in[i] = (const float*)d_in[i];
    a.out = (float*)d_out; a.ws = (unsigned char*)d_ws;
    const unsigned fast = FAST_MASK;
    if (fast == 0x1ffffu) {
        a.ph_lo = 0; a.ph_hi = NPHASE;
        void* args[] = {&a};
        hipError_t e = hipLaunchCooperativeKernel((const void*)mk_fwd, dim3(grid), dim3(NWAVES * 64), args, LDS_BYTES, stream);
        if (e != hipSuccess) fprintf(stderr, "kernel_launch: cooperative launch failed: %s (grid %d)\n", hipGetErrorString(e), grid);
        return;
    }
    unsigned char* ws = (unsigned char*)d_ws; float* out = (float*)d_out;
    bf16_t* xb = (bf16_t*)(ws + WS_XB); bf16_t* xb2 = (bf16_t*)(ws + WS_W); float* ssp0 = (float*)(ws + WS_SSP); float* ssp1 = ssp0 + (size_t)M * 16;
    bf16_t* act = (bf16_t*)(ws + WS_R + R_ACT); bf16_t* ob = (bf16_t*)(ws + WS_R + R_O);
    QkvOut qo; qo.qa = (bf16_t*)(ws + WS_R + R_QA); qo.ka = (bf16_t*)(ws + WS_R + R_KA); qo.va = (bf16_t*)(ws + WS_R + R_VA);
    qo.qb = (bf16_t*)(ws + WS_R + R_QB); qo.kb = (bf16_t*)(ws + WS_R + R_KB); qo.vb = (bf16_t*)(ws + WS_R + R_VB);
    for (int ph = 0; ph < NPHASE; ++ph) {
        if ((fast >> ph) & 1u) { a.ph_lo = ph; a.ph_hi = ph + 1; hipLaunchKernelGGL(mk_fwd, dim3(grid), dim3(NWAVES * 64), LDS_BYTES, stream, a); continue; }
        if (ph == 0) { rowstat_kernel<<<M / 4, 256, 0, stream>>>(a.in[0], xb, ssp0); continue; }
        const int l = (ph - 1) >> 3, k = (ph - 1) & 7;
        const float* xin = (l == 0 && k <= 1) ? a.in[0] : out;
        bf16_t* xbl = (l == 1) ? xb2 : xb;
        switch (k) {
        case 0: naive_ffn_in<<<dim3(DFF / 128, M / 128), 256, 0, stream>>>(xbl, ssp0, a.in[3] + l * D, a.in[4] + (size_t)l * D * 2 * DFF, act); break;
        case 1: naive_resid<<<dim3(D / 128, M / 128), 256, 0, stream>>>(act, DFF, a.in[5] + (size_t)l * DFF * D, xin, out, 0.5f); rowstat_kernel<<<M / 4, 256, 0, stream>>>(out, xb, ssp1); break;
        case 2: qo.qna = a.in[8] + l * HD; qo.kna = a.in[9] + l * HD; qo.qnb = a.in[10] + l * HD; qo.knb = a.in[11] + l * HD;
                naive_qkv<<<dim3(QKVW / 128, M / 128), 256, 0, stream>>>(xb, ssp1, a.in[6] + l * D, a.in[7] + (size_t)l * D * QKVW, qo); break;
        case 3: { AttnIn ai; ai.qa = qo.qa; ai.ka = qo.ka; ai.va = qo.va; ai.qb = qo.qb; ai.kb = qo.kb; ai.vb = qo.vb; ai.rel_bias = a.in[2]; ai.sink = a.in[12] + l * 8; ai.o = ob;
                naive_attn<<<dim3(S / 4, 16, NB), 256, 0, stream>>>(ai); } break;
        case 4: naive_resid<<<dim3(D / 128, M / 128), 256, 0, stream>>>(ob, D, a.in[13] + (size_t)l * D * D, out, out, 1.0f); rowstat_kernel<<<M / 4, 256, 0, stream>>>(out, xb, ssp0); break;
        case 5: naive_ffn_in<<<dim3(DFF / 128, M / 128), 256, 0, stream>>>(xb, ssp0, a.in[14] + l * D, a.in[15] + (size_t)l * D * 2 * DFF, act); break;
        case 6: naive_resid<<<dim3(D / 128, M / 128), 256, 0, stream>>>(act, DFF, a.in[16] + (size_t)l * DFF * D, out, out, 0.5f); rowstat_kernel<<<M / 4, 256, 0, stream>>>(out, xb, ssp1); break;
        case 7: naive_ple<<<dim3(D / 128, M / 128), 256, 0, stream>>>(xb, ssp1, a.in[17] + l * D, a.in[18] + (size_t)l * D * D, a.in[1] + (size_t)l * M * PLE, a.in[19] + (size_t)l * PLE * D, out, out);
                rowstat_kernel<<<M / 4, 256, 0, stream>>>(out, xb2, ssp0); break;
        }
    }
}
```

```cpp
#include <hip/hip_runtime.h>
#include <cstdio>
#include <cstdint>
#ifndef ATT_FAST
#define ATT_FAST 1
#endif
#ifndef PROBE_N
#define PROBE_N 0
#define PROBE_K -1
#endif

typedef unsigned short bf16_t;
constexpr int NB = 4, S = 4096, D = 1024, M = NB * S, DFF = 2816, QKVW = 2304, PLE = 256, DEPTH = 2, HD = 64;
constexpr float EPS = 1e-6f;
constexpr float QSCALE = 0.125f * 1.4426950408889634f;
constexpr float LOG2E = 1.4426950408889634f;

constexpr size_t MiB = 1u << 20;
constexpr size_t WS_CTL = 0, WS_W = 1 * MiB, WS_XB = 85 * MiB, WS_R = 117 * MiB, WS_PB = 221 * MiB, WS_PROJ = 229 * MiB, WS_SSP = 261 * MiB, WS_END = 263 * MiB + 512 * 1024;
constexpr size_t R_QA = 0, R_KA = 16 * MiB, R_VA = 32 * MiB, R_QB = 48 * MiB, R_KB = 64 * MiB, R_VB = 68 * MiB, R_O = 72 * MiB, R_ACT = 0;

__device__ __forceinline__ float bf2f(bf16_t v) { return __uint_as_float(((unsigned)v) << 16); }
__device__ __forceinline__ bf16_t f2bf(float f) { unsigned u = __float_as_uint(f); return (bf16_t)((u + 0x7fffu + ((u >> 16) & 1u)) >> 16); }

__global__ void __launch_bounds__(256) rowstat_kernel(const float* __restrict__ x, bf16_t* __restrict__ xb, float* __restrict__ ssp) {
    const int wave = threadIdx.x >> 6, lane = threadIdx.x & 63;
    const int row = blockIdx.x * 4 + wave;
    const float4* xr = (const float4*)(x + (size_t)row * D);
    float s = 0.f;
#pragma unroll
    for (int j = 0; j < 4; ++j) {
        float4 v = xr[lane + 64 * j];
        s += v.x * v.x + v.y * v.y + v.z * v.z + v.w * v.w;
        ushort4 o; o.x = f2bf(v.x); o.y = f2bf(v.y); o.z = f2bf(v.z); o.w = f2bf(v.w);
        ((ushort4*)(xb + (size_t)row * D))[lane + 64 * j] = o;
    }
#pragma unroll
    for (int o = 1; o < 64; o <<= 1) s += __shfl_xor(s, o);
    if (lane < 4) { float4 r; r.x = lane == 0 ? s : 0.f; r.y = 0.f; r.z = 0.f; r.w = 0.f; ((float4*)ssp)[row * 4 + lane] = r; }
}

__device__ __forceinline__ float row_rstd(const float* ssp, int row) {
    float s = 0.f;
#pragma unroll
    for (int j = 0; j < 4; ++j) { const float4 v = ((const float4*)ssp)[row * 4 + j]; s += (v.x + v.y) + (v.z + v.w); }
    return rsqrtf(s * (1.0f / D) + EPS);
}

template <typename AT> __device__ __forceinline__ float ldA(const AT* p);
template <> __device__ __forceinline__ float ldA<bf16_t>(const bf16_t* p) { return bf2f(*p); }
template <> __device__ __forceinline__ float ldA<float>(const float* p) { return *p; }

template <typename AT>
__device__ __forceinline__ void accum_tile(const AT* A, int lda, int K, const float* gain, const float* W, int ldw, int row0, int wcol0, float (&acc)[8][8], float* As, float* Bs) {
    const int tid = threadIdx.x, tx = tid & 15, ty = tid >> 4;
    for (int k0 = 0; k0 < K; k0 += 8) {
        __syncthreads();
#pragma unroll
        for (int i = 0; i < 4; ++i) { const int idx = tid + i * 256, r = idx >> 3, kk = idx & 7;
            As[kk * 132 + r] = ldA<AT>(A + (size_t)(row0 + r) * lda + k0 + kk) * (gain ? gain[k0 + kk] : 1.0f); }
#pragma unroll
        for (int i = 0; i < 4; ++i) { const int idx = tid + i * 256, kk = idx >> 7, c = idx & 127;
            Bs[kk * 128 + c] = W[(size_t)(k0 + kk) * ldw + wcol0 + c]; }
        __syncthreads();
#pragma unroll
        for (int kk = 0; kk < 8; ++kk) {
            float a[8], b[8];
#pragma unroll
            for (int i = 0; i < 8; ++i) a[i] = As[kk * 132 + ty * 8 + i];
#pragma unroll
            for (int j = 0; j < 8; ++j) b[j] = Bs[kk * 128 + tx * 8 + j];
#pragma unroll
            for (int i = 0; i < 8; ++i)
#pragma unroll
                for (int j = 0; j < 8; ++j) acc[i][j] += a[i] * b[j];
        }
    }
}
#define ZERO_ACC(acc) do { _Pragma("unroll") for (int i = 0; i < 8; ++i) _Pragma("unroll") for (int j = 0; j < 8; ++j) acc[i][j] = 0.f; } while (0)

__global__ void __launch_bounds__(256) naive_ffn_in(const bf16_t* xb, const float* ssp, const float* gain, const float* Win, bf16_t* act) {
    __shared__ float As[8 * 132]; __shared__ float Bs[8 * 128];
    const int row0 = blockIdx.y * 128, col0 = blockIdx.x * 128, tx = threadIdx.x & 15, ty = threadIdx.x >> 4;
    float ag[8][8], au[8][8]; ZERO_ACC(ag); ZERO_ACC(au);
    accum_tile<bf16_t>(xb, D, D, gain, Win, 2 * DFF, row0, col0, ag, As, Bs);
    accum_tile<bf16_t>(xb, D, D, gain, Win, 2 * DFF, row0, DFF + col0, au, As, Bs);
#pragma unroll
    for (int i = 0; i < 8; ++i) { const int row = row0 + ty * 8 + i; const float rs = row_rstd(ssp, row);
#pragma unroll
        for (int j = 0; j < 8; ++j) { const float g = ag[i][j] * rs, u = au[i][j] * rs; const float sg = g / (1.0f + __expf(-g));
            act[(size_t)row * DFF + col0 + tx * 8 + j] = f2bf(sg * u); } }
}
__global__ void __launch_bounds__(256) naive_resid(const bf16_t* A, int K, const float* W, const float* xin, float* xout, float coef) {
    __shared__ float As[8 * 132]; __shared__ float Bs[8 * 128];
    const int row0 = blockIdx.y * 128, col0 = blockIdx.x * 128, tx = threadIdx.x & 15, ty = threadIdx.x >> 4;
    float acc[8][8]; ZERO_ACC(acc);
    accum_tile<bf16_t>(A, K, K, nullptr, W, D, row0, col0, acc, As, Bs);
#pragma unroll
    for (int i = 0; i < 8; ++i) { const int row = row0 + ty * 8 + i;
#pragma unroll
        for (int j = 0; j < 8; ++j) { const size_t o = (size_t)row * D + col0 + tx * 8 + j; xout[o] = xin[o] + coef * acc[i][j]; } }
}
struct QkvOut { bf16_t *qa, *ka, *va, *qb, *kb, *vb; const float *qna, *kna, *qnb, *knb; };
__global__ void __launch_bounds__(256) naive_qkv(const bf16_t* xb, const float* ssp, const float* gain, const float* Wqkv, QkvOut o) {
    __shared__ float As[8 * 132]; __shared__ float Bs[8 * 128];
    const int row0 = blockIdx.y * 128, col0 = blockIdx.x * 128, tx = threadIdx.x & 15, ty = threadIdx.x >> 4;
    float acc[8][8]; ZERO_ACC(acc);
    accum_tile<bf16_t>(xb, D, D, gain, Wqkv, QKVW, row0, col0, acc, As, Bs);
    const int c = col0 + tx * 8;
    bf16_t* dst; const float* ng; int nh, hc; float sc = 1.0f;
    if (c < 512) { dst = o.qa; ng = o.qna; nh = 8; hc = c; sc = QSCALE; }
    else if (c < 1024) { dst = o.ka; ng = o.kna; nh = 8; hc = c - 512; }
    else if (c < 1536) { dst = o.va; ng = nullptr; nh = 8; hc = c - 1024; }
    else if (c < 2048) { dst = o.qb; ng = o.qnb; nh = 8; hc = c - 1536; sc = QSCALE; }
    else if (c < 2176) { dst = o.kb; ng = o.knb; nh = 2; hc = c - 2048; }
    else { dst = o.vb; ng = nullptr; nh = 2; hc = c - 2176; }
    const int h = hc >> 6, e0 = hc & 63;
#pragma unroll
    for (int i = 0; i < 8; ++i) { const int row = row0 + ty * 8 + i; const float rs = row_rstd(ssp, row);
        float v[8]; float ss = 0.f;
#pragma unroll
        for (int j = 0; j < 8; ++j) { v[j] = acc[i][j] * rs; ss += v[j] * v[j]; }
        ss += __shfl_xor(ss, 1); ss += __shfl_xor(ss, 2); ss += __shfl_xor(ss, 4);
        const float hr = rsqrtf(ss * (1.0f / HD) + EPS);
        const int b = row / S, s = row % S;
        bf16_t* p = dst + (((size_t)b * nh + h) * S + s) * HD + e0;
#pragma unroll
        for (int j = 0; j < 8; ++j) p[j] = f2bf(ng ? v[j] * hr * ng[e0 + j] * sc : v[j]); }
}
__global__ void __launch_bounds__(256) naive_ple(const bf16_t* xb, const float* ssp, const float* gain, const float* Wg, const float* p, const float* Wp, const float* xin, float* xout) {
    __shared__ float As[8 * 132]; __shared__ float Bs[8 * 128];
    const int row0 = blockIdx.y * 128, col0 = blockIdx.x * 128, tx = threadIdx.x & 15, ty = threadIdx.x >> 4;
    float ag[8][8], ap[8][8]; ZERO_ACC(ag); ZERO_ACC(ap);
    accum_tile<bf16_t>(xb, D, D, gain, Wg, D, row0, col0, ag, As, Bs);
    accum_tile<float>(p, PLE, PLE, nullptr, Wp, D, row0, col0, ap, As, Bs);
#pragma unroll
    for (int i = 0; i < 8; ++i) { const int row = row0 + ty * 8 + i; const float rs = row_rstd(ssp, row);
#pragma unroll
        for (int j = 0; j < 8; ++j) { const size_t o = (size_t)row * D + col0 + tx * 8 + j; const float g = 1.0f / (1.0f + __expf(-ag[i][j] * rs));
            xout[o] = xin[o] + g * ap[i][j]; } }
}

__device__ __forceinline__ int t5_bucket(int rel) {
    const int n = rel < 0 ? -rel : rel; const int ret = rel > 0 ? 16 : 0;
    if (n < 8) return ret + n;
    int large = 8 + (int)(logf((float)n / 8.0f) / 4.852030263919617f * 8.0f);
    large = large < 15 ? large : 15;
    return ret + large;
}
struct AttnIn { const bf16_t *qa, *ka, *va, *qb, *kb, *vb; const float* rel_bias; const float* sink; bf16_t* o; };
__global__ void __launch_bounds__(256) naive_attn(AttnIn a) {
    __shared__ float pl[4][400]; __shared__ int kl[4][400];
    const int wave = threadIdx.x >> 6, lane = threadIdx.x & 63;
    const int t = blockIdx.x * 4 + wave, head = blockIdx.y, b = blockIdx.z;
    const bool isA = head < 8;
    const bf16_t *q, *k, *v;
    if (isA) { q = a.qa + (((size_t)b * 8 + head) * S + t) * HD; k = a.ka + ((size_t)b * 8 + head) * S * HD; v = a.va + ((size_t)b * 8 + head) * S * HD; }
    else { const int hq = head - 8, hk = hq >> 2; q = a.qb + (((size_t)b * 8 + hq) * S + t) * HD; k = a.kb + ((size_t)b * 2 + hk) * S * HD; v = a.vb + ((size_t)b * 2 + hk) * S * HD; }
    float qf[HD];
#pragma unroll
    for (int e = 0; e < HD; ++e) qf[e] = bf2f(q[e]);
    const int nk = isA ? 387 : 257;
    float mx = -1e30f;
    for (int i = lane; i < nk; i += 64) {
        int rel;
        if (isA) { const int br = i / 129, j = i % 129 - 64; rel = j * (br == 0 ? 1 : br == 1 ? 4 : 16); }
        else rel = i - 128;
        const int tk = t + rel;
        float lg = -1e30f;
        if (tk >= 0 && tk < S) {
            float d = 0.f; const bf16_t* kr = k + (size_t)tk * HD;
#pragma unroll
            for (int e = 0; e < HD; ++e) d += qf[e] * bf2f(kr[e]);
            lg = d + a.rel_bias[t5_bucket(rel) * 16 + head] * LOG2E;
        }
        pl[wave][i] = lg; kl[wave][i] = tk;
        mx = fmaxf(mx, lg);
    }
#pragma unroll
    for (int o = 1; o < 64; o <<= 1) mx = fmaxf(mx, __shfl_xor(mx, o));
    float sinkl = 0.f;
    if (!isA) { sinkl = a.sink[head - 8] * LOG2E; mx = fmaxf(mx, sinkl); }
    float sum = 0.f;
    for (int i = lane; i < nk; i += 64) { const float lg = pl[wave][i]; const float pv = lg > -1e29f ? exp2f(lg - mx) : 0.f; pl[wave][i] = pv; sum += pv; }
#pragma unroll
    for (int o = 1; o < 64; o <<= 1) sum += __shfl_xor(sum, o);
    if (!isA) sum += exp2f(sinkl - mx);
    __syncthreads();
    float acc = 0.f;
    for (int i = 0; i < nk; ++i) { const float pv = pl[wave][i]; if (pv != 0.f) acc += pv * bf2f(v[(size_t)kl[wave][i] * HD + lane]); }
    a.o[((size_t)b * S + t) * D + head * HD + lane] = f2bf(acc / sum);
}

namespace pg8 {
#define PG8_LAS __attribute__((address_space(3)))
typedef unsigned short bf16_t;
typedef short bf16x8 __attribute__((ext_vector_type(8)));
typedef float f32x4 __attribute__((ext_vector_type(4)));
typedef unsigned u32x4 __attribute__((ext_vector_type(4)));
constexpr int BM = 256, BK = 64, HALF = 128, HTB = HALF * BK * 2  , STAGE_BYTES = 8 * HTB, NXCD = 8, WGM = 8;

__host__ __device__ __forceinline__ int lds_byte(int r, int c) { const int st = (r >> 4) * 2 + (c >> 5), rr = r & 15, cc = c & 31, ob = rr * 64 + cc * 2; return st * 1024 + (ob ^ (((ob >> 9) & 1) << 5)); }
__host__ __device__ __forceinline__ void stage_rc(int b, int& R, int& C) { const int st = b / 1024, sb = b % 1024, swz = sb ^ (((sb >> 9) & 1) << 5); R = (st >> 1) * 16 + swz / 64; C = (st & 1) * 32 + (swz % 64) / 2; }
__host__ __device__ __forceinline__ int perm32(int rho) { const int n = rho >> 4, i = rho & 15; return 8 * (i >> 2) + 4 * n + (i & 3); }

struct Unit { int pm, pn; };
struct Gemm { const bf16_t* A; const bf16_t* Bt; int M, N, K; };

struct StaticOrder {
    int nM, nN, nwg, G, c;
    __host__ __device__ void init(int M, int N, int G_, int c_) { nM = M / BM; nN = N / BM; nwg = nM * nN; G = G_; c = c_; }
    __host__ __device__ bool next(int i, Unit& u) const {
        const long L = (long)i * G + c; if (L >= nwg) return false;
        int wgid = (int)L; { const int q = nwg / NXCD, r = nwg % NXCD, xcd = wgid % NXCD, off = wgid / NXCD; wgid = (xcd < r ? xcd * (q + 1) : r * (q + 1) + (xcd - r) * q) + off; }
        const int nig = WGM * nN, gid = wgid / nig, fm = gid * WGM, gsz = (nM - fm) < WGM ? (nM - fm) : WGM;
        u.pm = fm + ((wgid % nig) % gsz); u.pn = (wgid % nig) / gsz; return true;
    }
    __device__ __forceinline__ void a_ready(const Unit&) const {}
    __device__ __forceinline__ void done(const Unit&) const {}
};

__device__ __forceinline__ unsigned cvt_pk_bf16(float lo, float hi) { unsigned r; asm volatile("v_cvt_pk_bf16_f32 %0, %1, %2" : "=v"(r) : "v"(lo), "v"(hi)); return r; }
typedef float f32x2 __attribute__((ext_vector_type(2)));
template <class Epi, class Sched, bool ALIGN_EPI = false, bool SP2 = false>
__device__ __forceinline__ void gemm_phase(PG8_LAS unsigned char* lds, const Gemm g, const Sched& S, const Epi& E, const int tid) {
    const int wid = __builtin_amdgcn_readfirstlane(tid >> 6), lane = tid & 63, wr = wid >> 2, wc = wid & 3, fr = lane & 15, fq = lane >> 4;
    const int K = g.K, nt = K / BK;
    unsigned voffA[2], voffB[2];
#pragma unroll
    for (int i = 0; i < 2; ++i) { int R, C; stage_rc(tid * 16 + i * 8192, R, C); const int Rb = Epi::PERM ? ((R & ~31) + perm32(R & 31)) : R;
        voffA[i] = (unsigned)(R * K + C) * 2u; voffB[i] = (unsigned)(Rb * K + C) * 2u; }
    const size_t kstep = (size_t)(BK * 2);
    const size_t hstep = (size_t)HALF * K * 2;
    const size_t tstep = 2 * hstep;
    const unsigned ldsw = (unsigned)wid * 1024u;
    const int aoff = lds_byte(wr * 64 + fr, fq * 8), boff = lds_byte(wc * 32 + fr, fq * 8);
#define PG8_SA(b, h) (((b) * 2 + (h)) * HTB)
#define PG8_SB(b, h) ((4 + (b) * 2 + (h)) * HTB)
#define PG8_STAGE(bufoff, gbase, voff) do { _Pragma("unroll") for (int _i = 0; _i < 2; ++_i) \
        __builtin_amdgcn_global_load_lds((const unsigned*)((const char*)(gbase) + (voff)[_i]), (PG8_LAS unsigned*)(lds + (bufoff) + ldsw + _i * 8192), 16, 0, 0); } while (0)
#define PG8_LDA(dst, b, h) do { _Pragma("unroll") for (int m = 0; m < 4; ++m) _Pragma("unroll") for (int k = 0; k < 2; ++k) dst[m][k] = *(const PG8_LAS bf16x8*)(lds + PG8_SA(b, h) + aoff + m * 2048 + k * 1024); } while (0)
#define PG8_LDB(dst, b, h) do { _Pragma("unroll") for (int n = 0; n < 2; ++n) _Pragma("unroll") for (int k = 0; k < 2; ++k) dst[n][k] = *(const PG8_LAS bf16x8*)(lds + PG8_SB(b, h) + boff + n * 2048 + k * 1024); } while (0)
#define PG8_MMA(ai, bj, At, Bt) do { __builtin_amdgcn_s_setprio(1); _Pragma("unroll") for (int m = 0; m < 4; ++m) _Pragma("unroll") for (int n = 0; n < 2; ++n) _Pragma("unroll") for (int k = 0; k < 2; ++k) \
        acc[ai][bj][m][n] = __builtin_amdgcn_mfma_f32_16x16x32_bf16(Bt[n][k], At[m][k], acc[ai][bj][m][n], 0, 0, 0); __builtin_amdgcn_s_setprio(0); } while (0)
#define PG8_WAIT_V(n) asm volatile("s_waitcnt vmcnt(" #n ")" ::: "memory")
#define PG8_WAIT_L(n) asm volatile("s_waitcnt lgkmcnt(" #n ")" ::: "memory")
#define PG8_BAR __builtin_amdgcn_s_barrier()
#define PG8_SCHED __builtin_amdgcn_sched_barrier(0)
    Unit cur, nxt; int ui = 0;
    if (!S.next(0, cur)) return;
    f32x4 acc[2][2][4][2];
#pragma unroll
    for (int a = 0; a < 2; ++a)
#pragma unroll
        for (int b = 0; b < 2; ++b)
#pragma unroll
            for (int m = 0; m < 4; ++m)
#pragma unroll
                for (int n = 0; n < 2; ++n) acc[a][b][m][n] = (f32x4){0.f, 0.f, 0.f, 0.f};
    bf16x8 At[4][2], B0[2][2], B1[2][2];
    const char* cA = (const char*)g.A + (size_t)cur.pm * tstep; const char* cB = (const char*)g.Bt + (size_t)cur.pn * tstep;
    S.a_ready(cur);
    if constexpr (SP2) {
        PG8_STAGE(PG8_SB(0, 0), cB, voffB); PG8_STAGE(PG8_SB(0, 1), cB + hstep, voffB); PG8_STAGE(PG8_SA(0, 0), cA, voffA); PG8_STAGE(PG8_SA(0, 1), cA + hstep, voffA);
        if (wr == 1) PG8_BAR;
        PG8_WAIT_V(2); PG8_BAR;
        PG8_STAGE(PG8_SB(1, 0), cB + kstep, voffB); PG8_STAGE(PG8_SA(1, 0), cA + kstep, voffA); PG8_STAGE(PG8_SB(1, 1), cB + hstep + kstep, voffB);
        PG8_WAIT_V(6); PG8_BAR;
    } else {
        PG8_STAGE(PG8_SB(0, 0), cB, voffB); PG8_STAGE(PG8_SA(0, 0), cA, voffA); PG8_STAGE(PG8_SB(0, 1), cB + hstep, voffB); PG8_STAGE(PG8_SA(0, 1), cA + hstep, voffA);
        if (wr == 1) PG8_BAR;
        PG8_WAIT_V(4); PG8_BAR;
        PG8_STAGE(PG8_SB(1, 0), cB + kstep, voffB); PG8_STAGE(PG8_SA(1, 0), cA + kstep, voffA); PG8_STAGE(PG8_SB(1, 1), cB + hstep + kstep, voffB);
        PG8_WAIT_V(6); PG8_BAR;
    }
    for (;;) {
        const bool has_next = S.next(ui + 1, nxt);
        const char* nA = has_next ? (const char*)g.A + (size_t)nxt.pm * tstep : cA; const char* nB = has_next ? (const char*)g.Bt + (size_t)nxt.pn * tstep : cB;
        for (int t = 0; t < nt; t += 2) {
            const bool last = (t == nt - 2);
            const char* a1 = cA + (size_t)(t + 1) * kstep;
            const char* a2 = last ? nA : cA + (size_t)(t + 2) * kstep; const char* b2 = last ? nB : cB + (size_t)(t + 2) * kstep;
            const char* a3 = a2 + kstep; const char* b3 = b2 + kstep;
            if (last && has_next) S.a_ready(nxt);
            if constexpr (SP2) {
            PG8_LDB(B0, 0, 0); PG8_LDB(B1, 0, 1); PG8_SCHED; PG8_LDA(At, 0, 0); PG8_STAGE(PG8_SA(1, 1), a1 + hstep, voffA);
            PG8_WAIT_V(8); PG8_WAIT_L(0); PG8_BAR; PG8_MMA(0, 0, At, B0); PG8_MMA(0, 1, At, B1); PG8_BAR; PG8_SCHED;
            PG8_LDA(At, 0, 1); PG8_STAGE(PG8_SB(0, 0), b2, voffB); PG8_STAGE(PG8_SB(0, 1), b2 + hstep, voffB); PG8_STAGE(PG8_SA(0, 0), a2, voffA);
            PG8_WAIT_V(8); PG8_WAIT_L(0); PG8_BAR; PG8_MMA(1, 0, At, B0); PG8_MMA(1, 1, At, B1); PG8_BAR; PG8_SCHED;
            PG8_LDB(B0, 1, 0); PG8_LDB(B1, 1, 1); PG8_SCHED; PG8_LDA(At, 1, 0); PG8_STAGE(PG8_SA(0, 1), a2 + hstep, voffA);
            PG8_WAIT_V(8); PG8_WAIT_L(0); PG8_BAR; PG8_MMA(0, 0, At, B0); PG8_MMA(0, 1, At, B1); PG8_BAR; PG8_SCHED;
            PG8_LDA(At, 1, 1); PG8_STAGE(PG8_SB(1, 0), b3, voffB); PG8_STAGE(PG8_SB(1, 1), b3 + hstep, voffB); PG8_STAGE(PG8_SA(1, 0), a3, voffA);
            PG8_WAIT_V(8); PG8_WAIT_L(0); PG8_BAR; PG8_MMA(1, 0, At, B0); PG8_MMA(1, 1, At, B1); PG8_BAR; PG8_SCHED;
            } else {
            PG8_LDB(B0, 0, 0); PG8_SCHED; PG8_LDA(At, 0, 0); PG8_STAGE(PG8_SA(1, 1), a1 + hstep, voffA);
            PG8_WAIT_L(8); PG8_BAR; PG8_WAIT_L(0); PG8_MMA(0, 0, At, B0); PG8_BAR; PG8_SCHED;
            PG8_LDB(B1, 0, 1); PG8_STAGE(PG8_SB(0, 0), b2, voffB);
            PG8_BAR; PG8_WAIT_L(0); PG8_MMA(0, 1, At, B1); PG8_BAR;
            PG8_LDA(At, 0, 1); PG8_STAGE(PG8_SA(0, 0), a2, voffA);
            PG8_BAR; PG8_WAIT_L(0); PG8_MMA(1, 0, At, B0); PG8_BAR; PG8_SCHED;
            PG8_STAGE(PG8_SB(0, 1), b2 + hstep, voffB);
            PG8_WAIT_V(6); PG8_BAR; PG8_MMA(1, 1, At, B1); PG8_BAR;
            PG8_LDB(B0, 1, 0); PG8_SCHED; PG8_LDA(At, 1, 0); PG8_STAGE(PG8_SA(0, 1), a2 + hstep, voffA);
            PG8_WAIT_L(8); PG8_BAR; PG8_WAIT_L(0); PG8_MMA(0, 0, At, B0); PG8_BAR; PG8_SCHED;
            PG8_LDB(B1, 1, 1); PG8_STAGE(PG8_SB(1, 0), b3, voffB);
            PG8_BAR; PG8_WAIT_L(0); PG8_MMA(0, 1, At, B1); PG8_BAR;
            PG8_LDA(At, 1, 1); PG8_STAGE(PG8_SA(1, 0), a3, voffA);
            PG8_BAR; PG8_WAIT_L(0); PG8_MMA(1, 0, At, B0); PG8_BAR; PG8_SCHED;
            PG8_STAGE(PG8_SB(1, 1), b3 + hstep, voffB);
            PG8_WAIT_V(6); PG8_BAR; PG8_MMA(1, 1, At, B1); PG8_BAR;
            }
        }
        if constexpr (ALIGN_EPI) { if (wr == 0) PG8_BAR; }
        if constexpr (!Epi::AFTER_DRAIN) { int l2_; asm volatile("v_mbcnt_lo_u32_b32 %0, -1, 0\n\tv_mbcnt_hi_u32_b32 %0, -1, %0" : "=v"(l2_)); E(acc, cur, wr, wc, l2_ & 15, l2_ >> 4); S.done(cur); }
        if (!has_next) break;
#pragma unroll
        for (int a = 0; a < 2; ++a)
#pragma unroll
            for (int b = 0; b < 2; ++b)
#pragma unroll
                for (int m = 0; m < 4; ++m)
#pragma unroll
                    for (int n = 0; n < 2; ++n) acc[a][b][m][n] = (f32x4){0.f, 0.f, 0.f, 0.f};
        cur = nxt; cA = nA; cB = nB; ++ui;
        if constexpr (ALIGN_EPI) { if (wr == 1) PG8_BAR; }
    }
    PG8_WAIT_V(0);
    if constexpr (!ALIGN_EPI) { if (wr == 0) PG8_BAR; }
    PG8_BAR;
    if constexpr (Epi::AFTER_DRAIN) { E.fused(acc, cur, wr, wc, fr, fq, lds, wid, lane); S.done(cur); }
#undef PG8_SA
#undef PG8_SB
#undef PG8_STAGE
#undef PG8_LDA
#undef PG8_LDB
#undef PG8_MMA
#undef PG8_WAIT_V
#undef PG8_WAIT_L
#undef PG8_BAR
#undef PG8_SCHED
}
}

namespace pg8 {
typedef float f32x2 __attribute__((ext_vector_type(2)));
__device__ __forceinline__ float shx(float v, int lane, int mask) { return __int_as_float(__builtin_amdgcn_ds_bpermute((lane ^ mask) << 2, __float_as_int(v))); }
__device__ __forceinline__ float rstd16(const float* ssp, int row, int fq, int lane) {
    const f32x4 v = *(const f32x4*)(ssp + (size_t)row * 16 + 4 * fq);
    float s = (v[0] + v[1]) + (v[2] + v[3]);
    s += shx(s, lane, 16); s += shx(s, lane, 32);
    return rsqrtf(s * (1.0f / 1024.0f) + 1e-6f);
}
__device__ __forceinline__ float sigm(float v) { return __builtin_amdgcn_rcpf(1.0f + __builtin_amdgcn_exp2f(-1.4426950408889634f * v)); }
__device__ __forceinline__ u32x4 pack8(const f32x4& a, const f32x4& b) { u32x4 w; w.x = cvt_pk_bf16(a[0], a[1]); w.y = cvt_pk_bf16(a[2], a[3]); w.z = cvt_pk_bf16(b[0], b[1]); w.w = cvt_pk_bf16(b[2], b[3]); return w; }
__device__ __forceinline__ float bflo(unsigned w) { return __uint_as_float(w << 16); }
__device__ __forceinline__ float bfhi(unsigned w) { return __uint_as_float(w & 0xffff0000u); }

struct EpiSwiglu {
    static constexpr bool PERM = true, AFTER_DRAIN = false;
    bf16_t* act; const float* ssp;
    __device__ __forceinline__ void operator()(const f32x4 (&acc)[2][2][4][2], const Unit& u, int wr, int wc, int fr, int fq) const {
        const int lane = fr + 16 * fq;
        const int row0 = u.pm * BM + wr * 64 + fr, col0 = u.pn * 128 + wc * 32 + 8 * fq;
#pragma unroll
        for (int ai = 0; ai < 2; ++ai)
#pragma unroll
            for (int m = 0; m < 4; ++m) { const int row = row0 + ai * HALF + m * 16; const float rs = rstd16(ssp, row, fq, lane);
                f32x4 o[2];
#pragma unroll
                for (int n = 0; n < 2; ++n)
#pragma unroll
                    for (int j = 0; j < 4; ++j) { const float g = acc[ai][0][m][n][j] * rs, up = acc[ai][1][m][n][j] * rs; o[n][j] = g * sigm(g) * up; }
                *(u32x4*)(act + (size_t)row * 2816 + col0) = pack8(o[0], o[1]); }
    }
};
struct EpiResid {
    static constexpr bool PERM = true, AFTER_DRAIN = false;
    const float* xin; float* xout; bf16_t* xb; float* sspw; float coef;
    __device__ __forceinline__ void operator()(const f32x4 (&acc)[2][2][4][2], const Unit& u, int wr, int wc, int fr, int fq) const {
        const int lane = fr + 16 * fq;
        float cf = __uint_as_float(__builtin_amdgcn_readfirstlane(__float_as_uint(coef))); asm volatile("" : "+s"(cf));
        const int row0 = u.pm * BM + wr * 64 + fr, col0 = u.pn * BM + wc * 32 + 8 * fq;
#pragma unroll
        for (int ai = 0; ai < 2; ++ai)
#pragma unroll
            for (int mh = 0; mh < 2; ++mh) {
            f32x4 xo[2][2][2];
#pragma unroll
            for (int mm = 0; mm < 2; ++mm)
#pragma unroll
                for (int bj = 0; bj < 2; ++bj) { const size_t off = (size_t)(row0 + ai * HALF + (2 * mh + mm) * 16) * 1024 + col0 + bj * HALF; xo[mm][bj][0] = *(const f32x4*)(xin + off); xo[mm][bj][1] = *(const f32x4*)(xin + off + 4); }
            asm volatile("" ::: "memory");
#pragma unroll
            for (int mm = 0; mm < 2; ++mm) { const int m = 2 * mh + mm, row = row0 + ai * HALF + m * 16; float ss = 0.f;
#pragma unroll
                for (int bj = 0; bj < 2; ++bj) { const size_t off = (size_t)row * 1024 + col0 + bj * HALF;
                    const f32x4 x0 = xo[mm][bj][0] + acc[ai][bj][m][0] * cf, x1 = xo[mm][bj][1] + acc[ai][bj][m][1] * cf;
                    *(f32x4*)(xout + off) = x0; *(f32x4*)(xout + off + 4) = x1;
                    *(u32x4*)(xb + off) = pack8(x0, x1);
                    ss += (x0[0] * x0[0] + x0[1] * x0[1]) + (x0[2] * x0[2] + x0[3] * x0[3]) + (x1[0] * x1[0] + x1[1] * x1[1]) + (x1[2] * x1[2] + x1[3] * x1[3]); }
                ss += shx(ss, lane, 16); ss += shx(ss, lane, 32);
                if (fq == 0) sspw[(size_t)row * 16 + u.pn * 4 + wc] = ss; }
            asm volatile("" ::: "memory");
        }
    }
};
struct EpiGate {
    static constexpr bool PERM = true, AFTER_DRAIN = false;
    const float* xin; float* xout; bf16_t* xb; float* sspw; const float* sspr; const bf16_t* proj; float coef;
    __device__ __forceinline__ void operator()(const f32x4 (&acc)[2][2][4][2], const Unit& u, int wr, int wc, int fr, int fq) const {
        const int lane = fr + 16 * fq;
        float cf = __uint_as_float(__builtin_amdgcn_readfirstlane(__float_as_uint(coef))); asm volatile("" : "+s"(cf));
        const int row0 = u.pm * BM + wr * 64 + fr, col0 = u.pn * BM + wc * 32 + 8 * fq;
#pragma unroll
        for (int ai = 0; ai < 2; ++ai)
#pragma unroll
            for (int mh = 0; mh < 2; ++mh) {
                f32x4 xo[2][2][2]; u32x4 pw[2][2]; float rs[2];
#pragma unroll
                for (int mm = 0; mm < 2; ++mm) { const int row = row0 + ai * HALF + (2 * mh + mm) * 16; rs[mm] = rstd16(sspr, row, fq, lane);
#pragma unroll
                    for (int bj = 0; bj < 2; ++bj) { const size_t off = (size_t)row * 1024 + col0 + bj * HALF; xo[mm][bj][0] = *(const f32x4*)(xin + off); xo[mm][bj][1] = *(const f32x4*)(xin + off + 4); pw[mm][bj] = *(const u32x4*)(proj + off); } }
                asm volatile("" ::: "memory");
#pragma unroll
                for (int mm = 0; mm < 2; ++mm) { const int m = 2 * mh + mm, row = row0 + ai * HALF + m * 16; float ss = 0.f;
#pragma unroll
                    for (int bj = 0; bj < 2; ++bj) { const size_t off = (size_t)row * 1024 + col0 + bj * HALF;
                        f32x4 x0 = xo[mm][bj][0], x1 = xo[mm][bj][1]; const u32x4 pq = pw[mm][bj];
                        const f32x4 p0 = {bflo(pq.x), bfhi(pq.x), bflo(pq.y), bfhi(pq.y)}, p1 = {bflo(pq.z), bfhi(pq.z), bflo(pq.w), bfhi(pq.w)};
#pragma unroll
                        for (int j = 0; j < 4; ++j) { x0[j] += cf * (sigm(acc[ai][bj][m][0][j] * rs[mm]) * p0[j]); x1[j] += cf * (sigm(acc[ai][bj][m][1][j] * rs[mm]) * p1[j]); }
                        *(f32x4*)(xout + off) = x0; *(f32x4*)(xout + off + 4) = x1;
                        *(u32x4*)(xb + off) = pack8(x0, x1);
                        ss += (x0[0] * x0[0] + x0[1] * x0[1]) + (x0[2] * x0[2] + x0[3] * x0[3]) + (x1[0] * x1[0] + x1[1] * x1[1]) + (x1[2] * x1[2] + x1[3] * x1[3]); }
                    ss += shx(ss, lane, 16); ss += shx(ss, lane, 32);
                    if (fq == 0) sspw[(size_t)row * 16 + u.pn * 4 + wc] = ss; }
                asm volatile("" ::: "memory");
            }
    }
};
struct EpiStoreBf16 {
    static constexpr bool PERM = true, AFTER_DRAIN = false;
    bf16_t* O; int ldc;
    __device__ __forceinline__ void operator()(const f32x4 (&acc)[2][2][4][2], const Unit& u, int wr, int wc, int fr, int fq) const {
        const int lane = fr + 16 * fq;
        const int row0 = u.pm * BM + wr * 64 + fr, col0 = u.pn * BM + wc * 32 + 8 * fq;
#pragma unroll
        for (int ai = 0; ai < 2; ++ai)
#pragma unroll
            for (int m = 0; m < 4; ++m) { const int row = row0 + ai * HALF + m * 16;
#pragma unroll
                for (int bj = 0; bj < 2; ++bj) *(u32x4*)(O + (size_t)row * ldc + col0 + bj * HALF) = pack8(acc[ai][bj][m][0], acc[ai][bj][m][1]); }
    }
};
struct EpiQkv {
    static constexpr bool PERM = true, AFTER_DRAIN = false;
    const float* ssp; bf16_t *qa, *ka, *va, *qb, *kb, *vb; const float *qna, *kna, *qnb, *knb;
    __device__ __forceinline__ void operator()(const f32x4 (&acc)[2][2][4][2], const Unit& u, int wr, int wc, int fr, int fq) const {
        const int lane = fr + 16 * fq;
        const int t = u.pn; bf16_t* dst; const float* ng; int nh, h; float sc = 1.0f;
        if (t < 2) { dst = qa; ng = qna; nh = 8; h = 4 * t + wc; sc = QSCALE; }
        else if (t < 4) { dst = ka; ng = kna; nh = 8; h = 4 * (t - 2) + wc; }
        else if (t < 6) { dst = va; ng = nullptr; nh = 8; h = 4 * (t - 4) + wc; }
        else if (t < 8) { dst = qb; ng = qnb; nh = 8; h = 4 * (t - 6) + wc; sc = QSCALE; }
        else if (wc < 2) { dst = kb; ng = knb; nh = 2; h = wc; }
        else { dst = vb; ng = nullptr; nh = 2; h = wc - 2; }
        f32x4 gv[2][2];
#pragma unroll
        for (int bj = 0; bj < 2; ++bj)
#pragma unroll
            for (int n = 0; n < 2; ++n) { if (ng) gv[bj][n] = *(const f32x4*)(ng + 32 * bj + 8 * fq + 4 * n) * sc; else gv[bj][n] = (f32x4){1.f, 1.f, 1.f, 1.f}; }
        const int row0 = u.pm * BM + wr * 64 + fr;
#pragma unroll
        for (int ai = 0; ai < 2; ++ai)
#pragma unroll
            for (int m = 0; m < 4; ++m) { const int row = row0 + ai * HALF + m * 16; const float rs = rstd16(ssp, row, fq, lane);
                f32x4 v[2][2]; float ss = 0.f;
#pragma unroll
                for (int bj = 0; bj < 2; ++bj)
#pragma unroll
                    for (int n = 0; n < 2; ++n) { v[bj][n] = acc[ai][bj][m][n] * rs; ss += (v[bj][n][0] * v[bj][n][0] + v[bj][n][1] * v[bj][n][1]) + (v[bj][n][2] * v[bj][n][2] + v[bj][n][3] * v[bj][n][3]); }
                ss += shx(ss, lane, 16); ss += shx(ss, lane, 32);
                const float hr = ng ? rsqrtf(ss * (1.0f / 64.0f) + 1e-6f) : 1.0f;
                const int b = row >> 12, s = row & 4095;
                bf16_t* p = dst + (((size_t)b * nh + h) * 4096 + s) * 64 + 8 * fq;
#pragma unroll
                for (int bj = 0; bj < 2; ++bj) *(u32x4*)(p + 32 * bj) = pack8(v[bj][0] * hr * gv[bj][0], v[bj][1] * hr * gv[bj][1]); }
    }
};
}

#include <hip/hip_cooperative_groups.h>
namespace cg = cooperative_groups;
#define LAS __attribute__((address_space(3)))
typedef unsigned v4u __attribute__((ext_vector_type(4)));
constexpr int NWAVES = 8, RING_BYTES = 131072, LDS_BYTES = 147456;
constexpr int NPHASE = 1 + 8 * DEPTH;
constexpr size_t WO_F1IN = 0, WO_F1OUT = WO_F1IN + (size_t)2 * DFF * D, WO_QKV = WO_F1OUT + (size_t)D * DFF, WO_WO = WO_QKV + (size_t)QKVW * D,
                 WO_F2IN = WO_WO + (size_t)D * D, WO_F2OUT = WO_F2IN + (size_t)2 * DFF * D, WO_WG = WO_F2OUT + (size_t)D * DFF, WO_WP = WO_WG + (size_t)D * D, W_LAYER = WO_WP + (size_t)D * PLE;
static_assert(W_LAYER * 2 * DEPTH <= 84 * MiB, "weights fit");

struct Args { const float* in[20]; float* out; unsigned char* ws; int ph_lo, ph_hi; };

__device__ __forceinline__ int src_col(int kind, int n0) {
    if (kind == 0) return n0;
    if (kind == 1) return ((n0 >> 7) & 1) * DFF + 128 * (n0 >> 8) + (n0 & 127);
    return 256 * (n0 >> 8) + 64 * ((n0 >> 5) & 3) + 32 * ((n0 >> 7) & 1);
}
__device__ __forceinline__ void transpose_item(const float* W, int K, int N, const float* gain, bf16_t* Bt, int kind, int item, LAS float* scr, int lane) {
    const int kblocks = K / 64, nb = item / kblocks, kb = item % kblocks, k0 = 64 * kb, n0 = 64 * nb;
    const int cseg = lane & 15, r0 = lane >> 4;
    const int c0 = src_col(kind, n0 + 32 * (cseg >> 3)) + 4 * (cseg & 7);
    float4 v[16];
#pragma unroll
    for (int i = 0; i < 16; ++i) v[i] = *(const float4*)(W + (size_t)(k0 + r0 + 4 * i) * N + c0);
    if (gain) {
#pragma unroll
        for (int i = 0; i < 16; ++i) { const float g = gain[k0 + r0 + 4 * i]; v[i].x *= g; v[i].y *= g; v[i].z *= g; v[i].w *= g; }
    }
#pragma unroll
    for (int i = 0; i < 16; ++i) { LAS float* p = scr + (r0 + 4 * i) * 65 + 4 * cseg; p[0] = v[i].x; p[1] = v[i].y; p[2] = v[i].z; p[3] = v[i].w; }
    asm volatile("s_waitcnt lgkmcnt(0)" ::: "memory");
    const int c = lane & 7;
#pragma unroll
    for (int j = 0; j < 8; ++j) { const int n = (lane >> 3) + 8 * j; const LAS float* sp = scr + (8 * c) * 65 + n;
        v4u o; o.x = pg8::cvt_pk_bf16(sp[0 * 65], sp[1 * 65]); o.y = pg8::cvt_pk_bf16(sp[2 * 65], sp[3 * 65]); o.z = pg8::cvt_pk_bf16(sp[4 * 65], sp[5 * 65]); o.w = pg8::cvt_pk_bf16(sp[6 * 65], sp[7 * 65]);
        *(v4u*)(Bt + (size_t)(n0 + n) * K + k0 + 8 * c) = o; }
    asm volatile("s_waitcnt lgkmcnt(0)" ::: "memory");
}

template <class AT> __device__ __forceinline__ void prologue_phase(const AT& a, LAS unsigned char* lds, int gw, int NGW, int wave, int lane) {
    LAS float* scr = (LAS float*)(lds + wave * 16640);
    bf16_t* wbase = (bf16_t*)(a.ws() + WS_W);
    constexpr int I_FIN = (D / 64) * (2 * DFF / 64), I_FOUT = (DFF / 64) * (D / 64), I_QKV = (D / 64) * (QKVW / 64), I_SQ = (D / 64) * (D / 64), I_WP = (PLE / 64) * (D / 64);
    constexpr int I_LAYER = 2 * I_FIN + 2 * I_FOUT + I_QKV + 2 * I_SQ + I_WP;
    for (int it = gw; it < DEPTH * I_LAYER; it += NGW) {
        const int l = it / I_LAYER; int r = it % I_LAYER; bf16_t* wl = wbase + (size_t)l * W_LAYER;
        if (r < I_FIN) { transpose_item(a.in(4) + (size_t)l * D * 2 * DFF, D, 2 * DFF, a.in(3) + l * D, wl + WO_F1IN, 1, r, scr, lane); continue; } r -= I_FIN;
        if (r < I_FOUT) { transpose_item(a.in(5) + (size_t)l * DFF * D, DFF, D, nullptr, wl + WO_F1OUT, 0, r, scr, lane); continue; } r -= I_FOUT;
        if (r < I_QKV) { transpose_item(a.in(7) + (size_t)l * D * QKVW, D, QKVW, a.in(6) + l * D, wl + WO_QKV, 2, r, scr, lane); continue; } r -= I_QKV;
        if (r < I_SQ) { transpose_item(a.in(13) + (size_t)l * D * D, D, D, nullptr, wl + WO_WO, 0, r, scr, lane); continue; } r -= I_SQ;
        if (r < I_FIN) { transpose_item(a.in(15) + (size_t)l * D * 2 * DFF, D, 2 * DFF, a.in(14) + l * D, wl + WO_F2IN, 1, r, scr, lane); continue; } r -= I_FIN;
        if (r < I_FOUT) { transpose_item(a.in(16) + (size_t)l * DFF * D, DFF, D, nullptr, wl + WO_F2OUT, 0, r, scr, lane); continue; } r -= I_FOUT;
        if (r < I_SQ) { transpose_item(a.in(18) + (size_t)l * D * D, D, D, a.in(17) + l * D, wl + WO_WG, 0, r, scr, lane); continue; } r -= I_SQ;
        transpose_item(a.in(19) + (size_t)l * PLE * D, PLE, D, nullptr, wl + WO_WP, 0, r, scr, lane);
    }
    const float* x = a.in(0); bf16_t* xb = (bf16_t*)(a.ws() + WS_XB); float* ssp = (float*)(a.ws() + WS_SSP);
    for (int row = gw; row < M; row += 2 * NGW) {
        const int row2 = row + NGW; const bool has2 = row2 < M;
        const float4* xr = (const float4*)(x + (size_t)row * D); const float4* xr2 = (const float4*)(x + (size_t)(has2 ? row2 : row) * D);
        float4 va[4], vb[4];
#pragma unroll
        for (int j = 0; j < 4; ++j) { va[j] = xr[lane + 64 * j]; vb[j] = xr2[lane + 64 * j]; }
        float s = 0.f, s2 = 0.f;
#pragma unroll
        for (int j = 0; j < 4; ++j) { s += va[j].x * va[j].x + va[j].y * va[j].y + va[j].z * va[j].z + va[j].w * va[j].w; s2 += vb[j].x * vb[j].x + vb[j].y * vb[j].y + vb[j].z * vb[j].z + vb[j].w * vb[j].w;
            uint2 o; o.x = pg8::cvt_pk_bf16(va[j].x, va[j].y); o.y = pg8::cvt_pk_bf16(va[j].z, va[j].w); ((uint2*)(xb + (size_t)row * D))[lane + 64 * j] = o;
            if (has2) { uint2 o2; o2.x = pg8::cvt_pk_bf16(vb[j].x, vb[j].y); o2.y = pg8::cvt_pk_bf16(vb[j].z, vb[j].w); ((uint2*)(xb + (size_t)row2 * D))[lane + 64 * j] = o2; } }
#pragma unroll
        for (int o = 1; o < 64; o <<= 1) { s += pg8::shx(s, lane, o); s2 += pg8::shx(s2, lane, o); }
        if (lane < 4) { float4 r; r.x = lane == 0 ? s : 0.f; r.y = 0.f; r.z = 0.f; r.w = 0.f; ((float4*)ssp)[row * 4 + lane] = r;
            if (has2) { r.x = lane == 0 ? s2 : 0.f; ((float4*)ssp)[row2 * 4 + lane] = r; } }
    }
}
__device__ __forceinline__ void convert_p(const float* p, bf16_t* pb, int gtid, int nthreads) {
    for (int i = gtid; i < M * PLE / 8; i += nthreads) { const float4 v0 = ((const float4*)p)[2 * i], v1 = ((const float4*)p)[2 * i + 1];
        v4u o; o.x = pg8::cvt_pk_bf16(v0.x, v0.y); o.y = pg8::cvt_pk_bf16(v0.z, v0.w); o.z = pg8::cvt_pk_bf16(v1.x, v1.y); o.w = pg8::cvt_pk_bf16(v1.z, v1.w); ((v4u*)pb)[i] = o; }
}

__device__ __forceinline__ void attn_simple_phase(LAS unsigned char* lds, const AttnIn& a, int G, int wave, int lane) {
    LAS float* pl = (LAS float*)(lds + wave * 4096); LAS int* kl = (LAS int*)(lds + wave * 4096 + 2048);
    const int total = NB * 16 * S;
    for (int item = blockIdx.x * NWAVES + wave; item < total; item += G * NWAVES) {
        const int t = item & (S - 1), head = (item >> 12) & 15, b = item >> 16;
        const bool isA = head < 8;
        const bf16_t *q, *k, *v;
        if (isA) { q = a.qa + (((size_t)b * 8 + head) * S + t) * HD; k = a.ka + ((size_t)b * 8 + head) * S * HD; v = a.va + ((size_t)b * 8 + head) * S * HD; }
        else { const int hq = head - 8, hk = hq >> 2; q = a.qb + (((size_t)b * 8 + hq) * S + t) * HD; k = a.kb + ((size_t)b * 2 + hk) * S * HD; v = a.vb + ((size_t)b * 2 + hk) * S * HD; }
        float qf[HD];
#pragma unroll
        for (int e = 0; e < HD; ++e) qf[e] = bf2f(q[e]);
        const int nk = isA ? 387 : 257;
        float mx = -1e30f;
        for (int i = lane; i < nk; i += 64) {
            int rel;
            if (isA) { const int br = i / 129, j = i % 129 - 64; rel = j * (br == 0 ? 1 : br == 1 ? 4 : 16); } else rel = i - 128;
            const int tk = t + rel; float lg = -1e30f;
            if (tk >= 0 && tk < S) { float d = 0.f; const bf16_t* kr = k + (size_t)tk * HD;
#pragma unroll
                for (int e = 0; e < HD; ++e) d += qf[e] * bf2f(kr[e]);
                lg = d + a.rel_bias[t5_bucket(rel) * 16 + head] * LOG2E; }
            pl[i] = lg; kl[i] = tk; mx = fmaxf(mx, lg);
        }
#pragma unroll
        for (int o = 1; o < 64; o <<= 1) mx = fmaxf(mx, pg8::shx(mx, lane, o));
        float sinkl = 0.f;
        if (!isA) { sinkl = a.sink[head - 8] * LOG2E; mx = fmaxf(mx, sinkl); }
        float sum = 0.f;
        for (int i = lane; i < nk; i += 64) { const float lg = pl[i]; const float pv = lg > -1e29f ? exp2f(lg - mx) : 0.f; pl[i] = pv; sum += pv; }
#pragma unroll
        for (int o = 1; o < 64; o <<= 1) sum += pg8::shx(sum, lane, o);
        if (!isA) sum += exp2f(sinkl - mx);
        asm volatile("s_waitcnt lgkmcnt(0)" ::: "memory");
        float acc = 0.f;
        for (int i = 0; i < nk; ++i) { const float pv = pl[i]; if (pv != 0.f) acc += pv * bf2f(v[(size_t)kl[i] * HD + lane]); }
        a.o[((size_t)b * S + t) * D + head * HD + lane] = f2bf(acc / sum);
    }
}

namespace att {
typedef short bf16x8 __attribute__((ext_vector_type(8)));
typedef short s16x4 __attribute__((ext_vector_type(4)));
typedef short v4i16_t __attribute__((ext_vector_type(4)));
typedef float f32x16 __attribute__((ext_vector_type(16)));
typedef unsigned u32x4 __attribute__((ext_vector_type(4)));
typedef float f32x2_t __attribute__((ext_vector_type(2))); typedef __bf16 bf16x2_t __attribute__((ext_vector_type(2)));
constexpr float NEG = -1e30f;
constexpr int WAVE_LDS = 8704, LUT_OFF = 8 * WAVE_LDS, LUTA_STRIDE = 200, LUTB_STRIDE = 328, LUTB_OFF = LUT_OFF + 3 * LUTA_STRIDE * 4, TAB_OFF = LUT_OFF + 8192, LSE_OFF = TAB_OFF + 65536, ATT_LDS_END = LSE_OFF + 2048;
static_assert(LUTB_OFF + 4 * LUTB_STRIDE * 4 <= TAB_OFF && ATT_LDS_END <= 147456, "attention LDS map");
__device__ __forceinline__ int crow(int r, int hi) { return (r & 3) + 8 * (r >> 2) + 4 * hi; }
__device__ __forceinline__ unsigned cvtpk(float lo, float hi) { f32x2_t v = {lo, hi}; bf16x2_t b = __builtin_convertvector(v, bf16x2_t); return __builtin_bit_cast(unsigned, b); }
__device__ __forceinline__ s16x4 vtr(const LAS unsigned char* p) { return __builtin_bit_cast(s16x4, __builtin_amdgcn_ds_read_tr16_b64_v4i16((LAS v4i16_t*)p)); }
__device__ __forceinline__ float halfmax(float v) { auto rr = __builtin_amdgcn_permlane32_swap(__float_as_uint(v), __float_as_uint(v), false, false); return fmaxf(__uint_as_float(rr[0]), __uint_as_float(rr[1])); }
__device__ __forceinline__ float halfsum(float v) { auto rr = __builtin_amdgcn_permlane32_swap(__float_as_uint(v), __float_as_uint(v), false, false); return __uint_as_float(rr[0]) + __uint_as_float(rr[1]); }

template <int NT>
__device__ __forceinline__ void qtile(const bf16_t* qrow, const bf16_t* kbase, const bf16_t* vbase, int tk0, int dstep, const LAS float* lut, float m0, float l0,
                                      LAS unsigned char* wl, int lane, f32x16 (&o)[2], float& m_out, float& l_out) {
    const int i = lane & 31, hi = lane >> 5;
    LAS float* wsf = (LAS float*)(wl + 8192);
    constexpr int C = NT / 2;
    bf16x8 qf[4];
#pragma unroll
    for (int ks = 0; ks < 4; ++ks) qf[ks] = *(const bf16x8*)(qrow + 16 * ks + 8 * hi);
    const int vrow = lane >> 3, vch = lane & 7;
    const int wr_off = vrow * 128 + ((vch ^ (((lane >> 4) & 1) << 2)) * 16);
    const int rd_base = (4 * hi + ((lane & 15) >> 2)) * 128 + 32 * ((lane >> 4) & 1) + 8 * (lane & 3);
    const int bit3 = (lane >> 3) & 1;
    const int vb0 = rd_base + 64 * bit3, vb1 = rd_base + 64 * (1 - bit3);
    bf16x8 kf[4]; u32x4 vr[4];
#define ATT_LOAD(j) do { \
        { int tk = tk0 + (32 * (j) + i) * dstep; tk = tk < 0 ? 0 : (tk > S - 1 ? S - 1 : tk); const bf16_t* kp = kbase + (size_t)tk * HD + 8 * hi; \
          _Pragma("unroll") for (int ks = 0; ks < 4; ++ks) kf[ks] = *(const bf16x8*)(kp + 16 * ks); } \
        _Pragma("unroll") for (int i4 = 0; i4 < 4; ++i4) { int tk = tk0 + (32 * (j) + vrow + 8 * i4) * dstep; tk = tk < 0 ? 0 : (tk > S - 1 ? S - 1 : tk); \
          vr[i4] = *(const u32x4*)(vbase + (size_t)tk * HD + 8 * vch); } } while (0)
    float m = m0, l = hi == 0 ? l0 : 0.f;
    o[0] = f32x16{}; o[1] = f32x16{};
    ATT_LOAD(C);
#pragma unroll 1
    for (int s = 0; s < NT; ++s) {
        const int j = (s == 0) ? C : (s <= C ? s - 1 : s);
        LAS unsigned char* vbuf = wl + (s & 1) * 4096;
#pragma unroll
        for (int i4 = 0; i4 < 4; ++i4) *(LAS u32x4*)(vbuf + wr_off + i4 * 1024) = vr[i4];
        f32x16 p = __builtin_amdgcn_mfma_f32_32x32x16_bf16(kf[0], qf[0], f32x16{}, 0, 0, 0);
        p = __builtin_amdgcn_mfma_f32_32x32x16_bf16(kf[1], qf[1], p, 0, 0, 0);
        p = __builtin_amdgcn_mfma_f32_32x32x16_bf16(kf[2], qf[2], p, 0, 0, 0);
        p = __builtin_amdgcn_mfma_f32_32x32x16_bf16(kf[3], qf[3], p, 0, 0, 0);
        if (s + 1 < NT) { const int jn = (s + 1 <= C) ? s : s + 1; ATT_LOAD(jn); }
        const int first = tk0 + 32 * j * dstep, lastk = first + 31 * dstep;
        const bool inside = first >= 0 && lastk < S;
        const LAS float* lp = lut + 32 * j - i + 4 * hi;
#pragma unroll
        for (int r = 0; r < 16; ++r) { const int kk0 = (r & 3) + 8 * (r >> 2); p[r] += lp[kk0]; }
        if (j == 0) {
#pragma unroll
            for (int r = 0; r < 16; ++r) { if (crow(r, hi) < i) p[r] = NEG; }
        }
        if (j == NT - 1) {
#pragma unroll
            for (int r = 0; r < 16; ++r) { if (crow(r, hi) > i) p[r] = NEG; }
        }
        if (!inside) {
#pragma unroll
            for (int r = 0; r < 16; ++r) { const int tk = first + crow(r, hi) * dstep; if ((unsigned)tk >= (unsigned)S) p[r] = NEG; }
        }
        float rm = p[0];
#pragma unroll
        for (int r = 1; r < 16; ++r) rm = fmaxf(rm, p[r]);
        rm = halfmax(rm);
        if (__any(rm > m)) {
            const float mn = fmaxf(m, rm), alpha = __builtin_amdgcn_exp2f(m - mn);
            l *= alpha; m = mn;
            if (hi == 0) wsf[i] = alpha;
#pragma unroll
            for (int r = 0; r < 16; ++r) { const float a = wsf[crow(r, hi)]; o[0][r] *= a; o[1][r] *= a; }
        }
        float rs = 0.f;
#pragma unroll
        for (int r = 0; r < 16; ++r) { p[r] = __builtin_amdgcn_exp2f(p[r] - m); rs += p[r]; }
        l += rs;
        u32x4 pw0 = {cvtpk(p[0], p[1]), cvtpk(p[2], p[3]), cvtpk(p[4], p[5]), cvtpk(p[6], p[7])};
        u32x4 pw1 = {cvtpk(p[8], p[9]), cvtpk(p[10], p[11]), cvtpk(p[12], p[13]), cvtpk(p[14], p[15])};
        const bf16x8 pa0 = __builtin_bit_cast(bf16x8, pw0), pa1 = __builtin_bit_cast(bf16x8, pw1);
#pragma unroll
        for (int d0 = 0; d0 < 2; ++d0) {
            const LAS unsigned char* vp = vbuf + (d0 == 0 ? vb0 : vb1);
            const s16x4 a0 = vtr(vp), a1 = vtr(vp + 1024), b0 = vtr(vp + 2048), b1 = vtr(vp + 3072);
            const bf16x8 f0 = {a0[0], a0[1], a0[2], a0[3], a1[0], a1[1], a1[2], a1[3]}, f1 = {b0[0], b0[1], b0[2], b0[3], b1[0], b1[1], b1[2], b1[3]};
            o[d0] = __builtin_amdgcn_mfma_f32_32x32x16_bf16(pa0, f0, o[d0], 0, 0, 0);
            o[d0] = __builtin_amdgcn_mfma_f32_32x32x16_bf16(pa1, f1, o[d0], 0, 0, 0);
        }
    }
#undef ATT_LOAD
    m_out = m; l_out = halfsum(l);
}

__device__ __forceinline__ void stage_o(const f32x16 (&o)[2], float m, float l, LAS unsigned char* wl, int lane) {
    const int i = lane & 31, hi = lane >> 5;
    LAS float* wsf = (LAS float*)(wl + 8192);
    if (hi == 0) { wsf[i] = __builtin_amdgcn_rcpf(l); wsf[32 + i] = m + __builtin_amdgcn_logf(l); }
    LAS bf16_t* stg = (LAS bf16_t*)wl;
#pragma unroll
    for (int r = 0; r < 16; ++r) { const int q = crow(r, hi); const float inv = wsf[q];
        stg[q * 64 + i] = (bf16_t)(cvtpk(o[0][r] * inv, 0.f) & 0xffffu); stg[q * 64 + 32 + i] = (bf16_t)(cvtpk(o[1][r] * inv, 0.f) & 0xffffu); }
}
__device__ __forceinline__ float bflo(unsigned w) { return __uint_as_float(w << 16); }
__device__ __forceinline__ float bfhi(unsigned w) { return __uint_as_float(w & 0xffff0000u); }
__device__ __forceinline__ unsigned mix2(unsigned a, unsigned b, float wa, float wb) { return cvtpk(wa * bflo(a) + wb * bflo(b), wa * bfhi(a) + wb * bfhi(b)); }

struct Tensors { const bf16_t *qa, *ka, *va, *qb, *kb, *vb; const float* rel_bias; const float* sink; bf16_t* o; };

__device__ __forceinline__ int bucket(int rel) {
    const int n = rel < 0 ? -rel : rel; const int ret = rel > 0 ? 16 : 0;
    if (n < 8) return ret + n;
    int large = 8 + (int)(logf((float)n / 8.0f) / 4.852030263919617f * 8.0f);
    large = large < 15 ? large : 15;
    return ret + large;
}

__device__ __forceinline__ void attn_unit(const Tensors& T, int u, LAS unsigned char* lds, int wave, int lane) {
    LAS unsigned char* wl = lds + wave * WAVE_LDS;
    LAS float* wsf = (LAS float*)(wl + 8192);
    LAS float* lutA = (LAS float*)(lds + LUT_OFF); LAS float* lutB = (LAS float*)(lds + LUTB_OFF);
    LAS unsigned char* tab = lds + TAB_OFF; LAS float* lsetab = (LAS float*)(lds + LSE_OFF);
    const int tid = wave * 64 + lane;
    const int i = lane & 31;
    {
        const int bh = u >> 3, blk = u & 7, b = bh >> 3, h = bh & 7, t0 = blk * 512;
        const bf16_t* qbase = T.qa + (size_t)bh * S * HD; const bf16_t* kbase = T.ka + (size_t)bh * S * HD; const bf16_t* vbase = T.va + (size_t)bh * S * HD;
        __syncthreads();
        for (int e = tid; e < 3 * 129; e += 512) { const int c = e / 129, idx = e % 129, d = c == 0 ? 1 : (c == 1 ? 4 : 16);
            lutA[c * LUTA_STRIDE + 32 + idx] = T.rel_bias[bucket((idx - 64) * d) * 16 + h] * LOG2E; }
        __syncthreads();
#pragma unroll 1
        for (int pass = 0; pass < 3; ++pass) {
            const int c = 2 - pass, d = c == 0 ? 1 : (c == 1 ? 4 : 16);
#pragma unroll 1
            for (int tt = 0; tt < 2; ++tt) {
                const int Tq = 2 * wave + tt;
                int rr, beta;
                if (c == 2) { rr = Tq; beta = 0; } else if (c == 1) { rr = Tq >> 2; beta = Tq & 3; } else { rr = 0; beta = Tq; }
                const int lam0 = 32 * beta;
                const int tq = t0 + d * (lam0 + i) + rr, tk0 = t0 + d * (lam0 - 64) + rr;
                f32x16 o[2]; float m, l;
                qtile<5>(qbase + (size_t)tq * HD, kbase, vbase, tk0, d, lutA + c * LUTA_STRIDE + 32, NEG, 0.f, wl, lane, o, m, l);
                stage_o(o, m, l, wl, lane);
#pragma unroll
                for (int i4 = 0; i4 < 4; ++i4) {
                    const int qi = (lane >> 3) + 8 * i4, ch = lane & 7, tau = d * (lam0 + qi) + rr;
                    u32x4 v = *(const LAS u32x4*)(wl + qi * 128 + ch * 16);
                    const float Lb = wsf[32 + qi];
                    LAS u32x4* te = (LAS u32x4*)(tab + tau * 128 + ch * 16);
                    if (pass == 0) { *te = v; if (ch == 0) lsetab[tau] = Lb; }
                    else {
                        const u32x4 tv = *te; const float La = lsetab[tau];
                        const float Lm = fmaxf(La, Lb), sa = __builtin_amdgcn_exp2f(La - Lm), sb = __builtin_amdgcn_exp2f(Lb - Lm), tot = sa + sb, rt = __builtin_amdgcn_rcpf(tot), wa = sa * rt, wb = sb * rt;
                        u32x4 w; w.x = mix2(tv.x, v.x, wa, wb); w.y = mix2(tv.y, v.y, wa, wb); w.z = mix2(tv.z, v.z, wa, wb); w.w = mix2(tv.w, v.w, wa, wb);
                        if (pass == 1) { *te = w; if (ch == 0) lsetab[tau] = Lm + __builtin_amdgcn_logf(tot); }
                        else *(u32x4*)(T.o + ((size_t)b * S + t0 + tau) * D + h * HD + ch * 8) = w;
                    }
                }
            }
            __syncthreads();
        }
    }
    {
        const int bk = u >> 5, blk = u & 31, b = bk >> 1, hk = bk & 1, t0 = blk * 128;
        const bf16_t* kbase = T.kb + (size_t)bk * S * HD; const bf16_t* vbase = T.vb + (size_t)bk * S * HD;
        for (int e = tid; e < 4 * 257; e += 512) { const int g = e / 257, idx = e % 257;
            lutB[g * LUTB_STRIDE + 32 + idx] = T.rel_bias[bucket(idx - 128) * 16 + 8 + 4 * hk + g] * LOG2E; }
        __syncthreads();
        const int qt = wave & 3;
#pragma unroll 1
        for (int gg = 0; gg < 2; ++gg) {
            const int g = 2 * (wave >> 2) + gg, hq = 4 * hk + g;
            const bf16_t* qbase = T.qb + ((size_t)b * 8 + hq) * S * HD;
            const int tq = t0 + 32 * qt + i, tk0 = t0 + 32 * qt - 128;
            f32x16 o[2]; float m, l;
            qtile<9>(qbase + (size_t)tq * HD, kbase, vbase, tk0, 1, lutB + g * LUTB_STRIDE + 32, T.sink[hq] * LOG2E, 1.0f, wl, lane, o, m, l);
            stage_o(o, m, l, wl, lane);
#pragma unroll
            for (int i4 = 0; i4 < 4; ++i4) { const int qi = (lane >> 3) + 8 * i4, ch = lane & 7;
                const u32x4 v = *(const LAS u32x4*)(wl + qi * 128 + ch * 16);
                *(u32x4*)(T.o + ((size_t)b * S + t0 + 32 * qt + qi) * D + (8 + hq) * HD + ch * 8) = v; }
        }
    }
}
}

#define XB_TMO      128
#define XB_XCNT(j)  (256  + 64 * (j))
#define XB_XSUB(j)  (1280 + 64 * (j))
#define XB_XGEN(j)  (2304 + 64 * (j))
#define XB_TOP      3328
#define XB_TOPGEN   3392
#define XCD_BAR_WORDS 3456
#define XB_SPIN_CAP (1u << 18)

__device__ __forceinline__ unsigned xb_ld(unsigned* p)              { return __hip_atomic_load(p, __ATOMIC_RELAXED, __HIP_MEMORY_SCOPE_AGENT); }
__device__ __forceinline__ unsigned xb_add(unsigned* p, unsigned v) { return __hip_atomic_fetch_add(p, v, __ATOMIC_RELAXED, __HIP_MEMORY_SCOPE_AGENT); }
__device__ __forceinline__ unsigned xb_xcc_id() { return (unsigned)__builtin_amdgcn_s_getreg((3 << 11) | 20) & 0xFu; }
#define XB_SPIN(cond, bar) do { unsigned _sp = 0; while (cond) { __builtin_amdgcn_s_sleep(1); \
    if ((++_sp & 255u) == 0u) { if (xb_ld(&(bar)[XB_TMO])) break; if (_sp > XB_SPIN_CAP) { atomicAdd(&(bar)[XB_TMO], 1u); break; } } } } while (0)

struct XcdBarrier {
    unsigned* bar; unsigned x;
    volatile LAS unsigned* st;
};

__device__ __forceinline__ XcdBarrier xcd_barrier_post(unsigned* bar, volatile LAS unsigned* st) {
    XcdBarrier b; b.bar = bar; b.x = xb_xcc_id(); b.st = st;
    if (threadIdx.x == 0) (void)xb_add(&bar[XB_XCNT(b.x)], 1u);
    return b;
}
__device__ __forceinline__ void xcd_barrier_complete(unsigned* bar, unsigned x, unsigned& nloc, unsigned& nx) {
    const unsigned G = gridDim.x * gridDim.y * gridDim.z;
    unsigned sum, cnt, mine, sp = 0u;
    for (;;) {
        sum = 0u; cnt = 0u; mine = 0u;
#pragma unroll
        for (unsigned j = 0; j < 16; ++j) { const unsigned c = xb_ld(&bar[XB_XCNT(j)]); sum += c; cnt += (c > 0u) ? 1u : 0u; mine = (j == x) ? c : mine; }
        if (sum == G) break;
        __builtin_amdgcn_s_sleep(1);
        if ((++sp & 255u) == 0u) { if (xb_ld(&bar[XB_TMO])) break; if (sp > XB_SPIN_CAP) { atomicAdd(&bar[XB_TMO], 1u); break; } }
    }
    nloc = mine > 0u ? mine : 1u; nx = cnt > 0u ? cnt : 1u;
}

__device__ __forceinline__ void xcd_barrier(const XcdBarrier& b) {
    asm volatile("s_waitcnt vmcnt(0)" ::: "memory");
    __syncthreads();
    if (threadIdx.x == 0) {
        unsigned* bar = b.bar;
        __builtin_amdgcn_s_waitcnt(0);
        unsigned nloc = b.st[0], nx = b.st[1];
        if (nloc == 0u) { xcd_barrier_complete(bar, b.x, nloc, nx); b.st[0] = nloc; b.st[1] = nx; }
        const unsigned old = xb_add(&bar[XB_XSUB(b.x)], 1u);
        const unsigned gen = old / nloc;
        if (old + 1u == (gen + 1u) * nloc) {
            __builtin_amdgcn_fence(__ATOMIC_RELEASE, "agent");
            asm volatile("s_waitcnt vmcnt(0)" ::: "memory");
            const unsigned og = xb_add(&bar[XB_TOP], 1u);
            const unsigned tg = og / nx;
            if (og + 1u == (tg + 1u) * nx) xb_add(&bar[XB_TOPGEN], 1u);
            else XB_SPIN(xb_ld(&bar[XB_TOPGEN]) == tg, bar);
            __builtin_amdgcn_fence(__ATOMIC_ACQUIRE, "agent");
            xb_add(&bar[XB_XGEN(b.x)], 1u);
            asm volatile("s_waitcnt vmcnt(0)" ::: "memory");
        } else {
            XB_SPIN(xb_ld(&bar[XB_XGEN(b.x)]) == gen, bar);
            __builtin_amdgcn_fence(__ATOMIC_ACQUIRE, "agent");
            asm volatile("s_waitcnt vmcnt(0)" ::: "memory");
        }
    }
    __syncthreads();
}
typedef const float* cfptr_t; typedef float* fptr_t; typedef unsigned char* ucptr_t;
typedef __attribute__((address_space(4))) const unsigned char* kargp_t;
struct KA {
    kargp_t kp;
    __device__ __forceinline__ const float* in(int i) const { return *(__attribute__((address_space(4))) const cfptr_t*)(kp + 8 * i); }
    __device__ __forceinline__ float* out() const { return *(__attribute__((address_space(4))) const fptr_t*)(kp + 160); }
    __device__ __forceinline__ unsigned char* ws() const { return *(__attribute__((address_space(4))) const ucptr_t*)(kp + 168); }
    __device__ __forceinline__ int ph_lo() const { return *(__attribute__((address_space(4))) const int*)(kp + 176); }
    __device__ __forceinline__ int ph_hi() const { return *(__attribute__((address_space(4))) const int*)(kp + 180); }
};
static_assert(sizeof(Args) == 184, "Args layout");
#define FRESH_LANE() ({ int l_; asm volatile("v_mbcnt_lo_u32_b32 %0, -1, 0\n\tv_mbcnt_hi_u32_b32 %0, -1, %0" : "=v"(l_)); l_; })
template <int PH>
__device__ __forceinline__ void run_phase(const KA& a, LAS unsigned char* lds, const int wave0, const int rep) {
    const int G = gridDim.x, bx = blockIdx.x, wave = wave0;
    const int vcu = (G % 8 == 0) ? (bx % 8) * (G / 8) + bx / 8 : bx;
    const int gw = vcu * NWAVES + wave, NGW = G * NWAVES;
    unsigned char* ws = a.ws();
    bf16_t* xb = (bf16_t*)(ws + WS_XB); float* ssp0 = (float*)(ws + WS_SSP); float* ssp1 = ssp0 + (size_t)M * 16;
    bf16_t* xb2 = (bf16_t*)(ws + WS_W);
    bf16_t* act = (bf16_t*)(ws + WS_R + R_ACT); bf16_t* ob = (bf16_t*)(ws + WS_R + R_O);
    bf16_t* pb = (bf16_t*)(ws + WS_PB); bf16_t* proj = (bf16_t*)(ws + WS_PROJ);
    const float cscale = rep == 0 ? 1.0f : 0.0f;
    if constexpr (PH == 0) {
        prologue_phase(a, lds, gw, NGW, wave, FRESH_LANE());
        convert_p(a.in(1), pb, bx * NWAVES * 64 + wave0 * 64 + FRESH_LANE(), G * NWAVES * 64);
    } else {
        constexpr int l = (PH - 1) >> 3, k = (PH - 1) & 7;
        const bf16_t* wl = (const bf16_t*)(ws + WS_W) + (size_t)l * W_LAYER;
        const float* xin = (l == 0 && k <= 1 && rep == 0) ? a.in(0) : a.out();
        if constexpr (k == 0 || k == 5) {
            pg8::Gemm g{(k == 0 && l == 1) ? xb2 : xb, wl + (k == 0 ? WO_F1IN : WO_F2IN), M, 2 * DFF, D}; pg8::StaticOrder S; S.init(M, 2 * DFF, G, bx);
            pg8::EpiSwiglu E{act, ssp0};
            pg8::gemm_phase<pg8::EpiSwiglu, pg8::StaticOrder, true, true>(lds, g, S, E, wave0 * 64 + FRESH_LANE());
        } else if constexpr (k == 1 || k == 6) {
            pg8::Gemm g{act, wl + (k == 1 ? WO_F1OUT : WO_F2OUT), M, D, DFF}; pg8::StaticOrder S; S.init(M, D, G, bx);
            pg8::EpiResid E{xin, a.out(), xb, ssp1, 0.5f * cscale};
            pg8::gemm_phase<pg8::EpiResid, pg8::StaticOrder, true, true>(lds, g, S, E, wave0 * 64 + FRESH_LANE());
        } else if constexpr (k == 2) {
            { pg8::Gemm g{xb, wl + WO_QKV, M, QKVW, D}; pg8::StaticOrder S; S.init(M, QKVW, G, bx);
              pg8::EpiQkv E; E.ssp = ssp1;
              E.qa = (bf16_t*)(ws + WS_R + R_QA); E.ka = (bf16_t*)(ws + WS_R + R_KA); E.va = (bf16_t*)(ws + WS_R + R_VA);
              E.qb = (bf16_t*)(ws + WS_R + R_QB); E.kb = (bf16_t*)(ws + WS_R + R_KB); E.vb = (bf16_t*)(ws + WS_R + R_VB);
              E.qna = a.in(8) + l * HD; E.kna = a.in(9) + l * HD; E.qnb = a.in(10) + l * HD; E.knb = a.in(11) + l * HD;
              pg8::gemm_phase<pg8::EpiQkv, pg8::StaticOrder, true, true>(lds, g, S, E, wave0 * 64 + FRESH_LANE()); }
            { pg8::Gemm g{pb, wl + WO_WP, M, D, PLE}; pg8::StaticOrder S; S.init(M, D, G, bx);
              pg8::EpiStoreBf16 E{proj, D};
              pg8::gemm_phase<pg8::EpiStoreBf16, pg8::StaticOrder, true, true>(lds, g, S, E, wave0 * 64 + FRESH_LANE()); }
        } else if constexpr (k == 3) {
            att::Tensors T; T.qa = (bf16_t*)(ws + WS_R + R_QA); T.ka = (bf16_t*)(ws + WS_R + R_KA); T.va = (bf16_t*)(ws + WS_R + R_VA);
            T.qb = (bf16_t*)(ws + WS_R + R_QB); T.kb = (bf16_t*)(ws + WS_R + R_KB); T.vb = (bf16_t*)(ws + WS_R + R_VB);
            T.rel_bias = a.in(2); T.sink = a.in(12) + l * 8; T.o = ob;
            const int lane = FRESH_LANE();
            for (int u = vcu; u < 256; u += G) att::attn_unit(T, u, lds, wave, lane);
        } else if constexpr (k == 4) {
            if (l + 1 < DEPTH) { convert_p(a.in(1) + (size_t)(l + 1) * M * PLE, pb, bx * NWAVES * 64 + wave0 * 64 + FRESH_LANE(), G * NWAVES * 64); asm volatile("s_waitcnt vmcnt(0)" ::: "memory"); }
            pg8::Gemm g{ob, wl + WO_WO, M, D, D}; pg8::StaticOrder S; S.init(M, D, G, bx);
            pg8::EpiResid E{xin, a.out(), xb, ssp0, 1.0f * cscale};
            pg8::gemm_phase<pg8::EpiResid, pg8::StaticOrder, true, true>(lds, g, S, E, wave0 * 64 + FRESH_LANE());
        } else {
            pg8::Gemm g{xb, wl + WO_WG, M, D, D}; pg8::StaticOrder S; S.init(M, D, G, bx);
            pg8::EpiGate E{xin, a.out(), xb2, ssp0, ssp1, proj, cscale};
            pg8::gemm_phase<pg8::EpiGate, pg8::StaticOrder, true, true>(lds, g, S, E, wave0 * 64 + FRESH_LANE());
        }
    }
}

__global__ void __launch_bounds__(NWAVES * 64, 2) mk_fwd(Args) {
    extern __shared__ __attribute__((aligned(16))) unsigned char lds_raw[];
    LAS unsigned char* lds = (LAS unsigned char*)lds_raw;
    cg::grid_group grid = cg::this_grid();
    const int wave0 = __builtin_amdgcn_readfirstlane(threadIdx.x >> 6);
    volatile LAS unsigned* bst = (volatile LAS unsigned*)((LAS unsigned char*)lds_raw + LDS_BYTES - 64);
    if (threadIdx.x < 2) bst[threadIdx.x] = 0u;
    __syncthreads();
    KA a; a.kp = (kargp_t)__builtin_amdgcn_kernarg_segment_ptr();
    const int ph_lo = a.ph_lo(), ph_hi = a.ph_hi();
    XcdBarrier xbar; xbar.bar = (unsigned*)(a.ws() + WS_CTL) + 4096; xbar.x = 0; xbar.st = bst;
    if (ph_hi - ph_lo > 1) xbar = xcd_barrier_post((unsigned*)(a.ws() + WS_CTL) + 4096, bst);
#define MK_NREP(P) ((PROBE_N > 0 && (((P) == 0 && PROBE_K == 8) || ((P) > 0 && (((P) - 1) & 7) == PROBE_K))) ? 1 + PROBE_N : 1)
#define MK_PHASE(P) if (ph_lo <= (P) && (P) < ph_hi) { _Pragma("unroll 1") for (int rep = 0; rep < MK_NREP(P); ++rep) { asm volatile("" : "+s"(a.kp)); run_phase<(P)>(a, lds, wave0, rep); \
        if ((P) + 1 < ph_hi || rep + 1 < MK_NREP(P)) { if ((P) == 0) grid.sync(); else xcd_barrier(xbar); } } }
    MK_PHASE(0) MK_PHASE(1) MK_PHASE(2) MK_PHASE(3) MK_PHASE(4) MK_PHASE(5) MK_PHASE(6) MK_PHASE(7) MK_PHASE(8)
    MK_PHASE(9) MK_PHASE(10) MK_PHASE(11) MK_PHASE(12) MK_PHASE(13) MK_PHASE(14) MK_PHASE(15) MK_PHASE(16)
    static_assert(NPHASE == 17, "phase program");
}

#ifndef FAST_MASK
#define FAST_MASK 0x1ffffu
#endif
extern "C" void kernel_launch(void* const* d_in, const int* in_sizes, int n_in, void* d_out, int out_size, void* d_ws, size_t ws_size, hipStream_t stream) {
    static int grid = 0;
    if (grid == 0) {
        if (n_in != 20 || in_sizes[0] != M * D || out_size != M * D || ws_size < WS_END) { fprintf(stderr, "kernel_launch: unexpected shapes (n_in %d, ws %zu)\n", n_in, ws_size); grid = -1; return; }
        int dev = 0, cus = 0, per_cu = 0;
        if (hipGetDevice(&dev) != hipSuccess || hipDeviceGetAttribute(&cus, hipDeviceAttributeMultiprocessorCount, dev) != hipSuccess) { grid = -1; return; }
        if (hipFuncSetAttribute((const void*)mk_fwd, hipFuncAttributeMaxDynamicSharedMemorySize, LDS_BYTES) != hipSuccess) { fprintf(stderr, "kernel_launch: hipFuncSetAttribute failed\n"); grid = -1; return; }
        if (hipOccupancyMaxActiveBlocksPerMultiprocessor(&per_cu, (const void*)mk_fwd, NWAVES * 64, LDS_BYTES) != hipSuccess || per_cu < 1) { fprintf(stderr, "kernel_launch: occupancy query says %d\n", per_cu); grid = -1; (void)hipGetLastError(); return; }
        grid = cus;
    }
    if (grid < 0) return;
    (void)hipMemsetAsync((char*)d_ws + WS_CTL, 0, 1 * MiB, stream);
    Args a{};
    for (int i = 0; i < 20; ++i) a.in[i] = (const float*)d_in[i];
    a.out = (float*)d_out; a.ws = (unsigned char*)d_ws;
    const unsigned fast = FAST_MASK;
    if (fast == 0x1ffffu) {
        a.ph_lo = 0; a.ph_hi = NPHASE;
        void* args[] = {&a};
        hipError_t e = hipLaunchCooperativeKernel((const void*)mk_fwd, dim3(grid), dim3(NWAVES * 64), args, LDS_BYTES, stream);
        if (e != hipSuccess) fprintf(stderr, "kernel_launch: cooperative launch failed: %s (grid %d)\n", hipGetErrorString(e), grid);
        return;
    }
    unsigned char* ws = (unsigned char*)d_ws; float* out = (float*)d_out;
    bf16_t* xb = (bf16_t*)(ws + WS_XB); bf16_t* xb2 = (bf16_t*)(ws + WS_W); float* ssp0 = (float*)(ws + WS_SSP); float* ssp1 = ssp0 + (size_t)M * 16;
    bf16_t* act = (bf16_t*)(ws + WS_R + R_ACT); bf16_t* ob = (bf16_t*)(ws + WS_R + R_O);
    QkvOut qo; qo.qa = (bf16_t*)(ws + WS_R + R_QA); qo.ka = (bf16_t*)(ws + WS_R + R_KA); qo.va = (bf16_t*)(ws + WS_R + R_VA);
    qo.qb = (bf16_t*)(ws + WS_R + R_QB); qo.kb = (bf16_t*)(ws + WS_R + R_KB); qo.vb = (bf16_t*)(ws + WS_R + R_VB);
    for (int ph = 0; ph < NPHASE; ++ph) {
        if ((fast >> ph) & 1u) { a.ph_lo = ph; a.ph_hi = ph + 1; hipLaunchKernelGGL(mk_fwd, dim3(grid), dim3(NWAVES * 64), LDS_BYTES, stream, a); continue; }
        if (ph == 0) { rowstat_kernel<<<M / 4, 256, 0, stream>>>(a.in[0], xb, ssp0); continue; }
        const int l = (ph - 1) >> 3, k = (ph - 1) & 7;
        const float* xin = (l == 0 && k <= 1) ? a.in[0] : out;
        bf16_t* xbl = (l == 1) ? xb2 : xb;
        switch (k) {
        case 0: naive_ffn_in<<<dim3(DFF / 128, M / 128), 256, 0, stream>>>(xbl, ssp0, a.in[3] + l * D, a.in[4] + (size_t)l * D * 2 * DFF, act); break;
        case 1: naive_resid<<<dim3(D / 128, M / 128), 256, 0, stream>>>(act, DFF, a.in[5] + (size_t)l * DFF * D, xin, out, 0.5f); rowstat_kernel<<<M / 4, 256, 0, stream>>>(out, xb, ssp1); break;
        case 2: qo.qna = a.in[8] + l * HD; qo.kna = a.in[9] + l * HD; qo.qnb = a.in[10] + l * HD; qo.knb = a.in[11] + l * HD;
                naive_qkv<<<dim3(QKVW / 128, M / 128), 256, 0, stream>>>(xb, ssp1, a.in[6] + l * D, a.in[7] + (size_t)l * D * QKVW, qo); break;
        case 3: { AttnIn ai; ai.qa = qo.qa; ai.ka = qo.ka; ai.va = qo.va; ai.qb = qo.qb; ai.kb = qo.kb; ai.vb = qo.vb; ai.rel_bias = a.in[2]; ai.sink = a.in[12] + l * 8; ai.o = ob;
                naive_attn<<<dim3(S / 4, 16, NB), 256, 0, stream>>>(ai); } break;
        case 4: naive_resid<<<dim3(D / 128, M / 128), 256, 0, stream>>>(ob, D, a.in[13] + (size_t)l * D * D, out, out, 1.0f); rowstat_kernel<<<M / 4, 256, 0, stream>>>(out, xb, ssp0); break;
        case 5: naive_ffn_in<<<dim3(DFF / 128, M / 128), 256, 0, stream>>>(xb, ssp0, a.in[14] + l * D, a.in[15] + (size_t)l * D * 2 * DFF, act); break;
        case 6: naive_resid<<<dim3(D / 128, M / 128), 256, 0, stream>>>(act, DFF, a.in[16] + (size_t)l * DFF * D, out, out, 0.5f); rowstat_kernel<<<M / 4, 256, 0, stream>>>(out, xb, ssp1); break;
        case 7: naive_ple<<<dim3(D / 128, M / 128), 256, 0, stream>>>(xb, ssp1, a.in[17] + l * D, a.in[18] + (size_t)l * D * D, a.in[1] + (size_t)l * M * PLE, a.in[19] + (size_t)l * PLE * D, out, out);
                rowstat_kernel<<<M / 4, 256, 0, stream>>>(out, xb2, ssp0); break;
        }
    }
}
```

```cpp
#include <hip/hip_runtime.h>
#include <cstdio>
#include <cstdint>
#ifndef ATT_FAST
#define ATT_FAST 1
#endif
#ifndef PROBE_N
#define PROBE_N 0
#define PROBE_K -1
#endif

typedef unsigned short bf16_t;
constexpr int NB = 4, S = 4096, D = 1024, M = NB * S, DFF = 2816, QKVW = 2304, PLE = 256, DEPTH = 2, HD = 64;
constexpr float EPS = 1e-6f;
constexpr float QSCALE = 0.125f * 1.4426950408889634f;
constexpr float LOG2E = 1.4426950408889634f;

constexpr size_t MiB = 1u << 20;
constexpr size_t WS_CTL = 0, WS_W = 1 * MiB, WS_XB = 85 * MiB, WS_R = 117 * MiB, WS_PB = 221 * MiB, WS_PROJ = 229 * MiB, WS_SSP = 261 * MiB, WS_END = 263 * MiB + 512 * 1024;
constexpr size_t R_QA = 0, R_KA = 16 * MiB, R_VA = 32 * MiB, R_QB = 48 * MiB, R_KB = 64 * MiB, R_VB = 68 * MiB, R_O = 72 * MiB, R_ACT = 0;

__device__ __forceinline__ float bf2f(bf16_t v) { return __uint_as_float(((unsigned)v) << 16); }
__device__ __forceinline__ bf16_t f2bf(float f) { unsigned u = __float_as_uint(f); return (bf16_t)((u + 0x7fffu + ((u >> 16) & 1u)) >> 16); }

__global__ void __launch_bounds__(256) rowstat_kernel(const float* __restrict__ x, bf16_t* __restrict__ xb, float* __restrict__ ssp) {
    const int wave = threadIdx.x >> 6, lane = threadIdx.x & 63;
    const int row = blockIdx.x * 4 + wave;
    const float4* xr = (const float4*)(x + (size_t)row * D);
    float s = 0.f;
#pragma unroll
    for (int j = 0; j < 4; ++j) {
        float4 v = xr[lane + 64 * j];
        s += v.x * v.x + v.y * v.y + v.z * v.z + v.w * v.w;
        ushort4 o; o.x = f2bf(v.x); o.y = f2bf(v.y); o.z = f2bf(v.z); o.w = f2bf(v.w);
        ((ushort4*)(xb + (size_t)row * D))[lane + 64 * j] = o;
    }
#pragma unroll
    for (int o = 1; o < 64; o <<= 1) s += __shfl_xor(s, o);
    if (lane < 4) { float4 r; r.x = lane == 0 ? s : 0.f; r.y = 0.f; r.z = 0.f; r.w = 0.f; ((float4*)ssp)[row * 4 + lane] = r; }
}

__device__ __forceinline__ float row_rstd(const float* ssp, int row) {
    float s = 0.f;
#pragma unroll
    for (int j = 0; j < 4; ++j) { const float4 v = ((const float4*)ssp)[row * 4 + j]; s += (v.x + v.y) + (v.z + v.w); }
    return rsqrtf(s * (1.0f / D) + EPS);
}

template <typename AT> __device__ __forceinline__ float ldA(const AT* p);
template <> __device__ __forceinline__ float ldA<bf16_t>(const bf16_t* p) { return bf2f(*p); }
template <> __device__ __forceinline__ float ldA<float>(const float* p) { return *p; }

template <typename AT>
__device__ __forceinline__ void accum_tile(const AT* A, int lda, int K, const float* gain, const float* W, int ldw, int row0, int wcol0, float (&acc)[8][8], float* As, float* Bs) {
    const int tid = threadIdx.x, tx = tid & 15, ty = tid >> 4;
    for (int k0 = 0; k0 < K; k0 += 8) {
        __syncthreads();
#pragma unroll
        for (int i = 0; i < 4; ++i) { const int idx = tid + i * 256, r = idx >> 3, kk = idx & 7;
            As[kk * 132 + r] = ldA<AT>(A + (size_t)(row0 + r) * lda + k0 + kk) * (gain ? gain[k0 + kk] : 1.0f); }
#pragma unroll
        for (int i = 0; i < 4; ++i) { const int idx = tid + i * 256, kk = idx >> 7, c = idx & 127;
            Bs[kk * 128 + c] = W[(size_t)(k0 + kk) * ldw + wcol0 + c]; }
        __syncthreads();
#pragma unroll
        for (int kk = 0; kk < 8; ++kk) {
            float a[8], b[8];
#pragma unroll
            for (int i = 0; i < 8; ++i) a[i] = As[kk * 132 + ty * 8 + i];
#pragma unroll
            for (int j = 0; j < 8; ++j) b[j] = Bs[kk * 128 + tx * 8 + j];
#pragma unroll
            for (int i = 0; i < 8; ++i)
#pragma unroll
                for (int j = 0; j < 8; ++j) acc[i][j] += a[i] * b[j];
        }
    }
}
#define ZERO_ACC(acc) do { _Pragma("unroll") for (int i = 0; i < 8; ++i) _Pragma("unroll") for (int j = 0; j < 8; ++j) acc[i][j] = 0.f; } while (0)

__global__ void __launch_bounds__(256) naive_ffn_in(const bf16_t* xb, const float* ssp, const float* gain, const float* Win, bf16_t* act) {
    __shared__ float As[8 * 132]; __shared__ float Bs[8 * 128];
    const int row0 = blockIdx.y * 128, col0 = blockIdx.x * 128, tx = threadIdx.x & 15, ty = threadIdx.x >> 4;
    float ag[8][8], au[8][8]; ZERO_ACC(ag); ZERO_ACC(au);
    accum_tile<bf16_t>(xb, D, D, gain, Win, 2 * DFF, row0, col0, ag, As, Bs);
    accum_tile<bf16_t>(xb, D, D, gain, Win, 2 * DFF, row0, DFF + col0, au, As, Bs);
#pragma unroll
    for (int i = 0; i < 8; ++i) { const int row = row0 + ty * 8 + i; const float rs = row_rstd(ssp, row);
#pragma unroll
        for (int j = 0; j < 8; ++j) { const float g = ag[i][j] * rs, u = au[i][j] * rs; const float sg = g / (1.0f + __expf(-g));
            act[(size_t)row * DFF + col0 + tx * 8 + j] = f2bf(sg * u); } }
}
__global__ void __launch_bounds__(256) naive_resid(const bf16_t* A, int K, const float* W, const float* xin, float* xout, float coef) {
    __shared__ float As[8 * 132]; __shared__ float Bs[8 * 128];
    const int row0 = blockIdx.y * 128, col0 = blockIdx.x * 128, tx = threadIdx.x & 15, ty = threadIdx.x >> 4;
    float acc[8][8]; ZERO_ACC(acc);
    accum_tile<bf16_t>(A, K, K, nullptr, W, D, row0, col0, acc, As, Bs);
#pragma unroll
    for (int i = 0; i < 8; ++i) { const int row = row0 + ty * 8 + i;
#pragma unroll
        for (int j = 0; j < 8; ++j) { const size_t o = (size_t)row * D + col0 + tx * 8 + j; xout[o] = xin[o] + coef * acc[i][j]; } }
}
struct QkvOut { bf16_t *qa, *ka, *va, *qb, *kb, *vb; const float *qna, *kna, *qnb, *knb; };
__global__ void __launch_bounds__(256) naive_qkv(const bf16_t* xb, const float* ssp, const float* gain, const float* Wqkv, QkvOut o) {
    __shared__ float As[8 * 132]; __shared__ float Bs[8 * 128];
    const int row0 = blockIdx.y * 128, col0 = blockIdx.x * 128, tx = threadIdx.x & 15, ty = threadIdx.x >> 4;
    float acc[8][8]; ZERO_ACC(acc);
    accum_tile<bf16_t>(xb, D, D, gain, Wqkv, QKVW, row0, col0, acc, As, Bs);
    const int c = col0 + tx * 8;
    bf16_t* dst; const float* ng; int nh, hc; float sc = 1.0f;
    if (c < 512) { dst = o.qa; ng = o.qna; nh = 8; hc = c; sc = QSCALE; }
    else if (c < 1024) { dst = o.ka; ng = o.kna; nh = 8; hc = c - 512; }
    else if (c < 1536) { dst = o.va; ng = nullptr; nh = 8; hc = c - 1024; }
    else if (c < 2048) { dst = o.qb; ng = o.qnb; nh = 8; hc = c - 1536; sc = QSCALE; }
    else if (c < 2176) { dst = o.kb; ng = o.knb; nh = 2; hc = c - 2048; }
    else { dst = o.vb; ng = nullptr; nh = 2; hc = c - 2176; }
    const int h = hc >> 6, e0 = hc & 63;
#pragma unroll
    for (int i = 0; i < 8; ++i) { const int row = row0 + ty * 8 + i; const float rs = row_rstd(ssp, row);
        float v[8]; float ss = 0.f;
#pragma unroll
        for (int j = 0; j < 8; ++j) { v[j] = acc[i][j] * rs; ss += v[j] * v[j]; }
        ss += __shfl_xor(ss, 1); ss += __shfl_xor(ss, 2); ss += __shfl_xor(ss, 4);
        const float hr = rsqrtf(ss * (1.0f / HD) + EPS);
        const int b = row / S, s = row % S;
        bf16_t* p = dst + (((size_t)b * nh + h) * S + s) * HD + e0;
#pragma unroll
        for (int j = 0; j < 8; ++j) p[j] = f2bf(ng ? v[j] * hr * ng[e0 + j] * sc : v[j]); }
}
__global__ void __launch_bounds__(256) naive_ple(const bf16_t* xb, const float* ssp, const float* gain, const float* Wg, const float* p, const float* Wp, const float* xin, float* xout) {
    __shared__ float As[8 * 132]; __shared__ float Bs[8 * 128];
    const int row0 = blockIdx.y * 128, col0 = blockIdx.x * 128, tx = threadIdx.x & 15, ty = threadIdx.x >> 4;
    float ag[8][8], ap[8][8]; ZERO_ACC(ag); ZERO_ACC(ap);
    accum_tile<bf16_t>(xb, D, D, gain, Wg, D, row0, col0, ag, As, Bs);
    accum_tile<float>(p, PLE, PLE, nullptr, Wp, D, row0, col0, ap, As, Bs);
#pragma unroll
    for (int i = 0; i < 8; ++i) { const int row = row0 + ty * 8 + i; const float rs = row_rstd(ssp, row);
#pragma unroll
        for (int j = 0; j < 8; ++j) { const size_t o = (size_t)row * D + col0 + tx * 8 + j; const float g = 1.0f / (1.0f + __expf(-ag[i][j] * rs));
            xout[o] = xin[o] + g * ap[i][j]; } }
}

__device__ __forceinline__ int t5_bucket(int rel) {
    const int n = rel < 0 ? -rel : rel; const int ret = rel > 0 ? 16 : 0;
    if (n < 8) return ret + n;
    int large = 8 + (int)(logf((float)n / 8.0f) / 4.852030263919617f * 8.0f);
    large = large < 15 ? large : 15;
    return ret + large;
}
struct AttnIn { const bf16_t *qa, *ka, *va, *qb, *kb, *vb; const float* rel_bias; const float* sink; bf16_t* o; };
__global__ void __launch_bounds__(256) naive_attn(AttnIn a) {
    __shared__ float pl[4][400]; __shared__ int kl[4][400];
    const int wave = threadIdx.x >> 6, lane = threadIdx.x & 63;
    const int t = blockIdx.x * 4 + wave, head = blockIdx.y, b = blockIdx.z;
    const bool isA = head < 8;
    const bf16_t *q, *k, *v;
    if (isA) { q = a.qa + (((size_t)b * 8 + head) * S + t) * HD; k = a.ka + ((size_t)b * 8 + head) * S * HD; v = a.va + ((size_t)b * 8 + head) * S * HD; }
    else { const int hq = head - 8, hk = hq >> 2; q = a.qb + (((size_t)b * 8 + hq) * S + t) * HD; k = a.kb + ((size_t)b * 2 + hk) * S * HD; v = a.vb + ((size_t)b * 2 + hk) * S * HD; }
    float qf[HD];
#pragma unroll
    for (int e = 0; e < HD; ++e) qf[e] = bf2f(q[e]);
    const int nk = isA ? 387 : 257;
    float mx = -1e30f;
    for (int i = lane; i < nk; i += 64) {
        int rel;
        if (isA) { const int br = i / 129, j = i % 129 - 64; rel = j * (br == 0 ? 1 : br == 1 ? 4 : 16); }
        else rel = i - 128;
        const int tk = t + rel;
        float lg = -1e30f;
        if (tk >= 0 && tk < S) {
            float d = 0.f; const bf16_t* kr = k + (size_t)tk * HD;
#pragma unroll
            for (int e = 0; e < HD; ++e) d += qf[e] * bf2f(kr[e]);
            lg = d + a.rel_bias[t5_bucket(rel) * 16 + head] * LOG2E;
        }
        pl[wave][i] = lg; kl[wave][i] = tk;
        mx = fmaxf(mx, lg);
    }
#pragma unroll
    for (int o = 1; o < 64; o <<= 1) mx = fmaxf(mx, __shfl_xor(mx, o));
    float sinkl = 0.f;
    if (!isA) { sinkl = a.sink[head - 8] * LOG2E; mx = fmaxf(mx, sinkl); }
    float sum = 0.f;
    for (int i = lane; i < nk; i += 64) { const float lg = pl[wave][i]; const float pv = lg > -1e29f ? exp2f(lg - mx) : 0.f; pl[wave][i] = pv; sum += pv; }
#pragma unroll
    for (int o = 1; o < 64; o <<= 1) sum += __shfl_xor(sum, o);
    if (!isA) sum += exp2f(sinkl - mx);
    __syncthreads();
    float acc = 0.f;
    for (int i = 0; i < nk; ++i) { const float pv = pl[wave][i]; if (pv != 0.f) acc += pv * bf2f(v[(size_t)kl[wave][i] * HD + lane]); }
    a.o[((size_t)b * S + t) * D + head * HD + lane] = f2bf(acc / sum);
}

namespace pg8 {
#define PG8_LAS __attribute__((address_space(3)))
typedef unsigned short bf16_t;
typedef short bf16x8 __attribute__((ext_vector_type(8)));
typedef float f32x4 __attribute__((ext_vector_type(4)));
typedef unsigned u32x4 __attribute__((ext_vector_type(4)));
constexpr int BM = 256, BK = 64, HALF = 128, HTB = HALF * BK * 2  , STAGE_BYTES = 8 * HTB, NXCD = 8, WGM = 8;

__host__ __device__ __forceinline__ int lds_byte(int r, int c) { const int st = (r >> 4) * 2 + (c >> 5), rr = r & 15, cc = c & 31, ob = rr * 64 + cc * 2; return st * 1024 + (ob ^ (((ob >> 9) & 1) << 5)); }
__host__ __device__ __forceinline__ void stage_rc(int b, int& R, int& C) { const int st = b / 1024, sb = b % 1024, swz = sb ^ (((sb >> 9) & 1) << 5); R = (st >> 1) * 16 + swz / 64; C = (st & 1) * 32 + (swz % 64) / 2; }
__host__ __device__ __forceinline__ int perm32(int rho) { const int n = rho >> 4, i = rho & 15; return 8 * (i >> 2) + 4 * n + (i & 3); }

struct Unit { int pm, pn; };
struct Gemm { const bf16_t* A; const bf16_t* Bt; int M, N, K; };

struct StaticOrder {
    int nM, nN, nwg, G, c;
    __host__ __device__ void init(int M, int N, int G_, int c_) { nM = M / BM; nN = N / BM; nwg = nM * nN; G = G_; c = c_; }
    __host__ __device__ bool next(int i, Unit& u) const {
        const long L = (long)i * G + c; if (L >= nwg) return false;
        int wgid = (int)L; { const int q = nwg / NXCD, r = nwg % NXCD, xcd = wgid % NXCD, off = wgid / NXCD; wgid = (xcd < r ? xcd * (q + 1) : r * (q + 1) + (xcd - r) * q) + off; }
        const int nig = WGM * nN, gid = wgid / nig, fm = gid * WGM, gsz = (nM - fm) < WGM ? (nM - fm) : WGM;
        u.pm = fm + ((wgid % nig) % gsz); u.pn = (wgid % nig) / gsz; return true;
    }
    __device__ __forceinline__ void a_ready(const Unit&) const {}
    __device__ __forceinline__ void done(const Unit&) const {}
};

__device__ __forceinline__ unsigned cvt_pk_bf16(float lo, float hi) { unsigned r; asm volatile("v_cvt_pk_bf16_f32 %0, %1, %2" : "=v"(r) : "v"(lo), "v"(hi)); return r; }
typedef float f32x2 __attribute__((ext_vector_type(2)));
template <class Epi, class Sched, bool ALIGN_EPI = false, bool SP2 = false>
__device__ __forceinline__ void gemm_phase(PG8_LAS unsigned char* lds, const Gemm g, const Sched& S, const Epi& E, const int tid) {
    const int wid = __builtin_amdgcn_readfirstlane(tid >> 6), lane = tid & 63, wr = wid >> 2, wc = wid & 3, fr = lane & 15, fq = lane >> 4;
    const int K = g.K, nt = K / BK;
    unsigned voffA[2], voffB[2];
#pragma unroll
    for (int i = 0; i < 2; ++i) { int R, C; stage_rc(tid * 16 + i * 8192, R, C); const int Rb = Epi::PERM ? ((R & ~31) + perm32(R & 31)) : R;
        voffA[i] = (unsigned)(R * K + C) * 2u; voffB[i] = (unsigned)(Rb * K + C) * 2u; }
    const size_t kstep = (size_t)(BK * 2);
    const size_t hstep = (size_t)HALF * K * 2;
    const size_t tstep = 2 * hstep;
    const unsigned ldsw = (unsigned)wid * 1024u;
    const int aoff = lds_byte(wr * 64 + fr, fq * 8), boff = lds_byte(wc * 32 + fr, fq * 8);
#define PG8_SA(b, h) (((b) * 2 + (h)) * HTB)
#define PG8_SB(b, h) ((4 + (b) * 2 + (h)) * HTB)
#define PG8_STAGE(bufoff, gbase, voff) do { _Pragma("unroll") for (int _i = 0; _i < 2; ++_i) \
        __builtin_amdgcn_global_load_lds((const unsigned*)((const char*)(gbase) + (voff)[_i]), (PG8_LAS unsigned*)(lds + (bufoff) + ldsw + _i * 8192), 16, 0, 0); } while (0)
#define PG8_LDA(dst, b, h) do { _Pragma("unroll") for (int m = 0; m < 4; ++m) _Pragma("unroll") for (int k = 0; k < 2; ++k) dst[m][k] = *(const PG8_LAS bf16x8*)(lds + PG8_SA(b, h) + aoff + m * 2048 + k * 1024); } while (0)
#define PG8_LDB(dst, b, h) do { _Pragma("unroll") for (int n = 0; n < 2; ++n) _Pragma("unroll") for (int k = 0; k < 2; ++k) dst[n][k] = *(const PG8_LAS bf16x8*)(lds + PG8_SB(b, h) + boff + n * 2048 + k * 1024); } while (0)
#define PG8_MMA(ai, bj, At, Bt) do { __builtin_amdgcn_s_setprio(1); _Pragma("unroll") for (int m = 0; m < 4; ++m) _Pragma("unroll") for (int n = 0; n < 2; ++n) _Pragma("unroll") for (int k = 0; k < 2; ++k) \
        acc[ai][bj][m][n] = __builtin_amdgcn_mfma_f32_16x16x32_bf16(Bt[n][k], At[m][k], acc[ai][bj][m][n], 0, 0, 0); __builtin_amdgcn_s_setprio(0); } while (0)
#define PG8_WAIT_V(n) asm volatile("s_waitcnt vmcnt(" #n ")" ::: "memory")
#define PG8_WAIT_L(n) asm volatile("s_waitcnt lgkmcnt(" #n ")" ::: "memory")
#define PG8_BAR __builtin_amdgcn_s_barrier()
#define PG8_SCHED __builtin_amdgcn_sched_barrier(0)
    Unit cur, nxt; int ui = 0;
    if (!S.next(0, cur)) return;
    f32x4 acc[2][2][4][2];
#pragma unroll
    for (int a = 0; a < 2; ++a)
#pragma unroll
        for (int b = 0; b < 2; ++b)
#pragma unroll
            for (int m = 0; m < 4; ++m)
#pragma unroll
                for (int n = 0; n < 2; ++n) acc[a][b][m][n] = (f32x4){0.f, 0.f, 0.f, 0.f};
    bf16x8 At[4][2], B0[2][2], B1[2][2];
    const char* cA = (const char*)g.A + (size_t)cur.pm * tstep; const char* cB = (const char*)g.Bt + (size_t)cur.pn * tstep;
    S.a_ready(cur);
    if constexpr (SP2) {
        PG8_STAGE(PG8_SB(0, 0), cB, voffB); PG8_STAGE(PG8_SB(0, 1), cB + hstep, voffB); PG8_STAGE(PG8_SA(0, 0), cA, voffA); PG8_STAGE(PG8_SA(0, 1), cA + hstep, voffA);
        if (wr == 1) PG8_BAR;
        PG8_WAIT_V(2); PG8_BAR;
        PG8_STAGE(PG8_SB(1, 0), cB + kstep, voffB); PG8_STAGE(PG8_SA(1, 0), cA + kstep, voffA); PG8_STAGE(PG8_SB(1, 1), cB + hstep + kstep, voffB);
        PG8_WAIT_V(6); PG8_BAR;
    } else {
        PG8_STAGE(PG8_SB(0, 0), cB, voffB); PG8_STAGE(PG8_SA(0, 0), cA, voffA); PG8_STAGE(PG8_SB(0, 1), cB + hstep, voffB); PG8_STAGE(PG8_SA(0, 1), cA + hstep, voffA);
        if (wr == 1) PG8_BAR;
        PG8_WAIT_V(4); PG8_BAR;
        PG8_STAGE(PG8_SB(1, 0), cB + kstep, voffB); PG8_STAGE(PG8_SA(1, 0), cA + kstep, voffA); PG8_STAGE(PG8_SB(1, 1), cB + hstep + kstep, voffB);
        PG8_WAIT_V(6); PG8_BAR;
    }
    for (;;) {
        const bool has_next = S.next(ui + 1, nxt);
        const char* nA = has_next ? (const char*)g.A + (size_t)nxt.pm * tstep : cA; const char* nB = has_next ? (const char*)g.Bt + (size_t)nxt.pn * tstep : cB;
        for (int t = 0; t < nt; t += 2) {
            const bool last = (t == nt - 2);
            const char* a1 = cA + (size_t)(t + 1) * kstep;
            const char* a2 = last ? nA : cA + (size_t)(t + 2) * kstep; const char* b2 = last ? nB : cB + (size_t)(t + 2) * kstep;
            const char* a3 = a2 + kstep; const char* b3 = b2 + kstep;
            if (last && has_next) S.a_ready(nxt);
            if constexpr (SP2) {
            PG8_LDB(B0, 0, 0); PG8_LDB(B1, 0, 1); PG8_SCHED; PG8_LDA(At, 0, 0); PG8_STAGE(PG8_SA(1, 1), a1 + hstep, voffA);
            PG8_WAIT_V(8); PG8_WAIT_L(0); PG8_BAR; PG8_MMA(0, 0, At, B0); PG8_MMA(0, 1, At, B1); PG8_BAR; PG8_SCHED;
            PG8_LDA(At, 0, 1); PG8_STAGE(PG8_SB(0, 0), b2, voffB); PG8_STAGE(PG8_SB(0, 1), b2 + hstep, voffB); PG8_STAGE(PG8_SA(0, 0), a2, voffA);
            PG8_WAIT_V(8); PG8_WAIT_L(0); PG8_BAR; PG8_MMA(1, 0, At, B0); PG8_MMA(1, 1, At, B1); PG8_BAR; PG8_SCHED;
            PG8_LDB(B0, 1, 0); PG8_LDB(B1, 1, 1); PG8_SCHED; PG8_LDA(At, 1, 0); PG8_STAGE(PG8_SA(0, 1), a2 + hstep, voffA);
            PG8_WAIT_V(8); PG8_WAIT_L(0); PG8_BAR; PG8_MMA(0, 0, At, B0); PG8_MMA(0, 1, At, B1); PG8_BAR; PG8_SCHED;
            PG8_LDA(At, 1, 1); PG8_STAGE(PG8_SB(1, 0), b3, voffB); PG8_STAGE(PG8_SB(1, 1), b3 + hstep, voffB); PG8_STAGE(PG8_SA(1, 0), a3, voffA);
            PG8_WAIT_V(8); PG8_WAIT_L(0); PG8_BAR; PG8_MMA(1, 0, At, B0); PG8_MMA(1, 1, At, B1); PG8_BAR; PG8_SCHED;
            } else {
            PG8_LDB(B0, 0, 0); PG8_SCHED; PG8_LDA(At, 0, 0); PG8_STAGE(PG8_SA(1, 1), a1 + hstep, voffA);
            PG8_WAIT_L(8); PG8_BAR; PG8_WAIT_L(0); PG8_MMA(0, 0, At, B0); PG8_BAR; PG8_SCHED;
            PG8_LDB(B1, 0, 1); PG8_STAGE(PG8_SB(0, 0), b2, voffB);
            PG8_BAR; PG8_WAIT_L(0); PG8_MMA(0, 1, At, B1); PG8_BAR;
            PG8_LDA(At, 0, 1); PG8_STAGE(PG8_SA(0, 0), a2, voffA);
            PG8_BAR; PG8_WAIT_L(0); PG8_MMA(1, 0, At, B0); PG8_BAR; PG8_SCHED;
            PG8_STAGE(PG8_SB(0, 1), b2 + hstep, voffB);
            PG8_WAIT_V(6); PG8_BAR; PG8_MMA(1, 1, At, B1); PG8_BAR;
            PG8_LDB(B0, 1, 0); PG8_SCHED; PG8_LDA(At, 1, 0); PG8_STAGE(PG8_SA(0, 1), a2 + hstep, voffA);
            PG8_WAIT_L(8); PG8_BAR; PG8_WAIT_L(0); PG8_MMA(0, 0, At, B0); PG8_BAR; PG8_SCHED;
            PG8_LDB(B1, 1, 1); PG8_STAGE(PG8_SB(1, 0), b3, voffB);
            PG8_BAR; PG8_WAIT_L(0); PG8_MMA(0, 1, At, B1); PG8_BAR;
            PG8_LDA(At, 1, 1); PG8_STAGE(PG8_SA(1, 0), a3, voffA);
            PG8_BAR; PG8_WAIT_L(0); PG8_MMA(1, 0, At, B0); PG8_BAR; PG8_SCHED;
            PG8_STAGE(PG8_SB(1, 1), b3 + hstep, voffB);
            PG8_WAIT_V(6); PG8_BAR; PG8_MMA(1, 1, At, B1); PG8_BAR;
            }
        }
        if constexpr (ALIGN_EPI) { if (wr == 0) PG8_BAR; }
        if constexpr (!Epi::AFTER_DRAIN) { int l2_; asm volatile("v_mbcnt_lo_u32_b32 %0, -1, 0\n\tv_mbcnt_hi_u32_b32 %0, -1, %0" : "=v"(l2_)); E(acc, cur, wr, wc, l2_ & 15, l2_ >> 4); S.done(cur); }
        if (!has_next) break;
#pragma unroll
        for (int a = 0; a < 2; ++a)
#pragma unroll
            for (int b = 0; b < 2; ++b)
#pragma unroll
                for (int m = 0; m < 4; ++m)
#pragma unroll
                    for (int n = 0; n < 2; ++n) acc[a][b][m][n] = (f32x4){0.f, 0.f, 0.f, 0.f};
        cur = nxt; cA = nA; cB = nB; ++ui;
        if constexpr (ALIGN_EPI) { if (wr == 1) PG8_BAR; }
    }
    PG8_WAIT_V(0);
    if constexpr (!ALIGN_EPI) { if (wr == 0) PG8_BAR; }
    PG8_BAR;
    if constexpr (Epi::AFTER_DRAIN) { E.fused(acc, cur, wr, wc, fr, fq, lds, wid, lane); S.done(cur); }
#undef PG8_SA
#undef PG8_SB
#undef PG8_STAGE
#undef PG8_LDA
#undef PG8_LDB
#undef PG8_MMA
#undef PG8_WAIT_V
#undef PG8_WAIT_L
#undef PG8_BAR
#undef PG8_SCHED
}
}

namespace pg8 {
typedef float f32x2 __attribute__((ext_vector_type(2)));
__device__ __forceinline__ float shx(float v, int lane, int mask) { return __int_as_float(__builtin_amdgcn_ds_bpermute((lane ^ mask) << 2, __float_as_int(v))); }
__device__ __forceinline__ float rstd16(const float* ssp, int row, int fq, int lane) {
    const f32x4 v = *(const f32x4*)(ssp + (size_t)row * 16 + 4 * fq);
    float s = (v[0] + v[1]) + (v[2] + v[3]);
    s += shx(s, lane, 16); s += shx(s, lane, 32);
    return rsqrtf(s * (1.0f / 1024.0f) + 1e-6f);
}
__device__ __forceinline__ float sigm(float v) { return __builtin_amdgcn_rcpf(1.0f + __builtin_amdgcn_exp2f(-1.4426950408889634f * v)); }
__device__ __forceinline__ u32x4 pack8(const f32x4& a, const f32x4& b) { u32x4 w; w.x = cvt_pk_bf16(a[0], a[1]); w.y = cvt_pk_bf16(a[2], a[3]); w.z = cvt_pk_bf16(b[0], b[1]); w.w = cvt_pk_bf16(b[2], b[3]); return w; }
__device__ __forceinline__ float bflo(unsigned w) { return __uint_as_float(w << 16); }
__device__ __forceinline__ float bfhi(unsigned w) { return __uint_as_float(w & 0xffff0000u); }

struct EpiSwiglu {
    static constexpr bool PERM = true, AFTER_DRAIN = false;
    bf16_t* act; const float* ssp;
    __device__ __forceinline__ void operator()(const f32x4 (&acc)[2][2][4][2], const Unit& u, int wr, int wc, int fr, int fq) const {
        const int lane = fr + 16 * fq;
        const int row0 = u.pm * BM + wr * 64 + fr, col0 = u.pn * 128 + wc * 32 + 8 * fq;
#pragma unroll
        for (int ai = 0; ai < 2; ++ai)
#pragma unroll
            for (int m = 0; m < 4; ++m) { const int row = row0 + ai * HALF + m * 16; const float rs = rstd16(ssp, row, fq, lane);
                f32x4 o[2];
#pragma unroll
                for (int n = 0; n < 2; ++n)
#pragma unroll
                    for (int j = 0; j < 4; ++j) { const float g = acc[ai][0][m][n][j] * rs, up = acc[ai][1][m][n][j] * rs; o[n][j] = g * sigm(g) * up; }
                *(u32x4*)(act + (size_t)row * 2816 + col0) = pack8(o[0], o[1]); }
    }
};
struct EpiResid {
    static constexpr bool PERM = true, AFTER_DRAIN = false;
    const float* xin; float* xout; bf16_t* xb; float* sspw; float coef;
    __device__ __forceinline__ void operator()(const f32x4 (&acc)[2][2][4][2], const Unit& u, int wr, int wc, int fr, int fq) const {
        const int lane = fr + 16 * fq;
        float cf = __uint_as_float(__builtin_amdgcn_readfirstlane(__float_as_uint(coef))); asm volatile("" : "+s"(cf));
        const int row0 = u.pm * BM + wr * 64 + fr, col0 = u.pn * BM + wc * 32 + 8 * fq;
#pragma unroll
        for (int ai = 0; ai < 2; ++ai)
#pragma unroll
            for (int mh = 0; mh < 2; ++mh) {
            f32x4 xo[2][2][2];
#pragma unroll
            for (int mm = 0; mm < 2; ++mm)
#pragma unroll
                for (int bj = 0; bj < 2; ++bj) { const size_t off = (size_t)(row0 + ai * HALF + (2 * mh + mm) * 16) * 1024 + col0 + bj * HALF; xo[mm][bj][0] = *(const f32x4*)(xin + off); xo[mm][bj][1] = *(const f32x4*)(xin + off + 4); }
            asm volatile("" ::: "memory");
#pragma unroll
            for (int mm = 0; mm < 2; ++mm) { const int m = 2 * mh + mm, row = row0 + ai * HALF + m * 16; float ss = 0.f;
#pragma unroll
                for (int bj = 0; bj < 2; ++bj) { const size_t off = (size_t)row * 1024 + col0 + bj * HALF;
                    const f32x4 x0 = xo[mm][bj][0] + acc[ai][bj][m][0] * cf, x1 = xo[mm][bj][1] + acc[ai][bj][m][1] * cf;
                    *(f32x4*)(xout + off) = x0; *(f32x4*)(xout + off + 4) = x1;
                    *(u32x4*)(xb + off) = pack8(x0, x1);
                    ss += (x0[0] * x0[0] + x0[1] * x0[1]) + (x0[2] * x0[2] + x0[3] * x0[3]) + (x1[0] * x1[0] + x1[1] * x1[1]) + (x1[2] * x1[2] + x1[3] * x1[3]); }
                ss += shx(ss, lane, 16); ss += shx(ss, lane, 32);
                if (fq == 0) sspw[(size_t)row * 16 + u.pn * 4 + wc] = ss; }
            asm volatile("" ::: "memory");
        }
    }
};
struct EpiGate {
    static constexpr bool PERM = true, AFTER_DRAIN = false;
    const float* xin; float* xout; bf16_t* xb; float* sspw; const float* sspr; const bf16_t* proj; float coef;
    __device__ __forceinline__ void operator()(const f32x4 (&acc)[2][2][4][2], const Unit& u, int wr, int wc, int fr, int fq) const {
        const int lane = fr + 16 * fq;
        float cf = __uint_as_float(__builtin_amdgcn_readfirstlane(__float_as_uint(coef))); asm volatile("" : "+s"(cf));
        const int row0 = u.pm * BM + wr * 64 + fr, col0 = u.pn * BM + wc * 32 + 8 * fq;
#pragma unroll
        for (int ai = 0; ai < 2; ++ai)
#pragma unroll
            for (int mh = 0; mh < 2; ++mh) {
                f32x4 xo[2][2][2]; u32x4 pw[2][2]; float rs[2];
#pragma unroll
                for (int mm = 0; mm < 2; ++mm) { const int row = row0 + ai * HALF + (2 * mh + mm) * 16; rs[mm] = rstd16(sspr, row, fq, lane);
#pragma unroll
                    for (int bj = 0; bj < 2; ++bj) { const size_t off = (size_t)row * 1024 + col0 + bj * HALF; xo[mm][bj][0] = *(const f32x4*)(xin + off); xo[mm][bj][1] = *(const f32x4*)(xin + off + 4); pw[mm][bj] = *(const u32x4*)(proj + off); } }
                asm volatile("" ::: "memory");
#pragma unroll
                for (int mm = 0; mm < 2; ++mm) { const int m = 2 * mh + mm, row = row0 + ai * HALF + m * 16; float ss = 0.f;
#pragma unroll
                    for (int bj = 0; bj < 2; ++bj) { const size_t off = (size_t)row * 1024 + col0 + bj * HALF;
                        f32x4 x0 = xo[mm][bj][0], x1 = xo[mm][bj][1]; const u32x4 pq = pw[mm][bj];
                        const f32x4 p0 = {bflo(pq.x), bfhi(pq.x), bflo(pq.y), bfhi(pq.y)}, p1 = {bflo(pq.z), bfhi(pq.z), bflo(pq.w), bfhi(pq.w)};
#pragma unroll
                        for (int j = 0; j < 4; ++j) { x0[j] += cf * (sigm(acc[ai][bj][m][0][j] * rs[mm]) * p0[j]); x1[j] += cf * (sigm(acc[ai][bj][m][1][j] * rs[mm]) * p1[j]); }
                        *(f32x4*)(xout + off) = x0; *(f32x4*)(xout + off + 4) = x1;
                        *(u32x4*)(xb + off) = pack8(x0, x1);
                        ss += (x0[0] * x0[0] + x0[1] * x0[1]) + (x0[2] * x0[2] + x0[3] * x0[3]) + (x1[0] * x1[0] + x1[1] * x1[1]) + (x1[2] * x1[2] + x1[3] * x1[3]); }
                    ss += shx(ss, lane, 16); ss += shx(ss, lane, 32);
                    if (fq == 0) sspw[(size_t)row * 16 + u.pn * 4 + wc] = ss; }
                asm volatile("" ::: "memory");
            }
    }
};
struct EpiStoreBf16 {
    static constexpr bool PERM = true, AFTER_DRAIN = false;
    bf16_t* O; int ldc;
    __device__ __forceinline__ void operator()(const f32x4 (&acc)[2][2][4][2], const Unit& u, int wr, int wc, int fr, int fq) const {
        const int lane = fr + 16 * fq;
        const int row0 = u.pm * BM + wr * 64 + fr, col0 = u.pn * BM + wc * 32 + 8 * fq;
#pragma unroll
        for (int ai = 0; ai < 2; ++ai)
#pragma unroll
            for (int m = 0; m < 4; ++m) { const int row = row0 + ai * HALF + m * 16;
#pragma unroll
                for (int bj = 0; bj < 2; ++bj) *(u32x4*)(O + (size_t)row * ldc + col0 + bj * HALF) = pack8(acc[ai][bj][m][0], acc[ai][bj][m][1]); }
    }
};
struct EpiQkv {
    static constexpr bool PERM = true, AFTER_DRAIN = false;
    const float* ssp; bf16_t *qa, *ka, *va, *qb, *kb, *vb; const float *qna, *kna, *qnb, *knb;
    __device__ __forceinline__ void operator()(const f32x4 (&acc)[2][2][4][2], const Unit& u, int wr, int wc, int fr, int fq) const {
        const int lane = fr + 16 * fq;
        const int t = u.pn; bf16_t* dst; const float* ng; int nh, h; float sc = 1.0f;
        if (t < 2) { dst = qa; ng = qna; nh = 8; h = 4 * t + wc; sc = QSCALE; }
        else if (t < 4) { dst = ka; ng = kna; nh = 8; h = 4 * (t - 2) + wc; }
        else if (t < 6) { dst = va; ng = nullptr; nh = 8; h = 4 * (t - 4) + wc; }
        else if (t < 8) { dst = qb; ng = qnb; nh = 8; h = 4 * (t - 6) + wc; sc = QSCALE; }
        else if (wc < 2) { dst = kb; ng = knb; nh = 2; h = wc; }
        else { dst = vb; ng = nullptr; nh = 2; h = wc - 2; }
        f32x4 gv[2][2];
#pragma unroll
        for (int bj = 0; bj < 2; ++bj)
#pragma unroll
            for (int n = 0; n < 2; ++n) { if (ng) gv[bj][n] = *(const f32x4*)(ng + 32 * bj + 8 * fq + 4 * n) * sc; else gv[bj][n] = (f32x4){1.f, 1.f, 1.f, 1.f}; }
        const int row0 = u.pm * BM + wr * 64 + fr;
#pragma unroll
        for (int ai = 0; ai < 2; ++ai)
#pragma unroll
            for (int m = 0; m < 4; ++m) { const int row = row0 + ai * HALF + m * 16; const float rs = rstd16(ssp, row, fq, lane);
                f32x4 v[2][2]; float ss = 0.f;
#pragma unroll
                for (int bj = 0; bj < 2; ++bj)
#pragma unroll
                    for (int n = 0; n < 2; ++n) { v[bj][n] = acc[ai][bj][m][n] * rs; ss += (v[bj][n][0] * v[bj][n][0] + v[bj][n][1] * v[bj][n][1]) + (v[bj][n][2] * v[bj][n][2] + v[bj][n][3] * v[bj][n][3]); }
                ss += shx(ss, lane, 16); ss += shx(ss, lane, 32);
                const float hr = ng ? rsqrtf(ss * (1.0f / 64.0f) + 1e-6f) : 1.0f;
                const int b = row >> 12, s = row & 4095;
                bf16_t* p = dst + (((size_t)b * nh + h) * 4096 + s) * 64 + 8 * fq;
#pragma unroll
                for (int bj = 0; bj < 2; ++bj) *(u32x4*)(p + 32 * bj) = pack8(v[bj][0] * hr * gv[bj][0], v[bj][1] * hr * gv[bj][1]); }
    }
};
}

#include <hip/hip_cooperative_groups.h>
namespace cg = cooperative_groups;
#define LAS __attribute__((address_space(3)))
typedef unsigned v4u __attribute__((ext_vector_type(4)));
constexpr int NWAVES = 8, RING_BYTES = 131072, LDS_BYTES = 147456;
constexpr int NPHASE = 1 + 8 * DEPTH;
constexpr size_t WO_F1IN = 0, WO_F1OUT = WO_F1IN + (size_t)2 * DFF * D, WO_QKV = WO_F1OUT + (size_t)D * DFF, WO_WO = WO_QKV + (size_t)QKVW * D,
                 WO_F2IN = WO_WO + (size_t)D * D, WO_F2OUT = WO_F2IN + (size_t)2 * DFF * D, WO_WG = WO_F2OUT + (size_t)D * DFF, WO_WP = WO_WG + (size_t)D * D, W_LAYER = WO_WP + (size_t)D * PLE;
static_assert(W_LAYER * 2 * DEPTH <= 84 * MiB, "weights fit");

struct Args { const float* in[20]; float* out; unsigned char* ws; int ph_lo, ph_hi; };

__device__ __forceinline__ int src_col(int kind, int n0) {
    if (kind == 0) return n0;
    if (kind == 1) return ((n0 >> 7) & 1) * DFF + 128 * (n0 >> 8) + (n0 & 127);
    return 256 * (n0 >> 8) + 64 * ((n0 >> 5) & 3) + 32 * ((n0 >> 7) & 1);
}
__device__ __forceinline__ void transpose_item(const float* W, int K, int N, const float* gain, bf16_t* Bt, int kind, int item, LAS float* scr, int lane) {
    const int kblocks = K / 64, nb = item / kblocks, kb = item % kblocks, k0 = 64 * kb, n0 = 64 * nb;
    const int cseg = lane & 15, r0 = lane >> 4;
    const int c0 = src_col(kind, n0 + 32 * (cseg >> 3)) + 4 * (cseg & 7);
    float4 v[16];
#pragma unroll
    for (int i = 0; i < 16; ++i) v[i] = *(const float4*)(W + (size_t)(k0 + r0 + 4 * i) * N + c0);
    if (gain) {
#pragma unroll
        for (int i = 0; i < 16; ++i) { const float g = gain[k0 + r0 + 4 * i]; v[i].x *= g; v[i].y *= g; v[i].z *= g; v[i].w *= g; }
    }
#pragma unroll
    for (int i = 0; i < 16; ++i) { LAS float* p = scr + (r0 + 4 * i) * 65 + 4 * cseg; p[0] = v[i].x; p[1] = v[i].y; p[2] = v[i].z; p[3] = v[i].w; }
    asm volatile("s_waitcnt lgkmcnt(0)" ::: "memory");
    const int c = lane & 7;
#pragma unroll
    for (int j = 0; j < 8; ++j) { const int n = (lane >> 3) + 8 * j; const LAS float* sp = scr + (8 * c) * 65 + n;
        v4u o; o.x = pg8::cvt_pk_bf16(sp[0 * 65], sp[1 * 65]); o.y = pg8::cvt_pk_bf16(sp[2 * 65], sp[3 * 65]); o.z = pg8::cvt_pk_bf16(sp[4 * 65], sp[5 * 65]); o.w = pg8::cvt_pk_bf16(sp[6 * 65], sp[7 * 65]);
        *(v4u*)(Bt + (size_t)(n0 + n) * K + k0 + 8 * c) = o; }
    asm volatile("s_waitcnt lgkmcnt(0)" ::: "memory");
}

template <class AT> __device__ __forceinline__ void prologue_phase(const AT& a, LAS unsigned char* lds, int gw, int NGW, int wave, int lane) {
    LAS float* scr = (LAS float*)(lds + wave * 16640);
    bf16_t* wbase = (bf16_t*)(a.ws() + WS_W);
    constexpr int I_FIN = (D / 64) * (2 * DFF / 64), I_FOUT = (DFF / 64) * (D / 64), I_QKV = (D / 64) * (QKVW / 64), I_SQ = (D / 64) * (D / 64), I_WP = (PLE / 64) * (D / 64);
    constexpr int I_LAYER = 2 * I_FIN + 2 * I_FOUT + I_QKV + 2 * I_SQ + I_WP;
    for (int it = gw; it < DEPTH * I_LAYER; it += NGW) {
        const int l = it / I_LAYER; int r = it % I_LAYER; bf16_t* wl = wbase + (size_t)l * W_LAYER;
        if (r < I_FIN) { transpose_item(a.in(4) + (size_t)l * D * 2 * DFF, D, 2 * DFF, a.in(3) + l * D, wl + WO_F1IN, 1, r, scr, lane); continue; } r -= I_FIN;
        if (r < I_FOUT) { transpose_item(a.in(5) + (size_t)l * DFF * D, DFF, D, nullptr, wl + WO_F1OUT, 0, r, scr, lane); continue; } r -= I_FOUT;
        if (r < I_QKV) { transpose_item(a.in(7) + (size_t)l * D * QKVW, D, QKVW, a.in(6) + l * D, wl + WO_QKV, 2, r, scr, lane); continue; } r -= I_QKV;
        if (r < I_SQ) { transpose_item(a.in(13) + (size_t)l * D * D, D, D, nullptr, wl + WO_WO, 0, r, scr, lane); continue; } r -= I_SQ;
        if (r < I_FIN) { transpose_item(a.in(15) + (size_t)l * D * 2 * DFF, D, 2 * DFF, a.in(14) + l * D, wl + WO_F2IN, 1, r, scr, lane); continue; } r -= I_FIN;
        if (r < I_FOUT) { transpose_item(a.in(16) + (size_t)l * DFF * D, DFF, D, nullptr, wl + WO_F2OUT, 0, r, scr, lane); continue; } r -= I_FOUT;
        if (r < I_SQ) { transpose_item(a.in(18) + (size_t)l * D * D, D, D, a.in(17) + l * D, wl + WO_WG, 0, r, scr, lane); continue; } r -= I_SQ;
        transpose_item(a.in(19) + (size_t)l * PLE * D, PLE, D, nullptr, wl + WO_WP, 0, r, scr, lane);
    }
    const float* x = a.in(0); bf16_t* xb = (bf16_t*)(a.ws() + WS_XB); float* ssp = (float*)(a.ws() + WS_SSP);
    for (int row = gw; row < M; row += 2 * NGW) {
        const int row2 = row + NGW; const bool has2 = row2 < M;
        const float4* xr = (const float4*)(x + (size_t)row * D); const float4* xr2 = (const float4*)(x + (size_t)(has2 ? row2 : row) * D);
        float4 va[4], vb[4];
#pragma unroll
        for (int j = 0; j < 4; ++j) { va[j] = xr[lane + 64 * j]; vb[j] = xr2[lane + 64 * j]; }
        float s = 0.f, s2 = 0.f;
#pragma unroll
        for (int j = 0; j < 4; ++j) { s += va[j].x * va[j].x + va[j].y * va[j].y + va[j].z * va[j].z + va[j].w * va[j].w; s2 += vb[j].x * vb[j].x + vb[j].y * vb[j].y + vb[j].z * vb[j].z + vb[j].w * vb[j].w;
            uint2 o; o.x = pg8::cvt_pk_bf16(va[j].x, va[j].y); o.y = pg8::cvt_pk_bf16(va[j].z, va[j].w); ((uint2*)(xb + (size_t)row * D))[lane + 64 * j] = o;
            if (has2) { uint2 o2; o2.x = pg8::cvt_pk_bf16(vb[j].x, vb[j].y); o2.y = pg8::cvt_pk_bf16(vb[j].z, vb[j].w); ((uint2*)(xb + (size_t)row2 * D))[lane + 64 * j] = o2; } }
#pragma unroll
        for (int o = 1; o < 64; o <<= 1) { s += pg8::shx(s, lane, o); s2 += pg8::shx(s2, lane, o); }
        if (lane < 4) { float4 r; r.x = lane == 0 ? s : 0.f; r.y = 0.f; r.z = 0.f; r.w = 0.f; ((float4*)ssp)[row * 4 + lane] = r;
            if (has2) { r.x = lane == 0 ? s2 : 0.f; ((float4*)ssp)[row2 * 4 + lane] = r; } }
    }
}
__device__ __forceinline__ void convert_p(const float* p, bf16_t* pb, int gtid, int nthreads) {
    for (int i = gtid; i < M * PLE / 8; i += nthreads) { const float4 v0 = ((const float4*)p)[2 * i], v1 = ((const float4*)p)[2 * i + 1];
        v4u o; o.x = pg8::cvt_pk_bf16(v0.x, v0.y); o.y = pg8::cvt_pk_bf16(v0.z, v0.w); o.z = pg8::cvt_pk_bf16(v1.x, v1.y); o.w = pg8::cvt_pk_bf16(v1.z, v1.w); ((v4u*)pb)[i] = o; }
}

__device__ __forceinline__ void attn_simple_phase(LAS unsigned char* lds, const AttnIn& a, int G, int wave, int lane) {
    LAS float* pl = (LAS float*)(lds + wave * 4096); LAS int* kl = (LAS int*)(lds + wave * 4096 + 2048);
    const int total = NB * 16 * S;
    for (int item = blockIdx.x * NWAVES + wave; item < total; item += G * NWAVES) {
        const int t = item & (S - 1), head = (item >> 12) & 15, b = item >> 16;
        const bool isA = head < 8;
        const bf16_t *q, *k, *v;
        if (isA) { q = a.qa + (((size_t)b * 8 + head) * S + t) * HD; k = a.ka + ((size_t)b * 8 + head) * S * HD; v = a.va + ((size_t)b * 8 + head) * S * HD; }
        else { const int hq = head - 8, hk = hq >> 2; q = a.qb + (((size_t)b * 8 + hq) * S + t) * HD; k = a.kb + ((size_t)b * 2 + hk) * S * HD; v = a.vb + ((size_t)b * 2 + hk) * S * HD; }
        float qf[HD];
#pragma unroll
        for (int e = 0; e < HD; ++e) qf[e] = bf2f(q[e]);
        const int nk = isA ? 387 : 257;
        float mx = -1e30f;
        for (int i = lane; i < nk; i += 64) {
            int rel;
            if (isA) { const int br = i / 129, j = i % 129 - 64; rel = j * (br == 0 ? 1 : br == 1 ? 4 : 16); } else rel = i - 128;
            const int tk = t + rel; float lg = -1e30f;
            if (tk >= 0 && tk < S) { float d = 0.f; const bf16_t* kr = k + (size_t)tk * HD;
#pragma unroll
                for (int e = 0; e < HD; ++e) d += qf[e] * bf2f(kr[e]);
                lg = d + a.rel_bias[t5_bucket(rel) * 16 + head] * LOG2E; }
            pl[i] = lg; kl[i] = tk; mx = fmaxf(mx, lg);
        }
#pragma unroll
        for (int o = 1; o < 64; o <<= 1) mx = fmaxf(mx, pg8::shx(mx, lane, o));
        float sinkl = 0.f;
        if (!isA) { sinkl = a.sink[head - 8] * LOG2E; mx = fmaxf(mx, sinkl); }
        float sum = 0.f;
        for (int i = lane; i < nk; i += 64) { const float lg = pl[i]; const float pv = lg > -1e29f ? exp2f(lg - mx) : 0.f; pl[i] = pv; sum += pv; }
#pragma unroll
        for (int o = 1; o < 64; o <<= 1) sum += pg8::shx(sum, lane, o);
        if (!isA) sum += exp2f(sinkl - mx);
        asm volatile("s_waitcnt lgkmcnt(0)" ::: "memory");
        float acc = 0.f;
        for (int i = 0; i < nk; ++i) { const float pv = pl[i]; if (pv != 0.f) acc += pv * bf2f(v[(size_t)kl[i] * HD + lane]); }
        a.o[((size_t)b * S + t) * D + head * HD + lane] = f2bf(acc / sum);
    }
}

namespace att {
typedef short bf16x8 __attribute__((ext_vector_type(8)));
typedef short s16x4 __attribute__((ext_vector_type(4)));
typedef short v4i16_t __attribute__((ext_vector_type(4)));
typedef float f32x16 __attribute__((ext_vector_type(16)));
typedef unsigned u32x4 __attribute__((ext_vector_type(4)));
typedef float f32x2_t __attribute__((ext_vector_type(2))); typedef __bf16 bf16x2_t __attribute__((ext_vector_type(2)));
constexpr float NEG = -1e30f;
constexpr int WAVE_LDS = 8704, LUT_OFF = 8 * WAVE_LDS, LUTA_STRIDE = 200, LUTB_STRIDE = 328, LUTB_OFF = LUT_OFF + 3 * LUTA_STRIDE * 4, TAB_OFF = LUT_OFF + 8192, LSE_OFF = TAB_OFF + 65536, ATT_LDS_END = LSE_OFF + 2048;
static_assert(LUTB_OFF + 4 * LUTB_STRIDE * 4 <= TAB_OFF && ATT_LDS_END <= 147456, "attention LDS map");
__device__ __forceinline__ int crow(int r, int hi) { return (r & 3) + 8 * (r >> 2) + 4 * hi; }
__device__ __forceinline__ unsigned cvtpk(float lo, float hi) { f32x2_t v = {lo, hi}; bf16x2_t b = __builtin_convertvector(v, bf16x2_t); return __builtin_bit_cast(unsigned, b); }
__device__ __forceinline__ s16x4 vtr(const LAS unsigned char* p) { return __builtin_bit_cast(s16x4, __builtin_amdgcn_ds_read_tr16_b64_v4i16((LAS v4i16_t*)p)); }
__device__ __forceinline__ float halfmax(float v) { auto rr = __builtin_amdgcn_permlane32_swap(__float_as_uint(v), __float_as_uint(v), false, false); return fmaxf(__uint_as_float(rr[0]), __uint_as_float(rr[1])); }
__device__ __forceinline__ float halfsum(float v) { auto rr = __builtin_amdgcn_permlane32_swap(__float_as_uint(v), __float_as_uint(v), false, false); return __uint_as_float(rr[0]) + __uint_as_float(rr[1]); }

template <int NT>
__device__ __forceinline__ void qtile(const bf16_t* qrow, const bf16_t* kbase, const bf16_t* vbase, int tk0, int dstep, const LAS float* lut, float m0, float l0,
                                      LAS unsigned char* wl, int lane_in, f32x16 (&o)[2], float& m_out, float& l_out) {
    int lane = lane_in; asm volatile("" : "+v"(lane));
    const int i = lane & 31, hi = lane >> 5;
    LAS float* wsf = (LAS float*)(wl + 8192);
    constexpr int C = NT / 2;
    bf16x8 qf[4];
#pragma unroll
    for (int ks = 0; ks < 4; ++ks) qf[ks] = *(const bf16x8*)(qrow + 16 * ks + 8 * hi);
    const int vrow = lane >> 3, vsw = (lane & 7) ^ (((lane >> 4) & 1) << 2);
    const int rd_base = (4 * hi + ((lane & 15) >> 2)) * 128 + 32 * ((lane >> 4) & 1) + 8 * (lane & 3);
    const int bit3 = (lane >> 3) & 1;
    const int vb0 = rd_base + 64 * bit3, vb1 = rd_base + 64 * (1 - bit3);
    bf16x8 kf[4];
#define ATT_LOAD(j, buf) do { \
        { int tk = tk0 + (32 * (j) + i) * dstep; tk = tk < 0 ? 0 : (tk > S - 1 ? S - 1 : tk); const bf16_t* kp = kbase + (size_t)tk * HD + 8 * hi; \
          _Pragma("unroll") for (int ks = 0; ks < 4; ++ks) kf[ks] = *(const bf16x8*)(kp + 16 * ks); } \
        _Pragma("unroll") for (int i4 = 0; i4 < 4; ++i4) { int tk = tk0 + (32 * (j) + vrow + 8 * i4) * dstep; tk = tk < 0 ? 0 : (tk > S - 1 ? S - 1 : tk); \
          __builtin_amdgcn_global_load_lds((const unsigned*)(vbase + (size_t)tk * HD + 8 * vsw), (LAS unsigned*)(wl + (buf) * 4096 + i4 * 1024), 16, 0, 0); } } while (0)
    float m = m0, l = hi == 0 ? l0 : 0.f;
    o[0] = f32x16{}; o[1] = f32x16{};
    ATT_LOAD(C, 0);
#pragma unroll 1
    for (int s = 0; s < NT; ++s) {
        const int j = (s == 0) ? C : (s <= C ? s - 1 : s);
        LAS unsigned char* vbuf = wl + (s & 1) * 4096;
        asm volatile("s_waitcnt vmcnt(0)" ::: "memory");
        f32x16 p = __builtin_amdgcn_mfma_f32_32x32x16_bf16(kf[0], qf[0], f32x16{}, 0, 0, 0);
        p = __builtin_amdgcn_mfma_f32_32x32x16_bf16(kf[1], qf[1], p, 0, 0, 0);
        p = __builtin_amdgcn_mfma_f32_32x32x16_bf16(kf[2], qf[2], p, 0, 0, 0);
        p = __builtin_amdgcn_mfma_f32_32x32x16_bf16(kf[3], qf[3], p, 0, 0, 0);
        if (s + 1 < NT) { const int jn = (s + 1 <= C) ? s : s + 1; ATT_LOAD(jn, (s + 1) & 1); }
        const int first = tk0 + 32 * j * dstep, lastk = first + 31 * dstep;
        const bool inside = first >= 0 && lastk < S;
        const LAS float* lp = lut + 32 * j - i + 4 * hi;
#pragma unroll
        for (int r = 0; r < 16; ++r) { const int kk0 = (r & 3) + 8 * (r >> 2); p[r] += lp[kk0]; }
        if (j == 0) {
#pragma unroll
            for (int r = 0; r < 16; ++r) { if (crow(r, hi) < i) p[r] = NEG; }
        }
        if (j == NT - 1) {
#pragma unroll
            for (int r = 0; r < 16; ++r) { if (crow(r, hi) > i) p[r] = NEG; }
        }
        if (!inside) {
#pragma unroll
            for (int r = 0; r < 16; ++r) { const int tk = first + crow(r, hi) * dstep; if ((unsigned)tk >= (unsigned)S) p[r] = NEG; }
        }
        float rm = p[0];
#pragma unroll
        for (int r = 1; r < 16; ++r) rm = fmaxf(rm, p[r]);
        rm = halfmax(rm);
        if (__any(rm > m)) {
            const float mn = fmaxf(m, rm), alpha = __builtin_amdgcn_exp2f(m - mn);
            l *= alpha; m = mn;
            if (hi == 0) wsf[i] = alpha;
#pragma unroll
            for (int r = 0; r < 16; ++r) { const float a = wsf[crow(r, hi)]; o[0][r] *= a; o[1][r] *= a; }
        }
        float rs = 0.f;
#pragma unroll
        for (int r = 0; r < 16; ++r) { p[r] = __builtin_amdgcn_exp2f(p[r] - m); rs += p[r]; }
        l += rs;
        u32x4 pw0 = {cvtpk(p[0], p[1]), cvtpk(p[2], p[3]), cvtpk(p[4], p[5]), cvtpk(p[6], p[7])};
        u32x4 pw1 = {cvtpk(p[8], p[9]), cvtpk(p[10], p[11]), cvtpk(p[12], p[13]), cvtpk(p[14], p[15])};
        const bf16x8 pa0 = __builtin_bit_cast(bf16x8, pw0), pa1 = __builtin_bit_cast(bf16x8, pw1);
#pragma unroll
        for (int d0 = 0; d0 < 2; ++d0) {
            const LAS unsigned char* vp = vbuf + (d0 == 0 ? vb0 : vb1);
            const s16x4 a0 = vtr(vp), a1 = vtr(vp + 1024), b0 = vtr(vp + 2048), b1 = vtr(vp + 3072);
            const bf16x8 f0 = {a0[0], a0[1], a0[2], a0[3], a1[0], a1[1], a1[2], a1[3]}, f1 = {b0[0], b0[1], b0[2], b0[3], b1[0], b1[1], b1[2], b1[3]};
            o[d0] = __builtin_amdgcn_mfma_f32_32x32x16_bf16(pa0, f0, o[d0], 0, 0, 0);
            o[d0] = __builtin_amdgcn_mfma_f32_32x32x16_bf16(pa1, f1, o[d0], 0, 0, 0);
        }
    }
#undef ATT_LOAD
    m_out = m; l_out = halfsum(l);
}

constexpr float MLOW = -1.0e4f;
constexpr float THR = 8.0f;
template <int NT>
__device__ __forceinline__ void sm_tile(f32x16& p, const LAS float* lut, const int j, const int i, const int hi, const int first, const int dstep, const bool inside,
                                        float& m, float& l, f32x16 (&o)[2], LAS float* wsf, bf16x8& pa0, bf16x8& pa1) {
    const LAS float* lp = lut + 32 * j - i + 4 * hi;
#pragma unroll
    for (int r = 0; r < 16; ++r) p[r] += lp[(r & 3) + 8 * (r >> 2)];
    if (j == 0) {
#pragma unroll
        for (int r = 0; r < 16; ++r) { if (crow(r, hi) < i) p[r] = NEG; }
    }
    if (j == NT - 1) {
#pragma unroll
        for (int r = 0; r < 16; ++r) { if (crow(r, hi) > i) p[r] = NEG; }
    }
    if (!inside) {
#pragma unroll
        for (int r = 0; r < 16; ++r) { const int tk = first + crow(r, hi) * dstep; if ((unsigned)tk >= (unsigned)S) p[r] = NEG; }
    }
    float rm = fmaxf(p[0], p[1]);
#pragma unroll
    for (int r = 2; r < 16; ++r) rm = fmaxf(rm, p[r]);
    rm = halfmax(rm);
    if (__any(rm > m + THR)) {
        const float mn = fmaxf(m, rm), alpha = __builtin_amdgcn_exp2f(m - mn);
        l *= alpha; m = mn;
        if (hi == 0) wsf[i] = alpha;
#pragma unroll
        for (int r = 0; r < 16; ++r) { const float a = wsf[crow(r, hi)]; o[0][r] *= a; o[1][r] *= a; }
    }
    float rs = 0.f;
#pragma unroll
    for (int r = 0; r < 16; ++r) { p[r] = __builtin_amdgcn_exp2f(p[r] - m); rs += p[r]; }
    l += rs;
    u32x4 pw0 = {cvtpk(p[0], p[1]), cvtpk(p[2], p[3]), cvtpk(p[4], p[5]), cvtpk(p[6], p[7])};
    u32x4 pw1 = {cvtpk(p[8], p[9]), cvtpk(p[10], p[11]), cvtpk(p[12], p[13]), cvtpk(p[14], p[15])};
    pa0 = __builtin_bit_cast(bf16x8, pw0); pa1 = __builtin_bit_cast(bf16x8, pw1);
}
template <int NT, int SHIFT>
__device__ __forceinline__ void qtile2(const bf16_t* qrow0, const bf16_t* qrow1, const bf16_t* kbase, const bf16_t* vbase, int tk0, int dstep, const LAS float* lut0, const LAS float* lut1,
                                       float mi0, float li0, float mi1, float li1, LAS unsigned char* wl, int lane_in,
                                       f32x16 (&o0)[2], float& m0_out, float& l0_out, f32x16 (&o1)[2], float& m1_out, float& l1_out) {
    int lane = lane_in; asm volatile("" : "+v"(lane));
    const int i = lane & 31, hi = lane >> 5;
    LAS float* wsf = (LAS float*)(wl + 8192);
    bf16x8 qf0[4], qf1[4];
#pragma unroll
    for (int ks = 0; ks < 4; ++ks) { qf0[ks] = *(const bf16x8*)(qrow0 + 16 * ks + 8 * hi); qf1[ks] = *(const bf16x8*)(qrow1 + 16 * ks + 8 * hi); }
    const int vrow = lane >> 3, vsw = (lane & 7) ^ (((lane >> 4) & 1) << 2);
    const int rd_base = (4 * hi + ((lane & 15) >> 2)) * 128 + 32 * ((lane >> 4) & 1) + 8 * (lane & 3);
    const int bit3 = (lane >> 3) & 1;
    const int vb0 = rd_base + 64 * bit3, vb1 = rd_base + 64 * (1 - bit3);
    bf16x8 kf[4];
#define ATT_LOAD(j, buf) do { \
        { int tk = tk0 + (32 * (j) + i) * dstep; tk = tk < 0 ? 0 : (tk > S - 1 ? S - 1 : tk); const bf16_t* kp = kbase + (size_t)tk * HD + 8 * hi; \
          _Pragma("unroll") for (int ks = 0; ks < 4; ++ks) kf[ks] = *(const bf16x8*)(kp + 16 * ks); } \
        _Pragma("unroll") for (int i4 = 0; i4 < 4; ++i4) { int tk = tk0 + (32 * (j) + vrow + 8 * i4) * dstep; tk = tk < 0 ? 0 : (tk > S - 1 ? S - 1 : tk); \
          __builtin_amdgcn_global_load_lds((const unsigned*)(vbase + (size_t)tk * HD + 8 * vsw), (LAS unsigned*)(wl + (buf) * 4096 + i4 * 1024), 16, 0, 0); } } while (0)
    float m0 = mi0, l0 = hi == 0 ? li0 : 0.f, m1 = mi1, l1 = hi == 0 ? li1 : 0.f;
    o0[0] = f32x16{}; o0[1] = f32x16{}; o1[0] = f32x16{}; o1[1] = f32x16{};
    ATT_LOAD(0, 0);
#pragma unroll 1
    for (int jj = 0; jj < NT + SHIFT; ++jj) {
        LAS unsigned char* vbuf = wl + (jj & 1) * 4096;
        const bool a0 = jj < NT, a1 = jj >= SHIFT;
        const int first = tk0 + 32 * jj * dstep, lastk = first + 31 * dstep;
        const bool inside = first >= 0 && lastk < S, dead = lastk < 0 || first >= S;
        asm volatile("s_waitcnt vmcnt(0)" ::: "memory");
        f32x16 p0 = f32x16{}, p1 = f32x16{};
        bf16x8 pa00, pa01, pa10, pa11;
        if (!dead) {
            if (a0) {
#pragma unroll
                for (int ks = 0; ks < 4; ++ks) p0 = __builtin_amdgcn_mfma_f32_32x32x16_bf16(kf[ks], qf0[ks], p0, 0, 0, 0);
            }
            if (a1) {
#pragma unroll
                for (int ks = 0; ks < 4; ++ks) p1 = __builtin_amdgcn_mfma_f32_32x32x16_bf16(kf[ks], qf1[ks], p1, 0, 0, 0);
            }
        }
        if (jj + 1 < NT + SHIFT) ATT_LOAD(jj + 1, (jj + 1) & 1);
        if (!dead) {
            if (a0) sm_tile<NT>(p0, lut0, jj, i, hi, first, dstep, inside, m0, l0, o0, wsf, pa00, pa01);
            if (a1) sm_tile<NT>(p1, lut1, jj - SHIFT, i, hi, first, dstep, inside, m1, l1, o1, wsf, pa10, pa11);
#pragma unroll
            for (int d0 = 0; d0 < 2; ++d0) {
                const LAS unsigned char* vp = vbuf + (d0 == 0 ? vb0 : vb1);
                const s16x4 x0 = vtr(vp), x1 = vtr(vp + 1024), y0 = vtr(vp + 2048), y1 = vtr(vp + 3072);
                const bf16x8 f0 = {x0[0], x0[1], x0[2], x0[3], x1[0], x1[1], x1[2], x1[3]}, f1 = {y0[0], y0[1], y0[2], y0[3], y1[0], y1[1], y1[2], y1[3]};
                if (a0) { o0[d0] = __builtin_amdgcn_mfma_f32_32x32x16_bf16(pa00, f0, o0[d0], 0, 0, 0); o0[d0] = __builtin_amdgcn_mfma_f32_32x32x16_bf16(pa01, f1, o0[d0], 0, 0, 0); }
                if (a1) { o1[d0] = __builtin_amdgcn_mfma_f32_32x32x16_bf16(pa10, f0, o1[d0], 0, 0, 0); o1[d0] = __builtin_amdgcn_mfma_f32_32x32x16_bf16(pa11, f1, o1[d0], 0, 0, 0); }
            }
        }
    }
#undef ATT_LOAD
    m0_out = m0; l0_out = halfsum(l0); m1_out = m1; l1_out = halfsum(l1);
}

__device__ __forceinline__ void stage_o(const f32x16 (&o)[2], float m, float l, LAS unsigned char* wl, int lane_in) {
    int lane = lane_in; asm volatile("" : "+v"(lane));
    const int i = lane & 31, hi = lane >> 5;
    LAS float* wsf = (LAS float*)(wl + 8192);
    if (hi == 0) { wsf[i] = __builtin_amdgcn_rcpf(l); wsf[32 + i] = m + __builtin_amdgcn_logf(l); }
    LAS bf16_t* stg = (LAS bf16_t*)wl;
#pragma unroll
    for (int r = 0; r < 16; ++r) { const int q = crow(r, hi); const float inv = wsf[q];
        stg[q * 64 + i] = (bf16_t)(cvtpk(o[0][r] * inv, 0.f) & 0xffffu); stg[q * 64 + 32 + i] = (bf16_t)(cvtpk(o[1][r] * inv, 0.f) & 0xffffu); }
}
__device__ __forceinline__ float bflo(unsigned w) { return __uint_as_float(w << 16); }
__device__ __forceinline__ float bfhi(unsigned w) { return __uint_as_float(w & 0xffff0000u); }
__device__ __forceinline__ unsigned mix2(unsigned a, unsigned b, float wa, float wb) { return cvtpk(wa * bflo(a) + wb * bflo(b), wa * bfhi(a) + wb * bfhi(b)); }

struct Tensors { const bf16_t *qa, *ka, *va, *qb, *kb, *vb; const float* rel_bias; const float* sink; bf16_t* o; };
__device__ __forceinline__ void finish_a(const f32x16 (&o)[2], float m, float l, int pass, int d, int lam0, int rr, LAS unsigned char* wl, LAS unsigned char* tab, LAS float* lsetab, bf16_t* orow0, int lane_in) {
    LAS float* wsf = (LAS float*)(wl + 8192);
    stage_o(o, m, l, wl, lane_in);
    int lane = lane_in; asm volatile("" : "+v"(lane));
#pragma unroll
    for (int i4 = 0; i4 < 4; ++i4) {
        const int qi = (lane >> 3) + 8 * i4, ch = lane & 7, tau = d * (lam0 + qi) + rr;
        u32x4 v = *(const LAS u32x4*)(wl + qi * 128 + ch * 16);
        const float Lb = wsf[32 + qi];
        LAS u32x4* te = (LAS u32x4*)(tab + tau * 128 + ch * 16);
        if (pass == 0) { *te = v; if (ch == 0) lsetab[tau] = Lb; }
        else {
            const u32x4 tv = *te; const float La = lsetab[tau];
            const float Lm = fmaxf(La, Lb), sa = __builtin_amdgcn_exp2f(La - Lm), sb = __builtin_amdgcn_exp2f(Lb - Lm), tot = sa + sb, rt = __builtin_amdgcn_rcpf(tot), wa = sa * rt, wb = sb * rt;
            u32x4 w; w.x = mix2(tv.x, v.x, wa, wb); w.y = mix2(tv.y, v.y, wa, wb); w.z = mix2(tv.z, v.z, wa, wb); w.w = mix2(tv.w, v.w, wa, wb);
            if (pass == 1) { *te = w; if (ch == 0) lsetab[tau] = Lm + __builtin_amdgcn_logf(tot); }
            else *(u32x4*)(orow0 + (size_t)tau * D + ch * 8) = w;
        }
    }
}


__device__ __forceinline__ int bucket(int rel) {
    const int n = rel < 0 ? -rel : rel; const int ret = rel > 0 ? 16 : 0;
    if (n < 8) return ret + n;
    int large = 8 + (int)(logf((float)n / 8.0f) / 4.852030263919617f * 8.0f);
    large = large < 15 ? large : 15;
    return ret + large;
}

__device__ __forceinline__ void attn_unit(const Tensors& T, int u, LAS unsigned char* lds, int wave, int lane) {
    LAS unsigned char* wl = lds + wave * WAVE_LDS;
    LAS float* wsf = (LAS float*)(wl + 8192);
    LAS float* lutA = (LAS float*)(lds + LUT_OFF); LAS float* lutB = (LAS float*)(lds + LUTB_OFF);
    LAS unsigned char* tab = lds + TAB_OFF; LAS float* lsetab = (LAS float*)(lds + LSE_OFF);
    const int tid = wave * 64 + lane;
    const int i = lane & 31;
    {
        const int bh = u >> 3, blk = u & 7, b = bh >> 3, h = bh & 7, t0 = blk * 512;
        const bf16_t* qbase = T.qa + (size_t)bh * S * HD; const bf16_t* kbase = T.ka + (size_t)bh * S * HD; const bf16_t* vbase = T.va + (size_t)bh * S * HD;
        __syncthreads();
        for (int e = tid; e < 3 * 129; e += 512) { const int c = e / 129, idx = e % 129, d = c == 0 ? 1 : (c == 1 ? 4 : 16);
            lutA[c * LUTA_STRIDE + 32 + idx] = T.rel_bias[bucket((idx - 64) * d) * 16 + h] * LOG2E; }
        __syncthreads();
        bf16_t* orow0 = T.o + ((size_t)b * S + t0) * D + h * HD;
#pragma unroll 1
        for (int pass = 0; pass < 3; ++pass) {
            const int c = 2 - pass, d = c == 0 ? 1 : (c == 1 ? 4 : 16);
            const LAS float* lt = lutA + c * LUTA_STRIDE + 32;
            if (c == 2) {
#pragma unroll 1
                for (int tt = 0; tt < 2; ++tt) { const int rr = 2 * wave + tt;
                    f32x16 o1[2]; float m1, l1;
                    qtile<5>(qbase + (size_t)(t0 + d * i + rr) * HD, kbase, vbase, t0 - 64 * d + rr, d, lt, NEG, 0.f, wl, lane, o1, m1, l1);
                    finish_a(o1, m1, l1, pass, d, 0, rr, wl, tab, lsetab, orow0, lane); }
            } else {
                const int Tq = 2 * wave, rr = c == 1 ? (Tq >> 2) : 0, lamA = 32 * (c == 1 ? (Tq & 3) : Tq);
                f32x16 oA[2], oB[2]; float mA, lA, mB, lB;
                qtile2<5, 1>(qbase + (size_t)(t0 + d * (lamA + i) + rr) * HD, qbase + (size_t)(t0 + d * (lamA + 32 + i) + rr) * HD, kbase, vbase, t0 + d * (lamA - 64) + rr, d, lt, lt,
                             MLOW, 0.f, MLOW, 0.f, wl, lane, oA, mA, lA, oB, mB, lB);
                finish_a(oA, mA, lA, pass, d, lamA, rr, wl, tab, lsetab, orow0, lane);
                finish_a(oB, mB, lB, pass, d, lamA + 32, rr, wl, tab, lsetab, orow0, lane);
            }
            __syncthreads();
        }
    }
    {
        const int bk = u >> 5, blk = u & 31, b = bk >> 1, hk = bk & 1, t0 = blk * 128;
        const bf16_t* kbase = T.kb + (size_t)bk * S * HD; const bf16_t* vbase = T.vb + (size_t)bk * S * HD;
        for (int e = tid; e < 4 * 257; e += 512) { const int g = e / 257, idx = e % 257;
            lutB[g * LUTB_STRIDE + 32 + idx] = T.rel_bias[bucket(idx - 128) * 16 + 8 + 4 * hk + g] * LOG2E; }
        __syncthreads();
        const int qt = wave & 3, g0 = 2 * (wave >> 2), hq0 = 4 * hk + g0;
        const int tq = t0 + 32 * qt + i, tk0 = t0 + 32 * qt - 128;
        f32x16 oA[2], oB[2]; float mA, lA, mB, lB;
        qtile2<9, 0>(T.qb + (((size_t)b * 8 + hq0) * S + tq) * HD, T.qb + (((size_t)b * 8 + hq0 + 1) * S + tq) * HD, kbase, vbase, tk0, 1,
                     lutB + g0 * LUTB_STRIDE + 32, lutB + (g0 + 1) * LUTB_STRIDE + 32, T.sink[hq0] * LOG2E, 1.0f, T.sink[hq0 + 1] * LOG2E, 1.0f, wl, lane, oA, mA, lA, oB, mB, lB);
        bf16_t* ob0 = T.o + ((size_t)b * S + t0 + 32 * qt) * D + (8 + hq0) * HD;
        stage_o(oA, mA, lA, wl, lane);
#pragma unroll
        for (int i4 = 0; i4 < 4; ++i4) { const int qi = (lane >> 3) + 8 * i4, ch = lane & 7; *(u32x4*)(ob0 + (size_t)qi * D + ch * 8) = *(const LAS u32x4*)(wl + qi * 128 + ch * 16); }
        stage_o(oB, mB, lB, wl, lane);
#pragma unroll
        for (int i4 = 0; i4 < 4; ++i4) { const int qi = (lane >> 3) + 8 * i4, ch = lane & 7; *(u32x4*)(ob0 + HD + (size_t)qi * D + ch * 8) = *(const LAS u32x4*)(wl + qi * 128 + ch * 16); }
    }
}
}

#define XB_TMO      128
#define XB_XCNT(j)  (256  + 64 * (j))
#define XB_XSUB(j)  (1280 + 64 * (j))
#define XB_XGEN(j)  (2304 + 64 * (j))
#define XB_TOP      3328
#define XB_TOPGEN   3392
#define XCD_BAR_WORDS 3456
#define XB_SPIN_CAP (1u << 18)

__device__ __forceinline__ unsigned xb_ld(unsigned* p)              { return __hip_atomic_load(p, __ATOMIC_RELAXED, __HIP_MEMORY_SCOPE_AGENT); }
__device__ __forceinline__ unsigned xb_add(unsigned* p, unsigned v) { return __hip_atomic_fetch_add(p, v, __ATOMIC_RELAXED, __HIP_MEMORY_SCOPE_AGENT); }
__device__ __forceinline__ unsigned xb_xcc_id() { return (unsigned)__builtin_amdgcn_s_getreg((3 << 11) | 20) & 0xFu; }
#define XB_SPIN(cond, bar) do { unsigned _sp = 0; while (cond) { __builtin_amdgcn_s_sleep(1); \
    if ((++_sp & 255u) == 0u) { if (xb_ld(&(bar)[XB_TMO])) break; if (_sp > XB_SPIN_CAP) { atomicAdd(&(bar)[XB_TMO], 1u); break; } } } } while (0)

struct XcdBarrier {
    unsigned* bar; unsigned x;
    volatile LAS unsigned* st;
};

__device__ __forceinline__ XcdBarrier xcd_barrier_post(unsigned* bar, volatile LAS unsigned* st) {
    XcdBarrier b; b.bar = bar; b.x = xb_xcc_id(); b.st = st;
    if (threadIdx.x == 0) (void)xb_add(&bar[XB_XCNT(b.x)], 1u);
    return b;
}
__device__ __forceinline__ void xcd_barrier_complete(unsigned* bar, unsigned x, unsigned& nloc, unsigned& nx) {
    const unsigned G = gridDim.x * gridDim.y * gridDim.z;
    unsigned sum, cnt, mine, sp = 0u;
    for (;;) {
        sum = 0u; cnt = 0u; mine = 0u;
#pragma unroll
        for (unsigned j = 0; j < 16; ++j) { const unsigned c = xb_ld(&bar[XB_XCNT(j)]); sum += c; cnt += (c > 0u) ? 1u : 0u; mine = (j == x) ? c : mine; }
        if (sum == G) break;
        __builtin_amdgcn_s_sleep(1);
        if ((++sp & 255u) == 0u) { if (xb_ld(&bar[XB_TMO])) break; if (sp > XB_SPIN_CAP) { atomicAdd(&bar[XB_TMO], 1u); break; } }
    }
    nloc = mine > 0u ? mine : 1u; nx = cnt > 0u ? cnt : 1u;
}

__device__ __forceinline__ void xcd_barrier(const XcdBarrier& b, const bool is_t0) {
    asm volatile("s_waitcnt vmcnt(0)" ::: "memory");
    __syncthreads();
    if (is_t0) {
        unsigned* bar = b.bar;
        __builtin_amdgcn_s_waitcnt(0);
        unsigned nloc = b.st[0], nx = b.st[1];
        if (nloc == 0u) { xcd_barrier_complete(bar, b.x, nloc, nx); b.st[0] = nloc; b.st[1] = nx; }
        const unsigned old = xb_add(&bar[XB_XSUB(b.x)], 1u);
        const unsigned gen = old / nloc;
        if (old + 1u == (gen + 1u) * nloc) {
            __builtin_amdgcn_fence(__ATOMIC_RELEASE, "agent");
            asm volatile("s_waitcnt vmcnt(0)" ::: "memory");
            const unsigned og = xb_add(&bar[XB_TOP], 1u);
            const unsigned tg = og / nx;
            if (og + 1u == (tg + 1u) * nx) xb_add(&bar[XB_TOPGEN], 1u);
            else XB_SPIN(xb_ld(&bar[XB_TOPGEN]) == tg, bar);
            __builtin_amdgcn_fence(__ATOMIC_ACQUIRE, "agent");
            xb_add(&bar[XB_XGEN(b.x)], 1u);
            asm volatile("s_waitcnt vmcnt(0)" ::: "memory");
        } else {
            XB_SPIN(xb_ld(&bar[XB_XGEN(b.x)]) == gen, bar);
            __builtin_amdgcn_fence(__ATOMIC_ACQUIRE, "agent");
            asm volatile("s_waitcnt vmcnt(0)" ::: "memory");
        }
    }
    __syncthreads();
}
typedef const float* cfptr_t; typedef float* fptr_t; typedef unsigned char* ucptr_t;
typedef __attribute__((address_space(4))) const unsigned char* kargp_t;
struct KA {
    kargp_t kp;
    __device__ __forceinline__ const float* in(int i) const { return *(__attribute__((address_space(4))) const cfptr_t*)(kp + 8 * i); }
    __device__ __forceinline__ float* out() const { return *(__attribute__((address_space(4))) const fptr_t*)(kp + 160); }
    __device__ __forceinline__ unsigned char* ws() const { return *(__attribute__((address_space(4))) const ucptr_t*)(kp + 168); }
    __device__ __forceinline__ int ph_lo() const { return *(__attribute__((address_space(4))) const int*)(kp + 176); }
    __device__ __forceinline__ int ph_hi() const { return *(__attribute__((address_space(4))) const int*)(kp + 180); }
};
static_assert(sizeof(Args) == 184, "Args layout");
#define FRESH_LANE() ({ int l_; asm volatile("v_mbcnt_lo_u32_b32 %0, -1, 0\n\tv_mbcnt_hi_u32_b32 %0, -1, %0" : "=v"(l_)); l_; })
template <int PH>
__device__ __forceinline__ void run_phase(const KA& a, LAS unsigned char* lds, const int wave0, const int rep) {
    const int G = gridDim.x, bx = blockIdx.x, wave = wave0;
    const int vcu = (G % 8 == 0) ? (bx % 8) * (G / 8) + bx / 8 : bx;
    const int gw = vcu * NWAVES + wave, NGW = G * NWAVES;
    unsigned char* ws = a.ws();
    bf16_t* xb = (bf16_t*)(ws + WS_XB); float* ssp0 = (float*)(ws + WS_SSP); float* ssp1 = ssp0 + (size_t)M * 16;
    bf16_t* xb2 = (bf16_t*)(ws + WS_W);
    bf16_t* act = (bf16_t*)(ws + WS_R + R_ACT); bf16_t* ob = (bf16_t*)(ws + WS_R + R_O);
    bf16_t* pb = (bf16_t*)(ws + WS_PB); bf16_t* proj = (bf16_t*)(ws + WS_PROJ);
    const float cscale = rep == 0 ? 1.0f : 0.0f;
    if constexpr (PH == 0) {
        prologue_phase(a, lds, gw, NGW, wave, FRESH_LANE());
        convert_p(a.in(1), pb, bx * NWAVES * 64 + wave0 * 64 + FRESH_LANE(), G * NWAVES * 64);
    } else {
        constexpr int l = (PH - 1) >> 3, k = (PH - 1) & 7;
        const bf16_t* wl = (const bf16_t*)(ws + WS_W) + (size_t)l * W_LAYER;
        const float* xin = (l == 0 && k <= 1 && rep == 0) ? a.in(0) : a.out();
        if constexpr (k == 0 || k == 5) {
            pg8::Gemm g{(k == 0 && l == 1) ? xb2 : xb, wl + (k == 0 ? WO_F1IN : WO_F2IN), M, 2 * DFF, D}; pg8::StaticOrder S; S.init(M, 2 * DFF, G, bx);
            pg8::EpiSwiglu E{act, ssp0};
            pg8::gemm_phase<pg8::EpiSwiglu, pg8::StaticOrder, true, true>(lds, g, S, E, wave0 * 64 + FRESH_LANE());
        } else if constexpr (k == 1 || k == 6) {
            pg8::Gemm g{act, wl + (k == 1 ? WO_F1OUT : WO_F2OUT), M, D, DFF}; pg8::StaticOrder S; S.init(M, D, G, bx);
            pg8::EpiResid E{xin, a.out(), xb, ssp1, 0.5f * cscale};
            pg8::gemm_phase<pg8::EpiResid, pg8::StaticOrder, true, true>(lds, g, S, E, wave0 * 64 + FRESH_LANE());
        } else if constexpr (k == 2) {
            { pg8::Gemm g{xb, wl + WO_QKV, M, QKVW, D}; pg8::StaticOrder S; S.init(M, QKVW, G, bx);
              pg8::EpiQkv E; E.ssp = ssp1;
              E.qa = (bf16_t*)(ws + WS_R + R_QA); E.ka = (bf16_t*)(ws + WS_R + R_KA); E.va = (bf16_t*)(ws + WS_R + R_VA);
              E.qb = (bf16_t*)(ws + WS_R + R_QB); E.kb = (bf16_t*)(ws + WS_R + R_KB); E.vb = (bf16_t*)(ws + WS_R + R_VB);
              E.qna = a.in(8) + l * HD; E.kna = a.in(9) + l * HD; E.qnb = a.in(10) + l * HD; E.knb = a.in(11) + l * HD;
              pg8::gemm_phase<pg8::EpiQkv, pg8::StaticOrder, true, true>(lds, g, S, E, wave0 * 64 + FRESH_LANE()); }
            { pg8::Gemm g{pb, wl + WO_WP, M, D, PLE}; pg8::StaticOrder S; S.init(M, D, G, bx);
              pg8::EpiStoreBf16 E{proj, D};
              pg8::gemm_phase<pg8::EpiStoreBf16, pg8::StaticOrder, true, true>(lds, g, S, E, wave0 * 64 + FRESH_LANE()); }
        } else if constexpr (k == 3) {
            att::Tensors T; T.qa = (bf16_t*)(ws + WS_R + R_QA); T.ka = (bf16_t*)(ws + WS_R + R_KA); T.va = (bf16_t*)(ws + WS_R + R_VA);
            T.qb = (bf16_t*)(ws + WS_R + R_QB); T.kb = (bf16_t*)(ws + WS_R + R_KB); T.vb = (bf16_t*)(ws + WS_R + R_VB);
            T.rel_bias = a.in(2); T.sink = a.in(12) + l * 8; T.o = ob;
            const int lane = FRESH_LANE();
            for (int u = vcu; u < 256; u += G) att::attn_unit(T, u, lds, wave, lane);
        } else if constexpr (k == 4) {
            if (l + 1 < DEPTH) { convert_p(a.in(1) + (size_t)(l + 1) * M * PLE, pb, bx * NWAVES * 64 + wave0 * 64 + FRESH_LANE(), G * NWAVES * 64); asm volatile("s_waitcnt vmcnt(0)" ::: "memory"); }
            pg8::Gemm g{ob, wl + WO_WO, M, D, D}; pg8::StaticOrder S; S.init(M, D, G, bx);
            pg8::EpiResid E{xin, a.out(), xb, ssp0, 1.0f * cscale};
            pg8::gemm_phase<pg8::EpiResid, pg8::StaticOrder, true, true>(lds, g, S, E, wave0 * 64 + FRESH_LANE());
        } else {
            pg8::Gemm g{xb, wl + WO_WG, M, D, D}; pg8::StaticOrder S; S.init(M, D, G, bx);
            pg8::EpiGate E{xin, a.out(), xb2, ssp0, ssp1, proj, cscale};
            pg8::gemm_phase<pg8::EpiGate, pg8::StaticOrder, true, true>(lds, g, S, E, wave0 * 64 + FRESH_LANE());
        }
    }
}

__global__ void __launch_bounds__(NWAVES * 64, 2) mk_fwd(Args) {
    extern __shared__ __attribute__((aligned(16))) unsigned char lds_raw[];
    LAS unsigned char* lds = (LAS unsigned char*)lds_raw;
    cg::grid_group grid = cg::this_grid();
    const int wave0 = __builtin_amdgcn_readfirstlane(threadIdx.x >> 6);
    volatile LAS unsigned* bst = (volatile LAS unsigned*)((LAS unsigned char*)lds_raw + LDS_BYTES - 64);
    if (threadIdx.x < 2) bst[threadIdx.x] = 0u;
    __syncthreads();
    KA a; a.kp = (kargp_t)__builtin_amdgcn_kernarg_segment_ptr();
    const int ph_lo = a.ph_lo(), ph_hi = a.ph_hi();
    XcdBarrier xbar; xbar.bar = (unsigned*)(a.ws() + WS_CTL) + 4096; xbar.x = 0; xbar.st = bst;
    if (ph_hi - ph_lo > 1) xbar = xcd_barrier_post((unsigned*)(a.ws() + WS_CTL) + 4096, bst);
#define MK_NREP(P) ((PROBE_N > 0 && (((P) == 0 && PROBE_K == 8) || ((P) > 0 && (((P) - 1) & 7) == PROBE_K))) ? 1 + PROBE_N : 1)
#define MK_PHASE(P) if (ph_lo <= (P) && (P) < ph_hi) { _Pragma("unroll 1") for (int rep = 0; rep < MK_NREP(P); ++rep) { asm volatile("" : "+s"(a.kp)); run_phase<(P)>(a, lds, wave0, rep); \
        if ((P) + 1 < ph_hi || rep + 1 < MK_NREP(P)) { if ((P) == 0) grid.sync(); else xcd_barrier(xbar, wave0 == 0 && FRESH_LANE() == 0); } } }
    MK_PHASE(0) MK_PHASE(1) MK_PHASE(2) MK_PHASE(3) MK_PHASE(4) MK_PHASE(5) MK_PHASE(6) MK_PHASE(7) MK_PHASE(8)
    MK_PHASE(9) MK_PHASE(10) MK_PHASE(11) MK_PHASE(12) MK_PHASE(13) MK_PHASE(14) MK_PHASE(15) MK_PHASE(16)
    static_assert(NPHASE == 17, "phase program");
}

#ifndef FAST_MASK
#define FAST_MASK 0x1ffffu
#endif
extern "C" void kernel_launch(void* const* d_in, const int* in_sizes, int n_in, void* d_out, int out_size, void* d_ws, size_t ws_size, hipStream_t stream) {
    static int grid = 0;
    if (grid == 0) {
        if (n_in != 20 || in_sizes[0] != M * D || out_size != M * D || ws_size < WS_END) { fprintf(stderr, "kernel_launch: unexpected shapes (n_in %d, ws %zu)\n", n_in, ws_size); grid = -1; return; }
        int dev = 0, cus = 0, per_cu = 0;
        if (hipGetDevice(&dev) != hipSuccess || hipDeviceGetAttribute(&cus, hipDeviceAttributeMultiprocessorCount, dev) != hipSuccess) { grid = -1; return; }
        if (hipFuncSetAttribute((const void*)mk_fwd, hipFuncAttributeMaxDynamicSharedMemorySize, LDS_BYTES) != hipSuccess) { fprintf(stderr, "kernel_launch: hipFuncSetAttribute failed\n"); grid = -1; return; }
        if (hipOccupancyMaxActiveBlocksPerMultiprocessor(&per_cu, (const void*)mk_fwd, NWAVES * 64, LDS_BYTES) != hipSuccess || per_cu < 1) { fprintf(stderr, "kernel_launch: occupancy query says %d\n", per_cu); grid = -1; (void)hipGetLastError(); return; }
        grid = cus;
    }
    if (grid < 0) return;
    (void)hipMemsetAsync((char*)d_ws + WS_CTL, 0, 1 * MiB, stream);
    Args a{};
    for (int i = 0; i < 20; ++i) a.in[i] = (const float*)d_in[i];
    a.out = (float*)d_out; a.ws = (unsigned char*)d_ws;
    const unsigned fast = FAST_MASK;
    if (fast == 0x1ffffu) {
        a.ph_lo = 0; a.ph_hi = NPHASE;
        void* args[] = {&a};
        hipError_t e = hipLaunchCooperativeKernel((const void*)mk_fwd, dim3(grid), dim3(NWAVES * 64), args, LDS_BYTES, stream);
        if (e != hipSuccess) fprintf(stderr, "kernel_launch: cooperative launch failed: %s (grid %d)\n", hipGetErrorString(e), grid);
        return;
    }
    unsigned char* ws = (unsigned char*)d_ws; float* out = (float*)d_out;
    bf16_t* xb = (bf16_t*)(ws + WS_XB); bf16_t* xb2 = (bf16_t*)(ws + WS_W); float* ssp0 = (float*)(ws + WS_SSP); float* ssp1 = ssp0 + (size_t)M * 16;
    bf16_t* act = (bf16_t*)(ws + WS_R + R_ACT); bf16_t* ob = (bf16_t*)(ws + WS_R + R_O);
    QkvOut qo; qo.qa = (bf16_t*)(ws + WS_R + R_QA); qo.ka = (bf16_t*)(ws + WS_R + R_KA); qo.va = (bf16_t*)(ws + WS_R + R_VA);
    qo.qb = (bf16_t*)(ws + WS_R + R_QB); qo.kb = (bf16_t*)(ws + WS_R + R_KB); qo.vb = (bf16_t*)(ws + WS_R + R_VB);
    for (int ph = 0; ph < NPHASE; ++ph) {
        if ((fast >> ph) & 1u) { a.ph_lo = ph; a.ph_hi = ph + 1; hipLaunchKernelGGL(mk_fwd, dim3(grid), dim3(NWAVES * 64), LDS_BYTES, stream, a); continue; }
        if (ph == 0) { rowstat_kernel<<<M / 4, 256, 0, stream>>>(a.in[0], xb, ssp0); continue; }
        const int l = (ph - 1) >> 3, k = (ph - 1) & 7;
        const float* xin = (l == 0 && k <= 1) ? a.in[0] : out;
        bf16_t* xbl = (l == 1) ? xb2 : xb;
        switch (k) {
        case 0: naive_ffn_in<<<dim3(DFF / 128, M / 128), 256, 0, stream>>>(xbl, ssp0, a.in[3] + l * D, a.in[4] + (size_t)l * D * 2 * DFF, act); break;
        case 1: naive_resid<<<dim3(D / 128, M / 128), 256, 0, stream>>>(act, DFF, a.in[5] + (size_t)l * DFF * D, xin, out, 0.5f); rowstat_kernel<<<M / 4, 256, 0, stream>>>(out, xb, ssp1); break;
        case 2: qo.qna = a.in[8] + l * HD; qo.kna = a.in[9] + l * HD; qo.qnb = a.in[10] + l * HD; qo.knb = a.in[11] + l * HD;
                naive_qkv<<<dim3(QKVW / 128, M / 128), 256, 0, stream>>>(xb, ssp1, a.in[6] + l * D, a.in[7] + (size_t)l * D * QKVW, qo); break;
        case 3: { AttnIn ai; ai.qa = qo.qa; ai.ka = qo.ka; ai.va = qo.va; ai.qb = qo.qb; ai.kb = qo.kb; ai.vb = qo.vb; ai.rel_bias = a.in[2]; ai.sink = a.in[12] + l * 8; ai.o = ob;
                naive_attn<<<dim3(S / 4, 16, NB), 256, 0, stream>>>(ai); } break;
        case 4: naive_resid<<<dim3(D / 128, M / 128), 256, 0, stream>>>(ob, D, a.in[13] + (size_t)l * D * D, out, out, 1.0f); rowstat_kernel<<<M / 4, 256, 0, stream>>>(out, xb, ssp0); break;
        case 5: naive_ffn_in<<<dim3(DFF / 128, M / 128), 256, 0, stream>>>(xb, ssp0, a.in[14] + l * D, a.in[15] + (size_t)l * D * 2 * DFF, act); break;
        case 6: naive_resid<<<dim3(D / 128, M / 128), 256, 0, stream>>>(act, DFF, a.in[16] + (size_t)l * DFF * D, out, out, 0.5f); rowstat_kernel<<<M / 4, 256, 0, stream>>>(out, xb, ssp1); break;
        case 7: naive_ple<<<dim3(D / 128, M / 128), 256, 0, stream>>>(xb, ssp1, a.in[17] + l * D, a.in[18] + (size_t)l * D * D, a.in[1] + (size_t)l * M * PLE, a.in[19] + (size_t)l * PLE * D, out, out);
                rowstat_kernel<<<M / 4, 256, 0, stream>>>(out, xb2, ssp0); break;
        }
    }
}
```

```cpp
#include <hip/hip_runtime.h>
#include <cstdio>
#include <cstdint>
#ifndef ATT_FAST
#define ATT_FAST 1
#endif
#ifndef PROBE_N
#define PROBE_N 0
#define PROBE_K -1
#endif
#ifndef USE_CG_SYNC
#define USE_CG_SYNC 0
#endif
#ifndef PROBE_NULL_EPI
#define PROBE_NULL_EPI 0
#endif

typedef unsigned short bf16_t;
constexpr int NB = 4, S = 4096, D = 1024, M = NB * S, DFF = 2816, QKVW = 2304, PLE = 256, DEPTH = 2, HD = 64;
constexpr float EPS = 1e-6f;
constexpr float QSCALE = 0.125f * 1.4426950408889634f;
constexpr float LOG2E = 1.4426950408889634f;

constexpr size_t MiB = 1u << 20;
constexpr size_t WS_CTL = 0, WS_W = 1 * MiB, WS_XB = 85 * MiB, WS_R = 117 * MiB, WS_PB = 221 * MiB, WS_PROJ = 229 * MiB, WS_SSP = 261 * MiB, WS_END = 263 * MiB + 512 * 1024;
constexpr size_t R_QA = 0, R_KA = 16 * MiB, R_VA = 32 * MiB, R_QB = 48 * MiB, R_KB = 64 * MiB, R_VB = 68 * MiB, R_O = 72 * MiB, R_ACT = 0;

__device__ __forceinline__ float bf2f(bf16_t v) { return __uint_as_float(((unsigned)v) << 16); }
__device__ __forceinline__ bf16_t f2bf(float f) { unsigned u = __float_as_uint(f); return (bf16_t)((u + 0x7fffu + ((u >> 16) & 1u)) >> 16); }

__global__ void __launch_bounds__(256) rowstat_kernel(const float* __restrict__ x, bf16_t* __restrict__ xb, float* __restrict__ ssp) {
    const int wave = threadIdx.x >> 6, lane = threadIdx.x & 63;
    const int row = blockIdx.x * 4 + wave;
    const float4* xr = (const float4*)(x + (size_t)row * D);
    float s = 0.f;
#pragma unroll
    for (int j = 0; j < 4; ++j) {
        float4 v = xr[lane + 64 * j];
        s += v.x * v.x + v.y * v.y + v.z * v.z + v.w * v.w;
        ushort4 o; o.x = f2bf(v.x); o.y = f2bf(v.y); o.z = f2bf(v.z); o.w = f2bf(v.w);
        ((ushort4*)(xb + (size_t)row * D))[lane + 64 * j] = o;
    }
#pragma unroll
    for (int o = 1; o < 64; o <<= 1) s += __shfl_xor(s, o);
    if (lane < 4) { float4 r; r.x = lane == 0 ? s : 0.f; r.y = 0.f; r.z = 0.f; r.w = 0.f; ((float4*)ssp)[row * 4 + lane] = r; }
}

__device__ __forceinline__ float row_rstd(const float* ssp, int row) {
    float s = 0.f;
#pragma unroll
    for (int j = 0; j < 4; ++j) { const float4 v = ((const float4*)ssp)[row * 4 + j]; s += (v.x + v.y) + (v.z + v.w); }
    return rsqrtf(s * (1.0f / D) + EPS);
}

template <typename AT> __device__ __forceinline__ float ldA(const AT* p);
template <> __device__ __forceinline__ float ldA<bf16_t>(const bf16_t* p) { return bf2f(*p); }
template <> __device__ __forceinline__ float ldA<float>(const float* p) { return *p; }

template <typename AT>
__device__ __forceinline__ void accum_tile(const AT* A, int lda, int K, const float* gain, const float* W, int ldw, int row0, int wcol0, float (&acc)[8][8], float* As, float* Bs) {
    const int tid = threadIdx.x, tx = tid & 15, ty = tid >> 4;
    for (int k0 = 0; k0 < K; k0 += 8) {
        __syncthreads();
#pragma unroll
        for (int i = 0; i < 4; ++i) { const int idx = tid + i * 256, r = idx >> 3, kk = idx & 7;
            As[kk * 132 + r] = ldA<AT>(A + (size_t)(row0 + r) * lda + k0 + kk) * (gain ? gain[k0 + kk] : 1.0f); }
#pragma unroll
        for (int i = 0; i < 4; ++i) { const int idx = tid + i * 256, kk = idx >> 7, c = idx & 127;
            Bs[kk * 128 + c] = W[(size_t)(k0 + kk) * ldw + wcol0 + c]; }
        __syncthreads();
#pragma unroll
        for (int kk = 0; kk < 8; ++kk) {
            float a[8], b[8];
#pragma unroll
            for (int i = 0; i < 8; ++i) a[i] = As[kk * 132 + ty * 8 + i];
#pragma unroll
            for (int j = 0; j < 8; ++j) b[j] = Bs[kk * 128 + tx * 8 + j];
#pragma unroll
            for (int i = 0; i < 8; ++i)
#pragma unroll
                for (int j = 0; j < 8; ++j) acc[i][j] += a[i] * b[j];
        }
    }
}
#define ZERO_ACC(acc) do { _Pragma("unroll") for (int i = 0; i < 8; ++i) _Pragma("unroll") for (int j = 0; j < 8; ++j) acc[i][j] = 0.f; } while (0)

__global__ void __launch_bounds__(256) naive_ffn_in(const bf16_t* xb, const float* ssp, const float* gain, const float* Win, bf16_t* act) {
    __shared__ float As[8 * 132]; __shared__ float Bs[8 * 128];
    const int row0 = blockIdx.y * 128, col0 = blockIdx.x * 128, tx = threadIdx.x & 15, ty = threadIdx.x >> 4;
    float ag[8][8], au[8][8]; ZERO_ACC(ag); ZERO_ACC(au);
    accum_tile<bf16_t>(xb, D, D, gain, Win, 2 * DFF, row0, col0, ag, As, Bs);
    accum_tile<bf16_t>(xb, D, D, gain, Win, 2 * DFF, row0, DFF + col0, au, As, Bs);
#pragma unroll
    for (int i = 0; i < 8; ++i) { const int row = row0 + ty * 8 + i; const float rs = row_rstd(ssp, row);
#pragma unroll
        for (int j = 0; j < 8; ++j) { const float g = ag[i][j] * rs, u = au[i][j] * rs; const float sg = g / (1.0f + __expf(-g));
            act[(size_t)row * DFF + col0 + tx * 8 + j] = f2bf(sg * u); } }
}
__global__ void __launch_bounds__(256) naive_resid(const bf16_t* A, int K, const float* W, const float* xin, float* xout, float coef) {
    __shared__ float As[8 * 132]; __shared__ float Bs[8 * 128];
    const int row0 = blockIdx.y * 128, col0 = blockIdx.x * 128, tx = threadIdx.x & 15, ty = threadIdx.x >> 4;
    float acc[8][8]; ZERO_ACC(acc);
    accum_tile<bf16_t>(A, K, K, nullptr, W, D, row0, col0, acc, As, Bs);
#pragma unroll
    for (int i = 0; i < 8; ++i) { const int row = row0 + ty * 8 + i;
#pragma unroll
        for (int j = 0; j < 8; ++j) { const size_t o = (size_t)row * D + col0 + tx * 8 + j; xout[o] = xin[o] + coef * acc[i][j]; } }
}
struct QkvOut { bf16_t *qa, *ka, *va, *qb, *kb, *vb; const float *qna, *kna, *qnb, *knb; };
__global__ void __launch_bounds__(256) naive_qkv(const bf16_t* xb, const float* ssp, const float* gain, const float* Wqkv, QkvOut o) {
    __shared__ float As[8 * 132]; __shared__ float Bs[8 * 128];
    const int row0 = blockIdx.y * 128, col0 = blockIdx.x * 128, tx = threadIdx.x & 15, ty = threadIdx.x >> 4;
    float acc[8][8]; ZERO_ACC(acc);
    accum_tile<bf16_t>(xb, D, D, gain, Wqkv, QKVW, row0, col0, acc, As, Bs);
    const int c = col0 + tx * 8;
    bf16_t* dst; const float* ng; int nh, hc; float sc = 1.0f;
    if (c < 512) { dst = o.qa; ng = o.qna; nh = 8; hc = c; sc = QSCALE; }
    else if (c < 1024) { dst = o.ka; ng = o.kna; nh = 8; hc = c - 512; }
    else if (c < 1536) { dst = o.va; ng = nullptr; nh = 8; hc = c - 1024; }
    else if (c < 2048) { dst = o.qb; ng = o.qnb; nh = 8; hc = c - 1536; sc = QSCALE; }
    else if (c < 2176) { dst = o.kb; ng = o.knb; nh = 2; hc = c - 2048; }
    else { dst = o.vb; ng = nullptr; nh = 2; hc = c - 2176; }
    const int h = hc >> 6, e0 = hc & 63;
#pragma unroll
    for (int i = 0; i < 8; ++i) { const int row = row0 + ty * 8 + i; const float rs = row_rstd(ssp, row);
        float v[8]; float ss = 0.f;
#pragma unroll
        for (int j = 0; j < 8; ++j) { v[j] = acc[i][j] * rs; ss += v[j] * v[j]; }
        ss += __shfl_xor(ss, 1); ss += __shfl_xor(ss, 2); ss += __shfl_xor(ss, 4);
        const float hr = rsqrtf(ss * (1.0f / HD) + EPS);
        const int b = row / S, s = row % S;
        bf16_t* p = dst + (((size_t)b * nh + h) * S + s) * HD + e0;
#pragma unroll
        for (int j = 0; j < 8; ++j) p[j] = f2bf(ng ? v[j] * hr * ng[e0 + j] * sc : v[j]); }
}
__global__ void __launch_bounds__(256) naive_ple(const bf16_t* xb, const float* ssp, const float* gain, const float* Wg, const float* p, const float* Wp, const float* xin, float* xout) {
    __shared__ float As[8 * 132]; __shared__ float Bs[8 * 128];
    const int row0 = blockIdx.y * 128, col0 = blockIdx.x * 128, tx = threadIdx.x & 15, ty = threadIdx.x >> 4;
    float ag[8][8], ap[8][8]; ZERO_ACC(ag); ZERO_ACC(ap);
    accum_tile<bf16_t>(xb, D, D, gain, Wg, D, row0, col0, ag, As, Bs);
    accum_tile<float>(p, PLE, PLE, nullptr, Wp, D, row0, col0, ap, As, Bs);
#pragma unroll
    for (int i = 0; i < 8; ++i) { const int row = row0 + ty * 8 + i; const float rs = row_rstd(ssp, row);
#pragma unroll
        for (int j = 0; j < 8; ++j) { const size_t o = (size_t)row * D + col0 + tx * 8 + j; const float g = 1.0f / (1.0f + __expf(-ag[i][j] * rs));
            xout[o] = xin[o] + g * ap[i][j]; } }
}

__device__ __forceinline__ int t5_bucket(int rel) {
    const int n = rel < 0 ? -rel : rel; const int ret = rel > 0 ? 16 : 0;
    if (n < 8) return ret + n;
    int large = 8 + (int)(logf((float)n / 8.0f) / 4.852030263919617f * 8.0f);
    large = large < 15 ? large : 15;
    return ret + large;
}
struct AttnIn { const bf16_t *qa, *ka, *va, *qb, *kb, *vb; const float* rel_bias; const float* sink; bf16_t* o; };
__global__ void __launch_bounds__(256) naive_attn(AttnIn a) {
    __shared__ float pl[4][400]; __shared__ int kl[4][400];
    const int wave = threadIdx.x >> 6, lane = threadIdx.x & 63;
    const int t = blockIdx.x * 4 + wave, head = blockIdx.y, b = blockIdx.z;
    const bool isA = head < 8;
    const bf16_t *q, *k, *v;
    if (isA) { q = a.qa + (((size_t)b * 8 + head) * S + t) * HD; k = a.ka + ((size_t)b * 8 + head) * S * HD; v = a.va + ((size_t)b * 8 + head) * S * HD; }
    else { const int hq = head - 8, hk = hq >> 2; q = a.qb + (((size_t)b * 8 + hq) * S + t) * HD; k = a.kb + ((size_t)b * 2 + hk) * S * HD; v = a.vb + ((size_t)b * 2 + hk) * S * HD; }
    float qf[HD];
#pragma unroll
    for (int e = 0; e < HD; ++e) qf[e] = bf2f(q[e]);
    const int nk = isA ? 387 : 257;
    float mx = -1e30f;
    for (int i = lane; i < nk; i += 64) {
        int rel;
        if (isA) { const int br = i / 129, j = i % 129 - 64; rel = j * (br == 0 ? 1 : br == 1 ? 4 : 16); }
        else rel = i - 128;
        const int tk = t + rel;
        float lg = -1e30f;
        if (tk >= 0 && tk < S) {
            float d = 0.f; const bf16_t* kr = k + (size_t)tk * HD;
#pragma unroll
            for (int e = 0; e < HD; ++e) d += qf[e] * bf2f(kr[e]);
            lg = d + a.rel_bias[t5_bucket(rel) * 16 + head] * LOG2E;
        }
        pl[wave][i] = lg; kl[wave][i] = tk;
        mx = fmaxf(mx, lg);
    }
#pragma unroll
    for (int o = 1; o < 64; o <<= 1) mx = fmaxf(mx, __shfl_xor(mx, o));
    float sinkl = 0.f;
    if (!isA) { sinkl = a.sink[head - 8] * LOG2E; mx = fmaxf(mx, sinkl); }
    float sum = 0.f;
    for (int i = lane; i < nk; i += 64) { const float lg = pl[wave][i]; const float pv = lg > -1e29f ? exp2f(lg - mx) : 0.f; pl[wave][i] = pv; sum += pv; }
#pragma unroll
    for (int o = 1; o < 64; o <<= 1) sum += __shfl_xor(sum, o);
    if (!isA) sum += exp2f(sinkl - mx);
    __syncthreads();
    float acc = 0.f;
    for (int i = 0; i < nk; ++i) { const float pv = pl[wave][i]; if (pv != 0.f) acc += pv * bf2f(v[(size_t)kl[wave][i] * HD + lane]); }
    a.o[((size_t)b * S + t) * D + head * HD + lane] = f2bf(acc / sum);
}

namespace pg8 {
#define PG8_LAS __attribute__((address_space(3)))
typedef unsigned short bf16_t;
typedef short bf16x8 __attribute__((ext_vector_type(8)));
typedef float f32x4 __attribute__((ext_vector_type(4)));
typedef unsigned u32x4 __attribute__((ext_vector_type(4)));
constexpr int BM = 256, BK = 64, HALF = 128, HTB = HALF * BK * 2  , STAGE_BYTES = 8 * HTB, NXCD = 8, WGM = 8;

__host__ __device__ __forceinline__ int lds_byte(int r, int c) { const int st = (r >> 4) * 2 + (c >> 5), rr = r & 15, cc = c & 31, ob = rr * 64 + cc * 2; return st * 1024 + (ob ^ (((ob >> 9) & 1) << 5)); }
__host__ __device__ __forceinline__ void stage_rc(int b, int& R, int& C) { const int st = b / 1024, sb = b % 1024, swz = sb ^ (((sb >> 9) & 1) << 5); R = (st >> 1) * 16 + swz / 64; C = (st & 1) * 32 + (swz % 64) / 2; }
__host__ __device__ __forceinline__ int perm32(int rho) { const int n = rho >> 4, i = rho & 15; return 8 * (i >> 2) + 4 * n + (i & 3); }

struct Unit { int pm, pn; };
struct Gemm { const bf16_t* A; const bf16_t* Bt; int M, N, K; };

struct StaticOrder {
    int nM, nN, nwg, G, c;
    __host__ __device__ void init(int M, int N, int G_, int c_) { nM = M / BM; nN = N / BM; nwg = nM * nN; G = G_; c = c_; }
    __host__ __device__ bool next(int i, Unit& u) const {
        const long L = (long)i * G + c; if (L >= nwg) return false;
        int wgid = (int)L; { const int q = nwg / NXCD, r = nwg % NXCD, xcd = wgid % NXCD, off = wgid / NXCD; wgid = (xcd < r ? xcd * (q + 1) : r * (q + 1) + (xcd - r) * q) + off; }
        const int nig = WGM * nN, gid = wgid / nig, fm = gid * WGM, gsz = (nM - fm) < WGM ? (nM - fm) : WGM;
        u.pm = fm + ((wgid % nig) % gsz); u.pn = (wgid % nig) / gsz; return true;
    }
    __device__ __forceinline__ void a_ready(const Unit&) const {}
    __device__ __forceinline__ void done(const Unit&) const {}
};

__device__ __forceinline__ unsigned cvt_pk_bf16(float lo, float hi) { unsigned r; asm volatile("v_cvt_pk_bf16_f32 %0, %1, %2" : "=v"(r) : "v"(lo), "v"(hi)); return r; }
typedef float f32x2 __attribute__((ext_vector_type(2)));
template <class Epi, class Sched, bool ALIGN_EPI = false, bool SP2 = false>
__device__ __forceinline__ void gemm_phase(PG8_LAS unsigned char* lds, const Gemm g, const Sched& S, const Epi& E, const int tid) {
    const int wid = __builtin_amdgcn_readfirstlane(tid >> 6), lane = tid & 63, wr = wid >> 2, wc = wid & 3, fr = lane & 15, fq = lane >> 4;
    const int K = g.K, nt = K / BK;
    unsigned voffA[2], voffB[2];
#pragma unroll
    for (int i = 0; i < 2; ++i) { int R, C; stage_rc(tid * 16 + i * 8192, R, C); const int Rb = Epi::PERM ? ((R & ~31) + perm32(R & 31)) : R;
        voffA[i] = (unsigned)(R * K + C) * 2u; voffB[i] = (unsigned)(Rb * K + C) * 2u; }
    const size_t kstep = (size_t)(BK * 2);
    const size_t hstep = (size_t)HALF * K * 2;
    const size_t tstep = 2 * hstep;
    const unsigned ldsw = (unsigned)wid * 1024u;
    const int aoff = lds_byte(wr * 64 + fr, fq * 8), boff = lds_byte(wc * 32 + fr, fq * 8);
#define PG8_SA(b, h) (((b) * 2 + (h)) * HTB)
#define PG8_SB(b, h) ((4 + (b) * 2 + (h)) * HTB)
#define PG8_STAGE(bufoff, gbase, voff) do { _Pragma("unroll") for (int _i = 0; _i < 2; ++_i) \
        __builtin_amdgcn_global_load_lds((const unsigned*)((const char*)(gbase) + (voff)[_i]), (PG8_LAS unsigned*)(lds + (bufoff) + ldsw + _i * 8192), 16, 0, 0); } while (0)
#define PG8_LDA(dst, b, h) do { _Pragma("unroll") for (int m = 0; m < 4; ++m) _Pragma("unroll") for (int k = 0; k < 2; ++k) dst[m][k] = *(const PG8_LAS bf16x8*)(lds + PG8_SA(b, h) + aoff + m * 2048 + k * 1024); } while (0)
#define PG8_LDB(dst, b, h) do { _Pragma("unroll") for (int n = 0; n < 2; ++n) _Pragma("unroll") for (int k = 0; k < 2; ++k) dst[n][k] = *(const PG8_LAS bf16x8*)(lds + PG8_SB(b, h) + boff + n * 2048 + k * 1024); } while (0)
#define PG8_MMA(ai, bj, At, Bt) do { __builtin_amdgcn_s_setprio(1); _Pragma("unroll") for (int m = 0; m < 4; ++m) _Pragma("unroll") for (int n = 0; n < 2; ++n) _Pragma("unroll") for (int k = 0; k < 2; ++k) \
        acc[ai][bj][m][n] = __builtin_amdgcn_mfma_f32_16x16x32_bf16(Bt[n][k], At[m][k], acc[ai][bj][m][n], 0, 0, 0); __builtin_amdgcn_s_setprio(0); } while (0)
#define PG8_WAIT_V(n) asm volatile("s_waitcnt vmcnt(" #n ")" ::: "memory")
#define PG8_WAIT_L(n) asm volatile("s_waitcnt lgkmcnt(" #n ")" ::: "memory")
#define PG8_BAR __builtin_amdgcn_s_barrier()
#define PG8_SCHED __builtin_amdgcn_sched_barrier(0)
    Unit cur, nxt; int ui = 0;
    if (!S.next(0, cur)) return;
    f32x4 acc[2][2][4][2];
#pragma unroll
    for (int a = 0; a < 2; ++a)
#pragma unroll
        for (int b = 0; b < 2; ++b)
#pragma unroll
            for (int m = 0; m < 4; ++m)
#pragma unroll
                for (int n = 0; n < 2; ++n) acc[a][b][m][n] = (f32x4){0.f, 0.f, 0.f, 0.f};
    bf16x8 At[4][2], B0[2][2], B1[2][2];
    const char* cA = (const char*)g.A + (size_t)cur.pm * tstep; const char* cB = (const char*)g.Bt + (size_t)cur.pn * tstep;
    S.a_ready(cur);
    if constexpr (SP2) {
        PG8_STAGE(PG8_SB(0, 0), cB, voffB); PG8_STAGE(PG8_SB(0, 1), cB + hstep, voffB); PG8_STAGE(PG8_SA(0, 0), cA, voffA); PG8_STAGE(PG8_SA(0, 1), cA + hstep, voffA);
        if (wr == 1) PG8_BAR;
        PG8_WAIT_V(2); PG8_BAR;
        PG8_STAGE(PG8_SB(1, 0), cB + kstep, voffB); PG8_STAGE(PG8_SA(1, 0), cA + kstep, voffA); PG8_STAGE(PG8_SB(1, 1), cB + hstep + kstep, voffB);
        PG8_WAIT_V(6); PG8_BAR;
    } else {
        PG8_STAGE(PG8_SB(0, 0), cB, voffB); PG8_STAGE(PG8_SA(0, 0), cA, voffA); PG8_STAGE(PG8_SB(0, 1), cB + hstep, voffB); PG8_STAGE(PG8_SA(0, 1), cA + hstep, voffA);
        if (wr == 1) PG8_BAR;
        PG8_WAIT_V(4); PG8_BAR;
        PG8_STAGE(PG8_SB(1, 0), cB + kstep, voffB); PG8_STAGE(PG8_SA(1, 0), cA + kstep, voffA); PG8_STAGE(PG8_SB(1, 1), cB + hstep + kstep, voffB);
        PG8_WAIT_V(6); PG8_BAR;
    }
    for (;;) {
        const bool has_next = S.next(ui + 1, nxt);
        const char* nA = has_next ? (const char*)g.A + (size_t)nxt.pm * tstep : cA; const char* nB = has_next ? (const char*)g.Bt + (size_t)nxt.pn * tstep : cB;
        for (int t = 0; t < nt; t += 2) {
            const bool last = (t == nt - 2);
            const char* a1 = cA + (size_t)(t + 1) * kstep;
            const char* a2 = last ? nA : cA + (size_t)(t + 2) * kstep; const char* b2 = last ? nB : cB + (size_t)(t + 2) * kstep;
            const char* a3 = a2 + kstep; const char* b3 = b2 + kstep;
            if (last && has_next) S.a_ready(nxt);
            if constexpr (SP2) {
            PG8_LDB(B0, 0, 0); PG8_LDB(B1, 0, 1); PG8_SCHED; PG8_LDA(At, 0, 0); PG8_STAGE(PG8_SA(1, 1), a1 + hstep, voffA);
            PG8_WAIT_V(8); PG8_WAIT_L(0); PG8_BAR; PG8_MMA(0, 0, At, B0); PG8_MMA(0, 1, At, B1); PG8_BAR; PG8_SCHED;
            PG8_LDA(At, 0, 1); PG8_STAGE(PG8_SB(0, 0), b2, voffB); PG8_STAGE(PG8_SB(0, 1), b2 + hstep, voffB); PG8_STAGE(PG8_SA(0, 0), a2, voffA);
            PG8_WAIT_V(8); PG8_WAIT_L(0); PG8_BAR; PG8_MMA(1, 0, At, B0); PG8_MMA(1, 1, At, B1); PG8_BAR; PG8_SCHED;
            PG8_LDB(B0, 1, 0); PG8_LDB(B1, 1, 1); PG8_SCHED; PG8_LDA(At, 1, 0); PG8_STAGE(PG8_SA(0, 1), a2 + hstep, voffA);
            PG8_WAIT_V(8); PG8_WAIT_L(0); PG8_BAR; PG8_MMA(0, 0, At, B0); PG8_MMA(0, 1, At, B1); PG8_BAR; PG8_SCHED;
            PG8_LDA(At, 1, 1); PG8_STAGE(PG8_SB(1, 0), b3, voffB); PG8_STAGE(PG8_SB(1, 1), b3 + hstep, voffB); PG8_STAGE(PG8_SA(1, 0), a3, voffA);
            PG8_WAIT_V(8); PG8_WAIT_L(0); PG8_BAR; PG8_MMA(1, 0, At, B0); PG8_MMA(1, 1, At, B1); PG8_BAR; PG8_SCHED;
            } else {
            PG8_LDB(B0, 0, 0); PG8_SCHED; PG8_LDA(At, 0, 0); PG8_STAGE(PG8_SA(1, 1), a1 + hstep, voffA);
            PG8_WAIT_L(8); PG8_BAR; PG8_WAIT_L(0); PG8_MMA(0, 0, At, B0); PG8_BAR; PG8_SCHED;
            PG8_LDB(B1, 0, 1); PG8_STAGE(PG8_SB(0, 0), b2, voffB);
            PG8_BAR; PG8_WAIT_L(0); PG8_MMA(0, 1, At, B1); PG8_BAR;
            PG8_LDA(At, 0, 1); PG8_STAGE(PG8_SA(0, 0), a2, voffA);
            PG8_BAR; PG8_WAIT_L(0); PG8_MMA(1, 0, At, B0); PG8_BAR; PG8_SCHED;
            PG8_STAGE(PG8_SB(0, 1), b2 + hstep, voffB);
            PG8_WAIT_V(6); PG8_BAR; PG8_MMA(1, 1, At, B1); PG8_BAR;
            PG8_LDB(B0, 1, 0); PG8_SCHED; PG8_LDA(At, 1, 0); PG8_STAGE(PG8_SA(0, 1), a2 + hstep, voffA);
            PG8_WAIT_L(8); PG8_BAR; PG8_WAIT_L(0); PG8_MMA(0, 0, At, B0); PG8_BAR; PG8_SCHED;
            PG8_LDB(B1, 1, 1); PG8_STAGE(PG8_SB(1, 0), b3, voffB);
            PG8_BAR; PG8_WAIT_L(0); PG8_MMA(0, 1, At, B1); PG8_BAR;
            PG8_LDA(At, 1, 1); PG8_STAGE(PG8_SA(1, 0), a3, voffA);
            PG8_BAR; PG8_WAIT_L(0); PG8_MMA(1, 0, At, B0); PG8_BAR; PG8_SCHED;
            PG8_STAGE(PG8_SB(1, 1), b3 + hstep, voffB);
            PG8_WAIT_V(6); PG8_BAR; PG8_MMA(1, 1, At, B1); PG8_BAR;
            }
        }
        if constexpr (ALIGN_EPI) { if (wr == 0) PG8_BAR; }
        if constexpr (!Epi::AFTER_DRAIN) { int l2_; asm volatile("v_mbcnt_lo_u32_b32 %0, -1, 0\n\tv_mbcnt_hi_u32_b32 %0, -1, %0" : "=v"(l2_)); E(acc, cur, wr, wc, l2_ & 15, l2_ >> 4); S.done(cur); }
        if (!has_next) break;
#pragma unroll
        for (int a = 0; a < 2; ++a)
#pragma unroll
            for (int b = 0; b < 2; ++b)
#pragma unroll
                for (int m = 0; m < 4; ++m)
#pragma unroll
                    for (int n = 0; n < 2; ++n) acc[a][b][m][n] = (f32x4){0.f, 0.f, 0.f, 0.f};
        cur = nxt; cA = nA; cB = nB; ++ui;
        if constexpr (ALIGN_EPI) { if (wr == 1) PG8_BAR; }
    }
    PG8_WAIT_V(0);
    if constexpr (!ALIGN_EPI) { if (wr == 0) PG8_BAR; }
    PG8_BAR;
    if constexpr (Epi::AFTER_DRAIN) { E.fused(acc, cur, wr, wc, fr, fq, lds, wid, lane); S.done(cur); }
#undef PG8_SA
#undef PG8_SB
#undef PG8_STAGE
#undef PG8_LDA
#undef PG8_LDB
#undef PG8_MMA
#undef PG8_WAIT_V
#undef PG8_WAIT_L
#undef PG8_BAR
#undef PG8_SCHED
}
}

namespace pg8 {
typedef float f32x2 __attribute__((ext_vector_type(2)));
__device__ __forceinline__ float shx(float v, int lane, int mask) { return __int_as_float(__builtin_amdgcn_ds_bpermute((lane ^ mask) << 2, __float_as_int(v))); }
__device__ __forceinline__ float rstd16(const float* ssp, int row, int fq, int lane) {
    const f32x4 v = *(const f32x4*)(ssp + (size_t)row * 16 + 4 * fq);
    float s = (v[0] + v[1]) + (v[2] + v[3]);
    s += shx(s, lane, 16); s += shx(s, lane, 32);
    return rsqrtf(s * (1.0f / 1024.0f) + 1e-6f);
}
__device__ __forceinline__ float sigm(float v) { return __builtin_amdgcn_rcpf(1.0f + __builtin_amdgcn_exp2f(-1.4426950408889634f * v)); }
__device__ __forceinline__ u32x4 pack8(const f32x4& a, const f32x4& b) { u32x4 w; w.x = cvt_pk_bf16(a[0], a[1]); w.y = cvt_pk_bf16(a[2], a[3]); w.z = cvt_pk_bf16(b[0], b[1]); w.w = cvt_pk_bf16(b[2], b[3]); return w; }
__device__ __forceinline__ float bflo(unsigned w) { return __uint_as_float(w << 16); }
__device__ __forceinline__ float bfhi(unsigned w) { return __uint_as_float(w & 0xffff0000u); }

struct EpiSwiglu {
    static constexpr bool PERM = true, AFTER_DRAIN = false;
    bf16_t* act; const float* ssp; int mode;
    __device__ __forceinline__ void operator()(const f32x4 (&acc)[2][2][4][2], const Unit& u, int wr, int wc, int fr, int fq) const {
        const int lane = fr + 16 * fq;
        const int row0 = u.pm * BM + wr * 64 + fr, col0 = u.pn * 128 + wc * 32 + 8 * fq;
#pragma unroll
        for (int ai = 0; ai < 2; ++ai)
#pragma unroll
            for (int m = 0; m < 4; ++m) { const int row = row0 + ai * HALF + m * 16; const float rs = rstd16(ssp, row, fq, lane);
                f32x4 o[2];
                const float c1 = -1.4426950408889634f * rs, rs2 = rs * rs;
#pragma unroll
                for (int n = 0; n < 2; ++n)
#pragma unroll
                    for (int j = 0; j < 4; ++j) { const float g = acc[ai][0][m][n][j], up = acc[ai][1][m][n][j];
                        o[n][j] = (PROBE_NULL_EPI && mode == 2) ? g + up : (g * up) * (rs2 * __builtin_amdgcn_rcpf(1.0f + __builtin_amdgcn_exp2f(c1 * g))); }
                const u32x4 w = pack8(o[0], o[1]);
                if (PROBE_NULL_EPI && mode == 1) asm volatile("" :: "v"(w)); else *(u32x4*)(act + (size_t)row * 2816 + col0) = w; }
    }
};
struct EpiResid {
    static constexpr bool PERM = true, AFTER_DRAIN = false;
    const float* xin; float* xout; bf16_t* xb; float* sspw; float coef;
    __device__ __forceinline__ void operator()(const f32x4 (&acc)[2][2][4][2], const Unit& u, int wr, int wc, int fr, int fq) const {
        const int lane = fr + 16 * fq;
        float cf = __uint_as_float(__builtin_amdgcn_readfirstlane(__float_as_uint(coef))); asm volatile("" : "+s"(cf));
        const int row0 = u.pm * BM + wr * 64 + fr, col0 = u.pn * BM + wc * 32 + 8 * fq;
#pragma unroll
        for (int ai = 0; ai < 2; ++ai)
#pragma unroll
            for (int mh = 0; mh < 2; ++mh) {
            f32x4 xo[2][2][2];
#pragma unroll
            for (int mm = 0; mm < 2; ++mm)
#pragma unroll
                for (int bj = 0; bj < 2; ++bj) { const size_t off = (size_t)(row0 + ai * HALF + (2 * mh + mm) * 16) * 1024 + col0 + bj * HALF; xo[mm][bj][0] = *(const f32x4*)(xin + off); xo[mm][bj][1] = *(const f32x4*)(xin + off + 4); }
            asm volatile("" ::: "memory");
#pragma unroll
            for (int mm = 0; mm < 2; ++mm) { const int m = 2 * mh + mm, row = row0 + ai * HALF + m * 16; float ss = 0.f;
#pragma unroll
                for (int bj = 0; bj < 2; ++bj) { const size_t off = (size_t)row * 1024 + col0 + bj * HALF;
                    const f32x4 x0 = xo[mm][bj][0] + acc[ai][bj][m][0] * cf, x1 = xo[mm][bj][1] + acc[ai][bj][m][1] * cf;
                    *(f32x4*)(xout + off) = x0; *(f32x4*)(xout + off + 4) = x1;
                    *(u32x4*)(xb + off) = pack8(x0, x1);
                    ss += (x0[0] * x0[0] + x0[1] * x0[1]) + (x0[2] * x0[2] + x0[3] * x0[3]) + (x1[0] * x1[0] + x1[1] * x1[1]) + (x1[2] * x1[2] + x1[3] * x1[3]); }
                ss += shx(ss, lane, 16); ss += shx(ss, lane, 32);
                if (fq == 0) sspw[(size_t)row * 16 + u.pn * 4 + wc] = ss; }
            asm volatile("" ::: "memory");
        }
    }
};
struct EpiGate {
    static constexpr bool PERM = true, AFTER_DRAIN = false;
    const float* xin; float* xout; bf16_t* xb; float* sspw; const float* sspr; const bf16_t* proj; float coef;
    __device__ __forceinline__ void operator()(const f32x4 (&acc)[2][2][4][2], const Unit& u, int wr, int wc, int fr, int fq) const {
        const int lane = fr + 16 * fq;
        float cf = __uint_as_float(__builtin_amdgcn_readfirstlane(__float_as_uint(coef))); asm volatile("" : "+s"(cf));
        const int row0 = u.pm * BM + wr * 64 + fr, col0 = u.pn * BM + wc * 32 + 8 * fq;
#pragma unroll
        for (int ai = 0; ai < 2; ++ai)
#pragma unroll
            for (int mh = 0; mh < 2; ++mh) {
                f32x4 xo[2][2][2]; u32x4 pw[2][2]; float rs[2];
#pragma unroll
                for (int mm = 0; mm < 2; ++mm) { const int row = row0 + ai * HALF + (2 * mh + mm) * 16; rs[mm] = rstd16(sspr, row, fq, lane);
#pragma unroll
                    for (int bj = 0; bj < 2; ++bj) { const size_t off = (size_t)row * 1024 + col0 + bj * HALF; xo[mm][bj][0] = *(const f32x4*)(xin + off); xo[mm][bj][1] = *(const f32x4*)(xin + off + 4); pw[mm][bj] = *(const u32x4*)(proj + off); } }
                asm volatile("" ::: "memory");
#pragma unroll
                for (int mm = 0; mm < 2; ++mm) { const int m = 2 * mh + mm, row = row0 + ai * HALF + m * 16; float ss = 0.f;
#pragma unroll
                    for (int bj = 0; bj < 2; ++bj) { const size_t off = (size_t)row * 1024 + col0 + bj * HALF;
                        f32x4 x0 = xo[mm][bj][0], x1 = xo[mm][bj][1]; const u32x4 pq = pw[mm][bj];
                        const f32x4 p0 = {bflo(pq.x), bfhi(pq.x), bflo(pq.y), bfhi(pq.y)}, p1 = {bflo(pq.z), bfhi(pq.z), bflo(pq.w), bfhi(pq.w)};
#pragma unroll
                        for (int j = 0; j < 4; ++j) { x0[j] += cf * (sigm(acc[ai][bj][m][0][j] * rs[mm]) * p0[j]); x1[j] += cf * (sigm(acc[ai][bj][m][1][j] * rs[mm]) * p1[j]); }
                        *(f32x4*)(xout + off) = x0; *(f32x4*)(xout + off + 4) = x1;
                        *(u32x4*)(xb + off) = pack8(x0, x1);
                        ss += (x0[0] * x0[0] + x0[1] * x0[1]) + (x0[2] * x0[2] + x0[3] * x0[3]) + (x1[0] * x1[0] + x1[1] * x1[1]) + (x1[2] * x1[2] + x1[3] * x1[3]); }
                    ss += shx(ss, lane, 16); ss += shx(ss, lane, 32);
                    if (fq == 0) sspw[(size_t)row * 16 + u.pn * 4 + wc] = ss; }
                asm volatile("" ::: "memory");
            }
    }
};
struct EpiStoreBf16 {
    static constexpr bool PERM = true, AFTER_DRAIN = false;
    bf16_t* O; int ldc;
    __device__ __forceinline__ void operator()(const f32x4 (&acc)[2][2][4][2], const Unit& u, int wr, int wc, int fr, int fq) const {
        const int lane = fr + 16 * fq;
        const int row0 = u.pm * BM + wr * 64 + fr, col0 = u.pn * BM + wc * 32 + 8 * fq;
#pragma unroll
        for (int ai = 0; ai < 2; ++ai)
#pragma unroll
            for (int m = 0; m < 4; ++m) { const int row = row0 + ai * HALF + m * 16;
#pragma unroll
                for (int bj = 0; bj < 2; ++bj) *(u32x4*)(O + (size_t)row * ldc + col0 + bj * HALF) = pack8(acc[ai][bj][m][0], acc[ai][bj][m][1]); }
    }
};
struct EpiNull {
    static constexpr bool PERM = true, AFTER_DRAIN = false;
    __device__ __forceinline__ void operator()(const f32x4 (&acc)[2][2][4][2], const Unit& u, int wr, int wc, int fr, int fq) const {
#pragma unroll
        for (int ai = 0; ai < 2; ++ai)
#pragma unroll
            for (int bj = 0; bj < 2; ++bj)
#pragma unroll
                for (int m = 0; m < 4; ++m)
#pragma unroll
                    for (int n = 0; n < 2; ++n) asm volatile("" :: "v"(acc[ai][bj][m][n]));
    }
};
struct EpiQkv {
    static constexpr bool PERM = true, AFTER_DRAIN = false;
    const float* ssp; bf16_t *qa, *ka, *va, *qb, *kb, *vb; const float *qna, *kna, *qnb, *knb;
    __device__ __forceinline__ void operator()(const f32x4 (&acc)[2][2][4][2], const Unit& u, int wr, int wc, int fr, int fq) const {
        const int lane = fr + 16 * fq;
        const int t = u.pn; bf16_t* dst; const float* ng; int nh, h; float sc = 1.0f;
        if (t < 2) { dst = qa; ng = qna; nh = 8; h = 4 * t + wc; sc = QSCALE; }
        else if (t < 4) { dst = ka; ng = kna; nh = 8; h = 4 * (t - 2) + wc; }
        else if (t < 6) { dst = va; ng = nullptr; nh = 8; h = 4 * (t - 4) + wc; }
        else if (t < 8) { dst = qb; ng = qnb; nh = 8; h = 4 * (t - 6) + wc; sc = QSCALE; }
        else if (wc < 2) { dst = kb; ng = knb; nh = 2; h = wc; }
        else { dst = vb; ng = nullptr; nh = 2; h = wc - 2; }
        f32x4 gv[2][2];
#pragma unroll
        for (int bj = 0; bj < 2; ++bj)
#pragma unroll
            for (int n = 0; n < 2; ++n) { if (ng) gv[bj][n] = *(const f32x4*)(ng + 32 * bj + 8 * fq + 4 * n) * sc; else gv[bj][n] = (f32x4){1.f, 1.f, 1.f, 1.f}; }
        const int row0 = u.pm * BM + wr * 64 + fr;
#pragma unroll
        for (int ai = 0; ai < 2; ++ai)
#pragma unroll
            for (int m = 0; m < 4; ++m) { const int row = row0 + ai * HALF + m * 16; const float rs = rstd16(ssp, row, fq, lane);
                f32x4 v[2][2]; float ss = 0.f;
#pragma unroll
                for (int bj = 0; bj < 2; ++bj)
#pragma unroll
                    for (int n = 0; n < 2; ++n) { v[bj][n] = acc[ai][bj][m][n] * rs; ss += (v[bj][n][0] * v[bj][n][0] + v[bj][n][1] * v[bj][n][1]) + (v[bj][n][2] * v[bj][n][2] + v[bj][n][3] * v[bj][n][3]); }
                ss += shx(ss, lane, 16); ss += shx(ss, lane, 32);
                const float hr = ng ? rsqrtf(ss * (1.0f / 64.0f) + 1e-6f) : 1.0f;
                const int b = row >> 12, s = row & 4095;
                bf16_t* p = dst + (((size_t)b * nh + h) * 4096 + s) * 64 + 8 * fq;
#pragma unroll
                for (int bj = 0; bj < 2; ++bj) *(u32x4*)(p + 32 * bj) = pack8(v[bj][0] * hr * gv[bj][0], v[bj][1] * hr * gv[bj][1]); }
    }
};
}

#include <hip/hip_cooperative_groups.h>
namespace cg = cooperative_groups;
#define LAS __attribute__((address_space(3)))
typedef unsigned v4u __attribute__((ext_vector_type(4)));
constexpr int NWAVES = 8, RING_BYTES = 131072, LDS_BYTES = 147456;
constexpr int NPHASE = 1 + 8 * DEPTH;
constexpr size_t WO_F1IN = 0, WO_F1OUT = WO_F1IN + (size_t)2 * DFF * D, WO_QKV = WO_F1OUT + (size_t)D * DFF, WO_WO = WO_QKV + (size_t)QKVW * D,
                 WO_F2IN = WO_WO + (size_t)D * D, WO_F2OUT = WO_F2IN + (size_t)2 * DFF * D, WO_WG = WO_F2OUT + (size_t)D * DFF, WO_WP = WO_WG + (size_t)D * D, W_LAYER = WO_WP + (size_t)D * PLE;
static_assert(W_LAYER * 2 * DEPTH <= 84 * MiB, "weights fit");

struct Args { const float* in[20]; float* out; unsigned char* ws; int ph_lo, ph_hi; };

__device__ __forceinline__ int src_col(int kind, int n0) {
    if (kind == 0) return n0;
    if (kind == 1) return ((n0 >> 7) & 1) * DFF + 128 * (n0 >> 8) + (n0 & 127);
    return 256 * (n0 >> 8) + 64 * ((n0 >> 5) & 3) + 32 * ((n0 >> 7) & 1);
}
__device__ __forceinline__ void transpose_item(const float* W, int K, int N, const float* gain, bf16_t* Bt, int kind, int item, LAS float* scr, int lane) {
    const int kblocks = K / 64, nb = item / kblocks, kb = item % kblocks, k0 = 64 * kb, n0 = 64 * nb;
    const int cseg = lane & 15, r0 = lane >> 4;
    const int c0 = src_col(kind, n0 + 32 * (cseg >> 3)) + 4 * (cseg & 7);
    float4 v[16];
#pragma unroll
    for (int i = 0; i < 16; ++i) v[i] = *(const float4*)(W + (size_t)(k0 + r0 + 4 * i) * N + c0);
    if (gain) {
#pragma unroll
        for (int i = 0; i < 16; ++i) { const float g = gain[k0 + r0 + 4 * i]; v[i].x *= g; v[i].y *= g; v[i].z *= g; v[i].w *= g; }
    }
#pragma unroll
    for (int i = 0; i < 16; ++i) { LAS float* p = scr + (r0 + 4 * i) * 65 + 4 * cseg; p[0] = v[i].x; p[1] = v[i].y; p[2] = v[i].z; p[3] = v[i].w; }
    asm volatile("s_waitcnt lgkmcnt(0)" ::: "memory");
    const int c = lane & 7;
#pragma unroll
    for (int j = 0; j < 8; ++j) { const int n = (lane >> 3) + 8 * j; const LAS float* sp = scr + (8 * c) * 65 + n;
        v4u o; o.x = pg8::cvt_pk_bf16(sp[0 * 65], sp[1 * 65]); o.y = pg8::cvt_pk_bf16(sp[2 * 65], sp[3 * 65]); o.z = pg8::cvt_pk_bf16(sp[4 * 65], sp[5 * 65]); o.w = pg8::cvt_pk_bf16(sp[6 * 65], sp[7 * 65]);
        *(v4u*)(Bt + (size_t)(n0 + n) * K + k0 + 8 * c) = o; }
    asm volatile("s_waitcnt lgkmcnt(0)" ::: "memory");
}

template <class AT> __device__ __forceinline__ void prologue_phase(const AT& a, LAS unsigned char* lds, int gw, int NGW, int wave, int lane) {
    LAS float* scr = (LAS float*)(lds + wave * 16640);
    bf16_t* wbase = (bf16_t*)(a.ws() + WS_W);
    constexpr int I_FIN = (D / 64) * (2 * DFF / 64), I_FOUT = (DFF / 64) * (D / 64), I_QKV = (D / 64) * (QKVW / 64), I_SQ = (D / 64) * (D / 64), I_WP = (PLE / 64) * (D / 64);
    constexpr int I_LAYER = 2 * I_FIN + 2 * I_FOUT + I_QKV + 2 * I_SQ + I_WP;
    for (int it = gw; it < DEPTH * I_LAYER; it += NGW) {
        const int l = it / I_LAYER; int r = it % I_LAYER; bf16_t* wl = wbase + (size_t)l * W_LAYER;
        if (r < I_FIN) { transpose_item(a.in(4) + (size_t)l * D * 2 * DFF, D, 2 * DFF, a.in(3) + l * D, wl + WO_F1IN, 1, r, scr, lane); continue; } r -= I_FIN;
        if (r < I_FOUT) { transpose_item(a.in(5) + (size_t)l * DFF * D, DFF, D, nullptr, wl + WO_F1OUT, 0, r, scr, lane); continue; } r -= I_FOUT;
        if (r < I_QKV) { transpose_item(a.in(7) + (size_t)l * D * QKVW, D, QKVW, a.in(6) + l * D, wl + WO_QKV, 2, r, scr, lane); continue; } r -= I_QKV;
        if (r < I_SQ) { transpose_item(a.in(13) + (size_t)l * D * D, D, D, nullptr, wl + WO_WO, 0, r, scr, lane); continue; } r -= I_SQ;
        if (r < I_FIN) { transpose_item(a.in(15) + (size_t)l * D * 2 * DFF, D, 2 * DFF, a.in(14) + l * D, wl + WO_F2IN, 1, r, scr, lane); continue; } r -= I_FIN;
        if (r < I_FOUT) { transpose_item(a.in(16) + (size_t)l * DFF * D, DFF, D, nullptr, wl + WO_F2OUT, 0, r, scr, lane); continue; } r -= I_FOUT;
        if (r < I_SQ) { transpose_item(a.in(18) + (size_t)l * D * D, D, D, a.in(17) + l * D, wl + WO_WG, 0, r, scr, lane); continue; } r -= I_SQ;
        transpose_item(a.in(19) + (size_t)l * PLE * D, PLE, D, nullptr, wl + WO_WP, 0, r, scr, lane);
    }
    const float* x = a.in(0); bf16_t* xb = (bf16_t*)(a.ws() + WS_XB); float* ssp = (float*)(a.ws() + WS_SSP);
    for (int row = gw; row < M; row += 2 * NGW) {
        const int row2 = row + NGW; const bool has2 = row2 < M;
        const float4* xr = (const float4*)(x + (size_t)row * D); const float4* xr2 = (const float4*)(x + (size_t)(has2 ? row2 : row) * D);
        float4 va[4], vb[4];
#pragma unroll
        for (int j = 0; j < 4; ++j) { va[j] = xr[lane + 64 * j]; vb[j] = xr2[lane + 64 * j]; }
        float s = 0.f, s2 = 0.f;
#pragma unroll
        for (int j = 0; j < 4; ++j) { s += va[j].x * va[j].x + va[j].y * va[j].y + va[j].z * va[j].z + va[j].w * va[j].w; s2 += vb[j].x * vb[j].x + vb[j].y * vb[j].y + vb[j].z * vb[j].z + vb[j].w * vb[j].w;
            uint2 o; o.x = pg8::cvt_pk_bf16(va[j].x, va[j].y); o.y = pg8::cvt_pk_bf16(va[j].z, va[j].w); ((uint2*)(xb + (size_t)row * D))[lane + 64 * j] = o;
            if (has2) { uint2 o2; o2.x = pg8::cvt_pk_bf16(vb[j].x, vb[j].y); o2.y = pg8::cvt_pk_bf16(vb[j].z, vb[j].w); ((uint2*)(xb + (size_t)row2 * D))[lane + 64 * j] = o2; } }
#pragma unroll
        for (int o = 1; o < 64; o <<= 1) { s += pg8::shx(s, lane, o); s2 += pg8::shx(s2, lane, o); }
        if (lane < 4) { float4 r; r.x = lane == 0 ? s : 0.f; r.y = 0.f; r.z = 0.f; r.w = 0.f; ((float4*)ssp)[row * 4 + lane] = r;
            if (has2) { r.x = lane == 0 ? s2 : 0.f; ((float4*)ssp)[row2 * 4 + lane] = r; } }
    }
}
__device__ __forceinline__ void convert_p(const float* p, bf16_t* pb, int gtid, int nthreads) {
    for (int i = gtid; i < M * PLE / 8; i += nthreads) { const float4 v0 = ((const float4*)p)[2 * i], v1 = ((const float4*)p)[2 * i + 1];
        v4u o; o.x = pg8::cvt_pk_bf16(v0.x, v0.y); o.y = pg8::cvt_pk_bf16(v0.z, v0.w); o.z = pg8::cvt_pk_bf16(v1.x, v1.y); o.w = pg8::cvt_pk_bf16(v1.z, v1.w); ((v4u*)pb)[i] = o; }
}

__device__ __forceinline__ void attn_simple_phase(LAS unsigned char* lds, const AttnIn& a, int G, int wave, int lane) {
    LAS float* pl = (LAS float*)(lds + wave * 4096); LAS int* kl = (LAS int*)(lds + wave * 4096 + 2048);
    const int total = NB * 16 * S;
    for (int item = blockIdx.x * NWAVES + wave; item < total; item += G * NWAVES) {
        const int t = item & (S - 1), head = (item >> 12) & 15, b = item >> 16;
        const bool isA = head < 8;
        const bf16_t *q, *k, *v;
        if (isA) { q = a.qa + (((size_t)b * 8 + head) * S + t) * HD; k = a.ka + ((size_t)b * 8 + head) * S * HD; v = a.va + ((size_t)b * 8 + head) * S * HD; }
        else { const int hq = head - 8, hk = hq >> 2; q = a.qb + (((size_t)b * 8 + hq) * S + t) * HD; k = a.kb + ((size_t)b * 2 + hk) * S * HD; v = a.vb + ((size_t)b * 2 + hk) * S * HD; }
        float qf[HD];
#pragma unroll
        for (int e = 0; e < HD; ++e) qf[e] = bf2f(q[e]);
        const int nk = isA ? 387 : 257;
        float mx = -1e30f;
        for (int i = lane; i < nk; i += 64) {
            int rel;
            if (isA) { const int br = i / 129, j = i % 129 - 64; rel = j * (br == 0 ? 1 : br == 1 ? 4 : 16); } else rel = i - 128;
            const int tk = t + rel; float lg = -1e30f;
            if (tk >= 0 && tk < S) { float d = 0.f; const bf16_t* kr = k + (size_t)tk * HD;
#pragma unroll
                for (int e = 0; e < HD; ++e) d += qf[e] * bf2f(kr[e]);
                lg = d + a.rel_bias[t5_bucket(rel) * 16 + head] * LOG2E; }
            pl[i] = lg; kl[i] = tk; mx = fmaxf(mx, lg);
        }
#pragma unroll
        for (int o = 1; o < 64; o <<= 1) mx = fmaxf(mx, pg8::shx(mx, lane, o));
        float sinkl = 0.f;
        if (!isA) { sinkl = a.sink[head - 8] * LOG2E; mx = fmaxf(mx, sinkl); }
        float sum = 0.f;
        for (int i = lane; i < nk; i += 64) { const float lg = pl[i]; const float pv = lg > -1e29f ? exp2f(lg - mx) : 0.f; pl[i] = pv; sum += pv; }
#pragma unroll
        for (int o = 1; o < 64; o <<= 1) sum += pg8::shx(sum, lane, o);
        if (!isA) sum += exp2f(sinkl - mx);
        asm volatile("s_waitcnt lgkmcnt(0)" ::: "memory");
        float acc = 0.f;
        for (int i = 0; i < nk; ++i) { const float pv = pl[i]; if (pv != 0.f) acc += pv * bf2f(v[(size_t)kl[i] * HD + lane]); }
        a.o[((size_t)b * S + t) * D + head * HD + lane] = f2bf(acc / sum);
    }
}

namespace att {
typedef short bf16x8 __attribute__((ext_vector_type(8)));
typedef short s16x4 __attribute__((ext_vector_type(4)));
typedef short v4i16_t __attribute__((ext_vector_type(4)));
typedef float f32x16 __attribute__((ext_vector_type(16)));
typedef unsigned u32x4 __attribute__((ext_vector_type(4)));
typedef float f32x2_t __attribute__((ext_vector_type(2))); typedef __bf16 bf16x2_t __attribute__((ext_vector_type(2)));
constexpr float NEG = -1e30f;
constexpr int WAVE_LDS = 8704, LUT_OFF = 0, WAVES_OFF = 8192, LUTA_STRIDE = 200, LUTB_STRIDE = 328, LUTB_OFF = LUT_OFF + 3 * LUTA_STRIDE * 4, TAB_OFF = WAVES_OFF + 8 * WAVE_LDS, LSE_OFF = TAB_OFF + 65536, ATT_LDS_END = LSE_OFF + 2048;
static_assert(LUTB_OFF + 4 * LUTB_STRIDE * 4 <= WAVES_OFF && ATT_LDS_END <= 147456 - 64, "attention LDS map");
__device__ __forceinline__ int crow(int r, int hi) { return (r & 3) + 8 * (r >> 2) + 4 * hi; }
__device__ __forceinline__ unsigned cvtpk(float lo, float hi) { f32x2_t v = {lo, hi}; bf16x2_t b = __builtin_convertvector(v, bf16x2_t); return __builtin_bit_cast(unsigned, b); }
__device__ __forceinline__ s16x4 vtr(const LAS unsigned char* p) { return __builtin_bit_cast(s16x4, __builtin_amdgcn_ds_read_tr16_b64_v4i16((LAS v4i16_t*)p)); }
__device__ __forceinline__ float halfmax(float v) { auto rr = __builtin_amdgcn_permlane32_swap(__float_as_uint(v), __float_as_uint(v), false, false); return fmaxf(__uint_as_float(rr[0]), __uint_as_float(rr[1])); }
__device__ __forceinline__ float halfsum(float v) { auto rr = __builtin_amdgcn_permlane32_swap(__float_as_uint(v), __float_as_uint(v), false, false); return __uint_as_float(rr[0]) + __uint_as_float(rr[1]); }

__device__ __forceinline__ void bias_add(f32x16& p, const LAS float* lut, const int j, const int i, const int hi) {
    const LAS float* lp = lut + 32 * j - i + 4 * hi;
#pragma unroll
    for (int r = 0; r < 16; ++r) p[r] += lp[(r & 3) + 8 * (r >> 2)];
}
template <int NT>
__device__ __forceinline__ void qtile(const bf16_t* qrow, const bf16_t* kbase, const bf16_t* vbase, int tk0, int dstep, const LAS float* lut, float m0, float l0,
                                      LAS unsigned char* wl, int lane_in, f32x16 (&o)[2], float& m_out, float& l_out) {
    int lane = lane_in; asm volatile("" : "+v"(lane));
    const int i = lane & 31, hi = lane >> 5;
    LAS float* wsf = (LAS float*)(wl + 8192);
    constexpr int C = NT / 2;
    bf16x8 qf[4];
#pragma unroll
    for (int ks = 0; ks < 4; ++ks) qf[ks] = *(const bf16x8*)(qrow + 16 * ks + 8 * hi);
    const int vrow = lane >> 3, vsw = (lane & 7) ^ (((lane >> 4) & 1) << 2);
    const int rd_base = (4 * hi + ((lane & 15) >> 2)) * 128 + 32 * ((lane >> 4) & 1) + 8 * (lane & 3);
    const int bit3 = (lane >> 3) & 1;
    const int vb0 = rd_base + 64 * bit3, vb1 = rd_base + 64 * (1 - bit3);
    bf16x8 kf[4];
#define ATT_LOAD(j, buf) do { \
        { int tk = tk0 + (32 * (j) + i) * dstep; tk = tk < 0 ? 0 : (tk > S - 1 ? S - 1 : tk); const bf16_t* kp = kbase + (size_t)tk * HD + 8 * hi; \
          _Pragma("unroll") for (int ks = 0; ks < 4; ++ks) kf[ks] = *(const bf16x8*)(kp + 16 * ks); } \
        _Pragma("unroll") for (int i4 = 0; i4 < 4; ++i4) { int tk = tk0 + (32 * (j) + vrow + 8 * i4) * dstep; tk = tk < 0 ? 0 : (tk > S - 1 ? S - 1 : tk); \
          __builtin_amdgcn_global_load_lds((const unsigned*)(vbase + (size_t)tk * HD + 8 * vsw), (LAS unsigned*)(wl + (buf) * 4096 + i4 * 1024), 16, 0, 0); } } while (0)
    float m = m0, l = hi == 0 ? l0 : 0.f;
    o[0] = f32x16{}; o[1] = f32x16{};
    ATT_LOAD(C, 0);
#pragma unroll 1
    for (int s = 0; s < NT; ++s) {
        const int j = (s == 0) ? C : (s <= C ? s - 1 : s);
        LAS unsigned char* vbuf = wl + (s & 1) * 4096;
        asm volatile("s_waitcnt vmcnt(0)" ::: "memory");
        f32x16 p = __builtin_amdgcn_mfma_f32_32x32x16_bf16(kf[0], qf[0], f32x16{}, 0, 0, 0);
        p = __builtin_amdgcn_mfma_f32_32x32x16_bf16(kf[1], qf[1], p, 0, 0, 0);
        p = __builtin_amdgcn_mfma_f32_32x32x16_bf16(kf[2], qf[2], p, 0, 0, 0);
        p = __builtin_amdgcn_mfma_f32_32x32x16_bf16(kf[3], qf[3], p, 0, 0, 0);
        bias_add(p, lut, j, i, hi);
        if (s + 1 < NT) { const int jn = (s + 1 <= C) ? s : s + 1; ATT_LOAD(jn, (s + 1) & 1); }
        const int first = tk0 + 32 * j * dstep, lastk = first + 31 * dstep;
        const bool inside = first >= 0 && lastk < S;
        if (!inside) {
#pragma unroll
            for (int r = 0; r < 16; ++r) { const int tk = first + crow(r, hi) * dstep; if ((unsigned)tk >= (unsigned)S) p[r] = NEG; }
        }
        float rm = p[0];
#pragma unroll
        for (int r = 1; r < 16; ++r) rm = fmaxf(rm, p[r]);
        rm = halfmax(rm);
        if (__any(rm > m)) {
            const float mn = fmaxf(m, rm), alpha = __builtin_amdgcn_exp2f(m - mn);
            l *= alpha; m = mn;
            if (hi == 0) wsf[i] = alpha;
#pragma unroll
            for (int r = 0; r < 16; ++r) { const float a = wsf[crow(r, hi)]; o[0][r] *= a; o[1][r] *= a; }
        }
        f32x2_t rs2 = {0.f, 0.f}; const f32x2_t nm2 = {-m, -m};
#pragma unroll
        for (int r = 0; r < 16; r += 2) { f32x2_t t = (f32x2_t){p[r], p[r + 1]} + nm2; t.x = __builtin_amdgcn_exp2f(t.x); t.y = __builtin_amdgcn_exp2f(t.y); p[r] = t.x; p[r + 1] = t.y; rs2 += t; }
        l += rs2.x + rs2.y;
        u32x4 pw0 = {cvtpk(p[0], p[1]), cvtpk(p[2], p[3]), cvtpk(p[4], p[5]), cvtpk(p[6], p[7])};
        u32x4 pw1 = {cvtpk(p[8], p[9]), cvtpk(p[10], p[11]), cvtpk(p[12], p[13]), cvtpk(p[14], p[15])};
        const bf16x8 pa0 = __builtin_bit_cast(bf16x8, pw0), pa1 = __builtin_bit_cast(bf16x8, pw1);
#pragma unroll
        for (int d0 = 0; d0 < 2; ++d0) {
            const unsigned vp = (unsigned)(uintptr_t)(vbuf + (d0 == 0 ? vb0 : vb1));
            s16x4 a0, a1, b0, b1;
            asm volatile("ds_read_b64_tr_b16 %0, %1" : "=&v"(a0) : "v"(vp) : "memory");
            asm volatile("ds_read_b64_tr_b16 %0, %1 offset:1024" : "=&v"(a1) : "v"(vp) : "memory");
            asm volatile("ds_read_b64_tr_b16 %0, %1 offset:2048" : "=&v"(b0) : "v"(vp) : "memory");
            asm volatile("ds_read_b64_tr_b16 %0, %1 offset:3072" : "=&v"(b1) : "v"(vp) : "memory");
            asm volatile("s_waitcnt lgkmcnt(0)" : "+v"(a0), "+v"(a1), "+v"(b0), "+v"(b1) :: "memory"); __builtin_amdgcn_sched_barrier(0);
            const bf16x8 f0 = {a0[0], a0[1], a0[2], a0[3], a1[0], a1[1], a1[2], a1[3]}, f1 = {b0[0], b0[1], b0[2], b0[3], b1[0], b1[1], b1[2], b1[3]};
            o[d0] = __builtin_amdgcn_mfma_f32_32x32x16_bf16(pa0, f0, o[d0], 0, 0, 0);
            o[d0] = __builtin_amdgcn_mfma_f32_32x32x16_bf16(pa1, f1, o[d0], 0, 0, 0);
        }
    }
#undef ATT_LOAD
    m_out = m; l_out = halfsum(l);
}

constexpr float MLOW = -1.0e4f;
constexpr float THR = 8.0f;
template <int NT>
__device__ __forceinline__ void sm_tile(f32x16& p, const LAS float* lut, const int j, const int i, const int hi, const int first, const int dstep, const bool inside,
                                        float& m, float& l, f32x16 (&o)[2], LAS float* wsf, bf16x8& pa0, bf16x8& pa1) {
    if (!inside) {
#pragma unroll
        for (int r = 0; r < 16; ++r) { const int tk = first + crow(r, hi) * dstep; if ((unsigned)tk >= (unsigned)S) p[r] = NEG; }
    }
    float rm = fmaxf(p[0], p[1]);
#pragma unroll
    for (int r = 2; r < 16; ++r) rm = fmaxf(rm, p[r]);
    rm = halfmax(rm);
    if (__any(rm > m + THR)) {
        const float mn = fmaxf(m, rm), alpha = __builtin_amdgcn_exp2f(m - mn);
        l *= alpha; m = mn;
        if (hi == 0) wsf[i] = alpha;
#pragma unroll
        for (int r = 0; r < 16; ++r) { const float a = wsf[crow(r, hi)]; o[0][r] *= a; o[1][r] *= a; }
    }
    f32x2_t rs2 = {0.f, 0.f}; const f32x2_t nm2 = {-m, -m};
#pragma unroll
    for (int r = 0; r < 16; r += 2) { f32x2_t t = (f32x2_t){p[r], p[r + 1]} + nm2; t.x = __builtin_amdgcn_exp2f(t.x); t.y = __builtin_amdgcn_exp2f(t.y); p[r] = t.x; p[r + 1] = t.y; rs2 += t; }
    l += rs2.x + rs2.y;
    u32x4 pw0 = {cvtpk(p[0], p[1]), cvtpk(p[2], p[3]), cvtpk(p[4], p[5]), cvtpk(p[6], p[7])};
    u32x4 pw1 = {cvtpk(p[8], p[9]), cvtpk(p[10], p[11]), cvtpk(p[12], p[13]), cvtpk(p[14], p[15])};
    pa0 = __builtin_bit_cast(bf16x8, pw0); pa1 = __builtin_bit_cast(bf16x8, pw1);
}
template <int NT, int SHIFT>
__device__ __forceinline__ void qtile2(const bf16_t* qrow0, const bf16_t* qrow1, const bf16_t* kbase, const bf16_t* vbase, int tk0, int dstep, const LAS float* lut0, const LAS float* lut1,
                                       float mi0, float li0, float mi1, float li1, LAS unsigned char* wl, int lane_in,
                                       f32x16 (&o0)[2], float& m0_out, float& l0_out, f32x16 (&o1)[2], float& m1_out, float& l1_out) {
    int lane = lane_in; asm volatile("" : "+v"(lane));
    const int i = lane & 31, hi = lane >> 5;
    LAS float* wsf = (LAS float*)(wl + 8192);
    bf16x8 qf0[4], qf1[4];
#pragma unroll
    for (int ks = 0; ks < 4; ++ks) { qf0[ks] = *(const bf16x8*)(qrow0 + 16 * ks + 8 * hi); qf1[ks] = *(const bf16x8*)(qrow1 + 16 * ks + 8 * hi); }
    const int vrow = lane >> 3, vsw = (lane & 7) ^ (((lane >> 4) & 1) << 2);
    const int rd_base = (4 * hi + ((lane & 15) >> 2)) * 128 + 32 * ((lane >> 4) & 1) + 8 * (lane & 3);
    const int bit3 = (lane >> 3) & 1;
    const int vb0 = rd_base + 64 * bit3, vb1 = rd_base + 64 * (1 - bit3);
    bf16x8 kf[4];
#define ATT_LOAD(j, buf) do { \
        { int tk = tk0 + (32 * (j) + i) * dstep; tk = tk < 0 ? 0 : (tk > S - 1 ? S - 1 : tk); const bf16_t* kp = kbase + (size_t)tk * HD + 8 * hi; \
          _Pragma("unroll") for (int ks = 0; ks < 4; ++ks) kf[ks] = *(const bf16x8*)(kp + 16 * ks); } \
        _Pragma("unroll") for (int i4 = 0; i4 < 4; ++i4) { int tk = tk0 + (32 * (j) + vrow + 8 * i4) * dstep; tk = tk < 0 ? 0 : (tk > S - 1 ? S - 1 : tk); \
          __builtin_amdgcn_global_load_lds((const unsigned*)(vbase + (size_t)tk * HD + 8 * vsw), (LAS unsigned*)(wl + (buf) * 4096 + i4 * 1024), 16, 0, 0); } } while (0)
    float m0 = mi0, l0 = hi == 0 ? li0 : 0.f, m1 = mi1, l1 = hi == 0 ? li1 : 0.f;
    o0[0] = f32x16{}; o0[1] = f32x16{}; o1[0] = f32x16{}; o1[1] = f32x16{};
    ATT_LOAD(0, 0);
#pragma unroll 1
    for (int jj = 0; jj < NT + SHIFT; ++jj) {
        LAS unsigned char* vbuf = wl + (jj & 1) * 4096;
        const bool a0 = jj < NT, a1 = jj >= SHIFT;
        const int first = tk0 + 32 * jj * dstep, lastk = first + 31 * dstep;
        const bool inside = first >= 0 && lastk < S;
        asm volatile("s_waitcnt vmcnt(0)" ::: "memory");
        f32x16 p0, p1;
        bf16x8 pa00, pa01, pa10, pa11;
        {
            if (a0) {
                p0 = __builtin_amdgcn_mfma_f32_32x32x16_bf16(kf[0], qf0[0], f32x16{}, 0, 0, 0);
#pragma unroll
                for (int ks = 1; ks < 4; ++ks) p0 = __builtin_amdgcn_mfma_f32_32x32x16_bf16(kf[ks], qf0[ks], p0, 0, 0, 0);
            }
            if (a1) {
                p1 = __builtin_amdgcn_mfma_f32_32x32x16_bf16(kf[0], qf1[0], f32x16{}, 0, 0, 0);
#pragma unroll
                for (int ks = 1; ks < 4; ++ks) p1 = __builtin_amdgcn_mfma_f32_32x32x16_bf16(kf[ks], qf1[ks], p1, 0, 0, 0);
            }
        }
        if (a0) bias_add(p0, lut0, jj, i, hi);
        if (a1) bias_add(p1, lut1, jj - SHIFT, i, hi);
        if (jj + 1 < NT + SHIFT) ATT_LOAD(jj + 1, (jj + 1) & 1);
        {
            if (a0) sm_tile<NT>(p0, lut0, jj, i, hi, first, dstep, inside, m0, l0, o0, wsf, pa00, pa01);
            if (a1) sm_tile<NT>(p1, lut1, jj - SHIFT, i, hi, first, dstep, inside, m1, l1, o1, wsf, pa10, pa11);
#pragma unroll
            for (int d0 = 0; d0 < 2; ++d0) {
                const unsigned vp = (unsigned)(uintptr_t)(vbuf + (d0 == 0 ? vb0 : vb1));
                s16x4 x0, x1, y0, y1;
                asm volatile("ds_read_b64_tr_b16 %0, %1" : "=&v"(x0) : "v"(vp) : "memory");
                asm volatile("ds_read_b64_tr_b16 %0, %1 offset:1024" : "=&v"(x1) : "v"(vp) : "memory");
                asm volatile("ds_read_b64_tr_b16 %0, %1 offset:2048" : "=&v"(y0) : "v"(vp) : "memory");
                asm volatile("ds_read_b64_tr_b16 %0, %1 offset:3072" : "=&v"(y1) : "v"(vp) : "memory");
                asm volatile("s_waitcnt lgkmcnt(0)" : "+v"(x0), "+v"(x1), "+v"(y0), "+v"(y1) :: "memory"); __builtin_amdgcn_sched_barrier(0);
                const bf16x8 f0 = {x0[0], x0[1], x0[2], x0[3], x1[0], x1[1], x1[2], x1[3]}, f1 = {y0[0], y0[1], y0[2], y0[3], y1[0], y1[1], y1[2], y1[3]};
                if (a0) { o0[d0] = __builtin_amdgcn_mfma_f32_32x32x16_bf16(pa00, f0, o0[d0], 0, 0, 0); o0[d0] = __builtin_amdgcn_mfma_f32_32x32x16_bf16(pa01, f1, o0[d0], 0, 0, 0); }
                if (a1) { o1[d0] = __builtin_amdgcn_mfma_f32_32x32x16_bf16(pa10, f0, o1[d0], 0, 0, 0); o1[d0] = __builtin_amdgcn_mfma_f32_32x32x16_bf16(pa11, f1, o1[d0], 0, 0, 0); }
            }
        }
    }
#undef ATT_LOAD
    m0_out = m0; l0_out = halfsum(l0); m1_out = m1; l1_out = halfsum(l1);
}

__device__ __forceinline__ void stage_o(const f32x16 (&o)[2], float m, float l, LAS unsigned char* wl, int lane_in) {
    int lane = lane_in; asm volatile("" : "+v"(lane));
    const int i = lane & 31, hi = lane >> 5;
    LAS float* wsf = (LAS float*)(wl + 8192);
    if (hi == 0) { wsf[i] = __builtin_amdgcn_rcpf(l); wsf[32 + i] = m + __builtin_amdgcn_logf(l); }
    LAS bf16_t* stg = (LAS bf16_t*)wl;
#pragma unroll
    for (int r = 0; r < 16; ++r) { const int q = crow(r, hi); const float inv = wsf[q];
        stg[q * 64 + i] = (bf16_t)(cvtpk(o[0][r] * inv, 0.f) & 0xffffu); stg[q * 64 + 32 + i] = (bf16_t)(cvtpk(o[1][r] * inv, 0.f) & 0xffffu); }
}
__device__ __forceinline__ float bflo(unsigned w) { return __uint_as_float(w << 16); }
__device__ __forceinline__ float bfhi(unsigned w) { return __uint_as_float(w & 0xffff0000u); }
__device__ __forceinline__ unsigned mix2(unsigned a, unsigned b, float wa, float wb) { return cvtpk(wa * bflo(a) + wb * bflo(b), wa * bfhi(a) + wb * bfhi(b)); }

struct Tensors { const bf16_t *qa, *ka, *va, *qb, *kb, *vb; const float* rel_bias; const float* sink; bf16_t* o; };
__device__ __forceinline__ void finish_a(const f32x16 (&o)[2], float m, float l, int pass, int d, int lam0, int rr, LAS unsigned char* wl, LAS unsigned char* tab, LAS float* lsetab, bf16_t* orow0, int lane_in) {
    LAS float* wsf = (LAS float*)(wl + 8192);
    stage_o(o, m, l, wl, lane_in);
    int lane = lane_in; asm volatile("" : "+v"(lane));
#pragma unroll
    for (int i4 = 0; i4 < 4; ++i4) {
        const int qi = (lane >> 3) + 8 * i4, ch = lane & 7, tau = d * (lam0 + qi) + rr;
        u32x4 v = *(const LAS u32x4*)(wl + qi * 128 + ch * 16);
        const float Lb = wsf[32 + qi];
        LAS u32x4* te = (LAS u32x4*)(tab + tau * 128 + ch * 16);
        if (pass == 0) { *te = v; if (ch == 0) lsetab[tau] = Lb; }
        else {
            const u32x4 tv = *te; const float La = lsetab[tau];
            const float Lm = fmaxf(La, Lb), sa = __builtin_amdgcn_exp2f(La - Lm), sb = __builtin_amdgcn_exp2f(Lb - Lm), tot = sa + sb, rt = __builtin_amdgcn_rcpf(tot), wa = sa * rt, wb = sb * rt;
            u32x4 w; w.x = mix2(tv.x, v.x, wa, wb); w.y = mix2(tv.y, v.y, wa, wb); w.z = mix2(tv.z, v.z, wa, wb); w.w = mix2(tv.w, v.w, wa, wb);
            if (pass == 1) { *te = w; if (ch == 0) lsetab[tau] = Lm + __builtin_amdgcn_logf(tot); }
            else *(u32x4*)(orow0 + (size_t)tau * D + ch * 8) = w;
        }
    }
}


__device__ __forceinline__ int bucket(int rel) {
    const int n = rel < 0 ? -rel : rel; const int ret = rel > 0 ? 16 : 0;
    if (n < 8) return ret + n;
    int large = 8 + (int)(logf((float)n / 8.0f) / 4.852030263919617f * 8.0f);
    large = large < 15 ? large : 15;
    return ret + large;
}

__device__ __forceinline__ void attn_unit(const Tensors& T, int u, LAS unsigned char* lds, int wave, int lane) {
    LAS unsigned char* wl = lds + WAVES_OFF + wave * WAVE_LDS;
    LAS float* wsf = (LAS float*)(wl + 8192);
    LAS float* lutA = (LAS float*)(lds + LUT_OFF); LAS float* lutB = (LAS float*)(lds + LUTB_OFF);
    LAS unsigned char* tab = lds + TAB_OFF; LAS float* lsetab = (LAS float*)(lds + LSE_OFF);
    const int tid = wave * 64 + lane;
    const int i = lane & 31;
    {
        const int bh = u >> 3, blk = u & 7, b = bh >> 3, h = bh & 7, t0 = blk * 512;
        const bf16_t* qbase = T.qa + (size_t)bh * S * HD; const bf16_t* kbase = T.ka + (size_t)bh * S * HD; const bf16_t* vbase = T.va + (size_t)bh * S * HD;
        __syncthreads();
        for (int e = tid; e < 3 * 193; e += 512) { const int c = e / 193, idx = e % 193 - 32, d = c == 0 ? 1 : (c == 1 ? 4 : 16);
            lutA[c * LUTA_STRIDE + 32 + idx] = (idx < 0 || idx > 128) ? NEG : T.rel_bias[bucket((idx - 64) * d) * 16 + h] * LOG2E; }
        __syncthreads();
        bf16_t* orow0 = T.o + ((size_t)b * S + t0) * D + h * HD;
#pragma unroll 1
        for (int pass = 0; pass < 3; ++pass) {
            const int c = 2 - pass, d = c == 0 ? 1 : (c == 1 ? 4 : 16);
            const LAS float* lt = lutA + c * LUTA_STRIDE + 32;
            if (c == 2) {
#pragma unroll 1
                for (int tt = 0; tt < 2; ++tt) { const int rr = 2 * wave + tt;
                    f32x16 o1[2]; float m1, l1;
                    qtile<5>(qbase + (size_t)(t0 + d * i + rr) * HD, kbase, vbase, t0 - 64 * d + rr, d, lt, NEG, 0.f, wl, lane, o1, m1, l1);
                    finish_a(o1, m1, l1, pass, d, 0, rr, wl, tab, lsetab, orow0, lane); }
            } else {
                const int Tq = 2 * wave, rr = c == 1 ? (Tq >> 2) : 0, lamA = 32 * (c == 1 ? (Tq & 3) : Tq);
                f32x16 oA[2], oB[2]; float mA, lA, mB, lB;
                qtile2<5, 1>(qbase + (size_t)(t0 + d * (lamA + i) + rr) * HD, qbase + (size_t)(t0 + d * (lamA + 32 + i) + rr) * HD, kbase, vbase, t0 + d * (lamA - 64) + rr, d, lt, lt,
                             MLOW, 0.f, MLOW, 0.f, wl, lane, oA, mA, lA, oB, mB, lB);
                finish_a(oA, mA, lA, pass, d, lamA, rr, wl, tab, lsetab, orow0, lane);
                finish_a(oB, mB, lB, pass, d, lamA + 32, rr, wl, tab, lsetab, orow0, lane);
            }
            __syncthreads();
        }
    }
    {
        const int bk = u >> 5, blk = u & 31, b = bk >> 1, hk = bk & 1, t0 = blk * 128;
        const bf16_t* kbase = T.kb + (size_t)bk * S * HD; const bf16_t* vbase = T.vb + (size_t)bk * S * HD;
        for (int e = tid; e < 4 * 321; e += 512) { const int g = e / 321, idx = e % 321 - 32;
            lutB[g * LUTB_STRIDE + 32 + idx] = (idx < 0 || idx > 256) ? NEG : T.rel_bias[bucket(idx - 128) * 16 + 8 + 4 * hk + g] * LOG2E; }
        __syncthreads();
        const int qt = wave & 3, g0 = 2 * (wave >> 2), hq0 = 4 * hk + g0;
        const int tq = t0 + 32 * qt + i, tk0 = t0 + 32 * qt - 128;
        f32x16 oA[2], oB[2]; float mA, lA, mB, lB;
        qtile2<9, 0>(T.qb + (((size_t)b * 8 + hq0) * S + tq) * HD, T.qb + (((size_t)b * 8 + hq0 + 1) * S + tq) * HD, kbase, vbase, tk0, 1,
                     lutB + g0 * LUTB_STRIDE + 32, lutB + (g0 + 1) * LUTB_STRIDE + 32, T.sink[hq0] * LOG2E, 1.0f, T.sink[hq0 + 1] * LOG2E, 1.0f, wl, lane, oA, mA, lA, oB, mB, lB);
        bf16_t* ob0 = T.o + ((size_t)b * S + t0 + 32 * qt) * D + (8 + hq0) * HD;
        stage_o(oA, mA, lA, wl, lane);
#pragma unroll
        for (int i4 = 0; i4 < 4; ++i4) { const int qi = (lane >> 3) + 8 * i4, ch = lane & 7; *(u32x4*)(ob0 + (size_t)qi * D + ch * 8) = *(const LAS u32x4*)(wl + qi * 128 + ch * 16); }
        stage_o(oB, mB, lB, wl, lane);
#pragma unroll
        for (int i4 = 0; i4 < 4; ++i4) { const int qi = (lane >> 3) + 8 * i4, ch = lane & 7; *(u32x4*)(ob0 + HD + (size_t)qi * D + ch * 8) = *(const LAS u32x4*)(wl + qi * 128 + ch * 16); }
    }
}
}

#define XB_TMO      128
#define XB_XCNT(j)  (256  + 64 * (j))
#define XB_XSUB(j)  (1280 + 64 * (j))
#define XB_XGEN(j)  (2304 + 64 * (j))
#define XB_TOP      3328
#define XB_TOPGEN   3392
#define XCD_BAR_WORDS 3456
#define XB_SPIN_CAP (1u << 18)

__device__ __forceinline__ unsigned xb_ld(unsigned* p)              { return __hip_atomic_load(p, __ATOMIC_RELAXED, __HIP_MEMORY_SCOPE_AGENT); }
__device__ __forceinline__ unsigned xb_add(unsigned* p, unsigned v) { return __hip_atomic_fetch_add(p, v, __ATOMIC_RELAXED, __HIP_MEMORY_SCOPE_AGENT); }
__device__ __forceinline__ unsigned xb_xcc_id() { return (unsigned)__builtin_amdgcn_s_getreg((3 << 11) | 20) & 0xFu; }
#define XB_SPIN(cond, bar) do { unsigned _sp = 0; while (cond) { __builtin_amdgcn_s_sleep(1); \
    if ((++_sp & 255u) == 0u) { if (xb_ld(&(bar)[XB_TMO])) break; if (_sp > XB_SPIN_CAP) { atomicAdd(&(bar)[XB_TMO], 1u); break; } } } } while (0)

struct XcdBarrier {
    unsigned* bar; unsigned x;
    volatile LAS unsigned* st;
};

__device__ __forceinline__ XcdBarrier xcd_barrier_post(unsigned* bar, volatile LAS unsigned* st) {
    XcdBarrier b; b.bar = bar; b.x = xb_xcc_id(); b.st = st;
    if (threadIdx.x == 0) (void)xb_add(&bar[XB_XCNT(b.x)], 1u);
    return b;
}
__device__ __forceinline__ void xcd_barrier_complete(unsigned* bar, unsigned x, unsigned& nloc, unsigned& nx) {
    const unsigned G = gridDim.x * gridDim.y * gridDim.z;
    unsigned sum, cnt, mine, sp = 0u;
    for (;;) {
        sum = 0u; cnt = 0u; mine = 0u;
#pragma unroll
        for (unsigned j = 0; j < 16; ++j) { const unsigned c = xb_ld(&bar[XB_XCNT(j)]); sum += c; cnt += (c > 0u) ? 1u : 0u; mine = (j == x) ? c : mine; }
        if (sum == G) break;
        __builtin_amdgcn_s_sleep(1);
        if ((++sp & 255u) == 0u) { if (xb_ld(&bar[XB_TMO])) break; if (sp > XB_SPIN_CAP) { atomicAdd(&bar[XB_TMO], 1u); break; } }
    }
    nloc = mine > 0u ? mine : 1u; nx = cnt > 0u ? cnt : 1u;
}

__device__ __forceinline__ void xcd_barrier(const XcdBarrier& b, const bool is_t0) {
    asm volatile("s_waitcnt vmcnt(0)" ::: "memory");
    __syncthreads();
    if (is_t0) {
        unsigned* bar = b.bar;
        __builtin_amdgcn_s_waitcnt(0);
        unsigned nloc = b.st[0], nx = b.st[1];
        if (nloc == 0u) { xcd_barrier_complete(bar, b.x, nloc, nx); b.st[0] = nloc; b.st[1] = nx; }
        const unsigned old = xb_add(&bar[XB_XSUB(b.x)], 1u);
        const unsigned gen = old / nloc;
        if (old + 1u == (gen + 1u) * nloc) {
            __builtin_amdgcn_fence(__ATOMIC_RELEASE, "agent");
            asm volatile("s_waitcnt vmcnt(0)" ::: "memory");
            const unsigned og = xb_add(&bar[XB_TOP], 1u);
            const unsigned tg = og / nx;
            if (og + 1u == (tg + 1u) * nx) xb_add(&bar[XB_TOPGEN], 1u);
            else XB_SPIN(xb_ld(&bar[XB_TOPGEN]) == tg, bar);
            __builtin_amdgcn_fence(__ATOMIC_ACQUIRE, "agent");
            xb_add(&bar[XB_XGEN(b.x)], 1u);
            asm volatile("s_waitcnt vmcnt(0)" ::: "memory");
        } else {
            XB_SPIN(xb_ld(&bar[XB_XGEN(b.x)]) == gen, bar);
            __builtin_amdgcn_fence(__ATOMIC_ACQUIRE, "agent");
            asm volatile("s_waitcnt vmcnt(0)" ::: "memory");
        }
    }
    __syncthreads();
}
typedef const float* cfptr_t; typedef float* fptr_t; typedef unsigned char* ucptr_t;
typedef __attribute__((address_space(4))) const unsigned char* kargp_t;
struct KA {
    kargp_t kp;
    __device__ __forceinline__ const float* in(int i) const { return *(__attribute__((address_space(4))) const cfptr_t*)(kp + 8 * i); }
    __device__ __forceinline__ float* out() const { return *(__attribute__((address_space(4))) const fptr_t*)(kp + 160); }
    __device__ __forceinline__ unsigned char* ws() const { return *(__attribute__((address_space(4))) const ucptr_t*)(kp + 168); }
    __device__ __forceinline__ int ph_lo() const { return *(__attribute__((address_space(4))) const int*)(kp + 176); }
    __device__ __forceinline__ int ph_hi() const { return *(__attribute__((address_space(4))) const int*)(kp + 180); }
};
static_assert(sizeof(Args) == 184, "Args layout");
#define FRESH_LANE() ({ int l_; asm volatile("v_mbcnt_lo_u32_b32 %0, -1, 0\n\tv_mbcnt_hi_u32_b32 %0, -1, %0" : "=v"(l_)); l_; })
template <int PH>
__device__ __forceinline__ void run_phase(const KA& a, LAS unsigned char* lds, const int wave0, const int rep) {
    const int G = gridDim.x, bx = blockIdx.x, wave = wave0;
    const int vcu = (G % 8 == 0) ? (bx % 8) * (G / 8) + bx / 8 : bx;
    const int gw = vcu * NWAVES + wave, NGW = G * NWAVES;
    unsigned char* ws = a.ws();
    bf16_t* xb = (bf16_t*)(ws + WS_XB); float* ssp0 = (float*)(ws + WS_SSP); float* ssp1 = ssp0 + (size_t)M * 16;
    bf16_t* xb2 = (bf16_t*)(ws + WS_W);
    bf16_t* act = (bf16_t*)(ws + WS_R + R_ACT); bf16_t* ob = (bf16_t*)(ws + WS_R + R_O);
    bf16_t* pb = (bf16_t*)(ws + WS_PB); bf16_t* proj = (bf16_t*)(ws + WS_PROJ);
    const float cscale = rep == 0 ? 1.0f : 0.0f;
    if constexpr (PH == 0) {
        prologue_phase(a, lds, gw, NGW, wave, FRESH_LANE());
        convert_p(a.in(1), pb, bx * NWAVES * 64 + wave0 * 64 + FRESH_LANE(), G * NWAVES * 64);
    } else {
        constexpr int l = (PH - 1) >> 3, k = (PH - 1) & 7;
        const bf16_t* wl = (const bf16_t*)(ws + WS_W) + (size_t)l * W_LAYER;
        const float* xin = (l == 0 && k <= 1 && rep == 0) ? a.in(0) : a.out();
        if constexpr (k == 0 || k == 5) {
            pg8::Gemm g{(k == 0 && l == 1) ? xb2 : xb, wl + (k == 0 ? WO_F1IN : WO_F2IN), M, 2 * DFF, D}; pg8::StaticOrder S; S.init(M, 2 * DFF, G, bx);
#if PROBE_NULL_EPI == 1
            if (rep > 0) { pg8::EpiNull E; pg8::gemm_phase<pg8::EpiNull, pg8::StaticOrder, true, true>(lds, g, S, E, wave0 * 64 + FRESH_LANE()); } else
#endif
            { pg8::EpiSwiglu E{act, ssp0, (PROBE_NULL_EPI >= 2 && rep > 0 && rep < PROBE_N) ? PROBE_NULL_EPI - 1 : 0};
            pg8::gemm_phase<pg8::EpiSwiglu, pg8::StaticOrder, true, true>(lds, g, S, E, wave0 * 64 + FRESH_LANE()); }
        } else if constexpr (k == 1 || k == 6) {
            pg8::Gemm g{act, wl + (k == 1 ? WO_F1OUT : WO_F2OUT), M, D, DFF}; pg8::StaticOrder S; S.init(M, D, G, bx);
            pg8::EpiResid E{xin, a.out(), xb, ssp1, 0.5f * cscale};
            pg8::gemm_phase<pg8::EpiResid, pg8::StaticOrder, true, true>(lds, g, S, E, wave0 * 64 + FRESH_LANE());
        } else if constexpr (k == 2) {
            { pg8::Gemm g{xb, wl + WO_QKV, M, QKVW, D}; pg8::StaticOrder S; S.init(M, QKVW, G, bx);
              pg8::EpiQkv E; E.ssp = ssp1;
              E.qa = (bf16_t*)(ws + WS_R + R_QA); E.ka = (bf16_t*)(ws + WS_R + R_KA); E.va = (bf16_t*)(ws + WS_R + R_VA);
              E.qb = (bf16_t*)(ws + WS_R + R_QB); E.kb = (bf16_t*)(ws + WS_R + R_KB); E.vb = (bf16_t*)(ws + WS_R + R_VB);
              E.qna = a.in(8) + l * HD; E.kna = a.in(9) + l * HD; E.qnb = a.in(10) + l * HD; E.knb = a.in(11) + l * HD;
              pg8::gemm_phase<pg8::EpiQkv, pg8::StaticOrder, true, true>(lds, g, S, E, wave0 * 64 + FRESH_LANE()); }
            { pg8::Gemm g{pb, wl + WO_WP, M, D, PLE}; pg8::StaticOrder S; S.init(M, D, G, bx);
              pg8::EpiStoreBf16 E{proj, D};
              pg8::gemm_phase<pg8::EpiStoreBf16, pg8::StaticOrder, true, true>(lds, g, S, E, wave0 * 64 + FRESH_LANE()); }
        } else if constexpr (k == 3) {
            att::Tensors T; T.qa = (bf16_t*)(ws + WS_R + R_QA); T.ka = (bf16_t*)(ws + WS_R + R_KA); T.va = (bf16_t*)(ws + WS_R + R_VA);
            T.qb = (bf16_t*)(ws + WS_R + R_QB); T.kb = (bf16_t*)(ws + WS_R + R_KB); T.vb = (bf16_t*)(ws + WS_R + R_VB);
            T.rel_bias = a.in(2); T.sink = a.in(12) + l * 8; T.o = ob;
            const int lane = FRESH_LANE();
            for (int u = vcu; u < 256; u += G) att::attn_unit(T, u, lds, wave, lane);
        } else if constexpr (k == 4) {
            if (l + 1 < DEPTH) { convert_p(a.in(1) + (size_t)(l + 1) * M * PLE, pb, bx * NWAVES * 64 + wave0 * 64 + FRESH_LANE(), G * NWAVES * 64); asm volatile("s_waitcnt vmcnt(0)" ::: "memory"); }
            pg8::Gemm g{ob, wl + WO_WO, M, D, D}; pg8::StaticOrder S; S.init(M, D, G, bx);
            pg8::EpiResid E{xin, a.out(), xb, ssp0, 1.0f * cscale};
            pg8::gemm_phase<pg8::EpiResid, pg8::StaticOrder, true, true>(lds, g, S, E, wave0 * 64 + FRESH_LANE());
        } else {
            pg8::Gemm g{xb, wl + WO_WG, M, D, D}; pg8::StaticOrder S; S.init(M, D, G, bx);
            pg8::EpiGate E{xin, a.out(), xb2, ssp0, ssp1, proj, cscale};
            pg8::gemm_phase<pg8::EpiGate, pg8::StaticOrder, true, true>(lds, g, S, E, wave0 * 64 + FRESH_LANE());
        }
    }
}

__global__ void __launch_bounds__(NWAVES * 64, 2) mk_fwd(Args) {
    extern __shared__ __attribute__((aligned(16))) unsigned char lds_raw[];
    LAS unsigned char* lds = (LAS unsigned char*)lds_raw;
    cg::grid_group grid = cg::this_grid();
    const int wave0 = __builtin_amdgcn_readfirstlane(threadIdx.x >> 6);
    volatile LAS unsigned* bst = (volatile LAS unsigned*)((LAS unsigned char*)lds_raw + LDS_BYTES - 64);
    if (threadIdx.x < 2) bst[threadIdx.x] = 0u;
    __syncthreads();
    KA a; a.kp = (kargp_t)__builtin_amdgcn_kernarg_segment_ptr();
    const int ph_lo = a.ph_lo(), ph_hi = a.ph_hi();
    XcdBarrier xbar; xbar.bar = (unsigned*)(a.ws() + WS_CTL) + 4096; xbar.x = 0; xbar.st = bst;
    if (ph_hi - ph_lo > 1) xbar = xcd_barrier_post((unsigned*)(a.ws() + WS_CTL) + 4096, bst);
    if (ph_lo < 0) grid.sync();
#define MK_NREP(P) ((PROBE_N > 0 && (((P) == 0 && PROBE_K == 8) || ((P) > 0 && (((P) - 1) & 7) == PROBE_K))) ? 1 + PROBE_N : 1)
#define MK_PHASE(P) if (ph_lo <= (P) && (P) < ph_hi) { _Pragma("unroll 1") for (int rep = 0; rep < MK_NREP(P); ++rep) { asm volatile("" : "+s"(a.kp)); run_phase<(P)>(a, lds, wave0, rep); \
        if ((P) + 1 < ph_hi || rep + 1 < MK_NREP(P)) { if (USE_CG_SYNC && (P) == 0) grid.sync(); else xcd_barrier(xbar, wave0 == 0 && FRESH_LANE() == 0); } } }
    MK_PHASE(0) MK_PHASE(1) MK_PHASE(2) MK_PHASE(3) MK_PHASE(4) MK_PHASE(5) MK_PHASE(6) MK_PHASE(7) MK_PHASE(8)
    MK_PHASE(9) MK_PHASE(10) MK_PHASE(11) MK_PHASE(12) MK_PHASE(13) MK_PHASE(14) MK_PHASE(15) MK_PHASE(16)
    static_assert(NPHASE == 17, "phase program");
}

#ifndef FAST_MASK
#define FAST_MASK 0x1ffffu
#endif
extern "C" void kernel_launch(void* const* d_in, const int* in_sizes, int n_in, void* d_out, int out_size, void* d_ws, size_t ws_size, hipStream_t stream) {
    static int grid = 0;
    if (grid == 0) {
        if (n_in != 20 || in_sizes[0] != M * D || out_size != M * D || ws_size < WS_END) { fprintf(stderr, "kernel_launch: unexpected shapes (n_in %d, ws %zu)\n", n_in, ws_size); grid = -1; return; }
        int dev = 0, cus = 0, per_cu = 0;
        if (hipGetDevice(&dev) != hipSuccess || hipDeviceGetAttribute(&cus, hipDeviceAttributeMultiprocessorCount, dev) != hipSuccess) { grid = -1; return; }
        if (hipFuncSetAttribute((const void*)mk_fwd, hipFuncAttributeMaxDynamicSharedMemorySize, LDS_BYTES) != hipSuccess) { fprintf(stderr, "kernel_launch: hipFuncSetAttribute failed\n"); grid = -1; return; }
        if (hipOccupancyMaxActiveBlocksPerMultiprocessor(&per_cu, (const void*)mk_fwd, NWAVES * 64, LDS_BYTES) != hipSuccess || per_cu < 1) { fprintf(stderr, "kernel_launch: occupancy query says %d\n", per_cu); grid = -1; (void)hipGetLastError(); return; }
        grid = cus;
    }
    if (grid < 0) return;
    (void)hipMemsetAsync((char*)d_ws + WS_CTL, 0, 1 * MiB, stream);
    Args a{};
    for (int i = 0; i < 20; ++i) a.in[i] = (const float*)d_in[i];
    a.out = (float*)d_out; a.ws = (unsigned char*)d_ws;
    const unsigned fast = FAST_MASK;
    if (fast == 0x1ffffu) {
        a.ph_lo = 0; a.ph_hi = NPHASE;
        void* args[] = {&a};
        hipError_t e = hipLaunchCooperativeKernel((const void*)mk_fwd, dim3(grid), dim3(NWAVES * 64), args, LDS_BYTES, stream);
        if (e != hipSuccess) fprintf(stderr, "kernel_launch: cooperative launch failed: %s (grid %d)\n", hipGetErrorString(e), grid);
        return;
    }
    unsigned char* ws = (unsigned char*)d_ws; float* out = (float*)d_out;
    bf16_t* xb = (bf16_t*)(ws + WS_XB); bf16_t* xb2 = (bf16_t*)(ws + WS_W); float* ssp0 = (float*)(ws + WS_SSP); float* ssp1 = ssp0 + (size_t)M * 16;
    bf16_t* act = (bf16_t*)(ws + WS_R + R_ACT); bf16_t* ob = (bf16_t*)(ws + WS_R + R_O);
    QkvOut qo; qo.qa = (bf16_t*)(ws + WS_R + R_QA); qo.ka = (bf16_t*)(ws + WS_R + R_KA); qo.va = (bf16_t*)(ws + WS_R + R_VA);
    qo.qb = (bf16_t*)(ws + WS_R + R_QB); qo.kb = (bf16_t*)(ws + WS_R + R_KB); qo.vb = (bf16_t*)(ws + WS_R + R_VB);
    for (int ph = 0; ph < NPHASE; ++ph) {
        if ((fast >> ph) & 1u) { a.ph_lo = ph; a.ph_hi = ph + 1; hipLaunchKernelGGL(mk_fwd, dim3(grid), dim3(NWAVES * 64), LDS_BYTES, stream, a); continue; }
        if (ph == 0) { rowstat_kernel<<<M / 4, 256, 0, stream>>>(a.in[0], xb, ssp0); continue; }
        const int l = (ph - 1) >> 3, k = (ph - 1) & 7;
        const float* xin = (l == 0 && k <= 1) ? a.in[0] : out;
        bf16_t* xbl = (l == 1) ? xb2 : xb;
        switch (k) {
        case 0: naive_ffn_in<<<dim3(DFF / 128, M / 128), 256, 0, stream>>>(xbl, ssp0, a.in[3] + l * D, a.in[4] + (size_t)l * D * 2 * DFF, act); break;
        case 1: naive_resid<<<dim3(D / 128, M / 128), 256, 0, stream>>>(act, DFF, a.in[5] + (size_t)l * DFF * D, xin, out, 0.5f); rowstat_kernel<<<M / 4, 256, 0, stream>>>(out, xb, ssp1); break;
        case 2: qo.qna = a.in[8] + l * HD; qo.kna = a.in[9] + l * HD; qo.qnb = a.in[10] + l * HD; qo.knb = a.in[11] + l * HD;
                naive_qkv<<<dim3(QKVW / 128, M / 128), 256, 0, stream>>>(xb, ssp1, a.in[6] + l * D, a.in[7] + (size_t)l * D * QKVW, qo); break;
        case 3: { AttnIn ai; ai.qa = qo.qa; ai.ka = qo.ka; ai.va = qo.va; ai.qb = qo.qb; ai.kb = qo.kb; ai.vb = qo.vb; ai.rel_bias = a.in[2]; ai.sink = a.in[12] + l * 8; ai.o = ob;
                naive_attn<<<dim3(S / 4, 16, NB), 256, 0, stream>>>(ai); } break;
        case 4: naive_resid<<<dim3(D / 128, M / 128), 256, 0, stream>>>(ob, D, a.in[13] + (size_t)l * D * D, out, out, 1.0f); rowstat_kernel<<<M / 4, 256, 0, stream>>>(out, xb, ssp0); break;
        case 5: naive_ffn_in<<<dim3(DFF / 128, M / 128), 256, 0, stream>>>(xb, ssp0, a.in[14] + l * D, a.in[15] + (size_t)l * D * 2 * DFF, act); break;
        case 6: naive_resid<<<dim3(D / 128, M / 128), 256, 0, stream>>>(act, DFF, a.in[16] + (size_t)l * DFF * D, out, out, 0.5f); rowstat_kernel<<<M / 4, 256, 0, stream>>>(out, xb, ssp1); break;
        case 7: naive_ple<<<dim3(D / 128, M / 128), 256, 0, stream>>>(xb, ssp1, a.in[17] + l * D, a.in[18] + (size_t)l * D * D, a.in[1] + (size_t)l * M * PLE, a.in[19] + (size_t)l * PLE * D, out, out);
                rowstat_kernel<<<M / 4, 256, 0, stream>>>(out, xb2, ssp0); break;
        }
    }
}
```

```cpp
#include <hip/hip_runtime.h>
#include <cstdio>
#include <cstdint>
#ifndef ATT_FAST
#define ATT_FAST 1
#endif
#ifndef PROBE_N
#define PROBE_N 0
#define PROBE_K -1
#endif
#ifndef USE_CG_SYNC
#define USE_CG_SYNC 0
#endif
#ifndef PROBE_NULL_EPI
#define PROBE_NULL_EPI 0
#endif

typedef unsigned short bf16_t;
constexpr int NB = 4, S = 4096, D = 1024, M = NB * S, DFF = 2816, QKVW = 2304, PLE = 256, DEPTH = 2, HD = 64;
constexpr float EPS = 1e-6f;
constexpr float QSCALE = 0.125f * 1.4426950408889634f;
constexpr float LOG2E = 1.4426950408889634f;

constexpr size_t MiB = 1u << 20;
constexpr size_t WS_CTL = 0, WS_W = 1 * MiB, WS_XB = 85 * MiB, WS_R = 117 * MiB, WS_PB = 221 * MiB, WS_PROJ = 229 * MiB, WS_SSP = 261 * MiB, WS_END = 263 * MiB + 512 * 1024;
constexpr size_t R_QA = 0, R_KA = 16 * MiB, R_VA = 32 * MiB, R_QB = 48 * MiB, R_KB = 64 * MiB, R_VB = 68 * MiB, R_O = 72 * MiB, R_ACT = 0;

__device__ __forceinline__ float bf2f(bf16_t v) { return __uint_as_float(((unsigned)v) << 16); }
__device__ __forceinline__ bf16_t f2bf(float f) { unsigned u = __float_as_uint(f); return (bf16_t)((u + 0x7fffu + ((u >> 16) & 1u)) >> 16); }

__global__ void __launch_bounds__(256) rowstat_kernel(const float* __restrict__ x, bf16_t* __restrict__ xb, float* __restrict__ ssp) {
    const int wave = threadIdx.x >> 6, lane = threadIdx.x & 63;
    const int row = blockIdx.x * 4 + wave;
    const float4* xr = (const float4*)(x + (size_t)row * D);
    float s = 0.f;
#pragma unroll
    for (int j = 0; j < 4; ++j) {
        float4 v = xr[lane + 64 * j];
        s += v.x * v.x + v.y * v.y + v.z * v.z + v.w * v.w;
        ushort4 o; o.x = f2bf(v.x); o.y = f2bf(v.y); o.z = f2bf(v.z); o.w = f2bf(v.w);
        ((ushort4*)(xb + (size_t)row * D))[lane + 64 * j] = o;
    }
#pragma unroll
    for (int o = 1; o < 64; o <<= 1) s += __shfl_xor(s, o);
    if (lane < 4) { float4 r; r.x = lane == 0 ? s : 0.f; r.y = 0.f; r.z = 0.f; r.w = 0.f; ((float4*)ssp)[row * 4 + lane] = r; }
}

__device__ __forceinline__ float row_rstd(const float* ssp, int row) {
    float s = 0.f;
#pragma unroll
    for (int j = 0; j < 4; ++j) { const float4 v = ((const float4*)ssp)[row * 4 + j]; s += (v.x + v.y) + (v.z + v.w); }
    return rsqrtf(s * (1.0f / D) + EPS);
}

template <typename AT> __device__ __forceinline__ float ldA(const AT* p);
template <> __device__ __forceinline__ float ldA<bf16_t>(const bf16_t* p) { return bf2f(*p); }
template <> __device__ __forceinline__ float ldA<float>(const float* p) { return *p; }

template <typename AT>
__device__ __forceinline__ void accum_tile(const AT* A, int lda, int K, const float* gain, const float* W, int ldw, int row0, int wcol0, float (&acc)[8][8], float* As, float* Bs) {
    const int tid = threadIdx.x, tx = tid & 15, ty = tid >> 4;
    for (int k0 = 0; k0 < K; k0 += 8) {
        __syncthreads();
#pragma unroll
        for (int i = 0; i < 4; ++i) { const int idx = tid + i * 256, r = idx >> 3, kk = idx & 7;
            As[kk * 132 + r] = ldA<AT>(A + (size_t)(row0 + r) * lda + k0 + kk) * (gain ? gain[k0 + kk] : 1.0f); }
#pragma unroll
        for (int i = 0; i < 4; ++i) { const int idx = tid + i * 256, kk = idx >> 7, c = idx & 127;
            Bs[kk * 128 + c] = W[(size_t)(k0 + kk) * ldw + wcol0 + c]; }
        __syncthreads();
#pragma unroll
        for (int kk = 0; kk < 8; ++kk) {
            float a[8], b[8];
#pragma unroll
            for (int i = 0; i < 8; ++i) a[i] = As[kk * 132 + ty * 8 + i];
#pragma unroll
            for (int j = 0; j < 8; ++j) b[j] = Bs[kk * 128 + tx * 8 + j];
#pragma unroll
            for (int i = 0; i < 8; ++i)
#pragma unroll
                for (int j = 0; j < 8; ++j) acc[i][j] += a[i] * b[j];
        }
    }
}
#define ZERO_ACC(acc) do { _Pragma("unroll") for (int i = 0; i < 8; ++i) _Pragma("unroll") for (int j = 0; j < 8; ++j) acc[i][j] = 0.f; } while (0)

__global__ void __launch_bounds__(256) naive_ffn_in(const bf16_t* xb, const float* ssp, const float* gain, const float* Win, bf16_t* act) {
    __shared__ float As[8 * 132]; __shared__ float Bs[8 * 128];
    const int row0 = blockIdx.y * 128, col0 = blockIdx.x * 128, tx = threadIdx.x & 15, ty = threadIdx.x >> 4;
    float ag[8][8], au[8][8]; ZERO_ACC(ag); ZERO_ACC(au);
    accum_tile<bf16_t>(xb, D, D, gain, Win, 2 * DFF, row0, col0, ag, As, Bs);
    accum_tile<bf16_t>(xb, D, D, gain, Win, 2 * DFF, row0, DFF + col0, au, As, Bs);
#pragma unroll
    for (int i = 0; i < 8; ++i) { const int row = row0 + ty * 8 + i; const float rs = row_rstd(ssp, row);
#pragma unroll
        for (int j = 0; j < 8; ++j) { const float g = ag[i][j] * rs, u = au[i][j] * rs; const float sg = g / (1.0f + __expf(-g));
            act[(size_t)row * DFF + col0 + tx * 8 + j] = f2bf(sg * u); } }
}
__global__ void __launch_bounds__(256) naive_resid(const bf16_t* A, int K, const float* W, const float* xin, float* xout, float coef) {
    __shared__ float As[8 * 132]; __shared__ float Bs[8 * 128];
    const int row0 = blockIdx.y * 128, col0 = blockIdx.x * 128, tx = threadIdx.x & 15, ty = threadIdx.x >> 4;
    float acc[8][8]; ZERO_ACC(acc);
    accum_tile<bf16_t>(A, K, K, nullptr, W, D, row0, col0, acc, As, Bs);
#pragma unroll
    for (int i = 0; i < 8; ++i) { const int row = row0 + ty * 8 + i;
#pragma unroll
        for (int j = 0; j < 8; ++j) { const size_t o = (size_t)row * D + col0 + tx * 8 + j; xout[o] = xin[o] + coef * acc[i][j]; } }
}
struct QkvOut { bf16_t *qa, *ka, *va, *qb, *kb, *vb; const float *qna, *kna, *qnb, *knb; };
__global__ void __launch_bounds__(256) naive_qkv(const bf16_t* xb, const float* ssp, const float* gain, const float* Wqkv, QkvOut o) {
    __shared__ float As[8 * 132]; __shared__ float Bs[8 * 128];
    const int row0 = blockIdx.y * 128, col0 = blockIdx.x * 128, tx = threadIdx.x & 15, ty = threadIdx.x >> 4;
    float acc[8][8]; ZERO_ACC(acc);
    accum_tile<bf16_t>(xb, D, D, gain, Wqkv, QKVW, row0, col0, acc, As, Bs);
    const int c = col0 + tx * 8;
    bf16_t* dst; const float* ng; int nh, hc; float sc = 1.0f;
    if (c < 512) { dst = o.qa; ng = o.qna; nh = 8; hc = c; sc = QSCALE; }
    else if (c < 1024) { dst = o.ka; ng = o.kna; nh = 8; hc = c - 512; }
    else if (c < 1536) { dst = o.va; ng = nullptr; nh = 8; hc = c - 1024; }
    else if (c < 2048) { dst = o.qb; ng = o.qnb; nh = 8; hc = c - 1536; sc = QSCALE; }
    else if (c < 2176) { dst = o.kb; ng = o.knb; nh = 2; hc = c - 2048; }
    else { dst = o.vb; ng = nullptr; nh = 2; hc = c - 2176; }
    const int h = hc >> 6, e0 = hc & 63;
#pragma unroll
    for (int i = 0; i < 8; ++i) { const int row = row0 + ty * 8 + i; const float rs = row_rstd(ssp, row);
        float v[8]; float ss = 0.f;
#pragma unroll
        for (int j = 0; j < 8; ++j) { v[j] = acc[i][j] * rs; ss += v[j] * v[j]; }
        ss += __shfl_xor(ss, 1); ss += __shfl_xor(ss, 2); ss += __shfl_xor(ss, 4);
        const float hr = rsqrtf(ss * (1.0f / HD) + EPS);
        const int b = row / S, s = row % S;
        bf16_t* p = dst + (((size_t)b * nh + h) * S + s) * HD + e0;
#pragma unroll
        for (int j = 0; j < 8; ++j) p[j] = f2bf(ng ? v[j] * hr * ng[e0 + j] * sc : v[j]); }
}
__global__ void __launch_bounds__(256) naive_ple(const bf16_t* xb, const float* ssp, const float* gain, const float* Wg, const float* p, const float* Wp, const float* xin, float* xout) {
    __shared__ float As[8 * 132]; __shared__ float Bs[8 * 128];
    const int row0 = blockIdx.y * 128, col0 = blockIdx.x * 128, tx = threadIdx.x & 15, ty = threadIdx.x >> 4;
    float ag[8][8], ap[8][8]; ZERO_ACC(ag); ZERO_ACC(ap);
    accum_tile<bf16_t>(xb, D, D, gain, Wg, D, row0, col0, ag, As, Bs);
    accum_tile<float>(p, PLE, PLE, nullptr, Wp, D, row0, col0, ap, As, Bs);
#pragma unroll
    for (int i = 0; i < 8; ++i) { const int row = row0 + ty * 8 + i; const float rs = row_rstd(ssp, row);
#pragma unroll
        for (int j = 0; j < 8; ++j) { const size_t o = (size_t)row * D + col0 + tx * 8 + j; const float g = 1.0f / (1.0f + __expf(-ag[i][j] * rs));
            xout[o] = xin[o] + g * ap[i][j]; } }
}

__device__ __forceinline__ int t5_bucket(int rel) {
    const int n = rel < 0 ? -rel : rel; const int ret = rel > 0 ? 16 : 0;
    if (n < 8) return ret + n;
    int large = 8 + (int)(logf((float)n / 8.0f) / 4.852030263919617f * 8.0f);
    large = large < 15 ? large : 15;
    return ret + large;
}
struct AttnIn { const bf16_t *qa, *ka, *va, *qb, *kb, *vb; const float* rel_bias; const float* sink; bf16_t* o; };
__global__ void __launch_bounds__(256) naive_attn(AttnIn a) {
    __shared__ float pl[4][400]; __shared__ int kl[4][400];
    const int wave = threadIdx.x >> 6, lane = threadIdx.x & 63;
    const int t = blockIdx.x * 4 + wave, head = blockIdx.y, b = blockIdx.z;
    const bool isA = head < 8;
    const bf16_t *q, *k, *v;
    if (isA) { q = a.qa + (((size_t)b * 8 + head) * S + t) * HD; k = a.ka + ((size_t)b * 8 + head) * S * HD; v = a.va + ((size_t)b * 8 + head) * S * HD; }
    else { const int hq = head - 8, hk = hq >> 2; q = a.qb + (((size_t)b * 8 + hq) * S + t) * HD; k = a.kb + ((size_t)b * 2 + hk) * S * HD; v = a.vb + ((size_t)b * 2 + hk) * S * HD; }
    float qf[HD];
#pragma unroll
    for (int e = 0; e < HD; ++e) qf[e] = bf2f(q[e]);
    const int nk = isA ? 387 : 257;
    float mx = -1e30f;
    for (int i = lane; i < nk; i += 64) {
        int rel;
        if (isA) { const int br = i / 129, j = i % 129 - 64; rel = j * (br == 0 ? 1 : br == 1 ? 4 : 16); }
        else rel = i - 128;
        const int tk = t + rel;
        float lg = -1e30f;
        if (tk >= 0 && tk < S) {
            float d = 0.f; const bf16_t* kr = k + (size_t)tk * HD;
#pragma unroll
            for (int e = 0; e < HD; ++e) d += qf[e] * bf2f(kr[e]);
            lg = d + a.rel_bias[t5_bucket(rel) * 16 + head] * LOG2E;
        }
        pl[wave][i] = lg; kl[wave][i] = tk;
        mx = fmaxf(mx, lg);
    }
#pragma unroll
    for (int o = 1; o < 64; o <<= 1) mx = fmaxf(mx, __shfl_xor(mx, o));
    float sinkl = 0.f;
    if (!isA) { sinkl = a.sink[head - 8] * LOG2E; mx = fmaxf(mx, sinkl); }
    float sum = 0.f;
    for (int i = lane; i < nk; i += 64) { const float lg = pl[wave][i]; const float pv = lg > -1e29f ? exp2f(lg - mx) : 0.f; pl[wave][i] = pv; sum += pv; }
#pragma unroll
    for (int o = 1; o < 64; o <<= 1) sum += __shfl_xor(sum, o);
    if (!isA) sum += exp2f(sinkl - mx);
    __syncthreads();
    float acc = 0.f;
    for (int i = 0; i < nk; ++i) { const float pv = pl[wave][i]; if (pv != 0.f) acc += pv * bf2f(v[(size_t)kl[wave][i] * HD + lane]); }
    a.o[((size_t)b * S + t) * D + head * HD + lane] = f2bf(acc / sum);
}

namespace pg8 {
#define PG8_LAS __attribute__((address_space(3)))
typedef unsigned short bf16_t;
typedef short bf16x8 __attribute__((ext_vector_type(8)));
typedef float f32x4 __attribute__((ext_vector_type(4)));
typedef unsigned u32x4 __attribute__((ext_vector_type(4)));
constexpr int BM = 256, BK = 64, HALF = 128, HTB = HALF * BK * 2  , STAGE_BYTES = 8 * HTB, NXCD = 8, WGM = 8;

__host__ __device__ __forceinline__ int lds_byte(int r, int c) { const int st = (r >> 4) * 2 + (c >> 5), rr = r & 15, cc = c & 31, ob = rr * 64 + cc * 2; return st * 1024 + (ob ^ (((ob >> 9) & 1) << 5)); }
__host__ __device__ __forceinline__ void stage_rc(int b, int& R, int& C) { const int st = b / 1024, sb = b % 1024, swz = sb ^ (((sb >> 9) & 1) << 5); R = (st >> 1) * 16 + swz / 64; C = (st & 1) * 32 + (swz % 64) / 2; }
__host__ __device__ __forceinline__ int perm32(int rho) { const int n = rho >> 4, i = rho & 15; return 8 * (i >> 2) + 4 * n + (i & 3); }

struct Unit { int pm, pn; };
struct Gemm { const bf16_t* A; const bf16_t* Bt; int M, N, K; };

struct StaticOrder {
    int nM, nN, nwg, G, c;
    __host__ __device__ void init(int M, int N, int G_, int c_) { nM = M / BM; nN = N / BM; nwg = nM * nN; G = G_; c = c_; }
    __host__ __device__ bool next(int i, Unit& u) const {
        const long L = (long)i * G + c; if (L >= nwg) return false;
        int wgid = (int)L; { const int q = nwg / NXCD, r = nwg % NXCD, xcd = wgid % NXCD, off = wgid / NXCD; wgid = (xcd < r ? xcd * (q + 1) : r * (q + 1) + (xcd - r) * q) + off; }
        const int nig = WGM * nN, gid = wgid / nig, fm = gid * WGM, gsz = (nM - fm) < WGM ? (nM - fm) : WGM;
        u.pm = fm + ((wgid % nig) % gsz); u.pn = (wgid % nig) / gsz; return true;
    }
    __device__ __forceinline__ void a_ready(const Unit&) const {}
    __device__ __forceinline__ void done(const Unit&) const {}
};

__device__ __forceinline__ unsigned cvt_pk_bf16(float lo, float hi) { unsigned r; asm volatile("v_cvt_pk_bf16_f32 %0, %1, %2" : "=v"(r) : "v"(lo), "v"(hi)); return r; }
typedef float f32x2 __attribute__((ext_vector_type(2)));
template <class Epi, class Sched, bool ALIGN_EPI = false, bool SP2 = false>
__device__ __forceinline__ void gemm_phase(PG8_LAS unsigned char* lds, const Gemm g, const Sched& S, const Epi& E, const int tid) {
    const int wid = __builtin_amdgcn_readfirstlane(tid >> 6), lane = tid & 63, wr = wid >> 2, wc = wid & 3, fr = lane & 15, fq = lane >> 4;
    const int K = g.K, nt = K / BK;
    unsigned voffA[2], voffB[2];
#pragma unroll
    for (int i = 0; i < 2; ++i) { int R, C; stage_rc(tid * 16 + i * 8192, R, C); const int Rb = Epi::PERM ? ((R & ~31) + perm32(R & 31)) : R;
        voffA[i] = (unsigned)(R * K + C) * 2u; voffB[i] = (unsigned)(Rb * K + C) * 2u; }
    const size_t kstep = (size_t)(BK * 2);
    const size_t hstep = (size_t)HALF * K * 2;
    const size_t tstep = 2 * hstep;
    const unsigned ldsw = (unsigned)wid * 1024u;
    const int aoff = lds_byte(wr * 64 + fr, fq * 8), boff = lds_byte(wc * 32 + fr, fq * 8);
#define PG8_SA(b, h) (((b) * 2 + (h)) * HTB)
#define PG8_SB(b, h) ((4 + (b) * 2 + (h)) * HTB)
#define PG8_STAGE(bufoff, gbase, voff) do { _Pragma("unroll") for (int _i = 0; _i < 2; ++_i) \
        __builtin_amdgcn_global_load_lds((const unsigned*)((const char*)(gbase) + (voff)[_i]), (PG8_LAS unsigned*)(lds + (bufoff) + ldsw + _i * 8192), 16, 0, 0); } while (0)
#define PG8_LDA(dst, b, h) do { _Pragma("unroll") for (int m = 0; m < 4; ++m) _Pragma("unroll") for (int k = 0; k < 2; ++k) dst[m][k] = *(const PG8_LAS bf16x8*)(lds + PG8_SA(b, h) + aoff + m * 2048 + k * 1024); } while (0)
#define PG8_LDB(dst, b, h) do { _Pragma("unroll") for (int n = 0; n < 2; ++n) _Pragma("unroll") for (int k = 0; k < 2; ++k) dst[n][k] = *(const PG8_LAS bf16x8*)(lds + PG8_SB(b, h) + boff + n * 2048 + k * 1024); } while (0)
#define PG8_MMA(ai, bj, At, Bt) do { __builtin_amdgcn_s_setprio(1); _Pragma("unroll") for (int m = 0; m < 4; ++m) _Pragma("unroll") for (int n = 0; n < 2; ++n) _Pragma("unroll") for (int k = 0; k < 2; ++k) \
        acc[ai][bj][m][n] = __builtin_amdgcn_mfma_f32_16x16x32_bf16(Bt[n][k], At[m][k], acc[ai][bj][m][n], 0, 0, 0); __builtin_amdgcn_s_setprio(0); } while (0)
#define PG8_WAIT_V(n) asm volatile("s_waitcnt vmcnt(" #n ")" ::: "memory")
#define PG8_WAIT_L(n) asm volatile("s_waitcnt lgkmcnt(" #n ")" ::: "memory")
#define PG8_BAR __builtin_amdgcn_s_barrier()
#define PG8_SCHED __builtin_amdgcn_sched_barrier(0)
    Unit cur, nxt; int ui = 0;
    if (!S.next(0, cur)) return;
    f32x4 acc[2][2][4][2];
#pragma unroll
    for (int a = 0; a < 2; ++a)
#pragma unroll
        for (int b = 0; b < 2; ++b)
#pragma unroll
            for (int m = 0; m < 4; ++m)
#pragma unroll
                for (int n = 0; n < 2; ++n) acc[a][b][m][n] = (f32x4){0.f, 0.f, 0.f, 0.f};
    bf16x8 At[4][2], B0[2][2], B1[2][2];
    const char* cA = (const char*)g.A + (size_t)cur.pm * tstep; const char* cB = (const char*)g.Bt + (size_t)cur.pn * tstep;
    S.a_ready(cur);
    if constexpr (SP2) {
        PG8_STAGE(PG8_SB(0, 0), cB, voffB); PG8_STAGE(PG8_SB(0, 1), cB + hstep, voffB); PG8_STAGE(PG8_SA(0, 0), cA, voffA); PG8_STAGE(PG8_SA(0, 1), cA + hstep, voffA);
        if (wr == 1) PG8_BAR;
        PG8_WAIT_V(2); PG8_BAR;
        PG8_STAGE(PG8_SB(1, 0), cB + kstep, voffB); PG8_STAGE(PG8_SA(1, 0), cA + kstep, voffA); PG8_STAGE(PG8_SB(1, 1), cB + hstep + kstep, voffB);
        PG8_WAIT_V(6); PG8_BAR;
    } else {
        PG8_STAGE(PG8_SB(0, 0), cB, voffB); PG8_STAGE(PG8_SA(0, 0), cA, voffA); PG8_STAGE(PG8_SB(0, 1), cB + hstep, voffB); PG8_STAGE(PG8_SA(0, 1), cA + hstep, voffA);
        if (wr == 1) PG8_BAR;
        PG8_WAIT_V(4); PG8_BAR;
        PG8_STAGE(PG8_SB(1, 0), cB + kstep, voffB); PG8_STAGE(PG8_SA(1, 0), cA + kstep, voffA); PG8_STAGE(PG8_SB(1, 1), cB + hstep + kstep, voffB);
        PG8_WAIT_V(6); PG8_BAR;
    }
    for (;;) {
        const bool has_next = S.next(ui + 1, nxt);
        const char* nA = has_next ? (const char*)g.A + (size_t)nxt.pm * tstep : cA; const char* nB = has_next ? (const char*)g.Bt + (size_t)nxt.pn * tstep : cB;
        for (int t = 0; t < nt; t += 2) {
            const bool last = (t == nt - 2);
            const char* a1 = cA + (size_t)(t + 1) * kstep;
            const char* a2 = last ? nA : cA + (size_t)(t + 2) * kstep; const char* b2 = last ? nB : cB + (size_t)(t + 2) * kstep;
            const char* a3 = a2 + kstep; const char* b3 = b2 + kstep;
            if (last && has_next) S.a_ready(nxt);
            if constexpr (SP2) {
            PG8_LDB(B0, 0, 0); PG8_LDB(B1, 0, 1); PG8_SCHED; PG8_LDA(At, 0, 0); PG8_STAGE(PG8_SA(1, 1), a1 + hstep, voffA);
            PG8_WAIT_V(8); PG8_WAIT_L(0); PG8_BAR; PG8_MMA(0, 0, At, B0); PG8_MMA(0, 1, At, B1); PG8_BAR; PG8_SCHED;
            PG8_LDA(At, 0, 1); PG8_STAGE(PG8_SB(0, 0), b2, voffB); PG8_STAGE(PG8_SB(0, 1), b2 + hstep, voffB); PG8_STAGE(PG8_SA(0, 0), a2, voffA);
            PG8_WAIT_V(8); PG8_WAIT_L(0); PG8_BAR; PG8_MMA(1, 0, At, B0); PG8_MMA(1, 1, At, B1); PG8_BAR; PG8_SCHED;
            PG8_LDB(B0, 1, 0); PG8_LDB(B1, 1, 1); PG8_SCHED; PG8_LDA(At, 1, 0); PG8_STAGE(PG8_SA(0, 1), a2 + hstep, voffA);
            PG8_WAIT_V(8); PG8_WAIT_L(0); PG8_BAR; PG8_MMA(0, 0, At, B0); PG8_MMA(0, 1, At, B1); PG8_BAR; PG8_SCHED;
            PG8_LDA(At, 1, 1); PG8_STAGE(PG8_SB(1, 0), b3, voffB); PG8_STAGE(PG8_SB(1, 1), b3 + hstep, voffB); PG8_STAGE(PG8_SA(1, 0), a3, voffA);
            PG8_WAIT_V(8); PG8_WAIT_L(0); PG8_BAR; PG8_MMA(1, 0, At, B0); PG8_MMA(1, 1, At, B1); PG8_BAR; PG8_SCHED;
            } else {
            PG8_LDB(B0, 0, 0); PG8_SCHED; PG8_LDA(At, 0, 0); PG8_STAGE(PG8_SA(1, 1), a1 + hstep, voffA);
            PG8_WAIT_L(8); PG8_BAR; PG8_WAIT_L(0); PG8_MMA(0, 0, At, B0); PG8_BAR; PG8_SCHED;
            PG8_LDB(B1, 0, 1); PG8_STAGE(PG8_SB(0, 0), b2, voffB);
            PG8_BAR; PG8_WAIT_L(0); PG8_MMA(0, 1, At, B1); PG8_BAR;
            PG8_LDA(At, 0, 1); PG8_STAGE(PG8_SA(0, 0), a2, voffA);
            PG8_BAR; PG8_WAIT_L(0); PG8_MMA(1, 0, At, B0); PG8_BAR; PG8_SCHED;
            PG8_STAGE(PG8_SB(0, 1), b2 + hstep, voffB);
            PG8_WAIT_V(6); PG8_BAR; PG8_MMA(1, 1, At, B1); PG8_BAR;
            PG8_LDB(B0, 1, 0); PG8_SCHED; PG8_LDA(At, 1, 0); PG8_STAGE(PG8_SA(0, 1), a2 + hstep, voffA);
            PG8_WAIT_L(8); PG8_BAR; PG8_WAIT_L(0); PG8_MMA(0, 0, At, B0); PG8_BAR; PG8_SCHED;
            PG8_LDB(B1, 1, 1); PG8_STAGE(PG8_SB(1, 0), b3, voffB);
            PG8_BAR; PG8_WAIT_L(0); PG8_MMA(0, 1, At, B1); PG8_BAR;
            PG8_LDA(At, 1, 1); PG8_STAGE(PG8_SA(1, 0), a3, voffA);
            PG8_BAR; PG8_WAIT_L(0); PG8_MMA(1, 0, At, B0); PG8_BAR; PG8_SCHED;
            PG8_STAGE(PG8_SB(1, 1), b3 + hstep, voffB);
            PG8_WAIT_V(6); PG8_BAR; PG8_MMA(1, 1, At, B1); PG8_BAR;
            }
        }
        if constexpr (ALIGN_EPI) { if (wr == 0) PG8_BAR; }
        if constexpr (!Epi::AFTER_DRAIN) { int l2_; asm volatile("v_mbcnt_lo_u32_b32 %0, -1, 0\n\tv_mbcnt_hi_u32_b32 %0, -1, %0" : "=v"(l2_)); E(acc, cur, wr, wc, l2_ & 15, l2_ >> 4); S.done(cur); }
        if (!has_next) break;
#pragma unroll
        for (int a = 0; a < 2; ++a)
#pragma unroll
            for (int b = 0; b < 2; ++b)
#pragma unroll
                for (int m = 0; m < 4; ++m)
#pragma unroll
                    for (int n = 0; n < 2; ++n) acc[a][b][m][n] = (f32x4){0.f, 0.f, 0.f, 0.f};
        cur = nxt; cA = nA; cB = nB; ++ui;
        if constexpr (ALIGN_EPI) { if (wr == 1) PG8_BAR; }
    }
    PG8_WAIT_V(0);
    if constexpr (!ALIGN_EPI) { if (wr == 0) PG8_BAR; }
    PG8_BAR;
    if constexpr (Epi::AFTER_DRAIN) { E.fused(acc, cur, wr, wc, fr, fq, lds, wid, lane); S.done(cur); }
#undef PG8_SA
#undef PG8_SB
#undef PG8_STAGE
#undef PG8_LDA
#undef PG8_LDB
#undef PG8_MMA
#undef PG8_WAIT_V
#undef PG8_WAIT_L
#undef PG8_BAR
#undef PG8_SCHED
}
}

namespace pg8 {
typedef float f32x2 __attribute__((ext_vector_type(2)));
__device__ __forceinline__ float shx(float v, int lane, int mask) { return __int_as_float(__builtin_amdgcn_ds_bpermute((lane ^ mask) << 2, __float_as_int(v))); }
__device__ __forceinline__ float rstd16(const float* ssp, int row, int fq, int lane) {
    const f32x4 v = *(const f32x4*)(ssp + (size_t)row * 16 + 4 * fq);
    float s = (v[0] + v[1]) + (v[2] + v[3]);
    s += shx(s, lane, 16); s += shx(s, lane, 32);
    return rsqrtf(s * (1.0f / 1024.0f) + 1e-6f);
}
__device__ __forceinline__ float sigm(float v) { return __builtin_amdgcn_rcpf(1.0f + __builtin_amdgcn_exp2f(-1.4426950408889634f * v)); }
__device__ __forceinline__ u32x4 pack8(const f32x4& a, const f32x4& b) { u32x4 w; w.x = cvt_pk_bf16(a[0], a[1]); w.y = cvt_pk_bf16(a[2], a[3]); w.z = cvt_pk_bf16(b[0], b[1]); w.w = cvt_pk_bf16(b[2], b[3]); return w; }
__device__ __forceinline__ float bflo(unsigned w) { return __uint_as_float(w << 16); }
__device__ __forceinline__ float bfhi(unsigned w) { return __uint_as_float(w & 0xffff0000u); }

struct EpiSwiglu {
    static constexpr bool PERM = true, AFTER_DRAIN = false;
    bf16_t* act; const float* ssp; int mode;
    __device__ __forceinline__ void operator()(const f32x4 (&acc)[2][2][4][2], const Unit& u, int wr, int wc, int fr, int fq) const {
        const int lane = fr + 16 * fq;
        const int row0 = u.pm * BM + wr * 64 + fr, col0 = u.pn * 128 + wc * 32 + 8 * fq;
#pragma unroll
        for (int ai = 0; ai < 2; ++ai)
#pragma unroll
            for (int m = 0; m < 4; ++m) { const int row = row0 + ai * HALF + m * 16; const float rs = rstd16(ssp, row, fq, lane);
                f32x4 o[2];
                const float c1 = -1.4426950408889634f * rs, rs2 = rs * rs;
#pragma unroll
                for (int n = 0; n < 2; ++n)
#pragma unroll
                    for (int j = 0; j < 4; ++j) { const float g = acc[ai][0][m][n][j], up = acc[ai][1][m][n][j];
                        o[n][j] = (PROBE_NULL_EPI && mode == 2) ? g + up : (g * up) * (rs2 * __builtin_amdgcn_rcpf(1.0f + __builtin_amdgcn_exp2f(c1 * g))); }
                const u32x4 w = pack8(o[0], o[1]);
                if (PROBE_NULL_EPI && mode == 1) asm volatile("" :: "v"(w)); else *(u32x4*)(act + (size_t)row * 2816 + col0) = w; }
    }
};
struct EpiResid {
    static constexpr bool PERM = true, AFTER_DRAIN = false;
    const float* xin; float* xout; bf16_t* xb; float* sspw; float coef;
    __device__ __forceinline__ void operator()(const f32x4 (&acc)[2][2][4][2], const Unit& u, int wr, int wc, int fr, int fq) const {
        const int lane = fr + 16 * fq;
        float cf = __uint_as_float(__builtin_amdgcn_readfirstlane(__float_as_uint(coef))); asm volatile("" : "+s"(cf));
        const int row0 = u.pm * BM + wr * 64 + fr, col0 = u.pn * BM + wc * 32 + 8 * fq;
#pragma unroll
        for (int ai = 0; ai < 2; ++ai)
#pragma unroll
            for (int mh = 0; mh < 2; ++mh) {
            f32x4 xo[2][2][2];
#pragma unroll
            for (int mm = 0; mm < 2; ++mm)
#pragma unroll
                for (int bj = 0; bj < 2; ++bj) { const size_t off = (size_t)(row0 + ai * HALF + (2 * mh + mm) * 16) * 1024 + col0 + bj * HALF; xo[mm][bj][0] = *(const f32x4*)(xin + off); xo[mm][bj][1] = *(const f32x4*)(xin + off + 4); }
            asm volatile("" ::: "memory");
#pragma unroll
            for (int mm = 0; mm < 2; ++mm) { const int m = 2 * mh + mm, row = row0 + ai * HALF + m * 16; float ss = 0.f;
#pragma unroll
                for (int bj = 0; bj < 2; ++bj) { const size_t off = (size_t)row * 1024 + col0 + bj * HALF;
                    const f32x4 x0 = xo[mm][bj][0] + acc[ai][bj][m][0] * cf, x1 = xo[mm][bj][1] + acc[ai][bj][m][1] * cf;
                    *(f32x4*)(xout + off) = x0; *(f32x4*)(xout + off + 4) = x1;
                    *(u32x4*)(xb + off) = pack8(x0, x1);
                    ss += (x0[0] * x0[0] + x0[1] * x0[1]) + (x0[2] * x0[2] + x0[3] * x0[3]) + (x1[0] * x1[0] + x1[1] * x1[1]) + (x1[2] * x1[2] + x1[3] * x1[3]); }
                ss += shx(ss, lane, 16); ss += shx(ss, lane, 32);
                if (fq == 0) sspw[(size_t)row * 16 + u.pn * 4 + wc] = ss; }
            asm volatile("" ::: "memory");
        }
    }
};
struct EpiGate {
    static constexpr bool PERM = true, AFTER_DRAIN = false;
    const float* xin; float* xout; bf16_t* xb; float* sspw; const float* sspr; const bf16_t* proj; float coef;
    __device__ __forceinline__ void operator()(const f32x4 (&acc)[2][2][4][2], const Unit& u, int wr, int wc, int fr, int fq) const {
        const int lane = fr + 16 * fq;
        float cf = __uint_as_float(__builtin_amdgcn_readfirstlane(__float_as_uint(coef))); asm volatile("" : "+s"(cf));
        const int row0 = u.pm * BM + wr * 64 + fr, col0 = u.pn * BM + wc * 32 + 8 * fq;
#pragma unroll
        for (int ai = 0; ai < 2; ++ai)
#pragma unroll
            for (int mh = 0; mh < 2; ++mh) {
                f32x4 xo[2][2][2]; u32x4 pw[2][2]; float rs[2];
#pragma unroll
                for (int mm = 0; mm < 2; ++mm) { const int row = row0 + ai * HALF + (2 * mh + mm) * 16; rs[mm] = rstd16(sspr, row, fq, lane);
#pragma unroll
                    for (int bj = 0; bj < 2; ++bj) { const size_t off = (size_t)row * 1024 + col0 + bj * HALF; xo[mm][bj][0] = *(const f32x4*)(xin + off); xo[mm][bj][1] = *(const f32x4*)(xin + off + 4); pw[mm][bj] = *(const u32x4*)(proj + off); } }
                asm volatile("" ::: "memory");
#pragma unroll
                for (int mm = 0; mm < 2; ++mm) { const int m = 2 * mh + mm, row = row0 + ai * HALF + m * 16; float ss = 0.f;
#pragma unroll
                    for (int bj = 0; bj < 2; ++bj) { const size_t off = (size_t)row * 1024 + col0 + bj * HALF;
                        f32x4 x0 = xo[mm][bj][0], x1 = xo[mm][bj][1]; const u32x4 pq = pw[mm][bj];
                        const f32x4 p0 = {bflo(pq.x), bfhi(pq.x), bflo(pq.y), bfhi(pq.y)}, p1 = {bflo(pq.z), bfhi(pq.z), bflo(pq.w), bfhi(pq.w)};
#pragma unroll
                        for (int j = 0; j < 4; ++j) { x0[j] += cf * (sigm(acc[ai][bj][m][0][j] * rs[mm]) * p0[j]); x1[j] += cf * (sigm(acc[ai][bj][m][1][j] * rs[mm]) * p1[j]); }
                        *(f32x4*)(xout + off) = x0; *(f32x4*)(xout + off + 4) = x1;
                        *(u32x4*)(xb + off) = pack8(x0, x1);
                        ss += (x0[0] * x0[0] + x0[1] * x0[1]) + (x0[2] * x0[2] + x0[3] * x0[3]) + (x1[0] * x1[0] + x1[1] * x1[1]) + (x1[2] * x1[2] + x1[3] * x1[3]); }
                    ss += shx(ss, lane, 16); ss += shx(ss, lane, 32);
                    if (fq == 0) sspw[(size_t)row * 16 + u.pn * 4 + wc] = ss; }
                asm volatile("" ::: "memory");
            }
    }
};
struct EpiStoreBf16 {
    static constexpr bool PERM = true, AFTER_DRAIN = false;
    bf16_t* O; int ldc;
    __device__ __forceinline__ void operator()(const f32x4 (&acc)[2][2][4][2], const Unit& u, int wr, int wc, int fr, int fq) const {
        const int lane = fr + 16 * fq;
        const int row0 = u.pm * BM + wr * 64 + fr, col0 = u.pn * BM + wc * 32 + 8 * fq;
#pragma unroll
        for (int ai = 0; ai < 2; ++ai)
#pragma unroll
            for (int m = 0; m < 4; ++m) { const int row = row0 + ai * HALF + m * 16;
#pragma unroll
                for (int bj = 0; bj < 2; ++bj) *(u32x4*)(O + (size_t)row * ldc + col0 + bj * HALF) = pack8(acc[ai][bj][m][0], acc[ai][bj][m][1]); }
    }
};
struct EpiNull {
    static constexpr bool PERM = true, AFTER_DRAIN = false;
    __device__ __forceinline__ void operator()(const f32x4 (&acc)[2][2][4][2], const Unit& u, int wr, int wc, int fr, int fq) const {
#pragma unroll
        for (int ai = 0; ai < 2; ++ai)
#pragma unroll
            for (int bj = 0; bj < 2; ++bj)
#pragma unroll
                for (int m = 0; m < 4; ++m)
#pragma unroll
                    for (int n = 0; n < 2; ++n) asm volatile("" :: "v"(acc[ai][bj][m][n]));
    }
};
struct EpiQkv {
    static constexpr bool PERM = true, AFTER_DRAIN = false;
    const float* ssp; bf16_t *qa, *ka, *va, *qb, *kb, *vb; const float *qna, *kna, *qnb, *knb;
    __device__ __forceinline__ void operator()(const f32x4 (&acc)[2][2][4][2], const Unit& u, int wr, int wc, int fr, int fq) const {
        const int lane = fr + 16 * fq;
        const int t = u.pn; bf16_t* dst; const float* ng; int nh, h; float sc = 1.0f;
        if (t < 2) { dst = qa; ng = qna; nh = 8; h = 4 * t + wc; sc = QSCALE; }
        else if (t < 4) { dst = ka; ng = kna; nh = 8; h = 4 * (t - 2) + wc; }
        else if (t < 6) { dst = va; ng = nullptr; nh = 8; h = 4 * (t - 4) + wc; }
        else if (t < 8) { dst = qb; ng = qnb; nh = 8; h = 4 * (t - 6) + wc; sc = QSCALE; }
        else if (wc < 2) { dst = kb; ng = knb; nh = 2; h = wc; }
        else { dst = vb; ng = nullptr; nh = 2; h = wc - 2; }
        f32x4 gv[2][2];
#pragma unroll
        for (int bj = 0; bj < 2; ++bj)
#pragma unroll
            for (int n = 0; n < 2; ++n) { if (ng) gv[bj][n] = *(const f32x4*)(ng + 32 * bj + 8 * fq + 4 * n) * sc; else gv[bj][n] = (f32x4){1.f, 1.f, 1.f, 1.f}; }
        const int row0 = u.pm * BM + wr * 64 + fr;
#pragma unroll
        for (int ai = 0; ai < 2; ++ai)
#pragma unroll
            for (int m = 0; m < 4; ++m) { const int row = row0 + ai * HALF + m * 16; const float rs = rstd16(ssp, row, fq, lane);
                f32x4 v[2][2]; float ss = 0.f;
#pragma unroll
                for (int bj = 0; bj < 2; ++bj)
#pragma unroll
                    for (int n = 0; n < 2; ++n) { v[bj][n] = acc[ai][bj][m][n] * rs; ss += (v[bj][n][0] * v[bj][n][0] + v[bj][n][1] * v[bj][n][1]) + (v[bj][n][2] * v[bj][n][2] + v[bj][n][3] * v[bj][n][3]); }
                ss += shx(ss, lane, 16); ss += shx(ss, lane, 32);
                const float hr = ng ? rsqrtf(ss * (1.0f / 64.0f) + 1e-6f) : 1.0f;
                const int b = row >> 12, s = row & 4095;
                bf16_t* p = dst + (((size_t)b * nh + h) * 4096 + s) * 64 + 8 * fq;
#pragma unroll
                for (int bj = 0; bj < 2; ++bj) *(u32x4*)(p + 32 * bj) = pack8(v[bj][0] * hr * gv[bj][0], v[bj][1] * hr * gv[bj][1]); }
    }
};
}

#include <hip/hip_cooperative_groups.h>
namespace cg = cooperative_groups;
#define LAS __attribute__((address_space(3)))
typedef unsigned v4u __attribute__((ext_vector_type(4)));
constexpr int NWAVES = 8, RING_BYTES = 131072, LDS_BYTES = 147456;
constexpr int NPHASE = 1 + 8 * DEPTH;
constexpr size_t WO_F1IN = 0, WO_F1OUT = WO_F1IN + (size_t)2 * DFF * D, WO_QKV = WO_F1OUT + (size_t)D * DFF, WO_WO = WO_QKV + (size_t)QKVW * D,
                 WO_F2IN = WO_WO + (size_t)D * D, WO_F2OUT = WO_F2IN + (size_t)2 * DFF * D, WO_WG = WO_F2OUT + (size_t)D * DFF, WO_WP = WO_WG + (size_t)D * D, W_LAYER = WO_WP + (size_t)D * PLE;
static_assert(W_LAYER * 2 * DEPTH <= 84 * MiB, "weights fit");

struct Args { const float* in[20]; float* out; unsigned char* ws; int ph_lo, ph_hi; };

__device__ __forceinline__ int src_col(int kind, int n0) {
    if (kind == 0) return n0;
    if (kind == 1) return ((n0 >> 7) & 1) * DFF + 128 * (n0 >> 8) + (n0 & 127);
    return 256 * (n0 >> 8) + 64 * ((n0 >> 5) & 3) + 32 * ((n0 >> 7) & 1);
}
__device__ __forceinline__ void transpose_item(const float* W, int K, int N, const float* gain, bf16_t* Bt, int kind, int item, LAS float* scr, int lane) {
    const int kblocks = K / 64, nb = item / kblocks, kb = item % kblocks, k0 = 64 * kb, n0 = 64 * nb;
    const int cseg = lane & 15, r0 = lane >> 4;
    const int c0 = src_col(kind, n0 + 32 * (cseg >> 3)) + 4 * (cseg & 7);
    float4 v[16];
#pragma unroll
    for (int i = 0; i < 16; ++i) v[i] = *(const float4*)(W + (size_t)(k0 + r0 + 4 * i) * N + c0);
    if (gain) {
#pragma unroll
        for (int i = 0; i < 16; ++i) { const float g = gain[k0 + r0 + 4 * i]; v[i].x *= g; v[i].y *= g; v[i].z *= g; v[i].w *= g; }
    }
#pragma unroll
    for (int i = 0; i < 16; ++i) { LAS float* p = scr + (r0 + 4 * i) * 65 + 4 * cseg; p[0] = v[i].x; p[1] = v[i].y; p[2] = v[i].z; p[3] = v[i].w; }
    asm volatile("s_waitcnt lgkmcnt(0)" ::: "memory");
    const int c = lane & 7;
#pragma unroll
    for (int j = 0; j < 8; ++j) { const int n = (lane >> 3) + 8 * j; const LAS float* sp = scr + (8 * c) * 65 + n;
        v4u o; o.x = pg8::cvt_pk_bf16(sp[0 * 65], sp[1 * 65]); o.y = pg8::cvt_pk_bf16(sp[2 * 65], sp[3 * 65]); o.z = pg8::cvt_pk_bf16(sp[4 * 65], sp[5 * 65]); o.w = pg8::cvt_pk_bf16(sp[6 * 65], sp[7 * 65]);
        *(v4u*)(Bt + (size_t)(n0 + n) * K + k0 + 8 * c) = o; }
    asm volatile("s_waitcnt lgkmcnt(0)" ::: "memory");
}

constexpr int I_FIN = (D / 64) * (2 * DFF / 64), I_FOUT = (DFF / 64) * (D / 64), I_QKV = (D / 64) * (QKVW / 64), I_SQ = (D / 64) * (D / 64), I_WP = (PLE / 64) * (D / 64);
constexpr int IT_FIN1 = 0, IT_FOUT1 = IT_FIN1 + I_FIN, IT_QKV = IT_FOUT1 + I_FOUT, IT_WO = IT_QKV + I_QKV, IT_FIN2 = IT_WO + I_SQ, IT_FOUT2 = IT_FIN2 + I_FIN, IT_WG = IT_FOUT2 + I_FOUT, IT_WP = IT_WG + I_SQ, I_LAYER = IT_WP + I_WP;
template <class AT> __device__ __forceinline__ void convert_weight_items(const AT& a, LAS unsigned char* lds, int first, int count, int widx, int nw, int wave, int lane) {
    LAS float* scr = (LAS float*)(lds + wave * 16640);
    bf16_t* wbase = (bf16_t*)(a.ws() + WS_W);
    for (int it = first + widx; it < first + count; it += nw) {
        const int l = it / I_LAYER; int r = it % I_LAYER; bf16_t* wl = wbase + (size_t)l * W_LAYER;
        if (r < I_FIN) { transpose_item(a.in(4) + (size_t)l * D * 2 * DFF, D, 2 * DFF, a.in(3) + l * D, wl + WO_F1IN, 1, r, scr, lane); continue; } r -= I_FIN;
        if (r < I_FOUT) { transpose_item(a.in(5) + (size_t)l * DFF * D, DFF, D, nullptr, wl + WO_F1OUT, 0, r, scr, lane); continue; } r -= I_FOUT;
        if (r < I_QKV) { transpose_item(a.in(7) + (size_t)l * D * QKVW, D, QKVW, a.in(6) + l * D, wl + WO_QKV, 2, r, scr, lane); continue; } r -= I_QKV;
        if (r < I_SQ) { transpose_item(a.in(13) + (size_t)l * D * D, D, D, nullptr, wl + WO_WO, 0, r, scr, lane); continue; } r -= I_SQ;
        if (r < I_FIN) { transpose_item(a.in(15) + (size_t)l * D * 2 * DFF, D, 2 * DFF, a.in(14) + l * D, wl + WO_F2IN, 1, r, scr, lane); continue; } r -= I_FIN;
        if (r < I_FOUT) { transpose_item(a.in(16) + (size_t)l * DFF * D, DFF, D, nullptr, wl + WO_F2OUT, 0, r, scr, lane); continue; } r -= I_FOUT;
        if (r < I_SQ) { transpose_item(a.in(18) + (size_t)l * D * D, D, D, a.in(17) + l * D, wl + WO_WG, 0, r, scr, lane); continue; } r -= I_SQ;
        transpose_item(a.in(19) + (size_t)l * PLE * D, PLE, D, nullptr, wl + WO_WP, 0, r, scr, lane);
    }
}
template <class AT> __device__ __forceinline__ void prologue_phase(const AT& a, LAS unsigned char* lds, int gw, int NGW, int wave, int lane, bool side_jobs) {
    if (side_jobs) convert_weight_items(a, lds, IT_FIN1, I_FIN, gw, NGW, wave, lane);
    else convert_weight_items(a, lds, 0, DEPTH * I_LAYER, gw, NGW, wave, lane);
    const float* x = a.in(0); bf16_t* xb = (bf16_t*)(a.ws() + WS_XB); float* ssp = (float*)(a.ws() + WS_SSP);
    for (int row = gw; row < M; row += 2 * NGW) {
        const int row2 = row + NGW; const bool has2 = row2 < M;
        const float4* xr = (const float4*)(x + (size_t)row * D); const float4* xr2 = (const float4*)(x + (size_t)(has2 ? row2 : row) * D);
        float4 va[4], vb[4];
#pragma unroll
        for (int j = 0; j < 4; ++j) { va[j] = xr[lane + 64 * j]; vb[j] = xr2[lane + 64 * j]; }
        float s = 0.f, s2 = 0.f;
#pragma unroll
        for (int j = 0; j < 4; ++j) { s += va[j].x * va[j].x + va[j].y * va[j].y + va[j].z * va[j].z + va[j].w * va[j].w; s2 += vb[j].x * vb[j].x + vb[j].y * vb[j].y + vb[j].z * vb[j].z + vb[j].w * vb[j].w;
            uint2 o; o.x = pg8::cvt_pk_bf16(va[j].x, va[j].y); o.y = pg8::cvt_pk_bf16(va[j].z, va[j].w); ((uint2*)(xb + (size_t)row * D))[lane + 64 * j] = o;
            if (has2) { uint2 o2; o2.x = pg8::cvt_pk_bf16(vb[j].x, vb[j].y); o2.y = pg8::cvt_pk_bf16(vb[j].z, vb[j].w); ((uint2*)(xb + (size_t)row2 * D))[lane + 64 * j] = o2; } }
#pragma unroll
        for (int o = 1; o < 64; o <<= 1) { s += pg8::shx(s, lane, o); s2 += pg8::shx(s2, lane, o); }
        if (lane < 4) { float4 r; r.x = lane == 0 ? s : 0.f; r.y = 0.f; r.z = 0.f; r.w = 0.f; ((float4*)ssp)[row * 4 + lane] = r;
            if (has2) { r.x = lane == 0 ? s2 : 0.f; ((float4*)ssp)[row2 * 4 + lane] = r; } }
    }
}
__device__ __forceinline__ void convert_p(const float* p, bf16_t* pb, int gtid, int nthreads) {
    for (int i = gtid; i < M * PLE / 8; i += nthreads) { const float4 v0 = ((const float4*)p)[2 * i], v1 = ((const float4*)p)[2 * i + 1];
        v4u o; o.x = pg8::cvt_pk_bf16(v0.x, v0.y); o.y = pg8::cvt_pk_bf16(v0.z, v0.w); o.z = pg8::cvt_pk_bf16(v1.x, v1.y); o.w = pg8::cvt_pk_bf16(v1.z, v1.w); ((v4u*)pb)[i] = o; }
}

__device__ __forceinline__ void attn_simple_phase(LAS unsigned char* lds, const AttnIn& a, int G, int wave, int lane) {
    LAS float* pl = (LAS float*)(lds + wave * 4096); LAS int* kl = (LAS int*)(lds + wave * 4096 + 2048);
    const int total = NB * 16 * S;
    for (int item = blockIdx.x * NWAVES + wave; item < total; item += G * NWAVES) {
        const int t = item & (S - 1), head = (item >> 12) & 15, b = item >> 16;
        const bool isA = head < 8;
        const bf16_t *q, *k, *v;
        if (isA) { q = a.qa + (((size_t)b * 8 + head) * S + t) * HD; k = a.ka + ((size_t)b * 8 + head) * S * HD; v = a.va + ((size_t)b * 8 + head) * S * HD; }
        else { const int hq = head - 8, hk = hq >> 2; q = a.qb + (((size_t)b * 8 + hq) * S + t) * HD; k = a.kb + ((size_t)b * 2 + hk) * S * HD; v = a.vb + ((size_t)b * 2 + hk) * S * HD; }
        float qf[HD];
#pragma unroll
        for (int e = 0; e < HD; ++e) qf[e] = bf2f(q[e]);
        const int nk = isA ? 387 : 257;
        float mx = -1e30f;
        for (int i = lane; i < nk; i += 64) {
            int rel;
            if (isA) { const int br = i / 129, j = i % 129 - 64; rel = j * (br == 0 ? 1 : br == 1 ? 4 : 16); } else rel = i - 128;
            const int tk = t + rel; float lg = -1e30f;
            if (tk >= 0 && tk < S) { float d = 0.f; const bf16_t* kr = k + (size_t)tk * HD;
#pragma unroll
                for (int e = 0; e < HD; ++e) d += qf[e] * bf2f(kr[e]);
                lg = d + a.rel_bias[t5_bucket(rel) * 16 + head] * LOG2E; }
            pl[i] = lg; kl[i] = tk; mx = fmaxf(mx, lg);
        }
#pragma unroll
        for (int o = 1; o < 64; o <<= 1) mx = fmaxf(mx, pg8::shx(mx, lane, o));
        float sinkl = 0.f;
        if (!isA) { sinkl = a.sink[head - 8] * LOG2E; mx = fmaxf(mx, sinkl); }
        float sum = 0.f;
        for (int i = lane; i < nk; i += 64) { const float lg = pl[i]; const float pv = lg > -1e29f ? exp2f(lg - mx) : 0.f; pl[i] = pv; sum += pv; }
#pragma unroll
        for (int o = 1; o < 64; o <<= 1) sum += pg8::shx(sum, lane, o);
        if (!isA) sum += exp2f(sinkl - mx);
        asm volatile("s_waitcnt lgkmcnt(0)" ::: "memory");
        float acc = 0.f;
        for (int i = 0; i < nk; ++i) { const float pv = pl[i]; if (pv != 0.f) acc += pv * bf2f(v[(size_t)kl[i] * HD + lane]); }
        a.o[((size_t)b * S + t) * D + head * HD + lane] = f2bf(acc / sum);
    }
}

namespace att {
typedef short bf16x8 __attribute__((ext_vector_type(8)));
typedef short s16x4 __attribute__((ext_vector_type(4)));
typedef short v4i16_t __attribute__((ext_vector_type(4)));
typedef float f32x16 __attribute__((ext_vector_type(16)));
typedef unsigned u32x4 __attribute__((ext_vector_type(4)));
typedef float f32x2_t __attribute__((ext_vector_type(2))); typedef __bf16 bf16x2_t __attribute__((ext_vector_type(2)));
constexpr float NEG = -1e30f;
constexpr int WAVE_LDS = 8704, LUT_OFF = 0, WAVES_OFF = 8192, LUTA_STRIDE = 200, LUTB_STRIDE = 328, LUTB_OFF = LUT_OFF + 3 * LUTA_STRIDE * 4, TAB_OFF = WAVES_OFF + 8 * WAVE_LDS, LSE_OFF = TAB_OFF + 65536, ATT_LDS_END = LSE_OFF + 2048;
static_assert(LUTB_OFF + 4 * LUTB_STRIDE * 4 <= WAVES_OFF && ATT_LDS_END <= 147456 - 64, "attention LDS map");
__device__ __forceinline__ int crow(int r, int hi) { return (r & 3) + 8 * (r >> 2) + 4 * hi; }
__device__ __forceinline__ unsigned cvtpk(float lo, float hi) { f32x2_t v = {lo, hi}; bf16x2_t b = __builtin_convertvector(v, bf16x2_t); return __builtin_bit_cast(unsigned, b); }
__device__ __forceinline__ s16x4 vtr(const LAS unsigned char* p) { return __builtin_bit_cast(s16x4, __builtin_amdgcn_ds_read_tr16_b64_v4i16((LAS v4i16_t*)p)); }
__device__ __forceinline__ float halfmax(float v) { auto rr = __builtin_amdgcn_permlane32_swap(__float_as_uint(v), __float_as_uint(v), false, false); return fmaxf(__uint_as_float(rr[0]), __uint_as_float(rr[1])); }
__device__ __forceinline__ float halfsum(float v) { auto rr = __builtin_amdgcn_permlane32_swap(__float_as_uint(v), __float_as_uint(v), false, false); return __uint_as_float(rr[0]) + __uint_as_float(rr[1]); }

__device__ __forceinline__ void bias_add(f32x16& p, const LAS float* lut, const int j, const int i, const int hi) {
    const LAS float* lp = lut + 32 * j - i + 4 * hi;
#pragma unroll
    for (int r = 0; r < 16; ++r) p[r] += lp[(r & 3) + 8 * (r >> 2)];
}
template <int NT>
__device__ __forceinline__ void qtile(const bf16_t* qrow, const bf16_t* kbase, const bf16_t* vbase, int tk0, int dstep, const LAS float* lut, float m0, float l0,
                                      LAS unsigned char* wl, int lane_in, f32x16 (&o)[2], float& m_out, float& l_out) {
    int lane = lane_in; asm volatile("" : "+v"(lane));
    const int i = lane & 31, hi = lane >> 5;
    LAS float* wsf = (LAS float*)(wl + 8192);
    constexpr int C = NT / 2;
    bf16x8 qf[4];
#pragma unroll
    for (int ks = 0; ks < 4; ++ks) qf[ks] = *(const bf16x8*)(qrow + 16 * ks + 8 * hi);
    const int vrow = lane >> 3, vsw = (lane & 7) ^ (((lane >> 4) & 1) << 2);
    const int rd_base = (4 * hi + ((lane & 15) >> 2)) * 128 + 32 * ((lane >> 4) & 1) + 8 * (lane & 3);
    const int bit3 = (lane >> 3) & 1;
    const int vb0 = rd_base + 64 * bit3, vb1 = rd_base + 64 * (1 - bit3);
    bf16x8 kf[4];
#define ATT_LOAD(j, buf) do { \
        { int tk = tk0 + (32 * (j) + i) * dstep; tk = tk < 0 ? 0 : (tk > S - 1 ? S - 1 : tk); const bf16_t* kp = kbase + (size_t)tk * HD + 8 * hi; \
          _Pragma("unroll") for (int ks = 0; ks < 4; ++ks) kf[ks] = *(const bf16x8*)(kp + 16 * ks); } \
        _Pragma("unroll") for (int i4 = 0; i4 < 4; ++i4) { int tk = tk0 + (32 * (j) + vrow + 8 * i4) * dstep; tk = tk < 0 ? 0 : (tk > S - 1 ? S - 1 : tk); \
          __builtin_amdgcn_global_load_lds((const unsigned*)(vbase + (size_t)tk * HD + 8 * vsw), (LAS unsigned*)(wl + (buf) * 4096 + i4 * 1024), 16, 0, 0); } } while (0)
    float m = m0, l = hi == 0 ? l0 : 0.f;
    o[0] = f32x16{}; o[1] = f32x16{};
    ATT_LOAD(C, 0);
#pragma unroll 1
    for (int s = 0; s < NT; ++s) {
        const int j = (s == 0) ? C : (s <= C ? s - 1 : s);
        LAS unsigned char* vbuf = wl + (s & 1) * 4096;
        asm volatile("s_waitcnt vmcnt(0)" ::: "memory");
        f32x16 p = __builtin_amdgcn_mfma_f32_32x32x16_bf16(kf[0], qf[0], f32x16{}, 0, 0, 0);
        p = __builtin_amdgcn_mfma_f32_32x32x16_bf16(kf[1], qf[1], p, 0, 0, 0);
        p = __builtin_amdgcn_mfma_f32_32x32x16_bf16(kf[2], qf[2], p, 0, 0, 0);
        p = __builtin_amdgcn_mfma_f32_32x32x16_bf16(kf[3], qf[3], p, 0, 0, 0);
        bias_add(p, lut, j, i, hi);
        if (s + 1 < NT) { const int jn = (s + 1 <= C) ? s : s + 1; ATT_LOAD(jn, (s + 1) & 1); }
        const int first = tk0 + 32 * j * dstep, lastk = first + 31 * dstep;
        const bool inside = first >= 0 && lastk < S;
        if (!inside) {
#pragma unroll
            for (int r = 0; r < 16; ++r) { const int tk = first + crow(r, hi) * dstep; if ((unsigned)tk >= (unsigned)S) p[r] = NEG; }
        }
        float rm = p[0];
#pragma unroll
        for (int r = 1; r < 16; ++r) rm = fmaxf(rm, p[r]);
        rm = halfmax(rm);
        if (__any(rm > m)) {
            const float mn = fmaxf(m, rm), alpha = __builtin_amdgcn_exp2f(m - mn);
            l *= alpha; m = mn;
            if (hi == 0) wsf[i] = alpha;
#pragma unroll
            for (int r = 0; r < 16; ++r) { const float a = wsf[crow(r, hi)]; o[0][r] *= a; o[1][r] *= a; }
        }
        f32x2_t rs2 = {0.f, 0.f}; const f32x2_t nm2 = {-m, -m};
#pragma unroll
        for (int r = 0; r < 16; r += 2) { f32x2_t t = (f32x2_t){p[r], p[r + 1]} + nm2; t.x = __builtin_amdgcn_exp2f(t.x); t.y = __builtin_amdgcn_exp2f(t.y); p[r] = t.x; p[r + 1] = t.y; rs2 += t; }
        l += rs2.x + rs2.y;
        u32x4 pw0 = {cvtpk(p[0], p[1]), cvtpk(p[2], p[3]), cvtpk(p[4], p[5]), cvtpk(p[6], p[7])};
        u32x4 pw1 = {cvtpk(p[8], p[9]), cvtpk(p[10], p[11]), cvtpk(p[12], p[13]), cvtpk(p[14], p[15])};
        const bf16x8 pa0 = __builtin_bit_cast(bf16x8, pw0), pa1 = __builtin_bit_cast(bf16x8, pw1);
#pragma unroll
        for (int d0 = 0; d0 < 2; ++d0) {
            const unsigned vp = (unsigned)(uintptr_t)(vbuf + (d0 == 0 ? vb0 : vb1));
            s16x4 a0, a1, b0, b1;
            asm volatile("ds_read_b64_tr_b16 %0, %1" : "=&v"(a0) : "v"(vp) : "memory");
            asm volatile("ds_read_b64_tr_b16 %0, %1 offset:1024" : "=&v"(a1) : "v"(vp) : "memory");
            asm volatile("ds_read_b64_tr_b16 %0, %1 offset:2048" : "=&v"(b0) : "v"(vp) : "memory");
            asm volatile("ds_read_b64_tr_b16 %0, %1 offset:3072" : "=&v"(b1) : "v"(vp) : "memory");
            asm volatile("s_waitcnt lgkmcnt(0)" : "+v"(a0), "+v"(a1), "+v"(b0), "+v"(b1) :: "memory"); __builtin_amdgcn_sched_barrier(0);
            const bf16x8 f0 = {a0[0], a0[1], a0[2], a0[3], a1[0], a1[1], a1[2], a1[3]}, f1 = {b0[0], b0[1], b0[2], b0[3], b1[0], b1[1], b1[2], b1[3]};
            o[d0] = __builtin_amdgcn_mfma_f32_32x32x16_bf16(pa0, f0, o[d0], 0, 0, 0);
            o[d0] = __builtin_amdgcn_mfma_f32_32x32x16_bf16(pa1, f1, o[d0], 0, 0, 0);
        }
    }
#undef ATT_LOAD
    m_out = m; l_out = halfsum(l);
}

constexpr float MLOW = -1.0e4f;
constexpr float THR = 8.0f;
template <int NT>
__device__ __forceinline__ void sm_tile(f32x16& p, const LAS float* lut, const int j, const int i, const int hi, const int first, const int dstep, const bool inside,
                                        float& m, float& l, f32x16 (&o)[2], LAS float* wsf, bf16x8& pa0, bf16x8& pa1) {
    if (!inside) {
#pragma unroll
        for (int r = 0; r < 16; ++r) { const int tk = first + crow(r, hi) * dstep; if ((unsigned)tk >= (unsigned)S) p[r] = NEG; }
    }
    float rm = fmaxf(p[0], p[1]);
#pragma unroll
    for (int r = 2; r < 16; ++r) rm = fmaxf(rm, p[r]);
    rm = halfmax(rm);
    if (__any(rm > m + THR)) {
        const float mn = fmaxf(m, rm), alpha = __builtin_amdgcn_exp2f(m - mn);
        l *= alpha; m = mn;
        if (hi == 0) wsf[i] = alpha;
#pragma unroll
        for (int r = 0; r < 16; ++r) { const float a = wsf[crow(r, hi)]; o[0][r] *= a; o[1][r] *= a; }
    }
    f32x2_t rs2 = {0.f, 0.f}; const f32x2_t nm2 = {-m, -m};
#pragma unroll
    for (int r = 0; r < 16; r += 2) { f32x2_t t = (f32x2_t){p[r], p[r + 1]} + nm2; t.x = __builtin_amdgcn_exp2f(t.x); t.y = __builtin_amdgcn_exp2f(t.y); p[r] = t.x; p[r + 1] = t.y; rs2 += t; }
    l += rs2.x + rs2.y;
    u32x4 pw0 = {cvtpk(p[0], p[1]), cvtpk(p[2], p[3]), cvtpk(p[4], p[5]), cvtpk(p[6], p[7])};
    u32x4 pw1 = {cvtpk(p[8], p[9]), cvtpk(p[10], p[11]), cvtpk(p[12], p[13]), cvtpk(p[14], p[15])};
    pa0 = __builtin_bit_cast(bf16x8, pw0); pa1 = __builtin_bit_cast(bf16x8, pw1);
}
template <int NT, int SHIFT>
__device__ __forceinline__ void qtile2(const bf16_t* qrow0, const bf16_t* qrow1, const bf16_t* kbase, const bf16_t* vbase, int tk0, int dstep, const LAS float* lut0, const LAS float* lut1,
                                       float mi0, float li0, float mi1, float li1, LAS unsigned char* wl, int lane_in,
                                       f32x16 (&o0)[2], float& m0_out, float& l0_out, f32x16 (&o1)[2], float& m1_out, float& l1_out) {
    int lane = lane_in; asm volatile("" : "+v"(lane));
    const int i = lane & 31, hi = lane >> 5;
    LAS float* wsf = (LAS float*)(wl + 8192);
    bf16x8 qf0[4], qf1[4];
#pragma unroll
    for (int ks = 0; ks < 4; ++ks) { qf0[ks] = *(const bf16x8*)(qrow0 + 16 * ks + 8 * hi); qf1[ks] = *(const bf16x8*)(qrow1 + 16 * ks + 8 * hi); }
    const int vrow = lane >> 3, vsw = (lane & 7) ^ (((lane >> 4) & 1) << 2);
    const int rd_base = (4 * hi + ((lane & 15) >> 2)) * 128 + 32 * ((lane >> 4) & 1) + 8 * (lane & 3);
    const int bit3 = (lane >> 3) & 1;
    const int vb0 = rd_base + 64 * bit3, vb1 = rd_base + 64 * (1 - bit3);
    bf16x8 kf[4];
#define ATT_LOAD(j, buf) do { \
        { int tk = tk0 + (32 * (j) + i) * dstep; tk = tk < 0 ? 0 : (tk > S - 1 ? S - 1 : tk); const bf16_t* kp = kbase + (size_t)tk * HD + 8 * hi; \
          _Pragma("unroll") for (int ks = 0; ks < 4; ++ks) kf[ks] = *(const bf16x8*)(kp + 16 * ks); } \
        _Pragma("unroll") for (int i4 = 0; i4 < 4; ++i4) { int tk = tk0 + (32 * (j) + vrow + 8 * i4) * dstep; tk = tk < 0 ? 0 : (tk > S - 1 ? S - 1 : tk); \
          __builtin_amdgcn_global_load_lds((const unsigned*)(vbase + (size_t)tk * HD + 8 * vsw), (LAS unsigned*)(wl + (buf) * 4096 + i4 * 1024), 16, 0, 0); } } while (0)
    float m0 = mi0, l0 = hi == 0 ? li0 : 0.f, m1 = mi1, l1 = hi == 0 ? li1 : 0.f;
    o0[0] = f32x16{}; o0[1] = f32x16{}; o1[0] = f32x16{}; o1[1] = f32x16{};
    ATT_LOAD(0, 0);
#pragma unroll 1
    for (int jj = 0; jj < NT + SHIFT; ++jj) {
        LAS unsigned char* vbuf = wl + (jj & 1) * 4096;
        const bool a0 = jj < NT, a1 = jj >= SHIFT;
        const int first = tk0 + 32 * jj * dstep, lastk = first + 31 * dstep;
        const bool inside = first >= 0 && lastk < S;
        asm volatile("s_waitcnt vmcnt(0)" ::: "memory");
        f32x16 p0, p1;
        bf16x8 pa00, pa01, pa10, pa11;
        {
            if (a0) {
                p0 = __builtin_amdgcn_mfma_f32_32x32x16_bf16(kf[0], qf0[0], f32x16{}, 0, 0, 0);
#pragma unroll
                for (int ks = 1; ks < 4; ++ks) p0 = __builtin_amdgcn_mfma_f32_32x32x16_bf16(kf[ks], qf0[ks], p0, 0, 0, 0);
            }
            if (a1) {
                p1 = __builtin_amdgcn_mfma_f32_32x32x16_bf16(kf[0], qf1[0], f32x16{}, 0, 0, 0);
#pragma unroll
                for (int ks = 1; ks < 4; ++ks) p1 = __builtin_amdgcn_mfma_f32_32x32x16_bf16(kf[ks], qf1[ks], p1, 0, 0, 0);
            }
        }
        if (a0) bias_add(p0, lut0, jj, i, hi);
        if (a1) bias_add(p1, lut1, jj - SHIFT, i, hi);
        if (jj + 1 < NT + SHIFT) ATT_LOAD(jj + 1, (jj + 1) & 1);
        {
            if (a0) sm_tile<NT>(p0, lut0, jj, i, hi, first, dstep, inside, m0, l0, o0, wsf, pa00, pa01);
            if (a1) sm_tile<NT>(p1, lut1, jj - SHIFT, i, hi, first, dstep, inside, m1, l1, o1, wsf, pa10, pa11);
#pragma unroll
            for (int d0 = 0; d0 < 2; ++d0) {
                const unsigned vp = (unsigned)(uintptr_t)(vbuf + (d0 == 0 ? vb0 : vb1));
                s16x4 x0, x1, y0, y1;
                asm volatile("ds_read_b64_tr_b16 %0, %1" : "=&v"(x0) : "v"(vp) : "memory");
                asm volatile("ds_read_b64_tr_b16 %0, %1 offset:1024" : "=&v"(x1) : "v"(vp) : "memory");
                asm volatile("ds_read_b64_tr_b16 %0, %1 offset:2048" : "=&v"(y0) : "v"(vp) : "memory");
                asm volatile("ds_read_b64_tr_b16 %0, %1 offset:3072" : "=&v"(y1) : "v"(vp) : "memory");
                asm volatile("s_waitcnt lgkmcnt(0)" : "+v"(x0), "+v"(x1), "+v"(y0), "+v"(y1) :: "memory"); __builtin_amdgcn_sched_barrier(0);
                const bf16x8 f0 = {x0[0], x0[1], x0[2], x0[3], x1[0], x1[1], x1[2], x1[3]}, f1 = {y0[0], y0[1], y0[2], y0[3], y1[0], y1[1], y1[2], y1[3]};
                if (a0) { o0[d0] = __builtin_amdgcn_mfma_f32_32x32x16_bf16(pa00, f0, o0[d0], 0, 0, 0); o0[d0] = __builtin_amdgcn_mfma_f32_32x32x16_bf16(pa01, f1, o0[d0], 0, 0, 0); }
                if (a1) { o1[d0] = __builtin_amdgcn_mfma_f32_32x32x16_bf16(pa10, f0, o1[d0], 0, 0, 0); o1[d0] = __builtin_amdgcn_mfma_f32_32x32x16_bf16(pa11, f1, o1[d0], 0, 0, 0); }
            }
        }
    }
#undef ATT_LOAD
    m0_out = m0; l0_out = halfsum(l0); m1_out = m1; l1_out = halfsum(l1);
}

__device__ __forceinline__ void stage_o(const f32x16 (&o)[2], float m, float l, LAS unsigned char* wl, int lane_in) {
    int lane = lane_in; asm volatile("" : "+v"(lane));
    const int i = lane & 31, hi = lane >> 5;
    LAS float* wsf = (LAS float*)(wl + 8192);
    if (hi == 0) { wsf[i] = __builtin_amdgcn_rcpf(l); wsf[32 + i] = m + __builtin_amdgcn_logf(l); }
    LAS bf16_t* stg = (LAS bf16_t*)wl;
#pragma unroll
    for (int r = 0; r < 16; ++r) { const int q = crow(r, hi); const float inv = wsf[q];
        stg[q * 64 + i] = (bf16_t)(cvtpk(o[0][r] * inv, 0.f) & 0xffffu); stg[q * 64 + 32 + i] = (bf16_t)(cvtpk(o[1][r] * inv, 0.f) & 0xffffu); }
}
__device__ __forceinline__ float bflo(unsigned w) { return __uint_as_float(w << 16); }
__device__ __forceinline__ float bfhi(unsigned w) { return __uint_as_float(w & 0xffff0000u); }
__device__ __forceinline__ unsigned mix2(unsigned a, unsigned b, float wa, float wb) { return cvtpk(wa * bflo(a) + wb * bflo(b), wa * bfhi(a) + wb * bfhi(b)); }

struct Tensors { const bf16_t *qa, *ka, *va, *qb, *kb, *vb; const float* rel_bias; const float* sink; bf16_t* o; };
__device__ __forceinline__ void finish_a(const f32x16 (&o)[2], float m, float l, int pass, int d, int lam0, int rr, LAS unsigned char* wl, LAS unsigned char* tab, LAS float* lsetab, bf16_t* orow0, int lane_in) {
    LAS float* wsf = (LAS float*)(wl + 8192);
    stage_o(o, m, l, wl, lane_in);
    int lane = lane_in; asm volatile("" : "+v"(lane));
#pragma unroll
    for (int i4 = 0; i4 < 4; ++i4) {
        const int qi = (lane >> 3) + 8 * i4, ch = lane & 7, tau = d * (lam0 + qi) + rr;
        u32x4 v = *(const LAS u32x4*)(wl + qi * 128 + ch * 16);
        const float Lb = wsf[32 + qi];
        LAS u32x4* te = (LAS u32x4*)(tab + tau * 128 + ch * 16);
        if (pass == 0) { *te = v; if (ch == 0) lsetab[tau] = Lb; }
        else {
            const u32x4 tv = *te; const float La = lsetab[tau];
            const float Lm = fmaxf(La, Lb), sa = __builtin_amdgcn_exp2f(La - Lm), sb = __builtin_amdgcn_exp2f(Lb - Lm), tot = sa + sb, rt = __builtin_amdgcn_rcpf(tot), wa = sa * rt, wb = sb * rt;
            u32x4 w; w.x = mix2(tv.x, v.x, wa, wb); w.y = mix2(tv.y, v.y, wa, wb); w.z = mix2(tv.z, v.z, wa, wb); w.w = mix2(tv.w, v.w, wa, wb);
            if (pass == 1) { *te = w; if (ch == 0) lsetab[tau] = Lm + __builtin_amdgcn_logf(tot); }
            else *(u32x4*)(orow0 + (size_t)tau * D + ch * 8) = w;
        }
    }
}


__device__ __forceinline__ int bucket(int rel) {
    const int n = rel < 0 ? -rel : rel; const int ret = rel > 0 ? 16 : 0;
    if (n < 8) return ret + n;
    int large = 8 + (int)(logf((float)n / 8.0f) / 4.852030263919617f * 8.0f);
    large = large < 15 ? large : 15;
    return ret + large;
}

__device__ __forceinline__ void attn_unit(const Tensors& T, int u, LAS unsigned char* lds, int wave, int lane) {
    LAS unsigned char* wl = lds + WAVES_OFF + wave * WAVE_LDS;
    LAS float* wsf = (LAS float*)(wl + 8192);
    LAS float* lutA = (LAS float*)(lds + LUT_OFF); LAS float* lutB = (LAS float*)(lds + LUTB_OFF);
    LAS unsigned char* tab = lds + TAB_OFF; LAS float* lsetab = (LAS float*)(lds + LSE_OFF);
    const int tid = wave * 64 + lane;
    const int i = lane & 31;
    {
        const int bh = u >> 3, blk = u & 7, b = bh >> 3, h = bh & 7, t0 = blk * 512;
        const bf16_t* qbase = T.qa + (size_t)bh * S * HD; const bf16_t* kbase = T.ka + (size_t)bh * S * HD; const bf16_t* vbase = T.va + (size_t)bh * S * HD;
        __syncthreads();
        for (int e = tid; e < 3 * 193; e += 512) { const int c = e / 193, idx = e % 193 - 32, d = c == 0 ? 1 : (c == 1 ? 4 : 16);
            lutA[c * LUTA_STRIDE + 32 + idx] = (idx < 0 || idx > 128) ? NEG : T.rel_bias[bucket((idx - 64) * d) * 16 + h] * LOG2E; }
        __syncthreads();
        bf16_t* orow0 = T.o + ((size_t)b * S + t0) * D + h * HD;
#pragma unroll 1
        for (int pass = 0; pass < 3; ++pass) {
            const int c = 2 - pass, d = c == 0 ? 1 : (c == 1 ? 4 : 16);
            const LAS float* lt = lutA + c * LUTA_STRIDE + 32;
            if (c == 2) {
#pragma unroll 1
                for (int tt = 0; tt < 2; ++tt) { const int rr = 2 * wave + tt;
                    f32x16 o1[2]; float m1, l1;
                    qtile<5>(qbase + (size_t)(t0 + d * i + rr) * HD, kbase, vbase, t0 - 64 * d + rr, d, lt, NEG, 0.f, wl, lane, o1, m1, l1);
                    finish_a(o1, m1, l1, pass, d, 0, rr, wl, tab, lsetab, orow0, lane); }
            } else {
                const int Tq = 2 * wave, rr = c == 1 ? (Tq >> 2) : 0, lamA = 32 * (c == 1 ? (Tq & 3) : Tq);
                f32x16 oA[2], oB[2]; float mA, lA, mB, lB;
                qtile2<5, 1>(qbase + (size_t)(t0 + d * (lamA + i) + rr) * HD, qbase + (size_t)(t0 + d * (lamA + 32 + i) + rr) * HD, kbase, vbase, t0 + d * (lamA - 64) + rr, d, lt, lt,
                             MLOW, 0.f, MLOW, 0.f, wl, lane, oA, mA, lA, oB, mB, lB);
                finish_a(oA, mA, lA, pass, d, lamA, rr, wl, tab, lsetab, orow0, lane);
                finish_a(oB, mB, lB, pass, d, lamA + 32, rr, wl, tab, lsetab, orow0, lane);
            }
            __syncthreads();
        }
    }
    {
        const int bk = u >> 5, blk = u & 31, b = bk >> 1, hk = bk & 1, t0 = blk * 128;
        const bf16_t* kbase = T.kb + (size_t)bk * S * HD; const bf16_t* vbase = T.vb + (size_t)bk * S * HD;
        for (int e = tid; e < 4 * 321; e += 512) { const int g = e / 321, idx = e % 321 - 32;
            lutB[g * LUTB_STRIDE + 32 + idx] = (idx < 0 || idx > 256) ? NEG : T.rel_bias[bucket(idx - 128) * 16 + 8 + 4 * hk + g] * LOG2E; }
        __syncthreads();
        const int qt = wave & 3, g0 = 2 * (wave >> 2), hq0 = 4 * hk + g0;
        const int tq = t0 + 32 * qt + i, tk0 = t0 + 32 * qt - 128;
        f32x16 oA[2], oB[2]; float mA, lA, mB, lB;
        qtile2<9, 0>(T.qb + (((size_t)b * 8 + hq0) * S + tq) * HD, T.qb + (((size_t)b * 8 + hq0 + 1) * S + tq) * HD, kbase, vbase, tk0, 1,
                     lutB + g0 * LUTB_STRIDE + 32, lutB + (g0 + 1) * LUTB_STRIDE + 32, T.sink[hq0] * LOG2E, 1.0f, T.sink[hq0 + 1] * LOG2E, 1.0f, wl, lane, oA, mA, lA, oB, mB, lB);
        bf16_t* ob0 = T.o + ((size_t)b * S + t0 + 32 * qt) * D + (8 + hq0) * HD;
        stage_o(oA, mA, lA, wl, lane);
#pragma unroll
        for (int i4 = 0; i4 < 4; ++i4) { const int qi = (lane >> 3) + 8 * i4, ch = lane & 7; *(u32x4*)(ob0 + (size_t)qi * D + ch * 8) = *(const LAS u32x4*)(wl + qi * 128 + ch * 16); }
        stage_o(oB, mB, lB, wl, lane);
#pragma unroll
        for (int i4 = 0; i4 < 4; ++i4) { const int qi = (lane >> 3) + 8 * i4, ch = lane & 7; *(u32x4*)(ob0 + HD + (size_t)qi * D + ch * 8) = *(const LAS u32x4*)(wl + qi * 128 + ch * 16); }
    }
}
}

#define XB_TMO      128
#define XB_XCNT(j)  (256  + 64 * (j))
#define XB_XSUB(j)  (1280 + 64 * (j))
#define XB_XGEN(j)  (2304 + 64 * (j))
#define XB_TOP      3328
#define XB_TOPGEN   3392
#define XCD_BAR_WORDS 3456
#define XB_SPIN_CAP (1u << 18)

__device__ __forceinline__ unsigned xb_ld(unsigned* p)              { return __hip_atomic_load(p, __ATOMIC_RELAXED, __HIP_MEMORY_SCOPE_AGENT); }
__device__ __forceinline__ unsigned xb_add(unsigned* p, unsigned v) { return __hip_atomic_fetch_add(p, v, __ATOMIC_RELAXED, __HIP_MEMORY_SCOPE_AGENT); }
__device__ __forceinline__ unsigned xb_xcc_id() { return (unsigned)__builtin_amdgcn_s_getreg((3 << 11) | 20) & 0xFu; }
#define XB_SPIN(cond, bar) do { unsigned _sp = 0; while (cond) { __builtin_amdgcn_s_sleep(1); \
    if ((++_sp & 255u) == 0u) { if (xb_ld(&(bar)[XB_TMO])) break; if (_sp > XB_SPIN_CAP) { atomicAdd(&(bar)[XB_TMO], 1u); break; } } } } while (0)

struct XcdBarrier {
    unsigned* bar; unsigned x;
    volatile LAS unsigned* st;
};

__device__ __forceinline__ XcdBarrier xcd_barrier_post(unsigned* bar, volatile LAS unsigned* st) {
    XcdBarrier b; b.bar = bar; b.x = xb_xcc_id(); b.st = st;
    if (threadIdx.x == 0) (void)xb_add(&bar[XB_XCNT(b.x)], 1u);
    return b;
}
__device__ __forceinline__ void xcd_barrier_complete(unsigned* bar, unsigned x, unsigned& nloc, unsigned& nx) {
    const unsigned G = gridDim.x * gridDim.y * gridDim.z;
    unsigned sum, cnt, mine, sp = 0u;
    for (;;) {
        sum = 0u; cnt = 0u; mine = 0u;
#pragma unroll
        for (unsigned j = 0; j < 16; ++j) { const unsigned c = xb_ld(&bar[XB_XCNT(j)]); sum += c; cnt += (c > 0u) ? 1u : 0u; mine = (j == x) ? c : mine; }
        if (sum == G) break;
        __builtin_amdgcn_s_sleep(1);
        if ((++sp & 255u) == 0u) { if (xb_ld(&bar[XB_TMO])) break; if (sp > XB_SPIN_CAP) { atomicAdd(&bar[XB_TMO], 1u); break; } }
    }
    nloc = mine > 0u ? mine : 1u; nx = cnt > 0u ? cnt : 1u;
}

__device__ __forceinline__ void xcd_barrier(const XcdBarrier& b, const bool is_t0) {
    asm volatile("s_waitcnt vmcnt(0)" ::: "memory");
    __syncthreads();
    if (is_t0) {
        unsigned* bar = b.bar;
        __builtin_amdgcn_s_waitcnt(0);
        unsigned nloc = b.st[0], nx = b.st[1];
        if (nloc == 0u) { xcd_barrier_complete(bar, b.x, nloc, nx); b.st[0] = nloc; b.st[1] = nx; }
        const unsigned old = xb_add(&bar[XB_XSUB(b.x)], 1u);
        const unsigned gen = old / nloc;
        if (old + 1u == (gen + 1u) * nloc) {
            __builtin_amdgcn_fence(__ATOMIC_RELEASE, "agent");
            asm volatile("s_waitcnt vmcnt(0)" ::: "memory");
            const unsigned og = xb_add(&bar[XB_TOP], 1u);
            const unsigned tg = og / nx;
            if (og + 1u == (tg + 1u) * nx) xb_add(&bar[XB_TOPGEN], 1u);
            else XB_SPIN(xb_ld(&bar[XB_TOPGEN]) == tg, bar);
            __builtin_amdgcn_fence(__ATOMIC_ACQUIRE, "agent");
            xb_add(&bar[XB_XGEN(b.x)], 1u);
            asm volatile("s_waitcnt vmcnt(0)" ::: "memory");
        } else {
            XB_SPIN(xb_ld(&bar[XB_XGEN(b.x)]) == gen, bar);
            __builtin_amdgcn_fence(__ATOMIC_ACQUIRE, "agent");
            asm volatile("s_waitcnt vmcnt(0)" ::: "memory");
        }
    }
    __syncthreads();
}
typedef const float* cfptr_t; typedef float* fptr_t; typedef unsigned char* ucptr_t;
typedef __attribute__((address_space(4))) const unsigned char* kargp_t;
struct KA {
    kargp_t kp;
    __device__ __forceinline__ const float* in(int i) const { return *(__attribute__((address_space(4))) const cfptr_t*)(kp + 8 * i); }
    __device__ __forceinline__ float* out() const { return *(__attribute__((address_space(4))) const fptr_t*)(kp + 160); }
    __device__ __forceinline__ unsigned char* ws() const { return *(__attribute__((address_space(4))) const ucptr_t*)(kp + 168); }
    __device__ __forceinline__ int ph_lo() const { return *(__attribute__((address_space(4))) const int*)(kp + 176); }
    __device__ __forceinline__ int ph_hi() const { return *(__attribute__((address_space(4))) const int*)(kp + 180); }
};
static_assert(sizeof(Args) == 184, "Args layout");
#define FRESH_LANE() ({ int l_; asm volatile("v_mbcnt_lo_u32_b32 %0, -1, 0\n\tv_mbcnt_hi_u32_b32 %0, -1, %0" : "=v"(l_)); l_; })
template <int PH>
__device__ __forceinline__ void run_phase(const KA& a, LAS unsigned char* lds, const int wave0, const int rep) {
    const int G = gridDim.x, bx = blockIdx.x, wave = wave0;
    const int vcu = (G % 8 == 0) ? (bx % 8) * (G / 8) + bx / 8 : bx;
    const int gw = vcu * NWAVES + wave, NGW = G * NWAVES;
    unsigned char* ws = a.ws();
    bf16_t* xb = (bf16_t*)(ws + WS_XB); float* ssp0 = (float*)(ws + WS_SSP); float* ssp1 = ssp0 + (size_t)M * 16;
    bf16_t* xb2 = (bf16_t*)(ws + WS_W);
    bf16_t* act = (bf16_t*)(ws + WS_R + R_ACT); bf16_t* ob = (bf16_t*)(ws + WS_R + R_O);
    bf16_t* pb = (bf16_t*)(ws + WS_PB); bf16_t* proj = (bf16_t*)(ws + WS_PROJ);
    const float cscale = rep == 0 ? 1.0f : 0.0f;
    if constexpr (PH == 0) {
        prologue_phase(a, lds, gw, NGW, wave, FRESH_LANE(), G == 256);
        convert_p(a.in(1), pb, bx * NWAVES * 64 + wave0 * 64 + FRESH_LANE(), G * NWAVES * 64);
    } else {
        constexpr int l = (PH - 1) >> 3, k = (PH - 1) & 7;
        const bf16_t* wl = (const bf16_t*)(ws + WS_W) + (size_t)l * W_LAYER;
        const float* xin = (l == 0 && k <= 1 && rep == 0) ? a.in(0) : a.out();
        if constexpr (k == 0 || k == 5) {
            pg8::Gemm g{(k == 0 && l == 1) ? xb2 : xb, wl + (k == 0 ? WO_F1IN : WO_F2IN), M, 2 * DFF, D}; pg8::StaticOrder S; S.init(M, 2 * DFF, G, bx);
#if PROBE_NULL_EPI == 1
            if (rep > 0) { pg8::EpiNull E; pg8::gemm_phase<pg8::EpiNull, pg8::StaticOrder, true, true>(lds, g, S, E, wave0 * 64 + FRESH_LANE()); } else
#endif
            { pg8::EpiSwiglu E{act, ssp0, (PROBE_NULL_EPI >= 2 && rep > 0 && rep < PROBE_N) ? PROBE_NULL_EPI - 1 : 0};
            pg8::gemm_phase<pg8::EpiSwiglu, pg8::StaticOrder, true, true>(lds, g, S, E, wave0 * 64 + FRESH_LANE()); }
            if (G == 256 && bx >= 128 && rep == 0) {
                const int widx = (bx - 128) * NWAVES + wave, nw = 128 * NWAVES, lane = FRESH_LANE();
                if constexpr (k == 0) { convert_weight_items(a, lds, l * I_LAYER + IT_FOUT1, IT_FIN2 - IT_FOUT1, widx, nw, wave, lane); convert_weight_items(a, lds, l * I_LAYER + IT_WP, I_WP, widx, nw, wave, lane); }
                else { convert_weight_items(a, lds, l * I_LAYER + IT_WG, I_SQ, widx, nw, wave, lane); if (l + 1 < DEPTH) convert_weight_items(a, lds, (l + 1) * I_LAYER + IT_FIN1, I_FIN, widx, nw, wave, lane); }
            }
        } else if constexpr (k == 1 || k == 6) {
            pg8::Gemm g{act, wl + (k == 1 ? WO_F1OUT : WO_F2OUT), M, D, DFF}; pg8::StaticOrder S; S.init(M, D, G, bx);
            pg8::EpiResid E{xin, a.out(), xb, ssp1, 0.5f * cscale};
            pg8::gemm_phase<pg8::EpiResid, pg8::StaticOrder, true, true>(lds, g, S, E, wave0 * 64 + FRESH_LANE());
        } else if constexpr (k == 2) {
            { pg8::Gemm g{xb, wl + WO_QKV, M, QKVW, D}; pg8::StaticOrder S; S.init(M, QKVW, G, bx);
              pg8::EpiQkv E; E.ssp = ssp1;
              E.qa = (bf16_t*)(ws + WS_R + R_QA); E.ka = (bf16_t*)(ws + WS_R + R_KA); E.va = (bf16_t*)(ws + WS_R + R_VA);
              E.qb = (bf16_t*)(ws + WS_R + R_QB); E.kb = (bf16_t*)(ws + WS_R + R_KB); E.vb = (bf16_t*)(ws + WS_R + R_VB);
              E.qna = a.in(8) + l * HD; E.kna = a.in(9) + l * HD; E.qnb = a.in(10) + l * HD; E.knb = a.in(11) + l * HD;
              pg8::gemm_phase<pg8::EpiQkv, pg8::StaticOrder, true, true>(lds, g, S, E, wave0 * 64 + FRESH_LANE()); }
            { pg8::Gemm g{pb, wl + WO_WP, M, D, PLE}; pg8::StaticOrder S; S.init(M, D, G, bx);
              pg8::EpiStoreBf16 E{proj, D};
              pg8::gemm_phase<pg8::EpiStoreBf16, pg8::StaticOrder, true, true>(lds, g, S, E, wave0 * 64 + FRESH_LANE()); }
            if (G == 256 && bx >= 64 && rep == 0)
                convert_weight_items(a, lds, l * I_LAYER + IT_FIN2, IT_WG - IT_FIN2, (bx - 64) * NWAVES + wave, 192 * NWAVES, wave, FRESH_LANE());
        } else if constexpr (k == 3) {
            att::Tensors T; T.qa = (bf16_t*)(ws + WS_R + R_QA); T.ka = (bf16_t*)(ws + WS_R + R_KA); T.va = (bf16_t*)(ws + WS_R + R_VA);
            T.qb = (bf16_t*)(ws + WS_R + R_QB); T.kb = (bf16_t*)(ws + WS_R + R_KB); T.vb = (bf16_t*)(ws + WS_R + R_VB);
            T.rel_bias = a.in(2); T.sink = a.in(12) + l * 8; T.o = ob;
            const int lane = FRESH_LANE();
            for (int u = vcu; u < 256; u += G) att::attn_unit(T, u, lds, wave, lane);
        } else if constexpr (k == 4) {
            if (l + 1 < DEPTH) { convert_p(a.in(1) + (size_t)(l + 1) * M * PLE, pb, bx * NWAVES * 64 + wave0 * 64 + FRESH_LANE(), G * NWAVES * 64); asm volatile("s_waitcnt vmcnt(0)" ::: "memory"); }
            pg8::Gemm g{ob, wl + WO_WO, M, D, D}; pg8::StaticOrder S; S.init(M, D, G, bx);
            pg8::EpiResid E{xin, a.out(), xb, ssp0, 1.0f * cscale};
            pg8::gemm_phase<pg8::EpiResid, pg8::StaticOrder, true, true>(lds, g, S, E, wave0 * 64 + FRESH_LANE());
        } else {
            pg8::Gemm g{xb, wl + WO_WG, M, D, D}; pg8::StaticOrder S; S.init(M, D, G, bx);
            pg8::EpiGate E{xin, a.out(), xb2, ssp0, ssp1, proj, cscale};
            pg8::gemm_phase<pg8::EpiGate, pg8::StaticOrder, true, true>(lds, g, S, E, wave0 * 64 + FRESH_LANE());
        }
    }
}

__global__ void __launch_bounds__(NWAVES * 64, 2) mk_fwd(Args) {
    extern __shared__ __attribute__((aligned(16))) unsigned char lds_raw[];
    LAS unsigned char* lds = (LAS unsigned char*)lds_raw;
    cg::grid_group grid = cg::this_grid();
    const int wave0 = __builtin_amdgcn_readfirstlane(threadIdx.x >> 6);
    volatile LAS unsigned* bst = (volatile LAS unsigned*)((LAS unsigned char*)lds_raw + LDS_BYTES - 64);
    if (threadIdx.x < 2) bst[threadIdx.x] = 0u;
    __syncthreads();
    KA a; a.kp = (kargp_t)__builtin_amdgcn_kernarg_segment_ptr();
    const int ph_lo = a.ph_lo(), ph_hi = a.ph_hi();
    XcdBarrier xbar; xbar.bar = (unsigned*)(a.ws() + WS_CTL) + 4096; xbar.x = 0; xbar.st = bst;
    if (ph_hi - ph_lo > 1) xbar = xcd_barrier_post((unsigned*)(a.ws() + WS_CTL) + 4096, bst);
    if (ph_lo < 0) grid.sync();
#define MK_NREP(P) ((PROBE_N > 0 && (((P) == 0 && PROBE_K == 8) || ((P) > 0 && (((P) - 1) & 7) == PROBE_K))) ? 1 + PROBE_N : 1)
#define MK_PHASE(P) if (ph_lo <= (P) && (P) < ph_hi) { _Pragma("unroll 1") for (int rep = 0; rep < MK_NREP(P); ++rep) { asm volatile("" : "+s"(a.kp)); run_phase<(P)>(a, lds, wave0, rep); \
        if ((P) + 1 < ph_hi || rep + 1 < MK_NREP(P)) { if (USE_CG_SYNC && (P) == 0) grid.sync(); else xcd_barrier(xbar, wave0 == 0 && FRESH_LANE() == 0); } } }
    MK_PHASE(0) MK_PHASE(1) MK_PHASE(2) MK_PHASE(3) MK_PHASE(4) MK_PHASE(5) MK_PHASE(6) MK_PHASE(7) MK_PHASE(8)
    MK_PHASE(9) MK_PHASE(10) MK_PHASE(11) MK_PHASE(12) MK_PHASE(13) MK_PHASE(14) MK_PHASE(15) MK_PHASE(16)
    static_assert(NPHASE == 17, "phase program");
}

#ifndef FAST_MASK
#define FAST_MASK 0x1ffffu
#endif
extern "C" void kernel_launch(void* const* d_in, const int* in_sizes, int n_in, void* d_out, int out_size, void* d_ws, size_t ws_size, hipStream_t stream) {
    static int grid = 0;
    if (grid == 0) {
        if (n_in != 20 || in_sizes[0] != M * D || out_size != M * D || ws_size < WS_END) { fprintf(stderr, "kernel_launch: unexpected shapes (n_in %d, ws %zu)\n", n_in, ws_size); grid = -1; return; }
        int dev = 0, cus = 0, per_cu = 0;
        if (hipGetDevice(&dev) != hipSuccess || hipDeviceGetAttribute(&cus, hipDeviceAttributeMultiprocessorCount, dev) != hipSuccess) { grid = -1; return; }
        if (hipFuncSetAttribute((const void*)mk_fwd, hipFuncAttributeMaxDynamicSharedMemorySize, LDS_BYTES) != hipSuccess) { fprintf(stderr, "kernel_launch: hipFuncSetAttribute failed\n"); grid = -1; return; }
        if (hipOccupancyMaxActiveBlocksPerMultiprocessor(&per_cu, (const void*)mk_fwd, NWAVES * 64, LDS_BYTES) != hipSuccess || per_cu < 1) { fprintf(stderr, "kernel_launch: occupancy query says %d\n", per_cu); grid = -1; (void)hipGetLastError(); return; }
        grid = cus;
    }
    if (grid < 0) return;
    (void)hipMemsetAsync((char*)d_ws + WS_CTL, 0, 1 * MiB, stream);
    Args a{};
    for (int i = 0; i < 20; ++i) a.in[i] = (const float*)d_in[i];
    a.out = (float*)d_out; a.ws = (unsigned char*)d_ws;
    const unsigned fast = FAST_MASK;
    if (fast == 0x1ffffu) {
        a.ph_lo = 0; a.ph_hi = NPHASE;
        void* args[] = {&a};
        hipError_t e = hipLaunchCooperativeKernel((const void*)mk_fwd, dim3(grid), dim3(NWAVES * 64), args, LDS_BYTES, stream);
        if (e != hipSuccess) fprintf(stderr, "kernel_launch: cooperative launch failed: %s (grid %d)\n", hipGetErrorString(e), grid);
        return;
    }
    unsigned char* ws = (unsigned char*)d_ws; float* out = (float*)d_out;
    bf16_t* xb = (bf16_t*)(ws + WS_XB); bf16_t* xb2 = (bf16_t*)(ws + WS_W); float* ssp0 = (float*)(ws + WS_SSP); float* ssp1 = ssp0 + (size_t)M * 16;
    bf16_t* act = (bf16_t*)(ws + WS_R + R_ACT); bf16_t* ob = (bf16_t*)(ws + WS_R + R_O);
    QkvOut qo; qo.qa = (bf16_t*)(ws + WS_R + R_QA); qo.ka = (bf16_t*)(ws + WS_R + R_KA); qo.va = (bf16_t*)(ws + WS_R + R_VA);
    qo.qb = (bf16_t*)(ws + WS_R + R_QB); qo.kb = (bf16_t*)(ws + WS_R + R_KB); qo.vb = (bf16_t*)(ws + WS_R + R_VB);
    for (int ph = 0; ph < NPHASE; ++ph) {
        if ((fast >> ph) & 1u) { a.ph_lo = ph; a.ph_hi = ph + 1; hipLaunchKernelGGL(mk_fwd, dim3(grid), dim3(NWAVES * 64), LDS_BYTES, stream, a); continue; }
        if (ph == 0) { rowstat_kernel<<<M / 4, 256, 0, stream>>>(a.in[0], xb, ssp0); continue; }
        const int l = (ph - 1) >> 3, k = (ph - 1) & 7;
        const float* xin = (l == 0 && k <= 1) ? a.in[0] : out;
        bf16_t* xbl = (l == 1) ? xb2 : xb;
        switch (k) {
        case 0: naive_ffn_in<<<dim3(DFF / 128, M / 128), 256, 0, stream>>>(xbl, ssp0, a.in[3] + l * D, a.in[4] + (size_t)l * D * 2 * DFF, act); break;
        case 1: naive_resid<<<dim3(D / 128, M / 128), 256, 0, stream>>>(act, DFF, a.in[5] + (size_t)l * DFF * D, xin, out, 0.5f); rowstat_kernel<<<M / 4, 256, 0, stream>>>(out, xb, ssp1); break;
        case 2: qo.qna = a.in[8] + l * HD; qo.kna = a.in[9] + l * HD; qo.qnb = a.in[10] + l * HD; qo.knb = a.in[11] + l * HD;
                naive_qkv<<<dim3(QKVW / 128, M / 128), 256, 0, stream>>>(xb, ssp1, a.in[6] + l * D, a.in[7] + (size_t)l * D * QKVW, qo); break;
        case 3: { AttnIn ai; ai.qa = qo.qa; ai.ka = qo.ka; ai.va = qo.va; ai.qb = qo.qb; ai.kb = qo.kb; ai.vb = qo.vb; ai.rel_bias = a.in[2]; ai.sink = a.in[12] + l * 8; ai.o = ob;
                naive_attn<<<dim3(S / 4, 16, NB), 256, 0, stream>>>(ai); } break;
        case 4: naive_resid<<<dim3(D / 128, M / 128), 256, 0, stream>>>(ob, D, a.in[13] + (size_t)l * D * D, out, out, 1.0f); rowstat_kernel<<<M / 4, 256, 0, stream>>>(out, xb, ssp0); break;
        case 5: naive_ffn_in<<<dim3(DFF / 128, M / 128), 256, 0, stream>>>(xb, ssp0, a.in[14] + l * D, a.in[15] + (size_t)l * D * 2 * DFF, act); break;
        case 6: naive_resid<<<dim3(D / 128, M / 128), 256, 0, stream>>>(act, DFF, a.in[16] + (size_t)l * DFF * D, out, out, 0.5f); rowstat_kernel<<<M / 4, 256, 0, stream>>>(out, xb, ssp1); break;
        case 7: naive_ple<<<dim3(D / 128, M / 128), 256, 0, stream>>>(xb, ssp1, a.in[17] + l * D, a.in[18] + (size_t)l * D * D, a.in[1] + (size_t)l * M * PLE, a.in[19] + (size_t)l * PLE * D, out, out);
                rowstat_kernel<<<M / 4, 256, 0, stream>>>(out, xb2, ssp0); break;
        }
    }
}
```

```cpp
#include <hip/hip_runtime.h>
#include <cstdio>
#include <cstdint>
#ifndef ATT_FAST
#define ATT_FAST 1
#endif
#ifndef PROBE_N
#define PROBE_N 0
#define PROBE_K -1
#endif
#ifndef USE_CG_SYNC
#define USE_CG_SYNC 0
#endif
#ifndef PROBE_NULL_EPI
#define PROBE_NULL_EPI 0
#endif

typedef unsigned short bf16_t;
constexpr int NB = 4, S = 4096, D = 1024, M = NB * S, DFF = 2816, QKVW = 2304, PLE = 256, DEPTH = 2, HD = 64;
constexpr float EPS = 1e-6f;
constexpr float QSCALE = 0.125f * 1.4426950408889634f;
constexpr float LOG2E = 1.4426950408889634f;

constexpr size_t MiB = 1u << 20;
constexpr size_t WS_CTL = 0, WS_W = 1 * MiB, WS_XB = 85 * MiB, WS_R = 117 * MiB, WS_PB = 221 * MiB, WS_PROJ = 229 * MiB, WS_SSP = 261 * MiB, WS_END = 263 * MiB + 512 * 1024;
constexpr size_t R_QA = 0, R_KA = 16 * MiB, R_VA = 32 * MiB, R_QB = 48 * MiB, R_KB = 64 * MiB, R_VB = 68 * MiB, R_O = 72 * MiB, R_ACT = 0;

__device__ __forceinline__ float bf2f(bf16_t v) { return __uint_as_float(((unsigned)v) << 16); }
__device__ __forceinline__ bf16_t f2bf(float f) { unsigned u = __float_as_uint(f); return (bf16_t)((u + 0x7fffu + ((u >> 16) & 1u)) >> 16); }

__global__ void __launch_bounds__(256) rowstat_kernel(const float* __restrict__ x, bf16_t* __restrict__ xb, float* __restrict__ ssp) {
    const int wave = threadIdx.x >> 6, lane = threadIdx.x & 63;
    const int row = blockIdx.x * 4 + wave;
    const float4* xr = (const float4*)(x + (size_t)row * D);
    float s = 0.f;
#pragma unroll
    for (int j = 0; j < 4; ++j) {
        float4 v = xr[lane + 64 * j];
        s += v.x * v.x + v.y * v.y + v.z * v.z + v.w * v.w;
        ushort4 o; o.x = f2bf(v.x); o.y = f2bf(v.y); o.z = f2bf(v.z); o.w = f2bf(v.w);
        ((ushort4*)(xb + (size_t)row * D))[lane + 64 * j] = o;
    }
#pragma unroll
    for (int o = 1; o < 64; o <<= 1) s += __shfl_xor(s, o);
    if (lane < 4) { float4 r; r.x = lane == 0 ? s : 0.f; r.y = 0.f; r.z = 0.f; r.w = 0.f; ((float4*)ssp)[row * 4 + lane] = r; }
}

__device__ __forceinline__ float row_rstd(const float* ssp, int row) {
    float s = 0.f;
#pragma unroll
    for (int j = 0; j < 4; ++j) { const float4 v = ((const float4*)ssp)[row * 4 + j]; s += (v.x + v.y) + (v.z + v.w); }
    return rsqrtf(s * (1.0f / D) + EPS);
}

template <typename AT> __device__ __forceinline__ float ldA(const AT* p);
template <> __device__ __forceinline__ float ldA<bf16_t>(const bf16_t* p) { return bf2f(*p); }
template <> __device__ __forceinline__ float ldA<float>(const float* p) { return *p; }

template <typename AT>
__device__ __forceinline__ void accum_tile(const AT* A, int lda, int K, const float* gain, const float* W, int ldw, int row0, int wcol0, float (&acc)[8][8], float* As, float* Bs) {
    const int tid = threadIdx.x, tx = tid & 15, ty = tid >> 4;
    for (int k0 = 0; k0 < K; k0 += 8) {
        __syncthreads();
#pragma unroll
        for (int i = 0; i < 4; ++i) { const int idx = tid + i * 256, r = idx >> 3, kk = idx & 7;
            As[kk * 132 + r] = ldA<AT>(A + (size_t)(row0 + r) * lda + k0 + kk) * (gain ? gain[k0 + kk] : 1.0f); }
#pragma unroll
        for (int i = 0; i < 4; ++i) { const int idx = tid + i * 256, kk = idx >> 7, c = idx & 127;
            Bs[kk * 128 + c] = W[(size_t)(k0 + kk) * ldw + wcol0 + c]; }
        __syncthreads();
#pragma unroll
        for (int kk = 0; kk < 8; ++kk) {
            float a[8], b[8];
#pragma unroll
            for (int i = 0; i < 8; ++i) a[i] = As[kk * 132 + ty * 8 + i];
#pragma unroll
            for (int j = 0; j < 8; ++j) b[j] = Bs[kk * 128 + tx * 8 + j];
#pragma unroll
            for (int i = 0; i < 8; ++i)
#pragma unroll
                for (int j = 0; j < 8; ++j) acc[i][j] += a[i] * b[j];
        }
    }
}
#define ZERO_ACC(acc) do { _Pragma("unroll") for (int i = 0; i < 8; ++i) _Pragma("unroll") for (int j = 0; j < 8; ++j) acc[i][j] = 0.f; } while (0)

__global__ void __launch_bounds__(256) naive_ffn_in(const bf16_t* xb, const float* ssp, const float* gain, const float* Win, bf16_t* act) {
    __shared__ float As[8 * 132]; __shared__ float Bs[8 * 128];
    const int row0 = blockIdx.y * 128, col0 = blockIdx.x * 128, tx = threadIdx.x & 15, ty = threadIdx.x >> 4;
    float ag[8][8], au[8][8]; ZERO_ACC(ag); ZERO_ACC(au);
    accum_tile<bf16_t>(xb, D, D, gain, Win, 2 * DFF, row0, col0, ag, As, Bs);
    accum_tile<bf16_t>(xb, D, D, gain, Win, 2 * DFF, row0, DFF + col0, au, As, Bs);
#pragma unroll
    for (int i = 0; i < 8; ++i) { const int row = row0 + ty * 8 + i; const float rs = row_rstd(ssp, row);
#pragma unroll
        for (int j = 0; j < 8; ++j) { const float g = ag[i][j] * rs, u = au[i][j] * rs; const float sg = g / (1.0f + __expf(-g));
            act[(size_t)row * DFF + col0 + tx * 8 + j] = f2bf(sg * u); } }
}
__global__ void __launch_bounds__(256) naive_resid(const bf16_t* A, int K, const float* W, const float* xin, float* xout, float coef) {
    __shared__ float As[8 * 132]; __shared__ float Bs[8 * 128];
    const int row0 = blockIdx.y * 128, col0 = blockIdx.x * 128, tx = threadIdx.x & 15, ty = threadIdx.x >> 4;
    float acc[8][8]; ZERO_ACC(acc);
    accum_tile<bf16_t>(A, K, K, nullptr, W, D, row0, col0, acc, As, Bs);
#pragma unroll
    for (int i = 0; i < 8; ++i) { const int row = row0 + ty * 8 + i;
#pragma unroll
        for (int j = 0; j < 8; ++j) { const size_t o = (size_t)row * D + col0 + tx * 8 + j; xout[o] = xin[o] + coef * acc[i][j]; } }
}
struct QkvOut { bf16_t *qa, *ka, *va, *qb, *kb, *vb; const float *qna, *kna, *qnb, *knb; };
__global__ void __launch_bounds__(256) naive_qkv(const bf16_t* xb, const float* ssp, const float* gain, const float* Wqkv, QkvOut o) {
    __shared__ float As[8 * 132]; __shared__ float Bs[8 * 128];
    const int row0 = blockIdx.y * 128, col0 = blockIdx.x * 128, tx = threadIdx.x & 15, ty = threadIdx.x >> 4;
    float acc[8][8]; ZERO_ACC(acc);
    accum_tile<bf16_t>(xb, D, D, gain, Wqkv, QKVW, row0, col0, acc, As, Bs);
    const int c = col0 + tx * 8;
    bf16_t* dst; const float* ng; int nh, hc; float sc = 1.0f;
    if (c < 512) { dst = o.qa; ng = o.qna; nh = 8; hc = c; sc = QSCALE; }
    else if (c < 1024) { dst = o.ka; ng = o.kna; nh = 8; hc = c - 512; }
    else if (c < 1536) { dst = o.va; ng = nullptr; nh = 8; hc = c - 1024; }
    else if (c < 2048) { dst = o.qb; ng = o.qnb; nh = 8; hc = c - 1536; sc = QSCALE; }
    else if (c < 2176) { dst = o.kb; ng = o.knb; nh = 2; hc = c - 2048; }
    else { dst = o.vb; ng = nullptr; nh = 2; hc = c - 2176; }
    const int h = hc >> 6, e0 = hc & 63;
#pragma unroll
    for (int i = 0; i < 8; ++i) { const int row = row0 + ty * 8 + i; const float rs = row_rstd(ssp, row);
        float v[8]; float ss = 0.f;
#pragma unroll
        for (int j = 0; j < 8; ++j) { v[j] = acc[i][j] * rs; ss += v[j] * v[j]; }
        ss += __shfl_xor(ss, 1); ss += __shfl_xor(ss, 2); ss += __shfl_xor(ss, 4);
        const float hr = rsqrtf(ss * (1.0f / HD) + EPS);
        const int b = row / S, s = row % S;
        bf16_t* p = dst + (((size_t)b * nh + h) * S + s) * HD + e0;
#pragma unroll
        for (int j = 0; j < 8; ++j) p[j] = f2bf(ng ? v[j] * hr * ng[e0 + j] * sc : v[j]); }
}
__global__ void __launch_bounds__(256) naive_ple(const bf16_t* xb, const float* ssp, const float* gain, const float* Wg, const float* p, const float* Wp, const float* xin, float* xout) {
    __shared__ float As[8 * 132]; __shared__ float Bs[8 * 128];
    const int row0 = blockIdx.y * 128, col0 = blockIdx.x * 128, tx = threadIdx.x & 15, ty = threadIdx.x >> 4;
    float ag[8][8], ap[8][8]; ZERO_ACC(ag); ZERO_ACC(ap);
    accum_tile<bf16_t>(xb, D, D, gain, Wg, D, row0, col0, ag, As, Bs);
    accum_tile<float>(p, PLE, PLE, nullptr, Wp, D, row0, col0, ap, As, Bs);
#pragma unroll
    for (int i = 0; i < 8; ++i) { const int row = row0 + ty * 8 + i; const float rs = row_rstd(ssp, row);
#pragma unroll
        for (int j = 0; j < 8; ++j) { const size_t o = (size_t)row * D + col0 + tx * 8 + j; const float g = 1.0f / (1.0f + __expf(-ag[i][j] * rs));
            xout[o] = xin[o] + g * ap[i][j]; } }
}

__device__ __forceinline__ int t5_bucket(int rel) {
    const int n = rel < 0 ? -rel : rel; const int ret = rel > 0 ? 16 : 0;
    if (n < 8) return ret + n;
    int large = 8 + (int)(logf((float)n / 8.0f) / 4.852030263919617f * 8.0f);
    large = large < 15 ? large : 15;
    return ret + large;
}
struct AttnIn { const bf16_t *qa, *ka, *va, *qb, *kb, *vb; const float* rel_bias; const float* sink; bf16_t* o; };
__global__ void __launch_bounds__(256) naive_attn(AttnIn a) {
    __shared__ float pl[4][400]; __shared__ int kl[4][400];
    const int wave = threadIdx.x >> 6, lane = threadIdx.x & 63;
    const int t = blockIdx.x * 4 + wave, head = blockIdx.y, b = blockIdx.z;
    const bool isA = head < 8;
    const bf16_t *q, *k, *v;
    if (isA) { q = a.qa + (((size_t)b * 8 + head) * S + t) * HD; k = a.ka + ((size_t)b * 8 + head) * S * HD; v = a.va + ((size_t)b * 8 + head) * S * HD; }
    else { const int hq = head - 8, hk = hq >> 2; q = a.qb + (((size_t)b * 8 + hq) * S + t) * HD; k = a.kb + ((size_t)b * 2 + hk) * S * HD; v = a.vb + ((size_t)b * 2 + hk) * S * HD; }
    float qf[HD];
#pragma unroll
    for (int e = 0; e < HD; ++e) qf[e] = bf2f(q[e]);
    const int nk = isA ? 387 : 257;
    float mx = -1e30f;
    for (int i = lane; i < nk; i += 64) {
        int rel;
        if (isA) { const int br = i / 129, j = i % 129 - 64; rel = j * (br == 0 ? 1 : br == 1 ? 4 : 16); }
        else rel = i - 128;
        const int tk = t + rel;
        float lg = -1e30f;
        if (tk >= 0 && tk < S) {
            float d = 0.f; const bf16_t* kr = k + (size_t)tk * HD;
#pragma unroll
            for (int e = 0; e < HD; ++e) d += qf[e] * bf2f(kr[e]);
            lg = d + a.rel_bias[t5_bucket(rel) * 16 + head] * LOG2E;
        }
        pl[wave][i] = lg; kl[wave][i] = tk;
        mx = fmaxf(mx, lg);
    }
#pragma unroll
    for (int o = 1; o < 64; o <<= 1) mx = fmaxf(mx, __shfl_xor(mx, o));
    float sinkl = 0.f;
    if (!isA) { sinkl = a.sink[head - 8] * LOG2E; mx = fmaxf(mx, sinkl); }
    float sum = 0.f;
    for (int i = lane; i < nk; i += 64) { const float lg = pl[wave][i]; const float pv = lg > -1e29f ? exp2f(lg - mx) : 0.f; pl[wave][i] = pv; sum += pv; }
#pragma unroll
    for (int o = 1; o < 64; o <<= 1) sum += __shfl_xor(sum, o);
    if (!isA) sum += exp2f(sinkl - mx);
    __syncthreads();
    float acc = 0.f;
    for (int i = 0; i < nk; ++i) { const float pv = pl[wave][i]; if (pv != 0.f) acc += pv * bf2f(v[(size_t)kl[wave][i] * HD + lane]); }
    a.o[((size_t)b * S + t) * D + head * HD + lane] = f2bf(acc / sum);
}

namespace pg8 {
#define PG8_LAS __attribute__((address_space(3)))
typedef unsigned short bf16_t;
typedef short bf16x8 __attribute__((ext_vector_type(8)));
typedef float f32x4 __attribute__((ext_vector_type(4)));
typedef unsigned u32x4 __attribute__((ext_vector_type(4)));
constexpr int BM = 256, BK = 64, HALF = 128, HTB = HALF * BK * 2  , STAGE_BYTES = 8 * HTB, NXCD = 8, WGM = 8;

__host__ __device__ __forceinline__ int lds_byte(int r, int c) { const int st = (r >> 4) * 2 + (c >> 5), rr = r & 15, cc = c & 31, ob = rr * 64 + cc * 2; return st * 1024 + (ob ^ (((ob >> 9) & 1) << 5)); }
__host__ __device__ __forceinline__ void stage_rc(int b, int& R, int& C) { const int st = b / 1024, sb = b % 1024, swz = sb ^ (((sb >> 9) & 1) << 5); R = (st >> 1) * 16 + swz / 64; C = (st & 1) * 32 + (swz % 64) / 2; }
__host__ __device__ __forceinline__ int perm32(int rho) { const int n = rho >> 4, i = rho & 15; return 8 * (i >> 2) + 4 * n + (i & 3); }

struct Unit { int pm, pn; };
struct Gemm { const bf16_t* A; const bf16_t* Bt; int M, N, K; };

struct StaticOrder {
    int nM, nN, nwg, G, c;
    __host__ __device__ void init(int M, int N, int G_, int c_) { nM = M / BM; nN = N / BM; nwg = nM * nN; G = G_; c = c_; }
    __host__ __device__ bool next(int i, Unit& u) const {
        const long L = (long)i * G + c; if (L >= nwg) return false;
        int wgid = (int)L; { const int q = nwg / NXCD, r = nwg % NXCD, xcd = wgid % NXCD, off = wgid / NXCD; wgid = (xcd < r ? xcd * (q + 1) : r * (q + 1) + (xcd - r) * q) + off; }
        const int nig = WGM * nN, gid = wgid / nig, fm = gid * WGM, gsz = (nM - fm) < WGM ? (nM - fm) : WGM;
        u.pm = fm + ((wgid % nig) % gsz); u.pn = (wgid % nig) / gsz; return true;
    }
    __device__ __forceinline__ void a_ready(const Unit&) const {}
    __device__ __forceinline__ void done(const Unit&) const {}
};

__device__ __forceinline__ unsigned cvt_pk_bf16(float lo, float hi) { unsigned r; asm volatile("v_cvt_pk_bf16_f32 %0, %1, %2" : "=v"(r) : "v"(lo), "v"(hi)); return r; }
typedef float f32x2 __attribute__((ext_vector_type(2)));
template <class Epi, class Sched, bool ALIGN_EPI = false, bool SP2 = false>
__device__ __forceinline__ void gemm_phase(PG8_LAS unsigned char* lds, const Gemm g, const Sched& S, const Epi& E, const int tid) {
    const int wid = __builtin_amdgcn_readfirstlane(tid >> 6), lane = tid & 63, wr = wid >> 2, wc = wid & 3, fr = lane & 15, fq = lane >> 4;
    const int K = g.K, nt = K / BK;
    unsigned voffA[2], voffB[2];
#pragma unroll
    for (int i = 0; i < 2; ++i) { int R, C; stage_rc(tid * 16 + i * 8192, R, C); const int Rb = Epi::PERM ? ((R & ~31) + perm32(R & 31)) : R;
        voffA[i] = (unsigned)(R * K + C) * 2u; voffB[i] = (unsigned)(Rb * K + C) * 2u; }
    const size_t kstep = (size_t)(BK * 2);
    const size_t hstep = (size_t)HALF * K * 2;
    const size_t tstep = 2 * hstep;
    const unsigned ldsw = (unsigned)wid * 1024u;
    const int aoff = lds_byte(wr * 64 + fr, fq * 8), boff = lds_byte(wc * 32 + fr, fq * 8);
#define PG8_SA(b, h) (((b) * 2 + (h)) * HTB)
#define PG8_SB(b, h) ((4 + (b) * 2 + (h)) * HTB)
#define PG8_STAGE(bufoff, gbase, voff) do { _Pragma("unroll") for (int _i = 0; _i < 2; ++_i) \
        __builtin_amdgcn_global_load_lds((const unsigned*)((const char*)(gbase) + (voff)[_i]), (PG8_LAS unsigned*)(lds + (bufoff) + ldsw + _i * 8192), 16, 0, 0); } while (0)
#define PG8_LDA(dst, b, h) do { _Pragma("unroll") for (int m = 0; m < 4; ++m) _Pragma("unroll") for (int k = 0; k < 2; ++k) dst[m][k] = *(const PG8_LAS bf16x8*)(lds + PG8_SA(b, h) + aoff + m * 2048 + k * 1024); } while (0)
#define PG8_LDB(dst, b, h) do { _Pragma("unroll") for (int n = 0; n < 2; ++n) _Pragma("unroll") for (int k = 0; k < 2; ++k) dst[n][k] = *(const PG8_LAS bf16x8*)(lds + PG8_SB(b, h) + boff + n * 2048 + k * 1024); } while (0)
#define PG8_MMA(ai, bj, At, Bt) do { __builtin_amdgcn_s_setprio(1); _Pragma("unroll") for (int m = 0; m < 4; ++m) _Pragma("unroll") for (int n = 0; n < 2; ++n) _Pragma("unroll") for (int k = 0; k < 2; ++k) \
        acc[ai][bj][m][n] = __builtin_amdgcn_mfma_f32_16x16x32_bf16(Bt[n][k], At[m][k], acc[ai][bj][m][n], 0, 0, 0); __builtin_amdgcn_s_setprio(0); } while (0)
#define PG8_WAIT_V(n) asm volatile("s_waitcnt vmcnt(" #n ")" ::: "memory")
#define PG8_WAIT_L(n) asm volatile("s_waitcnt lgkmcnt(" #n ")" ::: "memory")
#define PG8_BAR __builtin_amdgcn_s_barrier()
#define PG8_SCHED __builtin_amdgcn_sched_barrier(0)
    Unit cur, nxt; int ui = 0;
    if (!S.next(0, cur)) return;
    f32x4 acc[2][2][4][2];
#pragma unroll
    for (int a = 0; a < 2; ++a)
#pragma unroll
        for (int b = 0; b < 2; ++b)
#pragma unroll
            for (int m = 0; m < 4; ++m)
#pragma unroll
                for (int n = 0; n < 2; ++n) acc[a][b][m][n] = (f32x4){0.f, 0.f, 0.f, 0.f};
    bf16x8 At[4][2], B0[2][2], B1[2][2];
    const char* cA = (const char*)g.A + (size_t)cur.pm * tstep; const char* cB = (const char*)g.Bt + (size_t)cur.pn * tstep;
    S.a_ready(cur);
    if constexpr (SP2) {
        PG8_STAGE(PG8_SB(0, 0), cB, voffB); PG8_STAGE(PG8_SB(0, 1), cB + hstep, voffB); PG8_STAGE(PG8_SA(0, 0), cA, voffA); PG8_STAGE(PG8_SA(0, 1), cA + hstep, voffA);
        if (wr == 1) PG8_BAR;
        PG8_WAIT_V(2); PG8_BAR;
        PG8_STAGE(PG8_SB(1, 0), cB + kstep, voffB); PG8_STAGE(PG8_SA(1, 0), cA + kstep, voffA); PG8_STAGE(PG8_SB(1, 1), cB + hstep + kstep, voffB);
        PG8_WAIT_V(6); PG8_BAR;
    } else {
        PG8_STAGE(PG8_SB(0, 0), cB, voffB); PG8_STAGE(PG8_SA(0, 0), cA, voffA); PG8_STAGE(PG8_SB(0, 1), cB + hstep, voffB); PG8_STAGE(PG8_SA(0, 1), cA + hstep, voffA);
        if (wr == 1) PG8_BAR;
        PG8_WAIT_V(4); PG8_BAR;
        PG8_STAGE(PG8_SB(1, 0), cB + kstep, voffB); PG8_STAGE(PG8_SA(1, 0), cA + kstep, voffA); PG8_STAGE(PG8_SB(1, 1), cB + hstep + kstep, voffB);
        PG8_WAIT_V(6); PG8_BAR;
    }
    for (;;) {
        const bool has_next = S.next(ui + 1, nxt);
        const char* nA = has_next ? (const char*)g.A + (size_t)nxt.pm * tstep : cA; const char* nB = has_next ? (const char*)g.Bt + (size_t)nxt.pn * tstep : cB;
        for (int t = 0; t < nt; t += 2) {
            const bool last = (t == nt - 2);
            const char* a1 = cA + (size_t)(t + 1) * kstep;
            const char* a2 = last ? nA : cA + (size_t)(t + 2) * kstep; const char* b2 = last ? nB : cB + (size_t)(t + 2) * kstep;
            const char* a3 = a2 + kstep; const char* b3 = b2 + kstep;
            if (last && has_next) S.a_ready(nxt);
            if constexpr (SP2) {
            PG8_LDB(B0, 0, 0); PG8_LDB(B1, 0, 1); PG8_SCHED; PG8_LDA(At, 0, 0); PG8_STAGE(PG8_SA(1, 1), a1 + hstep, voffA);
            PG8_WAIT_V(8); PG8_WAIT_L(0); PG8_BAR; PG8_MMA(0, 0, At, B0); PG8_MMA(0, 1, At, B1); PG8_BAR; PG8_SCHED;
            PG8_LDA(At, 0, 1); PG8_STAGE(PG8_SB(0, 0), b2, voffB); PG8_STAGE(PG8_SB(0, 1), b2 + hstep, voffB); PG8_STAGE(PG8_SA(0, 0), a2, voffA);
            PG8_WAIT_V(8); PG8_WAIT_L(0); PG8_BAR; PG8_MMA(1, 0, At, B0); PG8_MMA(1, 1, At, B1); PG8_BAR; PG8_SCHED;
            PG8_LDB(B0, 1, 0); PG8_LDB(B1, 1, 1); PG8_SCHED; PG8_LDA(At, 1, 0); PG8_STAGE(PG8_SA(0, 1), a2 + hstep, voffA);
            PG8_WAIT_V(8); PG8_WAIT_L(0); PG8_BAR; PG8_MMA(0, 0, At, B0); PG8_MMA(0, 1, At, B1); PG8_BAR; PG8_SCHED;
            PG8_LDA(At, 1, 1); PG8_STAGE(PG8_SB(1, 0), b3, voffB); PG8_STAGE(PG8_SB(1, 1), b3 + hstep, voffB); PG8_STAGE(PG8_SA(1, 0), a3, voffA);
            PG8_WAIT_V(8); PG8_WAIT_L(0); PG8_BAR; PG8_MMA(1, 0, At, B0); PG8_MMA(1, 1, At, B1); PG8_BAR; PG8_SCHED;
            } else {
            PG8_LDB(B0, 0, 0); PG8_SCHED; PG8_LDA(At, 0, 0); PG8_STAGE(PG8_SA(1, 1), a1 + hstep, voffA);
            PG8_WAIT_L(8); PG8_BAR; PG8_WAIT_L(0); PG8_MMA(0, 0, At, B0); PG8_BAR; PG8_SCHED;
            PG8_LDB(B1, 0, 1); PG8_STAGE(PG8_SB(0, 0), b2, voffB);
            PG8_BAR; PG8_WAIT_L(0); PG8_MMA(0, 1, At, B1); PG8_BAR;
            PG8_LDA(At, 0, 1); PG8_STAGE(PG8_SA(0, 0), a2, voffA);
            PG8_BAR; PG8_WAIT_L(0); PG8_MMA(1, 0, At, B0); PG8_BAR; PG8_SCHED;
            PG8_STAGE(PG8_SB(0, 1), b2 + hstep, voffB);
            PG8_WAIT_V(6); PG8_BAR; PG8_MMA(1, 1, At, B1); PG8_BAR;
            PG8_LDB(B0, 1, 0); PG8_SCHED; PG8_LDA(At, 1, 0); PG8_STAGE(PG8_SA(0, 1), a2 + hstep, voffA);
            PG8_WAIT_L(8); PG8_BAR; PG8_WAIT_L(0); PG8_MMA(0, 0, At, B0); PG8_BAR; PG8_SCHED;
            PG8_LDB(B1, 1, 1); PG8_STAGE(PG8_SB(1, 0), b3, voffB);
            PG8_BAR; PG8_WAIT_L(0); PG8_MMA(0, 1, At, B1); PG8_BAR;
            PG8_LDA(At, 1, 1); PG8_STAGE(PG8_SA(1, 0), a3, voffA);
            PG8_BAR; PG8_WAIT_L(0); PG8_MMA(1, 0, At, B0); PG8_BAR; PG8_SCHED;
            PG8_STAGE(PG8_SB(1, 1), b3 + hstep, voffB);
            PG8_WAIT_V(6); PG8_BAR; PG8_MMA(1, 1, At, B1); PG8_BAR;
            }
        }
        if constexpr (ALIGN_EPI) { if (wr == 0) PG8_BAR; }
        if constexpr (!Epi::AFTER_DRAIN) { int l2_; asm volatile("v_mbcnt_lo_u32_b32 %0, -1, 0\n\tv_mbcnt_hi_u32_b32 %0, -1, %0" : "=v"(l2_)); E(acc, cur, wr, wc, l2_ & 15, l2_ >> 4); S.done(cur); }
        if (!has_next) break;
#pragma unroll
        for (int a = 0; a < 2; ++a)
#pragma unroll
            for (int b = 0; b < 2; ++b)
#pragma unroll
                for (int m = 0; m < 4; ++m)
#pragma unroll
                    for (int n = 0; n < 2; ++n) acc[a][b][m][n] = (f32x4){0.f, 0.f, 0.f, 0.f};
        cur = nxt; cA = nA; cB = nB; ++ui;
        if constexpr (ALIGN_EPI) { if (wr == 1) PG8_BAR; }
    }
    PG8_WAIT_V(0);
    if constexpr (!ALIGN_EPI) { if (wr == 0) PG8_BAR; }
    PG8_BAR;
    if constexpr (Epi::AFTER_DRAIN) { E.fused(acc, cur, wr, wc, fr, fq, lds, wid, lane); S.done(cur); }
#undef PG8_SA
#undef PG8_SB
#undef PG8_STAGE
#undef PG8_LDA
#undef PG8_LDB
#undef PG8_MMA
#undef PG8_WAIT_V
#undef PG8_WAIT_L
#undef PG8_BAR
#undef PG8_SCHED
}
}

namespace pg8 {
typedef float f32x2 __attribute__((ext_vector_type(2)));
__device__ __forceinline__ float shx(float v, int lane, int mask) { return __int_as_float(__builtin_amdgcn_ds_bpermute((lane ^ mask) << 2, __float_as_int(v))); }
__device__ __forceinline__ float rstd16(const float* ssp, int row, int fq, int lane) {
    const f32x4 v = *(const f32x4*)(ssp + (size_t)row * 16 + 4 * fq);
    float s = (v[0] + v[1]) + (v[2] + v[3]);
    s += shx(s, lane, 16); s += shx(s, lane, 32);
    return rsqrtf(s * (1.0f / 1024.0f) + 1e-6f);
}
__device__ __forceinline__ float sigm(float v) { return __builtin_amdgcn_rcpf(1.0f + __builtin_amdgcn_exp2f(-1.4426950408889634f * v)); }
__device__ __forceinline__ u32x4 pack8(const f32x4& a, const f32x4& b) { u32x4 w; w.x = cvt_pk_bf16(a[0], a[1]); w.y = cvt_pk_bf16(a[2], a[3]); w.z = cvt_pk_bf16(b[0], b[1]); w.w = cvt_pk_bf16(b[2], b[3]); return w; }
__device__ __forceinline__ float bflo(unsigned w) { return __uint_as_float(w << 16); }
__device__ __forceinline__ float bfhi(unsigned w) { return __uint_as_float(w & 0xffff0000u); }

struct EpiSwiglu {
    static constexpr bool PERM = true, AFTER_DRAIN = false;
    bf16_t* act; const float* ssp; int mode;
    __device__ __forceinline__ void operator()(const f32x4 (&acc)[2][2][4][2], const Unit& u, int wr, int wc, int fr, int fq) const {
        const int lane = fr + 16 * fq;
        const int row0 = u.pm * BM + wr * 64 + fr, col0 = u.pn * 128 + wc * 32 + 8 * fq;
#pragma unroll
        for (int ai = 0; ai < 2; ++ai)
#pragma unroll
            for (int m = 0; m < 4; ++m) { const int row = row0 + ai * HALF + m * 16; const float rs = rstd16(ssp, row, fq, lane);
                f32x4 o[2];
                const float c1 = -1.4426950408889634f * rs, rs2 = rs * rs;
#pragma unroll
                for (int n = 0; n < 2; ++n)
#pragma unroll
                    for (int j = 0; j < 4; ++j) { const float g = acc[ai][0][m][n][j], up = acc[ai][1][m][n][j];
                        o[n][j] = (PROBE_NULL_EPI && mode == 2) ? g + up : (g * up) * (rs2 * __builtin_amdgcn_rcpf(1.0f + __builtin_amdgcn_exp2f(c1 * g))); }
                const u32x4 w = pack8(o[0], o[1]);
                if (PROBE_NULL_EPI && mode == 1) asm volatile("" :: "v"(w)); else *(u32x4*)(act + (size_t)row * 2816 + col0) = w; }
    }
};
__device__ __forceinline__ void unpack8(const u32x4& w, f32x4& a, f32x4& b) { a = (f32x4){bflo(w.x), bfhi(w.x), bflo(w.y), bfhi(w.y)}; b = (f32x4){bflo(w.z), bfhi(w.z), bflo(w.w), bfhi(w.w)}; }
__device__ __forceinline__ void split8(const f32x4& x0, const f32x4& x1, u32x4& hi, u32x4& lo) {
    hi = pack8(x0, x1); f32x4 h0, h1; unpack8(hi, h0, h1); lo = pack8(x0 - h0, x1 - h1);
}
struct EpiResid {
    static constexpr bool PERM = true, AFTER_DRAIN = false;
    const bf16_t* hin; const bf16_t* lin; bf16_t* hout; bf16_t* lout; float* sspw; float coef;
    __device__ __forceinline__ void operator()(const f32x4 (&acc)[2][2][4][2], const Unit& u, int wr, int wc, int fr, int fq) const {
        const int lane = fr + 16 * fq;
        float cf = __uint_as_float(__builtin_amdgcn_readfirstlane(__float_as_uint(coef))); asm volatile("" : "+s"(cf));
        const int row0 = u.pm * BM + wr * 64 + fr, col0 = u.pn * BM + wc * 32 + 8 * fq;
#pragma unroll
        for (int ai = 0; ai < 2; ++ai) {
            u32x4 xh[4][2], xl[4][2];
#pragma unroll
            for (int m = 0; m < 4; ++m)
#pragma unroll
                for (int bj = 0; bj < 2; ++bj) { const size_t off = (size_t)(row0 + ai * HALF + m * 16) * 1024 + col0 + bj * HALF; xh[m][bj] = *(const u32x4*)(hin + off); xl[m][bj] = *(const u32x4*)(lin + off); }
            asm volatile("" ::: "memory");
#pragma unroll
            for (int m = 0; m < 4; ++m) { const int row = row0 + ai * HALF + m * 16; float ss = 0.f;
#pragma unroll
                for (int bj = 0; bj < 2; ++bj) { const size_t off = (size_t)row * 1024 + col0 + bj * HALF;
                    f32x4 h0, h1, l0, l1; unpack8(xh[m][bj], h0, h1); unpack8(xl[m][bj], l0, l1);
                    const f32x4 x0 = (h0 + l0) + acc[ai][bj][m][0] * cf, x1 = (h1 + l1) + acc[ai][bj][m][1] * cf;
                    u32x4 nh, nl; split8(x0, x1, nh, nl);
                    *(u32x4*)(hout + off) = nh; *(u32x4*)(lout + off) = nl;
                    ss += (x0[0] * x0[0] + x0[1] * x0[1]) + (x0[2] * x0[2] + x0[3] * x0[3]) + (x1[0] * x1[0] + x1[1] * x1[1]) + (x1[2] * x1[2] + x1[3] * x1[3]); }
                ss += shx(ss, lane, 16); ss += shx(ss, lane, 32);
                if (fq == 0) sspw[(size_t)row * 16 + u.pn * 4 + wc] = ss; }
            asm volatile("" ::: "memory");
        }
    }
};
struct EpiGate {
    static constexpr bool PERM = true, AFTER_DRAIN = false;
    const bf16_t* hin; const bf16_t* lin; bf16_t* hout; bf16_t* lout; float* fout; float* sspw; const float* sspr; const bf16_t* proj; float coef;
    __device__ __forceinline__ void operator()(const f32x4 (&acc)[2][2][4][2], const Unit& u, int wr, int wc, int fr, int fq) const {
        const int lane = fr + 16 * fq;
        float cf = __uint_as_float(__builtin_amdgcn_readfirstlane(__float_as_uint(coef))); asm volatile("" : "+s"(cf));
        const int row0 = u.pm * BM + wr * 64 + fr, col0 = u.pn * BM + wc * 32 + 8 * fq;
#pragma unroll
        for (int ai = 0; ai < 2; ++ai)
#pragma unroll
            for (int mh = 0; mh < 2; ++mh) {
                u32x4 xh[2][2], xl[2][2], pw[2][2]; float rs[2];
#pragma unroll
                for (int mm = 0; mm < 2; ++mm) { const int row = row0 + ai * HALF + (2 * mh + mm) * 16; rs[mm] = rstd16(sspr, row, fq, lane);
#pragma unroll
                    for (int bj = 0; bj < 2; ++bj) { const size_t off = (size_t)row * 1024 + col0 + bj * HALF; xh[mm][bj] = *(const u32x4*)(hin + off); xl[mm][bj] = *(const u32x4*)(lin + off); pw[mm][bj] = *(const u32x4*)(proj + off); } }
                asm volatile("" ::: "memory");
#pragma unroll
                for (int mm = 0; mm < 2; ++mm) { const int m = 2 * mh + mm, row = row0 + ai * HALF + m * 16; float ss = 0.f;
#pragma unroll
                    for (int bj = 0; bj < 2; ++bj) { const size_t off = (size_t)row * 1024 + col0 + bj * HALF;
                        f32x4 h0, h1, l0, l1, p0, p1; unpack8(xh[mm][bj], h0, h1); unpack8(xl[mm][bj], l0, l1); unpack8(pw[mm][bj], p0, p1);
                        f32x4 x0 = h0 + l0, x1 = h1 + l1;
#pragma unroll
                        for (int j = 0; j < 4; ++j) { x0[j] += cf * (sigm(acc[ai][bj][m][0][j] * rs[mm]) * p0[j]); x1[j] += cf * (sigm(acc[ai][bj][m][1][j] * rs[mm]) * p1[j]); }
                        if (fout) { *(f32x4*)(fout + off) = x0; *(f32x4*)(fout + off + 4) = x1; }
                        else { u32x4 nh, nl; split8(x0, x1, nh, nl); *(u32x4*)(hout + off) = nh; *(u32x4*)(lout + off) = nl;
                            ss += (x0[0] * x0[0] + x0[1] * x0[1]) + (x0[2] * x0[2] + x0[3] * x0[3]) + (x1[0] * x1[0] + x1[1] * x1[1]) + (x1[2] * x1[2] + x1[3] * x1[3]); } }
                    if (!fout) { ss += shx(ss, lane, 16); ss += shx(ss, lane, 32);
                        if (fq == 0) sspw[(size_t)row * 16 + u.pn * 4 + wc] = ss; } }
                asm volatile("" ::: "memory");
            }
    }
};
struct EpiStoreBf16 {
    static constexpr bool PERM = true, AFTER_DRAIN = false;
    bf16_t* O; int ldc;
    __device__ __forceinline__ void operator()(const f32x4 (&acc)[2][2][4][2], const Unit& u, int wr, int wc, int fr, int fq) const {
        const int lane = fr + 16 * fq;
        const int row0 = u.pm * BM + wr * 64 + fr, col0 = u.pn * BM + wc * 32 + 8 * fq;
#pragma unroll
        for (int ai = 0; ai < 2; ++ai)
#pragma unroll
            for (int m = 0; m < 4; ++m) { const int row = row0 + ai * HALF + m * 16;
#pragma unroll
                for (int bj = 0; bj < 2; ++bj) *(u32x4*)(O + (size_t)row * ldc + col0 + bj * HALF) = pack8(acc[ai][bj][m][0], acc[ai][bj][m][1]); }
    }
};
struct EpiNull {
    static constexpr bool PERM = true, AFTER_DRAIN = false;
    __device__ __forceinline__ void operator()(const f32x4 (&acc)[2][2][4][2], const Unit& u, int wr, int wc, int fr, int fq) const {
#pragma unroll
        for (int ai = 0; ai < 2; ++ai)
#pragma unroll
            for (int bj = 0; bj < 2; ++bj)
#pragma unroll
                for (int m = 0; m < 4; ++m)
#pragma unroll
                    for (int n = 0; n < 2; ++n) asm volatile("" :: "v"(acc[ai][bj][m][n]));
    }
};
struct EpiQkv {
    static constexpr bool PERM = true, AFTER_DRAIN = false;
    const float* ssp; bf16_t *qa, *ka, *va, *qb, *kb, *vb; const float *qna, *kna, *qnb, *knb;
    __device__ __forceinline__ void operator()(const f32x4 (&acc)[2][2][4][2], const Unit& u, int wr, int wc, int fr, int fq) const {
        const int lane = fr + 16 * fq;
        const int t = u.pn; bf16_t* dst; const float* ng; int nh, h; float sc = 1.0f;
        if (t < 2) { dst = qa; ng = qna; nh = 8; h = 4 * t + wc; sc = QSCALE; }
        else if (t < 4) { dst = ka; ng = kna; nh = 8; h = 4 * (t - 2) + wc; }
        else if (t < 6) { dst = va; ng = nullptr; nh = 8; h = 4 * (t - 4) + wc; }
        else if (t < 8) { dst = qb; ng = qnb; nh = 8; h = 4 * (t - 6) + wc; sc = QSCALE; }
        else if (wc < 2) { dst = kb; ng = knb; nh = 2; h = wc; }
        else { dst = vb; ng = nullptr; nh = 2; h = wc - 2; }
        f32x4 gv[2][2];
#pragma unroll
        for (int bj = 0; bj < 2; ++bj)
#pragma unroll
            for (int n = 0; n < 2; ++n) { if (ng) gv[bj][n] = *(const f32x4*)(ng + 32 * bj + 8 * fq + 4 * n) * sc; else gv[bj][n] = (f32x4){1.f, 1.f, 1.f, 1.f}; }
        const int row0 = u.pm * BM + wr * 64 + fr;
#pragma unroll
        for (int ai = 0; ai < 2; ++ai)
#pragma unroll
            for (int m = 0; m < 4; ++m) { const int row = row0 + ai * HALF + m * 16; const float rs = rstd16(ssp, row, fq, lane);
                f32x4 v[2][2]; float ss = 0.f;
#pragma unroll
                for (int bj = 0; bj < 2; ++bj)
#pragma unroll
                    for (int n = 0; n < 2; ++n) { v[bj][n] = acc[ai][bj][m][n] * rs; ss += (v[bj][n][0] * v[bj][n][0] + v[bj][n][1] * v[bj][n][1]) + (v[bj][n][2] * v[bj][n][2] + v[bj][n][3] * v[bj][n][3]); }
                ss += shx(ss, lane, 16); ss += shx(ss, lane, 32);
                const float hr = ng ? rsqrtf(ss * (1.0f / 64.0f) + 1e-6f) : 1.0f;
                const int b = row >> 12, s = row & 4095;
                bf16_t* p = dst + (((size_t)b * nh + h) * 4096 + s) * 64 + 8 * fq;
#pragma unroll
                for (int bj = 0; bj < 2; ++bj) *(u32x4*)(p + 32 * bj) = pack8(v[bj][0] * hr * gv[bj][0], v[bj][1] * hr * gv[bj][1]); }
    }
};
}

#include <hip/hip_cooperative_groups.h>
namespace cg = cooperative_groups;
#define LAS __attribute__((address_space(3)))
typedef unsigned v4u __attribute__((ext_vector_type(4)));
constexpr int NWAVES = 8, RING_BYTES = 131072, LDS_BYTES = 147456;
constexpr int NPHASE = 1 + 8 * DEPTH;
constexpr size_t WO_F1IN = 0, WO_F1OUT = WO_F1IN + (size_t)2 * DFF * D, WO_QKV = WO_F1OUT + (size_t)D * DFF, WO_WO = WO_QKV + (size_t)QKVW * D,
                 WO_F2IN = WO_WO + (size_t)D * D, WO_F2OUT = WO_F2IN + (size_t)2 * DFF * D, WO_WG = WO_F2OUT + (size_t)D * DFF, WO_WP = WO_WG + (size_t)D * D, W_LAYER = WO_WP + (size_t)D * PLE;
static_assert(W_LAYER * 2 * DEPTH <= 84 * MiB, "weights fit");

struct Args { const float* in[20]; float* out; unsigned char* ws; int ph_lo, ph_hi; };

__device__ __forceinline__ int src_col(int kind, int n0) {
    if (kind == 0) return n0;
    if (kind == 1) return ((n0 >> 7) & 1) * DFF + 128 * (n0 >> 8) + (n0 & 127);
    return 256 * (n0 >> 8) + 64 * ((n0 >> 5) & 3) + 32 * ((n0 >> 7) & 1);
}
__device__ __forceinline__ void transpose_item(const float* W, int K, int N, const float* gain, bf16_t* Bt, int kind, int item, LAS float* scr, int lane) {
    const int kblocks = K / 64, nb = item / kblocks, kb = item % kblocks, k0 = 64 * kb, n0 = 64 * nb;
    const int cseg = lane & 15, r0 = lane >> 4;
    const int c0 = src_col(kind, n0 + 32 * (cseg >> 3)) + 4 * (cseg & 7);
    float4 v[16];
#pragma unroll
    for (int i = 0; i < 16; ++i) v[i] = *(const float4*)(W + (size_t)(k0 + r0 + 4 * i) * N + c0);
    if (gain) {
#pragma unroll
        for (int i = 0; i < 16; ++i) { const float g = gain[k0 + r0 + 4 * i]; v[i].x *= g; v[i].y *= g; v[i].z *= g; v[i].w *= g; }
    }
#pragma unroll
    for (int i = 0; i < 16; ++i) { LAS float* p = scr + (r0 + 4 * i) * 65 + 4 * cseg; p[0] = v[i].x; p[1] = v[i].y; p[2] = v[i].z; p[3] = v[i].w; }
    asm volatile("s_waitcnt lgkmcnt(0)" ::: "memory");
    const int c = lane & 7;
#pragma unroll
    for (int j = 0; j < 8; ++j) { const int n = (lane >> 3) + 8 * j; const LAS float* sp = scr + (8 * c) * 65 + n;
        v4u o; o.x = pg8::cvt_pk_bf16(sp[0 * 65], sp[1 * 65]); o.y = pg8::cvt_pk_bf16(sp[2 * 65], sp[3 * 65]); o.z = pg8::cvt_pk_bf16(sp[4 * 65], sp[5 * 65]); o.w = pg8::cvt_pk_bf16(sp[6 * 65], sp[7 * 65]);
        *(v4u*)(Bt + (size_t)(n0 + n) * K + k0 + 8 * c) = o; }
    asm volatile("s_waitcnt lgkmcnt(0)" ::: "memory");
}

constexpr int I_FIN = (D / 64) * (2 * DFF / 64), I_FOUT = (DFF / 64) * (D / 64), I_QKV = (D / 64) * (QKVW / 64), I_SQ = (D / 64) * (D / 64), I_WP = (PLE / 64) * (D / 64);
constexpr int IT_FIN1 = 0, IT_FOUT1 = IT_FIN1 + I_FIN, IT_QKV = IT_FOUT1 + I_FOUT, IT_WO = IT_QKV + I_QKV, IT_FIN2 = IT_WO + I_SQ, IT_FOUT2 = IT_FIN2 + I_FIN, IT_WG = IT_FOUT2 + I_FOUT, IT_WP = IT_WG + I_SQ, I_LAYER = IT_WP + I_WP;
template <class AT> __device__ __forceinline__ void convert_weight_items(const AT& a, LAS unsigned char* lds, int first, int count, int widx, int nw, int wave, int lane) {
    LAS float* scr = (LAS float*)(lds + wave * 16640);
    bf16_t* wbase = (bf16_t*)(a.ws() + WS_W);
    for (int it = first + widx; it < first + count; it += nw) {
        const int l = it / I_LAYER; int r = it % I_LAYER; bf16_t* wl = wbase + (size_t)l * W_LAYER;
        if (r < I_FIN) { transpose_item(a.in(4) + (size_t)l * D * 2 * DFF, D, 2 * DFF, a.in(3) + l * D, wl + WO_F1IN, 1, r, scr, lane); continue; } r -= I_FIN;
        if (r < I_FOUT) { transpose_item(a.in(5) + (size_t)l * DFF * D, DFF, D, nullptr, wl + WO_F1OUT, 0, r, scr, lane); continue; } r -= I_FOUT;
        if (r < I_QKV) { transpose_item(a.in(7) + (size_t)l * D * QKVW, D, QKVW, a.in(6) + l * D, wl + WO_QKV, 2, r, scr, lane); continue; } r -= I_QKV;
        if (r < I_SQ) { transpose_item(a.in(13) + (size_t)l * D * D, D, D, nullptr, wl + WO_WO, 0, r, scr, lane); continue; } r -= I_SQ;
        if (r < I_FIN) { transpose_item(a.in(15) + (size_t)l * D * 2 * DFF, D, 2 * DFF, a.in(14) + l * D, wl + WO_F2IN, 1, r, scr, lane); continue; } r -= I_FIN;
        if (r < I_FOUT) { transpose_item(a.in(16) + (size_t)l * DFF * D, DFF, D, nullptr, wl + WO_F2OUT, 0, r, scr, lane); continue; } r -= I_FOUT;
        if (r < I_SQ) { transpose_item(a.in(18) + (size_t)l * D * D, D, D, a.in(17) + l * D, wl + WO_WG, 0, r, scr, lane); continue; } r -= I_SQ;
        transpose_item(a.in(19) + (size_t)l * PLE * D, PLE, D, nullptr, wl + WO_WP, 0, r, scr, lane);
    }
}
template <class AT> __device__ __forceinline__ void prologue_phase(const AT& a, LAS unsigned char* lds, int gw, int NGW, int wave, int lane, bool side_jobs) {
    if (side_jobs) convert_weight_items(a, lds, IT_FIN1, I_FIN, gw, NGW, wave, lane);
    else convert_weight_items(a, lds, 0, DEPTH * I_LAYER, gw, NGW, wave, lane);
    const float* x = a.in(0); bf16_t* xb = (bf16_t*)(a.ws() + WS_XB); bf16_t* xlo = (bf16_t*)a.out(); float* ssp = (float*)(a.ws() + WS_SSP);
    for (int row = gw; row < M; row += 2 * NGW) {
        const int row2 = row + NGW; const bool has2 = row2 < M;
        const float4* xr = (const float4*)(x + (size_t)row * D); const float4* xr2 = (const float4*)(x + (size_t)(has2 ? row2 : row) * D);
        float4 va[4], vb[4];
#pragma unroll
        for (int j = 0; j < 4; ++j) { va[j] = xr[lane + 64 * j]; vb[j] = xr2[lane + 64 * j]; }
        float s = 0.f, s2 = 0.f;
#pragma unroll
        for (int j = 0; j < 4; ++j) { s += va[j].x * va[j].x + va[j].y * va[j].y + va[j].z * va[j].z + va[j].w * va[j].w; s2 += vb[j].x * vb[j].x + vb[j].y * vb[j].y + vb[j].z * vb[j].z + vb[j].w * vb[j].w;
            uint2 o; o.x = pg8::cvt_pk_bf16(va[j].x, va[j].y); o.y = pg8::cvt_pk_bf16(va[j].z, va[j].w); ((uint2*)(xb + (size_t)row * D))[lane + 64 * j] = o;
            uint2 q; q.x = pg8::cvt_pk_bf16(va[j].x - pg8::bflo(o.x), va[j].y - pg8::bfhi(o.x)); q.y = pg8::cvt_pk_bf16(va[j].z - pg8::bflo(o.y), va[j].w - pg8::bfhi(o.y)); ((uint2*)(xlo + (size_t)row * D))[lane + 64 * j] = q;
            if (has2) { uint2 o2; o2.x = pg8::cvt_pk_bf16(vb[j].x, vb[j].y); o2.y = pg8::cvt_pk_bf16(vb[j].z, vb[j].w); ((uint2*)(xb + (size_t)row2 * D))[lane + 64 * j] = o2;
                uint2 q2; q2.x = pg8::cvt_pk_bf16(vb[j].x - pg8::bflo(o2.x), vb[j].y - pg8::bfhi(o2.x)); q2.y = pg8::cvt_pk_bf16(vb[j].z - pg8::bflo(o2.y), vb[j].w - pg8::bfhi(o2.y)); ((uint2*)(xlo + (size_t)row2 * D))[lane + 64 * j] = q2; } }
#pragma unroll
        for (int o = 1; o < 64; o <<= 1) { s += pg8::shx(s, lane, o); s2 += pg8::shx(s2, lane, o); }
        if (lane < 4) { float4 r; r.x = lane == 0 ? s : 0.f; r.y = 0.f; r.z = 0.f; r.w = 0.f; ((float4*)ssp)[row * 4 + lane] = r;
            if (has2) { r.x = lane == 0 ? s2 : 0.f; ((float4*)ssp)[row2 * 4 + lane] = r; } }
    }
}
__device__ __forceinline__ void convert_p(const float* p, bf16_t* pb, int gtid, int nthreads) {
    for (int i = gtid; i < M * PLE / 8; i += nthreads) { const float4 v0 = ((const float4*)p)[2 * i], v1 = ((const float4*)p)[2 * i + 1];
        v4u o; o.x = pg8::cvt_pk_bf16(v0.x, v0.y); o.y = pg8::cvt_pk_bf16(v0.z, v0.w); o.z = pg8::cvt_pk_bf16(v1.x, v1.y); o.w = pg8::cvt_pk_bf16(v1.z, v1.w); ((v4u*)pb)[i] = o; }
}

__device__ __forceinline__ void attn_simple_phase(LAS unsigned char* lds, const AttnIn& a, int G, int wave, int lane) {
    LAS float* pl = (LAS float*)(lds + wave * 4096); LAS int* kl = (LAS int*)(lds + wave * 4096 + 2048);
    const int total = NB * 16 * S;
    for (int item = blockIdx.x * NWAVES + wave; item < total; item += G * NWAVES) {
        const int t = item & (S - 1), head = (item >> 12) & 15, b = item >> 16;
        const bool isA = head < 8;
        const bf16_t *q, *k, *v;
        if (isA) { q = a.qa + (((size_t)b * 8 + head) * S + t) * HD; k = a.ka + ((size_t)b * 8 + head) * S * HD; v = a.va + ((size_t)b * 8 + head) * S * HD; }
        else { const int hq = head - 8, hk = hq >> 2; q = a.qb + (((size_t)b * 8 + hq) * S + t) * HD; k = a.kb + ((size_t)b * 2 + hk) * S * HD; v = a.vb + ((size_t)b * 2 + hk) * S * HD; }
        float qf[HD];
#pragma unroll
        for (int e = 0; e < HD; ++e) qf[e] = bf2f(q[e]);
        const int nk = isA ? 387 : 257;
        float mx = -1e30f;
        for (int i = lane; i < nk; i += 64) {
            int rel;
            if (isA) { const int br = i / 129, j = i % 129 - 64; rel = j * (br == 0 ? 1 : br == 1 ? 4 : 16); } else rel = i - 128;
            const int tk = t + rel; float lg = -1e30f;
            if (tk >= 0 && tk < S) { float d = 0.f; const bf16_t* kr = k + (size_t)tk * HD;
#pragma unroll
                for (int e = 0; e < HD; ++e) d += qf[e] * bf2f(kr[e]);
                lg = d + a.rel_bias[t5_bucket(rel) * 16 + head] * LOG2E; }
            pl[i] = lg; kl[i] = tk; mx = fmaxf(mx, lg);
        }
#pragma unroll
        for (int o = 1; o < 64; o <<= 1) mx = fmaxf(mx, pg8::shx(mx, lane, o));
        float sinkl = 0.f;
        if (!isA) { sinkl = a.sink[head - 8] * LOG2E; mx = fmaxf(mx, sinkl); }
        float sum = 0.f;
        for (int i = lane; i < nk; i += 64) { const float lg = pl[i]; const float pv = lg > -1e29f ? exp2f(lg - mx) : 0.f; pl[i] = pv; sum += pv; }
#pragma unroll
        for (int o = 1; o < 64; o <<= 1) sum += pg8::shx(sum, lane, o);
        if (!isA) sum += exp2f(sinkl - mx);
        asm volatile("s_waitcnt lgkmcnt(0)" ::: "memory");
        float acc = 0.f;
        for (int i = 0; i < nk; ++i) { const float pv = pl[i]; if (pv != 0.f) acc += pv * bf2f(v[(size_t)kl[i] * HD + lane]); }
        a.o[((size_t)b * S + t) * D + head * HD + lane] = f2bf(acc / sum);
    }
}

namespace att {
typedef short bf16x8 __attribute__((ext_vector_type(8)));
typedef short s16x4 __attribute__((ext_vector_type(4)));
typedef short v4i16_t __attribute__((ext_vector_type(4)));
typedef float f32x16 __attribute__((ext_vector_type(16)));
typedef unsigned u32x4 __attribute__((ext_vector_type(4)));
typedef float f32x2_t __attribute__((ext_vector_type(2))); typedef __bf16 bf16x2_t __attribute__((ext_vector_type(2)));
constexpr float NEG = -1e30f;
constexpr int WAVE_LDS = 8704, LUT_OFF = 0, WAVES_OFF = 8192, LUTA_STRIDE = 200, LUTB_STRIDE = 328, LUTB_OFF = LUT_OFF + 3 * LUTA_STRIDE * 4, TAB_OFF = WAVES_OFF + 8 * WAVE_LDS, LSE_OFF = TAB_OFF + 65536, ATT_LDS_END = LSE_OFF + 2048;
static_assert(LUTB_OFF + 4 * LUTB_STRIDE * 4 <= WAVES_OFF && ATT_LDS_END <= 147456 - 64, "attention LDS map");
__device__ __forceinline__ int crow(int r, int hi) { return (r & 3) + 8 * (r >> 2) + 4 * hi; }
__device__ __forceinline__ unsigned cvtpk(float lo, float hi) { f32x2_t v = {lo, hi}; bf16x2_t b = __builtin_convertvector(v, bf16x2_t); return __builtin_bit_cast(unsigned, b); }
__device__ __forceinline__ s16x4 vtr(const LAS unsigned char* p) { return __builtin_bit_cast(s16x4, __builtin_amdgcn_ds_read_tr16_b64_v4i16((LAS v4i16_t*)p)); }
__device__ __forceinline__ float halfmax(float v) { auto rr = __builtin_amdgcn_permlane32_swap(__float_as_uint(v), __float_as_uint(v), false, false); return fmaxf(__uint_as_float(rr[0]), __uint_as_float(rr[1])); }
__device__ __forceinline__ float halfsum(float v) { auto rr = __builtin_amdgcn_permlane32_swap(__float_as_uint(v), __float_as_uint(v), false, false); return __uint_as_float(rr[0]) + __uint_as_float(rr[1]); }

__device__ __forceinline__ void bias_add(f32x16& p, const LAS float* lut, const int j, const int i, const int hi) {
    const LAS float* lp = lut + 32 * j - i + 4 * hi;
#pragma unroll
    for (int r = 0; r < 16; ++r) p[r] += lp[(r & 3) + 8 * (r >> 2)];
}
template <int NT>
__device__ __forceinline__ void qtile(const bf16_t* qrow, const bf16_t* kbase, const bf16_t* vbase, int tk0, int dstep, const LAS float* lut, float m0, float l0,
                                      LAS unsigned char* wl, int lane_in, f32x16 (&o)[2], float& m_out, float& l_out) {
    int lane = lane_in; asm volatile("" : "+v"(lane));
    const int i = lane & 31, hi = lane >> 5;
    LAS float* wsf = (LAS float*)(wl + 8192);
    constexpr int C = NT / 2;
    bf16x8 qf[4];
#pragma unroll
    for (int ks = 0; ks < 4; ++ks) qf[ks] = *(const bf16x8*)(qrow + 16 * ks + 8 * hi);
    const int vrow = lane >> 3, vsw = (lane & 7) ^ (((lane >> 4) & 1) << 2);
    const int rd_base = (4 * hi + ((lane & 15) >> 2)) * 128 + 32 * ((lane >> 4) & 1) + 8 * (lane & 3);
    const int bit3 = (lane >> 3) & 1;
    const int vb0 = rd_base + 64 * bit3, vb1 = rd_base + 64 * (1 - bit3);
    bf16x8 kf[4];
#define ATT_LOAD(j, buf) do { \
        { int tk = tk0 + (32 * (j) + i) * dstep; tk = tk < 0 ? 0 : (tk > S - 1 ? S - 1 : tk); const bf16_t* kp = kbase + (size_t)tk * HD + 8 * hi; \
          _Pragma("unroll") for (int ks = 0; ks < 4; ++ks) kf[ks] = *(const bf16x8*)(kp + 16 * ks); } \
        _Pragma("unroll") for (int i4 = 0; i4 < 4; ++i4) { int tk = tk0 + (32 * (j) + vrow + 8 * i4) * dstep; tk = tk < 0 ? 0 : (tk > S - 1 ? S - 1 : tk); \
          __builtin_amdgcn_global_load_lds((const unsigned*)(vbase + (size_t)tk * HD + 8 * vsw), (LAS unsigned*)(wl + (buf) * 4096 + i4 * 1024), 16, 0, 0); } } while (0)
    float m = m0, l = hi == 0 ? l0 : 0.f;
    o[0] = f32x16{}; o[1] = f32x16{};
    ATT_LOAD(C, 0);
#pragma unroll 1
    for (int s = 0; s < NT; ++s) {
        const int j = (s == 0) ? C : (s <= C ? s - 1 : s);
        LAS unsigned char* vbuf = wl + (s & 1) * 4096;
        asm volatile("s_waitcnt vmcnt(0)" ::: "memory");
        f32x16 p = __builtin_amdgcn_mfma_f32_32x32x16_bf16(kf[0], qf[0], f32x16{}, 0, 0, 0);
        p = __builtin_amdgcn_mfma_f32_32x32x16_bf16(kf[1], qf[1], p, 0, 0, 0);
        p = __builtin_amdgcn_mfma_f32_32x32x16_bf16(kf[2], qf[2], p, 0, 0, 0);
        p = __builtin_amdgcn_mfma_f32_32x32x16_bf16(kf[3], qf[3], p, 0, 0, 0);
        bias_add(p, lut, j, i, hi);
        if (s + 1 < NT) { const int jn = (s + 1 <= C) ? s : s + 1; ATT_LOAD(jn, (s + 1) & 1); }
        const int first = tk0 + 32 * j * dstep, lastk = first + 31 * dstep;
        const bool inside = first >= 0 && lastk < S;
        if (!inside) {
#pragma unroll
            for (int r = 0; r < 16; ++r) { const int tk = first + crow(r, hi) * dstep; if ((unsigned)tk >= (unsigned)S) p[r] = NEG; }
        }
        float rm = p[0];
#pragma unroll
        for (int r = 1; r < 16; ++r) rm = fmaxf(rm, p[r]);
        rm = halfmax(rm);
        if (__any(rm > m)) {
            const float mn = fmaxf(m, rm), alpha = __builtin_amdgcn_exp2f(m - mn);
            l *= alpha; m = mn;
            if (hi == 0) wsf[i] = alpha;
#pragma unroll
            for (int r = 0; r < 16; ++r) { const float a = wsf[crow(r, hi)]; o[0][r] *= a; o[1][r] *= a; }
        }
        f32x2_t rs2 = {0.f, 0.f}; const f32x2_t nm2 = {-m, -m};
#pragma unroll
        for (int r = 0; r < 16; r += 2) { f32x2_t t = (f32x2_t){p[r], p[r + 1]} + nm2; t.x = __builtin_amdgcn_exp2f(t.x); t.y = __builtin_amdgcn_exp2f(t.y); p[r] = t.x; p[r + 1] = t.y; rs2 += t; }
        l += rs2.x + rs2.y;
        u32x4 pw0 = {cvtpk(p[0], p[1]), cvtpk(p[2], p[3]), cvtpk(p[4], p[5]), cvtpk(p[6], p[7])};
        u32x4 pw1 = {cvtpk(p[8], p[9]), cvtpk(p[10], p[11]), cvtpk(p[12], p[13]), cvtpk(p[14], p[15])};
        const bf16x8 pa0 = __builtin_bit_cast(bf16x8, pw0), pa1 = __builtin_bit_cast(bf16x8, pw1);
#pragma unroll
        for (int d0 = 0; d0 < 2; ++d0) {
            const unsigned vp = (unsigned)(uintptr_t)(vbuf + (d0 == 0 ? vb0 : vb1));
            s16x4 a0, a1, b0, b1;
            asm volatile("ds_read_b64_tr_b16 %0, %1" : "=&v"(a0) : "v"(vp) : "memory");
            asm volatile("ds_read_b64_tr_b16 %0, %1 offset:1024" : "=&v"(a1) : "v"(vp) : "memory");
            asm volatile("ds_read_b64_tr_b16 %0, %1 offset:2048" : "=&v"(b0) : "v"(vp) : "memory");
            asm volatile("ds_read_b64_tr_b16 %0, %1 offset:3072" : "=&v"(b1) : "v"(vp) : "memory");
            asm volatile("s_waitcnt lgkmcnt(0)" : "+v"(a0), "+v"(a1), "+v"(b0), "+v"(b1) :: "memory"); __builtin_amdgcn_sched_barrier(0);
            const bf16x8 f0 = {a0[0], a0[1], a0[2], a0[3], a1[0], a1[1], a1[2], a1[3]}, f1 = {b0[0], b0[1], b0[2], b0[3], b1[0], b1[1], b1[2], b1[3]};
            o[d0] = __builtin_amdgcn_mfma_f32_32x32x16_bf16(pa0, f0, o[d0], 0, 0, 0);
            o[d0] = __builtin_amdgcn_mfma_f32_32x32x16_bf16(pa1, f1, o[d0], 0, 0, 0);
        }
    }
#undef ATT_LOAD
    m_out = m; l_out = halfsum(l);
}

constexpr float MLOW = -1.0e4f;
constexpr float THR = 8.0f;
template <int NT>
__device__ __forceinline__ void sm_tile(f32x16& p, const LAS float* lut, const int j, const int i, const int hi, const int first, const int dstep, const bool inside,
                                        float& m, float& l, f32x16 (&o)[2], LAS float* wsf, bf16x8& pa0, bf16x8& pa1) {
    if (!inside) {
#pragma unroll
        for (int r = 0; r < 16; ++r) { const int tk = first + crow(r, hi) * dstep; if ((unsigned)tk >= (unsigned)S) p[r] = NEG; }
    }
    float rm = fmaxf(p[0], p[1]);
#pragma unroll
    for (int r = 2; r < 16; ++r) rm = fmaxf(rm, p[r]);
    rm = halfmax(rm);
    if (__any(rm > m + THR)) {
        const float mn = fmaxf(m, rm), alpha = __builtin_amdgcn_exp2f(m - mn);
        l *= alpha; m = mn;
        if (hi == 0) wsf[i] = alpha;
#pragma unroll
        for (int r = 0; r < 16; ++r) { const float a = wsf[crow(r, hi)]; o[0][r] *= a; o[1][r] *= a; }
    }
    f32x2_t rs2 = {0.f, 0.f}; const f32x2_t nm2 = {-m, -m};
#pragma unroll
    for (int r = 0; r < 16; r += 2) { f32x2_t t = (f32x2_t){p[r], p[r + 1]} + nm2; t.x = __builtin_amdgcn_exp2f(t.x); t.y = __builtin_amdgcn_exp2f(t.y); p[r] = t.x; p[r + 1] = t.y; rs2 += t; }
    l += rs2.x + rs2.y;
    u32x4 pw0 = {cvtpk(p[0], p[1]), cvtpk(p[2], p[3]), cvtpk(p[4], p[5]), cvtpk(p[6], p[7])};
    u32x4 pw1 = {cvtpk(p[8], p[9]), cvtpk(p[10], p[11]), cvtpk(p[12], p[13]), cvtpk(p[14], p[15])};
    pa0 = __builtin_bit_cast(bf16x8, pw0); pa1 = __builtin_bit_cast(bf16x8, pw1);
}
template <int NT, int SHIFT>
__device__ __forceinline__ void qtile2(const bf16_t* qrow0, const bf16_t* qrow1, const bf16_t* kbase, const bf16_t* vbase, int tk0, int dstep, const LAS float* lut0, const LAS float* lut1,
                                       float mi0, float li0, float mi1, float li1, LAS unsigned char* wl, int lane_in,
                                       f32x16 (&o0)[2], float& m0_out, float& l0_out, f32x16 (&o1)[2], float& m1_out, float& l1_out) {
    int lane = lane_in; asm volatile("" : "+v"(lane));
    const int i = lane & 31, hi = lane >> 5;
    LAS float* wsf = (LAS float*)(wl + 8192);
    bf16x8 qf0[4], qf1[4];
#pragma unroll
    for (int ks = 0; ks < 4; ++ks) { qf0[ks] = *(const bf16x8*)(qrow0 + 16 * ks + 8 * hi); qf1[ks] = *(const bf16x8*)(qrow1 + 16 * ks + 8 * hi); }
    const int vrow = lane >> 3, vsw = (lane & 7) ^ (((lane >> 4) & 1) << 2);
    const int rd_base = (4 * hi + ((lane & 15) >> 2)) * 128 + 32 * ((lane >> 4) & 1) + 8 * (lane & 3);
    const int bit3 = (lane >> 3) & 1;
    const int vb0 = rd_base + 64 * bit3, vb1 = rd_base + 64 * (1 - bit3);
    bf16x8 kf[4];
#define ATT_LOAD(j, buf) do { \
        { int tk = tk0 + (32 * (j) + i) * dstep; tk = tk < 0 ? 0 : (tk > S - 1 ? S - 1 : tk); const bf16_t* kp = kbase + (size_t)tk * HD + 8 * hi; \
          _Pragma("unroll") for (int ks = 0; ks < 4; ++ks) kf[ks] = *(const bf16x8*)(kp + 16 * ks); } \
        _Pragma("unroll") for (int i4 = 0; i4 < 4; ++i4) { int tk = tk0 + (32 * (j) + vrow + 8 * i4) * dstep; tk = tk < 0 ? 0 : (tk > S - 1 ? S - 1 : tk); \
          __builtin_amdgcn_global_load_lds((const unsigned*)(vbase + (size_t)tk * HD + 8 * vsw), (LAS unsigned*)(wl + (buf) * 4096 + i4 * 1024), 16, 0, 0); } } while (0)
    float m0 = mi0, l0 = hi == 0 ? li0 : 0.f, m1 = mi1, l1 = hi == 0 ? li1 : 0.f;
    o0[0] = f32x16{}; o0[1] = f32x16{}; o1[0] = f32x16{}; o1[1] = f32x16{};
    ATT_LOAD(0, 0);
#pragma unroll 1
    for (int jj = 0; jj < NT + SHIFT; ++jj) {
        LAS unsigned char* vbuf = wl + (jj & 1) * 4096;
        const bool a0 = jj < NT, a1 = jj >= SHIFT;
        const int first = tk0 + 32 * jj * dstep, lastk = first + 31 * dstep;
        const bool inside = first >= 0 && lastk < S;
        asm volatile("s_waitcnt vmcnt(0)" ::: "memory");
        f32x16 p0, p1;
        bf16x8 pa00, pa01, pa10, pa11;
        {
            if (a0) {
                p0 = __builtin_amdgcn_mfma_f32_32x32x16_bf16(kf[0], qf0[0], f32x16{}, 0, 0, 0);
#pragma unroll
                for (int ks = 1; ks < 4; ++ks) p0 = __builtin_amdgcn_mfma_f32_32x32x16_bf16(kf[ks], qf0[ks], p0, 0, 0, 0);
            }
            if (a1) {
                p1 = __builtin_amdgcn_mfma_f32_32x32x16_bf16(kf[0], qf1[0], f32x16{}, 0, 0, 0);
#pragma unroll
                for (int ks = 1; ks < 4; ++ks) p1 = __builtin_amdgcn_mfma_f32_32x32x16_bf16(kf[ks], qf1[ks], p1, 0, 0, 0);
            }
        }
        if (a0) bias_add(p0, lut0, jj, i, hi);
        if (a1) bias_add(p1, lut1, jj - SHIFT, i, hi);
        if (jj + 1 < NT + SHIFT) ATT_LOAD(jj + 1, (jj + 1) & 1);
        {
            if (a0) sm_tile<NT>(p0, lut0, jj, i, hi, first, dstep, inside, m0, l0, o0, wsf, pa00, pa01);
            if (a1) sm_tile<NT>(p1, lut1, jj - SHIFT, i, hi, first, dstep, inside, m1, l1, o1, wsf, pa10, pa11);
#pragma unroll
            for (int d0 = 0; d0 < 2; ++d0) {
                const unsigned vp = (unsigned)(uintptr_t)(vbuf + (d0 == 0 ? vb0 : vb1));
                s16x4 x0, x1, y0, y1;
                asm volatile("ds_read_b64_tr_b16 %0, %1" : "=&v"(x0) : "v"(vp) : "memory");
                asm volatile("ds_read_b64_tr_b16 %0, %1 offset:1024" : "=&v"(x1) : "v"(vp) : "memory");
                asm volatile("ds_read_b64_tr_b16 %0, %1 offset:2048" : "=&v"(y0) : "v"(vp) : "memory");
                asm volatile("ds_read_b64_tr_b16 %0, %1 offset:3072" : "=&v"(y1) : "v"(vp) : "memory");
                asm volatile("s_waitcnt lgkmcnt(0)" : "+v"(x0), "+v"(x1), "+v"(y0), "+v"(y1) :: "memory"); __builtin_amdgcn_sched_barrier(0);
                const bf16x8 f0 = {x0[0], x0[1], x0[2], x0[3], x1[0], x1[1], x1[2], x1[3]}, f1 = {y0[0], y0[1], y0[2], y0[3], y1[0], y1[1], y1[2], y1[3]};
                if (a0) { o0[d0] = __builtin_amdgcn_mfma_f32_32x32x16_bf16(pa00, f0, o0[d0], 0, 0, 0); o0[d0] = __builtin_amdgcn_mfma_f32_32x32x16_bf16(pa01, f1, o0[d0], 0, 0, 0); }
                if (a1) { o1[d0] = __builtin_amdgcn_mfma_f32_32x32x16_bf16(pa10, f0, o1[d0], 0, 0, 0); o1[d0] = __builtin_amdgcn_mfma_f32_32x32x16_bf16(pa11, f1, o1[d0], 0, 0, 0); }
            }
        }
    }
#undef ATT_LOAD
    m0_out = m0; l0_out = halfsum(l0); m1_out = m1; l1_out = halfsum(l1);
}

__device__ __forceinline__ void stage_o(const f32x16 (&o)[2], float m, float l, LAS unsigned char* wl, int lane_in) {
    int lane = lane_in; asm volatile("" : "+v"(lane));
    const int i = lane & 31, hi = lane >> 5;
    LAS float* wsf = (LAS float*)(wl + 8192);
    if (hi == 0) { wsf[i] = __builtin_amdgcn_rcpf(l); wsf[32 + i] = m + __builtin_amdgcn_logf(l); }
    LAS bf16_t* stg = (LAS bf16_t*)wl;
#pragma unroll
    for (int r = 0; r < 16; ++r) { const int q = crow(r, hi); const float inv = wsf[q];
        stg[q * 64 + i] = (bf16_t)(cvtpk(o[0][r] * inv, 0.f) & 0xffffu); stg[q * 64 + 32 + i] = (bf16_t)(cvtpk(o[1][r] * inv, 0.f) & 0xffffu); }
}
__device__ __forceinline__ float bflo(unsigned w) { return __uint_as_float(w << 16); }
__device__ __forceinline__ float bfhi(unsigned w) { return __uint_as_float(w & 0xffff0000u); }
__device__ __forceinline__ unsigned mix2(unsigned a, unsigned b, float wa, float wb) { return cvtpk(wa * bflo(a) + wb * bflo(b), wa * bfhi(a) + wb * bfhi(b)); }

struct Tensors { const bf16_t *qa, *ka, *va, *qb, *kb, *vb; const float* rel_bias; const float* sink; bf16_t* o; };
__device__ __forceinline__ void finish_a(const f32x16 (&o)[2], float m, float l, int pass, int d, int lam0, int rr, LAS unsigned char* wl, LAS unsigned char* tab, LAS float* lsetab, bf16_t* orow0, int lane_in) {
    LAS float* wsf = (LAS float*)(wl + 8192);
    stage_o(o, m, l, wl, lane_in);
    int lane = lane_in; asm volatile("" : "+v"(lane));
#pragma unroll
    for (int i4 = 0; i4 < 4; ++i4) {
        const int qi = (lane >> 3) + 8 * i4, ch = lane & 7, tau = d * (lam0 + qi) + rr;
        u32x4 v = *(const LAS u32x4*)(wl + qi * 128 + ch * 16);
        const float Lb = wsf[32 + qi];
        LAS u32x4* te = (LAS u32x4*)(tab + tau * 128 + ch * 16);
        if (pass == 0) { *te = v; if (ch == 0) lsetab[tau] = Lb; }
        else {
            const u32x4 tv = *te; const float La = lsetab[tau];
            const float Lm = fmaxf(La, Lb), sa = __builtin_amdgcn_exp2f(La - Lm), sb = __builtin_amdgcn_exp2f(Lb - Lm), tot = sa + sb, rt = __builtin_amdgcn_rcpf(tot), wa = sa * rt, wb = sb * rt;
            u32x4 w; w.x = mix2(tv.x, v.x, wa, wb); w.y = mix2(tv.y, v.y, wa, wb); w.z = mix2(tv.z, v.z, wa, wb); w.w = mix2(tv.w, v.w, wa, wb);
            if (pass == 1) { *te = w; if (ch == 0) lsetab[tau] = Lm + __builtin_amdgcn_logf(tot); }
            else *(u32x4*)(orow0 + (size_t)tau * D + ch * 8) = w;
        }
    }
}


__device__ __forceinline__ int bucket(int rel) {
    const int n = rel < 0 ? -rel : rel; const int ret = rel > 0 ? 16 : 0;
    if (n < 8) return ret + n;
    int large = 8 + (int)(logf((float)n / 8.0f) / 4.852030263919617f * 8.0f);
    large = large < 15 ? large : 15;
    return ret + large;
}

__device__ __forceinline__ void attn_unit(const Tensors& T, int u, LAS unsigned char* lds, int wave, int lane) {
    LAS unsigned char* wl = lds + WAVES_OFF + wave * WAVE_LDS;
    LAS float* wsf = (LAS float*)(wl + 8192);
    LAS float* lutA = (LAS float*)(lds + LUT_OFF); LAS float* lutB = (LAS float*)(lds + LUTB_OFF);
    LAS unsigned char* tab = lds + TAB_OFF; LAS float* lsetab = (LAS float*)(lds + LSE_OFF);
    const int tid = wave * 64 + lane;
    const int i = lane & 31;
    {
        const int bh = u >> 3, blk = u & 7, b = bh >> 3, h = bh & 7, t0 = blk * 512;
        const bf16_t* qbase = T.qa + (size_t)bh * S * HD; const bf16_t* kbase = T.ka + (size_t)bh * S * HD; const bf16_t* vbase = T.va + (size_t)bh * S * HD;
        __syncthreads();
        for (int e = tid; e < 3 * 193; e += 512) { const int c = e / 193, idx = e % 193 - 32, d = c == 0 ? 1 : (c == 1 ? 4 : 16);
            lutA[c * LUTA_STRIDE + 32 + idx] = (idx < 0 || idx > 128) ? NEG : T.rel_bias[bucket((idx - 64) * d) * 16 + h] * LOG2E; }
        __syncthreads();
        bf16_t* orow0 = T.o + ((size_t)b * S + t0) * D + h * HD;
#pragma unroll 1
        for (int pass = 0; pass < 3; ++pass) {
            const int c = 2 - pass, d = c == 0 ? 1 : (c == 1 ? 4 : 16);
            const LAS float* lt = lutA + c * LUTA_STRIDE + 32;
            if (c == 2) {
#pragma unroll 1
                for (int tt = 0; tt < 2; ++tt) { const int rr = 2 * wave + tt;
                    f32x16 o1[2]; float m1, l1;
                    qtile<5>(qbase + (size_t)(t0 + d * i + rr) * HD, kbase, vbase, t0 - 64 * d + rr, d, lt, NEG, 0.f, wl, lane, o1, m1, l1);
                    finish_a(o1, m1, l1, pass, d, 0, rr, wl, tab, lsetab, orow0, lane); }
            } else {
                const int Tq = 2 * wave, rr = c == 1 ? (Tq >> 2) : 0, lamA = 32 * (c == 1 ? (Tq & 3) : Tq);
                f32x16 oA[2], oB[2]; float mA, lA, mB, lB;
                qtile2<5, 1>(qbase + (size_t)(t0 + d * (lamA + i) + rr) * HD, qbase + (size_t)(t0 + d * (lamA + 32 + i) + rr) * HD, kbase, vbase, t0 + d * (lamA - 64) + rr, d, lt, lt,
                             MLOW, 0.f, MLOW, 0.f, wl, lane, oA, mA, lA, oB, mB, lB);
                finish_a(oA, mA, lA, pass, d, lamA, rr, wl, tab, lsetab, orow0, lane);
                finish_a(oB, mB, lB, pass, d, lamA + 32, rr, wl, tab, lsetab, orow0, lane);
            }
            __syncthreads();
        }
    }
    {
        const int bk = u >> 5, blk = u & 31, b = bk >> 1, hk = bk & 1, t0 = blk * 128;
        const bf16_t* kbase = T.kb + (size_t)bk * S * HD; const bf16_t* vbase = T.vb + (size_t)bk * S * HD;
        for (int e = tid; e < 4 * 321; e += 512) { const int g = e / 321, idx = e % 321 - 32;
            lutB[g * LUTB_STRIDE + 32 + idx] = (idx < 0 || idx > 256) ? NEG : T.rel_bias[bucket(idx - 128) * 16 + 8 + 4 * hk + g] * LOG2E; }
        __syncthreads();
        const int qt = wave & 3, g0 = 2 * (wave >> 2), hq0 = 4 * hk + g0;
        const int tq = t0 + 32 * qt + i, tk0 = t0 + 32 * qt - 128;
        f32x16 oA[2], oB[2]; float mA, lA, mB, lB;
        qtile2<9, 0>(T.qb + (((size_t)b * 8 + hq0) * S + tq) * HD, T.qb + (((size_t)b * 8 + hq0 + 1) * S + tq) * HD, kbase, vbase, tk0, 1,
                     lutB + g0 * LUTB_STRIDE + 32, lutB + (g0 + 1) * LUTB_STRIDE + 32, T.sink[hq0] * LOG2E, 1.0f, T.sink[hq0 + 1] * LOG2E, 1.0f, wl, lane, oA, mA, lA, oB, mB, lB);
        bf16_t* ob0 = T.o + ((size_t)b * S + t0 + 32 * qt) * D + (8 + hq0) * HD;
        stage_o(oA, mA, lA, wl, lane);
#pragma unroll
        for (int i4 = 0; i4 < 4; ++i4) { const int qi = (lane >> 3) + 8 * i4, ch = lane & 7; *(u32x4*)(ob0 + (size_t)qi * D + ch * 8) = *(const LAS u32x4*)(wl + qi * 128 + ch * 16); }
        stage_o(oB, mB, lB, wl, lane);
#pragma unroll
        for (int i4 = 0; i4 < 4; ++i4) { const int qi = (lane >> 3) + 8 * i4, ch = lane & 7; *(u32x4*)(ob0 + HD + (size_t)qi * D + ch * 8) = *(const LAS u32x4*)(wl + qi * 128 + ch * 16); }
    }
}
}

#define XB_TMO      128
#define XB_XCNT(j)  (256  + 64 * (j))
#define XB_XSUB(j)  (1280 + 64 * (j))
#define XB_XGEN(j)  (2304 + 64 * (j))
#define XB_TOP      3328
#define XB_TOPGEN   3392
#define XCD_BAR_WORDS 3456
#define XB_SPIN_CAP (1u << 18)

__device__ __forceinline__ unsigned xb_ld(unsigned* p)              { return __hip_atomic_load(p, __ATOMIC_RELAXED, __HIP_MEMORY_SCOPE_AGENT); }
__device__ __forceinline__ unsigned xb_add(unsigned* p, unsigned v) { return __hip_atomic_fetch_add(p, v, __ATOMIC_RELAXED, __HIP_MEMORY_SCOPE_AGENT); }
__device__ __forceinline__ unsigned xb_xcc_id() { return (unsigned)__builtin_amdgcn_s_getreg((3 << 11) | 20) & 0xFu; }
#define XB_SPIN(cond, bar) do { unsigned _sp = 0; while (cond) { __builtin_amdgcn_s_sleep(1); \
    if ((++_sp & 255u) == 0u) { if (xb_ld(&(bar)[XB_TMO])) break; if (_sp > XB_SPIN_CAP) { atomicAdd(&(bar)[XB_TMO], 1u); break; } } } } while (0)

struct XcdBarrier {
    unsigned* bar; unsigned x;
    volatile LAS unsigned* st;
};

__device__ __forceinline__ XcdBarrier xcd_barrier_post(unsigned* bar, volatile LAS unsigned* st) {
    XcdBarrier b; b.bar = bar; b.x = xb_xcc_id(); b.st = st;
    if (threadIdx.x == 0) (void)xb_add(&bar[XB_XCNT(b.x)], 1u);
    return b;
}
__device__ __forceinline__ void xcd_barrier_complete(unsigned* bar, unsigned x, unsigned& nloc, unsigned& nx) {
    const unsigned G = gridDim.x * gridDim.y * gridDim.z;
    unsigned sum, cnt, mine, sp = 0u;
    for (;;) {
        sum = 0u; cnt = 0u; mine = 0u;
#pragma unroll
        for (unsigned j = 0; j < 16; ++j) { const unsigned c = xb_ld(&bar[XB_XCNT(j)]); sum += c; cnt += (c > 0u) ? 1u : 0u; mine = (j == x) ? c : mine; }
        if (sum == G) break;
        __builtin_amdgcn_s_sleep(1);
        if ((++sp & 255u) == 0u) { if (xb_ld(&bar[XB_TMO])) break; if (sp > XB_SPIN_CAP) { atomicAdd(&bar[XB_TMO], 1u); break; } }
    }
    nloc = mine > 0u ? mine : 1u; nx = cnt > 0u ? cnt : 1u;
}

__device__ __forceinline__ void xcd_barrier(const XcdBarrier& b, const bool is_t0) {
    asm volatile("s_waitcnt vmcnt(0)" ::: "memory");
    __syncthreads();
    if (is_t0) {
        unsigned* bar = b.bar;
        __builtin_amdgcn_s_waitcnt(0);
        unsigned nloc = b.st[0], nx = b.st[1];
        if (nloc == 0u) { xcd_barrier_complete(bar, b.x, nloc, nx); b.st[0] = nloc; b.st[1] = nx; }
        const unsigned old = xb_add(&bar[XB_XSUB(b.x)], 1u);
        const unsigned gen = old / nloc;
        if (old + 1u == (gen + 1u) * nloc) {
            __builtin_amdgcn_fence(__ATOMIC_RELEASE, "agent");
            asm volatile("s_waitcnt vmcnt(0)" ::: "memory");
            const unsigned og = xb_add(&bar[XB_TOP], 1u);
            const unsigned tg = og / nx;
            if (og + 1u == (tg + 1u) * nx) xb_add(&bar[XB_TOPGEN], 1u);
            else XB_SPIN(xb_ld(&bar[XB_TOPGEN]) == tg, bar);
            __builtin_amdgcn_fence(__ATOMIC_ACQUIRE, "agent");
            xb_add(&bar[XB_XGEN(b.x)], 1u);
            asm volatile("s_waitcnt vmcnt(0)" ::: "memory");
        } else {
            XB_SPIN(xb_ld(&bar[XB_XGEN(b.x)]) == gen, bar);
            __builtin_amdgcn_fence(__ATOMIC_ACQUIRE, "agent");
            asm volatile("s_waitcnt vmcnt(0)" ::: "memory");
        }
    }
    __syncthreads();
}
typedef const float* cfptr_t; typedef float* fptr_t; typedef unsigned char* ucptr_t;
typedef __attribute__((address_space(4))) const unsigned char* kargp_t;
struct KA {
    kargp_t kp;
    __device__ __forceinline__ const float* in(int i) const { return *(__attribute__((address_space(4))) const cfptr_t*)(kp + 8 * i); }
    __device__ __forceinline__ float* out() const { return *(__attribute__((address_space(4))) const fptr_t*)(kp + 160); }
    __device__ __forceinline__ unsigned char* ws() const { return *(__attribute__((address_space(4))) const ucptr_t*)(kp + 168); }
    __device__ __forceinline__ int ph_lo() const { return *(__attribute__((address_space(4))) const int*)(kp + 176); }
    __device__ __forceinline__ int ph_hi() const { return *(__attribute__((address_space(4))) const int*)(kp + 180); }
};
static_assert(sizeof(Args) == 184, "Args layout");
#define FRESH_LANE() ({ int l_; asm volatile("v_mbcnt_lo_u32_b32 %0, -1, 0\n\tv_mbcnt_hi_u32_b32 %0, -1, %0" : "=v"(l_)); l_; })
template <int PH>
__device__ __forceinline__ void run_phase(const KA& a, LAS unsigned char* lds, const int wave0, const int rep) {
    const int G = gridDim.x, bx = blockIdx.x, wave = wave0;
    const int vcu = (G % 8 == 0) ? (bx % 8) * (G / 8) + bx / 8 : bx;
    const int gw = vcu * NWAVES + wave, NGW = G * NWAVES;
    unsigned char* ws = a.ws();
    bf16_t* xb = (bf16_t*)(ws + WS_XB); float* ssp0 = (float*)(ws + WS_SSP); float* ssp1 = ssp0 + (size_t)M * 16;
    bf16_t* xb2 = (bf16_t*)(ws + WS_W);
    bf16_t* act = (bf16_t*)(ws + WS_R + R_ACT); bf16_t* ob = (bf16_t*)(ws + WS_R + R_O);
    bf16_t* pb = (bf16_t*)(ws + WS_PB); bf16_t* proj = (bf16_t*)(ws + WS_PROJ);
    const float cscale = rep == 0 ? 1.0f : 0.0f;
    if constexpr (PH == 0) {
        prologue_phase(a, lds, gw, NGW, wave, FRESH_LANE(), G == 256);
        convert_p(a.in(1), pb, bx * NWAVES * 64 + wave0 * 64 + FRESH_LANE(), G * NWAVES * 64);
    } else {
        constexpr int l = (PH - 1) >> 3, k = (PH - 1) & 7;
        const bf16_t* wl = (const bf16_t*)(ws + WS_W) + (size_t)l * W_LAYER;
        bf16_t* lo_def = (bf16_t*)a.out(); bf16_t* lo_alt = xb2;
        const bf16_t* lin = (l == DEPTH - 1 && k == 7) ? lo_alt : lo_def; bf16_t* lout = (l == DEPTH - 1 && k == 6) ? lo_alt : lo_def;
        if constexpr (k == 0 || k == 5) {
            pg8::Gemm g{(k == 0 && l == 1) ? xb2 : xb, wl + (k == 0 ? WO_F1IN : WO_F2IN), M, 2 * DFF, D}; pg8::StaticOrder S; S.init(M, 2 * DFF, G, bx);
#if PROBE_NULL_EPI == 1
            if (rep > 0) { pg8::EpiNull E; pg8::gemm_phase<pg8::EpiNull, pg8::StaticOrder, true, true>(lds, g, S, E, wave0 * 64 + FRESH_LANE()); } else
#endif
            { pg8::EpiSwiglu E{act, ssp0, (PROBE_NULL_EPI >= 2 && rep > 0 && rep < PROBE_N) ? PROBE_NULL_EPI - 1 : 0};
            pg8::gemm_phase<pg8::EpiSwiglu, pg8::StaticOrder, true, true>(lds, g, S, E, wave0 * 64 + FRESH_LANE()); }
            if (G == 256 && bx >= 128 && rep == 0) {
                const int widx = (bx - 128) * NWAVES + wave, nw = 128 * NWAVES, lane = FRESH_LANE();
                if constexpr (k == 0) { convert_weight_items(a, lds, l * I_LAYER + IT_FOUT1, IT_FIN2 - IT_FOUT1, widx, nw, wave, lane); convert_weight_items(a, lds, l * I_LAYER + IT_WP, I_WP, widx, nw, wave, lane); }
                else { convert_weight_items(a, lds, l * I_LAYER + IT_WG, I_SQ, widx, nw, wave, lane);
                       if (l + 1 < DEPTH) { convert_weight_items(a, lds, (l + 1) * I_LAYER + IT_FIN1, I_FIN, widx, nw, wave, lane);
                                            convert_p(a.in(1) + (size_t)(l + 1) * M * PLE, pb, widx * 64 + lane, nw * 64); } }
            }
        } else if constexpr (k == 1 || k == 6) {
            pg8::Gemm g{act, wl + (k == 1 ? WO_F1OUT : WO_F2OUT), M, D, DFF}; pg8::StaticOrder S; S.init(M, D, G, bx);
            pg8::EpiResid E{(k == 1 && l > 0 && rep == 0) ? xb2 : xb, lin, xb, lout, ssp1, 0.5f * cscale};
            pg8::gemm_phase<pg8::EpiResid, pg8::StaticOrder, true, true>(lds, g, S, E, wave0 * 64 + FRESH_LANE());
        } else if constexpr (k == 2) {
            { pg8::Gemm g{xb, wl + WO_QKV, M, QKVW, D}; pg8::StaticOrder S; S.init(M, QKVW, G, bx);
              pg8::EpiQkv E; E.ssp = ssp1;
              E.qa = (bf16_t*)(ws + WS_R + R_QA); E.ka = (bf16_t*)(ws + WS_R + R_KA); E.va = (bf16_t*)(ws + WS_R + R_VA);
              E.qb = (bf16_t*)(ws + WS_R + R_QB); E.kb = (bf16_t*)(ws + WS_R + R_KB); E.vb = (bf16_t*)(ws + WS_R + R_VB);
              E.qna = a.in(8) + l * HD; E.kna = a.in(9) + l * HD; E.qnb = a.in(10) + l * HD; E.knb = a.in(11) + l * HD;
              pg8::gemm_phase<pg8::EpiQkv, pg8::StaticOrder, true, true>(lds, g, S, E, wave0 * 64 + FRESH_LANE()); }
            if (G != 256 || bx >= 64) {
              pg8::Gemm g{pb, wl + WO_WP, M, D, PLE}; pg8::StaticOrder S; if (G == 256) S.init(M, D, 192, bx - 64); else S.init(M, D, G, bx);
              pg8::EpiStoreBf16 E{proj, D};
              pg8::gemm_phase<pg8::EpiStoreBf16, pg8::StaticOrder, true, true>(lds, g, S, E, wave0 * 64 + FRESH_LANE()); }
            if (G == 256 && bx >= 64 && rep == 0)
                convert_weight_items(a, lds, l * I_LAYER + IT_FIN2, IT_WG - IT_FIN2, (bx - 64) * NWAVES + wave, 192 * NWAVES, wave, FRESH_LANE());
        } else if constexpr (k == 3) {
            att::Tensors T; T.qa = (bf16_t*)(ws + WS_R + R_QA); T.ka = (bf16_t*)(ws + WS_R + R_KA); T.va = (bf16_t*)(ws + WS_R + R_VA);
            T.qb = (bf16_t*)(ws + WS_R + R_QB); T.kb = (bf16_t*)(ws + WS_R + R_KB); T.vb = (bf16_t*)(ws + WS_R + R_VB);
            T.rel_bias = a.in(2); T.sink = a.in(12) + l * 8; T.o = ob;
            const int lane = FRESH_LANE();
            for (int u = vcu; u < 256; u += G) att::attn_unit(T, u, lds, wave, lane);
        } else if constexpr (k == 4) {
            if (G != 256 && l + 1 < DEPTH) { convert_p(a.in(1) + (size_t)(l + 1) * M * PLE, pb, bx * NWAVES * 64 + wave0 * 64 + FRESH_LANE(), G * NWAVES * 64); asm volatile("s_waitcnt vmcnt(0)" ::: "memory"); }
            pg8::Gemm g{ob, wl + WO_WO, M, D, D}; pg8::StaticOrder S; S.init(M, D, G, bx);
            pg8::EpiResid E{xb, lin, xb, lout, ssp0, 1.0f * cscale};
            pg8::gemm_phase<pg8::EpiResid, pg8::StaticOrder, true, true>(lds, g, S, E, wave0 * 64 + FRESH_LANE());
        } else {
            pg8::Gemm g{xb, wl + WO_WG, M, D, D}; pg8::StaticOrder S; S.init(M, D, G, bx);
            pg8::EpiGate E{xb, lin, xb2, lout, (l == DEPTH - 1) ? a.out() : nullptr, ssp0, ssp1, proj, cscale};
            pg8::gemm_phase<pg8::EpiGate, pg8::StaticOrder, true, true>(lds, g, S, E, wave0 * 64 + FRESH_LANE());
        }
    }
}

__global__ void __launch_bounds__(NWAVES * 64, 2) mk_fwd(Args) {
    extern __shared__ __attribute__((aligned(16))) unsigned char lds_raw[];
    LAS unsigned char* lds = (LAS unsigned char*)lds_raw;
    cg::grid_group grid = cg::this_grid();
    const int wave0 = __builtin_amdgcn_readfirstlane(threadIdx.x >> 6);
    volatile LAS unsigned* bst = (volatile LAS unsigned*)((LAS unsigned char*)lds_raw + LDS_BYTES - 64);
    if (threadIdx.x < 2) bst[threadIdx.x] = 0u;
    __syncthreads();
    KA a; a.kp = (kargp_t)__builtin_amdgcn_kernarg_segment_ptr();
    const int ph_lo = a.ph_lo(), ph_hi = a.ph_hi();
    XcdBarrier xbar; xbar.bar = (unsigned*)(a.ws() + WS_CTL) + 4096; xbar.x = 0; xbar.st = bst;
    if (ph_hi - ph_lo > 1) xbar = xcd_barrier_post((unsigned*)(a.ws() + WS_CTL) + 4096, bst);
    if (ph_lo < 0) grid.sync();
#define MK_NREP(P) ((PROBE_N > 0 && (((P) == 0 && PROBE_K == 8) || ((P) > 0 && (((P) - 1) & 7) == PROBE_K))) ? 1 + PROBE_N : 1)
#define MK_PHASE(P) if (ph_lo <= (P) && (P) < ph_hi) { _Pragma("unroll 1") for (int rep = 0; rep < MK_NREP(P); ++rep) { asm volatile("" : "+s"(a.kp)); run_phase<(P)>(a, lds, wave0, rep); \
        if ((P) + 1 < ph_hi || rep + 1 < MK_NREP(P)) { if (USE_CG_SYNC && (P) == 0) grid.sync(); else xcd_barrier(xbar, wave0 == 0 && FRESH_LANE() == 0); } } }
    MK_PHASE(0) MK_PHASE(1) MK_PHASE(2) MK_PHASE(3) MK_PHASE(4) MK_PHASE(5) MK_PHASE(6) MK_PHASE(7) MK_PHASE(8)
    MK_PHASE(9) MK_PHASE(10) MK_PHASE(11) MK_PHASE(12) MK_PHASE(13) MK_PHASE(14) MK_PHASE(15) MK_PHASE(16)
    static_assert(NPHASE == 17, "phase program");
}

#ifndef FAST_MASK
#define FAST_MASK 0x1ffffu
#endif
extern "C" void kernel_launch(void* const* d_in, const int* in_sizes, int n_in, void* d_out, int out_size, void* d_ws, size_t ws_size, hipStream_t stream) {
    static int grid = 0;
    if (grid == 0) {
        if (n_in != 20 || in_sizes[0] != M * D || out_size != M * D || ws_size < WS_END) { fprintf(stderr, "kernel_launch: unexpected shapes (n_in %d, ws %zu)\n", n_in, ws_size); grid = -1; return; }
        int dev = 0, cus = 0, per_cu = 0;
        if (hipGetDevice(&dev) != hipSuccess || hipDeviceGetAttribute(&cus, hipDeviceAttributeMultiprocessorCount, dev) != hipSuccess) { grid = -1; return; }
        if (hipFuncSetAttribute((const void*)mk_fwd, hipFuncAttributeMaxDynamicSharedMemorySize, LDS_BYTES) != hipSuccess) { fprintf(stderr, "kernel_launch: hipFuncSetAttribute failed\n"); grid = -1; return; }
        if (hipOccupancyMaxActiveBlocksPerMultiprocessor(&per_cu, (const void*)mk_fwd, NWAVES * 64, LDS_BYTES) != hipSuccess || per_cu < 1) { fprintf(stderr, "kernel_launch: occupancy query says %d\n", per_cu); grid = -1; (void)hipGetLastError(); return; }
        grid = cus;
    }
    if (grid < 0) return;
    (void)hipMemsetAsync((char*)d_ws + WS_CTL, 0, 1 * MiB, stream);
    Args a{};
    for (int i = 0; i < 20; ++i) a.in[i] = (const float*)d_in[i];
    a.out = (float*)d_out; a.ws = (unsigned char*)d_ws;
    const unsigned fast = FAST_MASK;
    if (fast == 0x1ffffu) {
        a.ph_lo = 0; a.ph_hi = NPHASE;
        void* args[] = {&a};
        hipError_t e = hipLaunchCooperativeKernel((const void*)mk_fwd, dim3(grid), dim3(NWAVES * 64), args, LDS_BYTES, stream);
        if (e != hipSuccess) fprintf(stderr, "kernel_launch: cooperative launch failed: %s (grid %d)\n", hipGetErrorString(e), grid);
        return;
    }
    unsigned char* ws = (unsigned char*)d_ws; float* out = (float*)d_out;
    bf16_t* xb = (bf16_t*)(ws + WS_XB); bf16_t* xb2 = (bf16_t*)(ws + WS_W); float* ssp0 = (float*)(ws + WS_SSP); float* ssp1 = ssp0 + (size_t)M * 16;
    bf16_t* act = (bf16_t*)(ws + WS_R + R_ACT); bf16_t* ob = (bf16_t*)(ws + WS_R + R_O);
    QkvOut qo; qo.qa = (bf16_t*)(ws + WS_R + R_QA); qo.ka = (bf16_t*)(ws + WS_R + R_KA); qo.va = (bf16_t*)(ws + WS_R + R_VA);
    qo.qb = (bf16_t*)(ws + WS_R + R_QB); qo.kb = (bf16_t*)(ws + WS_R + R_KB); qo.vb = (bf16_t*)(ws + WS_R + R_VB);
    for (int ph = 0; ph < NPHASE; ++ph) {
        if ((fast >> ph) & 1u) { a.ph_lo = ph; a.ph_hi = ph + 1; hipLaunchKernelGGL(mk_fwd, dim3(grid), dim3(NWAVES * 64), LDS_BYTES, stream, a); continue; }
        if (ph == 0) { rowstat_kernel<<<M / 4, 256, 0, stream>>>(a.in[0], xb, ssp0); continue; }
        const int l = (ph - 1) >> 3, k = (ph - 1) & 7;
        const float* xin = (l == 0 && k <= 1) ? a.in[0] : out;
        bf16_t* xbl = (l == 1) ? xb2 : xb;
        switch (k) {
        case 0: naive_ffn_in<<<dim3(DFF / 128, M / 128), 256, 0, stream>>>(xbl, ssp0, a.in[3] + l * D, a.in[4] + (size_t)l * D * 2 * DFF, act); break;
        case 1: naive_resid<<<dim3(D / 128, M / 128), 256, 0, stream>>>(act, DFF, a.in[5] + (size_t)l * DFF * D, xin, out, 0.5f); rowstat_kernel<<<M / 4, 256, 0, stream>>>(out, xb, ssp1); break;
        case 2: qo.qna = a.in[8] + l * HD; qo.kna = a.in[9] + l * HD; qo.qnb = a.in[10] + l * HD; qo.knb = a.in[11] + l * HD;
                naive_qkv<<<dim3(QKVW / 128, M / 128), 256, 0, stream>>>(xb, ssp1, a.in[6] + l * D, a.in[7] + (size_t)l * D * QKVW, qo); break;
        case 3: { AttnIn ai; ai.qa = qo.qa; ai.ka = qo.ka; ai.va = qo.va; ai.qb = qo.qb; ai.kb = qo.kb; ai.vb = qo.vb; ai.rel_bias = a.in[2]; ai.sink = a.in[12] + l * 8; ai.o = ob;
                naive_attn<<<dim3(S / 4, 16, NB), 256, 0, stream>>>(ai); } break;
        case 4: naive_resid<<<dim3(D / 128, M / 128), 256, 0, stream>>>(ob, D, a.in[13] + (size_t)l * D * D, out, out, 1.0f); rowstat_kernel<<<M / 4, 256, 0, stream>>>(out, xb, ssp0); break;
        case 5: naive_ffn_in<<<dim3(DFF / 128, M / 128), 256, 0, stream>>>(xb, ssp0, a.in[14] + l * D, a.in[15] + (size_t)l * D * 2 * DFF, act); break;
        case 6: naive_resid<<<dim3(D / 128, M / 128), 256, 0, stream>>>(act, DFF, a.in[16] + (size_t)l * DFF * D, out, out, 0.5f); rowstat_kernel<<<M / 4, 256, 0, stream>>>(out, xb, ssp1); break;
        case 7: naive_ple<<<dim3(D / 128, M / 128), 256, 0, stream>>>(xb, ssp1, a.in[17] + l * D, a.in[18] + (size_t)l * D * D, a.in[1] + (size_t)l * M * PLE, a.in[19] + (size_t)l * PLE * D, out, out);
                rowstat_kernel<<<M / 4, 256, 0, stream>>>(out, xb2, ssp0); break;
        }
    }
}
```

```cpp
#include <hip/hip_runtime.h>
#include <cstdio>
#include <cstdint>
#ifndef ATT_FAST
#define ATT_FAST 1
#endif
#ifndef PROBE_N
#define PROBE_N 0
#define PROBE_K -1
#endif
#ifndef ATT_ORDER
#define ATT_ORDER 0
#endif
#ifndef PROBE_ATT_MODE
#define PROBE_ATT_MODE 0
#endif
#ifndef USE_CG_SYNC
#define USE_CG_SYNC 0
#endif
#ifndef PROBE_NULL_EPI
#define PROBE_NULL_EPI 0
#endif

typedef unsigned short bf16_t;
constexpr int NB = 4, S = 4096, D = 1024, M = NB * S, DFF = 2816, QKVW = 2304, PLE = 256, DEPTH = 2, HD = 64;
constexpr float EPS = 1e-6f;
constexpr float QSCALE = 0.125f * 1.4426950408889634f;
constexpr float LOG2E = 1.4426950408889634f;

constexpr size_t MiB = 1u << 20;
constexpr size_t WS_CTL = 0, WS_W = 1 * MiB, WS_XB = 85 * MiB, WS_R = 117 * MiB, WS_PB = 221 * MiB, WS_PROJ = 229 * MiB, WS_SSP = 261 * MiB, WS_END = 263 * MiB + 512 * 1024;
constexpr size_t WS_LUT = 263 * MiB;
constexpr size_t R_QA = 0, R_KA = 16 * MiB, R_VA = 32 * MiB, R_QB = 48 * MiB, R_KB = 64 * MiB, R_VB = 68 * MiB, R_O = 72 * MiB, R_ACT = 0;

__device__ __forceinline__ float bf2f(bf16_t v) { return __uint_as_float(((unsigned)v) << 16); }
__device__ __forceinline__ bf16_t f2bf(float f) { unsigned u = __float_as_uint(f); return (bf16_t)((u + 0x7fffu + ((u >> 16) & 1u)) >> 16); }

__global__ void __launch_bounds__(256) rowstat_kernel(const float* __restrict__ x, bf16_t* __restrict__ xb, float* __restrict__ ssp) {
    const int wave = threadIdx.x >> 6, lane = threadIdx.x & 63;
    const int row = blockIdx.x * 4 + wave;
    const float4* xr = (const float4*)(x + (size_t)row * D);
    float s = 0.f;
#pragma unroll
    for (int j = 0; j < 4; ++j) {
        float4 v = xr[lane + 64 * j];
        s += v.x * v.x + v.y * v.y + v.z * v.z + v.w * v.w;
        ushort4 o; o.x = f2bf(v.x); o.y = f2bf(v.y); o.z = f2bf(v.z); o.w = f2bf(v.w);
        ((ushort4*)(xb + (size_t)row * D))[lane + 64 * j] = o;
    }
#pragma unroll
    for (int o = 1; o < 64; o <<= 1) s += __shfl_xor(s, o);
    if (lane < 4) { float4 r; r.x = lane == 0 ? s : 0.f; r.y = 0.f; r.z = 0.f; r.w = 0.f; ((float4*)ssp)[row * 4 + lane] = r; }
}

__device__ __forceinline__ float row_rstd(const float* ssp, int row) {
    float s = 0.f;
#pragma unroll
    for (int j = 0; j < 4; ++j) { const float4 v = ((const float4*)ssp)[row * 4 + j]; s += (v.x + v.y) + (v.z + v.w); }
    return rsqrtf(s * (1.0f / D) + EPS);
}

template <typename AT> __device__ __forceinline__ float ldA(const AT* p);
template <> __device__ __forceinline__ float ldA<bf16_t>(const bf16_t* p) { return bf2f(*p); }
template <> __device__ __forceinline__ float ldA<float>(const float* p) { return *p; }

template <typename AT>
__device__ __forceinline__ void accum_tile(const AT* A, int lda, int K, const float* gain, const float* W, int ldw, int row0, int wcol0, float (&acc)[8][8], float* As, float* Bs) {
    const int tid = threadIdx.x, tx = tid & 15, ty = tid >> 4;
    for (int k0 = 0; k0 < K; k0 += 8) {
        __syncthreads();
#pragma unroll
        for (int i = 0; i < 4; ++i) { const int idx = tid + i * 256, r = idx >> 3, kk = idx & 7;
            As[kk * 132 + r] = ldA<AT>(A + (size_t)(row0 + r) * lda + k0 + kk) * (gain ? gain[k0 + kk] : 1.0f); }
#pragma unroll
        for (int i = 0; i < 4; ++i) { const int idx = tid + i * 256, kk = idx >> 7, c = idx & 127;
            Bs[kk * 128 + c] = W[(size_t)(k0 + kk) * ldw + wcol0 + c]; }
        __syncthreads();
#pragma unroll
        for (int kk = 0; kk < 8; ++kk) {
            float a[8], b[8];
#pragma unroll
            for (int i = 0; i < 8; ++i) a[i] = As[kk * 132 + ty * 8 + i];
#pragma unroll
            for (int j = 0; j < 8; ++j) b[j] = Bs[kk * 128 + tx * 8 + j];
#pragma unroll
            for (int i = 0; i < 8; ++i)
#pragma unroll
                for (int j = 0; j < 8; ++j) acc[i][j] += a[i] * b[j];
        }
    }
}
#define ZERO_ACC(acc) do { _Pragma("unroll") for (int i = 0; i < 8; ++i) _Pragma("unroll") for (int j = 0; j < 8; ++j) acc[i][j] = 0.f; } while (0)

__global__ void __launch_bounds__(256) naive_ffn_in(const bf16_t* xb, const float* ssp, const float* gain, const float* Win, bf16_t* act) {
    __shared__ float As[8 * 132]; __shared__ float Bs[8 * 128];
    const int row0 = blockIdx.y * 128, col0 = blockIdx.x * 128, tx = threadIdx.x & 15, ty = threadIdx.x >> 4;
    float ag[8][8], au[8][8]; ZERO_ACC(ag); ZERO_ACC(au);
    accum_tile<bf16_t>(xb, D, D, gain, Win, 2 * DFF, row0, col0, ag, As, Bs);
    accum_tile<bf16_t>(xb, D, D, gain, Win, 2 * DFF, row0, DFF + col0, au, As, Bs);
#pragma unroll
    for (int i = 0; i < 8; ++i) { const int row = row0 + ty * 8 + i; const float rs = row_rstd(ssp, row);
#pragma unroll
        for (int j = 0; j < 8; ++j) { const float g = ag[i][j] * rs, u = au[i][j] * rs; const float sg = g / (1.0f + __expf(-g));
            act[(size_t)row * DFF + col0 + tx * 8 + j] = f2bf(sg * u); } }
}
__global__ void __launch_bounds__(256) naive_resid(const bf16_t* A, int K, const float* W, const float* xin, float* xout, float coef) {
    __shared__ float As[8 * 132]; __shared__ float Bs[8 * 128];
    const int row0 = blockIdx.y * 128, col0 = blockIdx.x * 128, tx = threadIdx.x & 15, ty = threadIdx.x >> 4;
    float acc[8][8]; ZERO_ACC(acc);
    accum_tile<bf16_t>(A, K, K, nullptr, W, D, row0, col0, acc, As, Bs);
#pragma unroll
    for (int i = 0; i < 8; ++i) { const int row = row0 + ty * 8 + i;
#pragma unroll
        for (int j = 0; j < 8; ++j) { const size_t o = (size_t)row * D + col0 + tx * 8 + j; xout[o] = xin[o] + coef * acc[i][j]; } }
}
struct QkvOut { bf16_t *qa, *ka, *va, *qb, *kb, *vb; const float *qna, *kna, *qnb, *knb; };
__global__ void __launch_bounds__(256) naive_qkv(const bf16_t* xb, const float* ssp, const float* gain, const float* Wqkv, QkvOut o) {
    __shared__ float As[8 * 132]; __shared__ float Bs[8 * 128];
    const int row0 = blockIdx.y * 128, col0 = blockIdx.x * 128, tx = threadIdx.x & 15, ty = threadIdx.x >> 4;
    float acc[8][8]; ZERO_ACC(acc);
    accum_tile<bf16_t>(xb, D, D, gain, Wqkv, QKVW, row0, col0, acc, As, Bs);
    const int c = col0 + tx * 8;
    bf16_t* dst; const float* ng; int nh, hc; float sc = 1.0f;
    if (c < 512) { dst = o.qa; ng = o.qna; nh = 8; hc = c; sc = QSCALE; }
    else if (c < 1024) { dst = o.ka; ng = o.kna; nh = 8; hc = c - 512; }
    else if (c < 1536) { dst = o.va; ng = nullptr; nh = 8; hc = c - 1024; }
    else if (c < 2048) { dst = o.qb; ng = o.qnb; nh = 8; hc = c - 1536; sc = QSCALE; }
    else if (c < 2176) { dst = o.kb; ng = o.knb; nh = 2; hc = c - 2048; }
    else { dst = o.vb; ng = nullptr; nh = 2; hc = c - 2176; }
    const int h = hc >> 6, e0 = hc & 63;
#pragma unroll
    for (int i = 0; i < 8; ++i) { const int row = row0 + ty * 8 + i; const float rs = row_rstd(ssp, row);
        float v[8]; float ss = 0.f;
#pragma unroll
        for (int j = 0; j < 8; ++j) { v[j] = acc[i][j] * rs; ss += v[j] * v[j]; }
        ss += __shfl_xor(ss, 1); ss += __shfl_xor(ss, 2); ss += __shfl_xor(ss, 4);
        const float hr = rsqrtf(ss * (1.0f / HD) + EPS);
        const int b = row / S, s = row % S;
        bf16_t* p = dst + (((size_t)b * nh + h) * S + s) * HD + e0;
#pragma unroll
        for (int j = 0; j < 8; ++j) p[j] = f2bf(ng ? v[j] * hr * ng[e0 + j] * sc : v[j]); }
}
__global__ void __launch_bounds__(256) naive_ple(const bf16_t* xb, const float* ssp, const float* gain, const float* Wg, const float* p, const float* Wp, const float* xin, float* xout) {
    __shared__ float As[8 * 132]; __shared__ float Bs[8 * 128];
    const int row0 = blockIdx.y * 128, col0 = blockIdx.x * 128, tx = threadIdx.x & 15, ty = threadIdx.x >> 4;
    float ag[8][8], ap[8][8]; ZERO_ACC(ag); ZERO_ACC(ap);
    accum_tile<bf16_t>(xb, D, D, gain, Wg, D, row0, col0, ag, As, Bs);
    accum_tile<float>(p, PLE, PLE, nullptr, Wp, D, row0, col0, ap, As, Bs);
#pragma unroll
    for (int i = 0; i < 8; ++i) { const int row = row0 + ty * 8 + i; const float rs = row_rstd(ssp, row);
#pragma unroll
        for (int j = 0; j < 8; ++j) { const size_t o = (size_t)row * D + col0 + tx * 8 + j; const float g = 1.0f / (1.0f + __expf(-ag[i][j] * rs));
            xout[o] = xin[o] + g * ap[i][j]; } }
}

__device__ __forceinline__ int t5_bucket(int rel) {
    const int n = rel < 0 ? -rel : rel; const int ret = rel > 0 ? 16 : 0;
    if (n < 8) return ret + n;
    int large = 8 + (int)(logf((float)n / 8.0f) / 4.852030263919617f * 8.0f);
    large = large < 15 ? large : 15;
    return ret + large;
}
struct AttnIn { const bf16_t *qa, *ka, *va, *qb, *kb, *vb; const float* rel_bias; const float* sink; bf16_t* o; };
__global__ void __launch_bounds__(256) naive_attn(AttnIn a) {
    __shared__ float pl[4][400]; __shared__ int kl[4][400];
    const int wave = threadIdx.x >> 6, lane = threadIdx.x & 63;
    const int t = blockIdx.x * 4 + wave, head = blockIdx.y, b = blockIdx.z;
    const bool isA = head < 8;
    const bf16_t *q, *k, *v;
    if (isA) { q = a.qa + (((size_t)b * 8 + head) * S + t) * HD; k = a.ka + ((size_t)b * 8 + head) * S * HD; v = a.va + ((size_t)b * 8 + head) * S * HD; }
    else { const int hq = head - 8, hk = hq >> 2; q = a.qb + (((size_t)b * 8 + hq) * S + t) * HD; k = a.kb + ((size_t)b * 2 + hk) * S * HD; v = a.vb + ((size_t)b * 2 + hk) * S * HD; }
    float qf[HD];
#pragma unroll
    for (int e = 0; e < HD; ++e) qf[e] = bf2f(q[e]);
    const int nk = isA ? 387 : 257;
    float mx = -1e30f;
    for (int i = lane; i < nk; i += 64) {
        int rel;
        if (isA) { const int br = i / 129, j = i % 129 - 64; rel = j * (br == 0 ? 1 : br == 1 ? 4 : 16); }
        else rel = i - 128;
        const int tk = t + rel;
        float lg = -1e30f;
        if (tk >= 0 && tk < S) {
            float d = 0.f; const bf16_t* kr = k + (size_t)tk * HD;
#pragma unroll
            for (int e = 0; e < HD; ++e) d += qf[e] * bf2f(kr[e]);
            lg = d + a.rel_bias[t5_bucket(rel) * 16 + head] * LOG2E;
        }
        pl[wave][i] = lg; kl[wave][i] = tk;
        mx = fmaxf(mx, lg);
    }
#pragma unroll
    for (int o = 1; o < 64; o <<= 1) mx = fmaxf(mx, __shfl_xor(mx, o));
    float sinkl = 0.f;
    if (!isA) { sinkl = a.sink[head - 8] * LOG2E; mx = fmaxf(mx, sinkl); }
    float sum = 0.f;
    for (int i = lane; i < nk; i += 64) { const float lg = pl[wave][i]; const float pv = lg > -1e29f ? exp2f(lg - mx) : 0.f; pl[wave][i] = pv; sum += pv; }
#pragma unroll
    for (int o = 1; o < 64; o <<= 1) sum += __shfl_xor(sum, o);
    if (!isA) sum += exp2f(sinkl - mx);
    __syncthreads();
    float acc = 0.f;
    for (int i = 0; i < nk; ++i) { const float pv = pl[wave][i]; if (pv != 0.f) acc += pv * bf2f(v[(size_t)kl[wave][i] * HD + lane]); }
    a.o[((size_t)b * S + t) * D + head * HD + lane] = f2bf(acc / sum);
}

namespace pg8 {
#define PG8_LAS __attribute__((address_space(3)))
typedef unsigned short bf16_t;
typedef short bf16x8 __attribute__((ext_vector_type(8)));
typedef float f32x4 __attribute__((ext_vector_type(4)));
typedef unsigned u32x4 __attribute__((ext_vector_type(4)));
constexpr int BM = 256, BK = 64, HALF = 128, HTB = HALF * BK * 2  , STAGE_BYTES = 8 * HTB, NXCD = 8, WGM = 8;

__host__ __device__ __forceinline__ int lds_byte(int r, int c) { const int st = (r >> 4) * 2 + (c >> 5), rr = r & 15, cc = c & 31, ob = rr * 64 + cc * 2; return st * 1024 + (ob ^ (((ob >> 9) & 1) << 5)); }
__host__ __device__ __forceinline__ void stage_rc(int b, int& R, int& C) { const int st = b / 1024, sb = b % 1024, swz = sb ^ (((sb >> 9) & 1) << 5); R = (st >> 1) * 16 + swz / 64; C = (st & 1) * 32 + (swz % 64) / 2; }
__host__ __device__ __forceinline__ int perm32(int rho) { const int n = rho >> 4, i = rho & 15; return 8 * (i >> 2) + 4 * n + (i & 3); }

struct Unit { int pm, pn; };
struct Gemm { const bf16_t* A; const bf16_t* Bt; int M, N, K; };

struct StaticOrder {
    int nM, nN, nwg, G, c;
    __host__ __device__ void init(int M, int N, int G_, int c_) { nM = M / BM; nN = N / BM; nwg = nM * nN; G = G_; c = c_; }
    __host__ __device__ bool next(int i, Unit& u) const {
        const long L = (long)i * G + c; if (L >= nwg) return false;
        int wgid = (int)L; { const int q = nwg / NXCD, r = nwg % NXCD, xcd = wgid % NXCD, off = wgid / NXCD; wgid = (xcd < r ? xcd * (q + 1) : r * (q + 1) + (xcd - r) * q) + off; }
        const int nig = WGM * nN, gid = wgid / nig, fm = gid * WGM, gsz = (nM - fm) < WGM ? (nM - fm) : WGM;
        u.pm = fm + ((wgid % nig) % gsz); u.pn = (wgid % nig) / gsz; return true;
    }
    __device__ __forceinline__ void a_ready(const Unit&) const {}
    __device__ __forceinline__ void done(const Unit&) const {}
};

__device__ __forceinline__ unsigned cvt_pk_bf16(float lo, float hi) { unsigned r; asm volatile("v_cvt_pk_bf16_f32 %0, %1, %2" : "=v"(r) : "v"(lo), "v"(hi)); return r; }
typedef float f32x2 __attribute__((ext_vector_type(2)));
template <class Epi, class Sched, bool ALIGN_EPI = false, bool SP2 = false>
__device__ __forceinline__ void gemm_phase(PG8_LAS unsigned char* lds, const Gemm g, const Sched& S, const Epi& E, const int tid) {
    const int wid = __builtin_amdgcn_readfirstlane(tid >> 6), lane = tid & 63, wr = wid >> 2, wc = wid & 3, fr = lane & 15, fq = lane >> 4;
    const int K = g.K, nt = K / BK;
    unsigned voffA[2], voffB[2];
#pragma unroll
    for (int i = 0; i < 2; ++i) { int R, C; stage_rc(tid * 16 + i * 8192, R, C); const int Rb = Epi::PERM ? ((R & ~31) + perm32(R & 31)) : R;
        voffA[i] = (unsigned)(R * K + C) * 2u; voffB[i] = (unsigned)(Rb * K + C) * 2u; }
    const size_t kstep = (size_t)(BK * 2);
    const size_t hstep = (size_t)HALF * K * 2;
    const size_t tstep = 2 * hstep;
    const unsigned ldsw = (unsigned)wid * 1024u;
    const int aoff = lds_byte(wr * 64 + fr, fq * 8), boff = lds_byte(wc * 32 + fr, fq * 8);
#define PG8_SA(b, h) (((b) * 2 + (h)) * HTB)
#define PG8_SB(b, h) ((4 + (b) * 2 + (h)) * HTB)
#define PG8_STAGE(bufoff, gbase, voff) do { _Pragma("unroll") for (int _i = 0; _i < 2; ++_i) \
        __builtin_amdgcn_global_load_lds((const unsigned*)((const char*)(gbase) + (voff)[_i]), (PG8_LAS unsigned*)(lds + (bufoff) + ldsw + _i * 8192), 16, 0, 0); } while (0)
#define PG8_LDA(dst, b, h) do { _Pragma("unroll") for (int m = 0; m < 4; ++m) _Pragma("unroll") for (int k = 0; k < 2; ++k) dst[m][k] = *(const PG8_LAS bf16x8*)(lds + PG8_SA(b, h) + aoff + m * 2048 + k * 1024); } while (0)
#define PG8_LDB(dst, b, h) do { _Pragma("unroll") for (int n = 0; n < 2; ++n) _Pragma("unroll") for (int k = 0; k < 2; ++k) dst[n][k] = *(const PG8_LAS bf16x8*)(lds + PG8_SB(b, h) + boff + n * 2048 + k * 1024); } while (0)
#define PG8_MMA(ai, bj, At, Bt) do { __builtin_amdgcn_s_setprio(1); _Pragma("unroll") for (int m = 0; m < 4; ++m) _Pragma("unroll") for (int n = 0; n < 2; ++n) _Pragma("unroll") for (int k = 0; k < 2; ++k) \
        acc[ai][bj][m][n] = __builtin_amdgcn_mfma_f32_16x16x32_bf16(Bt[n][k], At[m][k], acc[ai][bj][m][n], 0, 0, 0); __builtin_amdgcn_s_setprio(0); } while (0)
#define PG8_WAIT_V(n) asm volatile("s_waitcnt vmcnt(" #n ")" ::: "memory")
#define PG8_WAIT_L(n) asm volatile("s_waitcnt lgkmcnt(" #n ")" ::: "memory")
#define PG8_BAR __builtin_amdgcn_s_barrier()
#define PG8_SCHED __builtin_amdgcn_sched_barrier(0)
    Unit cur, nxt; int ui = 0;
    if (!S.next(0, cur)) return;
    f32x4 acc[2][2][4][2];
#pragma unroll
    for (int a = 0; a < 2; ++a)
#pragma unroll
        for (int b = 0; b < 2; ++b)
#pragma unroll
            for (int m = 0; m < 4; ++m)
#pragma unroll
                for (int n = 0; n < 2; ++n) acc[a][b][m][n] = (f32x4){0.f, 0.f, 0.f, 0.f};
    bf16x8 At[4][2], B0[2][2], B1[2][2];
    const char* cA = (const char*)g.A + (size_t)cur.pm * tstep; const char* cB = (const char*)g.Bt + (size_t)cur.pn * tstep;
    S.a_ready(cur);
    if constexpr (SP2) {
        PG8_STAGE(PG8_SB(0, 0), cB, voffB); PG8_STAGE(PG8_SB(0, 1), cB + hstep, voffB); PG8_STAGE(PG8_SA(0, 0), cA, voffA); PG8_STAGE(PG8_SA(0, 1), cA + hstep, voffA);
        if (wr == 1) PG8_BAR;
        PG8_WAIT_V(2); PG8_BAR;
        PG8_STAGE(PG8_SB(1, 0), cB + kstep, voffB); PG8_STAGE(PG8_SA(1, 0), cA + kstep, voffA); PG8_STAGE(PG8_SB(1, 1), cB + hstep + kstep, voffB);
        PG8_WAIT_V(6); PG8_BAR;
    } else {
        PG8_STAGE(PG8_SB(0, 0), cB, voffB); PG8_STAGE(PG8_SA(0, 0), cA, voffA); PG8_STAGE(PG8_SB(0, 1), cB + hstep, voffB); PG8_STAGE(PG8_SA(0, 1), cA + hstep, voffA);
        if (wr == 1) PG8_BAR;
        PG8_WAIT_V(4); PG8_BAR;
        PG8_STAGE(PG8_SB(1, 0), cB + kstep, voffB); PG8_STAGE(PG8_SA(1, 0), cA + kstep, voffA); PG8_STAGE(PG8_SB(1, 1), cB + hstep + kstep, voffB);
        PG8_WAIT_V(6); PG8_BAR;
    }
    for (;;) {
        const bool has_next = S.next(ui + 1, nxt);
        const char* nA = has_next ? (const char*)g.A + (size_t)nxt.pm * tstep : cA; const char* nB = has_next ? (const char*)g.Bt + (size_t)nxt.pn * tstep : cB;
        for (int t = 0; t < nt; t += 2) {
            const bool last = (t == nt - 2);
            const char* a1 = cA + (size_t)(t + 1) * kstep;
            const char* a2 = last ? nA : cA + (size_t)(t + 2) * kstep; const char* b2 = last ? nB : cB + (size_t)(t + 2) * kstep;
            const char* a3 = a2 + kstep; const char* b3 = b2 + kstep;
            if (last && has_next) S.a_ready(nxt);
            if constexpr (SP2) {
            PG8_LDB(B0, 0, 0); PG8_LDB(B1, 0, 1); PG8_SCHED; PG8_LDA(At, 0, 0); PG8_STAGE(PG8_SA(1, 1), a1 + hstep, voffA);
            PG8_WAIT_V(8); PG8_WAIT_L(0); PG8_BAR; PG8_MMA(0, 0, At, B0); PG8_MMA(0, 1, At, B1); PG8_BAR; PG8_SCHED;
            PG8_LDA(At, 0, 1); PG8_STAGE(PG8_SB(0, 0), b2, voffB); PG8_STAGE(PG8_SB(0, 1), b2 + hstep, voffB); PG8_STAGE(PG8_SA(0, 0), a2, voffA);
            PG8_WAIT_V(8); PG8_WAIT_L(0); PG8_BAR; PG8_MMA(1, 0, At, B0); PG8_MMA(1, 1, At, B1); PG8_BAR; PG8_SCHED;
            PG8_LDB(B0, 1, 0); PG8_LDB(B1, 1, 1); PG8_SCHED; PG8_LDA(At, 1, 0); PG8_STAGE(PG8_SA(0, 1), a2 + hstep, voffA);
            PG8_WAIT_V(8); PG8_WAIT_L(0); PG8_BAR; PG8_MMA(0, 0, At, B0); PG8_MMA(0, 1, At, B1); PG8_BAR; PG8_SCHED;
            PG8_LDA(At, 1, 1); PG8_STAGE(PG8_SB(1, 0), b3, voffB); PG8_STAGE(PG8_SB(1, 1), b3 + hstep, voffB); PG8_STAGE(PG8_SA(1, 0), a3, voffA);
            PG8_WAIT_V(8); PG8_WAIT_L(0); PG8_BAR; PG8_MMA(1, 0, At, B0); PG8_MMA(1, 1, At, B1); PG8_BAR; PG8_SCHED;
            } else {
            PG8_LDB(B0, 0, 0); PG8_SCHED; PG8_LDA(At, 0, 0); PG8_STAGE(PG8_SA(1, 1), a1 + hstep, voffA);
            PG8_WAIT_L(8); PG8_BAR; PG8_WAIT_L(0); PG8_MMA(0, 0, At, B0); PG8_BAR; PG8_SCHED;
            PG8_LDB(B1, 0, 1); PG8_STAGE(PG8_SB(0, 0), b2, voffB);
            PG8_BAR; PG8_WAIT_L(0); PG8_MMA(0, 1, At, B1); PG8_BAR;
            PG8_LDA(At, 0, 1); PG8_STAGE(PG8_SA(0, 0), a2, voffA);
            PG8_BAR; PG8_WAIT_L(0); PG8_MMA(1, 0, At, B0); PG8_BAR; PG8_SCHED;
            PG8_STAGE(PG8_SB(0, 1), b2 + hstep, voffB);
            PG8_WAIT_V(6); PG8_BAR; PG8_MMA(1, 1, At, B1); PG8_BAR;
            PG8_LDB(B0, 1, 0); PG8_SCHED; PG8_LDA(At, 1, 0); PG8_STAGE(PG8_SA(0, 1), a2 + hstep, voffA);
            PG8_WAIT_L(8); PG8_BAR; PG8_WAIT_L(0); PG8_MMA(0, 0, At, B0); PG8_BAR; PG8_SCHED;
            PG8_LDB(B1, 1, 1); PG8_STAGE(PG8_SB(1, 0), b3, voffB);
            PG8_BAR; PG8_WAIT_L(0); PG8_MMA(0, 1, At, B1); PG8_BAR;
            PG8_LDA(At, 1, 1); PG8_STAGE(PG8_SA(1, 0), a3, voffA);
            PG8_BAR; PG8_WAIT_L(0); PG8_MMA(1, 0, At, B0); PG8_BAR; PG8_SCHED;
            PG8_STAGE(PG8_SB(1, 1), b3 + hstep, voffB);
            PG8_WAIT_V(6); PG8_BAR; PG8_MMA(1, 1, At, B1); PG8_BAR;
            }
        }
        if constexpr (ALIGN_EPI) { if (wr == 0) PG8_BAR; }
        if constexpr (!Epi::AFTER_DRAIN) { int l2_; asm volatile("v_mbcnt_lo_u32_b32 %0, -1, 0\n\tv_mbcnt_hi_u32_b32 %0, -1, %0" : "=v"(l2_)); E(acc, cur, wr, wc, l2_ & 15, l2_ >> 4); S.done(cur); }
        if (!has_next) break;
#pragma unroll
        for (int a = 0; a < 2; ++a)
#pragma unroll
            for (int b = 0; b < 2; ++b)
#pragma unroll
                for (int m = 0; m < 4; ++m)
#pragma unroll
                    for (int n = 0; n < 2; ++n) acc[a][b][m][n] = (f32x4){0.f, 0.f, 0.f, 0.f};
        cur = nxt; cA = nA; cB = nB; ++ui;
        if constexpr (ALIGN_EPI) { if (wr == 1) PG8_BAR; }
    }
    PG8_WAIT_V(0);
    if constexpr (!ALIGN_EPI) { if (wr == 0) PG8_BAR; }
    PG8_BAR;
    if constexpr (Epi::AFTER_DRAIN) { E.fused(acc, cur, wr, wc, fr, fq, lds, wid, lane); S.done(cur); }
#undef PG8_SA
#undef PG8_SB
#undef PG8_STAGE
#undef PG8_LDA
#undef PG8_LDB
#undef PG8_MMA
#undef PG8_WAIT_V
#undef PG8_WAIT_L
#undef PG8_BAR
#undef PG8_SCHED
}
}

namespace pg8 {
typedef float f32x2 __attribute__((ext_vector_type(2)));
__device__ __forceinline__ float shx(float v, int lane, int mask) { return __int_as_float(__builtin_amdgcn_ds_bpermute((lane ^ mask) << 2, __float_as_int(v))); }
__device__ __forceinline__ float rstd16(const float* ssp, int row, int fq, int lane) {
    const f32x4 v = *(const f32x4*)(ssp + (size_t)row * 16 + 4 * fq);
    float s = (v[0] + v[1]) + (v[2] + v[3]);
    s += shx(s, lane, 16); s += shx(s, lane, 32);
    return rsqrtf(s * (1.0f / 1024.0f) + 1e-6f);
}
__device__ __forceinline__ float sigm(float v) { return __builtin_amdgcn_rcpf(1.0f + __builtin_amdgcn_exp2f(-1.4426950408889634f * v)); }
__device__ __forceinline__ u32x4 pack8(const f32x4& a, const f32x4& b) { u32x4 w; w.x = cvt_pk_bf16(a[0], a[1]); w.y = cvt_pk_bf16(a[2], a[3]); w.z = cvt_pk_bf16(b[0], b[1]); w.w = cvt_pk_bf16(b[2], b[3]); return w; }
__device__ __forceinline__ float bflo(unsigned w) { return __uint_as_float(w << 16); }
__device__ __forceinline__ float bfhi(unsigned w) { return __uint_as_float(w & 0xffff0000u); }

struct EpiSwiglu {
    static constexpr bool PERM = true, AFTER_DRAIN = false;
    bf16_t* act; const float* ssp; int mode;
    __device__ __forceinline__ void operator()(const f32x4 (&acc)[2][2][4][2], const Unit& u, int wr, int wc, int fr, int fq) const {
        const int lane = fr + 16 * fq;
        const int row0 = u.pm * BM + wr * 64 + fr, col0 = u.pn * 128 + wc * 32 + 8 * fq;
#pragma unroll
        for (int ai = 0; ai < 2; ++ai)
#pragma unroll
            for (int m = 0; m < 4; ++m) { const int row = row0 + ai * HALF + m * 16; const float rs = rstd16(ssp, row, fq, lane);
                f32x4 o[2];
                const float c1 = -1.4426950408889634f * rs, rs2 = rs * rs;
#pragma unroll
                for (int n = 0; n < 2; ++n)
#pragma unroll
                    for (int j = 0; j < 4; ++j) { const float g = acc[ai][0][m][n][j], up = acc[ai][1][m][n][j];
                        o[n][j] = (PROBE_NULL_EPI && mode == 2) ? g + up : (g * up) * (rs2 * __builtin_amdgcn_rcpf(1.0f + __builtin_amdgcn_exp2f(c1 * g))); }
                const u32x4 w = pack8(o[0], o[1]);
                if (PROBE_NULL_EPI && mode == 1) asm volatile("" :: "v"(w)); else *(u32x4*)(act + (size_t)row * 2816 + col0) = w; }
    }
};
__device__ __forceinline__ void unpack8(const u32x4& w, f32x4& a, f32x4& b) { a = (f32x4){bflo(w.x), bfhi(w.x), bflo(w.y), bfhi(w.y)}; b = (f32x4){bflo(w.z), bfhi(w.z), bflo(w.w), bfhi(w.w)}; }
__device__ __forceinline__ void split8(const f32x4& x0, const f32x4& x1, u32x4& hi, u32x4& lo) {
    hi = pack8(x0, x1); f32x4 h0, h1; unpack8(hi, h0, h1); lo = pack8(x0 - h0, x1 - h1);
}
struct EpiResid {
    static constexpr bool PERM = true, AFTER_DRAIN = false;
    const bf16_t* hin; const bf16_t* lin; bf16_t* hout; bf16_t* lout; float* sspw; float coef;
    __device__ __forceinline__ void operator()(const f32x4 (&acc)[2][2][4][2], const Unit& u, int wr, int wc, int fr, int fq) const {
        const int lane = fr + 16 * fq;
        float cf = __uint_as_float(__builtin_amdgcn_readfirstlane(__float_as_uint(coef))); asm volatile("" : "+s"(cf));
        const int row0 = u.pm * BM + wr * 64 + fr, col0 = u.pn * BM + wc * 32 + 8 * fq;
#pragma unroll
        for (int ai = 0; ai < 2; ++ai) {
            u32x4 xh[4][2], xl[4][2];
#pragma unroll
            for (int m = 0; m < 4; ++m)
#pragma unroll
                for (int bj = 0; bj < 2; ++bj) { const size_t off = (size_t)(row0 + ai * HALF + m * 16) * 1024 + col0 + bj * HALF; xh[m][bj] = *(const u32x4*)(hin + off); xl[m][bj] = *(const u32x4*)(lin + off); }
            asm volatile("" ::: "memory");
#pragma unroll
            for (int m = 0; m < 4; ++m) { const int row = row0 + ai * HALF + m * 16; float ss = 0.f;
#pragma unroll
                for (int bj = 0; bj < 2; ++bj) { const size_t off = (size_t)row * 1024 + col0 + bj * HALF;
                    f32x4 h0, h1, l0, l1; unpack8(xh[m][bj], h0, h1); unpack8(xl[m][bj], l0, l1);
                    const f32x4 x0 = (h0 + l0) + acc[ai][bj][m][0] * cf, x1 = (h1 + l1) + acc[ai][bj][m][1] * cf;
                    u32x4 nh, nl; split8(x0, x1, nh, nl);
                    *(u32x4*)(hout + off) = nh; *(u32x4*)(lout + off) = nl;
                    ss += (x0[0] * x0[0] + x0[1] * x0[1]) + (x0[2] * x0[2] + x0[3] * x0[3]) + (x1[0] * x1[0] + x1[1] * x1[1]) + (x1[2] * x1[2] + x1[3] * x1[3]); }
                ss += shx(ss, lane, 16); ss += shx(ss, lane, 32);
                if (fq == 0) sspw[(size_t)row * 16 + u.pn * 4 + wc] = ss; }
            asm volatile("" ::: "memory");
        }
    }
};
struct EpiGate {
    static constexpr bool PERM = true, AFTER_DRAIN = false;
    const bf16_t* hin; const bf16_t* lin; bf16_t* hout; bf16_t* lout; float* fout; float* sspw; const float* sspr; const bf16_t* proj; float coef;
    __device__ __forceinline__ void operator()(const f32x4 (&acc)[2][2][4][2], const Unit& u, int wr, int wc, int fr, int fq) const {
        const int lane = fr + 16 * fq;
        float cf = __uint_as_float(__builtin_amdgcn_readfirstlane(__float_as_uint(coef))); asm volatile("" : "+s"(cf));
        const int row0 = u.pm * BM + wr * 64 + fr, col0 = u.pn * BM + wc * 32 + 8 * fq;
#pragma unroll
        for (int ai = 0; ai < 2; ++ai)
#pragma unroll
            for (int mh = 0; mh < 2; ++mh) {
                u32x4 xh[2][2], xl[2][2], pw[2][2]; float rs[2];
#pragma unroll
                for (int mm = 0; mm < 2; ++mm) { const int row = row0 + ai * HALF + (2 * mh + mm) * 16; rs[mm] = rstd16(sspr, row, fq, lane);
#pragma unroll
                    for (int bj = 0; bj < 2; ++bj) { const size_t off = (size_t)row * 1024 + col0 + bj * HALF; xh[mm][bj] = *(const u32x4*)(hin + off); xl[mm][bj] = *(const u32x4*)(lin + off); pw[mm][bj] = *(const u32x4*)(proj + off); } }
                asm volatile("" ::: "memory");
#pragma unroll
                for (int mm = 0; mm < 2; ++mm) { const int m = 2 * mh + mm, row = row0 + ai * HALF + m * 16; float ss = 0.f;
#pragma unroll
                    for (int bj = 0; bj < 2; ++bj) { const size_t off = (size_t)row * 1024 + col0 + bj * HALF;
                        f32x4 h0, h1, l0, l1, p0, p1; unpack8(xh[mm][bj], h0, h1); unpack8(xl[mm][bj], l0, l1); unpack8(pw[mm][bj], p0, p1);
                        f32x4 x0 = h0 + l0, x1 = h1 + l1;
#pragma unroll
                        for (int j = 0; j < 4; ++j) { x0[j] += cf * (sigm(acc[ai][bj][m][0][j] * rs[mm]) * p0[j]); x1[j] += cf * (sigm(acc[ai][bj][m][1][j] * rs[mm]) * p1[j]); }
                        if (fout) { *(f32x4*)(fout + off) = x0; *(f32x4*)(fout + off + 4) = x1; }
                        else { u32x4 nh, nl; split8(x0, x1, nh, nl); *(u32x4*)(hout + off) = nh; *(u32x4*)(lout + off) = nl;
                            ss += (x0[0] * x0[0] + x0[1] * x0[1]) + (x0[2] * x0[2] + x0[3] * x0[3]) + (x1[0] * x1[0] + x1[1] * x1[1]) + (x1[2] * x1[2] + x1[3] * x1[3]); } }
                    if (!fout) { ss += shx(ss, lane, 16); ss += shx(ss, lane, 32);
                        if (fq == 0) sspw[(size_t)row * 16 + u.pn * 4 + wc] = ss; } }
                asm volatile("" ::: "memory");
            }
    }
};
struct EpiStoreBf16 {
    static constexpr bool PERM = true, AFTER_DRAIN = false;
    bf16_t* O; int ldc;
    __device__ __forceinline__ void operator()(const f32x4 (&acc)[2][2][4][2], const Unit& u, int wr, int wc, int fr, int fq) const {
        const int lane = fr + 16 * fq;
        const int row0 = u.pm * BM + wr * 64 + fr, col0 = u.pn * BM + wc * 32 + 8 * fq;
#pragma unroll
        for (int ai = 0; ai < 2; ++ai)
#pragma unroll
            for (int m = 0; m < 4; ++m) { const int row = row0 + ai * HALF + m * 16;
#pragma unroll
                for (int bj = 0; bj < 2; ++bj) *(u32x4*)(O + (size_t)row * ldc + col0 + bj * HALF) = pack8(acc[ai][bj][m][0], acc[ai][bj][m][1]); }
    }
};
struct EpiNull {
    static constexpr bool PERM = true, AFTER_DRAIN = false;
    __device__ __forceinline__ void operator()(const f32x4 (&acc)[2][2][4][2], const Unit& u, int wr, int wc, int fr, int fq) const {
#pragma unroll
        for (int ai = 0; ai < 2; ++ai)
#pragma unroll
            for (int bj = 0; bj < 2; ++bj)
#pragma unroll
                for (int m = 0; m < 4; ++m)
#pragma unroll
                    for (int n = 0; n < 2; ++n) asm volatile("" :: "v"(acc[ai][bj][m][n]));
    }
};
struct EpiQkv {
    static constexpr bool PERM = true, AFTER_DRAIN = false;
    const float* ssp; bf16_t *qa, *ka, *va, *qb, *kb, *vb; const float *qna, *kna, *qnb, *knb;
    __device__ __forceinline__ void operator()(const f32x4 (&acc)[2][2][4][2], const Unit& u, int wr, int wc, int fr, int fq) const {
        const int lane = fr + 16 * fq;
        const int t = u.pn; bf16_t* dst; const float* ng; int nh, h; float sc = 1.0f;
        if (t < 2) { dst = qa; ng = qna; nh = 8; h = 4 * t + wc; sc = QSCALE; }
        else if (t < 4) { dst = ka; ng = kna; nh = 8; h = 4 * (t - 2) + wc; }
        else if (t < 6) { dst = va; ng = nullptr; nh = 8; h = 4 * (t - 4) + wc; }
        else if (t < 8) { dst = qb; ng = qnb; nh = 8; h = 4 * (t - 6) + wc; sc = QSCALE; }
        else if (wc < 2) { dst = kb; ng = knb; nh = 2; h = wc; }
        else { dst = vb; ng = nullptr; nh = 2; h = wc - 2; }
        f32x4 gv[2][2];
#pragma unroll
        for (int bj = 0; bj < 2; ++bj)
#pragma unroll
            for (int n = 0; n < 2; ++n) { if (ng) gv[bj][n] = *(const f32x4*)(ng + 32 * bj + 8 * fq + 4 * n) * sc; else gv[bj][n] = (f32x4){1.f, 1.f, 1.f, 1.f}; }
        const int row0 = u.pm * BM + wr * 64 + fr;
#pragma unroll
        for (int ai = 0; ai < 2; ++ai)
#pragma unroll
            for (int m = 0; m < 4; ++m) { const int row = row0 + ai * HALF + m * 16; const float rs = rstd16(ssp, row, fq, lane);
                f32x4 v[2][2]; float ss = 0.f;
#pragma unroll
                for (int bj = 0; bj < 2; ++bj)
#pragma unroll
                    for (int n = 0; n < 2; ++n) { v[bj][n] = acc[ai][bj][m][n] * rs; ss += (v[bj][n][0] * v[bj][n][0] + v[bj][n][1] * v[bj][n][1]) + (v[bj][n][2] * v[bj][n][2] + v[bj][n][3] * v[bj][n][3]); }
                ss += shx(ss, lane, 16); ss += shx(ss, lane, 32);
                const float hr = ng ? rsqrtf(ss * (1.0f / 64.0f) + 1e-6f) : 1.0f;
                const int b = row >> 12, s = row & 4095;
                bf16_t* p = dst + (((size_t)b * nh + h) * 4096 + s) * 64 + 8 * fq;
#pragma unroll
                for (int bj = 0; bj < 2; ++bj) *(u32x4*)(p + 32 * bj) = pack8(v[bj][0] * hr * gv[bj][0], v[bj][1] * hr * gv[bj][1]); }
    }
};
}

#include <hip/hip_cooperative_groups.h>
namespace cg = cooperative_groups;
#define LAS __attribute__((address_space(3)))
typedef unsigned v4u __attribute__((ext_vector_type(4)));
constexpr int NWAVES = 8, RING_BYTES = 131072, LDS_BYTES = 147456;
constexpr int NPHASE = 1 + 8 * DEPTH;
constexpr size_t WO_F1IN = 0, WO_F1OUT = WO_F1IN + (size_t)2 * DFF * D, WO_QKV = WO_F1OUT + (size_t)D * DFF, WO_WO = WO_QKV + (size_t)QKVW * D,
                 WO_F2IN = WO_WO + (size_t)D * D, WO_F2OUT = WO_F2IN + (size_t)2 * DFF * D, WO_WG = WO_F2OUT + (size_t)D * DFF, WO_WP = WO_WG + (size_t)D * D, W_LAYER = WO_WP + (size_t)D * PLE;
static_assert(W_LAYER * 2 * DEPTH <= 84 * MiB, "weights fit");

struct Args { const float* in[20]; float* out; unsigned char* ws; int ph_lo, ph_hi; };

__device__ __forceinline__ int src_col(int kind, int n0) {
    if (kind == 0) return n0;
    if (kind == 1) return ((n0 >> 7) & 1) * DFF + 128 * (n0 >> 8) + (n0 & 127);
    return 256 * (n0 >> 8) + 64 * ((n0 >> 5) & 3) + 32 * ((n0 >> 7) & 1);
}
__device__ __forceinline__ void transpose_item(const float* W, int K, int N, const float* gain, bf16_t* Bt, int kind, int item, LAS float* scr, int lane) {
    const int kblocks = K / 64, nb = item / kblocks, kb = item % kblocks, k0 = 64 * kb, n0 = 64 * nb;
    const int cseg = lane & 15, r0 = lane >> 4;
    const int c0 = src_col(kind, n0 + 32 * (cseg >> 3)) + 4 * (cseg & 7);
    float4 v[16];
#pragma unroll
    for (int i = 0; i < 16; ++i) v[i] = *(const float4*)(W + (size_t)(k0 + r0 + 4 * i) * N + c0);
    if (gain) {
#pragma unroll
        for (int i = 0; i < 16; ++i) { const float g = gain[k0 + r0 + 4 * i]; v[i].x *= g; v[i].y *= g; v[i].z *= g; v[i].w *= g; }
    }
#pragma unroll
    for (int i = 0; i < 16; ++i) { LAS float* p = scr + (r0 + 4 * i) * 65 + 4 * cseg; p[0] = v[i].x; p[1] = v[i].y; p[2] = v[i].z; p[3] = v[i].w; }
    asm volatile("s_waitcnt lgkmcnt(0)" ::: "memory");
    const int c = lane & 7;
#pragma unroll
    for (int j = 0; j < 8; ++j) { const int n = (lane >> 3) + 8 * j; const LAS float* sp = scr + (8 * c) * 65 + n;
        v4u o; o.x = pg8::cvt_pk_bf16(sp[0 * 65], sp[1 * 65]); o.y = pg8::cvt_pk_bf16(sp[2 * 65], sp[3 * 65]); o.z = pg8::cvt_pk_bf16(sp[4 * 65], sp[5 * 65]); o.w = pg8::cvt_pk_bf16(sp[6 * 65], sp[7 * 65]);
        *(v4u*)(Bt + (size_t)(n0 + n) * K + k0 + 8 * c) = o; }
    asm volatile("s_waitcnt lgkmcnt(0)" ::: "memory");
}

constexpr int I_FIN = (D / 64) * (2 * DFF / 64), I_FOUT = (DFF / 64) * (D / 64), I_QKV = (D / 64) * (QKVW / 64), I_SQ = (D / 64) * (D / 64), I_WP = (PLE / 64) * (D / 64);
constexpr int IT_FIN1 = 0, IT_FOUT1 = IT_FIN1 + I_FIN, IT_QKV = IT_FOUT1 + I_FOUT, IT_WO = IT_QKV + I_QKV, IT_FIN2 = IT_WO + I_SQ, IT_FOUT2 = IT_FIN2 + I_FIN, IT_WG = IT_FOUT2 + I_FOUT, IT_WP = IT_WG + I_SQ, I_LAYER = IT_WP + I_WP;
template <class AT> __device__ __forceinline__ void convert_weight_items(const AT& a, LAS unsigned char* lds, int first, int count, int widx, int nw, int wave, int lane) {
    LAS float* scr = (LAS float*)(lds + wave * 16640);
    bf16_t* wbase = (bf16_t*)(a.ws() + WS_W);
    for (int it = first + widx; it < first + count; it += nw) {
        const int l = it / I_LAYER; int r = it % I_LAYER; bf16_t* wl = wbase + (size_t)l * W_LAYER;
        if (r < I_FIN) { transpose_item(a.in(4) + (size_t)l * D * 2 * DFF, D, 2 * DFF, a.in(3) + l * D, wl + WO_F1IN, 1, r, scr, lane); continue; } r -= I_FIN;
        if (r < I_FOUT) { transpose_item(a.in(5) + (size_t)l * DFF * D, DFF, D, nullptr, wl + WO_F1OUT, 0, r, scr, lane); continue; } r -= I_FOUT;
        if (r < I_QKV) { transpose_item(a.in(7) + (size_t)l * D * QKVW, D, QKVW, a.in(6) + l * D, wl + WO_QKV, 2, r, scr, lane); continue; } r -= I_QKV;
        if (r < I_SQ) { transpose_item(a.in(13) + (size_t)l * D * D, D, D, nullptr, wl + WO_WO, 0, r, scr, lane); continue; } r -= I_SQ;
        if (r < I_FIN) { transpose_item(a.in(15) + (size_t)l * D * 2 * DFF, D, 2 * DFF, a.in(14) + l * D, wl + WO_F2IN, 1, r, scr, lane); continue; } r -= I_FIN;
        if (r < I_FOUT) { transpose_item(a.in(16) + (size_t)l * DFF * D, DFF, D, nullptr, wl + WO_F2OUT, 0, r, scr, lane); continue; } r -= I_FOUT;
        if (r < I_SQ) { transpose_item(a.in(18) + (size_t)l * D * D, D, D, a.in(17) + l * D, wl + WO_WG, 0, r, scr, lane); continue; } r -= I_SQ;
        transpose_item(a.in(19) + (size_t)l * PLE * D, PLE, D, nullptr, wl + WO_WP, 0, r, scr, lane);
    }
}
template <class AT> __device__ __forceinline__ void prologue_phase(const AT& a, LAS unsigned char* lds, int gw, int NGW, int wave, int lane, bool side_jobs) {
    if (side_jobs) convert_weight_items(a, lds, IT_FIN1, I_FIN, gw, NGW, wave, lane);
    else convert_weight_items(a, lds, 0, DEPTH * I_LAYER, gw, NGW, wave, lane);
    const float* x = a.in(0); bf16_t* xb = (bf16_t*)(a.ws() + WS_XB); bf16_t* xlo = (bf16_t*)a.out(); float* ssp = (float*)(a.ws() + WS_SSP);
    for (int row = gw; row < M; row += 2 * NGW) {
        const int row2 = row + NGW; const bool has2 = row2 < M;
        const float4* xr = (const float4*)(x + (size_t)row * D); const float4* xr2 = (const float4*)(x + (size_t)(has2 ? row2 : row) * D);
        float4 va[4], vb[4];
#pragma unroll
        for (int j = 0; j < 4; ++j) { va[j] = xr[lane + 64 * j]; vb[j] = xr2[lane + 64 * j]; }
        float s = 0.f, s2 = 0.f;
#pragma unroll
        for (int j = 0; j < 4; ++j) { s += va[j].x * va[j].x + va[j].y * va[j].y + va[j].z * va[j].z + va[j].w * va[j].w; s2 += vb[j].x * vb[j].x + vb[j].y * vb[j].y + vb[j].z * vb[j].z + vb[j].w * vb[j].w;
            uint2 o; o.x = pg8::cvt_pk_bf16(va[j].x, va[j].y); o.y = pg8::cvt_pk_bf16(va[j].z, va[j].w); ((uint2*)(xb + (size_t)row * D))[lane + 64 * j] = o;
            uint2 q; q.x = pg8::cvt_pk_bf16(va[j].x - pg8::bflo(o.x), va[j].y - pg8::bfhi(o.x)); q.y = pg8::cvt_pk_bf16(va[j].z - pg8::bflo(o.y), va[j].w - pg8::bfhi(o.y)); ((uint2*)(xlo + (size_t)row * D))[lane + 64 * j] = q;
            if (has2) { uint2 o2; o2.x = pg8::cvt_pk_bf16(vb[j].x, vb[j].y); o2.y = pg8::cvt_pk_bf16(vb[j].z, vb[j].w); ((uint2*)(xb + (size_t)row2 * D))[lane + 64 * j] = o2;
                uint2 q2; q2.x = pg8::cvt_pk_bf16(vb[j].x - pg8::bflo(o2.x), vb[j].y - pg8::bfhi(o2.x)); q2.y = pg8::cvt_pk_bf16(vb[j].z - pg8::bflo(o2.y), vb[j].w - pg8::bfhi(o2.y)); ((uint2*)(xlo + (size_t)row2 * D))[lane + 64 * j] = q2; } }
#pragma unroll
        for (int o = 1; o < 64; o <<= 1) { s += pg8::shx(s, lane, o); s2 += pg8::shx(s2, lane, o); }
        if (lane < 4) { float4 r; r.x = lane == 0 ? s : 0.f; r.y = 0.f; r.z = 0.f; r.w = 0.f; ((float4*)ssp)[row * 4 + lane] = r;
            if (has2) { r.x = lane == 0 ? s2 : 0.f; ((float4*)ssp)[row2 * 4 + lane] = r; } }
    }
}
__device__ __forceinline__ void convert_p(const float* p, bf16_t* pb, int gtid, int nthreads) {
    for (int i = gtid; i < M * PLE / 8; i += nthreads) { const float4 v0 = ((const float4*)p)[2 * i], v1 = ((const float4*)p)[2 * i + 1];
        v4u o; o.x = pg8::cvt_pk_bf16(v0.x, v0.y); o.y = pg8::cvt_pk_bf16(v0.z, v0.w); o.z = pg8::cvt_pk_bf16(v1.x, v1.y); o.w = pg8::cvt_pk_bf16(v1.z, v1.w); ((v4u*)pb)[i] = o; }
}

__device__ __forceinline__ void attn_simple_phase(LAS unsigned char* lds, const AttnIn& a, int G, int wave, int lane) {
    LAS float* pl = (LAS float*)(lds + wave * 4096); LAS int* kl = (LAS int*)(lds + wave * 4096 + 2048);
    const int total = NB * 16 * S;
    for (int item = blockIdx.x * NWAVES + wave; item < total; item += G * NWAVES) {
        const int t = item & (S - 1), head = (item >> 12) & 15, b = item >> 16;
        const bool isA = head < 8;
        const bf16_t *q, *k, *v;
        if (isA) { q = a.qa + (((size_t)b * 8 + head) * S + t) * HD; k = a.ka + ((size_t)b * 8 + head) * S * HD; v = a.va + ((size_t)b * 8 + head) * S * HD; }
        else { const int hq = head - 8, hk = hq >> 2; q = a.qb + (((size_t)b * 8 + hq) * S + t) * HD; k = a.kb + ((size_t)b * 2 + hk) * S * HD; v = a.vb + ((size_t)b * 2 + hk) * S * HD; }
        float qf[HD];
#pragma unroll
        for (int e = 0; e < HD; ++e) qf[e] = bf2f(q[e]);
        const int nk = isA ? 387 : 257;
        float mx = -1e30f;
        for (int i = lane; i < nk; i += 64) {
            int rel;
            if (isA) { const int br = i / 129, j = i % 129 - 64; rel = j * (br == 0 ? 1 : br == 1 ? 4 : 16); } else rel = i - 128;
            const int tk = t + rel; float lg = -1e30f;
            if (tk >= 0 && tk < S) { float d = 0.f; const bf16_t* kr = k + (size_t)tk * HD;
#pragma unroll
                for (int e = 0; e < HD; ++e) d += qf[e] * bf2f(kr[e]);
                lg = d + a.rel_bias[t5_bucket(rel) * 16 + head] * LOG2E; }
            pl[i] = lg; kl[i] = tk; mx = fmaxf(mx, lg);
        }
#pragma unroll
        for (int o = 1; o < 64; o <<= 1) mx = fmaxf(mx, pg8::shx(mx, lane, o));
        float sinkl = 0.f;
        if (!isA) { sinkl = a.sink[head - 8] * LOG2E; mx = fmaxf(mx, sinkl); }
        float sum = 0.f;
        for (int i = lane; i < nk; i += 64) { const float lg = pl[i]; const float pv = lg > -1e29f ? exp2f(lg - mx) : 0.f; pl[i] = pv; sum += pv; }
#pragma unroll
        for (int o = 1; o < 64; o <<= 1) sum += pg8::shx(sum, lane, o);
        if (!isA) sum += exp2f(sinkl - mx);
        asm volatile("s_waitcnt lgkmcnt(0)" ::: "memory");
        float acc = 0.f;
        for (int i = 0; i < nk; ++i) { const float pv = pl[i]; if (pv != 0.f) acc += pv * bf2f(v[(size_t)kl[i] * HD + lane]); }
        a.o[((size_t)b * S + t) * D + head * HD + lane] = f2bf(acc / sum);
    }
}

namespace att {
typedef short bf16x8 __attribute__((ext_vector_type(8)));
typedef short s16x4 __attribute__((ext_vector_type(4)));
typedef short v4i16_t __attribute__((ext_vector_type(4)));
typedef float f32x16 __attribute__((ext_vector_type(16)));
typedef unsigned u32x4 __attribute__((ext_vector_type(4)));
typedef float f32x2_t __attribute__((ext_vector_type(2))); typedef __bf16 bf16x2_t __attribute__((ext_vector_type(2)));
constexpr float NEG = -1e30f;
constexpr int WAVE_LDS = 8704, LUT_OFF = 0, WAVES_OFF = 8192, LUTA_STRIDE = 200, LUTB_STRIDE = 328, LUTB_OFF = LUT_OFF + 3 * LUTA_STRIDE * 4, TAB_OFF = WAVES_OFF + 8 * WAVE_LDS, LSE_OFF = TAB_OFF + 65536, ATT_LDS_END = LSE_OFF + 2048;
static_assert(LUTB_OFF + 4 * LUTB_STRIDE * 4 <= WAVES_OFF && ATT_LDS_END <= 147456 - 64, "attention LDS map");
__device__ __forceinline__ int crow(int r, int hi) { return (r & 3) + 8 * (r >> 2) + 4 * hi; }
__device__ __forceinline__ unsigned cvtpk(float lo, float hi) { f32x2_t v = {lo, hi}; bf16x2_t b = __builtin_convertvector(v, bf16x2_t); return __builtin_bit_cast(unsigned, b); }
__device__ __forceinline__ s16x4 vtr(const LAS unsigned char* p) { return __builtin_bit_cast(s16x4, __builtin_amdgcn_ds_read_tr16_b64_v4i16((LAS v4i16_t*)p)); }
__device__ __forceinline__ float halfmax(float v) { auto rr = __builtin_amdgcn_permlane32_swap(__float_as_uint(v), __float_as_uint(v), false, false); return fmaxf(__uint_as_float(rr[0]), __uint_as_float(rr[1])); }
__device__ __forceinline__ float halfsum(float v) { auto rr = __builtin_amdgcn_permlane32_swap(__float_as_uint(v), __float_as_uint(v), false, false); return __uint_as_float(rr[0]) + __uint_as_float(rr[1]); }

__device__ __forceinline__ void bias_add(f32x16& p, const LAS float* lut, const int j, const int i, const int hi) {
    const LAS float* lp = lut + 32 * j - i + 4 * hi;
#pragma unroll
    for (int r = 0; r < 16; ++r) p[r] += lp[(r & 3) + 8 * (r >> 2)];
}
template <int NT>
__device__ __forceinline__ void qtile(const bf16_t* qrow, const bf16_t* kbase, const bf16_t* vbase, int tk0, int dstep, const LAS float* lut, float m0, float l0,
                                      LAS unsigned char* wl, int lane_in, f32x16 (&o)[2], float& m_out, float& l_out) {
    int lane = lane_in; asm volatile("" : "+v"(lane));
    const int i = lane & 31, hi = lane >> 5;
    LAS float* wsf = (LAS float*)(wl + 8192);
    constexpr int C = NT / 2;
    bf16x8 qf[4];
#pragma unroll
    for (int ks = 0; ks < 4; ++ks) qf[ks] = *(const bf16x8*)(qrow + 16 * ks + 8 * hi);
    const int vrow = lane >> 3, vsw = (lane & 7) ^ (((lane >> 4) & 1) << 2);
    const int rd_base = (4 * hi + ((lane & 15) >> 2)) * 128 + 32 * ((lane >> 4) & 1) + 8 * (lane & 3);
    const int bit3 = (lane >> 3) & 1;
    const int vb0 = rd_base + 64 * bit3, vb1 = rd_base + 64 * (1 - bit3);
    bf16x8 kf[4];
#define ATT_LOAD(j, buf) do { \
        { int tk = tk0 + (32 * (j) + i) * dstep; tk = tk < 0 ? 0 : (tk > S - 1 ? S - 1 : tk); const bf16_t* kp = kbase + (size_t)tk * HD + 8 * hi; \
          _Pragma("unroll") for (int ks = 0; ks < 4; ++ks) kf[ks] = *(const bf16x8*)(kp + 16 * ks); } \
        _Pragma("unroll") for (int i4 = 0; i4 < 4; ++i4) { int tk = tk0 + (32 * (j) + vrow + 8 * i4) * dstep; tk = tk < 0 ? 0 : (tk > S - 1 ? S - 1 : tk); \
          __builtin_amdgcn_global_load_lds((const unsigned*)(vbase + (size_t)tk * HD + 8 * vsw), (LAS unsigned*)(wl + (buf) * 4096 + i4 * 1024), 16, 0, 0); } } while (0)
    float m = m0, l = hi == 0 ? l0 : 0.f;
    o[0] = f32x16{}; o[1] = f32x16{};
    ATT_LOAD(C, 0);
#pragma unroll 1
    for (int s = 0; s < NT; ++s) {
        const int j = (s == 0) ? C : (s <= C ? s - 1 : s);
        LAS unsigned char* vbuf = wl + (s & 1) * 4096;
        asm volatile("s_waitcnt vmcnt(0)" ::: "memory");
        f32x16 p = __builtin_amdgcn_mfma_f32_32x32x16_bf16(kf[0], qf[0], f32x16{}, 0, 0, 0);
        p = __builtin_amdgcn_mfma_f32_32x32x16_bf16(kf[1], qf[1], p, 0, 0, 0);
        p = __builtin_amdgcn_mfma_f32_32x32x16_bf16(kf[2], qf[2], p, 0, 0, 0);
        p = __builtin_amdgcn_mfma_f32_32x32x16_bf16(kf[3], qf[3], p, 0, 0, 0);
        bias_add(p, lut, j, i, hi);
        if (s + 1 < NT) { const int jn = (s + 1 <= C) ? s : s + 1; ATT_LOAD(jn, (s + 1) & 1); }
        const int first = tk0 + 32 * j * dstep, lastk = first + 31 * dstep;
        const bool inside = first >= 0 && lastk < S;
        if (!inside) {
#pragma unroll
            for (int r = 0; r < 16; ++r) { const int tk = first + crow(r, hi) * dstep; if ((unsigned)tk >= (unsigned)S) p[r] = NEG; }
        }
        float rm = p[0];
#pragma unroll
        for (int r = 1; r < 16; ++r) rm = fmaxf(rm, p[r]);
        rm = halfmax(rm);
        if (__any(rm > m)) {
            const float mn = fmaxf(m, rm), alpha = __builtin_amdgcn_exp2f(m - mn);
            l *= alpha; m = mn;
            if (hi == 0) wsf[i] = alpha;
#pragma unroll
            for (int r = 0; r < 16; ++r) { const float a = wsf[crow(r, hi)]; o[0][r] *= a; o[1][r] *= a; }
        }
        f32x2_t rs2 = {0.f, 0.f}; const f32x2_t nm2 = {-m, -m};
#pragma unroll
        for (int r = 0; r < 16; r += 2) { f32x2_t t = (f32x2_t){p[r], p[r + 1]} + nm2; t.x = __builtin_amdgcn_exp2f(t.x); t.y = __builtin_amdgcn_exp2f(t.y); p[r] = t.x; p[r + 1] = t.y; rs2 += t; }
        l += rs2.x + rs2.y;
        u32x4 pw0 = {cvtpk(p[0], p[1]), cvtpk(p[2], p[3]), cvtpk(p[4], p[5]), cvtpk(p[6], p[7])};
        u32x4 pw1 = {cvtpk(p[8], p[9]), cvtpk(p[10], p[11]), cvtpk(p[12], p[13]), cvtpk(p[14], p[15])};
        const bf16x8 pa0 = __builtin_bit_cast(bf16x8, pw0), pa1 = __builtin_bit_cast(bf16x8, pw1);
#pragma unroll
        for (int d0 = 0; d0 < 2; ++d0) {
            const unsigned vp = (unsigned)(uintptr_t)(vbuf + (d0 == 0 ? vb0 : vb1));
            s16x4 a0, a1, b0, b1;
            asm volatile("ds_read_b64_tr_b16 %0, %1" : "=&v"(a0) : "v"(vp) : "memory");
            asm volatile("ds_read_b64_tr_b16 %0, %1 offset:1024" : "=&v"(a1) : "v"(vp) : "memory");
            asm volatile("ds_read_b64_tr_b16 %0, %1 offset:2048" : "=&v"(b0) : "v"(vp) : "memory");
            asm volatile("ds_read_b64_tr_b16 %0, %1 offset:3072" : "=&v"(b1) : "v"(vp) : "memory");
            asm volatile("s_waitcnt lgkmcnt(0)" : "+v"(a0), "+v"(a1), "+v"(b0), "+v"(b1) :: "memory"); __builtin_amdgcn_sched_barrier(0);
            const bf16x8 f0 = {a0[0], a0[1], a0[2], a0[3], a1[0], a1[1], a1[2], a1[3]}, f1 = {b0[0], b0[1], b0[2], b0[3], b1[0], b1[1], b1[2], b1[3]};
            o[d0] = __builtin_amdgcn_mfma_f32_32x32x16_bf16(pa0, f0, o[d0], 0, 0, 0);
            o[d0] = __builtin_amdgcn_mfma_f32_32x32x16_bf16(pa1, f1, o[d0], 0, 0, 0);
        }
    }
#undef ATT_LOAD
    m_out = m; l_out = halfsum(l);
}

constexpr float MLOW = -1.0e4f;
constexpr float THR = 8.0f;
template <int NT>
__device__ __forceinline__ void sm_tile(f32x16& p, const LAS float* lut, const int j, const int i, const int hi, const int first, const int dstep, const bool inside,
                                        float& m, float& l, f32x16 (&o)[2], LAS float* wsf, bf16x8& pa0, bf16x8& pa1) {
    if (!inside) {
#pragma unroll
        for (int r = 0; r < 16; ++r) { const int tk = first + crow(r, hi) * dstep; if ((unsigned)tk >= (unsigned)S) p[r] = NEG; }
    }
    float rm = fmaxf(p[0], p[1]);
#pragma unroll
    for (int r = 2; r < 16; ++r) rm = fmaxf(rm, p[r]);
    rm = halfmax(rm);
    if (__any(rm > m + THR)) {
        const float mn = fmaxf(m, rm), alpha = __builtin_amdgcn_exp2f(m - mn);
        l *= alpha; m = mn;
        if (hi == 0) wsf[i] = alpha;
#pragma unroll
        for (int r = 0; r < 16; ++r) { const float a = wsf[crow(r, hi)]; o[0][r] *= a; o[1][r] *= a; }
    }
    f32x2_t rs2 = {0.f, 0.f}; const f32x2_t nm2 = {-m, -m};
#pragma unroll
    for (int r = 0; r < 16; r += 2) { f32x2_t t = (f32x2_t){p[r], p[r + 1]} + nm2; t.x = __builtin_amdgcn_exp2f(t.x); t.y = __builtin_amdgcn_exp2f(t.y); p[r] = t.x; p[r + 1] = t.y; rs2 += t; }
    l += rs2.x + rs2.y;
    u32x4 pw0 = {cvtpk(p[0], p[1]), cvtpk(p[2], p[3]), cvtpk(p[4], p[5]), cvtpk(p[6], p[7])};
    u32x4 pw1 = {cvtpk(p[8], p[9]), cvtpk(p[10], p[11]), cvtpk(p[12], p[13]), cvtpk(p[14], p[15])};
    pa0 = __builtin_bit_cast(bf16x8, pw0); pa1 = __builtin_bit_cast(bf16x8, pw1);
}
template <int NT, int SHIFT>
__device__ __forceinline__ void qtile2(const bf16_t* qrow0, const bf16_t* qrow1, const bf16_t* kbase, const bf16_t* vbase, int tk0, int dstep, const LAS float* lut0, const LAS float* lut1,
                                       float mi0, float li0, float mi1, float li1, LAS unsigned char* wl, int lane_in,
                                       f32x16 (&o0)[2], float& m0_out, float& l0_out, f32x16 (&o1)[2], float& m1_out, float& l1_out) {
    int lane = lane_in; asm volatile("" : "+v"(lane));
    const int i = lane & 31, hi = lane >> 5;
    LAS float* wsf = (LAS float*)(wl + 8192);
    bf16x8 qf0[4], qf1[4];
#pragma unroll
    for (int ks = 0; ks < 4; ++ks) { qf0[ks] = *(const bf16x8*)(qrow0 + 16 * ks + 8 * hi); qf1[ks] = *(const bf16x8*)(qrow1 + 16 * ks + 8 * hi); }
    const int vrow = lane >> 3, vsw = (lane & 7) ^ (((lane >> 4) & 1) << 2);
    const int rd_base = (4 * hi + ((lane & 15) >> 2)) * 128 + 32 * ((lane >> 4) & 1) + 8 * (lane & 3);
    const int bit3 = (lane >> 3) & 1;
    const int vb0 = rd_base + 64 * bit3, vb1 = rd_base + 64 * (1 - bit3);
    bf16x8 kf[4];
#define ATT_LOAD(j, buf) do { \
        { int tk = tk0 + (32 * (j) + i) * dstep; tk = tk < 0 ? 0 : (tk > S - 1 ? S - 1 : tk); const bf16_t* kp = kbase + (size_t)tk * HD + 8 * hi; \
          _Pragma("unroll") for (int ks = 0; ks < 4; ++ks) kf[ks] = *(const bf16x8*)(kp + 16 * ks); } \
        _Pragma("unroll") for (int i4 = 0; i4 < 4; ++i4) { int tk = tk0 + (32 * (j) + vrow + 8 * i4) * dstep; tk = tk < 0 ? 0 : (tk > S - 1 ? S - 1 : tk); \
          __builtin_amdgcn_global_load_lds((const unsigned*)(vbase + (size_t)tk * HD + 8 * vsw), (LAS unsigned*)(wl + (buf) * 4096 + i4 * 1024), 16, 0, 0); } } while (0)
    float m0 = mi0, l0 = hi == 0 ? li0 : 0.f, m1 = mi1, l1 = hi == 0 ? li1 : 0.f;
    o0[0] = f32x16{}; o0[1] = f32x16{}; o1[0] = f32x16{}; o1[1] = f32x16{};
    ATT_LOAD(0, 0);
#pragma unroll 1
    for (int jj = 0; jj < NT + SHIFT; ++jj) {
        LAS unsigned char* vbuf = wl + (jj & 1) * 4096;
        const bool a0 = jj < NT, a1 = jj >= SHIFT;
        const int first = tk0 + 32 * jj * dstep, lastk = first + 31 * dstep;
        const bool inside = first >= 0 && lastk < S;
        asm volatile("s_waitcnt vmcnt(0)" ::: "memory");
        f32x16 p0, p1;
        bf16x8 pa00, pa01, pa10, pa11;
        {
            if (a0) {
                p0 = __builtin_amdgcn_mfma_f32_32x32x16_bf16(kf[0], qf0[0], f32x16{}, 0, 0, 0);
#pragma unroll
                for (int ks = 1; ks < 4; ++ks) p0 = __builtin_amdgcn_mfma_f32_32x32x16_bf16(kf[ks], qf0[ks], p0, 0, 0, 0);
            }
            if (a1) {
                p1 = __builtin_amdgcn_mfma_f32_32x32x16_bf16(kf[0], qf1[0], f32x16{}, 0, 0, 0);
#pragma unroll
                for (int ks = 1; ks < 4; ++ks) p1 = __builtin_amdgcn_mfma_f32_32x32x16_bf16(kf[ks], qf1[ks], p1, 0, 0, 0);
            }
        }
        if (a0) bias_add(p0, lut0, jj, i, hi);
        if (a1) bias_add(p1, lut1, jj - SHIFT, i, hi);
        if (jj + 1 < NT + SHIFT) ATT_LOAD(jj + 1, (jj + 1) & 1);
        {
            if (a0) sm_tile<NT>(p0, lut0, jj, i, hi, first, dstep, inside, m0, l0, o0, wsf, pa00, pa01);
            if (a1) sm_tile<NT>(p1, lut1, jj - SHIFT, i, hi, first, dstep, inside, m1, l1, o1, wsf, pa10, pa11);
#pragma unroll
            for (int d0 = 0; d0 < 2; ++d0) {
                const unsigned vp = (unsigned)(uintptr_t)(vbuf + (d0 == 0 ? vb0 : vb1));
                s16x4 x0, x1, y0, y1;
                asm volatile("ds_read_b64_tr_b16 %0, %1" : "=&v"(x0) : "v"(vp) : "memory");
                asm volatile("ds_read_b64_tr_b16 %0, %1 offset:1024" : "=&v"(x1) : "v"(vp) : "memory");
                asm volatile("ds_read_b64_tr_b16 %0, %1 offset:2048" : "=&v"(y0) : "v"(vp) : "memory");
                asm volatile("ds_read_b64_tr_b16 %0, %1 offset:3072" : "=&v"(y1) : "v"(vp) : "memory");
                asm volatile("s_waitcnt lgkmcnt(0)" : "+v"(x0), "+v"(x1), "+v"(y0), "+v"(y1) :: "memory"); __builtin_amdgcn_sched_barrier(0);
                const bf16x8 f0 = {x0[0], x0[1], x0[2], x0[3], x1[0], x1[1], x1[2], x1[3]}, f1 = {y0[0], y0[1], y0[2], y0[3], y1[0], y1[1], y1[2], y1[3]};
                if (a0) { o0[d0] = __builtin_amdgcn_mfma_f32_32x32x16_bf16(pa00, f0, o0[d0], 0, 0, 0); o0[d0] = __builtin_amdgcn_mfma_f32_32x32x16_bf16(pa01, f1, o0[d0], 0, 0, 0); }
                if (a1) { o1[d0] = __builtin_amdgcn_mfma_f32_32x32x16_bf16(pa10, f0, o1[d0], 0, 0, 0); o1[d0] = __builtin_amdgcn_mfma_f32_32x32x16_bf16(pa11, f1, o1[d0], 0, 0, 0); }
            }
        }
    }
#undef ATT_LOAD
    m0_out = m0; l0_out = halfsum(l0); m1_out = m1; l1_out = halfsum(l1);
}

__device__ __forceinline__ void glds16(const void* gsrc, unsigned lds_dst) { unsigned keep;
    asm volatile("s_mov_b32 %0, m0\n\ts_mov_b32 m0, %2\n\ts_nop 0\n\tglobal_load_lds_dwordx4 %1, off\n\ts_mov_b32 m0, %0" : "=&s"(keep) : "v"(gsrc), "s"(lds_dst) : "memory"); }
__device__ __forceinline__ void qtile16(const bf16_t* qrow, const bf16_t* kbase, const bf16_t* vbase, const int tk0, const LAS float* lut, LAS unsigned char* wl, LAS unsigned char* xbuf,
                                        int lane_in, f32x16 (&o)[2], float& m_out, float& l_out) {
    int lane = lane_in; asm volatile("" : "+v"(lane));
    const int i = lane & 31, hi = lane >> 5;
    LAS float* wsf = (LAS float*)(wl + 8192);
    bf16x8 qf[4];
    { const bf16_t* qp = qrow + 8 * hi;
      asm volatile("global_load_dwordx4 %0, %1, off" : "=v"(qf[0]) : "v"(qp) : "memory"); asm volatile("global_load_dwordx4 %0, %1, off offset:32" : "=v"(qf[1]) : "v"(qp) : "memory");
      asm volatile("global_load_dwordx4 %0, %1, off offset:64" : "=v"(qf[2]) : "v"(qp) : "memory"); asm volatile("global_load_dwordx4 %0, %1, off offset:96" : "=v"(qf[3]) : "v"(qp) : "memory"); }
    const int vrow = lane >> 3, vsw = (lane & 7) ^ (((lane >> 4) & 1) << 2);
    const int rd_base = (4 * hi + ((lane & 15) >> 2)) * 128 + 32 * ((lane >> 4) & 1) + 8 * (lane & 3);
    const int bit3 = (lane >> 3) & 1;
    const int vb0 = rd_base + 64 * bit3, vb1 = rd_base + 64 * (1 - bit3);
    const unsigned b0 = (unsigned)__builtin_amdgcn_readfirstlane((int)(unsigned)(uintptr_t)wl), b1 = b0 + 4096u, b2 = (unsigned)__builtin_amdgcn_readfirstlane((int)(unsigned)(uintptr_t)xbuf);
    bf16x8 kf[5][4];
#define Q16_K(t) do { int tk = tk0 + (32 * (t) + i) * 16; tk = tk < 0 ? 0 : (tk > S - 1 ? S - 1 : tk); const bf16_t* kp = kbase + (size_t)tk * HD + 8 * hi; \
        asm volatile("global_load_dwordx4 %0, %1, off" : "=v"(kf[t][0]) : "v"(kp) : "memory"); asm volatile("global_load_dwordx4 %0, %1, off offset:32" : "=v"(kf[t][1]) : "v"(kp) : "memory"); \
        asm volatile("global_load_dwordx4 %0, %1, off offset:64" : "=v"(kf[t][2]) : "v"(kp) : "memory"); asm volatile("global_load_dwordx4 %0, %1, off offset:96" : "=v"(kf[t][3]) : "v"(kp) : "memory"); } while (0)
#define Q16_V(t, buf) do { _Pragma("unroll") for (int i4 = 0; i4 < 4; ++i4) { int tk = tk0 + (32 * (t) + vrow + 8 * i4) * 16; tk = tk < 0 ? 0 : (tk > S - 1 ? S - 1 : tk); \
        glds16(vbase + (size_t)tk * HD + 8 * vsw, (buf) + i4 * 1024u); } } while (0)
#define Q16_WAIT(t, n) do { asm volatile("s_waitcnt vmcnt(" #n ")" : "+v"(kf[t][0]), "+v"(kf[t][1]), "+v"(kf[t][2]), "+v"(kf[t][3]) :: "memory"); __builtin_amdgcn_sched_barrier(0); } while (0)
    Q16_K(0); Q16_V(0, b0); Q16_K(1); Q16_V(1, b1); Q16_K(2); Q16_V(2, b2); Q16_K(3); Q16_K(4);
    float m = MLOW, l = 0.f;
    o[0] = f32x16{}; o[1] = f32x16{};
#define Q16_STEP(t, nwait, vimg, AFTER) do { \
        Q16_WAIT(t, nwait); \
        f32x16 p = __builtin_amdgcn_mfma_f32_32x32x16_bf16(kf[t][0], qf[0], f32x16{}, 0, 0, 0); \
        p = __builtin_amdgcn_mfma_f32_32x32x16_bf16(kf[t][1], qf[1], p, 0, 0, 0); p = __builtin_amdgcn_mfma_f32_32x32x16_bf16(kf[t][2], qf[2], p, 0, 0, 0); p = __builtin_amdgcn_mfma_f32_32x32x16_bf16(kf[t][3], qf[3], p, 0, 0, 0); \
        bias_add(p, lut, (t), i, hi); \
        const int first_ = tk0 + 32 * (t) * 16; const bool inside_ = first_ >= 0 && first_ + 31 * 16 < S; \
        bf16x8 pa0_, pa1_; sm_tile<5>(p, lut, (t), i, hi, first_, 16, inside_, m, l, o, wsf, pa0_, pa1_); \
        _Pragma("unroll") for (int d0 = 0; d0 < 2; ++d0) { const unsigned vp = (vimg) + (unsigned)(d0 == 0 ? vb0 : vb1); s16x4 a0, a1, c0, c1; \
            asm volatile("ds_read_b64_tr_b16 %0, %1" : "=&v"(a0) : "v"(vp) : "memory"); asm volatile("ds_read_b64_tr_b16 %0, %1 offset:1024" : "=&v"(a1) : "v"(vp) : "memory"); \
            asm volatile("ds_read_b64_tr_b16 %0, %1 offset:2048" : "=&v"(c0) : "v"(vp) : "memory"); asm volatile("ds_read_b64_tr_b16 %0, %1 offset:3072" : "=&v"(c1) : "v"(vp) : "memory"); \
            asm volatile("s_waitcnt lgkmcnt(0)" : "+v"(a0), "+v"(a1), "+v"(c0), "+v"(c1) :: "memory"); __builtin_amdgcn_sched_barrier(0); \
            const bf16x8 f0 = {a0[0], a0[1], a0[2], a0[3], a1[0], a1[1], a1[2], a1[3]}, f1 = {c0[0], c0[1], c0[2], c0[3], c1[0], c1[1], c1[2], c1[3]}; \
            o[d0] = __builtin_amdgcn_mfma_f32_32x32x16_bf16(pa0_, f0, o[d0], 0, 0, 0); o[d0] = __builtin_amdgcn_mfma_f32_32x32x16_bf16(pa1_, f1, o[d0], 0, 0, 0); } \
        AFTER; } while (0)
    asm volatile("s_waitcnt vmcnt(24)" : "+v"(qf[0]), "+v"(qf[1]), "+v"(qf[2]), "+v"(qf[3]) :: "memory");
    Q16_STEP(0, 24, b0, Q16_V(3, b0));
    Q16_STEP(1, 20, b1, Q16_V(4, b1));
    Q16_STEP(2, 16, b2, (void)0);
    Q16_STEP(3, 4, b0, (void)0);
    Q16_STEP(4, 0, b1, (void)0);
#undef Q16_K
#undef Q16_V
#undef Q16_WAIT
#undef Q16_STEP
    m_out = m; l_out = halfsum(l);
}

__device__ __forceinline__ void stage_o(const f32x16 (&o)[2], float m, float l, LAS unsigned char* wl, int lane_in) {
    int lane = lane_in; asm volatile("" : "+v"(lane));
    const int i = lane & 31, hi = lane >> 5;
    LAS float* wsf = (LAS float*)(wl + 8192);
    if (hi == 0) { wsf[i] = __builtin_amdgcn_rcpf(l); wsf[32 + i] = m + __builtin_amdgcn_logf(l); }
    LAS bf16_t* stg = (LAS bf16_t*)wl;
#pragma unroll
    for (int r = 0; r < 16; ++r) { const int q = crow(r, hi); const float inv = wsf[q];
        stg[q * 64 + i] = (bf16_t)(cvtpk(o[0][r] * inv, 0.f) & 0xffffu); stg[q * 64 + 32 + i] = (bf16_t)(cvtpk(o[1][r] * inv, 0.f) & 0xffffu); }
}
__device__ __forceinline__ float bflo(unsigned w) { return __uint_as_float(w << 16); }
__device__ __forceinline__ float bfhi(unsigned w) { return __uint_as_float(w & 0xffff0000u); }
__device__ __forceinline__ unsigned mix2(unsigned a, unsigned b, float wa, float wb) { return cvtpk(wa * bflo(a) + wb * bflo(b), wa * bfhi(a) + wb * bfhi(b)); }

struct Tensors { const bf16_t *qa, *ka, *va, *qb, *kb, *vb; const float* glut; const float* sink; bf16_t* o; };
__device__ __forceinline__ void finish_a(const f32x16 (&o)[2], float m, float l, int pass, int d, int lam0, int rr, LAS unsigned char* wl, LAS unsigned char* tab, LAS float* lsetab, bf16_t* orow0, int lane_in) {
    LAS float* wsf = (LAS float*)(wl + 8192);
    stage_o(o, m, l, wl, lane_in);
    int lane = lane_in; asm volatile("" : "+v"(lane));
#pragma unroll
    for (int i4 = 0; i4 < 4; ++i4) {
        const int qi = (lane >> 3) + 8 * i4, ch = lane & 7, tau = d * (lam0 + qi) + rr;
        u32x4 v = *(const LAS u32x4*)(wl + qi * 128 + ch * 16);
        const float Lb = wsf[32 + qi];
        const int e = (tau & 15) * 32 + (tau >> 4);
        LAS u32x4* te = (LAS u32x4*)(tab + e * 128 + ch * 16);
        if (pass == 0) { *te = v; if (ch == 0) lsetab[e] = Lb; }
        else {
            const u32x4 tv = *te; const float La = lsetab[e];
            const float Lm = fmaxf(La, Lb), sa = __builtin_amdgcn_exp2f(La - Lm), sb = __builtin_amdgcn_exp2f(Lb - Lm), tot = sa + sb, rt = __builtin_amdgcn_rcpf(tot), wa = sa * rt, wb = sb * rt;
            u32x4 w; w.x = mix2(tv.x, v.x, wa, wb); w.y = mix2(tv.y, v.y, wa, wb); w.z = mix2(tv.z, v.z, wa, wb); w.w = mix2(tv.w, v.w, wa, wb);
            if (pass == 1) { *te = w; if (ch == 0) lsetab[e] = Lm + __builtin_amdgcn_logf(tot); }
            else *(u32x4*)(orow0 + (size_t)tau * D + ch * 8) = w;
        }
    }
}


__device__ __forceinline__ int bucket(int rel) {
    const int n = rel < 0 ? -rel : rel; const int ret = rel > 0 ? 16 : 0;
    if (n < 8) return ret + n;
    int large = 8 + (int)(logf((float)n / 8.0f) / 4.852030263919617f * 8.0f);
    large = large < 15 ? large : 15;
    return ret + large;
}

constexpr int GLUT_A = 8 * 3 * LUTA_STRIDE, GLUT_B = 2 * 4 * LUTB_STRIDE;
__device__ __forceinline__ void build_luts(const float* rel_bias, float* glut, int gtid, int nthreads) {
    for (int e = gtid; e < GLUT_A + GLUT_B; e += nthreads) {
        float v = NEG;
        if (e < GLUT_A) { const int h = e / (3 * LUTA_STRIDE), c = (e / LUTA_STRIDE) % 3, idx = e % LUTA_STRIDE - 32, d = c == 0 ? 1 : (c == 1 ? 4 : 16);
            if (idx >= 0 && idx <= 128) v = rel_bias[bucket((idx - 64) * d) * 16 + h] * LOG2E; }
        else { const int f = e - GLUT_A, hk = f / (4 * LUTB_STRIDE), g = (f / LUTB_STRIDE) & 3, idx = f % LUTB_STRIDE - 32;
            if (idx >= 0 && idx <= 256) v = rel_bias[bucket(idx - 128) * 16 + 8 + 4 * hk + g] * LOG2E; }
        glut[e] = v;
    }
}
__device__ __forceinline__ void attn_unit(const Tensors& T, int u, LAS unsigned char* lds, int wave, int lane, const int pmode = 0x33) {
    LAS unsigned char* wl = lds + WAVES_OFF + wave * WAVE_LDS;
    LAS float* wsf = (LAS float*)(wl + 8192);
    LAS float* lutA = (LAS float*)(lds + LUT_OFF); LAS float* lutB = (LAS float*)(lds + LUTB_OFF);
    LAS unsigned char* tab = lds + TAB_OFF; LAS float* lsetab = (LAS float*)(lds + LSE_OFF);
    const int tid = wave * 64 + lane;
    const int i = lane & 31;
    __syncthreads();
    { const int hkb = (u >> 5) & 1, ha = (u >> 3) & 7;
      const float* ga = T.glut + ha * 3 * LUTA_STRIDE; const float* gb = T.glut + GLUT_A + hkb * 4 * LUTB_STRIDE;
      for (int e = tid; e < 3 * LUTA_STRIDE; e += 512) lutA[e] = ga[e];
      for (int e = tid; e < 4 * LUTB_STRIDE; e += 512) lutB[e] = gb[e]; }
    __syncthreads();
    if (pmode & 1) {
        const int bh = u >> 3, blk = u & 7, b = bh >> 3, h = bh & 7, t0 = blk * 512;
        const bf16_t* qbase = T.qa + (size_t)bh * S * HD; const bf16_t* kbase = T.ka + (size_t)bh * S * HD; const bf16_t* vbase = T.va + (size_t)bh * S * HD;
        bf16_t* orow0 = T.o + ((size_t)b * S + t0) * D + h * HD;
#pragma unroll 1
        for (int pass = 0; pass < (pmode >> 4); ++pass) {
            const int c = ATT_ORDER == 0 ? 2 - pass : (pass == 0 ? 2 : (pass == 1 ? 0 : 1)), d = c == 0 ? 1 : (c == 1 ? 4 : 16);
            const LAS float* lt = lutA + c * LUTA_STRIDE + 32;
            if (c == 2) {
#pragma unroll 1
                for (int tt = 0; tt < 2; ++tt) { const int rr = 2 * wave + tt;
                    f32x16 o1[2]; float m1, l1;
                    qtile16(qbase + (size_t)(t0 + d * i + rr) * HD, kbase, vbase, t0 - 64 * d + rr, lt, wl, tab + wave * 8192 + 4096, lane, o1, m1, l1);
                    finish_a(o1, m1, l1, pass, d, 0, rr, wl, tab, lsetab, orow0, lane); }
            } else {
                const int Tq = 2 * wave, rr = c == 1 ? (Tq >> 2) : 0, lamA = 32 * (c == 1 ? (Tq & 3) : Tq);
                f32x16 oA[2], oB[2]; float mA, lA, mB, lB;
                qtile2<5, 1>(qbase + (size_t)(t0 + d * (lamA + i) + rr) * HD, qbase + (size_t)(t0 + d * (lamA + 32 + i) + rr) * HD, kbase, vbase, t0 + d * (lamA - 64) + rr, d, lt, lt,
                             MLOW, 0.f, MLOW, 0.f, wl, lane, oA, mA, lA, oB, mB, lB);
                finish_a(oA, mA, lA, pass, d, lamA, rr, wl, tab, lsetab, orow0, lane);
                finish_a(oB, mB, lB, pass, d, lamA + 32, rr, wl, tab, lsetab, orow0, lane);
            }
            if (pass < 2) __syncthreads();
        }
    }
    if (pmode & 2) {
        const int bk = u >> 5, blk = u & 31, b = bk >> 1, hk = bk & 1, t0 = blk * 128;
        const bf16_t* kbase = T.kb + (size_t)bk * S * HD; const bf16_t* vbase = T.vb + (size_t)bk * S * HD;
        const int qt = wave & 3, g0 = 2 * (wave >> 2), hq0 = 4 * hk + g0;
        const int tq = t0 + 32 * qt + i, tk0 = t0 + 32 * qt - 128;
        f32x16 oA[2], oB[2]; float mA, lA, mB, lB;
        qtile2<9, 0>(T.qb + (((size_t)b * 8 + hq0) * S + tq) * HD, T.qb + (((size_t)b * 8 + hq0 + 1) * S + tq) * HD, kbase, vbase, tk0, 1,
                     lutB + g0 * LUTB_STRIDE + 32, lutB + (g0 + 1) * LUTB_STRIDE + 32, T.sink[hq0] * LOG2E, 1.0f, T.sink[hq0 + 1] * LOG2E, 1.0f, wl, lane, oA, mA, lA, oB, mB, lB);
        bf16_t* ob0 = T.o + ((size_t)b * S + t0 + 32 * qt) * D + (8 + hq0) * HD;
        stage_o(oA, mA, lA, wl, lane);
#pragma unroll
        for (int i4 = 0; i4 < 4; ++i4) { const int qi = (lane >> 3) + 8 * i4, ch = lane & 7; *(u32x4*)(ob0 + (size_t)qi * D + ch * 8) = *(const LAS u32x4*)(wl + qi * 128 + ch * 16); }
        stage_o(oB, mB, lB, wl, lane);
#pragma unroll
        for (int i4 = 0; i4 < 4; ++i4) { const int qi = (lane >> 3) + 8 * i4, ch = lane & 7; *(u32x4*)(ob0 + HD + (size_t)qi * D + ch * 8) = *(const LAS u32x4*)(wl + qi * 128 + ch * 16); }
    }
}
}

#define XB_TMO      128
#define XB_XCNT(j)  (256  + 64 * (j))
#define XB_XSUB(j)  (1280 + 64 * (j))
#define XB_XGEN(j)  (2304 + 64 * (j))
#define XB_TOP      3328
#define XB_TOPGEN   3392
#define XCD_BAR_WORDS 3456
#define XB_SPIN_CAP (1u << 18)

__device__ __forceinline__ unsigned xb_ld(unsigned* p)              { return __hip_atomic_load(p, __ATOMIC_RELAXED, __HIP_MEMORY_SCOPE_AGENT); }
__device__ __forceinline__ unsigned xb_add(unsigned* p, unsigned v) { return __hip_atomic_fetch_add(p, v, __ATOMIC_RELAXED, __HIP_MEMORY_SCOPE_AGENT); }
__device__ __forceinline__ unsigned xb_xcc_id() { return (unsigned)__builtin_amdgcn_s_getreg((3 << 11) | 20) & 0xFu; }
#define XB_SPIN(cond, bar) do { unsigned _sp = 0; while (cond) { __builtin_amdgcn_s_sleep(1); \
    if ((++_sp & 255u) == 0u) { if (xb_ld(&(bar)[XB_TMO])) break; if (_sp > XB_SPIN_CAP) { atomicAdd(&(bar)[XB_TMO], 1u); break; } } } } while (0)

struct XcdBarrier {
    unsigned* bar; unsigned x;
    volatile LAS unsigned* st;
};

__device__ __forceinline__ XcdBarrier xcd_barrier_post(unsigned* bar, volatile LAS unsigned* st) {
    XcdBarrier b; b.bar = bar; b.x = xb_xcc_id(); b.st = st;
    if (threadIdx.x == 0) (void)xb_add(&bar[XB_XCNT(b.x)], 1u);
    return b;
}
__device__ __forceinline__ void xcd_barrier_complete(unsigned* bar, unsigned x, unsigned& nloc, unsigned& nx) {
    const unsigned G = gridDim.x * gridDim.y * gridDim.z;
    unsigned sum, cnt, mine, sp = 0u;
    for (;;) {
        sum = 0u; cnt = 0u; mine = 0u;
#pragma unroll
        for (unsigned j = 0; j < 16; ++j) { const unsigned c = xb_ld(&bar[XB_XCNT(j)]); sum += c; cnt += (c > 0u) ? 1u : 0u; mine = (j == x) ? c : mine; }
        if (sum == G) break;
        __builtin_amdgcn_s_sleep(1);
        if ((++sp & 255u) == 0u) { if (xb_ld(&bar[XB_TMO])) break; if (sp > XB_SPIN_CAP) { atomicAdd(&bar[XB_TMO], 1u); break; } }
    }
    nloc = mine > 0u ? mine : 1u; nx = cnt > 0u ? cnt : 1u;
}

__device__ __forceinline__ void xcd_barrier(const XcdBarrier& b, const bool is_t0) {
    asm volatile("s_waitcnt vmcnt(0)" ::: "memory");
    __syncthreads();
    if (is_t0) {
        unsigned* bar = b.bar;
        __builtin_amdgcn_s_waitcnt(0);
        unsigned nloc = b.st[0], nx = b.st[1];
        if (nloc == 0u) { xcd_barrier_complete(bar, b.x, nloc, nx); b.st[0] = nloc; b.st[1] = nx; }
        const unsigned old = xb_add(&bar[XB_XSUB(b.x)], 1u);
        const unsigned gen = old / nloc;
        if (old + 1u == (gen + 1u) * nloc) {
            __builtin_amdgcn_fence(__ATOMIC_RELEASE, "agent");
            asm volatile("s_waitcnt vmcnt(0)" ::: "memory");
            const unsigned og = xb_add(&bar[XB_TOP], 1u);
            const unsigned tg = og / nx;
            if (og + 1u == (tg + 1u) * nx) xb_add(&bar[XB_TOPGEN], 1u);
            else XB_SPIN(xb_ld(&bar[XB_TOPGEN]) == tg, bar);
            __builtin_amdgcn_fence(__ATOMIC_ACQUIRE, "agent");
            xb_add(&bar[XB_XGEN(b.x)], 1u);
            asm volatile("s_waitcnt vmcnt(0)" ::: "memory");
        } else {
            XB_SPIN(xb_ld(&bar[XB_XGEN(b.x)]) == gen, bar);
            __builtin_amdgcn_fence(__ATOMIC_ACQUIRE, "agent");
            asm volatile("s_waitcnt vmcnt(0)" ::: "memory");
        }
    }
    __syncthreads();
}
typedef const float* cfptr_t; typedef float* fptr_t; typedef unsigned char* ucptr_t;
typedef __attribute__((address_space(4))) const unsigned char* kargp_t;
struct KA {
    kargp_t kp;
    __device__ __forceinline__ const float* in(int i) const { return *(__attribute__((address_space(4))) const cfptr_t*)(kp + 8 * i); }
    __device__ __forceinline__ float* out() const { return *(__attribute__((address_space(4))) const fptr_t*)(kp + 160); }
    __device__ __forceinline__ unsigned char* ws() const { return *(__attribute__((address_space(4))) const ucptr_t*)(kp + 168); }
    __device__ __forceinline__ int ph_lo() const { return *(__attribute__((address_space(4))) const int*)(kp + 176); }
    __device__ __forceinline__ int ph_hi() const { return *(__attribute__((address_space(4))) const int*)(kp + 180); }
};
static_assert(sizeof(Args) == 184, "Args layout");
#define FRESH_LANE() ({ int l_; asm volatile("v_mbcnt_lo_u32_b32 %0, -1, 0\n\tv_mbcnt_hi_u32_b32 %0, -1, %0" : "=v"(l_)); l_; })
template <int PH>
__device__ __forceinline__ void run_phase(const KA& a, LAS unsigned char* lds, const int wave0, const int rep) {
    const int G = gridDim.x, bx = blockIdx.x, wave = wave0;
    const int vcu = (G % 8 == 0) ? (bx % 8) * (G / 8) + bx / 8 : bx;
    const int gw = vcu * NWAVES + wave, NGW = G * NWAVES;
    unsigned char* ws = a.ws();
    bf16_t* xb = (bf16_t*)(ws + WS_XB); float* ssp0 = (float*)(ws + WS_SSP); float* ssp1 = ssp0 + (size_t)M * 16;
    bf16_t* xb2 = (bf16_t*)(ws + WS_W);
    bf16_t* act = (bf16_t*)(ws + WS_R + R_ACT); bf16_t* ob = (bf16_t*)(ws + WS_R + R_O);
    bf16_t* pb = (bf16_t*)(ws + WS_PB); bf16_t* proj = (bf16_t*)(ws + WS_PROJ);
    const float cscale = rep == 0 ? 1.0f : 0.0f;
    if constexpr (PH == 0) {
        prologue_phase(a, lds, gw, NGW, wave, FRESH_LANE(), G == 256);
        convert_p(a.in(1), pb, bx * NWAVES * 64 + wave0 * 64 + FRESH_LANE(), G * NWAVES * 64);
        att::build_luts(a.in(2), (float*)(ws + WS_LUT), bx * NWAVES * 64 + wave0 * 64 + FRESH_LANE(), G * NWAVES * 64);
    } else {
        constexpr int l = (PH - 1) >> 3, k = (PH - 1) & 7;
        const bf16_t* wl = (const bf16_t*)(ws + WS_W) + (size_t)l * W_LAYER;
        bf16_t* lo_def = (bf16_t*)a.out(); bf16_t* lo_alt = xb2;
        const bf16_t* lin = (l == DEPTH - 1 && k == 7) ? lo_alt : lo_def; bf16_t* lout = (l == DEPTH - 1 && k == 6) ? lo_alt : lo_def;
        if constexpr (k == 0 || k == 5) {
            pg8::Gemm g{(k == 0 && l == 1) ? xb2 : xb, wl + (k == 0 ? WO_F1IN : WO_F2IN), M, 2 * DFF, D}; pg8::StaticOrder S; S.init(M, 2 * DFF, G, bx);
#if PROBE_NULL_EPI == 1
            if (rep > 0) { pg8::EpiNull E; pg8::gemm_phase<pg8::EpiNull, pg8::StaticOrder, true, true>(lds, g, S, E, wave0 * 64 + FRESH_LANE()); } else
#endif
            { pg8::EpiSwiglu E{act, ssp0, (PROBE_NULL_EPI >= 2 && rep > 0 && rep < PROBE_N) ? PROBE_NULL_EPI - 1 : 0};
            pg8::gemm_phase<pg8::EpiSwiglu, pg8::StaticOrder, true, true>(lds, g, S, E, wave0 * 64 + FRESH_LANE()); }
            if (G == 256 && bx >= 128 && rep == 0) {
                const int widx = (bx - 128) * NWAVES + wave, nw = 128 * NWAVES, lane = FRESH_LANE();
                if constexpr (k == 0) { convert_weight_items(a, lds, l * I_LAYER + IT_FOUT1, IT_FIN2 - IT_FOUT1, widx, nw, wave, lane); convert_weight_items(a, lds, l * I_LAYER + IT_WP, I_WP, widx, nw, wave, lane); }
                else { convert_weight_items(a, lds, l * I_LAYER + IT_WG, I_SQ, widx, nw, wave, lane);
                       if (l + 1 < DEPTH) { convert_weight_items(a, lds, (l + 1) * I_LAYER + IT_FIN1, I_FIN, widx, nw, wave, lane);
                                            convert_p(a.in(1) + (size_t)(l + 1) * M * PLE, pb, widx * 64 + lane, nw * 64); } }
            }
        } else if constexpr (k == 1 || k == 6) {
            pg8::Gemm g{act, wl + (k == 1 ? WO_F1OUT : WO_F2OUT), M, D, DFF}; pg8::StaticOrder S; S.init(M, D, G, bx);
            pg8::EpiResid E{(k == 1 && l > 0 && rep == 0) ? xb2 : xb, lin, xb, lout, ssp1, 0.5f * cscale};
            pg8::gemm_phase<pg8::EpiResid, pg8::StaticOrder, true, true>(lds, g, S, E, wave0 * 64 + FRESH_LANE());
        } else if constexpr (k == 2) {
            { pg8::Gemm g{xb, wl + WO_QKV, M, QKVW, D}; pg8::StaticOrder S; S.init(M, QKVW, G, bx);
              pg8::EpiQkv E; E.ssp = ssp1;
              E.qa = (bf16_t*)(ws + WS_R + R_QA); E.ka = (bf16_t*)(ws + WS_R + R_KA); E.va = (bf16_t*)(ws + WS_R + R_VA);
              E.qb = (bf16_t*)(ws + WS_R + R_QB); E.kb = (bf16_t*)(ws + WS_R + R_KB); E.vb = (bf16_t*)(ws + WS_R + R_VB);
              E.qna = a.in(8) + l * HD; E.kna = a.in(9) + l * HD; E.qnb = a.in(10) + l * HD; E.knb = a.in(11) + l * HD;
              pg8::gemm_phase<pg8::EpiQkv, pg8::StaticOrder, true, true>(lds, g, S, E, wave0 * 64 + FRESH_LANE()); }
            if (G != 256 || bx >= 64) {
              pg8::Gemm g{pb, wl + WO_WP, M, D, PLE}; pg8::StaticOrder S; if (G == 256) S.init(M, D, 192, bx - 64); else S.init(M, D, G, bx);
              pg8::EpiStoreBf16 E{proj, D};
              pg8::gemm_phase<pg8::EpiStoreBf16, pg8::StaticOrder, true, true>(lds, g, S, E, wave0 * 64 + FRESH_LANE()); }
            if (G == 256 && bx >= 64 && rep == 0)
                convert_weight_items(a, lds, l * I_LAYER + IT_FIN2, IT_WG - IT_FIN2, (bx - 64) * NWAVES + wave, 192 * NWAVES, wave, FRESH_LANE());
        } else if constexpr (k == 3) {
            att::Tensors T; T.qa = (bf16_t*)(ws + WS_R + R_QA); T.ka = (bf16_t*)(ws + WS_R + R_KA); T.va = (bf16_t*)(ws + WS_R + R_VA);
            T.qb = (bf16_t*)(ws + WS_R + R_QB); T.kb = (bf16_t*)(ws + WS_R + R_KB); T.vb = (bf16_t*)(ws + WS_R + R_VB);
            T.glut = (const float*)(ws + WS_LUT); T.sink = a.in(12) + l * 8; T.o = ob;
            const int lane = FRESH_LANE();
            for (int u = vcu; u < 256; u += G) att::attn_unit(T, u, lds, wave, lane, (PROBE_ATT_MODE && rep > 0) ? PROBE_ATT_MODE : 0x33);
        } else if constexpr (k == 4) {
            if (G != 256 && l + 1 < DEPTH) { convert_p(a.in(1) + (size_t)(l + 1) * M * PLE, pb, bx * NWAVES * 64 + wave0 * 64 + FRESH_LANE(), G * NWAVES * 64); asm volatile("s_waitcnt vmcnt(0)" ::: "memory"); }
            pg8::Gemm g{ob, wl + WO_WO, M, D, D}; pg8::StaticOrder S; S.init(M, D, G, bx);
            pg8::EpiResid E{xb, lin, xb, lout, ssp0, 1.0f * cscale};
            pg8::gemm_phase<pg8::EpiResid, pg8::StaticOrder, true, true>(lds, g, S, E, wave0 * 64 + FRESH_LANE());
        } else {
            pg8::Gemm g{xb, wl + WO_WG, M, D, D}; pg8::StaticOrder S; S.init(M, D, G, bx);
            pg8::EpiGate E{xb, lin, xb2, lout, (l == DEPTH - 1) ? a.out() : nullptr, ssp0, ssp1, proj, cscale};
            pg8::gemm_phase<pg8::EpiGate, pg8::StaticOrder, true, true>(lds, g, S, E, wave0 * 64 + FRESH_LANE());
        }
    }
}

__global__ void __launch_bounds__(NWAVES * 64, 2) mk_fwd(Args) {
    extern __shared__ __attribute__((aligned(16))) unsigned char lds_raw[];
    LAS unsigned char* lds = (LAS unsigned char*)lds_raw;
    cg::grid_group grid = cg::this_grid();
    const int wave0 = __builtin_amdgcn_readfirstlane(threadIdx.x >> 6);
    volatile LAS unsigned* bst = (volatile LAS unsigned*)((LAS unsigned char*)lds_raw + LDS_BYTES - 64);
    if (threadIdx.x < 2) bst[threadIdx.x] = 0u;
    __syncthreads();
    KA a; a.kp = (kargp_t)__builtin_amdgcn_kernarg_segment_ptr();
    const int ph_lo = a.ph_lo(), ph_hi = a.ph_hi();
    XcdBarrier xbar; xbar.bar = (unsigned*)(a.ws() + WS_CTL) + 4096; xbar.x = 0; xbar.st = bst;
    if (ph_hi - ph_lo > 1) xbar = xcd_barrier_post((unsigned*)(a.ws() + WS_CTL) + 4096, bst);
    if (ph_lo < 0) grid.sync();
#define MK_NREP(P) ((PROBE_N > 0 && (((P) == 0 && PROBE_K == 8) || ((P) > 0 && (((P) - 1) & 7) == PROBE_K))) ? 1 + PROBE_N : 1)
#define MK_PHASE(P) if (ph_lo <= (P) && (P) < ph_hi) { _Pragma("unroll 1") for (int rep = 0; rep < MK_NREP(P); ++rep) { asm volatile("" : "+s"(a.kp)); run_phase<(P)>(a, lds, wave0, rep); \
        if ((P) + 1 < ph_hi || rep + 1 < MK_NREP(P)) { if (USE_CG_SYNC && (P) == 0) grid.sync(); else xcd_barrier(xbar, wave0 == 0 && FRESH_LANE() == 0); } } }
    MK_PHASE(0) MK_PHASE(1) MK_PHASE(2) MK_PHASE(3) MK_PHASE(4) MK_PHASE(5) MK_PHASE(6) MK_PHASE(7) MK_PHASE(8)
    MK_PHASE(9) MK_PHASE(10) MK_PHASE(11) MK_PHASE(12) MK_PHASE(13) MK_PHASE(14) MK_PHASE(15) MK_PHASE(16)
    static_assert(NPHASE == 17, "phase program");
}

#ifndef FAST_MASK
#define FAST_MASK 0x1ffffu
#endif
extern "C" void kernel_launch(void* const* d_in, const int* in_sizes, int n_in, void* d_out, int out_size, void* d_ws, size_t ws_size, hipStream_t stream) {
    static int grid = 0;
    if (grid == 0) {
        if (n_in != 20 || in_sizes[0] != M * D || out_size != M * D || ws_size < WS_END) { fprintf(stderr, "kernel_launch: unexpected shapes (n_in %d, ws %zu)\n", n_in, ws_size); grid = -1; return; }
        int dev = 0, cus = 0, per_cu = 0;
        if (hipGetDevice(&dev) != hipSuccess || hipDeviceGetAttribute(&cus, hipDeviceAttributeMultiprocessorCount, dev) != hipSuccess) { grid = -1; return; }
        if (hipFuncSetAttribute((const void*)mk_fwd, hipFuncAttributeMaxDynamicSharedMemorySize, LDS_BYTES) != hipSuccess) { fprintf(stderr, "kernel_launch: hipFuncSetAttribute failed\n"); grid = -1; return; }
        if (hipOccupancyMaxActiveBlocksPerMultiprocessor(&per_cu, (const void*)mk_fwd, NWAVES * 64, LDS_BYTES) != hipSuccess || per_cu < 1) { fprintf(stderr, "kernel_launch: occupancy query says %d\n", per_cu); grid = -1; (void)hipGetLastError(); return; }
        grid = cus;
    }
    if (grid < 0) return;
    (void)hipMemsetAsync((char*)d_ws + WS_CTL, 0, 1 * MiB, stream);
    Args a{};
    for (int i = 0; i < 20; ++i) a.in[i] = (const float*)d_in[i];
    a.out = (float*)d_out; a.ws = (unsigned char*)d_ws;
    const unsigned fast = FAST_MASK;
    if (fast == 0x1ffffu) {
        a.ph_lo = 0; a.ph_hi = NPHASE;
        void* args[] = {&a};
        hipError_t e = hipLaunchCooperativeKernel((const void*)mk_fwd, dim3(grid), dim3(NWAVES * 64), args, LDS_BYTES, stream);
        if (e != hipSuccess) fprintf(stderr, "kernel_launch: cooperative launch failed: %s (grid %d)\n", hipGetErrorString(e), grid);
        return;
    }
    unsigned char* ws = (unsigned char*)d_ws; float* out = (float*)d_out;
    bf16_t* xb = (bf16_t*)(ws + WS_XB); bf16_t* xb2 = (bf16_t*)(ws + WS_W); float* ssp0 = (float*)(ws + WS_SSP); float* ssp1 = ssp0 + (size_t)M * 16;
    bf16_t* act = (bf16_t*)(ws + WS_R + R_ACT); bf16_t* ob = (bf16_t*)(ws + WS_R + R_O);
    QkvOut qo; qo.qa = (bf16_t*)(ws + WS_R + R_QA); qo.ka = (bf16_t*)(ws + WS_R + R_KA); qo.va = (bf16_t*)(ws + WS_R + R_VA);
    qo.qb = (bf16_t*)(ws + WS_R + R_QB); qo.kb = (bf16_t*)(ws + WS_R + R_KB); qo.vb = (bf16_t*)(ws + WS_R + R_VB);
    for (int ph = 0; ph < NPHASE; ++ph) {
        if ((fast >> ph) & 1u) { a.ph_lo = ph; a.ph_hi = ph + 1; hipLaunchKernelGGL(mk_fwd, dim3(grid), dim3(NWAVES * 64), LDS_BYTES, stream, a); continue; }
        if (ph == 0) { rowstat_kernel<<<M / 4, 256, 0, stream>>>(a.in[0], xb, ssp0); continue; }
        const int l = (ph - 1) >> 3, k = (ph - 1) & 7;
        const float* xin = (l == 0 && k <= 1) ? a.in[0] : out;
        bf16_t* xbl = (l == 1) ? xb2 : xb;
        switch (k) {
        case 0: naive_ffn_in<<<dim3(DFF / 128, M / 128), 256, 0, stream>>>(xbl, ssp0, a.in[3] + l * D, a.in[4] + (size_t)l * D * 2 * DFF, act); break;
        case 1: naive_resid<<<dim3(D / 128, M / 128), 256, 0, stream>>>(act, DFF, a.in[5] + (size_t)l * DFF * D, xin, out, 0.5f); rowstat_kernel<<<M / 4, 256, 0, stream>>>(out, xb, ssp1); break;
        case 2: qo.qna = a.in[8] + l * HD; qo.kna = a.in[9] + l * HD; qo.qnb = a.in[10] + l * HD; qo.knb = a.in[11] + l * HD;
                naive_qkv<<<dim3(QKVW / 128, M / 128), 256, 0, stream>>>(xb, ssp1, a.in[6] + l * D, a.in[7] + (size_t)l * D * QKVW, qo); break;
        case 3: { AttnIn ai; ai.qa = qo.qa; ai.ka = qo.ka; ai.va = qo.va; ai.qb = qo.qb; ai.kb = qo.kb; ai.vb = qo.vb; ai.rel_bias = a.in[2]; ai.sink = a.in[12] + l * 8; ai.o = ob;
                naive_attn<<<dim3(S / 4, 16, NB), 256, 0, stream>>>(ai); } break;
        case 4: naive_resid<<<dim3(D / 128, M / 128), 256, 0, stream>>>(ob, D, a.in[13] + (size_t)l * D * D, out, out, 1.0f); rowstat_kernel<<<M / 4, 256, 0, stream>>>(out, xb, ssp0); break;
        case 5: naive_ffn_in<<<dim3(DFF / 128, M / 128), 256, 0, stream>>>(xb, ssp0, a.in[14] + l * D, a.in[15] + (size_t)l * D * 2 * DFF, act); break;
        case 6: naive_resid<<<dim3(D / 128, M / 128), 256, 0, stream>>>(act, DFF, a.in[16] + (size_t)l * DFF * D, out, out, 0.5f); rowstat_kernel<<<M / 4, 256, 0, stream>>>(out, xb, ssp1); break;
        case 7: naive_ple<<<dim3(D / 128, M / 128), 256, 0, stream>>>(xb, ssp1, a.in[17] + l * D, a.in[18] + (size_t)l * D * D, a.in[1] + (size_t)l * M * PLE, a.in[19] + (size_t)l * PLE * D, out, out);
                rowstat_kernel<<<M / 4, 256, 0, stream>>>(out, xb2, ssp0); break;
        }
    }
}
```

```cpp
#include <hip/hip_runtime.h>
#include <cstdio>
#include <cstdint>
#ifndef PROBE_N
#define PROBE_N 0
#define PROBE_K -1
#endif
#ifndef ATT_ORDER
#define ATT_ORDER 0
#endif
#ifndef PROBE_ATT_MODE
#define PROBE_ATT_MODE 0
#endif
#ifndef USE_CG_SYNC
#define USE_CG_SYNC 0
#endif
#ifndef PROBE_NULL_EPI
#define PROBE_NULL_EPI 0
#endif
#ifndef D16_MODE
#define D16_MODE 1
#endif
#ifndef XLO
#define XLO 0
#define LOCAL_SEAMS 1
#define PREFETCH_B 1
#endif

typedef unsigned short bf16_t;
constexpr int NB = 4, S = 4096, D = 1024, M = NB * S, DFF = 2816, QKVW = 2304, PLE = 256, DEPTH = 2, HD = 64;
constexpr float EPS = 1e-6f;
constexpr float QSCALE = 0.125f * 1.4426950408889634f;
constexpr float LOG2E = 1.4426950408889634f;

constexpr size_t MiB = 1u << 20;
constexpr size_t WS_CTL = 0, WS_W = 1 * MiB, WS_XB = 85 * MiB, WS_R = 117 * MiB, WS_PB = 221 * MiB, WS_PROJ = 229 * MiB, WS_SSP = 261 * MiB, WS_END = 263 * MiB + 512 * 1024;
constexpr size_t WS_LUT = 263 * MiB;
constexpr size_t R_QA = 0, R_KA = 16 * MiB, R_VA = 32 * MiB, R_QB = 48 * MiB, R_KB = 64 * MiB, R_VB = 68 * MiB, R_O = 72 * MiB, R_ACT = 0;

__device__ __forceinline__ float bf2f(bf16_t v) { return __uint_as_float(((unsigned)v) << 16); }
__device__ __forceinline__ bf16_t f2bf(float f) { unsigned u = __float_as_uint(f); return (bf16_t)((u + 0x7fffu + ((u >> 16) & 1u)) >> 16); }

namespace pg8 {
#define PG8_LAS __attribute__((address_space(3)))
typedef unsigned short bf16_t;
typedef short bf16x8 __attribute__((ext_vector_type(8)));
typedef float f32x4 __attribute__((ext_vector_type(4)));
typedef unsigned u32x4 __attribute__((ext_vector_type(4)));
constexpr int BM = 256, BK = 64, HALF = 128, HTB = HALF * BK * 2  , STAGE_BYTES = 8 * HTB, NXCD = 8, WGM = 8;

__host__ __device__ __forceinline__ int lds_byte(int r, int c) { const int st = (r >> 4) * 2 + (c >> 5), rr = r & 15, cc = c & 31, ob = rr * 64 + cc * 2; return st * 1024 + (ob ^ (((ob >> 9) & 1) << 5)); }
__host__ __device__ __forceinline__ void stage_rc(int b, int& R, int& C) { const int st = b / 1024, sb = b % 1024, swz = sb ^ (((sb >> 9) & 1) << 5); R = (st >> 1) * 16 + swz / 64; C = (st & 1) * 32 + (swz % 64) / 2; }
__host__ __device__ __forceinline__ int perm32(int rho) { const int n = rho >> 4, i = rho & 15; return 8 * (i >> 2) + 4 * n + (i & 3); }

struct Unit { int pm, pn; };
struct Gemm { const bf16_t* A; const bf16_t* Bt; int M, N, K; };

struct StaticOrder {
    int nM, nN, nwg, G, c;
    __host__ __device__ void init(int M, int N, int G_, int c_) { nM = M / BM; nN = N / BM; nwg = nM * nN; G = G_; c = c_; }
    __host__ __device__ bool next(int i, Unit& u) const {
        const long L = (long)i * G + c; if (L >= nwg) return false;
        int wgid = (int)L; { const int q = nwg / NXCD, r = nwg % NXCD, xcd = wgid % NXCD, off = wgid / NXCD; wgid = (xcd < r ? xcd * (q + 1) : r * (q + 1) + (xcd - r) * q) + off; }
        const int nig = WGM * nN, gid = wgid / nig, fm = gid * WGM, gsz = (nM - fm) < WGM ? (nM - fm) : WGM;
        u.pm = fm + ((wgid % nig) % gsz); u.pn = (wgid % nig) / gsz; return true;
    }
    __device__ __forceinline__ void a_ready(const Unit&) const {}
    __device__ __forceinline__ void done(const Unit&) const {}
};

__device__ __forceinline__ unsigned cvt_pk_bf16(float lo, float hi) { unsigned r; asm volatile("v_cvt_pk_bf16_f32 %0, %1, %2" : "=v"(r) : "v"(lo), "v"(hi)); return r; }
typedef float f32x2 __attribute__((ext_vector_type(2)));
template <class Epi, class Sched, bool ALIGN_EPI = false, bool SP2 = false>
__device__ __forceinline__ void gemm_phase(PG8_LAS unsigned char* lds, const Gemm g, const Sched& S, const Epi& E, const int tid, const bool bpre = false) {
    const int wid = __builtin_amdgcn_readfirstlane(tid >> 6), lane = tid & 63, wr = wid >> 2, wc = wid & 3, fr = lane & 15, fq = lane >> 4;
    const int K = g.K, nt = K / BK;
    unsigned voffA[2], voffB[2];
#pragma unroll
    for (int i = 0; i < 2; ++i) { int R, C; stage_rc(tid * 16 + i * 8192, R, C); const int Rb = Epi::PERM ? ((R & ~31) + perm32(R & 31)) : R;
        voffA[i] = (unsigned)(R * K + C) * 2u; voffB[i] = (unsigned)(Rb * K + C) * 2u; }
    const size_t kstep = (size_t)(BK * 2);
    const size_t hstep = (size_t)HALF * K * 2;
    const size_t tstep = 2 * hstep;
    const unsigned ldsw = (unsigned)wid * 1024u;
    const int aoff = lds_byte(wr * 64 + fr, fq * 8), boff = lds_byte(wc * 32 + fr, fq * 8);
#define PG8_SA(b, h) (((b) * 2 + (h)) * HTB)
#define PG8_SB(b, h) ((4 + (b) * 2 + (h)) * HTB)
#define PG8_STAGE(bufoff, gbase, voff) do { _Pragma("unroll") for (int _i = 0; _i < 2; ++_i) \
        __builtin_amdgcn_global_load_lds((const unsigned*)((const char*)(gbase) + (voff)[_i]), (PG8_LAS unsigned*)(lds + (bufoff) + ldsw + _i * 8192), 16, 0, 0); } while (0)
#define PG8_LDA(dst, b, h) do { _Pragma("unroll") for (int m = 0; m < 4; ++m) _Pragma("unroll") for (int k = 0; k < 2; ++k) dst[m][k] = *(const PG8_LAS bf16x8*)(lds + PG8_SA(b, h) + aoff + m * 2048 + k * 1024); } while (0)
#define PG8_LDB(dst, b, h) do { _Pragma("unroll") for (int n = 0; n < 2; ++n) _Pragma("unroll") for (int k = 0; k < 2; ++k) dst[n][k] = *(const PG8_LAS bf16x8*)(lds + PG8_SB(b, h) + boff + n * 2048 + k * 1024); } while (0)
#define PG8_MMA(ai, bj, At, Bt) do { __builtin_amdgcn_s_setprio(1); _Pragma("unroll") for (int m = 0; m < 4; ++m) _Pragma("unroll") for (int n = 0; n < 2; ++n) _Pragma("unroll") for (int k = 0; k < 2; ++k) \
        acc[ai][bj][m][n] = __builtin_amdgcn_mfma_f32_16x16x32_bf16(Bt[n][k], At[m][k], acc[ai][bj][m][n], 0, 0, 0); __builtin_amdgcn_s_setprio(0); } while (0)
#define PG8_WAIT_V(n) asm volatile("s_waitcnt vmcnt(" #n ")" ::: "memory")
#define PG8_WAIT_L(n) asm volatile("s_waitcnt lgkmcnt(" #n ")" ::: "memory")
#define PG8_BAR __builtin_amdgcn_s_barrier()
#define PG8_SCHED __builtin_amdgcn_sched_barrier(0)
    Unit cur, nxt; int ui = 0;
    if (!S.next(0, cur)) return;
    f32x4 acc[2][2][4][2];
#pragma unroll
    for (int a = 0; a < 2; ++a)
#pragma unroll
        for (int b = 0; b < 2; ++b)
#pragma unroll
            for (int m = 0; m < 4; ++m)
#pragma unroll
                for (int n = 0; n < 2; ++n) acc[a][b][m][n] = (f32x4){0.f, 0.f, 0.f, 0.f};
    bf16x8 At[4][2], B0[2][2], B1[2][2];
    const char* cA = (const char*)g.A + (size_t)cur.pm * tstep; const char* cB = (const char*)g.Bt + (size_t)cur.pn * tstep;
    S.a_ready(cur);
    if constexpr (SP2) {
        if (!bpre) { PG8_STAGE(PG8_SB(0, 0), cB, voffB); PG8_STAGE(PG8_SB(0, 1), cB + hstep, voffB); }
        PG8_STAGE(PG8_SA(0, 0), cA, voffA); PG8_STAGE(PG8_SA(0, 1), cA + hstep, voffA);
        if constexpr (Epi::HAS_PRE) E.pre(cur, tid, lds);
        if (wr == 1) PG8_BAR;
        PG8_WAIT_V(2); PG8_BAR;
        if (!bpre) { PG8_STAGE(PG8_SB(1, 0), cB + kstep, voffB); PG8_STAGE(PG8_SA(1, 0), cA + kstep, voffA); PG8_STAGE(PG8_SB(1, 1), cB + hstep + kstep, voffB); PG8_WAIT_V(6); }
        else { PG8_STAGE(PG8_SA(1, 0), cA + kstep, voffA); PG8_WAIT_V(2); }
        PG8_BAR;
    } else {
        PG8_STAGE(PG8_SB(0, 0), cB, voffB); PG8_STAGE(PG8_SA(0, 0), cA, voffA); PG8_STAGE(PG8_SB(0, 1), cB + hstep, voffB); PG8_STAGE(PG8_SA(0, 1), cA + hstep, voffA);
        if (wr == 1) PG8_BAR;
        PG8_WAIT_V(4); PG8_BAR;
        PG8_STAGE(PG8_SB(1, 0), cB + kstep, voffB); PG8_STAGE(PG8_SA(1, 0), cA + kstep, voffA); PG8_STAGE(PG8_SB(1, 1), cB + hstep + kstep, voffB);
        PG8_WAIT_V(6); PG8_BAR;
    }
    for (;;) {
        const bool has_next = S.next(ui + 1, nxt);
        const char* nA = has_next ? (const char*)g.A + (size_t)nxt.pm * tstep : cA; const char* nB = has_next ? (const char*)g.Bt + (size_t)nxt.pn * tstep : cB;
        for (int t = 0; t < nt; t += 2) {
            const bool last = (t == nt - 2);
            const char* a1 = cA + (size_t)(t + 1) * kstep;
            const char* a2 = last ? nA : cA + (size_t)(t + 2) * kstep; const char* b2 = last ? nB : cB + (size_t)(t + 2) * kstep;
            const char* a3 = a2 + kstep; const char* b3 = b2 + kstep;
            if (last && has_next) S.a_ready(nxt);
            if constexpr (SP2) {
            PG8_LDB(B0, 0, 0); PG8_LDB(B1, 0, 1); PG8_SCHED; PG8_LDA(At, 0, 0); PG8_STAGE(PG8_SA(1, 1), a1 + hstep, voffA);
            PG8_WAIT_V(8); PG8_WAIT_L(0); PG8_BAR; PG8_MMA(0, 0, At, B0); PG8_MMA(0, 1, At, B1); PG8_BAR; PG8_SCHED;
            PG8_LDA(At, 0, 1); PG8_STAGE(PG8_SB(0, 0), b2, voffB); PG8_STAGE(PG8_SB(0, 1), b2 + hstep, voffB); PG8_STAGE(PG8_SA(0, 0), a2, voffA);
            PG8_WAIT_V(8); PG8_WAIT_L(0); PG8_BAR; PG8_MMA(1, 0, At, B0); PG8_MMA(1, 1, At, B1); PG8_BAR; PG8_SCHED;
            PG8_LDB(B0, 1, 0); PG8_LDB(B1, 1, 1); PG8_SCHED; PG8_LDA(At, 1, 0); PG8_STAGE(PG8_SA(0, 1), a2 + hstep, voffA);
            PG8_WAIT_V(8); PG8_WAIT_L(0); PG8_BAR; PG8_MMA(0, 0, At, B0); PG8_MMA(0, 1, At, B1); PG8_BAR; PG8_SCHED;
            PG8_LDA(At, 1, 1); PG8_STAGE(PG8_SB(1, 0), b3, voffB); PG8_STAGE(PG8_SB(1, 1), b3 + hstep, voffB); PG8_STAGE(PG8_SA(1, 0), a3, voffA);
            PG8_WAIT_V(8); PG8_WAIT_L(0); PG8_BAR; PG8_MMA(1, 0, At, B0); PG8_MMA(1, 1, At, B1); PG8_BAR; PG8_SCHED;
            } else {
            PG8_LDB(B0, 0, 0); PG8_SCHED; PG8_LDA(At, 0, 0); PG8_STAGE(PG8_SA(1, 1), a1 + hstep, voffA);
            PG8_WAIT_L(8); PG8_BAR; PG8_WAIT_L(0); PG8_MMA(0, 0, At, B0); PG8_BAR; PG8_SCHED;
            PG8_LDB(B1, 0, 1); PG8_STAGE(PG8_SB(0, 0), b2, voffB);
            PG8_BAR; PG8_WAIT_L(0); PG8_MMA(0, 1, At, B1); PG8_BAR;
            PG8_LDA(At, 0, 1); PG8_STAGE(PG8_SA(0, 0), a2, voffA);
            PG8_BAR; PG8_WAIT_L(0); PG8_MMA(1, 0, At, B0); PG8_BAR; PG8_SCHED;
            PG8_STAGE(PG8_SB(0, 1), b2 + hstep, voffB);
            PG8_WAIT_V(6); PG8_BAR; PG8_MMA(1, 1, At, B1); PG8_BAR;
            PG8_LDB(B0, 1, 0); PG8_SCHED; PG8_LDA(At, 1, 0); PG8_STAGE(PG8_SA(0, 1), a2 + hstep, voffA);
            PG8_WAIT_L(8); PG8_BAR; PG8_WAIT_L(0); PG8_MMA(0, 0, At, B0); PG8_BAR; PG8_SCHED;
            PG8_LDB(B1, 1, 1); PG8_STAGE(PG8_SB(1, 0), b3, voffB);
            PG8_BAR; PG8_WAIT_L(0); PG8_MMA(0, 1, At, B1); PG8_BAR;
            PG8_LDA(At, 1, 1); PG8_STAGE(PG8_SA(1, 0), a3, voffA);
            PG8_BAR; PG8_WAIT_L(0); PG8_MMA(1, 0, At, B0); PG8_BAR; PG8_SCHED;
            PG8_STAGE(PG8_SB(1, 1), b3 + hstep, voffB);
            PG8_WAIT_V(6); PG8_BAR; PG8_MMA(1, 1, At, B1); PG8_BAR;
            }
        }
        if constexpr (ALIGN_EPI) { if (wr == 0) PG8_BAR; }
        if constexpr (!Epi::AFTER_DRAIN) { int l2_; asm volatile("v_mbcnt_lo_u32_b32 %0, -1, 0\n\tv_mbcnt_hi_u32_b32 %0, -1, %0" : "=v"(l2_)); if constexpr (Epi::HAS_PRE) E(acc, cur, wr, wc, l2_ & 15, l2_ >> 4, lds); else E(acc, cur, wr, wc, l2_ & 15, l2_ >> 4); S.done(cur); }
        if (!has_next) break;
#pragma unroll
        for (int a = 0; a < 2; ++a)
#pragma unroll
            for (int b = 0; b < 2; ++b)
#pragma unroll
                for (int m = 0; m < 4; ++m)
#pragma unroll
                    for (int n = 0; n < 2; ++n) acc[a][b][m][n] = (f32x4){0.f, 0.f, 0.f, 0.f};
        cur = nxt; cA = nA; cB = nB; ++ui;
        if constexpr (ALIGN_EPI) { if (wr == 1) PG8_BAR; }
    }
    PG8_WAIT_V(0);
    if constexpr (!ALIGN_EPI) { if (wr == 0) PG8_BAR; }
    PG8_BAR;
    if constexpr (Epi::AFTER_DRAIN) { E.fused(acc, cur, wr, wc, fr, fq, lds, wid, lane); S.done(cur); }
#undef PG8_SA
#undef PG8_SB
#undef PG8_STAGE
#undef PG8_LDA
#undef PG8_LDB
#undef PG8_MMA
#undef PG8_WAIT_V
#undef PG8_WAIT_L
#undef PG8_BAR
#undef PG8_SCHED
}
}

namespace pg8 {
typedef float f32x2 __attribute__((ext_vector_type(2)));
__device__ __forceinline__ void prefetch_b(PG8_LAS unsigned char* lds, const bf16_t* Bt, const int K, const int pn, const int tid) {
    const int wid = __builtin_amdgcn_readfirstlane(tid >> 6);
    const size_t hstep = (size_t)HALF * K * 2, tstep = 2 * hstep, kstep = (size_t)(BK * 2);
    const unsigned ldsw = (unsigned)wid * 1024u;
    const char* cB = (const char*)Bt + (size_t)pn * tstep;
#pragma unroll
    for (int i = 0; i < 2; ++i) { int R, C; stage_rc(tid * 16 + i * 8192, R, C); const int Rb = (R & ~31) + perm32(R & 31); const unsigned vo = (unsigned)(Rb * K + C) * 2u;
#pragma unroll
        for (int q = 0; q < 4; ++q) { const char* base = cB + (q & 1) * hstep + (q >> 1) * kstep;
            __builtin_amdgcn_global_load_lds((const unsigned*)(base + vo), (PG8_LAS unsigned*)(lds + (4 + q) * HTB + ldsw + i * 8192), 16, 0, 0); } }
}
__device__ __forceinline__ float shx(float v, int lane, int mask) { return __int_as_float(__builtin_amdgcn_ds_bpermute((lane ^ mask) << 2, __float_as_int(v))); }
__device__ __forceinline__ float rstd16(const float* ssp, int row, int fq, int lane) {
    const f32x4 v = *(const f32x4*)(ssp + (size_t)row * 16 + 4 * fq);
    float s = (v[0] + v[1]) + (v[2] + v[3]);
    s += shx(s, lane, 16); s += shx(s, lane, 32);
    return __builtin_amdgcn_rsqf(s * (1.0f / 1024.0f) + 1e-6f);
}
__device__ __forceinline__ f32x4 rstd_ld(const float* ssp, int row, int fq) { return *(const f32x4*)(ssp + (size_t)row * 16 + 4 * fq); }
__device__ __forceinline__ float rstd_fin(const f32x4& v, int lane) { float s = (v[0] + v[1]) + (v[2] + v[3]); s += shx(s, lane, 16); s += shx(s, lane, 32); return __builtin_amdgcn_rsqf(s * (1.0f / 1024.0f) + 1e-6f); }
__device__ __forceinline__ float sigm(float v) { return __builtin_amdgcn_rcpf(1.0f + __builtin_amdgcn_exp2f(-1.4426950408889634f * v)); }
__device__ __forceinline__ u32x4 pack8(const f32x4& a, const f32x4& b) { u32x4 w; w.x = cvt_pk_bf16(a[0], a[1]); w.y = cvt_pk_bf16(a[2], a[3]); w.z = cvt_pk_bf16(b[0], b[1]); w.w = cvt_pk_bf16(b[2], b[3]); return w; }
__device__ __forceinline__ float bflo(unsigned w) { return __uint_as_float(w << 16); }
__device__ __forceinline__ float bfhi(unsigned w) { return __uint_as_float(w & 0xffff0000u); }

constexpr int EPI_TAB = 131072 + 4096;
__device__ __forceinline__ void rstd_table(const float* ssp, int pm, PG8_LAS float* rst, int tid) {
    const int r = tid >> 1, hf = tid & 1;
    const float* p = ssp + (size_t)(pm * BM + r) * 16 + hf * 8;
    const f32x4 a = *(const f32x4*)p, b = *(const f32x4*)(p + 4);
    float s = ((a[0] + a[1]) + (a[2] + a[3])) + ((b[0] + b[1]) + (b[2] + b[3]));
    s += shx(s, tid & 63, 1);
    if (hf == 0) rst[r] = __builtin_amdgcn_rsqf(s * (1.0f / 1024.0f) + 1e-6f);
    if (tid == 0) ((PG8_LAS int*)rst)[512] = pm;
    asm volatile("s_waitcnt lgkmcnt(0)" ::: "memory");
}
__device__ __forceinline__ int rstd_table_pm(PG8_LAS float* rst) { int v; const unsigned a = (unsigned)(uintptr_t)rst; asm volatile("ds_read_b32 %0, %1 offset:2048\n\ts_waitcnt lgkmcnt(0)" : "=v"(v) : "v"(a) : "memory"); return __builtin_amdgcn_readfirstlane(v); }
__device__ __forceinline__ void rstd_table_rd(PG8_LAS float* rst, int wr, int fr, float (&rsv)[8]) {
    const unsigned ra = (unsigned)(uintptr_t)rst + 4u * (unsigned)(wr * 64 + fr);
    asm volatile("ds_read_b32 %0, %1" : "=v"(rsv[0]) : "v"(ra) : "memory");            asm volatile("ds_read_b32 %0, %1 offset:64" : "=v"(rsv[1]) : "v"(ra) : "memory");
    asm volatile("ds_read_b32 %0, %1 offset:128" : "=v"(rsv[2]) : "v"(ra) : "memory"); asm volatile("ds_read_b32 %0, %1 offset:192" : "=v"(rsv[3]) : "v"(ra) : "memory");
    asm volatile("ds_read_b32 %0, %1 offset:512" : "=v"(rsv[4]) : "v"(ra) : "memory"); asm volatile("ds_read_b32 %0, %1 offset:576" : "=v"(rsv[5]) : "v"(ra) : "memory");
    asm volatile("ds_read_b32 %0, %1 offset:640" : "=v"(rsv[6]) : "v"(ra) : "memory"); asm volatile("ds_read_b32 %0, %1 offset:704" : "=v"(rsv[7]) : "v"(ra) : "memory");
}
struct EpiSwiglu {
    static constexpr bool PERM = true, AFTER_DRAIN = false, HAS_PRE = true;
    bf16_t* act; const float* ssp; int mode;
    __device__ __forceinline__ void pre(const Unit& u, int tid, PG8_LAS unsigned char* lds) const { rstd_table(ssp, u.pm, (PG8_LAS float*)(lds + EPI_TAB), tid); }
    __device__ __forceinline__ void operator()(const f32x4 (&acc)[2][2][4][2], const Unit& u, int wr, int wc, int fr, int fq, PG8_LAS unsigned char* lds) const {
        PG8_LAS float* rst = (PG8_LAS float*)(lds + EPI_TAB); const int pre_pm = rstd_table_pm(rst);
        const int lane = fr + 16 * fq;
        const int row0 = u.pm * BM + wr * 64 + fr, col0 = u.pn * 128 + wc * 32 + 8 * fq;
        float rsv[8];
        if (u.pm == pre_pm) {
          rstd_table_rd(rst, wr, fr, rsv);
          asm volatile("s_waitcnt lgkmcnt(0)" : "+v"(rsv[0]), "+v"(rsv[1]), "+v"(rsv[2]), "+v"(rsv[3]), "+v"(rsv[4]), "+v"(rsv[5]), "+v"(rsv[6]), "+v"(rsv[7]) :: "memory");
        } else
        { f32x4 t8[8];
#pragma unroll
          for (int g = 0; g < 8; ++g) t8[g] = rstd_ld(ssp, row0 + (g >> 2) * HALF + (g & 3) * 16, fq);
#pragma unroll
          for (int g = 0; g < 8; ++g) rsv[g] = rstd_fin(t8[g], lane); }
        asm volatile("" ::: "memory");
#pragma unroll
        for (int ai = 0; ai < 2; ++ai)
#pragma unroll
            for (int m = 0; m < 4; ++m) { const int row = row0 + ai * HALF + m * 16; const float rs = rsv[ai * 4 + m];
                f32x4 o[2];
                const f32x2 c1 = {-1.4426950408889634f * rs, -1.4426950408889634f * rs}, rs2 = {rs * rs, rs * rs}, one = {1.0f, 1.0f};
#pragma unroll
                for (int n = 0; n < 2; ++n)
#pragma unroll
                    for (int j = 0; j < 4; j += 2) { const f32x2 g = {acc[ai][0][m][n][j], acc[ai][0][m][n][j + 1]}, up = {acc[ai][1][m][n][j], acc[ai][1][m][n][j + 1]};
                        f32x2 e = c1 * g; e.x = __builtin_amdgcn_exp2f(e.x); e.y = __builtin_amdgcn_exp2f(e.y);
                        f32x2 d = one + e; d.x = __builtin_amdgcn_rcpf(d.x); d.y = __builtin_amdgcn_rcpf(d.y);
                        const f32x2 r = (PROBE_NULL_EPI && mode == 2) ? g + up : (g * up) * (rs2 * d);
                        o[n][j] = r.x; o[n][j + 1] = r.y; }
                const u32x4 w = pack8(o[0], o[1]);
                if (PROBE_NULL_EPI && mode == 1) asm volatile("" :: "v"(w)); else *(u32x4*)(act + (size_t)row * 2816 + col0) = w; }
    }
};
__device__ __forceinline__ void unpack8(const u32x4& w, f32x4& a, f32x4& b) { a = (f32x4){bflo(w.x), bfhi(w.x), bflo(w.y), bfhi(w.y)}; b = (f32x4){bflo(w.z), bfhi(w.z), bflo(w.w), bfhi(w.w)}; }
__device__ __forceinline__ void split8(const f32x4& x0, const f32x4& x1, u32x4& hi, u32x4& lo) {
    hi = pack8(x0, x1); f32x4 h0, h1; unpack8(hi, h0, h1); lo = pack8(x0 - h0, x1 - h1);
}
struct EpiResid {
    static constexpr bool PERM = true, AFTER_DRAIN = false, HAS_PRE = false;
    const bf16_t* hin; const bf16_t* lin; bf16_t* hout; bf16_t* lout; float* sspw; float coef;
    __device__ __forceinline__ void operator()(const f32x4 (&acc)[2][2][4][2], const Unit& u, int wr, int wc, int fr, int fq) const {
        const int lane = fr + 16 * fq;
        float cf = __uint_as_float(__builtin_amdgcn_readfirstlane(__float_as_uint(coef))); asm volatile("" : "+s"(cf));
        const int row0 = u.pm * BM + wr * 64 + fr, col0 = u.pn * BM + wc * 32 + 8 * fq;
        u32x4 xh[3][2], xl[3][2];
#define RES_LOAD(g, sl) do { _Pragma("unroll") for (int bj = 0; bj < 2; ++bj) { const size_t off_ = (size_t)(row0 + ((g) >> 2) * HALF + ((g) & 3) * 16) * 1024 + col0 + bj * HALF; \
            xh[sl][bj] = *(const u32x4*)(hin + off_); if (XLO) xl[sl][bj] = *(const u32x4*)(lin + off_); else xl[sl][bj] = (u32x4){0u, 0u, 0u, 0u}; } } while (0)
        RES_LOAD(0, 0); RES_LOAD(1, 1);
#pragma unroll
        for (int g = 0; g < 8; ++g) { const int ai = g >> 2, m = g & 3, sl = g % 3, row = row0 + ai * HALF + m * 16; float ss = 0.f;
            if (g + 2 < 8) RES_LOAD(g + 2, (g + 2) % 3);
            asm volatile("" ::: "memory");
#pragma unroll
            for (int bj = 0; bj < 2; ++bj) { const size_t off = (size_t)row * 1024 + col0 + bj * HALF;
                f32x4 h0, h1, l0, l1; unpack8(xh[sl][bj], h0, h1); unpack8(xl[sl][bj], l0, l1);
                const f32x4 x0 = (h0 + l0) + acc[ai][bj][m][0] * cf, x1 = (h1 + l1) + acc[ai][bj][m][1] * cf;
                u32x4 nh, nl; split8(x0, x1, nh, nl);
                *(u32x4*)(hout + off) = nh; if (XLO) *(u32x4*)(lout + off) = nl;
                ss += (x0[0] * x0[0] + x0[1] * x0[1]) + (x0[2] * x0[2] + x0[3] * x0[3]) + (x1[0] * x1[0] + x1[1] * x1[1]) + (x1[2] * x1[2] + x1[3] * x1[3]); }
            ss += shx(ss, lane, 16); ss += shx(ss, lane, 32);
            if (fq == 0) sspw[(size_t)row * 16 + u.pn * 4 + wc] = ss;
            asm volatile("" ::: "memory"); }
#undef RES_LOAD
    }
};
struct EpiGate {
    static constexpr bool PERM = true, AFTER_DRAIN = false, HAS_PRE = false;
    const bf16_t* hin; const bf16_t* lin; bf16_t* hout; bf16_t* lout; float* fout; float* sspw; const float* sspr; const bf16_t* proj; float coef;
    __device__ __forceinline__ void operator()(const f32x4 (&acc)[2][2][4][2], const Unit& u, int wr, int wc, int fr, int fq) const {
        const int lane = fr + 16 * fq;
        float cf = __uint_as_float(__builtin_amdgcn_readfirstlane(__float_as_uint(coef))); asm volatile("" : "+s"(cf));
        const int row0 = u.pm * BM + wr * 64 + fr, col0 = u.pn * BM + wc * 32 + 8 * fq;
        u32x4 xh[2][2], xl[2][2], pw[2][2]; f32x4 rsn[2];
#define GATE_LOAD(g, sl) do { _Pragma("unroll") for (int bj = 0; bj < 2; ++bj) { const size_t off_ = (size_t)(row0 + ((g) >> 2) * HALF + ((g) & 3) * 16) * 1024 + col0 + bj * HALF; \
            xh[sl][bj] = *(const u32x4*)(hin + off_); if (XLO) xl[sl][bj] = *(const u32x4*)(lin + off_); else xl[sl][bj] = (u32x4){0u, 0u, 0u, 0u}; pw[sl][bj] = *(const u32x4*)(proj + off_); } \
            rsn[sl] = rstd_ld(sspr, row0 + ((g) >> 2) * HALF + ((g) & 3) * 16, fq); } while (0)
        GATE_LOAD(0, 0);
#pragma unroll
        for (int g = 0; g < 8; ++g) { const int ai = g >> 2, m = g & 3, sl = g & 1, row = row0 + ai * HALF + m * 16; float ss = 0.f;
            if (g + 1 < 8) GATE_LOAD(g + 1, (g + 1) & 1);
            asm volatile("" ::: "memory");
            const float rsg = rstd_fin(rsn[sl], lane);
#pragma unroll
            for (int bj = 0; bj < 2; ++bj) { const size_t off = (size_t)row * 1024 + col0 + bj * HALF;
                f32x4 h0, h1, l0, l1, p0, p1; unpack8(xh[sl][bj], h0, h1); unpack8(xl[sl][bj], l0, l1); unpack8(pw[sl][bj], p0, p1);
                f32x4 x0 = h0 + l0, x1 = h1 + l1;
#pragma unroll
                for (int j = 0; j < 4; ++j) { x0[j] += cf * (sigm(acc[ai][bj][m][0][j] * rsg) * p0[j]); x1[j] += cf * (sigm(acc[ai][bj][m][1][j] * rsg) * p1[j]); }
                if (fout) { *(f32x4*)(fout + off) = x0; *(f32x4*)(fout + off + 4) = x1; }
                else { u32x4 nh, nl; split8(x0, x1, nh, nl); *(u32x4*)(hout + off) = nh; if (XLO) *(u32x4*)(lout + off) = nl;
                    ss += (x0[0] * x0[0] + x0[1] * x0[1]) + (x0[2] * x0[2] + x0[3] * x0[3]) + (x1[0] * x1[0] + x1[1] * x1[1]) + (x1[2] * x1[2] + x1[3] * x1[3]); } }
            if (!fout) { ss += shx(ss, lane, 16); ss += shx(ss, lane, 32);
                if (fq == 0) sspw[(size_t)row * 16 + u.pn * 4 + wc] = ss; }
            asm volatile("" ::: "memory"); }
#undef GATE_LOAD
    }
};
struct EpiStoreBf16 {
    static constexpr bool PERM = true, AFTER_DRAIN = false, HAS_PRE = false;
    bf16_t* O; int ldc;
    __device__ __forceinline__ void operator()(const f32x4 (&acc)[2][2][4][2], const Unit& u, int wr, int wc, int fr, int fq) const {
        const int lane = fr + 16 * fq;
        const int row0 = u.pm * BM + wr * 64 + fr, col0 = u.pn * BM + wc * 32 + 8 * fq;
#pragma unroll
        for (int ai = 0; ai < 2; ++ai)
#pragma unroll
            for (int m = 0; m < 4; ++m) { const int row = row0 + ai * HALF + m * 16;
#pragma unroll
                for (int bj = 0; bj < 2; ++bj) *(u32x4*)(O + (size_t)row * ldc + col0 + bj * HALF) = pack8(acc[ai][bj][m][0], acc[ai][bj][m][1]); }
    }
};
struct EpiNull {
    static constexpr bool PERM = true, AFTER_DRAIN = false, HAS_PRE = false;
    __device__ __forceinline__ void operator()(const f32x4 (&acc)[2][2][4][2], const Unit& u, int wr, int wc, int fr, int fq) const {
#pragma unroll
        for (int ai = 0; ai < 2; ++ai)
#pragma unroll
            for (int bj = 0; bj < 2; ++bj)
#pragma unroll
                for (int m = 0; m < 4; ++m)
#pragma unroll
                    for (int n = 0; n < 2; ++n) asm volatile("" :: "v"(acc[ai][bj][m][n]));
    }
};
struct EpiQkv {
    static constexpr bool PERM = true, AFTER_DRAIN = false, HAS_PRE = true;
    const float* ssp; bf16_t *qa, *ka, *va, *qb, *kb, *vb; const float *qna, *kna, *qnb, *knb;
    __device__ __forceinline__ void pre(const Unit& u, int tid, PG8_LAS unsigned char* lds) const {
        PG8_LAS float* gtab = (PG8_LAS float*)(lds + EPI_TAB + 1024);
        const int wv = __builtin_amdgcn_readfirstlane(tid >> 6);
        if (wv == 0) gtab[tid & 63] = qna[tid & 63]; else if (wv == 1) gtab[64 + (tid & 63)] = kna[tid & 63]; else if (wv == 2) gtab[128 + (tid & 63)] = qnb[tid & 63]; else if (wv == 3) gtab[192 + (tid & 63)] = knb[tid & 63];
        rstd_table(ssp, u.pm, (PG8_LAS float*)(lds + EPI_TAB), tid);
    }
    __device__ __forceinline__ void operator()(const f32x4 (&acc)[2][2][4][2], const Unit& u, int wr, int wc, int fr, int fq, PG8_LAS unsigned char* lds) const {
        PG8_LAS float* rst = (PG8_LAS float*)(lds + EPI_TAB); PG8_LAS float* gtab = (PG8_LAS float*)(lds + EPI_TAB + 1024); const int pre_pm = rstd_table_pm(rst);
        const int lane = fr + 16 * fq;
        const int t = u.pn; bf16_t* dst; const float* ng; int nh, h, sel = 0; float sc = 1.0f;
        if (t < 2) { dst = qa; ng = qna; nh = 8; h = 4 * t + wc; sc = QSCALE; sel = 0; }
        else if (t < 4) { dst = ka; ng = kna; nh = 8; h = 4 * (t - 2) + wc; sel = 1; }
        else if (t < 6) { dst = va; ng = nullptr; nh = 8; h = 4 * (t - 4) + wc; }
        else if (t < 8) { dst = qb; ng = qnb; nh = 8; h = 4 * (t - 6) + wc; sc = QSCALE; sel = 2; }
        else if (wc < 2) { dst = kb; ng = knb; nh = 2; h = wc; sel = 3; }
        else { dst = vb; ng = nullptr; nh = 2; h = wc - 2; }
        f32x4 gv[2][2];
        const int row0 = u.pm * BM + wr * 64 + fr;
        float rsv[8];
        if (u.pm == pre_pm) {
          rstd_table_rd(rst, wr, fr, rsv);
          const unsigned ga = (unsigned)(uintptr_t)gtab + (unsigned)(sel * 256 + fq * 32);
          asm volatile("ds_read_b128 %0, %1" : "=v"(gv[0][0]) : "v"(ga) : "memory");            asm volatile("ds_read_b128 %0, %1 offset:16" : "=v"(gv[0][1]) : "v"(ga) : "memory");
          asm volatile("ds_read_b128 %0, %1 offset:128" : "=v"(gv[1][0]) : "v"(ga) : "memory"); asm volatile("ds_read_b128 %0, %1 offset:144" : "=v"(gv[1][1]) : "v"(ga) : "memory");
          asm volatile("s_waitcnt lgkmcnt(0)" : "+v"(rsv[0]), "+v"(rsv[1]), "+v"(rsv[2]), "+v"(rsv[3]), "+v"(rsv[4]), "+v"(rsv[5]), "+v"(rsv[6]), "+v"(rsv[7]), "+v"(gv[0][0]), "+v"(gv[0][1]), "+v"(gv[1][0]), "+v"(gv[1][1]) :: "memory");
        } else
        { f32x4 t8[8];
#pragma unroll
          for (int g = 0; g < 8; ++g) t8[g] = rstd_ld(ssp, row0 + (g >> 2) * HALF + (g & 3) * 16, fq);
          const float* ngp = ng ? ng : qna;
#pragma unroll
          for (int bj = 0; bj < 2; ++bj)
#pragma unroll
              for (int n = 0; n < 2; ++n) gv[bj][n] = *(const f32x4*)(ngp + 32 * bj + 8 * fq + 4 * n);
#pragma unroll
          for (int g = 0; g < 8; ++g) rsv[g] = rstd_fin(t8[g], lane); }
        const float gsc = ng ? sc : 0.0f, gad = ng ? 0.0f : 1.0f;
#pragma unroll
        for (int bj = 0; bj < 2; ++bj)
#pragma unroll
            for (int n = 0; n < 2; ++n) gv[bj][n] = gv[bj][n] * gsc + gad;
        asm volatile("" ::: "memory");
#pragma unroll
        for (int ai = 0; ai < 2; ++ai)
#pragma unroll
            for (int m = 0; m < 4; ++m) { const int row = row0 + ai * HALF + m * 16; const float rs = rsv[ai * 4 + m];
                f32x4 v[2][2]; float ss = 0.f;
#pragma unroll
                for (int bj = 0; bj < 2; ++bj)
#pragma unroll
                    for (int n = 0; n < 2; ++n) { v[bj][n] = acc[ai][bj][m][n] * rs; ss += (v[bj][n][0] * v[bj][n][0] + v[bj][n][1] * v[bj][n][1]) + (v[bj][n][2] * v[bj][n][2] + v[bj][n][3] * v[bj][n][3]); }
                ss += shx(ss, lane, 16); ss += shx(ss, lane, 32);
                const float hr = ng ? __builtin_amdgcn_rsqf(ss * (1.0f / 64.0f) + 1e-6f) : 1.0f;
                const int b = row >> 12, s = row & 4095;
                bf16_t* p = dst + (((size_t)b * nh + h) * 4096 + s) * 64 + 8 * fq;
#pragma unroll
                for (int bj = 0; bj < 2; ++bj) *(u32x4*)(p + 32 * bj) = pack8(v[bj][0] * hr * gv[bj][0], v[bj][1] * hr * gv[bj][1]); }
    }
};
}

#include <hip/hip_cooperative_groups.h>
namespace cg = cooperative_groups;
#define LAS __attribute__((address_space(3)))
typedef unsigned v4u __attribute__((ext_vector_type(4)));
constexpr int NWAVES = 8, RING_BYTES = 131072, LDS_BYTES = 147456;
static_assert(pg8::EPI_TAB >= 8 * 16640 && pg8::EPI_TAB + 4096 <= LDS_BYTES - 64, "epilogue tables");
constexpr int NPHASE = 1 + 8 * DEPTH;
constexpr size_t WO_F1IN = 0, WO_F1OUT = WO_F1IN + (size_t)2 * DFF * D, WO_QKV = WO_F1OUT + (size_t)D * DFF, WO_WO = WO_QKV + (size_t)QKVW * D,
                 WO_F2IN = WO_WO + (size_t)D * D, WO_F2OUT = WO_F2IN + (size_t)2 * DFF * D, WO_WG = WO_F2OUT + (size_t)D * DFF, WO_WP = WO_WG + (size_t)D * D, W_LAYER = WO_WP + (size_t)D * PLE;
static_assert(W_LAYER * 2 * DEPTH <= 84 * MiB, "weights fit");

struct Args { const float* in[20]; float* out; unsigned char* ws; int ph_lo, ph_hi; };

__device__ __forceinline__ int src_col(int kind, int n0) {
    if (kind == 0) return n0;
    if (kind == 1) return ((n0 >> 7) & 1) * DFF + 128 * (n0 >> 8) + (n0 & 127);
    return 256 * (n0 >> 8) + 64 * ((n0 >> 5) & 3) + 32 * ((n0 >> 7) & 1);
}
__device__ __forceinline__ unsigned cvt_pk_nv(float lo, float hi) { unsigned r; asm("v_cvt_pk_bf16_f32 %0, %1, %2" : "=v"(r) : "v"(lo), "v"(hi)); return r; }
struct TrItem { const float* W; const float* gain; bf16_t* Bt; int K, N, kind, item; };
__device__ __forceinline__ void tr_issue(const TrItem& d, int lane, float4 (&v)[16]) {
    const int kblocks = d.K / 64, nb = d.item / kblocks, kb = d.item % kblocks, k0 = 64 * kb, n0 = 64 * nb;
    const int cseg = lane & 15, r0 = lane >> 4;
    const int c0 = src_col(d.kind, n0 + 32 * (cseg >> 3)) + 4 * (cseg & 7);
#pragma unroll
    for (int i = 0; i < 16; ++i) v[i] = *(const float4*)(d.W + (size_t)(k0 + r0 + 4 * i) * d.N + c0);
}
__device__ __forceinline__ void tr_finish(const TrItem& d, LAS float* scr, int lane, const float4 (&v)[16]) {
    const int kblocks = d.K / 64, nb = d.item / kblocks, kb = d.item % kblocks, k0 = 64 * kb, n0 = 64 * nb;
    const int cseg = lane & 15, r0 = lane >> 4, c = lane & 7;
    const float* gp = d.gain ? d.gain + k0 + 8 * c : d.W;
    const float4 g0 = *(const float4*)gp, g1 = *(const float4*)(gp + 4);
#pragma unroll
    for (int i = 0; i < 16; ++i) { LAS float* p = scr + (r0 + 4 * i) * 65 + 4 * cseg; p[0] = v[i].x; p[1] = v[i].y; p[2] = v[i].z; p[3] = v[i].w; }
    asm volatile("s_waitcnt lgkmcnt(0)" ::: "memory");
    const bool hg = d.gain != nullptr;
    const float g[8] = {hg ? g0.x : 1.f, hg ? g0.y : 1.f, hg ? g0.z : 1.f, hg ? g0.w : 1.f, hg ? g1.x : 1.f, hg ? g1.y : 1.f, hg ? g1.z : 1.f, hg ? g1.w : 1.f};
#pragma unroll
    for (int jh = 0; jh < 2; ++jh) {
        float t[4][8];
#pragma unroll
        for (int j = 0; j < 4; ++j) { const LAS float* sp = scr + (8 * c) * 65 + (lane >> 3) + 8 * (4 * jh + j);
#pragma unroll
            for (int q = 0; q < 8; ++q) t[j][q] = sp[q * 65]; }
#pragma unroll
        for (int j = 0; j < 4; ++j) { const int n = (lane >> 3) + 8 * (4 * jh + j);
            v4u o; o.x = cvt_pk_nv(t[j][0] * g[0], t[j][1] * g[1]); o.y = cvt_pk_nv(t[j][2] * g[2], t[j][3] * g[3]); o.z = cvt_pk_nv(t[j][4] * g[4], t[j][5] * g[5]); o.w = cvt_pk_nv(t[j][6] * g[6], t[j][7] * g[7]);
            *(v4u*)(d.Bt + (size_t)(n0 + n) * d.K + k0 + 8 * c) = o; }
    }
    asm volatile("s_waitcnt lgkmcnt(0)" ::: "memory");
}

constexpr int I_FIN = (D / 64) * (2 * DFF / 64), I_FOUT = (DFF / 64) * (D / 64), I_QKV = (D / 64) * (QKVW / 64), I_SQ = (D / 64) * (D / 64), I_WP = (PLE / 64) * (D / 64);
constexpr int IT_FIN1 = 0, IT_FOUT1 = IT_FIN1 + I_FIN, IT_QKV = IT_FOUT1 + I_FOUT, IT_WO = IT_QKV + I_QKV, IT_FIN2 = IT_WO + I_SQ, IT_FOUT2 = IT_FIN2 + I_FIN, IT_WG = IT_FOUT2 + I_FOUT, IT_WP = IT_WG + I_SQ, I_LAYER = IT_WP + I_WP;
template <class AT> __device__ __forceinline__ TrItem tr_decode(const AT& a, int it) {
    bf16_t* wbase = (bf16_t*)(a.ws() + WS_W);
    const int l = it / I_LAYER; int r = it % I_LAYER; bf16_t* wl = wbase + (size_t)l * W_LAYER;
    TrItem d;
    if (r < I_FIN) { d = TrItem{a.in(4) + (size_t)l * D * 2 * DFF, a.in(3) + l * D, wl + WO_F1IN, D, 2 * DFF, 1, r}; return d; } r -= I_FIN;
    if (r < I_FOUT) { d = TrItem{a.in(5) + (size_t)l * DFF * D, nullptr, wl + WO_F1OUT, DFF, D, 0, r}; return d; } r -= I_FOUT;
    if (r < I_QKV) { d = TrItem{a.in(7) + (size_t)l * D * QKVW, a.in(6) + l * D, wl + WO_QKV, D, QKVW, 2, r}; return d; } r -= I_QKV;
    if (r < I_SQ) { d = TrItem{a.in(13) + (size_t)l * D * D, nullptr, wl + WO_WO, D, D, 0, r}; return d; } r -= I_SQ;
    if (r < I_FIN) { d = TrItem{a.in(15) + (size_t)l * D * 2 * DFF, a.in(14) + l * D, wl + WO_F2IN, D, 2 * DFF, 1, r}; return d; } r -= I_FIN;
    if (r < I_FOUT) { d = TrItem{a.in(16) + (size_t)l * DFF * D, nullptr, wl + WO_F2OUT, DFF, D, 0, r}; return d; } r -= I_FOUT;
    if (r < I_SQ) { d = TrItem{a.in(18) + (size_t)l * D * D, a.in(17) + l * D, wl + WO_WG, D, D, 0, r}; return d; } r -= I_SQ;
    d = TrItem{a.in(19) + (size_t)l * PLE * D, nullptr, wl + WO_WP, PLE, D, 0, r}; return d;
}
template <class AT> __device__ __forceinline__ void convert_weight_items(const AT& a, LAS unsigned char* lds, int f1, int c1, int widx, int nw, int wave, int lane, int f2 = 0, int c2 = 0, int f3 = 0, int c3 = 0) {
    LAS float* scr = (LAS float*)(lds + wave * 16640);
    const int total = c1 + c2 + c3;
    auto item_of = [&](int e) { return e < c1 ? f1 + e : (e < c1 + c2 ? f2 + (e - c1) : f3 + (e - c1 - c2)); };
    int e = __builtin_amdgcn_readfirstlane(widx);
    if (e >= total) return;
    float4 va[16], vb[16];
    TrItem d0 = tr_decode(a, item_of(e)), d1 = d0;
    tr_issue(d0, lane, va);
    for (;;) {
        const int e1 = e + nw; const bool h1 = e1 < total;
        if (h1) { d1 = tr_decode(a, item_of(e1)); tr_issue(d1, lane, vb); }
        tr_finish(d0, scr, lane, va);
        if (!h1) break;
        e = e1 + nw; const bool h0 = e < total;
        if (h0) { d0 = tr_decode(a, item_of(e)); tr_issue(d0, lane, va); }
        tr_finish(d1, scr, lane, vb);
        if (!h0) break;
    }
}
template <class AT> __device__ __forceinline__ void prologue_phase(const AT& a, LAS unsigned char* lds, int gw, int NGW, int wave, int lane, bool side_jobs) {
    if (side_jobs) convert_weight_items(a, lds, IT_FIN1, I_FIN, gw, NGW, wave, lane);
    else convert_weight_items(a, lds, 0, DEPTH * I_LAYER, gw, NGW, wave, lane);
    const float* x = a.in(0); bf16_t* xb = (bf16_t*)(a.ws() + WS_XB); bf16_t* xlo = (bf16_t*)a.out(); float* ssp = (float*)(a.ws() + WS_SSP);
    for (int row = gw; row < M; row += 2 * NGW) {
        const int row2 = row + NGW; const bool has2 = row2 < M;
        const float4* xr = (const float4*)(x + (size_t)row * D); const float4* xr2 = (const float4*)(x + (size_t)(has2 ? row2 : row) * D);
        float4 va[4], vb[4];
#pragma unroll
        for (int j = 0; j < 4; ++j) { va[j] = xr[lane + 64 * j]; vb[j] = xr2[lane + 64 * j]; }
        float s = 0.f, s2 = 0.f;
#pragma unroll
        for (int j = 0; j < 4; ++j) { s += va[j].x * va[j].x + va[j].y * va[j].y + va[j].z * va[j].z + va[j].w * va[j].w; s2 += vb[j].x * vb[j].x + vb[j].y * vb[j].y + vb[j].z * vb[j].z + vb[j].w * vb[j].w;
            uint2 o; o.x = pg8::cvt_pk_bf16(va[j].x, va[j].y); o.y = pg8::cvt_pk_bf16(va[j].z, va[j].w); ((uint2*)(xb + (size_t)row * D))[lane + 64 * j] = o;
            if (XLO) { uint2 q; q.x = pg8::cvt_pk_bf16(va[j].x - pg8::bflo(o.x), va[j].y - pg8::bfhi(o.x)); q.y = pg8::cvt_pk_bf16(va[j].z - pg8::bflo(o.y), va[j].w - pg8::bfhi(o.y)); ((uint2*)(xlo + (size_t)row * D))[lane + 64 * j] = q; }
            if (has2) { uint2 o2; o2.x = pg8::cvt_pk_bf16(vb[j].x, vb[j].y); o2.y = pg8::cvt_pk_bf16(vb[j].z, vb[j].w); ((uint2*)(xb + (size_t)row2 * D))[lane + 64 * j] = o2;
                if (XLO) { uint2 q2; q2.x = pg8::cvt_pk_bf16(vb[j].x - pg8::bflo(o2.x), vb[j].y - pg8::bfhi(o2.x)); q2.y = pg8::cvt_pk_bf16(vb[j].z - pg8::bflo(o2.y), vb[j].w - pg8::bfhi(o2.y)); ((uint2*)(xlo + (size_t)row2 * D))[lane + 64 * j] = q2; } } }
#pragma unroll
        for (int o = 1; o < 64; o <<= 1) { s += pg8::shx(s, lane, o); s2 += pg8::shx(s2, lane, o); }
        if (lane < 4) { float4 r; r.x = lane == 0 ? s : 0.f; r.y = 0.f; r.z = 0.f; r.w = 0.f; ((float4*)ssp)[row * 4 + lane] = r;
            if (has2) { r.x = lane == 0 ? s2 : 0.f; ((float4*)ssp)[row2 * 4 + lane] = r; } }
    }
}
__device__ __forceinline__ void convert_p(const float* p, bf16_t* pb, int gtid, int nthreads) {
    for (int i = gtid; i < M * PLE / 8; i += nthreads) { const float4 v0 = ((const float4*)p)[2 * i], v1 = ((const float4*)p)[2 * i + 1];
        v4u o; o.x = pg8::cvt_pk_bf16(v0.x, v0.y); o.y = pg8::cvt_pk_bf16(v0.z, v0.w); o.z = pg8::cvt_pk_bf16(v1.x, v1.y); o.w = pg8::cvt_pk_bf16(v1.z, v1.w); ((v4u*)pb)[i] = o; }
}

namespace att {
typedef short bf16x8 __attribute__((ext_vector_type(8)));
typedef short s16x4 __attribute__((ext_vector_type(4)));
typedef short v4i16_t __attribute__((ext_vector_type(4)));
typedef float f32x16 __attribute__((ext_vector_type(16)));
typedef unsigned u32x4 __attribute__((ext_vector_type(4)));
typedef float f32x2_t __attribute__((ext_vector_type(2))); typedef __bf16 bf16x2_t __attribute__((ext_vector_type(2)));
constexpr float NEG = -1e30f;
constexpr int WAVE_LDS = 8704, LUT_OFF = 0, WAVES_OFF = 8192, LUTA_STRIDE = 200, LUTB_STRIDE = 328, LUTB_OFF = LUT_OFF + 3 * LUTA_STRIDE * 4, TAB_OFF = WAVES_OFF + 8 * WAVE_LDS, LSE_OFF = TAB_OFF + 65536, ATT_LDS_END = LSE_OFF + 2048;
static_assert(LUTB_OFF + 4 * LUTB_STRIDE * 4 <= WAVES_OFF && ATT_LDS_END <= 147456 - 64, "attention LDS map");
__device__ __forceinline__ int crow(int r, int hi) { return (r & 3) + 8 * (r >> 2) + 4 * hi; }
__device__ __forceinline__ unsigned cvtpk(float lo, float hi) { f32x2_t v = {lo, hi}; bf16x2_t b = __builtin_convertvector(v, bf16x2_t); return __builtin_bit_cast(unsigned, b); }
__device__ __forceinline__ s16x4 vtr(const LAS unsigned char* p) { return __builtin_bit_cast(s16x4, __builtin_amdgcn_ds_read_tr16_b64_v4i16((LAS v4i16_t*)p)); }
__device__ __forceinline__ float halfmax(float v) { auto rr = __builtin_amdgcn_permlane32_swap(__float_as_uint(v), __float_as_uint(v), false, false); return fmaxf(__uint_as_float(rr[0]), __uint_as_float(rr[1])); }
__device__ __forceinline__ float halfsum(float v) { auto rr = __builtin_amdgcn_permlane32_swap(__float_as_uint(v), __float_as_uint(v), false, false); return __uint_as_float(rr[0]) + __uint_as_float(rr[1]); }

__device__ __forceinline__ f32x16 bias_ld(const LAS float* lut, const int j, const int i, const int hi) {
    const LAS float* lp = lut + 32 * j - i + 4 * hi; f32x16 b;
#pragma unroll
    for (int r = 0; r < 16; ++r) b[r] = lp[(r & 3) + 8 * (r >> 2)];
    return b;
}
__device__ __forceinline__ void bias_add(f32x16& p, const LAS float* lut, const int j, const int i, const int hi) {
    const LAS float* lp = lut + 32 * j - i + 4 * hi;
#pragma unroll
    for (int r = 0; r < 16; ++r) p[r] += lp[(r & 3) + 8 * (r >> 2)];
}
constexpr float MLOW = -1.0e4f;
constexpr float THR = 8.0f;
template <int NT>
__device__ __forceinline__ void sm_tile(f32x16& p, const LAS float* lut, const int j, const int i, const int hi, const int first, const int dstep, const bool inside,
                                        float& m, float& l, f32x16 (&o)[2], LAS float* wsf, bf16x8& pa0, bf16x8& pa1) {
    if (!inside) {
#pragma unroll
        for (int r = 0; r < 16; ++r) { const int tk = first + crow(r, hi) * dstep; if ((unsigned)tk >= (unsigned)S) p[r] = NEG; }
    }
    float rm = fmaxf(p[0], p[1]);
#pragma unroll
    for (int r = 2; r < 16; ++r) rm = fmaxf(rm, p[r]);
    rm = halfmax(rm);
    if (__any(rm > m + THR)) {
        const float mn = fmaxf(m, rm), alpha = __builtin_amdgcn_exp2f(m - mn);
        l *= alpha; m = mn;
        if (hi == 0) wsf[i] = alpha;
#pragma unroll
        for (int r = 0; r < 16; ++r) { const float a = wsf[crow(r, hi)]; o[0][r] *= a; o[1][r] *= a; }
    }
    f32x2_t rs2 = {0.f, 0.f}; const f32x2_t nm2 = {-m, -m};
#pragma unroll
    for (int r = 0; r < 16; r += 2) { f32x2_t t = (f32x2_t){p[r], p[r + 1]} + nm2; t.x = __builtin_amdgcn_exp2f(t.x); t.y = __builtin_amdgcn_exp2f(t.y); p[r] = t.x; p[r + 1] = t.y; rs2 += t; }
    l += rs2.x + rs2.y;
    u32x4 pw0 = {cvtpk(p[0], p[1]), cvtpk(p[2], p[3]), cvtpk(p[4], p[5]), cvtpk(p[6], p[7])};
    u32x4 pw1 = {cvtpk(p[8], p[9]), cvtpk(p[10], p[11]), cvtpk(p[12], p[13]), cvtpk(p[14], p[15])};
    pa0 = __builtin_bit_cast(bf16x8, pw0); pa1 = __builtin_bit_cast(bf16x8, pw1);
}
template <int NT, int SHIFT>
__device__ __forceinline__ void qtile2(const bf16_t* qrow0, const bf16_t* qrow1, const bf16_t* kbase, const bf16_t* vbase, int tk0, int dstep, const LAS float* lut0, const LAS float* lut1,
                                       float mi0, float li0, float mi1, float li1, LAS unsigned char* wl, int lane_in,
                                       f32x16 (&o0)[2], float& m0_out, float& l0_out, f32x16 (&o1)[2], float& m1_out, float& l1_out) {
    int lane = lane_in; asm volatile("" : "+v"(lane));
    const int i = lane & 31, hi = lane >> 5;
    LAS float* wsf = (LAS float*)(wl + 8192);
    bf16x8 qf0[4], qf1[4];
#pragma unroll
    for (int ks = 0; ks < 4; ++ks) { qf0[ks] = *(const bf16x8*)(qrow0 + 16 * ks + 8 * hi); qf1[ks] = *(const bf16x8*)(qrow1 + 16 * ks + 8 * hi); }
    const int vrow = lane >> 3, vsw = (lane & 7) ^ (((lane >> 4) & 1) << 2);
    const int rd_base = (4 * hi + ((lane & 15) >> 2)) * 128 + 32 * ((lane >> 4) & 1) + 8 * (lane & 3);
    const int bit3 = (lane >> 3) & 1;
    const int vb0 = rd_base + 64 * bit3, vb1 = rd_base + 64 * (1 - bit3);
    bf16x8 kf[4];
#define ATT_LOAD(j, buf) do { \
        { int tk = tk0 + (32 * (j) + i) * dstep; tk = tk < 0 ? 0 : (tk > S - 1 ? S - 1 : tk); const bf16_t* kp = kbase + (size_t)tk * HD + 8 * hi; \
          _Pragma("unroll") for (int ks = 0; ks < 4; ++ks) kf[ks] = *(const bf16x8*)(kp + 16 * ks); } \
        _Pragma("unroll") for (int i4 = 0; i4 < 4; ++i4) { int tk = tk0 + (32 * (j) + vrow + 8 * i4) * dstep; tk = tk < 0 ? 0 : (tk > S - 1 ? S - 1 : tk); \
          __builtin_amdgcn_global_load_lds((const unsigned*)(vbase + (size_t)tk * HD + 8 * vsw), (LAS unsigned*)(wl + (buf) * 4096 + i4 * 1024), 16, 0, 0); } } while (0)
    float m0 = mi0, l0 = hi == 0 ? li0 : 0.f, m1 = mi1, l1 = hi == 0 ? li1 : 0.f;
    o0[0] = f32x16{}; o0[1] = f32x16{}; o1[0] = f32x16{}; o1[1] = f32x16{};
    ATT_LOAD(0, 0);
#pragma unroll 1
    for (int jj = 0; jj < NT + SHIFT; ++jj) {
        LAS unsigned char* vbuf = wl + (jj & 1) * 4096;
        const bool a0 = jj < NT, a1 = jj >= SHIFT;
        const int first = tk0 + 32 * jj * dstep, lastk = first + 31 * dstep;
        const bool inside = first >= 0 && lastk < S;
        asm volatile("s_waitcnt vmcnt(0)" ::: "memory");
        f32x16 p0, p1;
        bf16x8 pa00, pa01, pa10, pa11;
        {
            if (a0) {
                p0 = __builtin_amdgcn_mfma_f32_32x32x16_bf16(kf[0], qf0[0], bias_ld(lut0, jj, i, hi), 0, 0, 0);
#pragma unroll
                for (int ks = 1; ks < 4; ++ks) p0 = __builtin_amdgcn_mfma_f32_32x32x16_bf16(kf[ks], qf0[ks], p0, 0, 0, 0);
            }
            if (a1) {
                p1 = __builtin_amdgcn_mfma_f32_32x32x16_bf16(kf[0], qf1[0], bias_ld(lut1, jj - SHIFT, i, hi), 0, 0, 0);
#pragma unroll
                for (int ks = 1; ks < 4; ++ks) p1 = __builtin_amdgcn_mfma_f32_32x32x16_bf16(kf[ks], qf1[ks], p1, 0, 0, 0);
            }
        }
        if (jj + 1 < NT + SHIFT) ATT_LOAD(jj + 1, (jj + 1) & 1);
        {
            if (a0) sm_tile<NT>(p0, lut0, jj, i, hi, first, dstep, inside, m0, l0, o0, wsf, pa00, pa01);
            if (a1) sm_tile<NT>(p1, lut1, jj - SHIFT, i, hi, first, dstep, inside, m1, l1, o1, wsf, pa10, pa11);
#pragma unroll
            for (int d0 = 0; d0 < 2; ++d0) {
                const unsigned vp = (unsigned)(uintptr_t)(vbuf + (d0 == 0 ? vb0 : vb1));
                s16x4 x0, x1, y0, y1;
                asm volatile("ds_read_b64_tr_b16 %0, %1" : "=&v"(x0) : "v"(vp) : "memory");
                asm volatile("ds_read_b64_tr_b16 %0, %1 offset:1024" : "=&v"(x1) : "v"(vp) : "memory");
                asm volatile("ds_read_b64_tr_b16 %0, %1 offset:2048" : "=&v"(y0) : "v"(vp) : "memory");
                asm volatile("ds_read_b64_tr_b16 %0, %1 offset:3072" : "=&v"(y1) : "v"(vp) : "memory");
                asm volatile("s_waitcnt lgkmcnt(0)" : "+v"(x0), "+v"(x1), "+v"(y0), "+v"(y1) :: "memory"); __builtin_amdgcn_sched_barrier(0);
                const bf16x8 f0 = {x0[0], x0[1], x0[2], x0[3], x1[0], x1[1], x1[2], x1[3]}, f1 = {y0[0], y0[1], y0[2], y0[3], y1[0], y1[1], y1[2], y1[3]};
                if (a0) { o0[d0] = __builtin_amdgcn_mfma_f32_32x32x16_bf16(pa00, f0, o0[d0], 0, 0, 0); o0[d0] = __builtin_amdgcn_mfma_f32_32x32x16_bf16(pa01, f1, o0[d0], 0, 0, 0); }
                if (a1) { o1[d0] = __builtin_amdgcn_mfma_f32_32x32x16_bf16(pa10, f0, o1[d0], 0, 0, 0); o1[d0] = __builtin_amdgcn_mfma_f32_32x32x16_bf16(pa11, f1, o1[d0], 0, 0, 0); }
            }
        }
    }
#undef ATT_LOAD
    m0_out = m0; l0_out = halfsum(l0); m1_out = m1; l1_out = halfsum(l1);
}

template <int NT>
__device__ __forceinline__ void qtile2s(const bf16_t* qrow0, const bf16_t* qrow1, const bf16_t* kbase, const bf16_t* vbase, int tk0a, int tk0b, int dstep, const LAS float* lut,
                                        LAS unsigned char* wl, LAS unsigned char* wlb, int lane_in,
                                        f32x16 (&o0)[2], float& m0_out, float& l0_out, f32x16 (&o1)[2], float& m1_out, float& l1_out) {
    int lane = lane_in; asm volatile("" : "+v"(lane));
    const int i = lane & 31, hi = lane >> 5;
    LAS float* wsf = (LAS float*)(wl + 8192);
    bf16x8 qf0[4], qf1[4];
#pragma unroll
    for (int ks = 0; ks < 4; ++ks) { qf0[ks] = *(const bf16x8*)(qrow0 + 16 * ks + 8 * hi); qf1[ks] = *(const bf16x8*)(qrow1 + 16 * ks + 8 * hi); }
    const int vrow = lane >> 3, vsw = (lane & 7) ^ (((lane >> 4) & 1) << 2);
    const int rd_base = (4 * hi + ((lane & 15) >> 2)) * 128 + 32 * ((lane >> 4) & 1) + 8 * (lane & 3);
    const int bit3 = (lane >> 3) & 1;
    const int vb0 = rd_base + 64 * bit3, vb1 = rd_base + 64 * (1 - bit3);
    bf16x8 kfa[4], kfb[4];
#define ATT_LOADS(j, buf, KF, TK0, WL) do { \
        { int tk = (TK0) + (32 * (j) + i) * dstep; tk = tk < 0 ? 0 : (tk > S - 1 ? S - 1 : tk); const bf16_t* kp = kbase + (size_t)tk * HD + 8 * hi; \
          _Pragma("unroll") for (int ks = 0; ks < 4; ++ks) KF[ks] = *(const bf16x8*)(kp + 16 * ks); } \
        _Pragma("unroll") for (int i4 = 0; i4 < 4; ++i4) { int tk = (TK0) + (32 * (j) + vrow + 8 * i4) * dstep; tk = tk < 0 ? 0 : (tk > S - 1 ? S - 1 : tk); \
          __builtin_amdgcn_global_load_lds((const unsigned*)(vbase + (size_t)tk * HD + 8 * vsw), (LAS unsigned*)((WL) + (buf) * 4096 + i4 * 1024), 16, 0, 0); } } while (0)
    float m0 = MLOW, l0 = 0.f, m1 = MLOW, l1 = 0.f;
    o0[0] = f32x16{}; o0[1] = f32x16{}; o1[0] = f32x16{}; o1[1] = f32x16{};
    ATT_LOADS(0, 0, kfa, tk0a, wl); ATT_LOADS(0, 0, kfb, tk0b, wlb);
#pragma unroll 1
    for (int jj = 0; jj < NT; ++jj) {
        LAS unsigned char* vbufa = wl + (jj & 1) * 4096; LAS unsigned char* vbufb = wlb + (jj & 1) * 4096;
        const int firsta = tk0a + 32 * jj * dstep, firstb = tk0b + 32 * jj * dstep;
        const bool insa = firsta >= 0 && firsta + 31 * dstep < S, insb = firstb >= 0 && firstb + 31 * dstep < S;
        asm volatile("s_waitcnt vmcnt(0)" ::: "memory");
        f32x16 p0, p1;
        bf16x8 pa00, pa01, pa10, pa11;
        p0 = __builtin_amdgcn_mfma_f32_32x32x16_bf16(kfa[0], qf0[0], bias_ld(lut, jj, i, hi), 0, 0, 0);
        p1 = __builtin_amdgcn_mfma_f32_32x32x16_bf16(kfb[0], qf1[0], bias_ld(lut, jj, i, hi), 0, 0, 0);
#pragma unroll
        for (int ks = 1; ks < 4; ++ks) { p0 = __builtin_amdgcn_mfma_f32_32x32x16_bf16(kfa[ks], qf0[ks], p0, 0, 0, 0); p1 = __builtin_amdgcn_mfma_f32_32x32x16_bf16(kfb[ks], qf1[ks], p1, 0, 0, 0); }
        if (jj + 1 < NT) { ATT_LOADS(jj + 1, (jj + 1) & 1, kfa, tk0a, wl); ATT_LOADS(jj + 1, (jj + 1) & 1, kfb, tk0b, wlb); }
        sm_tile<NT>(p0, lut, jj, i, hi, firsta, dstep, insa, m0, l0, o0, wsf, pa00, pa01);
        sm_tile<NT>(p1, lut, jj, i, hi, firstb, dstep, insb, m1, l1, o1, wsf, pa10, pa11);
#pragma unroll
        for (int d0 = 0; d0 < 2; ++d0) {
            const unsigned vpa = (unsigned)(uintptr_t)(vbufa + (d0 == 0 ? vb0 : vb1)), vpb = (unsigned)(uintptr_t)(vbufb + (d0 == 0 ? vb0 : vb1));
            s16x4 x0, x1, y0, y1, z0, z1, w0, w1;
            asm volatile("ds_read_b64_tr_b16 %0, %1" : "=&v"(x0) : "v"(vpa) : "memory"); asm volatile("ds_read_b64_tr_b16 %0, %1 offset:1024" : "=&v"(x1) : "v"(vpa) : "memory");
            asm volatile("ds_read_b64_tr_b16 %0, %1 offset:2048" : "=&v"(y0) : "v"(vpa) : "memory"); asm volatile("ds_read_b64_tr_b16 %0, %1 offset:3072" : "=&v"(y1) : "v"(vpa) : "memory");
            asm volatile("ds_read_b64_tr_b16 %0, %1" : "=&v"(z0) : "v"(vpb) : "memory"); asm volatile("ds_read_b64_tr_b16 %0, %1 offset:1024" : "=&v"(z1) : "v"(vpb) : "memory");
            asm volatile("ds_read_b64_tr_b16 %0, %1 offset:2048" : "=&v"(w0) : "v"(vpb) : "memory"); asm volatile("ds_read_b64_tr_b16 %0, %1 offset:3072" : "=&v"(w1) : "v"(vpb) : "memory");
            asm volatile("s_waitcnt lgkmcnt(0)" : "+v"(x0), "+v"(x1), "+v"(y0), "+v"(y1), "+v"(z0), "+v"(z1), "+v"(w0), "+v"(w1) :: "memory"); __builtin_amdgcn_sched_barrier(0);
            const bf16x8 f0 = {x0[0], x0[1], x0[2], x0[3], x1[0], x1[1], x1[2], x1[3]}, f1 = {y0[0], y0[1], y0[2], y0[3], y1[0], y1[1], y1[2], y1[3]};
            const bf16x8 g0 = {z0[0], z0[1], z0[2], z0[3], z1[0], z1[1], z1[2], z1[3]}, g1 = {w0[0], w0[1], w0[2], w0[3], w1[0], w1[1], w1[2], w1[3]};
            o0[d0] = __builtin_amdgcn_mfma_f32_32x32x16_bf16(pa00, f0, o0[d0], 0, 0, 0); o0[d0] = __builtin_amdgcn_mfma_f32_32x32x16_bf16(pa01, f1, o0[d0], 0, 0, 0);
            o1[d0] = __builtin_amdgcn_mfma_f32_32x32x16_bf16(pa10, g0, o1[d0], 0, 0, 0); o1[d0] = __builtin_amdgcn_mfma_f32_32x32x16_bf16(pa11, g1, o1[d0], 0, 0, 0);
        }
    }
#undef ATT_LOADS
    m0_out = m0; l0_out = halfsum(l0); m1_out = m1; l1_out = halfsum(l1);
}

__device__ __forceinline__ void glds16(const void* gsrc, unsigned lds_dst) { unsigned keep;
    asm volatile("s_mov_b32 %0, m0\n\ts_mov_b32 m0, %2\n\ts_nop 0\n\tglobal_load_lds_dwordx4 %1, off\n\ts_mov_b32 m0, %0" : "=&s"(keep) : "v"(gsrc), "s"(lds_dst) : "memory"); }
__device__ __forceinline__ void qtile16(const bf16_t* qrow, const bf16_t* kbase, const bf16_t* vbase, const int tk0, const LAS float* lut, LAS unsigned char* wl, LAS unsigned char* xbuf,
                                        int lane_in, f32x16 (&o)[2], float& m_out, float& l_out) {
    int lane = lane_in; asm volatile("" : "+v"(lane));
    const int i = lane & 31, hi = lane >> 5;
    LAS float* wsf = (LAS float*)(wl + 8192);
    bf16x8 qf[4];
    { const bf16_t* qp = qrow + 8 * hi;
      asm volatile("global_load_dwordx4 %0, %1, off" : "=v"(qf[0]) : "v"(qp) : "memory"); asm volatile("global_load_dwordx4 %0, %1, off offset:32" : "=v"(qf[1]) : "v"(qp) : "memory");
      asm volatile("global_load_dwordx4 %0, %1, off offset:64" : "=v"(qf[2]) : "v"(qp) : "memory"); asm volatile("global_load_dwordx4 %0, %1, off offset:96" : "=v"(qf[3]) : "v"(qp) : "memory"); }
    const int vrow = lane >> 3, vsw = (lane & 7) ^ (((lane >> 4) & 1) << 2);
    const int rd_base = (4 * hi + ((lane & 15) >> 2)) * 128 + 32 * ((lane >> 4) & 1) + 8 * (lane & 3);
    const int bit3 = (lane >> 3) & 1;
    const int vb0 = rd_base + 64 * bit3, vb1 = rd_base + 64 * (1 - bit3);
    const unsigned b0 = (unsigned)__builtin_amdgcn_readfirstlane((int)(unsigned)(uintptr_t)wl), b1 = b0 + 4096u, b2 = (unsigned)__builtin_amdgcn_readfirstlane((int)(unsigned)(uintptr_t)xbuf);
    bf16x8 kf[5][4];
#define Q16_K(t) do { int tk = tk0 + (32 * (t) + i) * 16; tk = tk < 0 ? 0 : (tk > S - 1 ? S - 1 : tk); const bf16_t* kp = kbase + (size_t)tk * HD + 8 * hi; \
        asm volatile("global_load_dwordx4 %0, %1, off" : "=v"(kf[t][0]) : "v"(kp) : "memory"); asm volatile("global_load_dwordx4 %0, %1, off offset:32" : "=v"(kf[t][1]) : "v"(kp) : "memory"); \
        asm volatile("global_load_dwordx4 %0, %1, off offset:64" : "=v"(kf[t][2]) : "v"(kp) : "memory"); asm volatile("global_load_dwordx4 %0, %1, off offset:96" : "=v"(kf[t][3]) : "v"(kp) : "memory"); } while (0)
#define Q16_V(t, buf) do { _Pragma("unroll") for (int i4 = 0; i4 < 4; ++i4) { int tk = tk0 + (32 * (t) + vrow + 8 * i4) * 16; tk = tk < 0 ? 0 : (tk > S - 1 ? S - 1 : tk); \
        glds16(vbase + (size_t)tk * HD + 8 * vsw, (buf) + i4 * 1024u); } } while (0)
#define Q16_WAIT(t, n) do { asm volatile("s_waitcnt vmcnt(" #n ")" : "+v"(kf[t][0]), "+v"(kf[t][1]), "+v"(kf[t][2]), "+v"(kf[t][3]) :: "memory"); __builtin_amdgcn_sched_barrier(0); } while (0)
    Q16_K(0); Q16_V(0, b0); Q16_K(1); Q16_V(1, b1); Q16_K(2); Q16_V(2, b2); Q16_K(3); Q16_K(4);
    float m = MLOW, l = 0.f;
    o[0] = f32x16{}; o[1] = f32x16{};
#define Q16_STEP(t, nwait, vimg, AFTER) do { \
        Q16_WAIT(t, nwait); \
        f32x16 p = __builtin_amdgcn_mfma_f32_32x32x16_bf16(kf[t][0], qf[0], bias_ld(lut, (t), i, hi), 0, 0, 0); \
        p = __builtin_amdgcn_mfma_f32_32x32x16_bf16(kf[t][1], qf[1], p, 0, 0, 0); p = __builtin_amdgcn_mfma_f32_32x32x16_bf16(kf[t][2], qf[2], p, 0, 0, 0); p = __builtin_amdgcn_mfma_f32_32x32x16_bf16(kf[t][3], qf[3], p, 0, 0, 0); \
        const int first_ = tk0 + 32 * (t) * 16; const bool inside_ = first_ >= 0 && first_ + 31 * 16 < S; \
        bf16x8 pa0_, pa1_; sm_tile<5>(p, lut, (t), i, hi, first_, 16, inside_, m, l, o, wsf, pa0_, pa1_); \
        _Pragma("unroll") for (int d0 = 0; d0 < 2; ++d0) { const unsigned vp = (vimg) + (unsigned)(d0 == 0 ? vb0 : vb1); s16x4 a0, a1, c0, c1; \
            asm volatile("ds_read_b64_tr_b16 %0, %1" : "=&v"(a0) : "v"(vp) : "memory"); asm volatile("ds_read_b64_tr_b16 %0, %1 offset:1024" : "=&v"(a1) : "v"(vp) : "memory"); \
            asm volatile("ds_read_b64_tr_b16 %0, %1 offset:2048" : "=&v"(c0) : "v"(vp) : "memory"); asm volatile("ds_read_b64_tr_b16 %0, %1 offset:3072" : "=&v"(c1) : "v"(vp) : "memory"); \
            asm volatile("s_waitcnt lgkmcnt(0)" : "+v"(a0), "+v"(a1), "+v"(c0), "+v"(c1) :: "memory"); __builtin_amdgcn_sched_barrier(0); \
            const bf16x8 f0 = {a0[0], a0[1], a0[2], a0[3], a1[0], a1[1], a1[2], a1[3]}, f1 = {c0[0], c0[1], c0[2], c0[3], c1[0], c1[1], c1[2], c1[3]}; \
            o[d0] = __builtin_amdgcn_mfma_f32_32x32x16_bf16(pa0_, f0, o[d0], 0, 0, 0); o[d0] = __builtin_amdgcn_mfma_f32_32x32x16_bf16(pa1_, f1, o[d0], 0, 0, 0); } \
        AFTER; } while (0)
    asm volatile("s_waitcnt vmcnt(24)" : "+v"(qf[0]), "+v"(qf[1]), "+v"(qf[2]), "+v"(qf[3]) :: "memory");
    Q16_STEP(0, 24, b0, Q16_V(3, b0));
    Q16_STEP(1, 20, b1, Q16_V(4, b1));
    Q16_STEP(2, 16, b2, (void)0);
    Q16_STEP(3, 4, b0, (void)0);
    Q16_STEP(4, 0, b1, (void)0);
#undef Q16_K
#undef Q16_V
#undef Q16_WAIT
#undef Q16_STEP
    m_out = m; l_out = halfsum(l);
}

__device__ __forceinline__ void stage_o(const f32x16 (&o)[2], float m, float l, LAS unsigned char* wl, int lane_in) {
    int lane = lane_in; asm volatile("" : "+v"(lane));
    const int i = lane & 31, hi = lane >> 5;
    LAS float* wsf = (LAS float*)(wl + 8192);
    if (hi == 0) { wsf[i] = __builtin_amdgcn_rcpf(l); wsf[32 + i] = m + __builtin_amdgcn_logf(l); }
    LAS bf16_t* stg = (LAS bf16_t*)wl;
#pragma unroll
    for (int r = 0; r < 16; ++r) { const int q = crow(r, hi); const float inv = wsf[q];
        stg[q * 64 + i] = (bf16_t)(cvtpk(o[0][r] * inv, 0.f) & 0xffffu); stg[q * 64 + 32 + i] = (bf16_t)(cvtpk(o[1][r] * inv, 0.f) & 0xffffu); }
}
__device__ __forceinline__ float bflo(unsigned w) { return __uint_as_float(w << 16); }
__device__ __forceinline__ float bfhi(unsigned w) { return __uint_as_float(w & 0xffff0000u); }
__device__ __forceinline__ unsigned mix2(unsigned a, unsigned b, float wa, float wb) { return cvtpk(wa * bflo(a) + wb * bflo(b), wa * bfhi(a) + wb * bfhi(b)); }

struct Tensors { const bf16_t *qa, *ka, *va, *qb, *kb, *vb; const float* glut; const float* sink; bf16_t* o; };
__device__ __forceinline__ void finish_a(const f32x16 (&o)[2], float m, float l, int pass, int d, int lam0, int rr, LAS unsigned char* wl, LAS unsigned char* tab, LAS float* lsetab, bf16_t* orow0, int lane_in) {
    LAS float* wsf = (LAS float*)(wl + 8192);
    stage_o(o, m, l, wl, lane_in);
    int lane = lane_in; asm volatile("" : "+v"(lane));
#pragma unroll
    for (int i4 = 0; i4 < 4; ++i4) {
        const int qi = (lane >> 3) + 8 * i4, ch = lane & 7, tau = d * (lam0 + qi) + rr;
        u32x4 v = *(const LAS u32x4*)(wl + qi * 128 + ch * 16);
        const float Lb = wsf[32 + qi];
        const int e = (tau & 15) * 32 + (tau >> 4);
        LAS u32x4* te = (LAS u32x4*)(tab + e * 128 + ch * 16);
        if (pass == 0) { *te = v; if (ch == 0) lsetab[e] = Lb; }
        else {
            const u32x4 tv = *te; const float La = lsetab[e];
            const float Lm = fmaxf(La, Lb), sa = __builtin_amdgcn_exp2f(La - Lm), sb = __builtin_amdgcn_exp2f(Lb - Lm), tot = sa + sb, rt = __builtin_amdgcn_rcpf(tot), wa = sa * rt, wb = sb * rt;
            u32x4 w; w.x = mix2(tv.x, v.x, wa, wb); w.y = mix2(tv.y, v.y, wa, wb); w.z = mix2(tv.z, v.z, wa, wb); w.w = mix2(tv.w, v.w, wa, wb);
            if (pass == 1) { *te = w; if (ch == 0) lsetab[e] = Lm + __builtin_amdgcn_logf(tot); }
            else *(u32x4*)(orow0 + (size_t)tau * D + ch * 8) = w;
        }
    }
}


__device__ __forceinline__ int bucket(int rel) {
    const int n = rel < 0 ? -rel : rel; const int ret = rel > 0 ? 16 : 0;
    if (n < 8) return ret + n;
    int large = 8 + (int)(logf((float)n / 8.0f) / 4.852030263919617f * 8.0f);
    large = large < 15 ? large : 15;
    return ret + large;
}

constexpr int GLUT_A = 8 * 3 * LUTA_STRIDE, GLUT_B = 2 * 4 * LUTB_STRIDE;
__device__ __forceinline__ void build_luts(const float* rel_bias, float* glut, int gtid, int nthreads) {
    for (int e = gtid; e < GLUT_A + GLUT_B; e += nthreads) {
        float v = NEG;
        if (e < GLUT_A) { const int h = e / (3 * LUTA_STRIDE), c = (e / LUTA_STRIDE) % 3, idx = e % LUTA_STRIDE - 32, d = c == 0 ? 1 : (c == 1 ? 4 : 16);
            if (idx >= 0 && idx <= 128) v = rel_bias[bucket((idx - 64) * d) * 16 + h] * LOG2E; }
        else { const int f = e - GLUT_A, hk = f / (4 * LUTB_STRIDE), g = (f / LUTB_STRIDE) & 3, idx = f % LUTB_STRIDE - 32;
            if (idx >= 0 && idx <= 256) v = rel_bias[bucket(idx - 128) * 16 + 8 + 4 * hk + g] * LOG2E; }
        glut[e] = v;
    }
}
__device__ __forceinline__ void attn_unit(const Tensors& T, int u, LAS unsigned char* lds, int wave, int lane, const int pmode = 0x33) {
    LAS unsigned char* wl = lds + WAVES_OFF + wave * WAVE_LDS;
    LAS float* wsf = (LAS float*)(wl + 8192);
    LAS float* lutA = (LAS float*)(lds + LUT_OFF); LAS float* lutB = (LAS float*)(lds + LUTB_OFF);
    LAS unsigned char* tab = lds + TAB_OFF; LAS float* lsetab = (LAS float*)(lds + LSE_OFF);
    const int tid = wave * 64 + lane;
    const int i = lane & 31;
    __syncthreads();
    { const int hkb = (u >> 5) & 1, ha = (u >> 3) & 7;
      const float* ga = T.glut + ha * 3 * LUTA_STRIDE; const float* gb = T.glut + GLUT_A + hkb * 4 * LUTB_STRIDE;
      for (int e = tid; e < 3 * LUTA_STRIDE; e += 512) lutA[e] = ga[e];
      for (int e = tid; e < 4 * LUTB_STRIDE; e += 512) lutB[e] = gb[e]; }
    __syncthreads();
    if (pmode & 1) {
        const int bh = u >> 3, blk = u & 7, b = bh >> 3, h = bh & 7, t0 = blk * 512;
        const bf16_t* qbase = T.qa + (size_t)bh * S * HD; const bf16_t* kbase = T.ka + (size_t)bh * S * HD; const bf16_t* vbase = T.va + (size_t)bh * S * HD;
        bf16_t* orow0 = T.o + ((size_t)b * S + t0) * D + h * HD;
#pragma unroll 1
        for (int pass = 0; pass < (pmode >> 4); ++pass) {
            const int c = ATT_ORDER == 0 ? 2 - pass : (pass == 0 ? 2 : (pass == 1 ? 0 : 1)), d = c == 0 ? 1 : (c == 1 ? 4 : 16);
            const LAS float* lt = lutA + c * LUTA_STRIDE + 32;
            if (c == 2) {
#if D16_MODE == 1
                const int rr = 2 * wave;
                f32x16 oA[2], oB[2]; float mA, lA, mB, lB;
                qtile2s<5>(qbase + (size_t)(t0 + d * i + rr) * HD, qbase + (size_t)(t0 + d * i + rr + 1) * HD, kbase, vbase, t0 - 64 * d + rr, t0 - 64 * d + rr + 1, d, lt,
                           wl, tab + wave * 8192, lane, oA, mA, lA, oB, mB, lB);
                finish_a(oA, mA, lA, pass, d, 0, rr, wl, tab, lsetab, orow0, lane);
                finish_a(oB, mB, lB, pass, d, 0, rr + 1, wl, tab, lsetab, orow0, lane);
#else
#pragma unroll 1
                for (int tt = 0; tt < 2; ++tt) { const int rr = 2 * wave + tt;
                    f32x16 o1[2]; float m1, l1;
                    qtile16(qbase + (size_t)(t0 + d * i + rr) * HD, kbase, vbase, t0 - 64 * d + rr, lt, wl, tab + wave * 8192 + 4096, lane, o1, m1, l1);
                    finish_a(o1, m1, l1, pass, d, 0, rr, wl, tab, lsetab, orow0, lane); }
#endif
            } else {
                const int Tq = 2 * wave, rr = c == 1 ? (Tq >> 2) : 0, lamA = 32 * (c == 1 ? (Tq & 3) : Tq);
                f32x16 oA[2], oB[2]; float mA, lA, mB, lB;
                qtile2<5, 1>(qbase + (size_t)(t0 + d * (lamA + i) + rr) * HD, qbase + (size_t)(t0 + d * (lamA + 32 + i) + rr) * HD, kbase, vbase, t0 + d * (lamA - 64) + rr, d, lt, lt,
                             MLOW, 0.f, MLOW, 0.f, wl, lane, oA, mA, lA, oB, mB, lB);
                finish_a(oA, mA, lA, pass, d, lamA, rr, wl, tab, lsetab, orow0, lane);
                finish_a(oB, mB, lB, pass, d, lamA + 32, rr, wl, tab, lsetab, orow0, lane);
            }
            if (pass < 2) __syncthreads();
        }
    }
    if (pmode & 2) {
        const int bk = u >> 5, blk = u & 31, b = bk >> 1, hk = bk & 1, t0 = blk * 128;
        const bf16_t* kbase = T.kb + (size_t)bk * S * HD; const bf16_t* vbase = T.vb + (size_t)bk * S * HD;
        const int qt = wave & 3, g0 = 2 * (wave >> 2), hq0 = 4 * hk + g0;
        const int tq = t0 + 32 * qt + i, tk0 = t0 + 32 * qt - 128;
        f32x16 oA[2], oB[2]; float mA, lA, mB, lB;
        qtile2<9, 0>(T.qb + (((size_t)b * 8 + hq0) * S + tq) * HD, T.qb + (((size_t)b * 8 + hq0 + 1) * S + tq) * HD, kbase, vbase, tk0, 1,
                     lutB + g0 * LUTB_STRIDE + 32, lutB + (g0 + 1) * LUTB_STRIDE + 32, T.sink[hq0] * LOG2E, 1.0f, T.sink[hq0 + 1] * LOG2E, 1.0f, wl, lane, oA, mA, lA, oB, mB, lB);
        bf16_t* ob0 = T.o + ((size_t)b * S + t0 + 32 * qt) * D + (8 + hq0) * HD;
        stage_o(oA, mA, lA, wl, lane);
#pragma unroll
        for (int i4 = 0; i4 < 4; ++i4) { const int qi = (lane >> 3) + 8 * i4, ch = lane & 7; *(u32x4*)(ob0 + (size_t)qi * D + ch * 8) = *(const LAS u32x4*)(wl + qi * 128 + ch * 16); }
        stage_o(oB, mB, lB, wl, lane);
#pragma unroll
        for (int i4 = 0; i4 < 4; ++i4) { const int qi = (lane >> 3) + 8 * i4, ch = lane & 7; *(u32x4*)(ob0 + HD + (size_t)qi * D + ch * 8) = *(const LAS u32x4*)(wl + qi * 128 + ch * 16); }
    }
}
}

#define XB_TMO      128
#define XB_XCNT(j)  (256  + 64 * (j))
#define XB_XSUB(j)  (1280 + 64 * (j))
#define XB_XGEN(j)  (2304 + 64 * (j))
#define XB_TOP      3328
#define XB_TOPGEN   3392
#define XCD_BAR_WORDS 3456
#define XB_SPIN_CAP (1u << 18)

__device__ __forceinline__ unsigned xb_ld(unsigned* p)              { return __hip_atomic_load(p, __ATOMIC_RELAXED, __HIP_MEMORY_SCOPE_AGENT); }
__device__ __forceinline__ unsigned xb_add(unsigned* p, unsigned v) { return __hip_atomic_fetch_add(p, v, __ATOMIC_RELAXED, __HIP_MEMORY_SCOPE_AGENT); }
__device__ __forceinline__ unsigned xb_xcc_id() { return (unsigned)__builtin_amdgcn_s_getreg((3 << 11) | 20) & 0xFu; }
#define XB_SPIN(cond, bar) do { unsigned _sp = 0; while (cond) { __builtin_amdgcn_s_sleep(1); \
    if ((++_sp & 255u) == 0u) { if (xb_ld(&(bar)[XB_TMO])) break; if (_sp > XB_SPIN_CAP) { atomicAdd(&(bar)[XB_TMO], 1u); break; } } } } while (0)

struct XcdBarrier {
    unsigned* bar; unsigned x;
    volatile LAS unsigned* st;
};

__device__ __forceinline__ XcdBarrier xcd_barrier_post(unsigned* bar, volatile LAS unsigned* st, unsigned& rank) {
    XcdBarrier b; b.bar = bar; b.x = xb_xcc_id(); b.st = st;
    if (threadIdx.x == 0) rank = xb_add(&bar[XB_XCNT(b.x)], 1u);
    return b;
}
__device__ __forceinline__ void xcd_barrier_complete(unsigned* bar, unsigned x, unsigned& nloc, unsigned& nx, unsigned& regular) {
    const unsigned G = gridDim.x * gridDim.y * gridDim.z;
    unsigned sum, cnt, mine, bad, sp = 0u;
    regular = 0u;
    for (;;) {
        sum = 0u; cnt = 0u; mine = 0u; bad = 0u;
#pragma unroll
        for (unsigned j = 0; j < 16; ++j) { const unsigned c = xb_ld(&bar[XB_XCNT(j)]); sum += c; cnt += (c > 0u) ? 1u : 0u; mine = (j == x) ? c : mine; bad |= (c != (j < 8u ? G / 8u : 0u)) ? 1u : 0u; }
        if (sum == G) { regular = (bad == 0u && G == 256u) ? 1u : 0u; break; }
        __builtin_amdgcn_s_sleep(1);
        if ((++sp & 255u) == 0u) { if (xb_ld(&bar[XB_TMO])) break; if (sp > XB_SPIN_CAP) { atomicAdd(&bar[XB_TMO], 1u); break; } }
    }
    nloc = mine > 0u ? mine : 1u; nx = cnt > 0u ? cnt : 1u;
}

template <class Mid> __device__ __forceinline__ void xcd_barrier(const XcdBarrier& b, const bool is_t0, const Mid& mid) {
    asm volatile("s_waitcnt vmcnt(0)" ::: "memory");
    __syncthreads();
    mid();
    if (is_t0) {
        unsigned* bar = b.bar;
        __builtin_amdgcn_s_waitcnt(0);
        unsigned nloc = b.st[0], nx = b.st[1];
        if (nloc == 0u) { unsigned reg; xcd_barrier_complete(bar, b.x, nloc, nx, reg); b.st[0] = nloc; b.st[1] = nx;
            b.st[2] = LOCAL_SEAMS ? reg : 0u; if (LOCAL_SEAMS && reg) b.st[3] = b.st[4] * 8u + b.x; }
        const unsigned old = xb_add(&bar[XB_XSUB(b.x)], 1u);
        const unsigned gen = old / nloc;
        if (old + 1u == (gen + 1u) * nloc) {
            __builtin_amdgcn_fence(__ATOMIC_RELEASE, "agent");
            asm volatile("s_waitcnt vmcnt(0)" ::: "memory");
            const unsigned og = xb_add(&bar[XB_TOP], 1u);
            const unsigned tg = og / nx;
            if (og + 1u == (tg + 1u) * nx) xb_add(&bar[XB_TOPGEN], 1u);
            else XB_SPIN(xb_ld(&bar[XB_TOPGEN]) == tg, bar);
            __builtin_amdgcn_fence(__ATOMIC_ACQUIRE, "agent");
            asm volatile("s_waitcnt vmcnt(0)" ::: "memory");
        } else {
            XB_SPIN(xb_ld(&bar[XB_TOPGEN]) == gen, bar);
            __builtin_amdgcn_fence(__ATOMIC_ACQUIRE, "agent");
            asm volatile("s_waitcnt vmcnt(0)" ::: "memory");
        }
    }
    __syncthreads();
}
#define XB_XLSUB(j) (3456 + 64 * (j))
#define XB_XLGEN(j) (4480 + 64 * (j))
template <class Mid> __device__ __forceinline__ void xcd_local_barrier(const XcdBarrier& b, const bool is_t0, const Mid& mid) {
    asm volatile("s_waitcnt vmcnt(0)" ::: "memory");
    __syncthreads();
    mid();
    if (is_t0) {
        unsigned* bar = b.bar;
        __builtin_amdgcn_s_waitcnt(0);
        const unsigned nloc = b.st[0];
        const unsigned old = xb_add(&bar[XB_XLSUB(b.x)], 1u);
        const unsigned gen = old / nloc;
        if (old + 1u == (gen + 1u) * nloc) xb_add(&bar[XB_XLGEN(b.x)], 1u);
        else XB_SPIN(xb_ld(&bar[XB_XLGEN(b.x)]) == gen, bar);
        __builtin_amdgcn_fence(__ATOMIC_ACQUIRE, "agent");
        asm volatile("s_waitcnt vmcnt(0)" ::: "memory");
    }
    __syncthreads();
}
typedef const float* cfptr_t; typedef float* fptr_t; typedef unsigned char* ucptr_t;
typedef __attribute__((address_space(4))) const unsigned char* kargp_t;
struct KA {
    kargp_t kp;
    __device__ __forceinline__ const float* in(int i) const { return *(__attribute__((address_space(4))) const cfptr_t*)(kp + 8 * i); }
    __device__ __forceinline__ float* out() const { return *(__attribute__((address_space(4))) const fptr_t*)(kp + 160); }
    __device__ __forceinline__ unsigned char* ws() const { return *(__attribute__((address_space(4))) const ucptr_t*)(kp + 168); }
    __device__ __forceinline__ int ph_lo() const { return *(__attribute__((address_space(4))) const int*)(kp + 176); }
    __device__ __forceinline__ int ph_hi() const { return *(__attribute__((address_space(4))) const int*)(kp + 180); }
};
static_assert(sizeof(Args) == 184, "Args layout");
#define FRESH_LANE() ({ int l_; asm volatile("v_mbcnt_lo_u32_b32 %0, -1, 0\n\tv_mbcnt_hi_u32_b32 %0, -1, %0" : "=v"(l_)); l_; })
constexpr bool prefb_phase(int Q) { return PREFETCH_B && PROBE_N == 0 && !USE_CG_SYNC && Q >= 1 && Q < NPHASE && ((((Q - 1) & 7) == 2) || (((Q - 1) & 7) == 4) || (((Q - 1) & 7) == 5) || (((Q - 1) & 7) == 6) || ((((Q - 1) & 7) == 0) && Q > 8)); }
template <int Q> __device__ __forceinline__ void prefetch_next_b(const KA& a, LAS unsigned char* lds, const int wave0) {
    if constexpr (prefb_phase(Q)) {
        if (wave0 == 0) return;
        constexpr int l = (Q - 1) >> 3, k = (Q - 1) & 7;
        constexpr size_t wo = k == 0 ? WO_F1IN : (k == 2 ? WO_QKV : (k == 4 ? WO_WO : (k == 5 ? WO_F2IN : WO_F2OUT)));
        constexpr int N = (k == 0 || k == 5) ? 2 * DFF : (k == 2 ? QKVW : D), K = k == 6 ? DFF : D;
        const int G = gridDim.x, bx = __builtin_amdgcn_readfirstlane((int)((volatile LAS unsigned*)(lds + LDS_BYTES - 64))[3]);
        const bf16_t* wl = (const bf16_t*)(a.ws() + WS_W) + (size_t)l * W_LAYER;
        pg8::StaticOrder S; S.init(M, N, G, bx); pg8::Unit u; if (!S.next(0, u)) return;
        pg8::prefetch_b(lds, wl + wo, K, u.pn, wave0 * 64 + FRESH_LANE());
    }
}
template <int PH>
__device__ __forceinline__ void run_phase(const KA& a, LAS unsigned char* lds, const int wave0, const int rep) {
    const int G = gridDim.x, wave = wave0;
    int bx = blockIdx.x;
    if constexpr (PH != 0) bx = __builtin_amdgcn_readfirstlane((int)((volatile LAS unsigned*)(lds + LDS_BYTES - 64))[3]);
    const int vcu = (G % 8 == 0) ? (bx % 8) * (G / 8) + bx / 8 : bx;
    const int gw = vcu * NWAVES + wave, NGW = G * NWAVES;
    unsigned char* ws = a.ws();
    bf16_t* xb = (bf16_t*)(ws + WS_XB); float* ssp0 = (float*)(ws + WS_SSP); float* ssp1 = ssp0 + (size_t)M * 16;
    bf16_t* xb2 = (bf16_t*)(ws + WS_W);
    bf16_t* act = (bf16_t*)(ws + WS_R + R_ACT); bf16_t* ob = XLO ? (bf16_t*)(ws + WS_R + R_O) : (bf16_t*)a.out();
    bf16_t* pb = (bf16_t*)(ws + WS_PB); bf16_t* proj = (bf16_t*)(ws + WS_PROJ);
    const float cscale = rep == 0 ? 1.0f : 0.0f;
    const bool bpre = prefb_phase(PH) && wave0 != 0 && a.ph_lo() < PH;
    if constexpr (PH == 0) {
        prologue_phase(a, lds, gw, NGW, wave, FRESH_LANE(), G == 256);
        convert_p(a.in(1), pb, bx * NWAVES * 64 + wave0 * 64 + FRESH_LANE(), G * NWAVES * 64);
        att::build_luts(a.in(2), (float*)(ws + WS_LUT), bx * NWAVES * 64 + wave0 * 64 + FRESH_LANE(), G * NWAVES * 64);
    } else {
        constexpr int l = (PH - 1) >> 3, k = (PH - 1) & 7;
        const bf16_t* wl = (const bf16_t*)(ws + WS_W) + (size_t)l * W_LAYER;
        bf16_t* lo_def = (bf16_t*)a.out(); bf16_t* lo_alt = xb2;
        const bf16_t* lin = (l == DEPTH - 1 && k == 7) ? lo_alt : lo_def; bf16_t* lout = (l == DEPTH - 1 && k == 6) ? lo_alt : lo_def;
        if constexpr (k == 0 || k == 5) {
            pg8::Gemm g{(k == 0 && l == 1) ? xb2 : xb, wl + (k == 0 ? WO_F1IN : WO_F2IN), M, 2 * DFF, D}; pg8::StaticOrder S; S.init(M, 2 * DFF, G, bx);
#if PROBE_NULL_EPI == 1
            if (rep > 0) { pg8::EpiNull E; pg8::gemm_phase<pg8::EpiNull, pg8::StaticOrder, true, true>(lds, g, S, E, wave0 * 64 + FRESH_LANE()); } else
#endif
            { pg8::EpiSwiglu E{act, ssp0, (PROBE_NULL_EPI >= 2 && rep > 0 && rep < PROBE_N) ? PROBE_NULL_EPI - 1 : 0};
            pg8::gemm_phase<pg8::EpiSwiglu, pg8::StaticOrder, true, true>(lds, g, S, E, wave0 * 64 + FRESH_LANE(), bpre); }
            if (G == 256 && bx >= 128 && rep == 0) {
                const int widx = (bx - 128) * NWAVES + wave, nw = 128 * NWAVES, lane = FRESH_LANE();
                if constexpr (k == 0) convert_weight_items(a, lds, l * I_LAYER + IT_FOUT1, IT_FIN2 - IT_FOUT1, widx, nw, wave, lane, l * I_LAYER + IT_WP, I_WP, l * I_LAYER + IT_FOUT2, I_FOUT);
                else { convert_weight_items(a, lds, l * I_LAYER + IT_WG, I_SQ, widx, nw, wave, lane, (l + 1) * I_LAYER + IT_FIN1, (l + 1 < DEPTH) ? I_FIN : 0);
                       if (l + 1 < DEPTH) {
                                            convert_p(a.in(1) + (size_t)(l + 1) * M * PLE, pb, widx * 64 + lane, nw * 64); } }
            }
        } else if constexpr (k == 1 || k == 6) {
            pg8::Gemm g{act, wl + (k == 1 ? WO_F1OUT : WO_F2OUT), M, D, DFF}; pg8::StaticOrder S; S.init(M, D, G, bx);
#if PROBE_NULL_EPI == 1
            if (rep > 0) { pg8::EpiNull E0; pg8::gemm_phase<pg8::EpiNull, pg8::StaticOrder, true, true>(lds, g, S, E0, wave0 * 64 + FRESH_LANE()); return; }
#endif
            pg8::EpiResid E{(k == 1 && l > 0 && rep == 0) ? xb2 : xb, lin, xb, lout, ssp1, 0.5f * cscale};
            pg8::gemm_phase<pg8::EpiResid, pg8::StaticOrder, true, true>(lds, g, S, E, wave0 * 64 + FRESH_LANE(), bpre);
        } else if constexpr (k == 2) {
            { pg8::Gemm g{xb, wl + WO_QKV, M, QKVW, D}; pg8::StaticOrder S; S.init(M, QKVW, G, bx);
              pg8::EpiQkv E; E.ssp = ssp1;
              E.qa = (bf16_t*)(ws + WS_R + R_QA); E.ka = (bf16_t*)(ws + WS_R + R_KA); E.va = (bf16_t*)(ws + WS_R + R_VA);
              E.qb = (bf16_t*)(ws + WS_R + R_QB); E.kb = (bf16_t*)(ws + WS_R + R_KB); E.vb = (bf16_t*)(ws + WS_R + R_VB);
              E.qna = a.in(8) + l * HD; E.kna = a.in(9) + l * HD; E.qnb = a.in(10) + l * HD; E.knb = a.in(11) + l * HD;
              pg8::gemm_phase<pg8::EpiQkv, pg8::StaticOrder, true, true>(lds, g, S, E, wave0 * 64 + FRESH_LANE(), bpre); }
            if (G != 256 || bx >= 64) {
              pg8::Gemm g{pb, wl + WO_WP, M, D, PLE}; pg8::StaticOrder S; if (G == 256) S.init(M, D, 192, bx - 64); else S.init(M, D, G, bx);
              pg8::EpiStoreBf16 E{proj, D};
              pg8::gemm_phase<pg8::EpiStoreBf16, pg8::StaticOrder, true, true>(lds, g, S, E, wave0 * 64 + FRESH_LANE()); }
            if (G == 256 && bx >= 128 && rep == 0)
                convert_weight_items(a, lds, l * I_LAYER + IT_FIN2, I_FIN, (bx - 128) * NWAVES + wave, 128 * NWAVES, wave, FRESH_LANE());
        } else if constexpr (k == 3) {
            att::Tensors T; T.qa = (bf16_t*)(ws + WS_R + R_QA); T.ka = (bf16_t*)(ws + WS_R + R_KA); T.va = (bf16_t*)(ws + WS_R + R_VA);
            T.qb = (bf16_t*)(ws + WS_R + R_QB); T.kb = (bf16_t*)(ws + WS_R + R_KB); T.vb = (bf16_t*)(ws + WS_R + R_VB);
            T.glut = (const float*)(ws + WS_LUT); T.sink = a.in(12) + l * 8; T.o = ob;
            const int lane = FRESH_LANE();
            for (int u = vcu; u < 256; u += G) att::attn_unit(T, u, lds, wave, lane, (PROBE_ATT_MODE && rep > 0) ? PROBE_ATT_MODE : 0x33);
        } else if constexpr (k == 4) {
            if (G != 256 && l + 1 < DEPTH) { convert_p(a.in(1) + (size_t)(l + 1) * M * PLE, pb, bx * NWAVES * 64 + wave0 * 64 + FRESH_LANE(), G * NWAVES * 64); asm volatile("s_waitcnt vmcnt(0)" ::: "memory"); }
            pg8::Gemm g{ob, wl + WO_WO, M, D, D}; pg8::StaticOrder S; S.init(M, D, G, bx);
            pg8::EpiResid E{xb, lin, xb, lout, ssp0, 1.0f * cscale};
            pg8::gemm_phase<pg8::EpiResid, pg8::StaticOrder, true, true>(lds, g, S, E, wave0 * 64 + FRESH_LANE(), bpre);
        } else {
            pg8::Gemm g{xb, wl + WO_WG, M, D, D}; pg8::StaticOrder S; S.init(M, D, G, bx);
            pg8::EpiGate E{xb, lin, xb2, lout, (l == DEPTH - 1) ? a.out() : nullptr, ssp0, ssp1, proj, cscale};
            pg8::gemm_phase<pg8::EpiGate, pg8::StaticOrder, true, true>(lds, g, S, E, wave0 * 64 + FRESH_LANE());
        }
    }
}

__global__ void __launch_bounds__(NWAVES * 64, 2) mk_fwd(Args) {
    extern __shared__ __attribute__((aligned(16))) unsigned char lds_raw[];
    LAS unsigned char* lds = (LAS unsigned char*)lds_raw;
    cg::grid_group grid = cg::this_grid();
    const int wave0 = __builtin_amdgcn_readfirstlane(threadIdx.x >> 6);
    volatile LAS unsigned* bst = (volatile LAS unsigned*)((LAS unsigned char*)lds_raw + LDS_BYTES - 64);
    if (threadIdx.x < 8) bst[threadIdx.x] = threadIdx.x == 3 ? blockIdx.x : 0u;
    __syncthreads();
    KA a; a.kp = (kargp_t)__builtin_amdgcn_kernarg_segment_ptr();
    const int ph_lo = a.ph_lo(), ph_hi = a.ph_hi();
    XcdBarrier xbar; xbar.bar = (unsigned*)(a.ws() + WS_CTL) + 4096; xbar.x = 0; xbar.st = bst;
    unsigned xrank = 0u;
    if (ph_hi - ph_lo > 1) xbar = xcd_barrier_post((unsigned*)(a.ws() + WS_CTL) + 4096, bst, xrank);
    if (ph_lo < 0) grid.sync();
#define MK_NREP(P) ((PROBE_N > 0 && (((P) == 0 && PROBE_K == 8) || ((P) > 0 && (((P) - 1) & 7) == PROBE_K))) ? 1 + PROBE_N : 1)
#define MK_LOCAL(P) (LOCAL_SEAMS && (P) > 0 && ((((P) - 1) & 7) == 4 || (((P) - 1) & 7) == 5 || ((((P) - 1) & 7) == 7 && (P) + 1 < NPHASE)))
#define MK_PHASE(P) if (ph_lo <= (P) && (P) < ph_hi) { _Pragma("unroll 1") for (int rep = 0; rep < MK_NREP(P); ++rep) { asm volatile("" : "+s"(a.kp)); run_phase<(P)>(a, lds, wave0, rep); \
        if ((P) == 0 && rep == 0 && threadIdx.x == 0) bst[4] = xrank; \
        if ((P) + 1 < ph_hi || rep + 1 < MK_NREP(P)) { if (USE_CG_SYNC && (P) == 0) grid.sync(); else { auto mid = [&]() { prefetch_next_b<(P) + 1>(a, lds, wave0); }; if (MK_LOCAL(P) && rep + 1 == MK_NREP(P) && bst[2] != 0u) xcd_local_barrier(xbar, wave0 == 0 && FRESH_LANE() == 0, mid); else xcd_barrier(xbar, wave0 == 0 && FRESH_LANE() == 0, mid); } } } }
    MK_PHASE(0) MK_PHASE(1) MK_PHASE(2) MK_PHASE(3) MK_PHASE(4) MK_PHASE(5) MK_PHASE(6) MK_PHASE(7) MK_PHASE(8)
    MK_PHASE(9) MK_PHASE(10) MK_PHASE(11) MK_PHASE(12) MK_PHASE(13) MK_PHASE(14) MK_PHASE(15) MK_PHASE(16)
    static_assert(NPHASE == 17, "phase program");
}

constexpr size_t CTL_BYTES = 64 * 1024;
static_assert((4096 + 4480 + 64 * 16) * 4 <= CTL_BYTES, "barrier words inside the per-call memset");
extern "C" void kernel_launch(void* const* d_in, const int* in_sizes, int n_in, void* d_out, int out_size, void* d_ws, size_t ws_size, hipStream_t stream) {
    static int grid = 0;
    if (grid == 0) {
        if (n_in != 20 || in_sizes[0] != M * D || out_size != M * D || ws_size < WS_END) { fprintf(stderr, "kernel_launch: unexpected shapes (n_in %d, ws %zu)\n", n_in, ws_size); grid = -1; return; }
        int dev = 0, cus = 0, per_cu = 0;
        if (hipGetDevice(&dev) != hipSuccess || hipDeviceGetAttribute(&cus, hipDeviceAttributeMultiprocessorCount, dev) != hipSuccess) { grid = -1; return; }
        if (hipFuncSetAttribute((const void*)mk_fwd, hipFuncAttributeMaxDynamicSharedMemorySize, LDS_BYTES) != hipSuccess) { fprintf(stderr, "kernel_launch: hipFuncSetAttribute failed\n"); grid = -1; return; }
        if (hipOccupancyMaxActiveBlocksPerMultiprocessor(&per_cu, (const void*)mk_fwd, NWAVES * 64, LDS_BYTES) != hipSuccess || per_cu < 1) { fprintf(stderr, "kernel_launch: occupancy query says %d\n", per_cu); grid = -1; (void)hipGetLastError(); return; }
        grid = cus;
    }
    if (grid < 0) return;
    (void)hipMemsetAsync((char*)d_ws + WS_CTL, 0, CTL_BYTES, stream);
    Args a{};
    for (int i = 0; i < 20; ++i) a.in[i] = (const float*)d_in[i];
    a.out = (float*)d_out; a.ws = (unsigned char*)d_ws;
    a.ph_lo = 0; a.ph_hi = NPHASE;
    void* args[] = {&a};
    hipError_t e = hipLaunchCooperativeKernel((const void*)mk_fwd, dim3(grid), dim3(NWAVES * 64), args, LDS_BYTES, stream);
    if (e != hipSuccess) fprintf(stderr, "kernel_launch: cooperative launch failed: %s (grid %d)\n", hipGetErrorString(e), grid);
}
```

```cpp
#include <hip/hip_runtime.h>
#include <cstdio>
#include <cstdint>
#ifndef PROBE_N
#define PROBE_N 0
#define PROBE_K -1
#endif
#ifndef ATT_ORDER
#define ATT_ORDER 0
#endif
#ifndef PROBE_ATT_MODE
#define PROBE_ATT_MODE 0
#endif
#ifndef USE_CG_SYNC
#define USE_CG_SYNC 0
#endif
#ifndef PROBE_NULL_EPI
#define PROBE_NULL_EPI 0
#endif
#ifndef D16_MODE
#define D16_MODE 1
#endif
#ifndef XLO
#define XLO 0
#define LOCAL_SEAMS 1
#endif

typedef unsigned short bf16_t;
constexpr int NB = 4, S = 4096, D = 1024, M = NB * S, DFF = 2816, QKVW = 2304, PLE = 256, DEPTH = 2, HD = 64;
constexpr float EPS = 1e-6f;
constexpr float QSCALE = 0.125f * 1.4426950408889634f;
constexpr float LOG2E = 1.4426950408889634f;

constexpr size_t MiB = 1u << 20;
constexpr size_t WS_CTL = 0, WS_W = 1 * MiB, WS_XB = 85 * MiB, WS_R = 117 * MiB, WS_PB = 221 * MiB, WS_PROJ = 229 * MiB, WS_SSP = 261 * MiB, WS_END = 263 * MiB + 512 * 1024;
constexpr size_t WS_LUT = 263 * MiB;
constexpr size_t R_QA = 0, R_KA = 16 * MiB, R_VA = 32 * MiB, R_QB = 48 * MiB, R_KB = 64 * MiB, R_VB = 68 * MiB, R_O = 72 * MiB, R_ACT = 0;

__device__ __forceinline__ float bf2f(bf16_t v) { return __uint_as_float(((unsigned)v) << 16); }
__device__ __forceinline__ bf16_t f2bf(float f) { unsigned u = __float_as_uint(f); return (bf16_t)((u + 0x7fffu + ((u >> 16) & 1u)) >> 16); }

namespace pg8 {
#define PG8_LAS __attribute__((address_space(3)))
typedef unsigned short bf16_t;
typedef short bf16x8 __attribute__((ext_vector_type(8)));
typedef float f32x4 __attribute__((ext_vector_type(4)));
typedef unsigned u32x4 __attribute__((ext_vector_type(4)));
constexpr int BM = 256, BK = 64, HALF = 128, HTB = HALF * BK * 2  , STAGE_BYTES = 8 * HTB, NXCD = 8, WGM = 8;

__host__ __device__ __forceinline__ int lds_byte(int r, int c) { const int st = (r >> 4) * 2 + (c >> 5), rr = r & 15, cc = c & 31, ob = rr * 64 + cc * 2; return st * 1024 + (ob ^ (((ob >> 9) & 1) << 5)); }
__host__ __device__ __forceinline__ void stage_rc(int b, int& R, int& C) { const int st = b / 1024, sb = b % 1024, swz = sb ^ (((sb >> 9) & 1) << 5); R = (st >> 1) * 16 + swz / 64; C = (st & 1) * 32 + (swz % 64) / 2; }
__host__ __device__ __forceinline__ int perm32(int rho) { const int n = rho >> 4, i = rho & 15; return 8 * (i >> 2) + 4 * n + (i & 3); }

struct Unit { int pm, pn; };
struct Gemm { const bf16_t* A; const bf16_t* Bt; int M, N, K; };

struct StaticOrder {
    int nM, nN, nwg, G, c;
    __host__ __device__ void init(int M, int N, int G_, int c_) { nM = M / BM; nN = N / BM; nwg = nM * nN; G = G_; c = c_; }
    __host__ __device__ bool next(int i, Unit& u) const {
        const long L = (long)i * G + c; if (L >= nwg) return false;
        int wgid = (int)L; { const int q = nwg / NXCD, r = nwg % NXCD, xcd = wgid % NXCD, off = wgid / NXCD; wgid = (xcd < r ? xcd * (q + 1) : r * (q + 1) + (xcd - r) * q) + off; }
        const int nig = WGM * nN, gid = wgid / nig, fm = gid * WGM, gsz = (nM - fm) < WGM ? (nM - fm) : WGM;
        u.pm = fm + ((wgid % nig) % gsz); u.pn = (wgid % nig) / gsz; return true;
    }
    __device__ __forceinline__ void a_ready(const Unit&) const {}
    __device__ __forceinline__ void done(const Unit&) const {}
};

__device__ __forceinline__ unsigned cvt_pk_bf16(float lo, float hi) { unsigned r; asm volatile("v_cvt_pk_bf16_f32 %0, %1, %2" : "=v"(r) : "v"(lo), "v"(hi)); return r; }
typedef float f32x2 __attribute__((ext_vector_type(2)));
template <class Epi, class Sched, bool ALIGN_EPI = false, bool SP2 = false>
__device__ __forceinline__ void gemm_phase(PG8_LAS unsigned char* lds, const Gemm g, const Sched& S, const Epi& E, const int tid) {
    const int wid = __builtin_amdgcn_readfirstlane(tid >> 6), lane = tid & 63, wr = wid >> 2, wc = wid & 3, fr = lane & 15, fq = lane >> 4;
    const int K = g.K, nt = K / BK;
    unsigned voffA[2], voffB[2];
#pragma unroll
    for (int i = 0; i < 2; ++i) { int R, C; stage_rc(tid * 16 + i * 8192, R, C); const int Rb = Epi::PERM ? ((R & ~31) + perm32(R & 31)) : R;
        voffA[i] = (unsigned)(R * K + C) * 2u; voffB[i] = (unsigned)(Rb * K + C) * 2u; }
    const size_t kstep = (size_t)(BK * 2);
    const size_t hstep = (size_t)HALF * K * 2;
    const size_t tstep = 2 * hstep;
    const unsigned ldsw = (unsigned)wid * 1024u;
    const int aoff = lds_byte(wr * 64 + fr, fq * 8), boff = lds_byte(wc * 32 + fr, fq * 8);
#define PG8_SA(b, h) (((b) * 2 + (h)) * HTB)
#define PG8_SB(b, h) ((4 + (b) * 2 + (h)) * HTB)
#define PG8_STAGE(bufoff, gbase, voff) do { _Pragma("unroll") for (int _i = 0; _i < 2; ++_i) \
        __builtin_amdgcn_global_load_lds((const unsigned*)((const char*)(gbase) + (voff)[_i]), (PG8_LAS unsigned*)(lds + (bufoff) + ldsw + _i * 8192), 16, 0, 0); } while (0)
#define PG8_LDA(dst, b, h) do { _Pragma("unroll") for (int m = 0; m < 4; ++m) _Pragma("unroll") for (int k = 0; k < 2; ++k) dst[m][k] = *(const PG8_LAS bf16x8*)(lds + PG8_SA(b, h) + aoff + m * 2048 + k * 1024); } while (0)
#define PG8_LDB(dst, b, h) do { _Pragma("unroll") for (int n = 0; n < 2; ++n) _Pragma("unroll") for (int k = 0; k < 2; ++k) dst[n][k] = *(const PG8_LAS bf16x8*)(lds + PG8_SB(b, h) + boff + n * 2048 + k * 1024); } while (0)
#define PG8_MMA(ai, bj, At, Bt) do { __builtin_amdgcn_s_setprio(1); _Pragma("unroll") for (int m = 0; m < 4; ++m) _Pragma("unroll") for (int n = 0; n < 2; ++n) _Pragma("unroll") for (int k = 0; k < 2; ++k) \
        acc[ai][bj][m][n] = __builtin_amdgcn_mfma_f32_16x16x32_bf16(Bt[n][k], At[m][k], acc[ai][bj][m][n], 0, 0, 0); __builtin_amdgcn_s_setprio(0); } while (0)
#define PG8_WAIT_V(n) asm volatile("s_waitcnt vmcnt(" #n ")" ::: "memory")
#define PG8_WAIT_L(n) asm volatile("s_waitcnt lgkmcnt(" #n ")" ::: "memory")
#define PG8_BAR __builtin_amdgcn_s_barrier()
#define PG8_SCHED __builtin_amdgcn_sched_barrier(0)
    Unit cur, nxt; int ui = 0;
    if (!S.next(0, cur)) return;
    f32x4 acc[2][2][4][2];
#pragma unroll
    for (int a = 0; a < 2; ++a)
#pragma unroll
        for (int b = 0; b < 2; ++b)
#pragma unroll
            for (int m = 0; m < 4; ++m)
#pragma unroll
                for (int n = 0; n < 2; ++n) acc[a][b][m][n] = (f32x4){0.f, 0.f, 0.f, 0.f};
    bf16x8 At[4][2], B0[2][2], B1[2][2];
    const char* cA = (const char*)g.A + (size_t)cur.pm * tstep; const char* cB = (const char*)g.Bt + (size_t)cur.pn * tstep;
    S.a_ready(cur);
    if constexpr (SP2) {
        PG8_STAGE(PG8_SB(0, 0), cB, voffB); PG8_STAGE(PG8_SB(0, 1), cB + hstep, voffB); PG8_STAGE(PG8_SA(0, 0), cA, voffA); PG8_STAGE(PG8_SA(0, 1), cA + hstep, voffA);
        if constexpr (Epi::HAS_PRE) E.pre(cur, tid, lds);
        if (wr == 1) PG8_BAR;
        PG8_WAIT_V(2); PG8_BAR;
        PG8_STAGE(PG8_SB(1, 0), cB + kstep, voffB); PG8_STAGE(PG8_SA(1, 0), cA + kstep, voffA); PG8_STAGE(PG8_SB(1, 1), cB + hstep + kstep, voffB);
        PG8_WAIT_V(6); PG8_BAR;
    } else {
        PG8_STAGE(PG8_SB(0, 0), cB, voffB); PG8_STAGE(PG8_SA(0, 0), cA, voffA); PG8_STAGE(PG8_SB(0, 1), cB + hstep, voffB); PG8_STAGE(PG8_SA(0, 1), cA + hstep, voffA);
        if (wr == 1) PG8_BAR;
        PG8_WAIT_V(4); PG8_BAR;
        PG8_STAGE(PG8_SB(1, 0), cB + kstep, voffB); PG8_STAGE(PG8_SA(1, 0), cA + kstep, voffA); PG8_STAGE(PG8_SB(1, 1), cB + hstep + kstep, voffB);
        PG8_WAIT_V(6); PG8_BAR;
    }
    for (;;) {
        const bool has_next = S.next(ui + 1, nxt);
        const char* nA = has_next ? (const char*)g.A + (size_t)nxt.pm * tstep : cA; const char* nB = has_next ? (const char*)g.Bt + (size_t)nxt.pn * tstep : cB;
        for (int t = 0; t < nt; t += 2) {
            const bool last = (t == nt - 2);
            const char* a1 = cA + (size_t)(t + 1) * kstep;
            const char* a2 = last ? nA : cA + (size_t)(t + 2) * kstep; const char* b2 = last ? nB : cB + (size_t)(t + 2) * kstep;
            const char* a3 = a2 + kstep; const char* b3 = b2 + kstep;
            if (last && has_next) S.a_ready(nxt);
            if constexpr (SP2) {
            PG8_LDB(B0, 0, 0); PG8_LDB(B1, 0, 1); PG8_SCHED; PG8_LDA(At, 0, 0); PG8_STAGE(PG8_SA(1, 1), a1 + hstep, voffA);
            PG8_WAIT_V(8); PG8_WAIT_L(0); PG8_BAR; PG8_MMA(0, 0, At, B0); PG8_MMA(0, 1, At, B1); PG8_BAR; PG8_SCHED;
            PG8_LDA(At, 0, 1); PG8_STAGE(PG8_SB(0, 0), b2, voffB); PG8_STAGE(PG8_SB(0, 1), b2 + hstep, voffB); PG8_STAGE(PG8_SA(0, 0), a2, voffA);
            PG8_WAIT_V(8); PG8_WAIT_L(0); PG8_BAR; PG8_MMA(1, 0, At, B0); PG8_MMA(1, 1, At, B1); PG8_BAR; PG8_SCHED;
            PG8_LDB(B0, 1, 0); PG8_LDB(B1, 1, 1); PG8_SCHED; PG8_LDA(At, 1, 0); PG8_STAGE(PG8_SA(0, 1), a2 + hstep, voffA);
            PG8_WAIT_V(8); PG8_WAIT_L(0); PG8_BAR; PG8_MMA(0, 0, At, B0); PG8_MMA(0, 1, At, B1); PG8_BAR; PG8_SCHED;
            PG8_LDA(At, 1, 1); PG8_STAGE(PG8_SB(1, 0), b3, voffB); PG8_STAGE(PG8_SB(1, 1), b3 + hstep, voffB); PG8_STAGE(PG8_SA(1, 0), a3, voffA);
            PG8_WAIT_V(8); PG8_WAIT_L(0); PG8_BAR; PG8_MMA(1, 0, At, B0); PG8_MMA(1, 1, At, B1); PG8_BAR; PG8_SCHED;
            } else {
            PG8_LDB(B0, 0, 0); PG8_SCHED; PG8_LDA(At, 0, 0); PG8_STAGE(PG8_SA(1, 1), a1 + hstep, voffA);
            PG8_WAIT_L(8); PG8_BAR; PG8_WAIT_L(0); PG8_MMA(0, 0, At, B0); PG8_BAR; PG8_SCHED;
            PG8_LDB(B1, 0, 1); PG8_STAGE(PG8_SB(0, 0), b2, voffB);
            PG8_BAR; PG8_WAIT_L(0); PG8_MMA(0, 1, At, B1); PG8_BAR;
            PG8_LDA(At, 0, 1); PG8_STAGE(PG8_SA(0, 0), a2, voffA);
            PG8_BAR; PG8_WAIT_L(0); PG8_MMA(1, 0, At, B0); PG8_BAR; PG8_SCHED;
            PG8_STAGE(PG8_SB(0, 1), b2 + hstep, voffB);
            PG8_WAIT_V(6); PG8_BAR; PG8_MMA(1, 1, At, B1); PG8_BAR;
            PG8_LDB(B0, 1, 0); PG8_SCHED; PG8_LDA(At, 1, 0); PG8_STAGE(PG8_SA(0, 1), a2 + hstep, voffA);
            PG8_WAIT_L(8); PG8_BAR; PG8_WAIT_L(0); PG8_MMA(0, 0, At, B0); PG8_BAR; PG8_SCHED;
            PG8_LDB(B1, 1, 1); PG8_STAGE(PG8_SB(1, 0), b3, voffB);
            PG8_BAR; PG8_WAIT_L(0); PG8_MMA(0, 1, At, B1); PG8_BAR;
            PG8_LDA(At, 1, 1); PG8_STAGE(PG8_SA(1, 0), a3, voffA);
            PG8_BAR; PG8_WAIT_L(0); PG8_MMA(1, 0, At, B0); PG8_BAR; PG8_SCHED;
            PG8_STAGE(PG8_SB(1, 1), b3 + hstep, voffB);
            PG8_WAIT_V(6); PG8_BAR; PG8_MMA(1, 1, At, B1); PG8_BAR;
            }
        }
        if constexpr (ALIGN_EPI) { if (wr == 0) PG8_BAR; }
        if constexpr (!Epi::AFTER_DRAIN) { int l2_; asm volatile("v_mbcnt_lo_u32_b32 %0, -1, 0\n\tv_mbcnt_hi_u32_b32 %0, -1, %0" : "=v"(l2_)); if constexpr (Epi::HAS_PRE) E(acc, cur, wr, wc, l2_ & 15, l2_ >> 4, lds); else E(acc, cur, wr, wc, l2_ & 15, l2_ >> 4); S.done(cur); }
        if (!has_next) break;
#pragma unroll
        for (int a = 0; a < 2; ++a)
#pragma unroll
            for (int b = 0; b < 2; ++b)
#pragma unroll
                for (int m = 0; m < 4; ++m)
#pragma unroll
                    for (int n = 0; n < 2; ++n) acc[a][b][m][n] = (f32x4){0.f, 0.f, 0.f, 0.f};
        cur = nxt; cA = nA; cB = nB; ++ui;
        if constexpr (ALIGN_EPI) { if (wr == 1) PG8_BAR; }
    }
    PG8_WAIT_V(0);
    if constexpr (!ALIGN_EPI) { if (wr == 0) PG8_BAR; }
    PG8_BAR;
    if constexpr (Epi::AFTER_DRAIN) { E.fused(acc, cur, wr, wc, fr, fq, lds, wid, lane); S.done(cur); }
#undef PG8_SA
#undef PG8_SB
#undef PG8_STAGE
#undef PG8_LDA
#undef PG8_LDB
#undef PG8_MMA
#undef PG8_WAIT_V
#undef PG8_WAIT_L
#undef PG8_BAR
#undef PG8_SCHED
}
}

namespace pg8 {
typedef float f32x2 __attribute__((ext_vector_type(2)));
__device__ __forceinline__ float shx(float v, int lane, int mask) { return __int_as_float(__builtin_amdgcn_ds_bpermute((lane ^ mask) << 2, __float_as_int(v))); }
__device__ __forceinline__ float rstd16(const float* ssp, int row, int fq, int lane) {
    const f32x4 v = *(const f32x4*)(ssp + (size_t)row * 16 + 4 * fq);
    float s = (v[0] + v[1]) + (v[2] + v[3]);
    s += shx(s, lane, 16); s += shx(s, lane, 32);
    return __builtin_amdgcn_rsqf(s * (1.0f / 1024.0f) + 1e-6f);
}
__device__ __forceinline__ f32x4 rstd_ld(const float* ssp, int row, int fq) { return *(const f32x4*)(ssp + (size_t)row * 16 + 4 * fq); }
__device__ __forceinline__ float rstd_fin(const f32x4& v, int lane) { float s = (v[0] + v[1]) + (v[2] + v[3]); s += shx(s, lane, 16); s += shx(s, lane, 32); return __builtin_amdgcn_rsqf(s * (1.0f / 1024.0f) + 1e-6f); }
__device__ __forceinline__ float sigm(float v) { return __builtin_amdgcn_rcpf(1.0f + __builtin_amdgcn_exp2f(-1.4426950408889634f * v)); }
__device__ __forceinline__ u32x4 pack8(const f32x4& a, const f32x4& b) { u32x4 w; w.x = cvt_pk_bf16(a[0], a[1]); w.y = cvt_pk_bf16(a[2], a[3]); w.z = cvt_pk_bf16(b[0], b[1]); w.w = cvt_pk_bf16(b[2], b[3]); return w; }
__device__ __forceinline__ float bflo(unsigned w) { return __uint_as_float(w << 16); }
__device__ __forceinline__ float bfhi(unsigned w) { return __uint_as_float(w & 0xffff0000u); }

constexpr int EPI_TAB = 131072 + 4096;
__device__ __forceinline__ void rstd_table(const float* ssp, int pm, PG8_LAS float* rst, int tid) {
    const int r = tid >> 1, hf = tid & 1;
    const float* p = ssp + (size_t)(pm * BM + r) * 16 + hf * 8;
    const f32x4 a = *(const f32x4*)p, b = *(const f32x4*)(p + 4);
    float s = ((a[0] + a[1]) + (a[2] + a[3])) + ((b[0] + b[1]) + (b[2] + b[3]));
    s += shx(s, tid & 63, 1);
    if (hf == 0) rst[r] = __builtin_amdgcn_rsqf(s * (1.0f / 1024.0f) + 1e-6f);
    if (tid == 0) ((PG8_LAS int*)rst)[512] = pm;
    asm volatile("s_waitcnt lgkmcnt(0)" ::: "memory");
}
__device__ __forceinline__ int rstd_table_pm(PG8_LAS float* rst) { int v; const unsigned a = (unsigned)(uintptr_t)rst; asm volatile("ds_read_b32 %0, %1 offset:2048\n\ts_waitcnt lgkmcnt(0)" : "=v"(v) : "v"(a) : "memory"); return __builtin_amdgcn_readfirstlane(v); }
__device__ __forceinline__ void rstd_table_rd(PG8_LAS float* rst, int wr, int fr, float (&rsv)[8]) {
    const unsigned ra = (unsigned)(uintptr_t)rst + 4u * (unsigned)(wr * 64 + fr);
    asm volatile("ds_read_b32 %0, %1" : "=v"(rsv[0]) : "v"(ra) : "memory");            asm volatile("ds_read_b32 %0, %1 offset:64" : "=v"(rsv[1]) : "v"(ra) : "memory");
    asm volatile("ds_read_b32 %0, %1 offset:128" : "=v"(rsv[2]) : "v"(ra) : "memory"); asm volatile("ds_read_b32 %0, %1 offset:192" : "=v"(rsv[3]) : "v"(ra) : "memory");
    asm volatile("ds_read_b32 %0, %1 offset:512" : "=v"(rsv[4]) : "v"(ra) : "memory"); asm volatile("ds_read_b32 %0, %1 offset:576" : "=v"(rsv[5]) : "v"(ra) : "memory");
    asm volatile("ds_read_b32 %0, %1 offset:640" : "=v"(rsv[6]) : "v"(ra) : "memory"); asm volatile("ds_read_b32 %0, %1 offset:704" : "=v"(rsv[7]) : "v"(ra) : "memory");
}
struct EpiSwiglu {
    static constexpr bool PERM = true, AFTER_DRAIN = false, HAS_PRE = true;
    bf16_t* act; const float* ssp; int mode;
    __device__ __forceinline__ void pre(const Unit& u, int tid, PG8_LAS unsigned char* lds) const { rstd_table(ssp, u.pm, (PG8_LAS float*)(lds + EPI_TAB), tid); }
    __device__ __forceinline__ void operator()(const f32x4 (&acc)[2][2][4][2], const Unit& u, int wr, int wc, int fr, int fq, PG8_LAS unsigned char* lds) const {
        PG8_LAS float* rst = (PG8_LAS float*)(lds + EPI_TAB); const int pre_pm = rstd_table_pm(rst);
        const int lane = fr + 16 * fq;
        const int row0 = u.pm * BM + wr * 64 + fr, col0 = u.pn * 128 + wc * 32 + 8 * fq;
        float rsv[8];
        if (u.pm == pre_pm) {
          rstd_table_rd(rst, wr, fr, rsv);
          asm volatile("s_waitcnt lgkmcnt(0)" : "+v"(rsv[0]), "+v"(rsv[1]), "+v"(rsv[2]), "+v"(rsv[3]), "+v"(rsv[4]), "+v"(rsv[5]), "+v"(rsv[6]), "+v"(rsv[7]) :: "memory");
        } else
        { f32x4 t8[8];
#pragma unroll
          for (int g = 0; g < 8; ++g) t8[g] = rstd_ld(ssp, row0 + (g >> 2) * HALF + (g & 3) * 16, fq);
#pragma unroll
          for (int g = 0; g < 8; ++g) rsv[g] = rstd_fin(t8[g], lane); }
        asm volatile("" ::: "memory");
#pragma unroll
        for (int ai = 0; ai < 2; ++ai)
#pragma unroll
            for (int m = 0; m < 4; ++m) { const int row = row0 + ai * HALF + m * 16; const float rs = rsv[ai * 4 + m];
                f32x4 o[2];
                const f32x2 c1 = {-1.4426950408889634f * rs, -1.4426950408889634f * rs}, rs2 = {rs * rs, rs * rs}, one = {1.0f, 1.0f};
#pragma unroll
                for (int n = 0; n < 2; ++n)
#pragma unroll
                    for (int j = 0; j < 4; j += 2) { const f32x2 g = {acc[ai][0][m][n][j], acc[ai][0][m][n][j + 1]}, up = {acc[ai][1][m][n][j], acc[ai][1][m][n][j + 1]};
                        f32x2 e = c1 * g; e.x = __builtin_amdgcn_exp2f(e.x); e.y = __builtin_amdgcn_exp2f(e.y);
                        f32x2 d = one + e; d.x = __builtin_amdgcn_rcpf(d.x); d.y = __builtin_amdgcn_rcpf(d.y);
                        const f32x2 r = (PROBE_NULL_EPI && mode == 2) ? g + up : (g * up) * (rs2 * d);
                        o[n][j] = r.x; o[n][j + 1] = r.y; }
                const u32x4 w = pack8(o[0], o[1]);
                if (PROBE_NULL_EPI && mode == 1) asm volatile("" :: "v"(w)); else *(u32x4*)(act + (size_t)row * 2816 + col0) = w; }
    }
};
__device__ __forceinline__ void unpack8(const u32x4& w, f32x4& a, f32x4& b) { a = (f32x4){bflo(w.x), bfhi(w.x), bflo(w.y), bfhi(w.y)}; b = (f32x4){bflo(w.z), bfhi(w.z), bflo(w.w), bfhi(w.w)}; }
__device__ __forceinline__ void split8(const f32x4& x0, const f32x4& x1, u32x4& hi, u32x4& lo) {
    hi = pack8(x0, x1); f32x4 h0, h1; unpack8(hi, h0, h1); lo = pack8(x0 - h0, x1 - h1);
}
struct EpiResid {
    static constexpr bool PERM = true, AFTER_DRAIN = false, HAS_PRE = false;
    const bf16_t* hin; const bf16_t* lin; bf16_t* hout; bf16_t* lout; float* sspw; float coef;
    __device__ __forceinline__ void operator()(const f32x4 (&acc)[2][2][4][2], const Unit& u, int wr, int wc, int fr, int fq) const {
        const int lane = fr + 16 * fq;
        float cf = __uint_as_float(__builtin_amdgcn_readfirstlane(__float_as_uint(coef))); asm volatile("" : "+s"(cf));
        const int row0 = u.pm * BM + wr * 64 + fr, col0 = u.pn * BM + wc * 32 + 8 * fq;
        u32x4 xh[3][2], xl[3][2];
#define RES_LOAD(g, sl) do { _Pragma("unroll") for (int bj = 0; bj < 2; ++bj) { const size_t off_ = (size_t)(row0 + ((g) >> 2) * HALF + ((g) & 3) * 16) * 1024 + col0 + bj * HALF; \
            xh[sl][bj] = *(const u32x4*)(hin + off_); if (XLO) xl[sl][bj] = *(const u32x4*)(lin + off_); else xl[sl][bj] = (u32x4){0u, 0u, 0u, 0u}; } } while (0)
        RES_LOAD(0, 0); RES_LOAD(1, 1);
#pragma unroll
        for (int g = 0; g < 8; ++g) { const int ai = g >> 2, m = g & 3, sl = g % 3, row = row0 + ai * HALF + m * 16; float ss = 0.f;
            if (g + 2 < 8) RES_LOAD(g + 2, (g + 2) % 3);
            asm volatile("" ::: "memory");
#pragma unroll
            for (int bj = 0; bj < 2; ++bj) { const size_t off = (size_t)row * 1024 + col0 + bj * HALF;
                f32x4 h0, h1, l0, l1; unpack8(xh[sl][bj], h0, h1); unpack8(xl[sl][bj], l0, l1);
                const f32x4 x0 = (h0 + l0) + acc[ai][bj][m][0] * cf, x1 = (h1 + l1) + acc[ai][bj][m][1] * cf;
                u32x4 nh, nl; split8(x0, x1, nh, nl);
                *(u32x4*)(hout + off) = nh; if (XLO) *(u32x4*)(lout + off) = nl;
                ss += (x0[0] * x0[0] + x0[1] * x0[1]) + (x0[2] * x0[2] + x0[3] * x0[3]) + (x1[0] * x1[0] + x1[1] * x1[1]) + (x1[2] * x1[2] + x1[3] * x1[3]); }
            ss += shx(ss, lane, 16); ss += shx(ss, lane, 32);
            if (fq == 0) sspw[(size_t)row * 16 + u.pn * 4 + wc] = ss;
            asm volatile("" ::: "memory"); }
#undef RES_LOAD
    }
};
struct EpiGate {
    static constexpr bool PERM = true, AFTER_DRAIN = false, HAS_PRE = false;
    const bf16_t* hin; const bf16_t* lin; bf16_t* hout; bf16_t* lout; float* fout; float* sspw; const float* sspr; const bf16_t* proj; float coef;
    __device__ __forceinline__ void operator()(const f32x4 (&acc)[2][2][4][2], const Unit& u, int wr, int wc, int fr, int fq) const {
        const int lane = fr + 16 * fq;
        float cf = __uint_as_float(__builtin_amdgcn_readfirstlane(__float_as_uint(coef))); asm volatile("" : "+s"(cf));
        const int row0 = u.pm * BM + wr * 64 + fr, col0 = u.pn * BM + wc * 32 + 8 * fq;
        u32x4 xh[2][2], xl[2][2], pw[2][2]; f32x4 rsn[2];
#define GATE_LOAD(g, sl) do { _Pragma("unroll") for (int bj = 0; bj < 2; ++bj) { const size_t off_ = (size_t)(row0 + ((g) >> 2) * HALF + ((g) & 3) * 16) * 1024 + col0 + bj * HALF; \
            xh[sl][bj] = *(const u32x4*)(hin + off_); if (XLO) xl[sl][bj] = *(const u32x4*)(lin + off_); else xl[sl][bj] = (u32x4){0u, 0u, 0u, 0u}; pw[sl][bj] = *(const u32x4*)(proj + off_); } \
            rsn[sl] = rstd_ld(sspr, row0 + ((g) >> 2) * HALF + ((g) & 3) * 16, fq); } while (0)
        GATE_LOAD(0, 0);
#pragma unroll
        for (int g = 0; g < 8; ++g) { const int ai = g >> 2, m = g & 3, sl = g & 1, row = row0 + ai * HALF + m * 16; float ss = 0.f;
            if (g + 1 < 8) GATE_LOAD(g + 1, (g + 1) & 1);
            asm volatile("" ::: "memory");
            const float rsg = rstd_fin(rsn[sl], lane);
#pragma unroll
            for (int bj = 0; bj < 2; ++bj) { const size_t off = (size_t)row * 1024 + col0 + bj * HALF;
                f32x4 h0, h1, l0, l1, p0, p1; unpack8(xh[sl][bj], h0, h1); unpack8(xl[sl][bj], l0, l1); unpack8(pw[sl][bj], p0, p1);
                f32x4 x0 = h0 + l0, x1 = h1 + l1;
#pragma unroll
                for (int j = 0; j < 4; ++j) { x0[j] += cf * (sigm(acc[ai][bj][m][0][j] * rsg) * p0[j]); x1[j] += cf * (sigm(acc[ai][bj][m][1][j] * rsg) * p1[j]); }
                if (fout) { *(f32x4*)(fout + off) = x0; *(f32x4*)(fout + off + 4) = x1; }
                else { u32x4 nh, nl; split8(x0, x1, nh, nl); *(u32x4*)(hout + off) = nh; if (XLO) *(u32x4*)(lout + off) = nl;
                    ss += (x0[0] * x0[0] + x0[1] * x0[1]) + (x0[2] * x0[2] + x0[3] * x0[3]) + (x1[0] * x1[0] + x1[1] * x1[1]) + (x1[2] * x1[2] + x1[3] * x1[3]); } }
            if (!fout) { ss += shx(ss, lane, 16); ss += shx(ss, lane, 32);
                if (fq == 0) sspw[(size_t)row * 16 + u.pn * 4 + wc] = ss; }
            asm volatile("" ::: "memory"); }
#undef GATE_LOAD
    }
};
struct EpiStoreBf16 {
    static constexpr bool PERM = true, AFTER_DRAIN = false, HAS_PRE = false;
    bf16_t* O; int ldc;
    __device__ __forceinline__ void operator()(const f32x4 (&acc)[2][2][4][2], const Unit& u, int wr, int wc, int fr, int fq) const {
        const int lane = fr + 16 * fq;
        const int row0 = u.pm * BM + wr * 64 + fr, col0 = u.pn * BM + wc * 32 + 8 * fq;
#pragma unroll
        for (int ai = 0; ai < 2; ++ai)
#pragma unroll
            for (int m = 0; m < 4; ++m) { const int row = row0 + ai * HALF + m * 16;
#pragma unroll
                for (int bj = 0; bj < 2; ++bj) *(u32x4*)(O + (size_t)row * ldc + col0 + bj * HALF) = pack8(acc[ai][bj][m][0], acc[ai][bj][m][1]); }
    }
};
struct EpiNull {
    static constexpr bool PERM = true, AFTER_DRAIN = false, HAS_PRE = false;
    __device__ __forceinline__ void operator()(const f32x4 (&acc)[2][2][4][2], const Unit& u, int wr, int wc, int fr, int fq) const {
#pragma unroll
        for (int ai = 0; ai < 2; ++ai)
#pragma unroll
            for (int bj = 0; bj < 2; ++bj)
#pragma unroll
                for (int m = 0; m < 4; ++m)
#pragma unroll
                    for (int n = 0; n < 2; ++n) asm volatile("" :: "v"(acc[ai][bj][m][n]));
    }
};
struct EpiQkv {
    static constexpr bool PERM = true, AFTER_DRAIN = false, HAS_PRE = true;
    const float* ssp; bf16_t *qa, *ka, *va, *qb, *kb, *vb; const float *qna, *kna, *qnb, *knb;
    __device__ __forceinline__ void pre(const Unit& u, int tid, PG8_LAS unsigned char* lds) const {
        PG8_LAS float* gtab = (PG8_LAS float*)(lds + EPI_TAB + 1024);
        const int wv = __builtin_amdgcn_readfirstlane(tid >> 6);
        if (wv == 0) gtab[tid & 63] = qna[tid & 63]; else if (wv == 1) gtab[64 + (tid & 63)] = kna[tid & 63]; else if (wv == 2) gtab[128 + (tid & 63)] = qnb[tid & 63]; else if (wv == 3) gtab[192 + (tid & 63)] = knb[tid & 63];
        rstd_table(ssp, u.pm, (PG8_LAS float*)(lds + EPI_TAB), tid);
    }
    __device__ __forceinline__ void operator()(const f32x4 (&acc)[2][2][4][2], const Unit& u, int wr, int wc, int fr, int fq, PG8_LAS unsigned char* lds) const {
        PG8_LAS float* rst = (PG8_LAS float*)(lds + EPI_TAB); PG8_LAS float* gtab = (PG8_LAS float*)(lds + EPI_TAB + 1024); const int pre_pm = rstd_table_pm(rst);
        const int lane = fr + 16 * fq;
        const int t = u.pn; bf16_t* dst; const float* ng; int nh, h, sel = 0; float sc = 1.0f;
        if (t < 2) { dst = qa; ng = qna; nh = 8; h = 4 * t + wc; sc = QSCALE; sel = 0; }
        else if (t < 4) { dst = ka; ng = kna; nh = 8; h = 4 * (t - 2) + wc; sel = 1; }
        else if (t < 6) { dst = va; ng = nullptr; nh = 8; h = 4 * (t - 4) + wc; }
        else if (t < 8) { dst = qb; ng = qnb; nh = 8; h = 4 * (t - 6) + wc; sc = QSCALE; sel = 2; }
        else if (wc < 2) { dst = kb; ng = knb; nh = 2; h = wc; sel = 3; }
        else { dst = vb; ng = nullptr; nh = 2; h = wc - 2; }
        f32x4 gv[2][2];
        const int row0 = u.pm * BM + wr * 64 + fr;
        float rsv[8];
        if (u.pm == pre_pm) {
          rstd_table_rd(rst, wr, fr, rsv);
          const unsigned ga = (unsigned)(uintptr_t)gtab + (unsigned)(sel * 256 + fq * 32);
          asm volatile("ds_read_b128 %0, %1" : "=v"(gv[0][0]) : "v"(ga) : "memory");            asm volatile("ds_read_b128 %0, %1 offset:16" : "=v"(gv[0][1]) : "v"(ga) : "memory");
          asm volatile("ds_read_b128 %0, %1 offset:128" : "=v"(gv[1][0]) : "v"(ga) : "memory"); asm volatile("ds_read_b128 %0, %1 offset:144" : "=v"(gv[1][1]) : "v"(ga) : "memory");
          asm volatile("s_waitcnt lgkmcnt(0)" : "+v"(rsv[0]), "+v"(rsv[1]), "+v"(rsv[2]), "+v"(rsv[3]), "+v"(rsv[4]), "+v"(rsv[5]), "+v"(rsv[6]), "+v"(rsv[7]), "+v"(gv[0][0]), "+v"(gv[0][1]), "+v"(gv[1][0]), "+v"(gv[1][1]) :: "memory");
        } else
        { f32x4 t8[8];
#pragma unroll
          for (int g = 0; g < 8; ++g) t8[g] = rstd_ld(ssp, row0 + (g >> 2) * HALF + (g & 3) * 16, fq);
          const float* ngp = ng ? ng : qna;
#pragma unroll
          for (int bj = 0; bj < 2; ++bj)
#pragma unroll
              for (int n = 0; n < 2; ++n) gv[bj][n] = *(const f32x4*)(ngp + 32 * bj + 8 * fq + 4 * n);
#pragma unroll
          for (int g = 0; g < 8; ++g) rsv[g] = rstd_fin(t8[g], lane); }
        const float gsc = ng ? sc : 0.0f, gad = ng ? 0.0f : 1.0f;
#pragma unroll
        for (int bj = 0; bj < 2; ++bj)
#pragma unroll
            for (int n = 0; n < 2; ++n) gv[bj][n] = gv[bj][n] * gsc + gad;
        asm volatile("" ::: "memory");
#pragma unroll
        for (int ai = 0; ai < 2; ++ai)
#pragma unroll
            for (int m = 0; m < 4; ++m) { const int row = row0 + ai * HALF + m * 16; const float rs = rsv[ai * 4 + m];
                f32x4 v[2][2]; float ss = 0.f;
#pragma unroll
                for (int bj = 0; bj < 2; ++bj)
#pragma unroll
                    for (int n = 0; n < 2; ++n) { v[bj][n] = acc[ai][bj][m][n] * rs; ss += (v[bj][n][0] * v[bj][n][0] + v[bj][n][1] * v[bj][n][1]) + (v[bj][n][2] * v[bj][n][2] + v[bj][n][3] * v[bj][n][3]); }
                ss += shx(ss, lane, 16); ss += shx(ss, lane, 32);
                const float hr = ng ? __builtin_amdgcn_rsqf(ss * (1.0f / 64.0f) + 1e-6f) : 1.0f;
                const int b = row >> 12, s = row & 4095;
                bf16_t* p = dst + (((size_t)b * nh + h) * 4096 + s) * 64 + 8 * fq;
#pragma unroll
                for (int bj = 0; bj < 2; ++bj) *(u32x4*)(p + 32 * bj) = pack8(v[bj][0] * hr * gv[bj][0], v[bj][1] * hr * gv[bj][1]); }
    }
};
}

#include <hip/hip_cooperative_groups.h>
namespace cg = cooperative_groups;
#define LAS __attribute__((address_space(3)))
typedef unsigned v4u __attribute__((ext_vector_type(4)));
constexpr int NWAVES = 8, RING_BYTES = 131072, LDS_BYTES = 147456;
static_assert(pg8::EPI_TAB >= 8 * 16640 && pg8::EPI_TAB + 4096 <= LDS_BYTES - 64, "epilogue tables");
constexpr int NPHASE = 1 + 8 * DEPTH;
constexpr size_t WO_F1IN = 0, WO_F1OUT = WO_F1IN + (size_t)2 * DFF * D, WO_QKV = WO_F1OUT + (size_t)D * DFF, WO_WO = WO_QKV + (size_t)QKVW * D,
                 WO_F2IN = WO_WO + (size_t)D * D, WO_F2OUT = WO_F2IN + (size_t)2 * DFF * D, WO_WG = WO_F2OUT + (size_t)D * DFF, WO_WP = WO_WG + (size_t)D * D, W_LAYER = WO_WP + (size_t)D * PLE;
static_assert(W_LAYER * 2 * DEPTH <= 84 * MiB, "weights fit");

struct Args { const float* in[20]; float* out; unsigned char* ws; int ph_lo, ph_hi; };

__device__ __forceinline__ int src_col(int kind, int n0) {
    if (kind == 0) return n0;
    if (kind == 1) return ((n0 >> 7) & 1) * DFF + 128 * (n0 >> 8) + (n0 & 127);
    return 256 * (n0 >> 8) + 64 * ((n0 >> 5) & 3) + 32 * ((n0 >> 7) & 1);
}
__device__ __forceinline__ unsigned cvt_pk_nv(float lo, float hi) { unsigned r; asm("v_cvt_pk_bf16_f32 %0, %1, %2" : "=v"(r) : "v"(lo), "v"(hi)); return r; }
struct TrItem { const float* W; const float* gain; bf16_t* Bt; int K, N, kind, item; };
__device__ __forceinline__ void tr_issue(const TrItem& d, int lane, float4 (&v)[16]) {
    const int kblocks = d.K / 64, nb = d.item / kblocks, kb = d.item % kblocks, k0 = 64 * kb, n0 = 64 * nb;
    const int cseg = lane & 15, r0 = lane >> 4;
    const int c0 = src_col(d.kind, n0 + 32 * (cseg >> 3)) + 4 * (cseg & 7);
#pragma unroll
    for (int i = 0; i < 16; ++i) v[i] = *(const float4*)(d.W + (size_t)(k0 + r0 + 4 * i) * d.N + c0);
}
__device__ __forceinline__ void tr_finish(const TrItem& d, LAS float* scr, int lane, const float4 (&v)[16]) {
    const int kblocks = d.K / 64, nb = d.item / kblocks, kb = d.item % kblocks, k0 = 64 * kb, n0 = 64 * nb;
    const int cseg = lane & 15, r0 = lane >> 4, c = lane & 7;
    const float* gp = d.gain ? d.gain + k0 + 8 * c : d.W;
    const float4 g0 = *(const float4*)gp, g1 = *(const float4*)(gp + 4);
#pragma unroll
    for (int i = 0; i < 16; ++i) { LAS float* p = scr + (r0 + 4 * i) * 65 + 4 * cseg; p[0] = v[i].x; p[1] = v[i].y; p[2] = v[i].z; p[3] = v[i].w; }
    asm volatile("s_waitcnt lgkmcnt(0)" ::: "memory");
    const bool hg = d.gain != nullptr;
    const float g[8] = {hg ? g0.x : 1.f, hg ? g0.y : 1.f, hg ? g0.z : 1.f, hg ? g0.w : 1.f, hg ? g1.x : 1.f, hg ? g1.y : 1.f, hg ? g1.z : 1.f, hg ? g1.w : 1.f};
#pragma unroll
    for (int jh = 0; jh < 2; ++jh) {
        float t[4][8];
#pragma unroll
        for (int j = 0; j < 4; ++j) { const LAS float* sp = scr + (8 * c) * 65 + (lane >> 3) + 8 * (4 * jh + j);
#pragma unroll
            for (int q = 0; q < 8; ++q) t[j][q] = sp[q * 65]; }
#pragma unroll
        for (int j = 0; j < 4; ++j) { const int n = (lane >> 3) + 8 * (4 * jh + j);
            v4u o; o.x = cvt_pk_nv(t[j][0] * g[0], t[j][1] * g[1]); o.y = cvt_pk_nv(t[j][2] * g[2], t[j][3] * g[3]); o.z = cvt_pk_nv(t[j][4] * g[4], t[j][5] * g[5]); o.w = cvt_pk_nv(t[j][6] * g[6], t[j][7] * g[7]);
            *(v4u*)(d.Bt + (size_t)(n0 + n) * d.K + k0 + 8 * c) = o; }
    }
    asm volatile("s_waitcnt lgkmcnt(0)" ::: "memory");
}

constexpr int I_FIN = (D / 64) * (2 * DFF / 64), I_FOUT = (DFF / 64) * (D / 64), I_QKV = (D / 64) * (QKVW / 64), I_SQ = (D / 64) * (D / 64), I_WP = (PLE / 64) * (D / 64);
constexpr int IT_FIN1 = 0, IT_FOUT1 = IT_FIN1 + I_FIN, IT_QKV = IT_FOUT1 + I_FOUT, IT_WO = IT_QKV + I_QKV, IT_FIN2 = IT_WO + I_SQ, IT_FOUT2 = IT_FIN2 + I_FIN, IT_WG = IT_FOUT2 + I_FOUT, IT_WP = IT_WG + I_SQ, I_LAYER = IT_WP + I_WP;
template <class AT> __device__ __forceinline__ TrItem tr_decode(const AT& a, int it) {
    bf16_t* wbase = (bf16_t*)(a.ws() + WS_W);
    const int l = it / I_LAYER; int r = it % I_LAYER; bf16_t* wl = wbase + (size_t)l * W_LAYER;
    TrItem d;
    if (r < I_FIN) { d = TrItem{a.in(4) + (size_t)l * D * 2 * DFF, a.in(3) + l * D, wl + WO_F1IN, D, 2 * DFF, 1, r}; return d; } r -= I_FIN;
    if (r < I_FOUT) { d = TrItem{a.in(5) + (size_t)l * DFF * D, nullptr, wl + WO_F1OUT, DFF, D, 0, r}; return d; } r -= I_FOUT;
    if (r < I_QKV) { d = TrItem{a.in(7) + (size_t)l * D * QKVW, a.in(6) + l * D, wl + WO_QKV, D, QKVW, 2, r}; return d; } r -= I_QKV;
    if (r < I_SQ) { d = TrItem{a.in(13) + (size_t)l * D * D, nullptr, wl + WO_WO, D, D, 0, r}; return d; } r -= I_SQ;
    if (r < I_FIN) { d = TrItem{a.in(15) + (size_t)l * D * 2 * DFF, a.in(14) + l * D, wl + WO_F2IN, D, 2 * DFF, 1, r}; return d; } r -= I_FIN;
    if (r < I_FOUT) { d = TrItem{a.in(16) + (size_t)l * DFF * D, nullptr, wl + WO_F2OUT, DFF, D, 0, r}; return d; } r -= I_FOUT;
    if (r < I_SQ) { d = TrItem{a.in(18) + (size_t)l * D * D, a.in(17) + l * D, wl + WO_WG, D, D, 0, r}; return d; } r -= I_SQ;
    d = TrItem{a.in(19) + (size_t)l * PLE * D, nullptr, wl + WO_WP, PLE, D, 0, r}; return d;
}
template <class AT> __device__ __forceinline__ void convert_weight_items(const AT& a, LAS unsigned char* lds, int f1, int c1, int widx, int nw, int wave, int lane, int f2 = 0, int c2 = 0, int f3 = 0, int c3 = 0) {
    LAS float* scr = (LAS float*)(lds + wave * 16640);
    const int total = c1 + c2 + c3;
    auto item_of = [&](int e) { return e < c1 ? f1 + e : (e < c1 + c2 ? f2 + (e - c1) : f3 + (e - c1 - c2)); };
    int e = __builtin_amdgcn_readfirstlane(widx);
    if (e >= total) return;
    float4 va[16], vb[16];
    TrItem d0 = tr_decode(a, item_of(e)), d1 = d0;
    tr_issue(d0, lane, va);
    for (;;) {
        const int e1 = e + nw; const bool h1 = e1 < total;
        if (h1) { d1 = tr_decode(a, item_of(e1)); tr_issue(d1, lane, vb); }
        tr_finish(d0, scr, lane, va);
        if (!h1) break;
        e = e1 + nw; const bool h0 = e < total;
        if (h0) { d0 = tr_decode(a, item_of(e)); tr_issue(d0, lane, va); }
        tr_finish(d1, scr, lane, vb);
        if (!h0) break;
    }
}
template <class AT> __device__ __forceinline__ void prologue_phase(const AT& a, LAS unsigned char* lds, int gw, int NGW, int wave, int lane, bool side_jobs) {
    if (side_jobs) convert_weight_items(a, lds, IT_FIN1, I_FIN, gw, NGW, wave, lane);
    else convert_weight_items(a, lds, 0, DEPTH * I_LAYER, gw, NGW, wave, lane);
    const float* x = a.in(0); bf16_t* xb = (bf16_t*)(a.ws() + WS_XB); bf16_t* xlo = (bf16_t*)a.out(); float* ssp = (float*)(a.ws() + WS_SSP);
    for (int row = gw; row < M; row += 2 * NGW) {
        const int row2 = row + NGW; const bool has2 = row2 < M;
        const float4* xr = (const float4*)(x + (size_t)row * D); const float4* xr2 = (const float4*)(x + (size_t)(has2 ? row2 : row) * D);
        float4 va[4], vb[4];
#pragma unroll
        for (int j = 0; j < 4; ++j) { va[j] = xr[lane + 64 * j]; vb[j] = xr2[lane + 64 * j]; }
        float s = 0.f, s2 = 0.f;
#pragma unroll
        for (int j = 0; j < 4; ++j) { s += va[j].x * va[j].x + va[j].y * va[j].y + va[j].z * va[j].z + va[j].w * va[j].w; s2 += vb[j].x * vb[j].x + vb[j].y * vb[j].y + vb[j].z * vb[j].z + vb[j].w * vb[j].w;
            uint2 o; o.x = pg8::cvt_pk_bf16(va[j].x, va[j].y); o.y = pg8::cvt_pk_bf16(va[j].z, va[j].w); ((uint2*)(xb + (size_t)row * D))[lane + 64 * j] = o;
            if (XLO) { uint2 q; q.x = pg8::cvt_pk_bf16(va[j].x - pg8::bflo(o.x), va[j].y - pg8::bfhi(o.x)); q.y = pg8::cvt_pk_bf16(va[j].z - pg8::bflo(o.y), va[j].w - pg8::bfhi(o.y)); ((uint2*)(xlo + (size_t)row * D))[lane + 64 * j] = q; }
            if (has2) { uint2 o2; o2.x = pg8::cvt_pk_bf16(vb[j].x, vb[j].y); o2.y = pg8::cvt_pk_bf16(vb[j].z, vb[j].w); ((uint2*)(xb + (size_t)row2 * D))[lane + 64 * j] = o2;
                if (XLO) { uint2 q2; q2.x = pg8::cvt_pk_bf16(vb[j].x - pg8::bflo(o2.x), vb[j].y - pg8::bfhi(o2.x)); q2.y = pg8::cvt_pk_bf16(vb[j].z - pg8::bflo(o2.y), vb[j].w - pg8::bfhi(o2.y)); ((uint2*)(xlo + (size_t)row2 * D))[lane + 64 * j] = q2; } } }
#pragma unroll
        for (int o = 1; o < 64; o <<= 1) { s += pg8::shx(s, lane, o); s2 += pg8::shx(s2, lane, o); }
        if (lane < 4) { float4 r; r.x = lane == 0 ? s : 0.f; r.y = 0.f; r.z = 0.f; r.w = 0.f; ((float4*)ssp)[row * 4 + lane] = r;
            if (has2) { r.x = lane == 0 ? s2 : 0.f; ((float4*)ssp)[row2 * 4 + lane] = r; } }
    }
}
__device__ __forceinline__ void convert_p(const float* p, bf16_t* pb, int gtid, int nthreads) {
    for (int i = gtid; i < M * PLE / 8; i += nthreads) { const float4 v0 = ((const float4*)p)[2 * i], v1 = ((const float4*)p)[2 * i + 1];
        v4u o; o.x = pg8::cvt_pk_bf16(v0.x, v0.y); o.y = pg8::cvt_pk_bf16(v0.z, v0.w); o.z = pg8::cvt_pk_bf16(v1.x, v1.y); o.w = pg8::cvt_pk_bf16(v1.z, v1.w); ((v4u*)pb)[i] = o; }
}

namespace att {
typedef short bf16x8 __attribute__((ext_vector_type(8)));
typedef short s16x4 __attribute__((ext_vector_type(4)));
typedef short v4i16_t __attribute__((ext_vector_type(4)));
typedef float f32x16 __attribute__((ext_vector_type(16)));
typedef unsigned u32x4 __attribute__((ext_vector_type(4)));
typedef float f32x2_t __attribute__((ext_vector_type(2))); typedef __bf16 bf16x2_t __attribute__((ext_vector_type(2)));
constexpr float NEG = -1e30f;
constexpr int WAVE_LDS = 8704, LUT_OFF = 0, WAVES_OFF = 8192, LUTA_STRIDE = 200, LUTB_STRIDE = 328, LUTB_OFF = LUT_OFF + 3 * LUTA_STRIDE * 4, TAB_OFF = WAVES_OFF + 8 * WAVE_LDS, LSE_OFF = TAB_OFF + 65536, ATT_LDS_END = LSE_OFF + 2048;
static_assert(LUTB_OFF + 4 * LUTB_STRIDE * 4 <= WAVES_OFF && ATT_LDS_END <= 147456 - 64, "attention LDS map");
__device__ __forceinline__ int crow(int r, int hi) { return (r & 3) + 8 * (r >> 2) + 4 * hi; }
__device__ __forceinline__ unsigned cvtpk(float lo, float hi) { f32x2_t v = {lo, hi}; bf16x2_t b = __builtin_convertvector(v, bf16x2_t); return __builtin_bit_cast(unsigned, b); }
__device__ __forceinline__ s16x4 vtr(const LAS unsigned char* p) { return __builtin_bit_cast(s16x4, __builtin_amdgcn_ds_read_tr16_b64_v4i16((LAS v4i16_t*)p)); }
__device__ __forceinline__ float halfmax(float v) { auto rr = __builtin_amdgcn_permlane32_swap(__float_as_uint(v), __float_as_uint(v), false, false); return fmaxf(__uint_as_float(rr[0]), __uint_as_float(rr[1])); }
__device__ __forceinline__ float halfsum(float v) { auto rr = __builtin_amdgcn_permlane32_swap(__float_as_uint(v), __float_as_uint(v), false, false); return __uint_as_float(rr[0]) + __uint_as_float(rr[1]); }

__device__ __forceinline__ f32x16 bias_ld(const LAS float* lut, const int j, const int i, const int hi) {
    const LAS float* lp = lut + 32 * j - i + 4 * hi; f32x16 b;
#pragma unroll
    for (int r = 0; r < 16; ++r) b[r] = lp[(r & 3) + 8 * (r >> 2)];
    return b;
}
__device__ __forceinline__ void bias_add(f32x16& p, const LAS float* lut, const int j, const int i, const int hi) {
    const LAS float* lp = lut + 32 * j - i + 4 * hi;
#pragma unroll
    for (int r = 0; r < 16; ++r) p[r] += lp[(r & 3) + 8 * (r >> 2)];
}
constexpr float MLOW = -1.0e4f;
constexpr float THR = 8.0f;
template <int NT>
__device__ __forceinline__ void sm_tile(f32x16& p, const LAS float* lut, const int j, const int i, const int hi, const int first, const int dstep, const bool inside,
                                        float& m, float& l, f32x16 (&o)[2], LAS float* wsf, bf16x8& pa0, bf16x8& pa1) {
    if (!inside) {
#pragma unroll
        for (int r = 0; r < 16; ++r) { const int tk = first + crow(r, hi) * dstep; if ((unsigned)tk >= (unsigned)S) p[r] = NEG; }
    }
    float rm = fmaxf(p[0], p[1]);
#pragma unroll
    for (int r = 2; r < 16; ++r) rm = fmaxf(rm, p[r]);
    rm = halfmax(rm);
    if (__any(rm > m + THR)) {
        const float mn = fmaxf(m, rm), alpha = __builtin_amdgcn_exp2f(m - mn);
        l *= alpha; m = mn;
        if (hi == 0) wsf[i] = alpha;
#pragma unroll
        for (int r = 0; r < 16; ++r) { const float a = wsf[crow(r, hi)]; o[0][r] *= a; o[1][r] *= a; }
    }
    f32x2_t rs2 = {0.f, 0.f}; const f32x2_t nm2 = {-m, -m};
#pragma unroll
    for (int r = 0; r < 16; r += 2) { f32x2_t t = (f32x2_t){p[r], p[r + 1]} + nm2; t.x = __builtin_amdgcn_exp2f(t.x); t.y = __builtin_amdgcn_exp2f(t.y); p[r] = t.x; p[r + 1] = t.y; rs2 += t; }
    l += rs2.x + rs2.y;
    u32x4 pw0 = {cvtpk(p[0], p[1]), cvtpk(p[2], p[3]), cvtpk(p[4], p[5]), cvtpk(p[6], p[7])};
    u32x4 pw1 = {cvtpk(p[8], p[9]), cvtpk(p[10], p[11]), cvtpk(p[12], p[13]), cvtpk(p[14], p[15])};
    pa0 = __builtin_bit_cast(bf16x8, pw0); pa1 = __builtin_bit_cast(bf16x8, pw1);
}
template <int NT, int SHIFT>
__device__ __forceinline__ void qtile2(const bf16_t* qrow0, const bf16_t* qrow1, const bf16_t* kbase, const bf16_t* vbase, int tk0, int dstep, const LAS float* lut0, const LAS float* lut1,
                                       float mi0, float li0, float mi1, float li1, LAS unsigned char* wl, int lane_in,
                                       f32x16 (&o0)[2], float& m0_out, float& l0_out, f32x16 (&o1)[2], float& m1_out, float& l1_out) {
    int lane = lane_in; asm volatile("" : "+v"(lane));
    const int i = lane & 31, hi = lane >> 5;
    LAS float* wsf = (LAS float*)(wl + 8192);
    bf16x8 qf0[4], qf1[4];
#pragma unroll
    for (int ks = 0; ks < 4; ++ks) { qf0[ks] = *(const bf16x8*)(qrow0 + 16 * ks + 8 * hi); qf1[ks] = *(const bf16x8*)(qrow1 + 16 * ks + 8 * hi); }
    const int vrow = lane >> 3, vsw = (lane & 7) ^ (((lane >> 4) & 1) << 2);
    const int rd_base = (4 * hi + ((lane & 15) >> 2)) * 128 + 32 * ((lane >> 4) & 1) + 8 * (lane & 3);
    const int bit3 = (lane >> 3) & 1;
    const int vb0 = rd_base + 64 * bit3, vb1 = rd_base + 64 * (1 - bit3);
    bf16x8 kf[4];
#define ATT_LOAD(j, buf) do { \
        { int tk = tk0 + (32 * (j) + i) * dstep; tk = tk < 0 ? 0 : (tk > S - 1 ? S - 1 : tk); const bf16_t* kp = kbase + (size_t)tk * HD + 8 * hi; \
          _Pragma("unroll") for (int ks = 0; ks < 4; ++ks) kf[ks] = *(const bf16x8*)(kp + 16 * ks); } \
        _Pragma("unroll") for (int i4 = 0; i4 < 4; ++i4) { int tk = tk0 + (32 * (j) + vrow + 8 * i4) * dstep; tk = tk < 0 ? 0 : (tk > S - 1 ? S - 1 : tk); \
          __builtin_amdgcn_global_load_lds((const unsigned*)(vbase + (size_t)tk * HD + 8 * vsw), (LAS unsigned*)(wl + (buf) * 4096 + i4 * 1024), 16, 0, 0); } } while (0)
    float m0 = mi0, l0 = hi == 0 ? li0 : 0.f, m1 = mi1, l1 = hi == 0 ? li1 : 0.f;
    o0[0] = f32x16{}; o0[1] = f32x16{}; o1[0] = f32x16{}; o1[1] = f32x16{};
    ATT_LOAD(0, 0);
#pragma unroll 1
    for (int jj = 0; jj < NT + SHIFT; ++jj) {
        LAS unsigned char* vbuf = wl + (jj & 1) * 4096;
        const bool a0 = jj < NT, a1 = jj >= SHIFT;
        const int first = tk0 + 32 * jj * dstep, lastk = first + 31 * dstep;
        const bool inside = first >= 0 && lastk < S;
        asm volatile("s_waitcnt vmcnt(0)" ::: "memory");
        f32x16 p0, p1;
        bf16x8 pa00, pa01, pa10, pa11;
        {
            if (a0) {
                p0 = __builtin_amdgcn_mfma_f32_32x32x16_bf16(kf[0], qf0[0], bias_ld(lut0, jj, i, hi), 0, 0, 0);
#pragma unroll
                for (int ks = 1; ks < 4; ++ks) p0 = __builtin_amdgcn_mfma_f32_32x32x16_bf16(kf[ks], qf0[ks], p0, 0, 0, 0);
            }
            if (a1) {
                p1 = __builtin_amdgcn_mfma_f32_32x32x16_bf16(kf[0], qf1[0], bias_ld(lut1, jj - SHIFT, i, hi), 0, 0, 0);
#pragma unroll
                for (int ks = 1; ks < 4; ++ks) p1 = __builtin_amdgcn_mfma_f32_32x32x16_bf16(kf[ks], qf1[ks], p1, 0, 0, 0);
            }
        }
        if (jj + 1 < NT + SHIFT) ATT_LOAD(jj + 1, (jj + 1) & 1);
        {
            if (a0) sm_tile<NT>(p0, lut0, jj, i, hi, first, dstep, inside, m0, l0, o0, wsf, pa00, pa01);
            if (a1) sm_tile<NT>(p1, lut1, jj - SHIFT, i, hi, first, dstep, inside, m1, l1, o1, wsf, pa10, pa11);
            {
                const unsigned vpa = (unsigned)(uintptr_t)(vbuf + vb0), vpb = (unsigned)(uintptr_t)(vbuf + vb1);
                s16x4 x0, x1, y0, y1, z0, z1, w0, w1;
                asm volatile("ds_read_b64_tr_b16 %0, %1" : "=&v"(x0) : "v"(vpa) : "memory");
                asm volatile("ds_read_b64_tr_b16 %0, %1 offset:1024" : "=&v"(x1) : "v"(vpa) : "memory");
                asm volatile("ds_read_b64_tr_b16 %0, %1 offset:2048" : "=&v"(y0) : "v"(vpa) : "memory");
                asm volatile("ds_read_b64_tr_b16 %0, %1 offset:3072" : "=&v"(y1) : "v"(vpa) : "memory");
                asm volatile("ds_read_b64_tr_b16 %0, %1" : "=&v"(z0) : "v"(vpb) : "memory");
                asm volatile("ds_read_b64_tr_b16 %0, %1 offset:1024" : "=&v"(z1) : "v"(vpb) : "memory");
                asm volatile("ds_read_b64_tr_b16 %0, %1 offset:2048" : "=&v"(w0) : "v"(vpb) : "memory");
                asm volatile("ds_read_b64_tr_b16 %0, %1 offset:3072" : "=&v"(w1) : "v"(vpb) : "memory");
                asm volatile("s_waitcnt lgkmcnt(4)" : "+v"(x0), "+v"(x1), "+v"(y0), "+v"(y1) :: "memory"); __builtin_amdgcn_sched_barrier(0);
                { const bf16x8 f0 = {x0[0], x0[1], x0[2], x0[3], x1[0], x1[1], x1[2], x1[3]}, f1 = {y0[0], y0[1], y0[2], y0[3], y1[0], y1[1], y1[2], y1[3]};
                  if (a0) { o0[0] = __builtin_amdgcn_mfma_f32_32x32x16_bf16(pa00, f0, o0[0], 0, 0, 0); o0[0] = __builtin_amdgcn_mfma_f32_32x32x16_bf16(pa01, f1, o0[0], 0, 0, 0); }
                  if (a1) { o1[0] = __builtin_amdgcn_mfma_f32_32x32x16_bf16(pa10, f0, o1[0], 0, 0, 0); o1[0] = __builtin_amdgcn_mfma_f32_32x32x16_bf16(pa11, f1, o1[0], 0, 0, 0); } }
                asm volatile("s_waitcnt lgkmcnt(0)" : "+v"(z0), "+v"(z1), "+v"(w0), "+v"(w1) :: "memory"); __builtin_amdgcn_sched_barrier(0);
                { const bf16x8 f0 = {z0[0], z0[1], z0[2], z0[3], z1[0], z1[1], z1[2], z1[3]}, f1 = {w0[0], w0[1], w0[2], w0[3], w1[0], w1[1], w1[2], w1[3]};
                  if (a0) { o0[1] = __builtin_amdgcn_mfma_f32_32x32x16_bf16(pa00, f0, o0[1], 0, 0, 0); o0[1] = __builtin_amdgcn_mfma_f32_32x32x16_bf16(pa01, f1, o0[1], 0, 0, 0); }
                  if (a1) { o1[1] = __builtin_amdgcn_mfma_f32_32x32x16_bf16(pa10, f0, o1[1], 0, 0, 0); o1[1] = __builtin_amdgcn_mfma_f32_32x32x16_bf16(pa11, f1, o1[1], 0, 0, 0); } }
            }
        }
    }
#undef ATT_LOAD
    m0_out = m0; l0_out = halfsum(l0); m1_out = m1; l1_out = halfsum(l1);
}

template <int NT>
__device__ __forceinline__ void qtile2s(const bf16_t* qrow0, const bf16_t* qrow1, const bf16_t* kbase, const bf16_t* vbase, int tk0a, int tk0b, int dstep, const LAS float* lut,
                                        LAS unsigned char* wl, LAS unsigned char* wlb, int lane_in,
                                        f32x16 (&o0)[2], float& m0_out, float& l0_out, f32x16 (&o1)[2], float& m1_out, float& l1_out) {
    int lane = lane_in; asm volatile("" : "+v"(lane));
    const int i = lane & 31, hi = lane >> 5;
    LAS float* wsf = (LAS float*)(wl + 8192);
    bf16x8 qf0[4], qf1[4];
#pragma unroll
    for (int ks = 0; ks < 4; ++ks) { qf0[ks] = *(const bf16x8*)(qrow0 + 16 * ks + 8 * hi); qf1[ks] = *(const bf16x8*)(qrow1 + 16 * ks + 8 * hi); }
    const int vrow = lane >> 3, vsw = (lane & 7) ^ (((lane >> 4) & 1) << 2);
    const int rd_base = (4 * hi + ((lane & 15) >> 2)) * 128 + 32 * ((lane >> 4) & 1) + 8 * (lane & 3);
    const int bit3 = (lane >> 3) & 1;
    const int vb0 = rd_base + 64 * bit3, vb1 = rd_base + 64 * (1 - bit3);
    bf16x8 kfa[4], kfb[4];
#define ATT_LOADS(j, buf, KF, TK0, WL) do { \
        { int tk = (TK0) + (32 * (j) + i) * dstep; tk = tk < 0 ? 0 : (tk > S - 1 ? S - 1 : tk); const bf16_t* kp = kbase + (size_t)tk * HD + 8 * hi; \
          _Pragma("unroll") for (int ks = 0; ks < 4; ++ks) KF[ks] = *(const bf16x8*)(kp + 16 * ks); } \
        _Pragma("unroll") for (int i4 = 0; i4 < 4; ++i4) { int tk = (TK0) + (32 * (j) + vrow + 8 * i4) * dstep; tk = tk < 0 ? 0 : (tk > S - 1 ? S - 1 : tk); \
          __builtin_amdgcn_global_load_lds((const unsigned*)(vbase + (size_t)tk * HD + 8 * vsw), (LAS unsigned*)((WL) + (buf) * 4096 + i4 * 1024), 16, 0, 0); } } while (0)
    float m0 = MLOW, l0 = 0.f, m1 = MLOW, l1 = 0.f;
    o0[0] = f32x16{}; o0[1] = f32x16{}; o1[0] = f32x16{}; o1[1] = f32x16{};
    ATT_LOADS(0, 0, kfa, tk0a, wl); ATT_LOADS(0, 0, kfb, tk0b, wlb);
#pragma unroll 1
    for (int jj = 0; jj < NT; ++jj) {
        LAS unsigned char* vbufa = wl + (jj & 1) * 4096; LAS unsigned char* vbufb = wlb + (jj & 1) * 4096;
        const int firsta = tk0a + 32 * jj * dstep, firstb = tk0b + 32 * jj * dstep;
        const bool insa = firsta >= 0 && firsta + 31 * dstep < S, insb = firstb >= 0 && firstb + 31 * dstep < S;
        asm volatile("s_waitcnt vmcnt(0)" ::: "memory");
        f32x16 p0, p1;
        bf16x8 pa00, pa01, pa10, pa11;
        p0 = __builtin_amdgcn_mfma_f32_32x32x16_bf16(kfa[0], qf0[0], bias_ld(lut, jj, i, hi), 0, 0, 0);
        p1 = __builtin_amdgcn_mfma_f32_32x32x16_bf16(kfb[0], qf1[0], bias_ld(lut, jj, i, hi), 0, 0, 0);
#pragma unroll
        for (int ks = 1; ks < 4; ++ks) { p0 = __builtin_amdgcn_mfma_f32_32x32x16_bf16(kfa[ks], qf0[ks], p0, 0, 0, 0); p1 = __builtin_amdgcn_mfma_f32_32x32x16_bf16(kfb[ks], qf1[ks], p1, 0, 0, 0); }
        if (jj + 1 < NT) { ATT_LOADS(jj + 1, (jj + 1) & 1, kfa, tk0a, wl); ATT_LOADS(jj + 1, (jj + 1) & 1, kfb, tk0b, wlb); }
        sm_tile<NT>(p0, lut, jj, i, hi, firsta, dstep, insa, m0, l0, o0, wsf, pa00, pa01);
        sm_tile<NT>(p1, lut, jj, i, hi, firstb, dstep, insb, m1, l1, o1, wsf, pa10, pa11);
#pragma unroll
        for (int d0 = 0; d0 < 2; ++d0) {
            const unsigned vpa = (unsigned)(uintptr_t)(vbufa + (d0 == 0 ? vb0 : vb1)), vpb = (unsigned)(uintptr_t)(vbufb + (d0 == 0 ? vb0 : vb1));
            s16x4 x0, x1, y0, y1, z0, z1, w0, w1;
            asm volatile("ds_read_b64_tr_b16 %0, %1" : "=&v"(x0) : "v"(vpa) : "memory"); asm volatile("ds_read_b64_tr_b16 %0, %1 offset:1024" : "=&v"(x1) : "v"(vpa) : "memory");
            asm volatile("ds_read_b64_tr_b16 %0, %1 offset:2048" : "=&v"(y0) : "v"(vpa) : "memory"); asm volatile("ds_read_b64_tr_b16 %0, %1 offset:3072" : "=&v"(y1) : "v"(vpa) : "memory");
            asm volatile("ds_read_b64_tr_b16 %0, %1" : "=&v"(z0) : "v"(vpb) : "memory"); asm volatile("ds_read_b64_tr_b16 %0, %1 offset:1024" : "=&v"(z1) : "v"(vpb) : "memory");
            asm volatile("ds_read_b64_tr_b16 %0, %1 offset:2048" : "=&v"(w0) : "v"(vpb) : "memory"); asm volatile("ds_read_b64_tr_b16 %0, %1 offset:3072" : "=&v"(w1) : "v"(vpb) : "memory");
            asm volatile("s_waitcnt lgkmcnt(0)" : "+v"(x0), "+v"(x1), "+v"(y0), "+v"(y1), "+v"(z0), "+v"(z1), "+v"(w0), "+v"(w1) :: "memory"); __builtin_amdgcn_sched_barrier(0);
            const bf16x8 f0 = {x0[0], x0[1], x0[2], x0[3], x1[0], x1[1], x1[2], x1[3]}, f1 = {y0[0], y0[1], y0[2], y0[3], y1[0], y1[1], y1[2], y1[3]};
            const bf16x8 g0 = {z0[0], z0[1], z0[2], z0[3], z1[0], z1[1], z1[2], z1[3]}, g1 = {w0[0], w0[1], w0[2], w0[3], w1[0], w1[1], w1[2], w1[3]};
            o0[d0] = __builtin_amdgcn_mfma_f32_32x32x16_bf16(pa00, f0, o0[d0], 0, 0, 0); o0[d0] = __builtin_amdgcn_mfma_f32_32x32x16_bf16(pa01, f1, o0[d0], 0, 0, 0);
            o1[d0] = __builtin_amdgcn_mfma_f32_32x32x16_bf16(pa10, g0, o1[d0], 0, 0, 0); o1[d0] = __builtin_amdgcn_mfma_f32_32x32x16_bf16(pa11, g1, o1[d0], 0, 0, 0);
        }
    }
#undef ATT_LOADS
    m0_out = m0; l0_out = halfsum(l0); m1_out = m1; l1_out = halfsum(l1);
}

__device__ __forceinline__ void glds16(const void* gsrc, unsigned lds_dst) { unsigned keep;
    asm volatile("s_mov_b32 %0, m0\n\ts_mov_b32 m0, %2\n\ts_nop 0\n\tglobal_load_lds_dwordx4 %1, off\n\ts_mov_b32 m0, %0" : "=&s"(keep) : "v"(gsrc), "s"(lds_dst) : "memory"); }
__device__ __forceinline__ void qtile16(const bf16_t* qrow, const bf16_t* kbase, const bf16_t* vbase, const int tk0, const LAS float* lut, LAS unsigned char* wl, LAS unsigned char* xbuf,
                                        int lane_in, f32x16 (&o)[2], float& m_out, float& l_out) {
    int lane = lane_in; asm volatile("" : "+v"(lane));
    const int i = lane & 31, hi = lane >> 5;
    LAS float* wsf = (LAS float*)(wl + 8192);
    bf16x8 qf[4];
    { const bf16_t* qp = qrow + 8 * hi;
      asm volatile("global_load_dwordx4 %0, %1, off" : "=v"(qf[0]) : "v"(qp) : "memory"); asm volatile("global_load_dwordx4 %0, %1, off offset:32" : "=v"(qf[1]) : "v"(qp) : "memory");
      asm volatile("global_load_dwordx4 %0, %1, off offset:64" : "=v"(qf[2]) : "v"(qp) : "memory"); asm volatile("global_load_dwordx4 %0, %1, off offset:96" : "=v"(qf[3]) : "v"(qp) : "memory"); }
    const int vrow = lane >> 3, vsw = (lane & 7) ^ (((lane >> 4) & 1) << 2);
    const int rd_base = (4 * hi + ((lane & 15) >> 2)) * 128 + 32 * ((lane >> 4) & 1) + 8 * (lane & 3);
    const int bit3 = (lane >> 3) & 1;
    const int vb0 = rd_base + 64 * bit3, vb1 = rd_base + 64 * (1 - bit3);
    const unsigned b0 = (unsigned)__builtin_amdgcn_readfirstlane((int)(unsigned)(uintptr_t)wl), b1 = b0 + 4096u, b2 = (unsigned)__builtin_amdgcn_readfirstlane((int)(unsigned)(uintptr_t)xbuf);
    bf16x8 kf[5][4];
#define Q16_K(t) do { int tk = tk0 + (32 * (t) + i) * 16; tk = tk < 0 ? 0 : (tk > S - 1 ? S - 1 : tk); const bf16_t* kp = kbase + (size_t)tk * HD + 8 * hi; \
        asm volatile("global_load_dwordx4 %0, %1, off" : "=v"(kf[t][0]) : "v"(kp) : "memory"); asm volatile("global_load_dwordx4 %0, %1, off offset:32" : "=v"(kf[t][1]) : "v"(kp) : "memory"); \
        asm volatile("global_load_dwordx4 %0, %1, off offset:64" : "=v"(kf[t][2]) : "v"(kp) : "memory"); asm volatile("global_load_dwordx4 %0, %1, off offset:96" : "=v"(kf[t][3]) : "v"(kp) : "memory"); } while (0)
#define Q16_V(t, buf) do { _Pragma("unroll") for (int i4 = 0; i4 < 4; ++i4) { int tk = tk0 + (32 * (t) + vrow + 8 * i4) * 16; tk = tk < 0 ? 0 : (tk > S - 1 ? S - 1 : tk); \
        glds16(vbase + (size_t)tk * HD + 8 * vsw, (buf) + i4 * 1024u); } } while (0)
#define Q16_WAIT(t, n) do { asm volatile("s_waitcnt vmcnt(" #n ")" : "+v"(kf[t][0]), "+v"(kf[t][1]), "+v"(kf[t][2]), "+v"(kf[t][3]) :: "memory"); __builtin_amdgcn_sched_barrier(0); } while (0)
    Q16_K(0); Q16_V(0, b0); Q16_K(1); Q16_V(1, b1); Q16_K(2); Q16_V(2, b2); Q16_K(3); Q16_K(4);
    float m = MLOW, l = 0.f;
    o[0] = f32x16{}; o[1] = f32x16{};
#define Q16_STEP(t, nwait, vimg, AFTER) do { \
        Q16_WAIT(t, nwait); \
        f32x16 p = __builtin_amdgcn_mfma_f32_32x32x16_bf16(kf[t][0], qf[0], bias_ld(lut, (t), i, hi), 0, 0, 0); \
        p = __builtin_amdgcn_mfma_f32_32x32x16_bf16(kf[t][1], qf[1], p, 0, 0, 0); p = __builtin_amdgcn_mfma_f32_32x32x16_bf16(kf[t][2], qf[2], p, 0, 0, 0); p = __builtin_amdgcn_mfma_f32_32x32x16_bf16(kf[t][3], qf[3], p, 0, 0, 0); \
        const int first_ = tk0 + 32 * (t) * 16; const bool inside_ = first_ >= 0 && first_ + 31 * 16 < S; \
        bf16x8 pa0_, pa1_; sm_tile<5>(p, lut, (t), i, hi, first_, 16, inside_, m, l, o, wsf, pa0_, pa1_); \
        _Pragma("unroll") for (int d0 = 0; d0 < 2; ++d0) { const unsigned vp = (vimg) + (unsigned)(d0 == 0 ? vb0 : vb1); s16x4 a0, a1, c0, c1; \
            asm volatile("ds_read_b64_tr_b16 %0, %1" : "=&v"(a0) : "v"(vp) : "memory"); asm volatile("ds_read_b64_tr_b16 %0, %1 offset:1024" : "=&v"(a1) : "v"(vp) : "memory"); \
            asm volatile("ds_read_b64_tr_b16 %0, %1 offset:2048" : "=&v"(c0) : "v"(vp) : "memory"); asm volatile("ds_read_b64_tr_b16 %0, %1 offset:3072" : "=&v"(c1) : "v"(vp) : "memory"); \
            asm volatile("s_waitcnt lgkmcnt(0)" : "+v"(a0), "+v"(a1), "+v"(c0), "+v"(c1) :: "memory"); __builtin_amdgcn_sched_barrier(0); \
            const bf16x8 f0 = {a0[0], a0[1], a0[2], a0[3], a1[0], a1[1], a1[2], a1[3]}, f1 = {c0[0], c0[1], c0[2], c0[3], c1[0], c1[1], c1[2], c1[3]}; \
            o[d0] = __builtin_amdgcn_mfma_f32_32x32x16_bf16(pa0_, f0, o[d0], 0, 0, 0); o[d0] = __builtin_amdgcn_mfma_f32_32x32x16_bf16(pa1_, f1, o[d0], 0, 0, 0); } \
        AFTER; } while (0)
    asm volatile("s_waitcnt vmcnt(24)" : "+v"(qf[0]), "+v"(qf[1]), "+v"(qf[2]), "+v"(qf[3]) :: "memory");
    Q16_STEP(0, 24, b0, Q16_V(3, b0));
    Q16_STEP(1, 20, b1, Q16_V(4, b1));
    Q16_STEP(2, 16, b2, (void)0);
    Q16_STEP(3, 4, b0, (void)0);
    Q16_STEP(4, 0, b1, (void)0);
#undef Q16_K
#undef Q16_V
#undef Q16_WAIT
#undef Q16_STEP
    m_out = m; l_out = halfsum(l);
}

__device__ __forceinline__ void stage_o(const f32x16 (&o)[2], float m, float l, LAS unsigned char* wl, int lane_in) {
    int lane = lane_in; asm volatile("" : "+v"(lane));
    const int i = lane & 31, hi = lane >> 5;
    LAS float* wsf = (LAS float*)(wl + 8192);
    if (hi == 0) { wsf[i] = __builtin_amdgcn_rcpf(l); wsf[32 + i] = m + __builtin_amdgcn_logf(l); }
    LAS bf16_t* stg = (LAS bf16_t*)wl;
#pragma unroll
    for (int r = 0; r < 16; ++r) { const int q = crow(r, hi); const float inv = wsf[q];
        stg[q * 64 + i] = (bf16_t)(cvtpk(o[0][r] * inv, 0.f) & 0xffffu); stg[q * 64 + 32 + i] = (bf16_t)(cvtpk(o[1][r] * inv, 0.f) & 0xffffu); }
}
__device__ __forceinline__ float bflo(unsigned w) { return __uint_as_float(w << 16); }
__device__ __forceinline__ float bfhi(unsigned w) { return __uint_as_float(w & 0xffff0000u); }
__device__ __forceinline__ unsigned mix2(unsigned a, unsigned b, float wa, float wb) { return cvtpk(wa * bflo(a) + wb * bflo(b), wa * bfhi(a) + wb * bfhi(b)); }

struct Tensors { const bf16_t *qa, *ka, *va, *qb, *kb, *vb; const float* glut; const float* sink; bf16_t* o; };
__device__ __forceinline__ void finish_a(const f32x16 (&o)[2], float m, float l, int pass, int d, int lam0, int rr, LAS unsigned char* wl, LAS unsigned char* tab, LAS float* lsetab, bf16_t* orow0, int lane_in) {
    LAS float* wsf = (LAS float*)(wl + 8192);
    stage_o(o, m, l, wl, lane_in);
    int lane = lane_in; asm volatile("" : "+v"(lane));
#pragma unroll
    for (int i4 = 0; i4 < 4; ++i4) {
        const int qi = (lane >> 3) + 8 * i4, ch = lane & 7, tau = d * (lam0 + qi) + rr;
        u32x4 v = *(const LAS u32x4*)(wl + qi * 128 + ch * 16);
        const float Lb = wsf[32 + qi];
        const int e = (tau & 15) * 32 + (tau >> 4);
        LAS u32x4* te = (LAS u32x4*)(tab + e * 128 + ch * 16);
        if (pass == 0) { *te = v; if (ch == 0) lsetab[e] = Lb; }
        else {
            const u32x4 tv = *te; const float La = lsetab[e];
            const float Lm = fmaxf(La, Lb), sa = __builtin_amdgcn_exp2f(La - Lm), sb = __builtin_amdgcn_exp2f(Lb - Lm), tot = sa + sb, rt = __builtin_amdgcn_rcpf(tot), wa = sa * rt, wb = sb * rt;
            u32x4 w; w.x = mix2(tv.x, v.x, wa, wb); w.y = mix2(tv.y, v.y, wa, wb); w.z = mix2(tv.z, v.z, wa, wb); w.w = mix2(tv.w, v.w, wa, wb);
            if (pass == 1) { *te = w; if (ch == 0) lsetab[e] = Lm + __builtin_amdgcn_logf(tot); }
            else *(u32x4*)(orow0 + (size_t)tau * D + ch * 8) = w;
        }
    }
}


__device__ __forceinline__ int bucket(int rel) {
    const int n = rel < 0 ? -rel : rel; const int ret = rel > 0 ? 16 : 0;
    if (n < 8) return ret + n;
    int large = 8 + (int)(logf((float)n / 8.0f) / 4.852030263919617f * 8.0f);
    large = large < 15 ? large : 15;
    return ret + large;
}

constexpr int GLUT_A = 8 * 3 * LUTA_STRIDE, GLUT_B = 2 * 4 * LUTB_STRIDE;
__device__ __forceinline__ void build_luts(const float* rel_bias, float* glut, int gtid, int nthreads) {
    for (int e = gtid; e < GLUT_A + GLUT_B; e += nthreads) {
        float v = NEG;
        if (e < GLUT_A) { const int h = e / (3 * LUTA_STRIDE), c = (e / LUTA_STRIDE) % 3, idx = e % LUTA_STRIDE - 32, d = c == 0 ? 1 : (c == 1 ? 4 : 16);
            if (idx >= 0 && idx <= 128) v = rel_bias[bucket((idx - 64) * d) * 16 + h] * LOG2E; }
        else { const int f = e - GLUT_A, hk = f / (4 * LUTB_STRIDE), g = (f / LUTB_STRIDE) & 3, idx = f % LUTB_STRIDE - 32;
            if (idx >= 0 && idx <= 256) v = rel_bias[bucket(idx - 128) * 16 + 8 + 4 * hk + g] * LOG2E; }
        glut[e] = v;
    }
}
__device__ __forceinline__ void attn_unit(const Tensors& T, int u, LAS unsigned char* lds, int wave, int lane, const int pmode = 0x33) {
    LAS unsigned char* wl = lds + WAVES_OFF + wave * WAVE_LDS;
    LAS float* wsf = (LAS float*)(wl + 8192);
    LAS float* lutA = (LAS float*)(lds + LUT_OFF); LAS float* lutB = (LAS float*)(lds + LUTB_OFF);
    LAS unsigned char* tab = lds + TAB_OFF; LAS float* lsetab = (LAS float*)(lds + LSE_OFF);
    const int tid = wave * 64 + lane;
    const int i = lane & 31;
    __syncthreads();
    { const int hkb = (u >> 5) & 1, ha = (u >> 3) & 7;
      const float* ga = T.glut + ha * 3 * LUTA_STRIDE; const float* gb = T.glut + GLUT_A + hkb * 4 * LUTB_STRIDE;
      for (int e = tid; e < 3 * LUTA_STRIDE; e += 512) lutA[e] = ga[e];
      for (int e = tid; e < 4 * LUTB_STRIDE; e += 512) lutB[e] = gb[e]; }
    __syncthreads();
    if (pmode & 1) {
        const int bh = u >> 3, blk = u & 7, b = bh >> 3, h = bh & 7, t0 = blk * 512;
        const bf16_t* qbase = T.qa + (size_t)bh * S * HD; const bf16_t* kbase = T.ka + (size_t)bh * S * HD; const bf16_t* vbase = T.va + (size_t)bh * S * HD;
        bf16_t* orow0 = T.o + ((size_t)b * S + t0) * D + h * HD;
#pragma unroll 1
        for (int pass = 0; pass < (pmode >> 4); ++pass) {
            const int c = ATT_ORDER == 0 ? 2 - pass : (pass == 0 ? 2 : (pass == 1 ? 0 : 1)), d = c == 0 ? 1 : (c == 1 ? 4 : 16);
            const LAS float* lt = lutA + c * LUTA_STRIDE + 32;
            if (c == 2) {
#if D16_MODE == 1
                const int rr = 2 * wave;
                f32x16 oA[2], oB[2]; float mA, lA, mB, lB;
                qtile2s<5>(qbase + (size_t)(t0 + d * i + rr) * HD, qbase + (size_t)(t0 + d * i + rr + 1) * HD, kbase, vbase, t0 - 64 * d + rr, t0 - 64 * d + rr + 1, d, lt,
                           wl, tab + wave * 8192, lane, oA, mA, lA, oB, mB, lB);
                finish_a(oA, mA, lA, pass, d, 0, rr, wl, tab, lsetab, orow0, lane);
                finish_a(oB, mB, lB, pass, d, 0, rr + 1, wl, tab, lsetab, orow0, lane);
#else
#pragma unroll 1
                for (int tt = 0; tt < 2; ++tt) { const int rr = 2 * wave + tt;
                    f32x16 o1[2]; float m1, l1;
                    qtile16(qbase + (size_t)(t0 + d * i + rr) * HD, kbase, vbase, t0 - 64 * d + rr, lt, wl, tab + wave * 8192 + 4096, lane, o1, m1, l1);
                    finish_a(o1, m1, l1, pass, d, 0, rr, wl, tab, lsetab, orow0, lane); }
#endif
            } else {
                const int Tq = 2 * wave, rr = c == 1 ? (Tq >> 2) : 0, lamA = 32 * (c == 1 ? (Tq & 3) : Tq);
                f32x16 oA[2], oB[2]; float mA, lA, mB, lB;
                qtile2<5, 1>(qbase + (size_t)(t0 + d * (lamA + i) + rr) * HD, qbase + (size_t)(t0 + d * (lamA + 32 + i) + rr) * HD, kbase, vbase, t0 + d * (lamA - 64) + rr, d, lt, lt,
                             MLOW, 0.f, MLOW, 0.f, wl, lane, oA, mA, lA, oB, mB, lB);
                finish_a(oA, mA, lA, pass, d, lamA, rr, wl, tab, lsetab, orow0, lane);
                finish_a(oB, mB, lB, pass, d, lamA + 32, rr, wl, tab, lsetab, orow0, lane);
            }
            if (pass < 2) __syncthreads();
        }
    }
    if (pmode & 2) {
        const int bk = u >> 5, blk = u & 31, b = bk >> 1, hk = bk & 1, t0 = blk * 128;
        const bf16_t* kbase = T.kb + (size_t)bk * S * HD; const bf16_t* vbase = T.vb + (size_t)bk * S * HD;
        const int qt = wave & 3, g0 = 2 * (wave >> 2), hq0 = 4 * hk + g0;
        const int tq = t0 + 32 * qt + i, tk0 = t0 + 32 * qt - 128;
        f32x16 oA[2], oB[2]; float mA, lA, mB, lB;
        qtile2<9, 0>(T.qb + (((size_t)b * 8 + hq0) * S + tq) * HD, T.qb + (((size_t)b * 8 + hq0 + 1) * S + tq) * HD, kbase, vbase, tk0, 1,
                     lutB + g0 * LUTB_STRIDE + 32, lutB + (g0 + 1) * LUTB_STRIDE + 32, T.sink[hq0] * LOG2E, 1.0f, T.sink[hq0 + 1] * LOG2E, 1.0f, wl, lane, oA, mA, lA, oB, mB, lB);
        bf16_t* ob0 = T.o + ((size_t)b * S + t0 + 32 * qt) * D + (8 + hq0) * HD;
        stage_o(oA, mA, lA, wl, lane);
#pragma unroll
        for (int i4 = 0; i4 < 4; ++i4) { const int qi = (lane >> 3) + 8 * i4, ch = lane & 7; *(u32x4*)(ob0 + (size_t)qi * D + ch * 8) = *(const LAS u32x4*)(wl + qi * 128 + ch * 16); }
        stage_o(oB, mB, lB, wl, lane);
#pragma unroll
        for (int i4 = 0; i4 < 4; ++i4) { const int qi = (lane >> 3) + 8 * i4, ch = lane & 7; *(u32x4*)(ob0 + HD + (size_t)qi * D + ch * 8) = *(const LAS u32x4*)(wl + qi * 128 + ch * 16); }
    }
}
}

#define XB_TMO      128
#define XB_XCNT(j)  (256  + 64 * (j))
#define XB_XSUB(j)  (1280 + 64 * (j))
#define XB_XGEN(j)  (2304 + 64 * (j))
#define XB_TOP      3328
#define XB_TOPGEN   3392
#define XCD_BAR_WORDS 3456
#define XB_SPIN_CAP (1u << 18)

__device__ __forceinline__ unsigned xb_ld(unsigned* p)              { return __hip_atomic_load(p, __ATOMIC_RELAXED, __HIP_MEMORY_SCOPE_AGENT); }
__device__ __forceinline__ unsigned xb_add(unsigned* p, unsigned v) { return __hip_atomic_fetch_add(p, v, __ATOMIC_RELAXED, __HIP_MEMORY_SCOPE_AGENT); }
__device__ __forceinline__ unsigned xb_xcc_id() { return (unsigned)__builtin_amdgcn_s_getreg((3 << 11) | 20) & 0xFu; }
#define XB_SPIN(cond, bar) do { unsigned _sp = 0; while (cond) { __builtin_amdgcn_s_sleep(1); \
    if ((++_sp & 255u) == 0u) { if (xb_ld(&(bar)[XB_TMO])) break; if (_sp > XB_SPIN_CAP) { atomicAdd(&(bar)[XB_TMO], 1u); break; } } } } while (0)

struct XcdBarrier {
    unsigned* bar; unsigned x;
    volatile LAS unsigned* st;
};

__device__ __forceinline__ XcdBarrier xcd_barrier_post(unsigned* bar, volatile LAS unsigned* st, unsigned& rank) {
    XcdBarrier b; b.bar = bar; b.x = xb_xcc_id(); b.st = st;
    if (threadIdx.x == 0) rank = xb_add(&bar[XB_XCNT(b.x)], 1u);
    return b;
}
__device__ __forceinline__ void xcd_barrier_complete(unsigned* bar, unsigned x, unsigned& nloc, unsigned& nx, unsigned& regular) {
    const unsigned G = gridDim.x * gridDim.y * gridDim.z;
    unsigned sum, cnt, mine, bad, sp = 0u;
    regular = 0u;
    for (;;) {
        sum = 0u; cnt = 0u; mine = 0u; bad = 0u;
#pragma unroll
        for (unsigned j = 0; j < 16; ++j) { const unsigned c = xb_ld(&bar[XB_XCNT(j)]); sum += c; cnt += (c > 0u) ? 1u : 0u; mine = (j == x) ? c : mine; bad |= (c != (j < 8u ? G / 8u : 0u)) ? 1u : 0u; }
        if (sum == G) { regular = (bad == 0u && G == 256u) ? 1u : 0u; break; }
        __builtin_amdgcn_s_sleep(1);
        if ((++sp & 255u) == 0u) { if (xb_ld(&bar[XB_TMO])) break; if (sp > XB_SPIN_CAP) { atomicAdd(&bar[XB_TMO], 1u); break; } }
    }
    nloc = mine > 0u ? mine : 1u; nx = cnt > 0u ? cnt : 1u;
}

__device__ __forceinline__ void xcd_barrier(const XcdBarrier& b, const bool is_t0) {
    asm volatile("s_waitcnt vmcnt(0)" ::: "memory");
    __syncthreads();
    if (is_t0) {
        unsigned* bar = b.bar;
        __builtin_amdgcn_s_waitcnt(0);
        unsigned nloc = b.st[0], nx = b.st[1];
        if (nloc == 0u) { unsigned reg; xcd_barrier_complete(bar, b.x, nloc, nx, reg); b.st[0] = nloc; b.st[1] = nx;
            b.st[2] = LOCAL_SEAMS ? reg : 0u; if (LOCAL_SEAMS && reg) b.st[3] = b.st[4] * 8u + b.x; }
        const unsigned old = xb_add(&bar[XB_XSUB(b.x)], 1u);
        const unsigned gen = old / nloc;
        if (old + 1u == (gen + 1u) * nloc) {
            __builtin_amdgcn_fence(__ATOMIC_RELEASE, "agent");
            asm volatile("s_waitcnt vmcnt(0)" ::: "memory");
            const unsigned og = xb_add(&bar[XB_TOP], 1u);
            const unsigned tg = og / nx;
            if (og + 1u == (tg + 1u) * nx) xb_add(&bar[XB_TOPGEN], 1u);
            else XB_SPIN(xb_ld(&bar[XB_TOPGEN]) == tg, bar);
            __builtin_amdgcn_fence(__ATOMIC_ACQUIRE, "agent");
            asm volatile("s_waitcnt vmcnt(0)" ::: "memory");
        } else {
            XB_SPIN(xb_ld(&bar[XB_TOPGEN]) == gen, bar);
            __builtin_amdgcn_fence(__ATOMIC_ACQUIRE, "agent");
            asm volatile("s_waitcnt vmcnt(0)" ::: "memory");
        }
    }
    __syncthreads();
}
#define XB_XLSUB(j) (3456 + 64 * (j))
#define XB_XLGEN(j) (4480 + 64 * (j))
__device__ __forceinline__ void xcd_local_barrier(const XcdBarrier& b, const bool is_t0) {
    asm volatile("s_waitcnt vmcnt(0)" ::: "memory");
    __syncthreads();
    if (is_t0) {
        unsigned* bar = b.bar;
        __builtin_amdgcn_s_waitcnt(0);
        const unsigned nloc = b.st[0];
        const unsigned old = xb_add(&bar[XB_XLSUB(b.x)], 1u);
        const unsigned gen = old / nloc;
        if (old + 1u == (gen + 1u) * nloc) xb_add(&bar[XB_XLGEN(b.x)], 1u);
        else XB_SPIN(xb_ld(&bar[XB_XLGEN(b.x)]) == gen, bar);
        __builtin_amdgcn_fence(__ATOMIC_ACQUIRE, "agent");
        asm volatile("s_waitcnt vmcnt(0)" ::: "memory");
    }
    __syncthreads();
}
typedef const float* cfptr_t; typedef float* fptr_t; typedef unsigned char* ucptr_t;
typedef __attribute__((address_space(4))) const unsigned char* kargp_t;
struct KA {
    kargp_t kp;
    __device__ __forceinline__ const float* in(int i) const { return *(__attribute__((address_space(4))) const cfptr_t*)(kp + 8 * i); }
    __device__ __forceinline__ float* out() const { return *(__attribute__((address_space(4))) const fptr_t*)(kp + 160); }
    __device__ __forceinline__ unsigned char* ws() const { return *(__attribute__((address_space(4))) const ucptr_t*)(kp + 168); }
    __device__ __forceinline__ int ph_lo() const { return *(__attribute__((address_space(4))) const int*)(kp + 176); }
    __device__ __forceinline__ int ph_hi() const { return *(__attribute__((address_space(4))) const int*)(kp + 180); }
};
static_assert(sizeof(Args) == 184, "Args layout");
#define FRESH_LANE() ({ int l_; asm volatile("v_mbcnt_lo_u32_b32 %0, -1, 0\n\tv_mbcnt_hi_u32_b32 %0, -1, %0" : "=v"(l_)); l_; })
template <int PH>
__device__ __forceinline__ void run_phase(const KA& a, LAS unsigned char* lds, const int wave0, const int rep) {
    const int G = gridDim.x, wave = wave0;
    int bx = blockIdx.x;
    if constexpr (PH != 0) bx = __builtin_amdgcn_readfirstlane((int)((volatile LAS unsigned*)(lds + LDS_BYTES - 64))[3]);
    const int vcu = (G % 8 == 0) ? (bx % 8) * (G / 8) + bx / 8 : bx;
    const int gw = vcu * NWAVES + wave, NGW = G * NWAVES;
    unsigned char* ws = a.ws();
    bf16_t* xb = (bf16_t*)(ws + WS_XB); float* ssp0 = (float*)(ws + WS_SSP); float* ssp1 = ssp0 + (size_t)M * 16;
    bf16_t* xb2 = (bf16_t*)(ws + WS_W);
    bf16_t* act = (bf16_t*)(ws + WS_R + R_ACT); bf16_t* ob = XLO ? (bf16_t*)(ws + WS_R + R_O) : (bf16_t*)a.out();
    bf16_t* pb = (bf16_t*)(ws + WS_PB); bf16_t* proj = (bf16_t*)(ws + WS_PROJ);
    const float cscale = rep == 0 ? 1.0f : 0.0f;
    if constexpr (PH == 0) {
        prologue_phase(a, lds, gw, NGW, wave, FRESH_LANE(), G == 256);
        convert_p(a.in(1), pb, bx * NWAVES * 64 + wave0 * 64 + FRESH_LANE(), G * NWAVES * 64);
        att::build_luts(a.in(2), (float*)(ws + WS_LUT), bx * NWAVES * 64 + wave0 * 64 + FRESH_LANE(), G * NWAVES * 64);
    } else {
        constexpr int l = (PH - 1) >> 3, k = (PH - 1) & 7;
        const bf16_t* wl = (const bf16_t*)(ws + WS_W) + (size_t)l * W_LAYER;
        bf16_t* lo_def = (bf16_t*)a.out(); bf16_t* lo_alt = xb2;
        const bf16_t* lin = (l == DEPTH - 1 && k == 7) ? lo_alt : lo_def; bf16_t* lout = (l == DEPTH - 1 && k == 6) ? lo_alt : lo_def;
        if constexpr (k == 0 || k == 5) {
            pg8::Gemm g{(k == 0 && l == 1) ? xb2 : xb, wl + (k == 0 ? WO_F1IN : WO_F2IN), M, 2 * DFF, D}; pg8::StaticOrder S; S.init(M, 2 * DFF, G, bx);
#if PROBE_NULL_EPI == 1
            if (rep > 0) { pg8::EpiNull E; pg8::gemm_phase<pg8::EpiNull, pg8::StaticOrder, true, true>(lds, g, S, E, wave0 * 64 + FRESH_LANE()); } else
#endif
            { pg8::EpiSwiglu E{act, ssp0, (PROBE_NULL_EPI >= 2 && rep > 0 && rep < PROBE_N) ? PROBE_NULL_EPI - 1 : 0};
            pg8::gemm_phase<pg8::EpiSwiglu, pg8::StaticOrder, true, true>(lds, g, S, E, wave0 * 64 + FRESH_LANE()); }
            if (G == 256 && bx >= 128 && rep == 0) {
                const int widx = (bx - 128) * NWAVES + wave, nw = 128 * NWAVES, lane = FRESH_LANE();
                if constexpr (k == 0) convert_weight_items(a, lds, l * I_LAYER + IT_FOUT1, IT_FIN2 - IT_FOUT1, widx, nw, wave, lane, l * I_LAYER + IT_WP, I_WP, l * I_LAYER + IT_FOUT2, I_FOUT);
                else { convert_weight_items(a, lds, l * I_LAYER + IT_WG, I_SQ, widx, nw, wave, lane, (l + 1) * I_LAYER + IT_FIN1, (l + 1 < DEPTH) ? I_FIN : 0);
                       if (l + 1 < DEPTH) {
                                            convert_p(a.in(1) + (size_t)(l + 1) * M * PLE, pb, widx * 64 + lane, nw * 64); } }
            }
        } else if constexpr (k == 1 || k == 6) {
            pg8::Gemm g{act, wl + (k == 1 ? WO_F1OUT : WO_F2OUT), M, D, DFF}; pg8::StaticOrder S; S.init(M, D, G, bx);
#if PROBE_NULL_EPI == 1
            if (rep > 0) { pg8::EpiNull E0; pg8::gemm_phase<pg8::EpiNull, pg8::StaticOrder, true, true>(lds, g, S, E0, wave0 * 64 + FRESH_LANE()); return; }
#endif
            pg8::EpiResid E{(k == 1 && l > 0 && rep == 0) ? xb2 : xb, lin, xb, lout, ssp1, 0.5f * cscale};
            pg8::gemm_phase<pg8::EpiResid, pg8::StaticOrder, true, true>(lds, g, S, E, wave0 * 64 + FRESH_LANE());
        } else if constexpr (k == 2) {
            { pg8::Gemm g{xb, wl + WO_QKV, M, QKVW, D}; pg8::StaticOrder S; S.init(M, QKVW, G, bx);
              pg8::EpiQkv E; E.ssp = ssp1;
              E.qa = (bf16_t*)(ws + WS_R + R_QA); E.ka = (bf16_t*)(ws + WS_R + R_KA); E.va = (bf16_t*)(ws + WS_R + R_VA);
              E.qb = (bf16_t*)(ws + WS_R + R_QB); E.kb = (bf16_t*)(ws + WS_R + R_KB); E.vb = (bf16_t*)(ws + WS_R + R_VB);
              E.qna = a.in(8) + l * HD; E.kna = a.in(9) + l * HD; E.qnb = a.in(10) + l * HD; E.knb = a.in(11) + l * HD;
              pg8::gemm_phase<pg8::EpiQkv, pg8::StaticOrder, true, true>(lds, g, S, E, wave0 * 64 + FRESH_LANE()); }
            if (G != 256 || bx >= 64) {
              pg8::Gemm g{pb, wl + WO_WP, M, D, PLE}; pg8::StaticOrder S; if (G == 256) S.init(M, D, 192, bx - 64); else S.init(M, D, G, bx);
              pg8::EpiStoreBf16 E{proj, D};
              pg8::gemm_phase<pg8::EpiStoreBf16, pg8::StaticOrder, true, true>(lds, g, S, E, wave0 * 64 + FRESH_LANE()); }
            if (G == 256 && bx >= 128 && rep == 0)
                convert_weight_items(a, lds, l * I_LAYER + IT_FIN2, I_FIN, (bx - 128) * NWAVES + wave, 128 * NWAVES, wave, FRESH_LANE());
        } else if constexpr (k == 3) {
            att::Tensors T; T.qa = (bf16_t*)(ws + WS_R + R_QA); T.ka = (bf16_t*)(ws + WS_R + R_KA); T.va = (bf16_t*)(ws + WS_R + R_VA);
            T.qb = (bf16_t*)(ws + WS_R + R_QB); T.kb = (bf16_t*)(ws + WS_R + R_KB); T.vb = (bf16_t*)(ws + WS_R + R_VB);
            T.glut = (const float*)(ws + WS_LUT); T.sink = a.in(12) + l * 8; T.o = ob;
            const int lane = FRESH_LANE();
            for (int u = vcu; u < 256; u += G) att::attn_unit(T, u, lds, wave, lane, (PROBE_ATT_MODE && rep > 0) ? PROBE_ATT_MODE : 0x33);
        } else if constexpr (k == 4) {
            if (G != 256 && l + 1 < DEPTH) { convert_p(a.in(1) + (size_t)(l + 1) * M * PLE, pb, bx * NWAVES * 64 + wave0 * 64 + FRESH_LANE(), G * NWAVES * 64); asm volatile("s_waitcnt vmcnt(0)" ::: "memory"); }
            pg8::Gemm g{ob, wl + WO_WO, M, D, D}; pg8::StaticOrder S; S.init(M, D, G, bx);
            pg8::EpiResid E{xb, lin, xb, lout, ssp0, 1.0f * cscale};
            pg8::gemm_phase<pg8::EpiResid, pg8::StaticOrder, true, true>(lds, g, S, E, wave0 * 64 + FRESH_LANE());
        } else {
            pg8::Gemm g{xb, wl + WO_WG, M, D, D}; pg8::StaticOrder S; S.init(M, D, G, bx);
            pg8::EpiGate E{xb, lin, xb2, lout, (l == DEPTH - 1) ? a.out() : nullptr, ssp0, ssp1, proj, cscale};
            pg8::gemm_phase<pg8::EpiGate, pg8::StaticOrder, true, true>(lds, g, S, E, wave0 * 64 + FRESH_LANE());
        }
    }
}

__global__ void __launch_bounds__(NWAVES * 64, 2) mk_fwd(Args) {
    extern __shared__ __attribute__((aligned(16))) unsigned char lds_raw[];
    LAS unsigned char* lds = (LAS unsigned char*)lds_raw;
    cg::grid_group grid = cg::this_grid();
    const int wave0 = __builtin_amdgcn_readfirstlane(threadIdx.x >> 6);
    volatile LAS unsigned* bst = (volatile LAS unsigned*)((LAS unsigned char*)lds_raw + LDS_BYTES - 64);
    if (threadIdx.x < 8) bst[threadIdx.x] = threadIdx.x == 3 ? blockIdx.x : 0u;
    __syncthreads();
    KA a; a.kp = (kargp_t)__builtin_amdgcn_kernarg_segment_ptr();
    const int ph_lo = a.ph_lo(), ph_hi = a.ph_hi();
    XcdBarrier xbar; xbar.bar = (unsigned*)(a.ws() + WS_CTL) + 4096; xbar.x = 0; xbar.st = bst;
    unsigned xrank = 0u;
    if (ph_hi - ph_lo > 1) xbar = xcd_barrier_post((unsigned*)(a.ws() + WS_CTL) + 4096, bst, xrank);
    if (ph_lo < 0) grid.sync();
#define MK_NREP(P) ((PROBE_N > 0 && (((P) == 0 && PROBE_K == 8) || ((P) > 0 && (((P) - 1) & 7) == PROBE_K))) ? 1 + PROBE_N : 1)
#define MK_LOCAL(P) (LOCAL_SEAMS && (P) > 0 && ((((P) - 1) & 7) == 4 || (((P) - 1) & 7) == 5 || ((((P) - 1) & 7) == 7 && (P) + 1 < NPHASE)))
#define MK_PHASE(P) if (ph_lo <= (P) && (P) < ph_hi) { _Pragma("unroll 1") for (int rep = 0; rep < MK_NREP(P); ++rep) { asm volatile("" : "+s"(a.kp)); run_phase<(P)>(a, lds, wave0, rep); \
        if ((P) == 0 && rep == 0 && threadIdx.x == 0) bst[4] = xrank; \
        if ((P) + 1 < ph_hi || rep + 1 < MK_NREP(P)) { if (USE_CG_SYNC && (P) == 0) grid.sync(); else if (MK_LOCAL(P) && rep + 1 == MK_NREP(P) && bst[2] != 0u) xcd_local_barrier(xbar, wave0 == 0 && FRESH_LANE() == 0); else xcd_barrier(xbar, wave0 == 0 && FRESH_LANE() == 0); } } }
    MK_PHASE(0) MK_PHASE(1) MK_PHASE(2) MK_PHASE(3) MK_PHASE(4) MK_PHASE(5) MK_PHASE(6) MK_PHASE(7) MK_PHASE(8)
    MK_PHASE(9) MK_PHASE(10) MK_PHASE(11) MK_PHASE(12) MK_PHASE(13) MK_PHASE(14) MK_PHASE(15) MK_PHASE(16)
    static_assert(NPHASE == 17, "phase program");
}

constexpr size_t CTL_BYTES = 64 * 1024;
static_assert((4096 + 4480 + 64 * 16) * 4 <= CTL_BYTES, "barrier words inside the per-call memset");
extern "C" void kernel_launch(void* const* d_in, const int* in_sizes, int n_in, void* d_out, int out_size, void* d_ws, size_t ws_size, hipStream_t stream) {
    static int grid = 0;
    if (grid == 0) {
        if (n_in != 20 || in_sizes[0] != M * D || out_size != M * D || ws_size < WS_END) { fprintf(stderr, "kernel_launch: unexpected shapes (n_in %d, ws %zu)\n", n_in, ws_size); grid = -1; return; }
        int dev = 0, cus = 0, per_cu = 0;
        if (hipGetDevice(&dev) != hipSuccess || hipDeviceGetAttribute(&cus, hipDeviceAttributeMultiprocessorCount, dev) != hipSuccess) { grid = -1; return; }
        if (hipFuncSetAttribute((const void*)mk_fwd, hipFuncAttributeMaxDynamicSharedMemorySize, LDS_BYTES) != hipSuccess) { fprintf(stderr, "kernel_launch: hipFuncSetAttribute failed\n"); grid = -1; return; }
        if (hipOccupancyMaxActiveBlocksPerMultiprocessor(&per_cu, (const void*)mk_fwd, NWAVES * 64, LDS_BYTES) != hipSuccess || per_cu < 1) { fprintf(stderr, "kernel_launch: occupancy query says %d\n", per_cu); grid = -1; (void)hipGetLastError(); return; }
        grid = cus;
    }
    if (grid < 0) return;
    (void)hipMemsetAsync((char*)d_ws + WS_CTL, 0, CTL_BYTES, stream);
    Args a{};
    for (int i = 0; i < 20; ++i) a.in[i] = (const float*)d_in[i];
    a.out = (float*)d_out; a.ws = (unsigned char*)d_ws;
    a.ph_lo = 0; a.ph_hi = NPHASE;
    void* args[] = {&a};
    hipError_t e = hipLaunchCooperativeKernel((const void*)mk_fwd, dim3(grid), dim3(NWAVES * 64), args, LDS_BYTES, stream);
    if (e != hipSuccess) fprintf(stderr, "kernel_launch: cooperative launch failed: %s (grid %d)\n", hipGetErrorString(e), grid);
}
```

```cpp
#include <hip/hip_runtime.h>
#include <cstdio>
#include <cstdint>
#ifndef PROBE_N
#define PROBE_N 0
#define PROBE_K -1
#endif
#ifndef ATT_ORDER
#define ATT_ORDER 0
#endif
#ifndef PROBE_ATT_MODE
#define PROBE_ATT_MODE 0
#endif
#ifndef USE_CG_SYNC
#define USE_CG_SYNC 0
#endif
#ifndef PROBE_NULL_EPI
#define PROBE_NULL_EPI 0
#endif
#ifndef D16_MODE
#define D16_MODE 1
#endif
#ifndef XLO
#define XLO 0
#define LOCAL_SEAMS 1
#define EARLY_INV 1
#endif

typedef unsigned short bf16_t;
constexpr int NB = 4, S = 4096, D = 1024, M = NB * S, DFF = 2816, QKVW = 2304, PLE = 256, DEPTH = 2, HD = 64;
constexpr float EPS = 1e-6f;
constexpr float QSCALE = 0.125f * 1.4426950408889634f;
constexpr float LOG2E = 1.4426950408889634f;

constexpr size_t MiB = 1u << 20;
constexpr size_t WS_CTL = 0, WS_W = 1 * MiB, WS_XB = 85 * MiB, WS_R = 117 * MiB, WS_PB = 221 * MiB, WS_PROJ = 229 * MiB, WS_SSP = 261 * MiB, WS_END = 263 * MiB + 512 * 1024;
constexpr size_t WS_LUT = 263 * MiB;
constexpr size_t R_QA = 0, R_KA = 16 * MiB, R_VA = 32 * MiB, R_QB = 48 * MiB, R_KB = 64 * MiB, R_VB = 68 * MiB, R_O = 72 * MiB, R_ACT = 0;

__device__ __forceinline__ float bf2f(bf16_t v) { return __uint_as_float(((unsigned)v) << 16); }
__device__ __forceinline__ bf16_t f2bf(float f) { unsigned u = __float_as_uint(f); return (bf16_t)((u + 0x7fffu + ((u >> 16) & 1u)) >> 16); }

namespace pg8 {
#define PG8_LAS __attribute__((address_space(3)))
typedef unsigned short bf16_t;
typedef short bf16x8 __attribute__((ext_vector_type(8)));
typedef float f32x4 __attribute__((ext_vector_type(4)));
typedef unsigned u32x4 __attribute__((ext_vector_type(4)));
constexpr int BM = 256, BK = 64, HALF = 128, HTB = HALF * BK * 2  , STAGE_BYTES = 8 * HTB, NXCD = 8, WGM = 8;

__host__ __device__ __forceinline__ int lds_byte(int r, int c) { const int st = (r >> 4) * 2 + (c >> 5), rr = r & 15, cc = c & 31, ob = rr * 64 + cc * 2; return st * 1024 + (ob ^ (((ob >> 9) & 1) << 5)); }
__host__ __device__ __forceinline__ void stage_rc(int b, int& R, int& C) { const int st = b / 1024, sb = b % 1024, swz = sb ^ (((sb >> 9) & 1) << 5); R = (st >> 1) * 16 + swz / 64; C = (st & 1) * 32 + (swz % 64) / 2; }
__host__ __device__ __forceinline__ int perm32(int rho) { const int n = rho >> 4, i = rho & 15; return 8 * (i >> 2) + 4 * n + (i & 3); }

struct Unit { int pm, pn; };
struct Gemm { const bf16_t* A; const bf16_t* Bt; int M, N, K; };

struct StaticOrder {
    int nM, nN, nwg, G, c;
    __host__ __device__ void init(int M, int N, int G_, int c_) { nM = M / BM; nN = N / BM; nwg = nM * nN; G = G_; c = c_; }
    __host__ __device__ bool next(int i, Unit& u) const {
        const long L = (long)i * G + c; if (L >= nwg) return false;
        int wgid = (int)L; { const int q = nwg / NXCD, r = nwg % NXCD, xcd = wgid % NXCD, off = wgid / NXCD; wgid = (xcd < r ? xcd * (q + 1) : r * (q + 1) + (xcd - r) * q) + off; }
        const int nig = WGM * nN, gid = wgid / nig, fm = gid * WGM, gsz = (nM - fm) < WGM ? (nM - fm) : WGM;
        u.pm = fm + ((wgid % nig) % gsz); u.pn = (wgid % nig) / gsz; return true;
    }
    __device__ __forceinline__ void a_ready(const Unit&) const {}
    __device__ __forceinline__ void done(const Unit&) const {}
};

__device__ __forceinline__ unsigned cvt_pk_bf16(float lo, float hi) { unsigned r; asm volatile("v_cvt_pk_bf16_f32 %0, %1, %2" : "=v"(r) : "v"(lo), "v"(hi)); return r; }
typedef float f32x2 __attribute__((ext_vector_type(2)));
template <class Epi, class Sched, bool ALIGN_EPI = false, bool SP2 = false>
__device__ __forceinline__ void gemm_phase(PG8_LAS unsigned char* lds, const Gemm g, const Sched& S, const Epi& E, const int tid) {
    const int wid = __builtin_amdgcn_readfirstlane(tid >> 6), lane = tid & 63, wr = wid >> 2, wc = wid & 3, fr = lane & 15, fq = lane >> 4;
    const int K = g.K, nt = K / BK;
    unsigned voffA[2], voffB[2];
#pragma unroll
    for (int i = 0; i < 2; ++i) { int R, C; stage_rc(tid * 16 + i * 8192, R, C); const int Rb = Epi::PERM ? ((R & ~31) + perm32(R & 31)) : R;
        voffA[i] = (unsigned)(R * K + C) * 2u; voffB[i] = (unsigned)(Rb * K + C) * 2u; }
    const size_t kstep = (size_t)(BK * 2);
    const size_t hstep = (size_t)HALF * K * 2;
    const size_t tstep = 2 * hstep;
    const unsigned ldsw = (unsigned)wid * 1024u;
    const int aoff = lds_byte(wr * 64 + fr, fq * 8), boff = lds_byte(wc * 32 + fr, fq * 8);
#define PG8_SA(b, h) (((b) * 2 + (h)) * HTB)
#define PG8_SB(b, h) ((4 + (b) * 2 + (h)) * HTB)
#define PG8_STAGE(bufoff, gbase, voff) do { _Pragma("unroll") for (int _i = 0; _i < 2; ++_i) \
        __builtin_amdgcn_global_load_lds((const unsigned*)((const char*)(gbase) + (voff)[_i]), (PG8_LAS unsigned*)(lds + (bufoff) + ldsw + _i * 8192), 16, 0, 0); } while (0)
#define PG8_LDA(dst, b, h) do { _Pragma("unroll") for (int m = 0; m < 4; ++m) _Pragma("unroll") for (int k = 0; k < 2; ++k) dst[m][k] = *(const PG8_LAS bf16x8*)(lds + PG8_SA(b, h) + aoff + m * 2048 + k * 1024); } while (0)
#define PG8_LDB(dst, b, h) do { _Pragma("unroll") for (int n = 0; n < 2; ++n) _Pragma("unroll") for (int k = 0; k < 2; ++k) dst[n][k] = *(const PG8_LAS bf16x8*)(lds + PG8_SB(b, h) + boff + n * 2048 + k * 1024); } while (0)
#define PG8_MMA(ai, bj, At, Bt) do { __builtin_amdgcn_s_setprio(1); _Pragma("unroll") for (int m = 0; m < 4; ++m) _Pragma("unroll") for (int n = 0; n < 2; ++n) _Pragma("unroll") for (int k = 0; k < 2; ++k) \
        acc[ai][bj][m][n] = __builtin_amdgcn_mfma_f32_16x16x32_bf16(Bt[n][k], At[m][k], acc[ai][bj][m][n], 0, 0, 0); __builtin_amdgcn_s_setprio(0); } while (0)
#define PG8_WAIT_V(n) asm volatile("s_waitcnt vmcnt(" #n ")" ::: "memory")
#define PG8_WAIT_L(n) asm volatile("s_waitcnt lgkmcnt(" #n ")" ::: "memory")
#define PG8_BAR __builtin_amdgcn_s_barrier()
#define PG8_SCHED __builtin_amdgcn_sched_barrier(0)
    Unit cur, nxt; int ui = 0;
    if (!S.next(0, cur)) return;
    f32x4 acc[2][2][4][2];
#pragma unroll
    for (int a = 0; a < 2; ++a)
#pragma unroll
        for (int b = 0; b < 2; ++b)
#pragma unroll
            for (int m = 0; m < 4; ++m)
#pragma unroll
                for (int n = 0; n < 2; ++n) acc[a][b][m][n] = (f32x4){0.f, 0.f, 0.f, 0.f};
    bf16x8 At[4][2], B0[2][2], B1[2][2];
    const char* cA = (const char*)g.A + (size_t)cur.pm * tstep; const char* cB = (const char*)g.Bt + (size_t)cur.pn * tstep;
    S.a_ready(cur);
    if constexpr (SP2) {
        PG8_STAGE(PG8_SB(0, 0), cB, voffB); PG8_STAGE(PG8_SB(0, 1), cB + hstep, voffB); PG8_STAGE(PG8_SA(0, 0), cA, voffA); PG8_STAGE(PG8_SA(0, 1), cA + hstep, voffA);
        if constexpr (Epi::HAS_PRE) E.pre(cur, tid, lds);
        if (wr == 1) PG8_BAR;
        PG8_WAIT_V(2); PG8_BAR;
        PG8_STAGE(PG8_SB(1, 0), cB + kstep, voffB); PG8_STAGE(PG8_SA(1, 0), cA + kstep, voffA); PG8_STAGE(PG8_SB(1, 1), cB + hstep + kstep, voffB);
        PG8_WAIT_V(6); PG8_BAR;
    } else {
        PG8_STAGE(PG8_SB(0, 0), cB, voffB); PG8_STAGE(PG8_SA(0, 0), cA, voffA); PG8_STAGE(PG8_SB(0, 1), cB + hstep, voffB); PG8_STAGE(PG8_SA(0, 1), cA + hstep, voffA);
        if (wr == 1) PG8_BAR;
        PG8_WAIT_V(4); PG8_BAR;
        PG8_STAGE(PG8_SB(1, 0), cB + kstep, voffB); PG8_STAGE(PG8_SA(1, 0), cA + kstep, voffA); PG8_STAGE(PG8_SB(1, 1), cB + hstep + kstep, voffB);
        PG8_WAIT_V(6); PG8_BAR;
    }
    for (;;) {
        const bool has_next = S.next(ui + 1, nxt);
        const char* nA = has_next ? (const char*)g.A + (size_t)nxt.pm * tstep : cA; const char* nB = has_next ? (const char*)g.Bt + (size_t)nxt.pn * tstep : cB;
        for (int t = 0; t < nt; t += 2) {
            const bool last = (t == nt - 2);
            const char* a1 = cA + (size_t)(t + 1) * kstep;
            const char* a2 = last ? nA : cA + (size_t)(t + 2) * kstep; const char* b2 = last ? nB : cB + (size_t)(t + 2) * kstep;
            const char* a3 = a2 + kstep; const char* b3 = b2 + kstep;
            if (last && has_next) S.a_ready(nxt);
            if constexpr (SP2) {
            PG8_LDB(B0, 0, 0); PG8_LDB(B1, 0, 1); PG8_SCHED; PG8_LDA(At, 0, 0); PG8_STAGE(PG8_SA(1, 1), a1 + hstep, voffA);
            PG8_WAIT_V(8); PG8_WAIT_L(0); PG8_BAR; PG8_MMA(0, 0, At, B0); PG8_MMA(0, 1, At, B1); PG8_BAR; PG8_SCHED;
            PG8_LDA(At, 0, 1); PG8_STAGE(PG8_SB(0, 0), b2, voffB); PG8_STAGE(PG8_SB(0, 1), b2 + hstep, voffB); PG8_STAGE(PG8_SA(0, 0), a2, voffA);
            PG8_WAIT_V(8); PG8_WAIT_L(0); PG8_BAR; PG8_MMA(1, 0, At, B0); PG8_MMA(1, 1, At, B1); PG8_BAR; PG8_SCHED;
            PG8_LDB(B0, 1, 0); PG8_LDB(B1, 1, 1); PG8_SCHED; PG8_LDA(At, 1, 0); PG8_STAGE(PG8_SA(0, 1), a2 + hstep, voffA);
            PG8_WAIT_V(8); PG8_WAIT_L(0); PG8_BAR; PG8_MMA(0, 0, At, B0); PG8_MMA(0, 1, At, B1); PG8_BAR; PG8_SCHED;
            PG8_LDA(At, 1, 1); PG8_STAGE(PG8_SB(1, 0), b3, voffB); PG8_STAGE(PG8_SB(1, 1), b3 + hstep, voffB); PG8_STAGE(PG8_SA(1, 0), a3, voffA);
            PG8_WAIT_V(8); PG8_WAIT_L(0); PG8_BAR; PG8_MMA(1, 0, At, B0); PG8_MMA(1, 1, At, B1); PG8_BAR; PG8_SCHED;
            } else {
            PG8_LDB(B0, 0, 0); PG8_SCHED; PG8_LDA(At, 0, 0); PG8_STAGE(PG8_SA(1, 1), a1 + hstep, voffA);
            PG8_WAIT_L(8); PG8_BAR; PG8_WAIT_L(0); PG8_MMA(0, 0, At, B0); PG8_BAR; PG8_SCHED;
            PG8_LDB(B1, 0, 1); PG8_STAGE(PG8_SB(0, 0), b2, voffB);
            PG8_BAR; PG8_WAIT_L(0); PG8_MMA(0, 1, At, B1); PG8_BAR;
            PG8_LDA(At, 0, 1); PG8_STAGE(PG8_SA(0, 0), a2, voffA);
            PG8_BAR; PG8_WAIT_L(0); PG8_MMA(1, 0, At, B0); PG8_BAR; PG8_SCHED;
            PG8_STAGE(PG8_SB(0, 1), b2 + hstep, voffB);
            PG8_WAIT_V(6); PG8_BAR; PG8_MMA(1, 1, At, B1); PG8_BAR;
            PG8_LDB(B0, 1, 0); PG8_SCHED; PG8_LDA(At, 1, 0); PG8_STAGE(PG8_SA(0, 1), a2 + hstep, voffA);
            PG8_WAIT_L(8); PG8_BAR; PG8_WAIT_L(0); PG8_MMA(0, 0, At, B0); PG8_BAR; PG8_SCHED;
            PG8_LDB(B1, 1, 1); PG8_STAGE(PG8_SB(1, 0), b3, voffB);
            PG8_BAR; PG8_WAIT_L(0); PG8_MMA(0, 1, At, B1); PG8_BAR;
            PG8_LDA(At, 1, 1); PG8_STAGE(PG8_SA(1, 0), a3, voffA);
            PG8_BAR; PG8_WAIT_L(0); PG8_MMA(1, 0, At, B0); PG8_BAR; PG8_SCHED;
            PG8_STAGE(PG8_SB(1, 1), b3 + hstep, voffB);
            PG8_WAIT_V(6); PG8_BAR; PG8_MMA(1, 1, At, B1); PG8_BAR;
            }
        }
        if constexpr (ALIGN_EPI) { if (wr == 0) PG8_BAR; }
        if constexpr (!Epi::AFTER_DRAIN) { int l2_; asm volatile("v_mbcnt_lo_u32_b32 %0, -1, 0\n\tv_mbcnt_hi_u32_b32 %0, -1, %0" : "=v"(l2_)); if constexpr (Epi::HAS_PRE) E(acc, cur, wr, wc, l2_ & 15, l2_ >> 4, lds); else E(acc, cur, wr, wc, l2_ & 15, l2_ >> 4); S.done(cur); }
        if (!has_next) break;
#pragma unroll
        for (int a = 0; a < 2; ++a)
#pragma unroll
            for (int b = 0; b < 2; ++b)
#pragma unroll
                for (int m = 0; m < 4; ++m)
#pragma unroll
                    for (int n = 0; n < 2; ++n) acc[a][b][m][n] = (f32x4){0.f, 0.f, 0.f, 0.f};
        cur = nxt; cA = nA; cB = nB; ++ui;
        if constexpr (ALIGN_EPI) { if (wr == 1) PG8_BAR; }
    }
    PG8_WAIT_V(0);
    if constexpr (!ALIGN_EPI) { if (wr == 0) PG8_BAR; }
    PG8_BAR;
    if constexpr (Epi::AFTER_DRAIN) { E.fused(acc, cur, wr, wc, fr, fq, lds, wid, lane); S.done(cur); }
#undef PG8_SA
#undef PG8_SB
#undef PG8_STAGE
#undef PG8_LDA
#undef PG8_LDB
#undef PG8_MMA
#undef PG8_WAIT_V
#undef PG8_WAIT_L
#undef PG8_BAR
#undef PG8_SCHED
}
}

namespace pg8 {
typedef float f32x2 __attribute__((ext_vector_type(2)));
__device__ __forceinline__ float shx(float v, int lane, int mask) { return __int_as_float(__builtin_amdgcn_ds_bpermute((lane ^ mask) << 2, __float_as_int(v))); }
__device__ __forceinline__ float rstd16(const float* ssp, int row, int fq, int lane) {
    const f32x4 v = *(const f32x4*)(ssp + (size_t)row * 16 + 4 * fq);
    float s = (v[0] + v[1]) + (v[2] + v[3]);
    s += shx(s, lane, 16); s += shx(s, lane, 32);
    return __builtin_amdgcn_rsqf(s * (1.0f / 1024.0f) + 1e-6f);
}
__device__ __forceinline__ f32x4 rstd_ld(const float* ssp, int row, int fq) { return *(const f32x4*)(ssp + (size_t)row * 16 + 4 * fq); }
__device__ __forceinline__ float rstd_fin(const f32x4& v, int lane) { float s = (v[0] + v[1]) + (v[2] + v[3]); s += shx(s, lane, 16); s += shx(s, lane, 32); return __builtin_amdgcn_rsqf(s * (1.0f / 1024.0f) + 1e-6f); }
__device__ __forceinline__ float sigm(float v) { return __builtin_amdgcn_rcpf(1.0f + __builtin_amdgcn_exp2f(-1.4426950408889634f * v)); }
__device__ __forceinline__ u32x4 pack8(const f32x4& a, const f32x4& b) { u32x4 w; w.x = cvt_pk_bf16(a[0], a[1]); w.y = cvt_pk_bf16(a[2], a[3]); w.z = cvt_pk_bf16(b[0], b[1]); w.w = cvt_pk_bf16(b[2], b[3]); return w; }
__device__ __forceinline__ float bflo(unsigned w) { return __uint_as_float(w << 16); }
__device__ __forceinline__ float bfhi(unsigned w) { return __uint_as_float(w & 0xffff0000u); }

constexpr int EPI_TAB = 131072 + 4096;
__device__ __forceinline__ void rstd_table(const float* ssp, int pm, PG8_LAS float* rst, int tid) {
    const int r = tid >> 1, hf = tid & 1;
    const float* p = ssp + (size_t)(pm * BM + r) * 16 + hf * 8;
    const f32x4 a = *(const f32x4*)p, b = *(const f32x4*)(p + 4);
    float s = ((a[0] + a[1]) + (a[2] + a[3])) + ((b[0] + b[1]) + (b[2] + b[3]));
    s += shx(s, tid & 63, 1);
    if (hf == 0) rst[r] = __builtin_amdgcn_rsqf(s * (1.0f / 1024.0f) + 1e-6f);
    if (tid == 0) ((PG8_LAS int*)rst)[512] = pm;
    asm volatile("s_waitcnt lgkmcnt(0)" ::: "memory");
}
__device__ __forceinline__ int rstd_table_pm(PG8_LAS float* rst) { int v; const unsigned a = (unsigned)(uintptr_t)rst; asm volatile("ds_read_b32 %0, %1 offset:2048\n\ts_waitcnt lgkmcnt(0)" : "=v"(v) : "v"(a) : "memory"); return __builtin_amdgcn_readfirstlane(v); }
__device__ __forceinline__ void rstd_table_rd(PG8_LAS float* rst, int wr, int fr, float (&rsv)[8]) {
    const unsigned ra = (unsigned)(uintptr_t)rst + 4u * (unsigned)(wr * 64 + fr);
    asm volatile("ds_read_b32 %0, %1" : "=v"(rsv[0]) : "v"(ra) : "memory");            asm volatile("ds_read_b32 %0, %1 offset:64" : "=v"(rsv[1]) : "v"(ra) : "memory");
    asm volatile("ds_read_b32 %0, %1 offset:128" : "=v"(rsv[2]) : "v"(ra) : "memory"); asm volatile("ds_read_b32 %0, %1 offset:192" : "=v"(rsv[3]) : "v"(ra) : "memory");
    asm volatile("ds_read_b32 %0, %1 offset:512" : "=v"(rsv[4]) : "v"(ra) : "memory"); asm volatile("ds_read_b32 %0, %1 offset:576" : "=v"(rsv[5]) : "v"(ra) : "memory");
    asm volatile("ds_read_b32 %0, %1 offset:640" : "=v"(rsv[6]) : "v"(ra) : "memory"); asm volatile("ds_read_b32 %0, %1 offset:704" : "=v"(rsv[7]) : "v"(ra) : "memory");
}
struct EpiSwiglu {
    static constexpr bool PERM = true, AFTER_DRAIN = false, HAS_PRE = true;
    bf16_t* act; const float* ssp; int mode;
    __device__ __forceinline__ void pre(const Unit& u, int tid, PG8_LAS unsigned char* lds) const { rstd_table(ssp, u.pm, (PG8_LAS float*)(lds + EPI_TAB), tid); }
    __device__ __forceinline__ void operator()(const f32x4 (&acc)[2][2][4][2], const Unit& u, int wr, int wc, int fr, int fq, PG8_LAS unsigned char* lds) const {
        PG8_LAS float* rst = (PG8_LAS float*)(lds + EPI_TAB); const int pre_pm = rstd_table_pm(rst);
        const int lane = fr + 16 * fq;
        const int row0 = u.pm * BM + wr * 64 + fr, col0 = u.pn * 128 + wc * 32 + 8 * fq;
        float rsv[8];
        if (u.pm == pre_pm) {
          rstd_table_rd(rst, wr, fr, rsv);
          asm volatile("s_waitcnt lgkmcnt(0)" : "+v"(rsv[0]), "+v"(rsv[1]), "+v"(rsv[2]), "+v"(rsv[3]), "+v"(rsv[4]), "+v"(rsv[5]), "+v"(rsv[6]), "+v"(rsv[7]) :: "memory");
        } else
        { f32x4 t8[8];
#pragma unroll
          for (int g = 0; g < 8; ++g) t8[g] = rstd_ld(ssp, row0 + (g >> 2) * HALF + (g & 3) * 16, fq);
#pragma unroll
          for (int g = 0; g < 8; ++g) rsv[g] = rstd_fin(t8[g], lane); }
        asm volatile("" ::: "memory");
#pragma unroll
        for (int ai = 0; ai < 2; ++ai)
#pragma unroll
            for (int m = 0; m < 4; ++m) { const int row = row0 + ai * HALF + m * 16; const float rs = rsv[ai * 4 + m];
                f32x4 o[2];
                const f32x2 c1 = {-1.4426950408889634f * rs, -1.4426950408889634f * rs}, rs2 = {rs * rs, rs * rs}, one = {1.0f, 1.0f};
#pragma unroll
                for (int n = 0; n < 2; ++n)
#pragma unroll
                    for (int j = 0; j < 4; j += 2) { const f32x2 g = {acc[ai][0][m][n][j], acc[ai][0][m][n][j + 1]}, up = {acc[ai][1][m][n][j], acc[ai][1][m][n][j + 1]};
                        f32x2 e = c1 * g; e.x = __builtin_amdgcn_exp2f(e.x); e.y = __builtin_amdgcn_exp2f(e.y);
                        f32x2 d = one + e; d.x = __builtin_amdgcn_rcpf(d.x); d.y = __builtin_amdgcn_rcpf(d.y);
                        const f32x2 r = (PROBE_NULL_EPI && mode == 2) ? g + up : (g * up) * (rs2 * d);
                        o[n][j] = r.x; o[n][j + 1] = r.y; }
                const u32x4 w = pack8(o[0], o[1]);
                if (PROBE_NULL_EPI && mode == 1) asm volatile("" :: "v"(w)); else *(u32x4*)(act + (size_t)row * 2816 + col0) = w; }
    }
};
__device__ __forceinline__ void unpack8(const u32x4& w, f32x4& a, f32x4& b) { a = (f32x4){bflo(w.x), bfhi(w.x), bflo(w.y), bfhi(w.y)}; b = (f32x4){bflo(w.z), bfhi(w.z), bflo(w.w), bfhi(w.w)}; }
__device__ __forceinline__ void split8(const f32x4& x0, const f32x4& x1, u32x4& hi, u32x4& lo) {
    hi = pack8(x0, x1); f32x4 h0, h1; unpack8(hi, h0, h1); lo = pack8(x0 - h0, x1 - h1);
}
struct EpiResid {
    static constexpr bool PERM = true, AFTER_DRAIN = false, HAS_PRE = false;
    const bf16_t* hin; const bf16_t* lin; bf16_t* hout; bf16_t* lout; float* sspw; float coef;
    __device__ __forceinline__ void operator()(const f32x4 (&acc)[2][2][4][2], const Unit& u, int wr, int wc, int fr, int fq) const {
        const int lane = fr + 16 * fq;
        float cf = __uint_as_float(__builtin_amdgcn_readfirstlane(__float_as_uint(coef))); asm volatile("" : "+s"(cf));
        const int row0 = u.pm * BM + wr * 64 + fr, col0 = u.pn * BM + wc * 32 + 8 * fq;
        u32x4 xh[3][2], xl[3][2];
#define RES_LOAD(g, sl) do { _Pragma("unroll") for (int bj = 0; bj < 2; ++bj) { const size_t off_ = (size_t)(row0 + ((g) >> 2) * HALF + ((g) & 3) * 16) * 1024 + col0 + bj * HALF; \
            xh[sl][bj] = *(const u32x4*)(hin + off_); if (XLO) xl[sl][bj] = *(const u32x4*)(lin + off_); else xl[sl][bj] = (u32x4){0u, 0u, 0u, 0u}; } } while (0)
        RES_LOAD(0, 0); RES_LOAD(1, 1);
#pragma unroll
        for (int g = 0; g < 8; ++g) { const int ai = g >> 2, m = g & 3, sl = g % 3, row = row0 + ai * HALF + m * 16; float ss = 0.f;
            if (g + 2 < 8) RES_LOAD(g + 2, (g + 2) % 3);
            asm volatile("" ::: "memory");
#pragma unroll
            for (int bj = 0; bj < 2; ++bj) { const size_t off = (size_t)row * 1024 + col0 + bj * HALF;
                f32x4 h0, h1, l0, l1; unpack8(xh[sl][bj], h0, h1); unpack8(xl[sl][bj], l0, l1);
                const f32x4 x0 = (h0 + l0) + acc[ai][bj][m][0] * cf, x1 = (h1 + l1) + acc[ai][bj][m][1] * cf;
                u32x4 nh, nl; split8(x0, x1, nh, nl);
                *(u32x4*)(hout + off) = nh; if (XLO) *(u32x4*)(lout + off) = nl;
                ss += (x0[0] * x0[0] + x0[1] * x0[1]) + (x0[2] * x0[2] + x0[3] * x0[3]) + (x1[0] * x1[0] + x1[1] * x1[1]) + (x1[2] * x1[2] + x1[3] * x1[3]); }
            ss += shx(ss, lane, 16); ss += shx(ss, lane, 32);
            if (fq == 0) sspw[(size_t)row * 16 + u.pn * 4 + wc] = ss;
            asm volatile("" ::: "memory"); }
#undef RES_LOAD
    }
};
struct EpiGate {
    static constexpr bool PERM = true, AFTER_DRAIN = false, HAS_PRE = false;
    const bf16_t* hin; const bf16_t* lin; bf16_t* hout; bf16_t* lout; float* fout; float* sspw; const float* sspr; const bf16_t* proj; float coef;
    __device__ __forceinline__ void operator()(const f32x4 (&acc)[2][2][4][2], const Unit& u, int wr, int wc, int fr, int fq) const {
        const int lane = fr + 16 * fq;
        float cf = __uint_as_float(__builtin_amdgcn_readfirstlane(__float_as_uint(coef))); asm volatile("" : "+s"(cf));
        const int row0 = u.pm * BM + wr * 64 + fr, col0 = u.pn * BM + wc * 32 + 8 * fq;
        u32x4 xh[2][2], xl[2][2], pw[2][2]; f32x4 rsn[2];
#define GATE_LOAD(g, sl) do { _Pragma("unroll") for (int bj = 0; bj < 2; ++bj) { const size_t off_ = (size_t)(row0 + ((g) >> 2) * HALF + ((g) & 3) * 16) * 1024 + col0 + bj * HALF; \
            xh[sl][bj] = *(const u32x4*)(hin + off_); if (XLO) xl[sl][bj] = *(const u32x4*)(lin + off_); else xl[sl][bj] = (u32x4){0u, 0u, 0u, 0u}; pw[sl][bj] = *(const u32x4*)(proj + off_); } \
            rsn[sl] = rstd_ld(sspr, row0 + ((g) >> 2) * HALF + ((g) & 3) * 16, fq); } while (0)
        GATE_LOAD(0, 0);
#pragma unroll
        for (int g = 0; g < 8; ++g) { const int ai = g >> 2, m = g & 3, sl = g & 1, row = row0 + ai * HALF + m * 16; float ss = 0.f;
            if (g + 1 < 8) GATE_LOAD(g + 1, (g + 1) & 1);
            asm volatile("" ::: "memory");
            const float rsg = rstd_fin(rsn[sl], lane);
#pragma unroll
            for (int bj = 0; bj < 2; ++bj) { const size_t off = (size_t)row * 1024 + col0 + bj * HALF;
                f32x4 h0, h1, l0, l1, p0, p1; unpack8(xh[sl][bj], h0, h1); unpack8(xl[sl][bj], l0, l1); unpack8(pw[sl][bj], p0, p1);
                f32x4 x0 = h0 + l0, x1 = h1 + l1;
#pragma unroll
                for (int j = 0; j < 4; ++j) { x0[j] += cf * (sigm(acc[ai][bj][m][0][j] * rsg) * p0[j]); x1[j] += cf * (sigm(acc[ai][bj][m][1][j] * rsg) * p1[j]); }
                if (fout) { *(f32x4*)(fout + off) = x0; *(f32x4*)(fout + off + 4) = x1; }
                else { u32x4 nh, nl; split8(x0, x1, nh, nl); *(u32x4*)(hout + off) = nh; if (XLO) *(u32x4*)(lout + off) = nl;
                    ss += (x0[0] * x0[0] + x0[1] * x0[1]) + (x0[2] * x0[2] + x0[3] * x0[3]) + (x1[0] * x1[0] + x1[1] * x1[1]) + (x1[2] * x1[2] + x1[3] * x1[3]); } }
            if (!fout) { ss += shx(ss, lane, 16); ss += shx(ss, lane, 32);
                if (fq == 0) sspw[(size_t)row * 16 + u.pn * 4 + wc] = ss; }
            asm volatile("" ::: "memory"); }
#undef GATE_LOAD
    }
};
struct EpiStoreBf16 {
    static constexpr bool PERM = true, AFTER_DRAIN = false, HAS_PRE = false;
    bf16_t* O; int ldc;
    __device__ __forceinline__ void operator()(const f32x4 (&acc)[2][2][4][2], const Unit& u, int wr, int wc, int fr, int fq) const {
        const int lane = fr + 16 * fq;
        const int row0 = u.pm * BM + wr * 64 + fr, col0 = u.pn * BM + wc * 32 + 8 * fq;
#pragma unroll
        for (int ai = 0; ai < 2; ++ai)
#pragma unroll
            for (int m = 0; m < 4; ++m) { const int row = row0 + ai * HALF + m * 16;
#pragma unroll
                for (int bj = 0; bj < 2; ++bj) *(u32x4*)(O + (size_t)row * ldc + col0 + bj * HALF) = pack8(acc[ai][bj][m][0], acc[ai][bj][m][1]); }
    }
};
struct EpiNull {
    static constexpr bool PERM = true, AFTER_DRAIN = false, HAS_PRE = false;
    __device__ __forceinline__ void operator()(const f32x4 (&acc)[2][2][4][2], const Unit& u, int wr, int wc, int fr, int fq) const {
#pragma unroll
        for (int ai = 0; ai < 2; ++ai)
#pragma unroll
            for (int bj = 0; bj < 2; ++bj)
#pragma unroll
                for (int m = 0; m < 4; ++m)
#pragma unroll
                    for (int n = 0; n < 2; ++n) asm volatile("" :: "v"(acc[ai][bj][m][n]));
    }
};
struct EpiQkv {
    static constexpr bool PERM = true, AFTER_DRAIN = false, HAS_PRE = true;
    const float* ssp; bf16_t *qa, *ka, *va, *qb, *kb, *vb; const float *qna, *kna, *qnb, *knb;
    __device__ __forceinline__ void pre(const Unit& u, int tid, PG8_LAS unsigned char* lds) const {
        PG8_LAS float* gtab = (PG8_LAS float*)(lds + EPI_TAB + 1024);
        const int wv = __builtin_amdgcn_readfirstlane(tid >> 6);
        if (wv == 0) gtab[tid & 63] = qna[tid & 63]; else if (wv == 1) gtab[64 + (tid & 63)] = kna[tid & 63]; else if (wv == 2) gtab[128 + (tid & 63)] = qnb[tid & 63]; else if (wv == 3) gtab[192 + (tid & 63)] = knb[tid & 63];
        rstd_table(ssp, u.pm, (PG8_LAS float*)(lds + EPI_TAB), tid);
    }
    __device__ __forceinline__ void operator()(const f32x4 (&acc)[2][2][4][2], const Unit& u, int wr, int wc, int fr, int fq, PG8_LAS unsigned char* lds) const {
        PG8_LAS float* rst = (PG8_LAS float*)(lds + EPI_TAB); PG8_LAS float* gtab = (PG8_LAS float*)(lds + EPI_TAB + 1024); const int pre_pm = rstd_table_pm(rst);
        const int lane = fr + 16 * fq;
        const int t = u.pn; bf16_t* dst; const float* ng; int nh, h, sel = 0; float sc = 1.0f;
        if (t < 2) { dst = qa; ng = qna; nh = 8; h = 4 * t + wc; sc = QSCALE; sel = 0; }
        else if (t < 4) { dst = ka; ng = kna; nh = 8; h = 4 * (t - 2) + wc; sel = 1; }
        else if (t < 6) { dst = va; ng = nullptr; nh = 8; h = 4 * (t - 4) + wc; }
        else if (t < 8) { dst = qb; ng = qnb; nh = 8; h = 4 * (t - 6) + wc; sc = QSCALE; sel = 2; }
        else if (wc < 2) { dst = kb; ng = knb; nh = 2; h = wc; sel = 3; }
        else { dst = vb; ng = nullptr; nh = 2; h = wc - 2; }
        f32x4 gv[2][2];
        const int row0 = u.pm * BM + wr * 64 + fr;
        float rsv[8];
        if (u.pm == pre_pm) {
          rstd_table_rd(rst, wr, fr, rsv);
          const unsigned ga = (unsigned)(uintptr_t)gtab + (unsigned)(sel * 256 + fq * 32);
          asm volatile("ds_read_b128 %0, %1" : "=v"(gv[0][0]) : "v"(ga) : "memory");            asm volatile("ds_read_b128 %0, %1 offset:16" : "=v"(gv[0][1]) : "v"(ga) : "memory");
          asm volatile("ds_read_b128 %0, %1 offset:128" : "=v"(gv[1][0]) : "v"(ga) : "memory"); asm volatile("ds_read_b128 %0, %1 offset:144" : "=v"(gv[1][1]) : "v"(ga) : "memory");
          asm volatile("s_waitcnt lgkmcnt(0)" : "+v"(rsv[0]), "+v"(rsv[1]), "+v"(rsv[2]), "+v"(rsv[3]), "+v"(rsv[4]), "+v"(rsv[5]), "+v"(rsv[6]), "+v"(rsv[7]), "+v"(gv[0][0]), "+v"(gv[0][1]), "+v"(gv[1][0]), "+v"(gv[1][1]) :: "memory");
        } else
        { f32x4 t8[8];
#pragma unroll
          for (int g = 0; g < 8; ++g) t8[g] = rstd_ld(ssp, row0 + (g >> 2) * HALF + (g & 3) * 16, fq);
          const float* ngp = ng ? ng : qna;
#pragma unroll
          for (int bj = 0; bj < 2; ++bj)
#pragma unroll
              for (int n = 0; n < 2; ++n) gv[bj][n] = *(const f32x4*)(ngp + 32 * bj + 8 * fq + 4 * n);
#pragma unroll
          for (int g = 0; g < 8; ++g) rsv[g] = rstd_fin(t8[g], lane); }
        const float gsc = ng ? sc : 0.0f, gad = ng ? 0.0f : 1.0f;
#pragma unroll
        for (int bj = 0; bj < 2; ++bj)
#pragma unroll
            for (int n = 0; n < 2; ++n) gv[bj][n] = gv[bj][n] * gsc + gad;
        asm volatile("" ::: "memory");
#pragma unroll
        for (int ai = 0; ai < 2; ++ai)
#pragma unroll
            for (int m = 0; m < 4; ++m) { const int row = row0 + ai * HALF + m * 16; const float rs = rsv[ai * 4 + m];
                f32x4 v[2][2]; float ss = 0.f;
#pragma unroll
                for (int bj = 0; bj < 2; ++bj)
#pragma unroll
                    for (int n = 0; n < 2; ++n) { v[bj][n] = acc[ai][bj][m][n] * rs; ss += (v[bj][n][0] * v[bj][n][0] + v[bj][n][1] * v[bj][n][1]) + (v[bj][n][2] * v[bj][n][2] + v[bj][n][3] * v[bj][n][3]); }
                ss += shx(ss, lane, 16); ss += shx(ss, lane, 32);
                const float hr = ng ? __builtin_amdgcn_rsqf(ss * (1.0f / 64.0f) + 1e-6f) : 1.0f;
                const int b = row >> 12, s = row & 4095;
                bf16_t* p = dst + (((size_t)b * nh + h) * 4096 + s) * 64 + 8 * fq;
#pragma unroll
                for (int bj = 0; bj < 2; ++bj) *(u32x4*)(p + 32 * bj) = pack8(v[bj][0] * hr * gv[bj][0], v[bj][1] * hr * gv[bj][1]); }
    }
};
}

#include <hip/hip_cooperative_groups.h>
namespace cg = cooperative_groups;
#define LAS __attribute__((address_space(3)))
typedef unsigned v4u __attribute__((ext_vector_type(4)));
constexpr int NWAVES = 8, RING_BYTES = 131072, LDS_BYTES = 147456;
static_assert(pg8::EPI_TAB >= 8 * 16640 && pg8::EPI_TAB + 4096 <= LDS_BYTES - 64, "epilogue tables");
constexpr int NPHASE = 1 + 8 * DEPTH;
constexpr size_t WO_F1IN = 0, WO_F1OUT = WO_F1IN + (size_t)2 * DFF * D, WO_QKV = WO_F1OUT + (size_t)D * DFF, WO_WO = WO_QKV + (size_t)QKVW * D,
                 WO_F2IN = WO_WO + (size_t)D * D, WO_F2OUT = WO_F2IN + (size_t)2 * DFF * D, WO_WG = WO_F2OUT + (size_t)D * DFF, WO_WP = WO_WG + (size_t)D * D, W_LAYER = WO_WP + (size_t)D * PLE;
static_assert(W_LAYER * 2 * DEPTH <= 84 * MiB, "weights fit");

struct Args { const float* in[20]; float* out; unsigned char* ws; int ph_lo, ph_hi; };

__device__ __forceinline__ int src_col(int kind, int n0) {
    if (kind == 0) return n0;
    if (kind == 1) return ((n0 >> 7) & 1) * DFF + 128 * (n0 >> 8) + (n0 & 127);
    return 256 * (n0 >> 8) + 64 * ((n0 >> 5) & 3) + 32 * ((n0 >> 7) & 1);
}
__device__ __forceinline__ unsigned cvt_pk_nv(float lo, float hi) { unsigned r; asm("v_cvt_pk_bf16_f32 %0, %1, %2" : "=v"(r) : "v"(lo), "v"(hi)); return r; }
struct TrItem { const float* W; const float* gain; bf16_t* Bt; int K, N, kind, item; };
__device__ __forceinline__ void tr_issue(const TrItem& d, int lane, float4 (&v)[16]) {
    const int kblocks = d.K / 64, nb = d.item / kblocks, kb = d.item % kblocks, k0 = 64 * kb, n0 = 64 * nb;
    const int cseg = lane & 15, r0 = lane >> 4;
    const int c0 = src_col(d.kind, n0 + 32 * (cseg >> 3)) + 4 * (cseg & 7);
#pragma unroll
    for (int i = 0; i < 16; ++i) v[i] = *(const float4*)(d.W + (size_t)(k0 + r0 + 4 * i) * d.N + c0);
}
__device__ __forceinline__ void tr_finish(const TrItem& d, LAS float* scr, int lane, const float4 (&v)[16]) {
    const int kblocks = d.K / 64, nb = d.item / kblocks, kb = d.item % kblocks, k0 = 64 * kb, n0 = 64 * nb;
    const int cseg = lane & 15, r0 = lane >> 4, c = lane & 7;
    const float* gp = d.gain ? d.gain + k0 + 8 * c : d.W;
    const float4 g0 = *(const float4*)gp, g1 = *(const float4*)(gp + 4);
#pragma unroll
    for (int i = 0; i < 16; ++i) { LAS float* p = scr + (r0 + 4 * i) * 65 + 4 * cseg; p[0] = v[i].x; p[1] = v[i].y; p[2] = v[i].z; p[3] = v[i].w; }
    asm volatile("s_waitcnt lgkmcnt(0)" ::: "memory");
    const bool hg = d.gain != nullptr;
    const float g[8] = {hg ? g0.x : 1.f, hg ? g0.y : 1.f, hg ? g0.z : 1.f, hg ? g0.w : 1.f, hg ? g1.x : 1.f, hg ? g1.y : 1.f, hg ? g1.z : 1.f, hg ? g1.w : 1.f};
#pragma unroll
    for (int jh = 0; jh < 2; ++jh) {
        float t[4][8];
#pragma unroll
        for (int j = 0; j < 4; ++j) { const LAS float* sp = scr + (8 * c) * 65 + (lane >> 3) + 8 * (4 * jh + j);
#pragma unroll
            for (int q = 0; q < 8; ++q) t[j][q] = sp[q * 65]; }
#pragma unroll
        for (int j = 0; j < 4; ++j) { const int n = (lane >> 3) + 8 * (4 * jh + j);
            v4u o; o.x = cvt_pk_nv(t[j][0] * g[0], t[j][1] * g[1]); o.y = cvt_pk_nv(t[j][2] * g[2], t[j][3] * g[3]); o.z = cvt_pk_nv(t[j][4] * g[4], t[j][5] * g[5]); o.w = cvt_pk_nv(t[j][6] * g[6], t[j][7] * g[7]);
            *(v4u*)(d.Bt + (size_t)(n0 + n) * d.K + k0 + 8 * c) = o; }
    }
    asm volatile("s_waitcnt lgkmcnt(0)" ::: "memory");
}

constexpr int I_FIN = (D / 64) * (2 * DFF / 64), I_FOUT = (DFF / 64) * (D / 64), I_QKV = (D / 64) * (QKVW / 64), I_SQ = (D / 64) * (D / 64), I_WP = (PLE / 64) * (D / 64);
constexpr int IT_FIN1 = 0, IT_FOUT1 = IT_FIN1 + I_FIN, IT_QKV = IT_FOUT1 + I_FOUT, IT_WO = IT_QKV + I_QKV, IT_FIN2 = IT_WO + I_SQ, IT_FOUT2 = IT_FIN2 + I_FIN, IT_WG = IT_FOUT2 + I_FOUT, IT_WP = IT_WG + I_SQ, I_LAYER = IT_WP + I_WP;
template <class AT> __device__ __forceinline__ TrItem tr_decode(const AT& a, int it) {
    bf16_t* wbase = (bf16_t*)(a.ws() + WS_W);
    const int l = it / I_LAYER; int r = it % I_LAYER; bf16_t* wl = wbase + (size_t)l * W_LAYER;
    TrItem d;
    if (r < I_FIN) { d = TrItem{a.in(4) + (size_t)l * D * 2 * DFF, a.in(3) + l * D, wl + WO_F1IN, D, 2 * DFF, 1, r}; return d; } r -= I_FIN;
    if (r < I_FOUT) { d = TrItem{a.in(5) + (size_t)l * DFF * D, nullptr, wl + WO_F1OUT, DFF, D, 0, r}; return d; } r -= I_FOUT;
    if (r < I_QKV) { d = TrItem{a.in(7) + (size_t)l * D * QKVW, a.in(6) + l * D, wl + WO_QKV, D, QKVW, 2, r}; return d; } r -= I_QKV;
    if (r < I_SQ) { d = TrItem{a.in(13) + (size_t)l * D * D, nullptr, wl + WO_WO, D, D, 0, r}; return d; } r -= I_SQ;
    if (r < I_FIN) { d = TrItem{a.in(15) + (size_t)l * D * 2 * DFF, a.in(14) + l * D, wl + WO_F2IN, D, 2 * DFF, 1, r}; return d; } r -= I_FIN;
    if (r < I_FOUT) { d = TrItem{a.in(16) + (size_t)l * DFF * D, nullptr, wl + WO_F2OUT, DFF, D, 0, r}; return d; } r -= I_FOUT;
    if (r < I_SQ) { d = TrItem{a.in(18) + (size_t)l * D * D, a.in(17) + l * D, wl + WO_WG, D, D, 0, r}; return d; } r -= I_SQ;
    d = TrItem{a.in(19) + (size_t)l * PLE * D, nullptr, wl + WO_WP, PLE, D, 0, r}; return d;
}
template <class AT> __device__ __forceinline__ void convert_weight_items(const AT& a, LAS unsigned char* lds, int f1, int c1, int widx, int nw, int wave, int lane, int f2 = 0, int c2 = 0, int f3 = 0, int c3 = 0) {
    LAS float* scr = (LAS float*)(lds + wave * 16640);
    const int total = c1 + c2 + c3;
    auto item_of = [&](int e) { return e < c1 ? f1 + e : (e < c1 + c2 ? f2 + (e - c1) : f3 + (e - c1 - c2)); };
    int e = __builtin_amdgcn_readfirstlane(widx);
    if (e >= total) return;
    float4 va[16], vb[16];
    TrItem d0 = tr_decode(a, item_of(e)), d1 = d0;
    tr_issue(d0, lane, va);
    for (;;) {
        const int e1 = e + nw; const bool h1 = e1 < total;
        if (h1) { d1 = tr_decode(a, item_of(e1)); tr_issue(d1, lane, vb); }
        tr_finish(d0, scr, lane, va);
        if (!h1) break;
        e = e1 + nw; const bool h0 = e < total;
        if (h0) { d0 = tr_decode(a, item_of(e)); tr_issue(d0, lane, va); }
        tr_finish(d1, scr, lane, vb);
        if (!h0) break;
    }
}
template <class AT> __device__ __forceinline__ void prologue_phase(const AT& a, LAS unsigned char* lds, int gw, int NGW, int wave, int lane, bool side_jobs) {
    if (side_jobs) convert_weight_items(a, lds, IT_FIN1, I_FIN, gw, NGW, wave, lane);
    else convert_weight_items(a, lds, 0, DEPTH * I_LAYER, gw, NGW, wave, lane);
    const float* x = a.in(0); bf16_t* xb = (bf16_t*)(a.ws() + WS_XB); bf16_t* xlo = (bf16_t*)a.out(); float* ssp = (float*)(a.ws() + WS_SSP);
    for (int row = gw; row < M; row += 2 * NGW) {
        const int row2 = row + NGW; const bool has2 = row2 < M;
        const float4* xr = (const float4*)(x + (size_t)row * D); const float4* xr2 = (const float4*)(x + (size_t)(has2 ? row2 : row) * D);
        float4 va[4], vb[4];
#pragma unroll
        for (int j = 0; j < 4; ++j) { va[j] = xr[lane + 64 * j]; vb[j] = xr2[lane + 64 * j]; }
        float s = 0.f, s2 = 0.f;
#pragma unroll
        for (int j = 0; j < 4; ++j) { s += va[j].x * va[j].x + va[j].y * va[j].y + va[j].z * va[j].z + va[j].w * va[j].w; s2 += vb[j].x * vb[j].x + vb[j].y * vb[j].y + vb[j].z * vb[j].z + vb[j].w * vb[j].w;
            uint2 o; o.x = pg8::cvt_pk_bf16(va[j].x, va[j].y); o.y = pg8::cvt_pk_bf16(va[j].z, va[j].w); ((uint2*)(xb + (size_t)row * D))[lane + 64 * j] = o;
            if (XLO) { uint2 q; q.x = pg8::cvt_pk_bf16(va[j].x - pg8::bflo(o.x), va[j].y - pg8::bfhi(o.x)); q.y = pg8::cvt_pk_bf16(va[j].z - pg8::bflo(o.y), va[j].w - pg8::bfhi(o.y)); ((uint2*)(xlo + (size_t)row * D))[lane + 64 * j] = q; }
            if (has2) { uint2 o2; o2.x = pg8::cvt_pk_bf16(vb[j].x, vb[j].y); o2.y = pg8::cvt_pk_bf16(vb[j].z, vb[j].w); ((uint2*)(xb + (size_t)row2 * D))[lane + 64 * j] = o2;
                if (XLO) { uint2 q2; q2.x = pg8::cvt_pk_bf16(vb[j].x - pg8::bflo(o2.x), vb[j].y - pg8::bfhi(o2.x)); q2.y = pg8::cvt_pk_bf16(vb[j].z - pg8::bflo(o2.y), vb[j].w - pg8::bfhi(o2.y)); ((uint2*)(xlo + (size_t)row2 * D))[lane + 64 * j] = q2; } } }
#pragma unroll
        for (int o = 1; o < 64; o <<= 1) { s += pg8::shx(s, lane, o); s2 += pg8::shx(s2, lane, o); }
        if (lane < 4) { float4 r; r.x = lane == 0 ? s : 0.f; r.y = 0.f; r.z = 0.f; r.w = 0.f; ((float4*)ssp)[row * 4 + lane] = r;
            if (has2) { r.x = lane == 0 ? s2 : 0.f; ((float4*)ssp)[row2 * 4 + lane] = r; } }
    }
}
__device__ __forceinline__ void convert_p(const float* p, bf16_t* pb, int gtid, int nthreads) {
    for (int i = gtid; i < M * PLE / 8; i += nthreads) { const float4 v0 = ((const float4*)p)[2 * i], v1 = ((const float4*)p)[2 * i + 1];
        v4u o; o.x = pg8::cvt_pk_bf16(v0.x, v0.y); o.y = pg8::cvt_pk_bf16(v0.z, v0.w); o.z = pg8::cvt_pk_bf16(v1.x, v1.y); o.w = pg8::cvt_pk_bf16(v1.z, v1.w); ((v4u*)pb)[i] = o; }
}

namespace att {
typedef short bf16x8 __attribute__((ext_vector_type(8)));
typedef short s16x4 __attribute__((ext_vector_type(4)));
typedef short v4i16_t __attribute__((ext_vector_type(4)));
typedef float f32x16 __attribute__((ext_vector_type(16)));
typedef unsigned u32x4 __attribute__((ext_vector_type(4)));
typedef float f32x2_t __attribute__((ext_vector_type(2))); typedef __bf16 bf16x2_t __attribute__((ext_vector_type(2)));
constexpr float NEG = -1e30f;
constexpr int WAVE_LDS = 8704, LUT_OFF = 0, WAVES_OFF = 8192, LUTA_STRIDE = 200, LUTB_STRIDE = 328, LUTB_OFF = LUT_OFF + 3 * LUTA_STRIDE * 4, TAB_OFF = WAVES_OFF + 8 * WAVE_LDS, LSE_OFF = TAB_OFF + 65536, ATT_LDS_END = LSE_OFF + 2048;
static_assert(LUTB_OFF + 4 * LUTB_STRIDE * 4 <= WAVES_OFF && ATT_LDS_END <= 147456 - 64, "attention LDS map");
__device__ __forceinline__ int crow(int r, int hi) { return (r & 3) + 8 * (r >> 2) + 4 * hi; }
__device__ __forceinline__ unsigned cvtpk(float lo, float hi) { f32x2_t v = {lo, hi}; bf16x2_t b = __builtin_convertvector(v, bf16x2_t); return __builtin_bit_cast(unsigned, b); }
__device__ __forceinline__ s16x4 vtr(const LAS unsigned char* p) { return __builtin_bit_cast(s16x4, __builtin_amdgcn_ds_read_tr16_b64_v4i16((LAS v4i16_t*)p)); }
__device__ __forceinline__ float halfmax(float v) { auto rr = __builtin_amdgcn_permlane32_swap(__float_as_uint(v), __float_as_uint(v), false, false); return fmaxf(__uint_as_float(rr[0]), __uint_as_float(rr[1])); }
__device__ __forceinline__ float halfsum(float v) { auto rr = __builtin_amdgcn_permlane32_swap(__float_as_uint(v), __float_as_uint(v), false, false); return __uint_as_float(rr[0]) + __uint_as_float(rr[1]); }

__device__ __forceinline__ f32x16 bias_ld(const LAS float* lut, const int j, const int i, const int hi) {
    const LAS float* lp = lut + 32 * j - i + 4 * hi; f32x16 b;
#pragma unroll
    for (int r = 0; r < 16; ++r) b[r] = lp[(r & 3) + 8 * (r >> 2)];
    return b;
}
__device__ __forceinline__ void bias_add(f32x16& p, const LAS float* lut, const int j, const int i, const int hi) {
    const LAS float* lp = lut + 32 * j - i + 4 * hi;
#pragma unroll
    for (int r = 0; r < 16; ++r) p[r] += lp[(r & 3) + 8 * (r >> 2)];
}
constexpr float MLOW = -1.0e4f;
constexpr float THR = 8.0f;
template <int NT>
__device__ __forceinline__ void sm_tile(f32x16& p, const LAS float* lut, const int j, const int i, const int hi, const int first, const int dstep, const bool inside,
                                        float& m, float& l, f32x16 (&o)[2], LAS float* wsf, bf16x8& pa0, bf16x8& pa1) {
    if (!inside) {
#pragma unroll
        for (int r = 0; r < 16; ++r) { const int tk = first + crow(r, hi) * dstep; if ((unsigned)tk >= (unsigned)S) p[r] = NEG; }
    }
    float rm = fmaxf(p[0], p[1]);
#pragma unroll
    for (int r = 2; r < 16; ++r) rm = fmaxf(rm, p[r]);
    rm = halfmax(rm);
    if (__any(rm > m + THR)) {
        const float mn = fmaxf(m, rm), alpha = __builtin_amdgcn_exp2f(m - mn);
        l *= alpha; m = mn;
        if (hi == 0) wsf[i] = alpha;
#pragma unroll
        for (int r = 0; r < 16; ++r) { const float a = wsf[crow(r, hi)]; o[0][r] *= a; o[1][r] *= a; }
    }
    f32x2_t rs2 = {0.f, 0.f}; const f32x2_t nm2 = {-m, -m};
#pragma unroll
    for (int r = 0; r < 16; r += 2) { f32x2_t t = (f32x2_t){p[r], p[r + 1]} + nm2; t.x = __builtin_amdgcn_exp2f(t.x); t.y = __builtin_amdgcn_exp2f(t.y); p[r] = t.x; p[r + 1] = t.y; rs2 += t; }
    l += rs2.x + rs2.y;
    u32x4 pw0 = {cvtpk(p[0], p[1]), cvtpk(p[2], p[3]), cvtpk(p[4], p[5]), cvtpk(p[6], p[7])};
    u32x4 pw1 = {cvtpk(p[8], p[9]), cvtpk(p[10], p[11]), cvtpk(p[12], p[13]), cvtpk(p[14], p[15])};
    pa0 = __builtin_bit_cast(bf16x8, pw0); pa1 = __builtin_bit_cast(bf16x8, pw1);
}
template <int NT, int SHIFT>
__device__ __forceinline__ void qtile2(const bf16_t* qrow0, const bf16_t* qrow1, const bf16_t* kbase, const bf16_t* vbase, int tk0, int dstep, const LAS float* lut0, const LAS float* lut1,
                                       float mi0, float li0, float mi1, float li1, LAS unsigned char* wl, int lane_in,
                                       f32x16 (&o0)[2], float& m0_out, float& l0_out, f32x16 (&o1)[2], float& m1_out, float& l1_out) {
    int lane = lane_in; asm volatile("" : "+v"(lane));
    const int i = lane & 31, hi = lane >> 5;
    LAS float* wsf = (LAS float*)(wl + 8192);
    bf16x8 qf0[4], qf1[4];
#pragma unroll
    for (int ks = 0; ks < 4; ++ks) { qf0[ks] = *(const bf16x8*)(qrow0 + 16 * ks + 8 * hi); qf1[ks] = *(const bf16x8*)(qrow1 + 16 * ks + 8 * hi); }
    const int vrow = lane >> 3, vsw = (lane & 7) ^ (((lane >> 4) & 1) << 2);
    const int rd_base = (4 * hi + ((lane & 15) >> 2)) * 128 + 32 * ((lane >> 4) & 1) + 8 * (lane & 3);
    const int bit3 = (lane >> 3) & 1;
    const int vb0 = rd_base + 64 * bit3, vb1 = rd_base + 64 * (1 - bit3);
    bf16x8 kf[4];
#define ATT_LOAD(j, buf) do { \
        { int tk = tk0 + (32 * (j) + i) * dstep; tk = tk < 0 ? 0 : (tk > S - 1 ? S - 1 : tk); const bf16_t* kp = kbase + (size_t)tk * HD + 8 * hi; \
          _Pragma("unroll") for (int ks = 0; ks < 4; ++ks) kf[ks] = *(const bf16x8*)(kp + 16 * ks); } \
        _Pragma("unroll") for (int i4 = 0; i4 < 4; ++i4) { int tk = tk0 + (32 * (j) + vrow + 8 * i4) * dstep; tk = tk < 0 ? 0 : (tk > S - 1 ? S - 1 : tk); \
          __builtin_amdgcn_global_load_lds((const unsigned*)(vbase + (size_t)tk * HD + 8 * vsw), (LAS unsigned*)(wl + (buf) * 4096 + i4 * 1024), 16, 0, 0); } } while (0)
    float m0 = mi0, l0 = hi == 0 ? li0 : 0.f, m1 = mi1, l1 = hi == 0 ? li1 : 0.f;
    o0[0] = f32x16{}; o0[1] = f32x16{}; o1[0] = f32x16{}; o1[1] = f32x16{};
    ATT_LOAD(0, 0);
#pragma unroll 1
    for (int jj = 0; jj < NT + SHIFT; ++jj) {
        LAS unsigned char* vbuf = wl + (jj & 1) * 4096;
        const bool a0 = jj < NT, a1 = jj >= SHIFT;
        const int first = tk0 + 32 * jj * dstep, lastk = first + 31 * dstep;
        const bool inside = first >= 0 && lastk < S;
        asm volatile("s_waitcnt vmcnt(0)" ::: "memory");
        f32x16 p0, p1;
        bf16x8 pa00, pa01, pa10, pa11;
        {
            if (a0) {
                p0 = __builtin_amdgcn_mfma_f32_32x32x16_bf16(kf[0], qf0[0], bias_ld(lut0, jj, i, hi), 0, 0, 0);
#pragma unroll
                for (int ks = 1; ks < 4; ++ks) p0 = __builtin_amdgcn_mfma_f32_32x32x16_bf16(kf[ks], qf0[ks], p0, 0, 0, 0);
            }
            if (a1) {
                p1 = __builtin_amdgcn_mfma_f32_32x32x16_bf16(kf[0], qf1[0], bias_ld(lut1, jj - SHIFT, i, hi), 0, 0, 0);
#pragma unroll
                for (int ks = 1; ks < 4; ++ks) p1 = __builtin_amdgcn_mfma_f32_32x32x16_bf16(kf[ks], qf1[ks], p1, 0, 0, 0);
            }
        }
        if (jj + 1 < NT + SHIFT) ATT_LOAD(jj + 1, (jj + 1) & 1);
        {
            if (a0) sm_tile<NT>(p0, lut0, jj, i, hi, first, dstep, inside, m0, l0, o0, wsf, pa00, pa01);
            if (a1) sm_tile<NT>(p1, lut1, jj - SHIFT, i, hi, first, dstep, inside, m1, l1, o1, wsf, pa10, pa11);
            {
                const unsigned vpa = (unsigned)(uintptr_t)(vbuf + vb0), vpb = (unsigned)(uintptr_t)(vbuf + vb1);
                s16x4 x0, x1, y0, y1, z0, z1, w0, w1;
                asm volatile("ds_read_b64_tr_b16 %0, %1" : "=&v"(x0) : "v"(vpa) : "memory");
                asm volatile("ds_read_b64_tr_b16 %0, %1 offset:1024" : "=&v"(x1) : "v"(vpa) : "memory");
                asm volatile("ds_read_b64_tr_b16 %0, %1 offset:2048" : "=&v"(y0) : "v"(vpa) : "memory");
                asm volatile("ds_read_b64_tr_b16 %0, %1 offset:3072" : "=&v"(y1) : "v"(vpa) : "memory");
                asm volatile("ds_read_b64_tr_b16 %0, %1" : "=&v"(z0) : "v"(vpb) : "memory");
                asm volatile("ds_read_b64_tr_b16 %0, %1 offset:1024" : "=&v"(z1) : "v"(vpb) : "memory");
                asm volatile("ds_read_b64_tr_b16 %0, %1 offset:2048" : "=&v"(w0) : "v"(vpb) : "memory");
                asm volatile("ds_read_b64_tr_b16 %0, %1 offset:3072" : "=&v"(w1) : "v"(vpb) : "memory");
                asm volatile("s_waitcnt lgkmcnt(4)" : "+v"(x0), "+v"(x1), "+v"(y0), "+v"(y1) :: "memory"); __builtin_amdgcn_sched_barrier(0);
                { const bf16x8 f0 = {x0[0], x0[1], x0[2], x0[3], x1[0], x1[1], x1[2], x1[3]}, f1 = {y0[0], y0[1], y0[2], y0[3], y1[0], y1[1], y1[2], y1[3]};
                  if (a0) { o0[0] = __builtin_amdgcn_mfma_f32_32x32x16_bf16(pa00, f0, o0[0], 0, 0, 0); o0[0] = __builtin_amdgcn_mfma_f32_32x32x16_bf16(pa01, f1, o0[0], 0, 0, 0); }
                  if (a1) { o1[0] = __builtin_amdgcn_mfma_f32_32x32x16_bf16(pa10, f0, o1[0], 0, 0, 0); o1[0] = __builtin_amdgcn_mfma_f32_32x32x16_bf16(pa11, f1, o1[0], 0, 0, 0); } }
                asm volatile("s_waitcnt lgkmcnt(0)" : "+v"(z0), "+v"(z1), "+v"(w0), "+v"(w1) :: "memory"); __builtin_amdgcn_sched_barrier(0);
                { const bf16x8 f0 = {z0[0], z0[1], z0[2], z0[3], z1[0], z1[1], z1[2], z1[3]}, f1 = {w0[0], w0[1], w0[2], w0[3], w1[0], w1[1], w1[2], w1[3]};
                  if (a0) { o0[1] = __builtin_amdgcn_mfma_f32_32x32x16_bf16(pa00, f0, o0[1], 0, 0, 0); o0[1] = __builtin_amdgcn_mfma_f32_32x32x16_bf16(pa01, f1, o0[1], 0, 0, 0); }
                  if (a1) { o1[1] = __builtin_amdgcn_mfma_f32_32x32x16_bf16(pa10, f0, o1[1], 0, 0, 0); o1[1] = __builtin_amdgcn_mfma_f32_32x32x16_bf16(pa11, f1, o1[1], 0, 0, 0); } }
            }
        }
    }
#undef ATT_LOAD
    m0_out = m0; l0_out = halfsum(l0); m1_out = m1; l1_out = halfsum(l1);
}

template <int NT>
__device__ __forceinline__ void qtile2s(const bf16_t* qrow0, const bf16_t* qrow1, const bf16_t* kbase, const bf16_t* vbase, int tk0a, int tk0b, int dstep, const LAS float* lut,
                                        LAS unsigned char* wl, LAS unsigned char* wlb, int lane_in,
                                        f32x16 (&o0)[2], float& m0_out, float& l0_out, f32x16 (&o1)[2], float& m1_out, float& l1_out) {
    int lane = lane_in; asm volatile("" : "+v"(lane));
    const int i = lane & 31, hi = lane >> 5;
    LAS float* wsf = (LAS float*)(wl + 8192);
    bf16x8 qf0[4], qf1[4];
#pragma unroll
    for (int ks = 0; ks < 4; ++ks) { qf0[ks] = *(const bf16x8*)(qrow0 + 16 * ks + 8 * hi); qf1[ks] = *(const bf16x8*)(qrow1 + 16 * ks + 8 * hi); }
    const int vrow = lane >> 3, vsw = (lane & 7) ^ (((lane >> 4) & 1) << 2);
    const int rd_base = (4 * hi + ((lane & 15) >> 2)) * 128 + 32 * ((lane >> 4) & 1) + 8 * (lane & 3);
    const int bit3 = (lane >> 3) & 1;
    const int vb0 = rd_base + 64 * bit3, vb1 = rd_base + 64 * (1 - bit3);
    bf16x8 kfa[4], kfb[4];
#define ATT_LOADS(j, buf, KF, TK0, WL) do { \
        { int tk = (TK0) + (32 * (j) + i) * dstep; tk = tk < 0 ? 0 : (tk > S - 1 ? S - 1 : tk); const bf16_t* kp = kbase + (size_t)tk * HD + 8 * hi; \
          _Pragma("unroll") for (int ks = 0; ks < 4; ++ks) KF[ks] = *(const bf16x8*)(kp + 16 * ks); } \
        _Pragma("unroll") for (int i4 = 0; i4 < 4; ++i4) { int tk = (TK0) + (32 * (j) + vrow + 8 * i4) * dstep; tk = tk < 0 ? 0 : (tk > S - 1 ? S - 1 : tk); \
          __builtin_amdgcn_global_load_lds((const unsigned*)(vbase + (size_t)tk * HD + 8 * vsw), (LAS unsigned*)((WL) + (buf) * 4096 + i4 * 1024), 16, 0, 0); } } while (0)
    float m0 = MLOW, l0 = 0.f, m1 = MLOW, l1 = 0.f;
    o0[0] = f32x16{}; o0[1] = f32x16{}; o1[0] = f32x16{}; o1[1] = f32x16{};
    ATT_LOADS(0, 0, kfa, tk0a, wl); ATT_LOADS(0, 0, kfb, tk0b, wlb);
#pragma unroll 1
    for (int jj = 0; jj < NT; ++jj) {
        LAS unsigned char* vbufa = wl + (jj & 1) * 4096; LAS unsigned char* vbufb = wlb + (jj & 1) * 4096;
        const int firsta = tk0a + 32 * jj * dstep, firstb = tk0b + 32 * jj * dstep;
        const bool insa = firsta >= 0 && firsta + 31 * dstep < S, insb = firstb >= 0 && firstb + 31 * dstep < S;
        asm volatile("s_waitcnt vmcnt(0)" ::: "memory");
        f32x16 p0, p1;
        bf16x8 pa00, pa01, pa10, pa11;
        p0 = __builtin_amdgcn_mfma_f32_32x32x16_bf16(kfa[0], qf0[0], bias_ld(lut, jj, i, hi), 0, 0, 0);
        p1 = __builtin_amdgcn_mfma_f32_32x32x16_bf16(kfb[0], qf1[0], bias_ld(lut, jj, i, hi), 0, 0, 0);
#pragma unroll
        for (int ks = 1; ks < 4; ++ks) { p0 = __builtin_amdgcn_mfma_f32_32x32x16_bf16(kfa[ks], qf0[ks], p0, 0, 0, 0); p1 = __builtin_amdgcn_mfma_f32_32x32x16_bf16(kfb[ks], qf1[ks], p1, 0, 0, 0); }
        if (jj + 1 < NT) { ATT_LOADS(jj + 1, (jj + 1) & 1, kfa, tk0a, wl); ATT_LOADS(jj + 1, (jj + 1) & 1, kfb, tk0b, wlb); }
        sm_tile<NT>(p0, lut, jj, i, hi, firsta, dstep, insa, m0, l0, o0, wsf, pa00, pa01);
        sm_tile<NT>(p1, lut, jj, i, hi, firstb, dstep, insb, m1, l1, o1, wsf, pa10, pa11);
#pragma unroll
        for (int d0 = 0; d0 < 2; ++d0) {
            const unsigned vpa = (unsigned)(uintptr_t)(vbufa + (d0 == 0 ? vb0 : vb1)), vpb = (unsigned)(uintptr_t)(vbufb + (d0 == 0 ? vb0 : vb1));
            s16x4 x0, x1, y0, y1, z0, z1, w0, w1;
            asm volatile("ds_read_b64_tr_b16 %0, %1" : "=&v"(x0) : "v"(vpa) : "memory"); asm volatile("ds_read_b64_tr_b16 %0, %1 offset:1024" : "=&v"(x1) : "v"(vpa) : "memory");
            asm volatile("ds_read_b64_tr_b16 %0, %1 offset:2048" : "=&v"(y0) : "v"(vpa) : "memory"); asm volatile("ds_read_b64_tr_b16 %0, %1 offset:3072" : "=&v"(y1) : "v"(vpa) : "memory");
            asm volatile("ds_read_b64_tr_b16 %0, %1" : "=&v"(z0) : "v"(vpb) : "memory"); asm volatile("ds_read_b64_tr_b16 %0, %1 offset:1024" : "=&v"(z1) : "v"(vpb) : "memory");
            asm volatile("ds_read_b64_tr_b16 %0, %1 offset:2048" : "=&v"(w0) : "v"(vpb) : "memory"); asm volatile("ds_read_b64_tr_b16 %0, %1 offset:3072" : "=&v"(w1) : "v"(vpb) : "memory");
            asm volatile("s_waitcnt lgkmcnt(0)" : "+v"(x0), "+v"(x1), "+v"(y0), "+v"(y1), "+v"(z0), "+v"(z1), "+v"(w0), "+v"(w1) :: "memory"); __builtin_amdgcn_sched_barrier(0);
            const bf16x8 f0 = {x0[0], x0[1], x0[2], x0[3], x1[0], x1[1], x1[2], x1[3]}, f1 = {y0[0], y0[1], y0[2], y0[3], y1[0], y1[1], y1[2], y1[3]};
            const bf16x8 g0 = {z0[0], z0[1], z0[2], z0[3], z1[0], z1[1], z1[2], z1[3]}, g1 = {w0[0], w0[1], w0[2], w0[3], w1[0], w1[1], w1[2], w1[3]};
            o0[d0] = __builtin_amdgcn_mfma_f32_32x32x16_bf16(pa00, f0, o0[d0], 0, 0, 0); o0[d0] = __builtin_amdgcn_mfma_f32_32x32x16_bf16(pa01, f1, o0[d0], 0, 0, 0);
            o1[d0] = __builtin_amdgcn_mfma_f32_32x32x16_bf16(pa10, g0, o1[d0], 0, 0, 0); o1[d0] = __builtin_amdgcn_mfma_f32_32x32x16_bf16(pa11, g1, o1[d0], 0, 0, 0);
        }
    }
#undef ATT_LOADS
    m0_out = m0; l0_out = halfsum(l0); m1_out = m1; l1_out = halfsum(l1);
}

__device__ __forceinline__ void glds16(const void* gsrc, unsigned lds_dst) { unsigned keep;
    asm volatile("s_mov_b32 %0, m0\n\ts_mov_b32 m0, %2\n\ts_nop 0\n\tglobal_load_lds_dwordx4 %1, off\n\ts_mov_b32 m0, %0" : "=&s"(keep) : "v"(gsrc), "s"(lds_dst) : "memory"); }
__device__ __forceinline__ void qtile16(const bf16_t* qrow, const bf16_t* kbase, const bf16_t* vbase, const int tk0, const LAS float* lut, LAS unsigned char* wl, LAS unsigned char* xbuf,
                                        int lane_in, f32x16 (&o)[2], float& m_out, float& l_out) {
    int lane = lane_in; asm volatile("" : "+v"(lane));
    const int i = lane & 31, hi = lane >> 5;
    LAS float* wsf = (LAS float*)(wl + 8192);
    bf16x8 qf[4];
    { const bf16_t* qp = qrow + 8 * hi;
      asm volatile("global_load_dwordx4 %0, %1, off" : "=v"(qf[0]) : "v"(qp) : "memory"); asm volatile("global_load_dwordx4 %0, %1, off offset:32" : "=v"(qf[1]) : "v"(qp) : "memory");
      asm volatile("global_load_dwordx4 %0, %1, off offset:64" : "=v"(qf[2]) : "v"(qp) : "memory"); asm volatile("global_load_dwordx4 %0, %1, off offset:96" : "=v"(qf[3]) : "v"(qp) : "memory"); }
    const int vrow = lane >> 3, vsw = (lane & 7) ^ (((lane >> 4) & 1) << 2);
    const int rd_base = (4 * hi + ((lane & 15) >> 2)) * 128 + 32 * ((lane >> 4) & 1) + 8 * (lane & 3);
    const int bit3 = (lane >> 3) & 1;
    const int vb0 = rd_base + 64 * bit3, vb1 = rd_base + 64 * (1 - bit3);
    const unsigned b0 = (unsigned)__builtin_amdgcn_readfirstlane((int)(unsigned)(uintptr_t)wl), b1 = b0 + 4096u, b2 = (unsigned)__builtin_amdgcn_readfirstlane((int)(unsigned)(uintptr_t)xbuf);
    bf16x8 kf[5][4];
#define Q16_K(t) do { int tk = tk0 + (32 * (t) + i) * 16; tk = tk < 0 ? 0 : (tk > S - 1 ? S - 1 : tk); const bf16_t* kp = kbase + (size_t)tk * HD + 8 * hi; \
        asm volatile("global_load_dwordx4 %0, %1, off" : "=v"(kf[t][0]) : "v"(kp) : "memory"); asm volatile("global_load_dwordx4 %0, %1, off offset:32" : "=v"(kf[t][1]) : "v"(kp) : "memory"); \
        asm volatile("global_load_dwordx4 %0, %1, off offset:64" : "=v"(kf[t][2]) : "v"(kp) : "memory"); asm volatile("global_load_dwordx4 %0, %1, off offset:96" : "=v"(kf[t][3]) : "v"(kp) : "memory"); } while (0)
#define Q16_V(t, buf) do { _Pragma("unroll") for (int i4 = 0; i4 < 4; ++i4) { int tk = tk0 + (32 * (t) + vrow + 8 * i4) * 16; tk = tk < 0 ? 0 : (tk > S - 1 ? S - 1 : tk); \
        glds16(vbase + (size_t)tk * HD + 8 * vsw, (buf) + i4 * 1024u); } } while (0)
#define Q16_WAIT(t, n) do { asm volatile("s_waitcnt vmcnt(" #n ")" : "+v"(kf[t][0]), "+v"(kf[t][1]), "+v"(kf[t][2]), "+v"(kf[t][3]) :: "memory"); __builtin_amdgcn_sched_barrier(0); } while (0)
    Q16_K(0); Q16_V(0, b0); Q16_K(1); Q16_V(1, b1); Q16_K(2); Q16_V(2, b2); Q16_K(3); Q16_K(4);
    float m = MLOW, l = 0.f;
    o[0] = f32x16{}; o[1] = f32x16{};
#define Q16_STEP(t, nwait, vimg, AFTER) do { \
        Q16_WAIT(t, nwait); \
        f32x16 p = __builtin_amdgcn_mfma_f32_32x32x16_bf16(kf[t][0], qf[0], bias_ld(lut, (t), i, hi), 0, 0, 0); \
        p = __builtin_amdgcn_mfma_f32_32x32x16_bf16(kf[t][1], qf[1], p, 0, 0, 0); p = __builtin_amdgcn_mfma_f32_32x32x16_bf16(kf[t][2], qf[2], p, 0, 0, 0); p = __builtin_amdgcn_mfma_f32_32x32x16_bf16(kf[t][3], qf[3], p, 0, 0, 0); \
        const int first_ = tk0 + 32 * (t) * 16; const bool inside_ = first_ >= 0 && first_ + 31 * 16 < S; \
        bf16x8 pa0_, pa1_; sm_tile<5>(p, lut, (t), i, hi, first_, 16, inside_, m, l, o, wsf, pa0_, pa1_); \
        _Pragma("unroll") for (int d0 = 0; d0 < 2; ++d0) { const unsigned vp = (vimg) + (unsigned)(d0 == 0 ? vb0 : vb1); s16x4 a0, a1, c0, c1; \
            asm volatile("ds_read_b64_tr_b16 %0, %1" : "=&v"(a0) : "v"(vp) : "memory"); asm volatile("ds_read_b64_tr_b16 %0, %1 offset:1024" : "=&v"(a1) : "v"(vp) : "memory"); \
            asm volatile("ds_read_b64_tr_b16 %0, %1 offset:2048" : "=&v"(c0) : "v"(vp) : "memory"); asm volatile("ds_read_b64_tr_b16 %0, %1 offset:3072" : "=&v"(c1) : "v"(vp) : "memory"); \
            asm volatile("s_waitcnt lgkmcnt(0)" : "+v"(a0), "+v"(a1), "+v"(c0), "+v"(c1) :: "memory"); __builtin_amdgcn_sched_barrier(0); \
            const bf16x8 f0 = {a0[0], a0[1], a0[2], a0[3], a1[0], a1[1], a1[2], a1[3]}, f1 = {c0[0], c0[1], c0[2], c0[3], c1[0], c1[1], c1[2], c1[3]}; \
            o[d0] = __builtin_amdgcn_mfma_f32_32x32x16_bf16(pa0_, f0, o[d0], 0, 0, 0); o[d0] = __builtin_amdgcn_mfma_f32_32x32x16_bf16(pa1_, f1, o[d0], 0, 0, 0); } \
        AFTER; } while (0)
    asm volatile("s_waitcnt vmcnt(24)" : "+v"(qf[0]), "+v"(qf[1]), "+v"(qf[2]), "+v"(qf[3]) :: "memory");
    Q16_STEP(0, 24, b0, Q16_V(3, b0));
    Q16_STEP(1, 20, b1, Q16_V(4, b1));
    Q16_STEP(2, 16, b2, (void)0);
    Q16_STEP(3, 4, b0, (void)0);
    Q16_STEP(4, 0, b1, (void)0);
#undef Q16_K
#undef Q16_V
#undef Q16_WAIT
#undef Q16_STEP
    m_out = m; l_out = halfsum(l);
}

__device__ __forceinline__ void stage_o(const f32x16 (&o)[2], float m, float l, LAS unsigned char* wl, int lane_in) {
    int lane = lane_in; asm volatile("" : "+v"(lane));
    const int i = lane & 31, hi = lane >> 5;
    LAS float* wsf = (LAS float*)(wl + 8192);
    if (hi == 0) { wsf[i] = __builtin_amdgcn_rcpf(l); wsf[32 + i] = m + __builtin_amdgcn_logf(l); }
    LAS bf16_t* stg = (LAS bf16_t*)wl;
#pragma unroll
    for (int r = 0; r < 16; ++r) { const int q = crow(r, hi); const float inv = wsf[q];
        stg[q * 64 + i] = (bf16_t)(cvtpk(o[0][r] * inv, 0.f) & 0xffffu); stg[q * 64 + 32 + i] = (bf16_t)(cvtpk(o[1][r] * inv, 0.f) & 0xffffu); }
}
__device__ __forceinline__ float bflo(unsigned w) { return __uint_as_float(w << 16); }
__device__ __forceinline__ float bfhi(unsigned w) { return __uint_as_float(w & 0xffff0000u); }
__device__ __forceinline__ unsigned mix2(unsigned a, unsigned b, float wa, float wb) { return cvtpk(wa * bflo(a) + wb * bflo(b), wa * bfhi(a) + wb * bfhi(b)); }

struct Tensors { const bf16_t *qa, *ka, *va, *qb, *kb, *vb; const float* glut; const float* sink; bf16_t* o; };
__device__ __forceinline__ void finish_a(const f32x16 (&o)[2], float m, float l, int pass, int d, int lam0, int rr, LAS unsigned char* wl, LAS unsigned char* tab, LAS float* lsetab, bf16_t* orow0, int lane_in) {
    LAS float* wsf = (LAS float*)(wl + 8192);
    stage_o(o, m, l, wl, lane_in);
    int lane = lane_in; asm volatile("" : "+v"(lane));
#pragma unroll
    for (int i4 = 0; i4 < 4; ++i4) {
        const int qi = (lane >> 3) + 8 * i4, ch = lane & 7, tau = d * (lam0 + qi) + rr;
        u32x4 v = *(const LAS u32x4*)(wl + qi * 128 + ch * 16);
        const float Lb = wsf[32 + qi];
        const int e = (tau & 15) * 32 + (tau >> 4);
        LAS u32x4* te = (LAS u32x4*)(tab + e * 128 + ch * 16);
        if (pass == 0) { *te = v; if (ch == 0) lsetab[e] = Lb; }
        else {
            const u32x4 tv = *te; const float La = lsetab[e];
            const float Lm = fmaxf(La, Lb), sa = __builtin_amdgcn_exp2f(La - Lm), sb = __builtin_amdgcn_exp2f(Lb - Lm), tot = sa + sb, rt = __builtin_amdgcn_rcpf(tot), wa = sa * rt, wb = sb * rt;
            u32x4 w; w.x = mix2(tv.x, v.x, wa, wb); w.y = mix2(tv.y, v.y, wa, wb); w.z = mix2(tv.z, v.z, wa, wb); w.w = mix2(tv.w, v.w, wa, wb);
            if (pass == 1) { *te = w; if (ch == 0) lsetab[e] = Lm + __builtin_amdgcn_logf(tot); }
            else *(u32x4*)(orow0 + (size_t)tau * D + ch * 8) = w;
        }
    }
}


__device__ __forceinline__ int bucket(int rel) {
    const int n = rel < 0 ? -rel : rel; const int ret = rel > 0 ? 16 : 0;
    if (n < 8) return ret + n;
    int large = 8 + (int)(logf((float)n / 8.0f) / 4.852030263919617f * 8.0f);
    large = large < 15 ? large : 15;
    return ret + large;
}

constexpr int GLUT_A = 8 * 3 * LUTA_STRIDE, GLUT_B = 2 * 4 * LUTB_STRIDE;
__device__ __forceinline__ void build_luts(const float* rel_bias, float* glut, int gtid, int nthreads) {
    for (int e = gtid; e < GLUT_A + GLUT_B; e += nthreads) {
        float v = NEG;
        if (e < GLUT_A) { const int h = e / (3 * LUTA_STRIDE), c = (e / LUTA_STRIDE) % 3, idx = e % LUTA_STRIDE - 32, d = c == 0 ? 1 : (c == 1 ? 4 : 16);
            if (idx >= 0 && idx <= 128) v = rel_bias[bucket((idx - 64) * d) * 16 + h] * LOG2E; }
        else { const int f = e - GLUT_A, hk = f / (4 * LUTB_STRIDE), g = (f / LUTB_STRIDE) & 3, idx = f % LUTB_STRIDE - 32;
            if (idx >= 0 && idx <= 256) v = rel_bias[bucket(idx - 128) * 16 + 8 + 4 * hk + g] * LOG2E; }
        glut[e] = v;
    }
}
__device__ __forceinline__ void attn_unit(const Tensors& T, int u, LAS unsigned char* lds, int wave, int lane, const int pmode = 0x33) {
    LAS unsigned char* wl = lds + WAVES_OFF + wave * WAVE_LDS;
    LAS float* wsf = (LAS float*)(wl + 8192);
    LAS float* lutA = (LAS float*)(lds + LUT_OFF); LAS float* lutB = (LAS float*)(lds + LUTB_OFF);
    LAS unsigned char* tab = lds + TAB_OFF; LAS float* lsetab = (LAS float*)(lds + LSE_OFF);
    const int tid = wave * 64 + lane;
    const int i = lane & 31;
    __syncthreads();
    { const int hkb = (u >> 5) & 1, ha = (u >> 3) & 7;
      const float* ga = T.glut + ha * 3 * LUTA_STRIDE; const float* gb = T.glut + GLUT_A + hkb * 4 * LUTB_STRIDE;
      for (int e = tid; e < 3 * LUTA_STRIDE; e += 512) lutA[e] = ga[e];
      for (int e = tid; e < 4 * LUTB_STRIDE; e += 512) lutB[e] = gb[e]; }
    __syncthreads();
    if (pmode & 1) {
        const int bh = u >> 3, blk = u & 7, b = bh >> 3, h = bh & 7, t0 = blk * 512;
        const bf16_t* qbase = T.qa + (size_t)bh * S * HD; const bf16_t* kbase = T.ka + (size_t)bh * S * HD; const bf16_t* vbase = T.va + (size_t)bh * S * HD;
        bf16_t* orow0 = T.o + ((size_t)b * S + t0) * D + h * HD;
#pragma unroll 1
        for (int pass = 0; pass < (pmode >> 4); ++pass) {
            const int c = ATT_ORDER == 0 ? 2 - pass : (pass == 0 ? 2 : (pass == 1 ? 0 : 1)), d = c == 0 ? 1 : (c == 1 ? 4 : 16);
            const LAS float* lt = lutA + c * LUTA_STRIDE + 32;
            if (c == 2) {
#if D16_MODE == 1
                const int rr = 2 * wave;
                f32x16 oA[2], oB[2]; float mA, lA, mB, lB;
                qtile2s<5>(qbase + (size_t)(t0 + d * i + rr) * HD, qbase + (size_t)(t0 + d * i + rr + 1) * HD, kbase, vbase, t0 - 64 * d + rr, t0 - 64 * d + rr + 1, d, lt,
                           wl, tab + wave * 8192, lane, oA, mA, lA, oB, mB, lB);
                finish_a(oA, mA, lA, pass, d, 0, rr, wl, tab, lsetab, orow0, lane);
                finish_a(oB, mB, lB, pass, d, 0, rr + 1, wl, tab, lsetab, orow0, lane);
#else
#pragma unroll 1
                for (int tt = 0; tt < 2; ++tt) { const int rr = 2 * wave + tt;
                    f32x16 o1[2]; float m1, l1;
                    qtile16(qbase + (size_t)(t0 + d * i + rr) * HD, kbase, vbase, t0 - 64 * d + rr, lt, wl, tab + wave * 8192 + 4096, lane, o1, m1, l1);
                    finish_a(o1, m1, l1, pass, d, 0, rr, wl, tab, lsetab, orow0, lane); }
#endif
            } else {
                const int Tq = 2 * wave, rr = c == 1 ? (Tq >> 2) : 0, lamA = 32 * (c == 1 ? (Tq & 3) : Tq);
                f32x16 oA[2], oB[2]; float mA, lA, mB, lB;
                qtile2<5, 1>(qbase + (size_t)(t0 + d * (lamA + i) + rr) * HD, qbase + (size_t)(t0 + d * (lamA + 32 + i) + rr) * HD, kbase, vbase, t0 + d * (lamA - 64) + rr, d, lt, lt,
                             MLOW, 0.f, MLOW, 0.f, wl, lane, oA, mA, lA, oB, mB, lB);
                finish_a(oA, mA, lA, pass, d, lamA, rr, wl, tab, lsetab, orow0, lane);
                finish_a(oB, mB, lB, pass, d, lamA + 32, rr, wl, tab, lsetab, orow0, lane);
            }
            if (pass < 2) __syncthreads();
        }
    }
    if (pmode & 2) {
        const int bk = u >> 5, blk = u & 31, b = bk >> 1, hk = bk & 1, t0 = blk * 128;
        const bf16_t* kbase = T.kb + (size_t)bk * S * HD; const bf16_t* vbase = T.vb + (size_t)bk * S * HD;
        const int qt = wave & 3, g0 = 2 * (wave >> 2), hq0 = 4 * hk + g0;
        const int tq = t0 + 32 * qt + i, tk0 = t0 + 32 * qt - 128;
        f32x16 oA[2], oB[2]; float mA, lA, mB, lB;
        qtile2<9, 0>(T.qb + (((size_t)b * 8 + hq0) * S + tq) * HD, T.qb + (((size_t)b * 8 + hq0 + 1) * S + tq) * HD, kbase, vbase, tk0, 1,
                     lutB + g0 * LUTB_STRIDE + 32, lutB + (g0 + 1) * LUTB_STRIDE + 32, T.sink[hq0] * LOG2E, 1.0f, T.sink[hq0 + 1] * LOG2E, 1.0f, wl, lane, oA, mA, lA, oB, mB, lB);
        bf16_t* ob0 = T.o + ((size_t)b * S + t0 + 32 * qt) * D + (8 + hq0) * HD;
        stage_o(oA, mA, lA, wl, lane);
#pragma unroll
        for (int i4 = 0; i4 < 4; ++i4) { const int qi = (lane >> 3) + 8 * i4, ch = lane & 7; *(u32x4*)(ob0 + (size_t)qi * D + ch * 8) = *(const LAS u32x4*)(wl + qi * 128 + ch * 16); }
        stage_o(oB, mB, lB, wl, lane);
#pragma unroll
        for (int i4 = 0; i4 < 4; ++i4) { const int qi = (lane >> 3) + 8 * i4, ch = lane & 7; *(u32x4*)(ob0 + HD + (size_t)qi * D + ch * 8) = *(const LAS u32x4*)(wl + qi * 128 + ch * 16); }
    }
}
}

#define XB_TMO      128
#define XB_XCNT(j)  (256  + 64 * (j))
#define XB_XSUB(j)  (1280 + 64 * (j))
#define XB_XGEN(j)  (2304 + 64 * (j))
#define XB_TOP      3328
#define XB_TOPGEN   3392
#define XCD_BAR_WORDS 3456
#define XB_SPIN_CAP (1u << 18)

__device__ __forceinline__ unsigned xb_ld(unsigned* p)              { return __hip_atomic_load(p, __ATOMIC_RELAXED, __HIP_MEMORY_SCOPE_AGENT); }
__device__ __forceinline__ unsigned xb_add(unsigned* p, unsigned v) { return __hip_atomic_fetch_add(p, v, __ATOMIC_RELAXED, __HIP_MEMORY_SCOPE_AGENT); }
__device__ __forceinline__ unsigned xb_xcc_id() { return (unsigned)__builtin_amdgcn_s_getreg((3 << 11) | 20) & 0xFu; }
#define XB_SPIN(cond, bar) do { unsigned _sp = 0; while (cond) { __builtin_amdgcn_s_sleep(1); \
    if ((++_sp & 255u) == 0u) { if (xb_ld(&(bar)[XB_TMO])) break; if (_sp > XB_SPIN_CAP) { atomicAdd(&(bar)[XB_TMO], 1u); break; } } } } while (0)

struct XcdBarrier {
    unsigned* bar; unsigned x;
    volatile LAS unsigned* st;
};

__device__ __forceinline__ XcdBarrier xcd_barrier_post(unsigned* bar, volatile LAS unsigned* st, unsigned& rank) {
    XcdBarrier b; b.bar = bar; b.x = xb_xcc_id(); b.st = st;
    if (threadIdx.x == 0) rank = xb_add(&bar[XB_XCNT(b.x)], 1u);
    return b;
}
__device__ __forceinline__ void xcd_barrier_complete(unsigned* bar, unsigned x, unsigned& nloc, unsigned& nx, unsigned& regular) {
    const unsigned G = gridDim.x * gridDim.y * gridDim.z;
    unsigned sum, cnt, mine, bad, sp = 0u;
    regular = 0u;
    for (;;) {
        sum = 0u; cnt = 0u; mine = 0u; bad = 0u;
#pragma unroll
        for (unsigned j = 0; j < 16; ++j) { const unsigned c = xb_ld(&bar[XB_XCNT(j)]); sum += c; cnt += (c > 0u) ? 1u : 0u; mine = (j == x) ? c : mine; bad |= (c != (j < 8u ? G / 8u : 0u)) ? 1u : 0u; }
        if (sum == G) { regular = (bad == 0u && G == 256u) ? 1u : 0u; break; }
        __builtin_amdgcn_s_sleep(1);
        if ((++sp & 255u) == 0u) { if (xb_ld(&bar[XB_TMO])) break; if (sp > XB_SPIN_CAP) { atomicAdd(&bar[XB_TMO], 1u); break; } }
    }
    nloc = mine > 0u ? mine : 1u; nx = cnt > 0u ? cnt : 1u;
}

__device__ __forceinline__ void xcd_barrier(const XcdBarrier& b, const bool is_t0) {
    asm volatile("s_waitcnt vmcnt(0)" ::: "memory");
    __syncthreads();
    if (is_t0) {
        unsigned* bar = b.bar;
        __builtin_amdgcn_s_waitcnt(0);
        unsigned nloc = b.st[0], nx = b.st[1];
        if (nloc == 0u) { unsigned reg; xcd_barrier_complete(bar, b.x, nloc, nx, reg); b.st[0] = nloc; b.st[1] = nx;
            b.st[2] = LOCAL_SEAMS ? reg : 0u; if (LOCAL_SEAMS && reg) b.st[3] = b.st[4] * 8u + b.x; }
        const unsigned old = xb_add(&bar[XB_XSUB(b.x)], 1u);
        if (EARLY_INV) asm volatile("buffer_inv sc1" ::: "memory");
        const unsigned gen = old / nloc;
        if (old + 1u == (gen + 1u) * nloc) {
            __builtin_amdgcn_fence(__ATOMIC_RELEASE, "agent");
            asm volatile("s_waitcnt vmcnt(0)" ::: "memory");
            const unsigned og = xb_add(&bar[XB_TOP], 1u);
            const unsigned tg = og / nx;
            if (og + 1u == (tg + 1u) * nx) xb_add(&bar[XB_TOPGEN], 1u);
            else XB_SPIN(xb_ld(&bar[XB_TOPGEN]) == tg, bar);
            if (!EARLY_INV) __builtin_amdgcn_fence(__ATOMIC_ACQUIRE, "agent");
            asm volatile("s_waitcnt vmcnt(0)" ::: "memory");
        } else {
            XB_SPIN(xb_ld(&bar[XB_TOPGEN]) == gen, bar);
            if (!EARLY_INV) __builtin_amdgcn_fence(__ATOMIC_ACQUIRE, "agent");
            asm volatile("s_waitcnt vmcnt(0)" ::: "memory");
        }
    }
    __syncthreads();
}
#define XB_XLSUB(j) (3456 + 64 * (j))
#define XB_XLGEN(j) (4480 + 64 * (j))
__device__ __forceinline__ void xcd_local_barrier(const XcdBarrier& b, const bool is_t0) {
    asm volatile("s_waitcnt vmcnt(0)" ::: "memory");
    __syncthreads();
    if (is_t0) {
        unsigned* bar = b.bar;
        __builtin_amdgcn_s_waitcnt(0);
        const unsigned nloc = b.st[0];
        const unsigned old = xb_add(&bar[XB_XLSUB(b.x)], 1u);
        if (EARLY_INV) asm volatile("buffer_inv sc1" ::: "memory");
        const unsigned gen = old / nloc;
        if (old + 1u == (gen + 1u) * nloc) xb_add(&bar[XB_XLGEN(b.x)], 1u);
        else XB_SPIN(xb_ld(&bar[XB_XLGEN(b.x)]) == gen, bar);
        if (!EARLY_INV) __builtin_amdgcn_fence(__ATOMIC_ACQUIRE, "agent");
        asm volatile("s_waitcnt vmcnt(0)" ::: "memory");
    }
    __syncthreads();
}
typedef const float* cfptr_t; typedef float* fptr_t; typedef unsigned char* ucptr_t;
typedef __attribute__((address_space(4))) const unsigned char* kargp_t;
struct KA {
    kargp_t kp;
    __device__ __forceinline__ const float* in(int i) const { return *(__attribute__((address_space(4))) const cfptr_t*)(kp + 8 * i); }
    __device__ __forceinline__ float* out() const { return *(__attribute__((address_space(4))) const fptr_t*)(kp + 160); }
    __device__ __forceinline__ unsigned char* ws() const { return *(__attribute__((address_space(4))) const ucptr_t*)(kp + 168); }
    __device__ __forceinline__ int ph_lo() const { return *(__attribute__((address_space(4))) const int*)(kp + 176); }
    __device__ __forceinline__ int ph_hi() const { return *(__attribute__((address_space(4))) const int*)(kp + 180); }
};
static_assert(sizeof(Args) == 184, "Args layout");
#define FRESH_LANE() ({ int l_; asm volatile("v_mbcnt_lo_u32_b32 %0, -1, 0\n\tv_mbcnt_hi_u32_b32 %0, -1, %0" : "=v"(l_)); l_; })
template <int PH>
__device__ __forceinline__ void run_phase(const KA& a, LAS unsigned char* lds, const int wave0, const int rep) {
    const int G = gridDim.x, wave = wave0;
    int bx = blockIdx.x;
    if constexpr (PH != 0) bx = __builtin_amdgcn_readfirstlane((int)((volatile LAS unsigned*)(lds + LDS_BYTES - 64))[3]);
    const int vcu = (G % 8 == 0) ? (bx % 8) * (G / 8) + bx / 8 : bx;
    const int gw = vcu * NWAVES + wave, NGW = G * NWAVES;
    unsigned char* ws = a.ws();
    bf16_t* xb = (bf16_t*)(ws + WS_XB); float* ssp0 = (float*)(ws + WS_SSP); float* ssp1 = ssp0 + (size_t)M * 16;
    bf16_t* xb2 = (bf16_t*)(ws + WS_W);
    bf16_t* act = (bf16_t*)(ws + WS_R + R_ACT); bf16_t* ob = XLO ? (bf16_t*)(ws + WS_R + R_O) : (bf16_t*)a.out();
    bf16_t* pb = (bf16_t*)(ws + WS_PB); bf16_t* proj = (bf16_t*)(ws + WS_PROJ);
    const float cscale = rep == 0 ? 1.0f : 0.0f;
    if constexpr (PH == 0) {
        prologue_phase(a, lds, gw, NGW, wave, FRESH_LANE(), G == 256);
        convert_p(a.in(1), pb, bx * NWAVES * 64 + wave0 * 64 + FRESH_LANE(), G * NWAVES * 64);
        att::build_luts(a.in(2), (float*)(ws + WS_LUT), bx * NWAVES * 64 + wave0 * 64 + FRESH_LANE(), G * NWAVES * 64);
    } else {
        constexpr int l = (PH - 1) >> 3, k = (PH - 1) & 7;
        const bf16_t* wl = (const bf16_t*)(ws + WS_W) + (size_t)l * W_LAYER;
        bf16_t* lo_def = (bf16_t*)a.out(); bf16_t* lo_alt = xb2;
        const bf16_t* lin = (l == DEPTH - 1 && k == 7) ? lo_alt : lo_def; bf16_t* lout = (l == DEPTH - 1 && k == 6) ? lo_alt : lo_def;
        if constexpr (k == 0 || k == 5) {
            pg8::Gemm g{(k == 0 && l == 1) ? xb2 : xb, wl + (k == 0 ? WO_F1IN : WO_F2IN), M, 2 * DFF, D}; pg8::StaticOrder S; S.init(M, 2 * DFF, G, bx);
#if PROBE_NULL_EPI == 1
            if (rep > 0) { pg8::EpiNull E; pg8::gemm_phase<pg8::EpiNull, pg8::StaticOrder, true, true>(lds, g, S, E, wave0 * 64 + FRESH_LANE()); } else
#endif
            { pg8::EpiSwiglu E{act, ssp0, (PROBE_NULL_EPI >= 2 && rep > 0 && rep < PROBE_N) ? PROBE_NULL_EPI - 1 : 0};
            pg8::gemm_phase<pg8::EpiSwiglu, pg8::StaticOrder, true, true>(lds, g, S, E, wave0 * 64 + FRESH_LANE()); }
            if (G == 256 && bx >= 128 && rep == 0) {
                const int widx = (bx - 128) * NWAVES + wave, nw = 128 * NWAVES, lane = FRESH_LANE();
                if constexpr (k == 0) convert_weight_items(a, lds, l * I_LAYER + IT_FOUT1, IT_FIN2 - IT_FOUT1, widx, nw, wave, lane, l * I_LAYER + IT_WP, I_WP, l * I_LAYER + IT_FOUT2, I_FOUT);
                else { convert_weight_items(a, lds, l * I_LAYER + IT_WG, I_SQ, widx, nw, wave, lane, (l + 1) * I_LAYER + IT_FIN1, (l + 1 < DEPTH) ? I_FIN : 0);
                       if (l + 1 < DEPTH) {
                                            convert_p(a.in(1) + (size_t)(l + 1) * M * PLE, pb, widx * 64 + lane, nw * 64); } }
            }
        } else if constexpr (k == 1 || k == 6) {
            pg8::Gemm g{act, wl + (k == 1 ? WO_F1OUT : WO_F2OUT), M, D, DFF}; pg8::StaticOrder S; S.init(M, D, G, bx);
#if PROBE_NULL_EPI == 1
            if (rep > 0) { pg8::EpiNull E0; pg8::gemm_phase<pg8::EpiNull, pg8::StaticOrder, true, true>(lds, g, S, E0, wave0 * 64 + FRESH_LANE()); return; }
#endif
            pg8::EpiResid E{(k == 1 && l > 0 && rep == 0) ? xb2 : xb, lin, xb, lout, ssp1, 0.5f * cscale};
            pg8::gemm_phase<pg8::EpiResid, pg8::StaticOrder, true, true>(lds, g, S, E, wave0 * 64 + FRESH_LANE());
        } else if constexpr (k == 2) {
            { pg8::Gemm g{xb, wl + WO_QKV, M, QKVW, D}; pg8::StaticOrder S; S.init(M, QKVW, G, bx);
              pg8::EpiQkv E; E.ssp = ssp1;
              E.qa = (bf16_t*)(ws + WS_R + R_QA); E.ka = (bf16_t*)(ws + WS_R + R_KA); E.va = (bf16_t*)(ws + WS_R + R_VA);
              E.qb = (bf16_t*)(ws + WS_R + R_QB); E.kb = (bf16_t*)(ws + WS_R + R_KB); E.vb = (bf16_t*)(ws + WS_R + R_VB);
              E.qna = a.in(8) + l * HD; E.kna = a.in(9) + l * HD; E.qnb = a.in(10) + l * HD; E.knb = a.in(11) + l * HD;
              pg8::gemm_phase<pg8::EpiQkv, pg8::StaticOrder, true, true>(lds, g, S, E, wave0 * 64 + FRESH_LANE()); }
            if (G != 256 || bx >= 64) {
              pg8::Gemm g{pb, wl + WO_WP, M, D, PLE}; pg8::StaticOrder S; if (G == 256) S.init(M, D, 192, bx - 64); else S.init(M, D, G, bx);
              pg8::EpiStoreBf16 E{proj, D};
              pg8::gemm_phase<pg8::EpiStoreBf16, pg8::StaticOrder, true, true>(lds, g, S, E, wave0 * 64 + FRESH_LANE()); }
            if (G == 256 && bx >= 128 && rep == 0)
                convert_weight_items(a, lds, l * I_LAYER + IT_FIN2, I_FIN, (bx - 128) * NWAVES + wave, 128 * NWAVES, wave, FRESH_LANE());
        } else if constexpr (k == 3) {
            att::Tensors T; T.qa = (bf16_t*)(ws + WS_R + R_QA); T.ka = (bf16_t*)(ws + WS_R + R_KA); T.va = (bf16_t*)(ws + WS_R + R_VA);
            T.qb = (bf16_t*)(ws + WS_R + R_QB); T.kb = (bf16_t*)(ws + WS_R + R_KB); T.vb = (bf16_t*)(ws + WS_R + R_VB);
            T.glut = (const float*)(ws + WS_LUT); T.sink = a.in(12) + l * 8; T.o = ob;
            const int lane = FRESH_LANE();
            for (int u = vcu; u < 256; u += G) att::attn_unit(T, u, lds, wave, lane, (PROBE_ATT_MODE && rep > 0) ? PROBE_ATT_MODE : 0x33);
        } else if constexpr (k == 4) {
            if (G != 256 && l + 1 < DEPTH) { convert_p(a.in(1) + (size_t)(l + 1) * M * PLE, pb, bx * NWAVES * 64 + wave0 * 64 + FRESH_LANE(), G * NWAVES * 64); asm volatile("s_waitcnt vmcnt(0)" ::: "memory"); }
            pg8::Gemm g{ob, wl + WO_WO, M, D, D}; pg8::StaticOrder S; S.init(M, D, G, bx);
            pg8::EpiResid E{xb, lin, xb, lout, ssp0, 1.0f * cscale};
            pg8::gemm_phase<pg8::EpiResid, pg8::StaticOrder, true, true>(lds, g, S, E, wave0 * 64 + FRESH_LANE());
        } else {
            pg8::Gemm g{xb, wl + WO_WG, M, D, D}; pg8::StaticOrder S; S.init(M, D, G, bx);
            pg8::EpiGate E{xb, lin, xb2, lout, (l == DEPTH - 1) ? a.out() : nullptr, ssp0, ssp1, proj, cscale};
            pg8::gemm_phase<pg8::EpiGate, pg8::StaticOrder, true, true>(lds, g, S, E, wave0 * 64 + FRESH_LANE());
        }
    }
}

__global__ void __launch_bounds__(NWAVES * 64, 2) mk_fwd(Args) {
    extern __shared__ __attribute__((aligned(16))) unsigned char lds_raw[];
    LAS unsigned char* lds = (LAS unsigned char*)lds_raw;
    cg::grid_group grid = cg::this_grid();
    const int wave0 = __builtin_amdgcn_readfirstlane(threadIdx.x >> 6);
    volatile LAS unsigned* bst = (volatile LAS unsigned*)((LAS unsigned char*)lds_raw + LDS_BYTES - 64);
    if (threadIdx.x < 8) bst[threadIdx.x] = threadIdx.x == 3 ? blockIdx.x : 0u;
    __syncthreads();
    KA a; a.kp = (kargp_t)__builtin_amdgcn_kernarg_segment_ptr();
    const int ph_lo = a.ph_lo(), ph_hi = a.ph_hi();
    XcdBarrier xbar; xbar.bar = (unsigned*)(a.ws() + WS_CTL) + 4096; xbar.x = 0; xbar.st = bst;
    unsigned xrank = 0u;
    if (ph_hi - ph_lo > 1) xbar = xcd_barrier_post((unsigned*)(a.ws() + WS_CTL) + 4096, bst, xrank);
    if (ph_lo < 0) grid.sync();
#define MK_NREP(P) ((PROBE_N > 0 && (((P) == 0 && PROBE_K == 8) || ((P) > 0 && (((P) - 1) & 7) == PROBE_K))) ? 1 + PROBE_N : 1)
#define MK_LOCAL(P) (LOCAL_SEAMS && (P) > 0 && ((((P) - 1) & 7) == 4 || (((P) - 1) & 7) == 5 || ((((P) - 1) & 7) == 7 && (P) + 1 < NPHASE)))
#define MK_PHASE(P) if (ph_lo <= (P) && (P) < ph_hi) { _Pragma("unroll 1") for (int rep = 0; rep < MK_NREP(P); ++rep) { asm volatile("" : "+s"(a.kp)); run_phase<(P)>(a, lds, wave0, rep); \
        if ((P) == 0 && rep == 0 && threadIdx.x == 0) bst[4] = xrank; \
        if ((P) + 1 < ph_hi || rep + 1 < MK_NREP(P)) { if (USE_CG_SYNC && (P) == 0) grid.sync(); else if (MK_LOCAL(P) && rep + 1 == MK_NREP(P) && bst[2] != 0u) xcd_local_barrier(xbar, wave0 == 0 && FRESH_LANE() == 0); else xcd_barrier(xbar, wave0 == 0 && FRESH_LANE() == 0); } } }
    MK_PHASE(0) MK_PHASE(1) MK_PHASE(2) MK_PHASE(3) MK_PHASE(4) MK_PHASE(5) MK_PHASE(6) MK_PHASE(7) MK_PHASE(8)
    MK_PHASE(9) MK_PHASE(10) MK_PHASE(11) MK_PHASE(12) MK_PHASE(13) MK_PHASE(14) MK_PHASE(15) MK_PHASE(16)
    static_assert(NPHASE == 17, "phase program");
}

constexpr size_t CTL_BYTES = 64 * 1024;
static_assert((4096 + 4480 + 64 * 16) * 4 <= CTL_BYTES, "barrier words inside the per-call memset");
extern "C" void kernel_launch(void* const* d_in, const int* in_sizes, int n_in, void* d_out, int out_size, void* d_ws, size_t ws_size, hipStream_t stream) {
    static int grid = 0;
    if (grid == 0) {
        if (n_in != 20 || in_sizes[0] != M * D || out_size != M * D || ws_size < WS_END) { fprintf(stderr, "kernel_launch: unexpected shapes (n_in %d, ws %zu)\n", n_in, ws_size); grid = -1; return; }
        int dev = 0, cus = 0, per_cu = 0;
        if (hipGetDevice(&dev) != hipSuccess || hipDeviceGetAttribute(&cus, hipDeviceAttributeMultiprocessorCount, dev) != hipSuccess) { grid = -1; return; }
        if (hipFuncSetAttribute((const void*)mk_fwd, hipFuncAttributeMaxDynamicSharedMemorySize, LDS_BYTES) != hipSuccess) { fprintf(stderr, "kernel_launch: hipFuncSetAttribute failed\n"); grid = -1; return; }
        if (hipOccupancyMaxActiveBlocksPerMultiprocessor(&per_cu, (const void*)mk_fwd, NWAVES * 64, LDS_BYTES) != hipSuccess || per_cu < 1) { fprintf(stderr, "kernel_launch: occupancy query says %d\n", per_cu); grid = -1; (void)hipGetLastError(); return; }
        grid = cus;
    }
    if (grid < 0) return;
    (void)hipMemsetAsync((char*)d_ws + WS_CTL, 0, CTL_BYTES, stream);
    Args a{};
    for (int i = 0; i < 20; ++i) a.in[i] = (const float*)d_in[i];
    a.out = (float*)d_out; a.ws = (unsigned char*)d_ws;
    a.ph_lo = 0; a.ph_hi = NPHASE;
    void* args[] = {&a};
    hipError_t e = hipLaunchCooperativeKernel((const void*)mk_fwd, dim3(grid), dim3(NWAVES * 64), args, LDS_BYTES, stream);
    if (e != hipSuccess) fprintf(stderr, "kernel_launch: cooperative launch failed: %s (grid %d)\n", hipGetErrorString(e), grid);
}
```
